# Optimizing an MI355X kernel written in HIP

```python
import jax, jax.numpy as jnp
from jax import lax
import numpy as np

D_MODEL = 2048
BATCH = 4
SEQ = 8192
DEPTH = 4
DEC_BATCH = 8
DEC_SEQ = 32
PAST_LEN = 1024

CHUNK = 64
CONV_DIM = D_MODEL // 4
CONV_WIDTH = 3
ATT_HEAD_DIM = 128
ATT_DIM = D_MODEL // 2
ATT_HEADS = ATT_DIM // ATT_HEAD_DIM
BAND_CHUNKS = 8
BAND_PAST = BAND_CHUNKS * CHUNK
BAND_LEN = BAND_PAST + CHUNK
MAX_REL = 128
ML_HEAD_DIM = 128
ML_DIM = D_MODEL // 4
ML_HEADS = ML_DIM // ML_HEAD_DIM
D_FF = 4 * D_MODEL
EPS = 1e-6
NEG_INF = -1e30
IN_SPLITS = (CONV_DIM, CONV_DIM, CONV_DIM, ATT_DIM, ATT_DIM, ATT_DIM, ML_DIM, ML_DIM, ML_DIM, ML_DIM, ML_HEADS, ML_HEADS)
IN_DIM = sum(IN_SPLITS)

kernel_name = "hybrid_streaming_encoder_step"


def rmsnorm(x, g):
    xf = x.astype(jnp.float32)
    y = xf * lax.rsqrt(jnp.mean(xf * xf, axis=-1, keepdims=True) + EPS)
    return (y * g.astype(jnp.float32)).astype(x.dtype)


def split_proj(proj):
    idx = [int(i) for i in np.cumsum(IN_SPLITS)[:-1]]
    return jnp.split(proj, idx, axis=-1)


def short_conv(xa, gate_b, gate_c, conv_w, buf):
    u = gate_c * xa
    u_ext = jnp.concatenate([buf.astype(u.dtype), u], axis=1)
    L = u.shape[1]
    y = sum(conv_w[j] * u_ext[:, j:j + L] for j in range(CONV_WIDTH))
    return gate_b * y, u_ext[:, -(CONV_WIDTH - 1):]


def band_attention(q, k, v, q_pos, k_pos, k_valid, rel_bias):
    s = jnp.einsum('bqhd,bkhd->bhqk', q, k).astype(jnp.float32) * (ATT_HEAD_DIM ** -0.5)
    rel = jnp.clip(q_pos[:, None] - k_pos[None, :], -MAX_REL, MAX_REL) + MAX_REL
    s = s + rel_bias.astype(jnp.float32)[:, rel][None]
    s = jnp.where(k_valid[None, None, None, :], s, NEG_INF)
    p = jax.nn.softmax(s, axis=-1)
    return jnp.einsum('bhqk,bkhd->bqhd', p.astype(v.dtype), v)


def prompt_attention(q, k, v, rel_bias):
    B, L = q.shape[0], q.shape[1]
    nc = L // CHUNK
    pad = ((0, 0), (BAND_PAST, 0), (0, 0), (0, 0))
    kp = jnp.pad(k, pad)
    vp = jnp.pad(v, pad)

    def one_chunk(c):
        start = c * CHUNK
        qc = lax.dynamic_slice_in_dim(q, start, CHUNK, axis=1)
        kb = lax.dynamic_slice_in_dim(kp, start, BAND_LEN, axis=1)
        vb = lax.dynamic_slice_in_dim(vp, start, BAND_LEN, axis=1)
        q_pos = start + jnp.arange(CHUNK)
        k_pos = start - BAND_PAST + jnp.arange(BAND_LEN)
        return band_attention(qc, kb, vb, q_pos, k_pos, k_pos >= 0, rel_bias)

    out = lax.map(one_chunk, jnp.arange(nc))
    return out.transpose(1, 0, 2, 3, 4).reshape(B, L, ATT_HEADS, ATT_HEAD_DIM)


def mlstm_chunk(state, q, k, v, log_i, log_f):
    c0, n0, m0 = state
    L = q.shape[2]
    b = jnp.cumsum(log_f, axis=-1)
    causal = jnp.tril(jnp.ones((L, L), dtype=bool))
    d = jnp.where(causal, b[..., :, None] - b[..., None, :] + log_i[..., None, :], -jnp.inf)
    inter = b + m0[..., None]
    m = jnp.maximum(inter, jnp.max(d, axis=-1))
    w_intra = jnp.exp(d - m[..., None])
    w_inter = jnp.exp(inter - m)
    s = jnp.einsum('bhtd,bhsd->bhts', q, k) * w_intra
    num = w_inter[..., None] * jnp.einsum('bhtd,bhde->bhte', q, c0) + jnp.einsum('bhts,bhse->bhte', s, v)
    den = w_inter * jnp.einsum('bhtd,bhd->bht', q, n0) + jnp.sum(s, axis=-1)
    h = num / jnp.maximum(jnp.abs(den), jnp.exp(-m))[..., None]
    b_last = b[..., -1]
    g = b_last[..., None] - b + log_i
    m_new = jnp.maximum(b_last + m0, jnp.max(g, axis=-1))
    w_state = jnp.exp(g - m_new[..., None])
    decay = jnp.exp(b_last + m0 - m_new)
    kw = k * w_state[..., None]
    c_new = decay[..., None, None] * c0 + jnp.einsum('bhsd,bhse->bhde', kw, v)
    n_new = decay[..., None] * n0 + jnp.sum(kw, axis=2)
    return (c_new, n_new, m_new), h


def mlstm_prompt(q, k, v, li, lf):
    B, L = q.shape[0], q.shape[1]
    nc = L // CHUNK

    def to_chunks4(a):
        return a.reshape(B, nc, CHUNK, ML_HEADS, ML_HEAD_DIM).transpose(1, 0, 3, 2, 4)

    def to_chunks3(a):
        return a.reshape(B, nc, CHUNK, ML_HEADS).transpose(1, 0, 3, 2)

    init = (jnp.zeros((B, ML_HEADS, ML_HEAD_DIM, ML_HEAD_DIM), jnp.float32),
            jnp.zeros((B, ML_HEADS, ML_HEAD_DIM), jnp.float32),
            jnp.zeros((B, ML_HEADS), jnp.float32))

    def step(carry, xs):
        return mlstm_chunk(carry, *xs)

    xs = (to_chunks4(q), to_chunks4(k), to_chunks4(v), to_chunks3(li), to_chunks3(lf))
    final, h = lax.scan(step, init, xs)
    h = h.transpose(1, 0, 3, 2, 4).reshape(B, L, ML_HEADS, ML_HEAD_DIM)
    return h, final


def mlstm_sample(q, k, v, li, lf, state):
    st = tuple(a.astype(jnp.float32) for a in state)
    new_state, h = mlstm_chunk(st, q.transpose(0, 2, 1, 3), k.transpose(0, 2, 1, 3), v.transpose(0, 2, 1, 3),
                               li.transpose(0, 2, 1), lf.transpose(0, 2, 1))
    return h.transpose(0, 2, 1, 3), new_state


def trunk_layer(x, conv_buf, past_k, past_v, ml_state, norm_mix_g, w_in, conv_w, q_norm_g, k_norm_g, rel_bias,
                b_igate, b_fgate, mlstm_norm_g, w_out, norm_mlp_g, w_up, w_down):
    B, L, _ = x.shape
    h = rmsnorm(x, norm_mix_g)
    xa, gb, gc, q, k, v, mq, mk, mv, mo, ig, fg = split_proj(h @ w_in)
    ya, conv_new = short_conv(xa, gb, gc, conv_w, conv_buf)
    q = rmsnorm(q.reshape(B, L, ATT_HEADS, ATT_HEAD_DIM), q_norm_g)
    k = rmsnorm(k.reshape(B, L, ATT_HEADS, ATT_HEAD_DIM), k_norm_g)
    v = v.reshape(B, L, ATT_HEADS, ATT_HEAD_DIM)
    if past_k is None:
        att = prompt_attention(q, k, v, rel_bias)
        keep = min(BAND_PAST, L)
        k_rows, v_rows = k[:, L - keep:], v[:, L - keep:]
    else:
        lc = past_k.shape[1]
        kb = jnp.concatenate([past_k.astype(k.dtype), k], axis=1)
        vb = jnp.concatenate([past_v.astype(v.dtype), v], axis=1)
        k_pos = jnp.arange(-lc, L)
        att = band_attention(q, kb, vb, jnp.arange(L), k_pos, jnp.ones((lc + L,), dtype=bool), rel_bias)
        k_rows, v_rows = k, v
    mq = mq.reshape(B, L, ML_HEADS, ML_HEAD_DIM).astype(jnp.float32)
    mk = mk.reshape(B, L, ML_HEADS, ML_HEAD_DIM).astype(jnp.float32) * (ML_HEAD_DIM ** -0.5)
    mv = mv.reshape(B, L, ML_HEADS, ML_HEAD_DIM).astype(jnp.float32)
    li = (ig + b_igate).astype(jnp.float32)
    lf = jax.nn.log_sigmoid((fg + b_fgate).astype(jnp.float32))
    if ml_state is None:
        h_ml, ml_new = mlstm_prompt(mq, mk, mv, li, lf)
    else:
        h_ml, ml_new = mlstm_sample(mq, mk, mv, li, lf, ml_state)
    yc = rmsnorm(h_ml, mlstm_norm_g.reshape(ML_HEADS, ML_HEAD_DIM)).astype(x.dtype)
    yc = yc * jax.nn.sigmoid(mo).reshape(B, L, ML_HEADS, ML_HEAD_DIM)
    mixed = jnp.concatenate([ya, att.reshape(B, L, ATT_DIM), yc.reshape(B, L, ML_DIM)], axis=-1)
    x = x + mixed @ w_out
    h2 = rmsnorm(x, norm_mlp_g)
    x = x + jnp.square(jax.nn.relu(h2 @ w_up)) @ w_down
    return x, conv_new, k_rows, v_rows, ml_new


def setup_inputs(seed: int = 0) -> dict:
    key = jax.random.key(seed)
    ks = jax.random.split(key, 24)

    def nrm(k, shape, scale):
        return jax.random.normal(k, shape, jnp.float32) * scale

    att_rows = min(BAND_PAST, PAST_LEN)
    return {
        "x_prompt": nrm(ks[0], (BATCH, SEQ, D_MODEL), 1.0),
        "x_sample": nrm(ks[1], (DEC_BATCH, DEC_SEQ, D_MODEL), 1.0),
        "cache_att_k": nrm(ks[2], (DEPTH, DEC_BATCH, att_rows, ATT_HEADS, ATT_HEAD_DIM), 1.0),
        "cache_att_v": nrm(ks[3], (DEPTH, DEC_BATCH, att_rows, ATT_HEADS, ATT_HEAD_DIM), 1.0),
        "state_conv": nrm(ks[4], (DEPTH, DEC_BATCH, CONV_WIDTH - 1, CONV_DIM), 1.0),
        "state_mlstm_c": nrm(ks[5], (DEPTH, DEC_BATCH, ML_HEADS, ML_HEAD_DIM, ML_HEAD_DIM), 0.5),
        "state_mlstm_n": nrm(ks[6], (DEPTH, DEC_BATCH, ML_HEADS, ML_HEAD_DIM), 0.5),
        "state_mlstm_m": nrm(ks[7], (DEPTH, DEC_BATCH, ML_HEADS), 1.0),
        "norm_mix_g": 1.0 + nrm(ks[8], (DEPTH, D_MODEL), 0.05),
        "w_in": nrm(ks[9], (DEPTH, D_MODEL, IN_DIM), D_MODEL ** -0.5),
        "conv_w": nrm(ks[10], (DEPTH, CONV_WIDTH, CONV_DIM), CONV_WIDTH ** -0.5),
        "q_norm_g": 1.0 + nrm(ks[11], (DEPTH, ATT_HEAD_DIM), 0.05),
        "k_norm_g": 1.0 + nrm(ks[12], (DEPTH, ATT_HEAD_DIM), 0.05),
        "rel_bias": nrm(ks[13], (DEPTH, ATT_HEADS, 2 * MAX_REL + 1), 0.2),
        "b_igate": nrm(ks[14], (DEPTH, ML_HEADS), 0.1),
        "b_fgate": jnp.linspace(3.0, 6.0, ML_HEADS, dtype=jnp.float32)[None, :] + nrm(ks[15], (DEPTH, ML_HEADS), 0.1),
        "mlstm_norm_g": 1.0 + nrm(ks[16], (DEPTH, ML_DIM), 0.05),
        "w_out": nrm(ks[17], (DEPTH, D_MODEL, D_MODEL), D_MODEL ** -0.5),
        "norm_mlp_g": 1.0 + nrm(ks[18], (DEPTH, D_MODEL), 0.05),
        "w_up": nrm(ks[19], (DEPTH, D_MODEL, D_FF), D_MODEL ** -0.5),
        "w_down": nrm(ks[20], (DEPTH, D_FF, D_MODEL), D_FF ** -0.5),
    }


def reference(x_prompt, x_sample, cache_att_k, cache_att_v, state_conv, state_mlstm_c, state_mlstm_n, state_mlstm_m,
              norm_mix_g, w_in, conv_w, q_norm_g, k_norm_g, rel_bias, b_igate, b_fgate, mlstm_norm_g, w_out,
              norm_mlp_g, w_up, w_down):
    yp, ys = x_prompt, x_sample
    pc, pk, pv, pcc, pn, pm = [], [], [], [], [], []
    sc, sk, sv, scc, sn, sm = [], [], [], [], [], []
    for l in range(DEPTH):
        params = (norm_mix_g[l], w_in[l], conv_w[l], q_norm_g[l], k_norm_g[l], rel_bias[l], b_igate[l], b_fgate[l],
                  mlstm_norm_g[l], w_out[l], norm_mlp_g[l], w_up[l], w_down[l])
        zero_buf = jnp.zeros((yp.shape[0], CONV_WIDTH - 1, CONV_DIM), yp.dtype)
        yp, cb, kr, vr, (c_, n_, m_) = trunk_layer(yp, zero_buf, None, None, None, *params)
        pc.append(cb); pk.append(kr); pv.append(vr); pcc.append(c_); pn.append(n_); pm.append(m_)
        ys, cb, kr, vr, (c_, n_, m_) = trunk_layer(ys, state_conv[l], cache_att_k[l], cache_att_v[l],
                                                   (state_mlstm_c[l], state_mlstm_n[l], state_mlstm_m[l]), *params)
        sc.append(cb); sk.append(kr); sv.append(vr); scc.append(c_); sn.append(n_); sm.append(m_)
    p_conv, p_k, p_v = jnp.stack(pc), jnp.stack(pk), jnp.stack(pv)
    p_c, p_n, p_m = jnp.stack(pcc), jnp.stack(pn), jnp.stack(pm)
    s_conv, s_k, s_v = jnp.stack(sc), jnp.stack(sk), jnp.stack(sv)
    s_c, s_n, s_m = jnp.stack(scc), jnp.stack(sn), jnp.stack(sm)
    return (yp, ys, p_conv, p_k, p_v, p_c, p_n, p_m, s_conv, s_k, s_v, s_c, s_n, s_m)
```

```cpp
#include <hip/hip_runtime.h>
#include <cstdio>
#include <cstdint>

#ifndef MK_PER_PHASE
#define MK_PER_PHASE 0
#endif

#ifndef PH_EN
#define PH_EN 0x3ff
#endif
#ifndef PE_EN
#define PE_EN 0xf
#endif
#ifndef WGM_B
#define WGM_B 4
#endif
#ifndef WGM_F
#define WGM_F 4
#endif
#ifndef WGM_H
#define WGM_H 4
#endif
#ifndef WGM_I
#define WGM_I 4
#endif
#ifndef PH_DUP
#define PH_DUP 0
#endif
#define LAS __attribute__((address_space(3)))
#define GAS __attribute__((address_space(1)))
typedef unsigned short bf16;
typedef short bf16x8 __attribute__((ext_vector_type(8)));
typedef short s16x4 __attribute__((ext_vector_type(4)));
typedef float f32x2 __attribute__((ext_vector_type(2)));
typedef float f32x4 __attribute__((ext_vector_type(4)));
typedef float f32x16 __attribute__((ext_vector_type(16)));
typedef unsigned u32x2 __attribute__((ext_vector_type(2)));
typedef unsigned u32x4 __attribute__((ext_vector_type(4)));

constexpr int D = 2048, NB = 4, SEQ = 8192, DEPTH = 4, SBATCH = 8, SSEQ = 32;
constexpr int MP = NB * SEQ, MS = SBATCH * SSEQ, MR = MP + MS;
constexpr int NH = 8, HD = 128, MH = 4;
constexpr int NPROJ = 6656, IN_DIM = 6664, FF = 8192;
constexpr int C_XA = 0, C_GB = 512, C_GC = 1024, C_Q = 1536, C_K = 2560, C_V = 3584, C_MQ = 4608, C_MK = 5120, C_MV = 5632, C_MO = 6144;
constexpr int KEEP = 512;
constexpr int SKV_ROWS = 640;
constexpr float EPS = 1e-6f;
constexpr float LOG2E = 1.4426950408889634f;
constexpr int NGRP = SEQ / 256;

constexpr size_t O_YP = 0, O_YS = O_YP + (size_t)MP * D, O_PCONV = O_YS + (size_t)MS * D, O_PK = O_PCONV + (size_t)DEPTH * NB * 2 * 512,
                 O_PV = O_PK + (size_t)DEPTH * NB * KEEP * 1024, O_PC = O_PV + (size_t)DEPTH * NB * KEEP * 1024, O_PN = O_PC + (size_t)DEPTH * NB * MH * HD * HD,
                 O_PM = O_PN + (size_t)DEPTH * NB * MH * HD, O_SCONV = O_PM + (size_t)DEPTH * NB * MH, O_SK = O_SCONV + (size_t)DEPTH * SBATCH * 2 * 512,
                 O_SV = O_SK + (size_t)DEPTH * SBATCH * SSEQ * 1024, O_SC = O_SV + (size_t)DEPTH * SBATCH * SSEQ * 1024, O_SN = O_SC + (size_t)DEPTH * SBATCH * MH * HD * HD,
                 O_SM = O_SN + (size_t)DEPTH * SBATCH * MH * HD, O_END = O_SM + (size_t)DEPTH * SBATCH * MH;

constexpr size_t al256(size_t x) { return (x + 255) / 256 * 256; }
constexpr size_t WS_CTL = 0, CTL_BYTES = 1u << 20;
constexpr size_t WS_WIN = CTL_BYTES;
constexpr size_t WS_WOUT = WS_WIN + (size_t)NPROJ * D * 2;
constexpr size_t WS_WUP = WS_WOUT + (size_t)D * D * 2;
constexpr size_t WS_WDN = WS_WUP + (size_t)FF * D * 2;
constexpr size_t WS_H = WS_WDN + (size_t)D * FF * 2;
constexpr size_t WS_XB = WS_H + (size_t)MR * D * 2;
constexpr size_t WS_BIG = WS_XB + (size_t)MR * D * 2;
constexpr size_t BIG_BYTES = (size_t)MR * FF * 2;
constexpr size_t WS_CLOC = WS_BIG + al256((size_t)MR * NPROJ * 2);
constexpr size_t WS_C0 = WS_CLOC + (size_t)16 * NGRP * HD * HD * 4;
constexpr size_t WS_NLOC = WS_C0 + (size_t)16 * NGRP * HD * HD * 2;
constexpr size_t WS_N0 = WS_NLOC + (size_t)16 * NGRP * HD * 4;
constexpr size_t WS_MSC = WS_N0 + (size_t)16 * NGRP * HD * 4;
constexpr size_t WS_MIX_END = WS_MSC + (size_t)16 * NGRP * 4 * 4;
static_assert(WS_MIX_END <= WS_BIG + BIG_BYTES, "mLSTM scratch fits in the free top of BIG");
constexpr size_t WS_GATE = WS_BIG + BIG_BYTES;
constexpr size_t SKV_IMG = (size_t)SBATCH * SKV_ROWS * 1024 * 2;
constexpr size_t WS_SK = WS_GATE + (size_t)MR * 8 * 4;
constexpr size_t WS_SV = WS_SK + 2 * SKV_IMG;
constexpr size_t WS_RSTD = WS_SV + 2 * SKV_IMG;
constexpr size_t WS_PART = WS_RSTD + (size_t)MR * 4;
constexpr size_t WS_PARTS = WS_PART + (size_t)8 * MP * 4;
constexpr size_t WS_END = WS_PARTS + (size_t)32 * MS * 4;
static_assert(WS_END <= 1235000000ull, "workspace budget");

constexpr int RING_BYTES = 131072;
constexpr int MISC_OFF = RING_BYTES;
constexpr int SCR_OFF = MISC_OFF + 256;
constexpr int LDS_BYTES = 147456;
constexpr int NWAVES = 8, NTHREADS = 512;

__device__ __forceinline__ unsigned cvtpk(float lo, float hi) { unsigned r; asm volatile("v_cvt_pk_bf16_f32 %0, %1, %2" : "=v"(r) : "v"(lo), "v"(hi)); return r; }
__device__ __forceinline__ float bflo(unsigned w) { return __uint_as_float(w << 16); }
__device__ __forceinline__ float bfhi(unsigned w) { return __uint_as_float(w & 0xffff0000u); }
__device__ __forceinline__ float bf2f(bf16 b) { return __uint_as_float(((unsigned)b) << 16); }
__device__ __forceinline__ float shx(float v, int o, int lane) { return __int_as_float(__builtin_amdgcn_ds_bpermute((lane ^ o) << 2, __float_as_int(v))); }
__device__ __forceinline__ float shup(float v, int o, int lane) { const int s = lane - o; return __int_as_float(__builtin_amdgcn_ds_bpermute((s < 0 ? lane : s) << 2, __float_as_int(v))); }
__device__ __forceinline__ float wave_sum(float v, int lane) {
#pragma unroll
    for (int o = 1; o < 64; o <<= 1) v += shx(v, o, lane);
    return v;
}
__device__ __forceinline__ float fast_rsqrt(float x) { return __builtin_amdgcn_rsqf(x); }
__device__ __forceinline__ float fast_exp(float x) { return __builtin_amdgcn_exp2f(x * 1.4426950408889634f); }
__device__ __forceinline__ float fast_log(float x) { return __builtin_amdgcn_logf(x) * 0.6931471805599453f; }
__device__ __forceinline__ float opaque_zero() { float z; asm volatile("v_mov_b32 %0, 0" : "=v"(z)); return z; }
#define LDS_WAIT() asm volatile("s_waitcnt lgkmcnt(0)" ::: "memory")
#define VM_WAIT() asm volatile("s_waitcnt vmcnt(0)" ::: "memory")
#define SBAR() __builtin_amdgcn_sched_barrier(0)

namespace pg8 {
typedef unsigned short bf16_t;
constexpr int MP_ROWS = 32768;
constexpr int BM = 256, BK = 64, HALF = 128, HTB = HALF * BK * 2, STAGE_BYTES = 8 * HTB, NXCD = 8, WGM = 4;
__host__ __device__ __forceinline__ int lds_byte(int r, int c) { const int st = (r >> 4) * 2 + (c >> 5), rr = r & 15, cc = c & 31, ob = rr * 64 + cc * 2; return st * 1024 + (ob ^ (((ob >> 9) & 1) << 5)); }
__host__ __device__ __forceinline__ void stage_rc(int b, int& R, int& C) { const int st = b / 1024, sb = b % 1024, swz = sb ^ (((sb >> 9) & 1) << 5); R = (st >> 1) * 16 + swz / 64; C = (st & 1) * 32 + (swz % 64) / 2; }
__host__ __device__ __forceinline__ int perm32(int rho) { const int n = rho >> 4, i = rho & 15; return 8 * (i >> 2) + 4 * n + (i & 3); }
struct Unit { int pm, pn; };
struct Gemm { const bf16_t* A; const bf16_t* Bt; int M, N, K; };
struct StaticOrder {
    int nM, nN, nwg, G, c, wgm;
    __host__ __device__ void init(int M, int N, int G_, int c_, int wgm_ = WGM) { nM = M / BM; nN = N / BM; nwg = nM * nN; G = G_; c = c_; wgm = wgm_; }
    __host__ __device__ bool next(int i, Unit& u) const {
        const long L = (long)i * G + c; if (L >= nwg) return false;
        int wgid = (int)L; { const int q = nwg / NXCD, r = nwg % NXCD, xcd = wgid % NXCD, off = wgid / NXCD; wgid = (xcd < r ? xcd * (q + 1) : r * (q + 1) + (xcd - r) * q) + off; }
        const int nig = wgm * nN, gid = wgid / nig, fm = gid * wgm, gsz = (nM - fm) < wgm ? (nM - fm) : wgm;
        u.pm = fm + ((wgid % nig) % gsz); u.pn = (wgid % nig) / gsz; return true;
    }
    __device__ __forceinline__ void a_ready(const Unit&) const {}
    __device__ __forceinline__ void done(const Unit&) const {}
};
template <int ACT  > struct EpiBf16 {
    static constexpr bool PERM = true, AFTER_DRAIN = false;
    static constexpr bool RSL = true;
    bf16_t* O; int ldc; const float* rstd; LAS float* T; int npart;
    __device__ __forceinline__ void rs_fetch(const Unit& u, int tid, int par) const { if (rstd && tid < BM) {
        float v;
        if (npart) { float s = 0.f;
#pragma unroll
            for (int p = 0; p < 8; ++p) s += rstd[(size_t)p * MP_ROWS + u.pm * BM + tid];
            v = fast_rsqrt(s * (1.0f / 2048.0f) + 1e-6f); }
        else v = rstd[u.pm * BM + tid];
        (T + 2048 + par * BM)[tid] = v; } }
    __device__ __forceinline__ void operator()(const f32x4 (&acc)[2][2][4][2], const Unit& u, int wr, int wc, int fr, int fq, int par) const {
        const int row0 = u.pm * BM + wr * 64 + fr; const int col0 = u.pn * BM + wc * 32 + 8 * fq;
#pragma unroll
        for (int ai = 0; ai < 2; ++ai)
#pragma unroll
            for (int m = 0; m < 4; ++m) { bf16_t* rowp = O + (size_t)(row0 + ai * HALF + m * 16) * ldc + col0; const float rsv = rstd ? (T + 2048 + par * BM)[wr * 64 + fr + ai * HALF + m * 16] : 1.0f;
#pragma unroll
                for (int bj = 0; bj < 2; ++bj) { f32x4 v0 = acc[ai][bj][m][0] * rsv, v1 = acc[ai][bj][m][1] * rsv;
                    if (ACT == 1) {
#pragma unroll
                        for (int j = 0; j < 4; ++j) { const float a = fmaxf(v0[j], 0.f), b = fmaxf(v1[j], 0.f); v0[j] = a * a; v1[j] = b * b; } }
                    u32x4 w; w.x = cvtpk(v0[0], v0[1]); w.y = cvtpk(v0[2], v0[3]); w.z = cvtpk(v1[0], v1[1]); w.w = cvtpk(v1[2], v1[3]);
                    *(u32x4*)(rowp + bj * HALF) = w; } }
    }
};
struct EpiProj {
    static constexpr bool PERM = true, AFTER_DRAIN = false;
    static constexpr bool RSL = true;
    bf16_t* O; int ldc; const float* gq; const float* gk; LAS float* T; const float* rstd;
    __device__ __forceinline__ void rs_fetch(const Unit& u, int tid, int par) const { if (tid < BM) (T + 2048 + par * BM)[tid] = rstd[u.pm * BM + tid]; }
    __device__ __forceinline__ void operator()(const f32x4 (&acc)[2][2][4][2], const Unit& u, int wr, int wc, int fr, int fq, int par) const {
        const int row0 = u.pm * BM + wr * 64 + fr; const int col0 = u.pn * BM + wc * 32 + 8 * fq;
        const bool isqk = (u.pn >= 6) && (u.pn < 14);
        float rs[2][4];
#pragma unroll
        for (int ai = 0; ai < 2; ++ai)
#pragma unroll
            for (int m = 0; m < 4; ++m) rs[ai][m] = (T + 2048 + par * BM)[wr * 64 + fr + ai * HALF + m * 16];
        if (!isqk) {
#pragma unroll
            for (int ai = 0; ai < 2; ++ai)
#pragma unroll
                for (int m = 0; m < 4; ++m) { bf16_t* rowp = O + (size_t)(row0 + ai * HALF + m * 16) * ldc + col0;
#pragma unroll
                    for (int bj = 0; bj < 2; ++bj) { const f32x4 v0 = acc[ai][bj][m][0] * rs[ai][m], v1 = acc[ai][bj][m][1] * rs[ai][m];
                        u32x4 w; w.x = cvtpk(v0[0], v0[1]); w.y = cvtpk(v0[2], v0[3]); w.z = cvtpk(v1[0], v1[1]); w.w = cvtpk(v1[2], v1[3]);
                        *(u32x4*)(rowp + bj * HALF) = w; } }
            return;
        }
        const int lane = fr + 16 * fq;
        float ss[2][4][2];
#pragma unroll
        for (int ai = 0; ai < 2; ++ai)
#pragma unroll
            for (int m = 0; m < 4; ++m)
#pragma unroll
                for (int bj = 0; bj < 2; ++bj) { const f32x4 v0 = acc[ai][bj][m][0] * rs[ai][m], v1 = acc[ai][bj][m][1] * rs[ai][m];
                    float s = (v0[0] * v0[0] + v0[1] * v0[1]) + (v0[2] * v0[2] + v0[3] * v0[3]) + (v1[0] * v1[0] + v1[1] * v1[1]) + (v1[2] * v1[2] + v1[3] * v1[3]);
                    s += shx(s, 16, lane); s += shx(s, 32, lane); ss[ai][m][bj] = s; }
        if (fq == 0) {
#pragma unroll
            for (int ai = 0; ai < 2; ++ai)
#pragma unroll
                for (int m = 0; m < 4; ++m)
#pragma unroll
                    for (int bj = 0; bj < 2; ++bj) T[(ai * HALF + wr * 64 + m * 16 + fr) * 8 + bj * 4 + wc] = ss[ai][m][bj];
        }
        asm volatile("s_waitcnt lgkmcnt(0)" ::: "memory"); __builtin_amdgcn_s_barrier(); asm volatile("" ::: "memory");
        const float* gg = ((u.pn < 10) ? gq : gk) + wc * 32 + 8 * fq;
        const f32x4 g0 = *(const f32x4*)gg, g1 = *(const f32x4*)(gg + 4);
#pragma unroll
        for (int ai = 0; ai < 2; ++ai)
#pragma unroll
            for (int m = 0; m < 4; ++m) { bf16_t* rowp = O + (size_t)(row0 + ai * HALF + m * 16) * ldc + col0;
#pragma unroll
                for (int bj = 0; bj < 2; ++bj) { const f32x4 t = *(const LAS f32x4*)(T + (ai * HALF + wr * 64 + m * 16 + fr) * 8 + bj * 4);
                    const float rq = fast_rsqrt(((t[0] + t[1]) + (t[2] + t[3])) * (1.0f / 128.0f) + 1e-6f) * rs[ai][m];
                    const f32x4 v0 = acc[ai][bj][m][0] * rq * g0, v1 = acc[ai][bj][m][1] * rq * g1;
                    u32x4 w; w.x = cvtpk(v0[0], v0[1]); w.y = cvtpk(v0[2], v0[3]); w.z = cvtpk(v1[0], v1[1]); w.w = cvtpk(v1[2], v1[3]);
                    *(u32x4*)(rowp + bj * HALF) = w; } }
    }
};
struct EpiResAdd {
    static constexpr bool RSL = false;
    static constexpr bool PERM = true, AFTER_DRAIN = false;
    bf16_t* XB; float* Y; int ldc; bool fin; float* part; LAS float* T;
    __device__ __forceinline__ void operator()(const f32x4 (&acc)[2][2][4][2], const Unit& u, int wr, int wc, int fr, int fq, int) const {
        const int row0 = u.pm * BM + wr * 64 + fr, col0 = u.pn * BM + wc * 32 + 8 * fq;
        float ss[2][4];
#pragma unroll
        for (int ai = 0; ai < 2; ++ai)
#pragma unroll
            for (int m = 0; m < 4; ++m) ss[ai][m] = 0.f;
        u32x4 r[2][4][2];
#pragma unroll
        for (int ai = 0; ai < 2; ++ai)
#pragma unroll
            for (int m = 0; m < 4; ++m)
#pragma unroll
                for (int bj = 0; bj < 2; ++bj) r[ai][m][bj] = *(const u32x4*)(XB + (size_t)(row0 + ai * HALF + m * 16) * ldc + col0 + bj * HALF);
#pragma unroll
        for (int ai = 0; ai < 2; ++ai)
#pragma unroll
            for (int m = 0; m < 4; ++m)
#pragma unroll
                for (int bj = 0; bj < 2; ++bj) { const u32x4 w = r[ai][m][bj]; const f32x4 a0 = acc[ai][bj][m][0], a1 = acc[ai][bj][m][1];
                    const f32x4 v0 = (f32x4){bflo(w.x) + a0[0], bfhi(w.x) + a0[1], bflo(w.y) + a0[2], bfhi(w.y) + a0[3]}, v1 = (f32x4){bflo(w.z) + a1[0], bfhi(w.z) + a1[1], bflo(w.w) + a1[2], bfhi(w.w) + a1[3]};
                    const size_t off = (size_t)(row0 + ai * HALF + m * 16) * ldc + col0 + bj * HALF;
                    ss[ai][m] += (v0[0] * v0[0] + v0[1] * v0[1]) + (v0[2] * v0[2] + v0[3] * v0[3]) + (v1[0] * v1[0] + v1[1] * v1[1]) + (v1[2] * v1[2] + v1[3] * v1[3]);
                    if (fin) { *(f32x4*)(Y + off) = v0; *(f32x4*)(Y + off + 4) = v1; }
                    else { u32x4 o; o.x = cvtpk(v0[0], v0[1]); o.y = cvtpk(v0[2], v0[3]); o.z = cvtpk(v1[0], v1[1]); o.w = cvtpk(v1[2], v1[3]); *(u32x4*)(XB + off) = o; } }
        if (part) {
            const int lane = fr + 16 * fq;
#pragma unroll
            for (int ai = 0; ai < 2; ++ai)
#pragma unroll
                for (int m = 0; m < 4; ++m) { float s = ss[ai][m]; s += shx(s, 16, lane); s += shx(s, 32, lane);
                    if (fq == 0) T[(ai * HALF + wr * 64 + m * 16 + fr) * 4 + wc] = s; }
            asm volatile("s_waitcnt lgkmcnt(0)" ::: "memory"); __builtin_amdgcn_s_barrier(); asm volatile("" ::: "memory");
            const int tid = (wr * 4 + wc) * 64 + lane;
            if (tid < BM) { const f32x4 t = *(const LAS f32x4*)(T + tid * 4); part[(size_t)u.pn * MP_ROWS + u.pm * BM + tid] = (t[0] + t[1]) + (t[2] + t[3]); }
        }
    }
};

template <class Epi, class Sched, bool ALIGN_EPI = false, bool SP2 = false>
__device__ __forceinline__ void gemm_phase(LAS unsigned char* lds, const Gemm g, const Sched& S, const Epi& E, const int wave_) {
    int ln_; asm volatile("v_mbcnt_lo_u32_b32 %0, -1, 0\n\tv_mbcnt_hi_u32_b32 %0, -1, %0" : "=v"(ln_)); const int tid = wave_ * 64 + ln_;
    const int wid = __builtin_amdgcn_readfirstlane(tid >> 6), lane = tid & 63, wr = wid >> 2, wc = wid & 3, fr = lane & 15, fq = lane >> 4;
    const int K = g.K, nt = K / BK;
    unsigned voffA[2], voffB[2];
#pragma unroll
    for (int i = 0; i < 2; ++i) { int R, C; stage_rc(tid * 16 + i * 8192, R, C); const int Rb = Epi::PERM ? ((R & ~31) + perm32(R & 31)) : R;
        voffA[i] = (unsigned)(R * K + C) * 2u; voffB[i] = (unsigned)(Rb * K + C) * 2u; }
    const size_t kstep = (size_t)(BK * 2);
    const size_t hstep = (size_t)HALF * K * 2;
    const size_t tstep = 2 * hstep;
    const unsigned ldsw = (unsigned)wid * 1024u;
    const int aoff = lds_byte(wr * 64 + fr, fq * 8), boff = lds_byte(wc * 32 + fr, fq * 8);
#define PG8_SA(b, h) (((b) * 2 + (h)) * HTB)
#define PG8_SB(b, h) ((4 + (b) * 2 + (h)) * HTB)
#define PG8_STAGE(bufoff, gbase, voff) do { _Pragma("unroll") for (int _i = 0; _i < 2; ++_i) \
        __builtin_amdgcn_global_load_lds((const unsigned*)((const char*)(gbase) + (voff)[_i]), (LAS unsigned*)(lds + (bufoff) + ldsw + _i * 8192), 16, 0, 0); } while (0)
#define PG8_LDA(dst, b, h) do { _Pragma("unroll") for (int m = 0; m < 4; ++m) _Pragma("unroll") for (int k = 0; k < 2; ++k) dst[m][k] = *(const LAS bf16x8*)(lds + PG8_SA(b, h) + aoff + m * 2048 + k * 1024); } while (0)
#define PG8_LDB(dst, b, h) do { _Pragma("unroll") for (int n = 0; n < 2; ++n) _Pragma("unroll") for (int k = 0; k < 2; ++k) dst[n][k] = *(const LAS bf16x8*)(lds + PG8_SB(b, h) + boff + n * 2048 + k * 1024); } while (0)
#define PG8_MMA(ai, bj, At, Bt) do { __builtin_amdgcn_s_setprio(1); _Pragma("unroll") for (int m = 0; m < 4; ++m) _Pragma("unroll") for (int n = 0; n < 2; ++n) _Pragma("unroll") for (int k = 0; k < 2; ++k) \
        acc[ai][bj][m][n] = __builtin_amdgcn_mfma_f32_16x16x32_bf16(Bt[n][k], At[m][k], acc[ai][bj][m][n], 0, 0, 0); __builtin_amdgcn_s_setprio(0); } while (0)
#define PG8_WAIT_V(n) asm volatile("s_waitcnt vmcnt(" #n ")" ::: "memory")
#define PG8_WAIT_L(n) asm volatile("s_waitcnt lgkmcnt(" #n ")" ::: "memory")
#define PG8_BAR __builtin_amdgcn_s_barrier()
#define PG8_SCHED __builtin_amdgcn_sched_barrier(0)
    Unit cur, nxt; int ui = 0;
    if (!S.next(0, cur)) return;
    f32x4 acc[2][2][4][2];
    { const float z = opaque_zero();
#pragma unroll
    for (int a = 0; a < 2; ++a)
#pragma unroll
        for (int b = 0; b < 2; ++b)
#pragma unroll
            for (int m = 0; m < 4; ++m)
#pragma unroll
                for (int n = 0; n < 2; ++n) acc[a][b][m][n] = (f32x4){z, z, z, z}; }
    bf16x8 At[4][2], B0[2][2], B1[2][2];
    const char* cA = (const char*)g.A + (size_t)cur.pm * tstep; const char* cB = (const char*)g.Bt + (size_t)cur.pn * tstep;
    S.a_ready(cur);
    if constexpr (Epi::RSL) E.rs_fetch(cur, tid, 0);
    if constexpr (SP2) {
        PG8_STAGE(PG8_SB(0, 0), cB, voffB); PG8_STAGE(PG8_SB(0, 1), cB + hstep, voffB); PG8_STAGE(PG8_SA(0, 0), cA, voffA); PG8_STAGE(PG8_SA(0, 1), cA + hstep, voffA);
        if (wr == 1) PG8_BAR;
        PG8_WAIT_V(2); PG8_BAR;
        PG8_STAGE(PG8_SB(1, 0), cB + kstep, voffB); PG8_STAGE(PG8_SA(1, 0), cA + kstep, voffA); PG8_STAGE(PG8_SB(1, 1), cB + hstep + kstep, voffB);
        PG8_WAIT_V(6); PG8_BAR;
    } else {
        PG8_STAGE(PG8_SB(0, 0), cB, voffB); PG8_STAGE(PG8_SA(0, 0), cA, voffA); PG8_STAGE(PG8_SB(0, 1), cB + hstep, voffB); PG8_STAGE(PG8_SA(0, 1), cA + hstep, voffA);
        if (wr == 1) PG8_BAR;
        PG8_WAIT_V(4); PG8_BAR;
        PG8_STAGE(PG8_SB(1, 0), cB + kstep, voffB); PG8_STAGE(PG8_SA(1, 0), cA + kstep, voffA); PG8_STAGE(PG8_SB(1, 1), cB + hstep + kstep, voffB);
        PG8_WAIT_V(6); PG8_BAR;
    }
    for (;;) {
        const bool has_next = S.next(ui + 1, nxt);
        const char* nA = has_next ? (const char*)g.A + (size_t)nxt.pm * tstep : cA; const char* nB = has_next ? (const char*)g.Bt + (size_t)nxt.pn * tstep : cB;
        for (int t = 0; t < nt; t += 2) {
            const bool last = (t == nt - 2);
            const char* a1 = cA + (size_t)(t + 1) * kstep;
            const char* a2 = last ? nA : cA + (size_t)(t + 2) * kstep; const char* b2 = last ? nB : cB + (size_t)(t + 2) * kstep;
            const char* a3 = a2 + kstep; const char* b3 = b2 + kstep;
            if (last && has_next) S.a_ready(nxt);
            if constexpr (SP2) {
            PG8_LDB(B0, 0, 0); PG8_LDB(B1, 0, 1); PG8_SCHED; PG8_LDA(At, 0, 0); PG8_STAGE(PG8_SA(1, 1), a1 + hstep, voffA);
            PG8_WAIT_V(8); PG8_WAIT_L(0); PG8_BAR; PG8_MMA(0, 0, At, B0); PG8_MMA(0, 1, At, B1); PG8_BAR; PG8_SCHED;
            PG8_LDA(At, 0, 1); PG8_STAGE(PG8_SB(0, 0), b2, voffB); PG8_STAGE(PG8_SB(0, 1), b2 + hstep, voffB); PG8_STAGE(PG8_SA(0, 0), a2, voffA);
            PG8_WAIT_V(8); PG8_WAIT_L(0); PG8_BAR; PG8_MMA(1, 0, At, B0); PG8_MMA(1, 1, At, B1); PG8_BAR; PG8_SCHED;
            PG8_LDB(B0, 1, 0); PG8_LDB(B1, 1, 1); PG8_SCHED; PG8_LDA(At, 1, 0); PG8_STAGE(PG8_SA(0, 1), a2 + hstep, voffA);
            PG8_WAIT_V(8); PG8_WAIT_L(0); PG8_BAR; PG8_MMA(0, 0, At, B0); PG8_MMA(0, 1, At, B1); PG8_BAR; PG8_SCHED;
            PG8_LDA(At, 1, 1); PG8_STAGE(PG8_SB(1, 0), b3, voffB); PG8_STAGE(PG8_SB(1, 1), b3 + hstep, voffB); PG8_STAGE(PG8_SA(1, 0), a3, voffA);
            PG8_WAIT_V(8); PG8_WAIT_L(0); PG8_BAR; PG8_MMA(1, 0, At, B0); PG8_MMA(1, 1, At, B1); PG8_BAR; PG8_SCHED;
            } else {
            PG8_LDB(B0, 0, 0); PG8_SCHED; PG8_LDA(At, 0, 0); PG8_STAGE(PG8_SA(1, 1), a1 + hstep, voffA);
            PG8_WAIT_L(8); PG8_BAR; PG8_WAIT_L(0); PG8_MMA(0, 0, At, B0); PG8_BAR; PG8_SCHED;
            PG8_LDB(B1, 0, 1); PG8_STAGE(PG8_SB(0, 0), b2, voffB);
            PG8_BAR; PG8_WAIT_L(0); PG8_MMA(0, 1, At, B1); PG8_BAR;
            PG8_LDA(At, 0, 1); PG8_STAGE(PG8_SA(0, 0), a2, voffA);
            PG8_BAR; PG8_WAIT_L(0); PG8_MMA(1, 0, At, B0); PG8_BAR; PG8_SCHED;
            PG8_STAGE(PG8_SB(0, 1), b2 + hstep, voffB);
            PG8_WAIT_V(6); PG8_BAR; PG8_MMA(1, 1, At, B1); PG8_BAR;
            PG8_LDB(B0, 1, 0); PG8_SCHED; PG8_LDA(At, 1, 0); PG8_STAGE(PG8_SA(0, 1), a2 + hstep, voffA);
            PG8_WAIT_L(8); PG8_BAR; PG8_WAIT_L(0); PG8_MMA(0, 0, At, B0); PG8_BAR; PG8_SCHED;
            PG8_LDB(B1, 1, 1); PG8_STAGE(PG8_SB(1, 0), b3, voffB);
            PG8_BAR; PG8_WAIT_L(0); PG8_MMA(0, 1, At, B1); PG8_BAR;
            PG8_LDA(At, 1, 1); PG8_STAGE(PG8_SA(1, 0), a3, voffA);
            PG8_BAR; PG8_WAIT_L(0); PG8_MMA(1, 0, At, B0); PG8_BAR; PG8_SCHED;
            PG8_STAGE(PG8_SB(1, 1), b3 + hstep, voffB);
            PG8_WAIT_V(6); PG8_BAR; PG8_MMA(1, 1, At, B1); PG8_BAR;
            }
        }
        if constexpr (ALIGN_EPI) { if (wr == 0) PG8_BAR; }
        if constexpr (!Epi::AFTER_DRAIN) { E(acc, cur, wr, wc, fr, fq, ui & 1); S.done(cur); if constexpr (Epi::RSL) { if (has_next) E.rs_fetch(nxt, tid, (ui + 1) & 1); } }
        if (!has_next) break;
        { const float z = opaque_zero();
#pragma unroll
        for (int a = 0; a < 2; ++a)
#pragma unroll
            for (int b = 0; b < 2; ++b)
#pragma unroll
                for (int m = 0; m < 4; ++m)
#pragma unroll
                    for (int n = 0; n < 2; ++n) acc[a][b][m][n] = (f32x4){z, z, z, z}; }
        cur = nxt; cA = nA; cB = nB; ++ui;
        if constexpr (ALIGN_EPI) { if (wr == 1) PG8_BAR; }
    }
    PG8_WAIT_V(0);
    if constexpr (!ALIGN_EPI) { if (wr == 0) PG8_BAR; }
    PG8_BAR;
#undef PG8_SA
#undef PG8_SB
#undef PG8_STAGE
#undef PG8_LDA
#undef PG8_LDB
#undef PG8_MMA
#undef PG8_WAIT_V
#undef PG8_WAIT_L
#undef PG8_BAR
#undef PG8_SCHED
}
}

struct SEpiBf16 { bf16* O; int ldc; int act; const float* rstd;
    __device__ __forceinline__ void operator()(int row, int col, f32x4 s0, f32x4 s1, int) const {
        { const float r_ = rstd[row]; s0 = s0 * r_; s1 = s1 * r_; }
        if (act) {
#pragma unroll
            for (int j = 0; j < 4; ++j) { const float a = fmaxf(s0[j], 0.f), b = fmaxf(s1[j], 0.f); s0[j] = a * a; s1[j] = b * b; } }
        u32x4 w; w.x = cvtpk(s0[0], s0[1]); w.y = cvtpk(s0[2], s0[3]); w.z = cvtpk(s1[0], s1[1]); w.w = cvtpk(s1[2], s1[3]);
        *(u32x4*)(O + (size_t)row * ldc + col) = w; } };
struct SEpiResAdd { bf16* XB; float* Y; int ldc; bool fin; float* parts;
    __device__ __forceinline__ void operator()(int row, int col, f32x4 s0, f32x4 s1, int lane) const {
        const size_t off = (size_t)row * ldc + col; const u32x4 w = *(const u32x4*)(XB + off);
        const f32x4 v0 = (f32x4){bflo(w.x) + s0[0], bfhi(w.x) + s0[1], bflo(w.y) + s0[2], bfhi(w.y) + s0[3]}, v1 = (f32x4){bflo(w.z) + s1[0], bfhi(w.z) + s1[1], bflo(w.w) + s1[2], bfhi(w.w) + s1[3]};
        if (parts) { float s = (v0[0] * v0[0] + v0[1] * v0[1]) + (v0[2] * v0[2] + v0[3] * v0[3]) + (v1[0] * v1[0] + v1[1] * v1[1]) + (v1[2] * v1[2] + v1[3] * v1[3]);
            s += shx(s, 1, lane); s += shx(s, 2, lane); s += shx(s, 4, lane);
            if ((lane & 7) == 0) parts[(size_t)(col >> 6) * 256 + row] = s; }
        if (fin) { *(f32x4*)(Y + off) = v0; *(f32x4*)(Y + off + 4) = v1; }
        else { u32x4 o; o.x = cvtpk(v0[0], v0[1]); o.y = cvtpk(v0[2], v0[3]); o.z = cvtpk(v1[0], v1[1]); o.w = cvtpk(v1[2], v1[3]); *(u32x4*)(XB + off) = o; } } };
template <class Epi>
__device__ __forceinline__ void sample_gemm(LAS unsigned char* lds, int wave, int vcu, int G, const bf16* __restrict__ A, const bf16* __restrict__ Bt, int N, int K, const Epi& E) {
    int ln_; asm volatile("v_mbcnt_lo_u32_b32 %0, -1, 0\n\tv_mbcnt_hi_u32_b32 %0, -1, %0" : "=v"(ln_)); const int tid = wave * 64 + ln_;
    const int lane = tid & 63, fr = lane & 15, fq = lane >> 4;
    const int ntiles = 4 * (N >> 6), kslice = K >> 3, kb = wave * kslice;
    LAS float* red = (LAS float*)lds;
    for (int t = vcu; t < ntiles; t += G) {
        const int rt = t & 3, ct = t >> 2;
        f32x4 acc[4][4];
        { const float z = opaque_zero();
#pragma unroll
          for (int m = 0; m < 4; ++m)
#pragma unroll
              for (int n = 0; n < 4; ++n) acc[m][n] = (f32x4){z, z, z, z}; }
        const bf16* ap = A + (size_t)(rt * 64 + fr) * K + kb + 8 * fq;
        const bf16* bp = Bt + (size_t)(ct * 64 + fr) * K + kb + 8 * fq;
        const size_t r16 = (size_t)16 * K;
#pragma unroll 4
        for (int k = 0; k < kslice; k += 64) {
            bf16x8 a0[4], a1[4], b0[4], b1[4];
#pragma unroll
            for (int m = 0; m < 4; ++m) { a0[m] = *(const bf16x8*)(ap + m * r16 + k); a1[m] = *(const bf16x8*)(ap + m * r16 + k + 32); }
#pragma unroll
            for (int n = 0; n < 4; ++n) { b0[n] = *(const bf16x8*)(bp + n * r16 + k); b1[n] = *(const bf16x8*)(bp + n * r16 + k + 32); }
#pragma unroll
            for (int m = 0; m < 4; ++m)
#pragma unroll
                for (int n = 0; n < 4; ++n) { acc[m][n] = __builtin_amdgcn_mfma_f32_16x16x32_bf16(a0[m], b0[n], acc[m][n], 0, 0, 0);
                                              acc[m][n] = __builtin_amdgcn_mfma_f32_16x16x32_bf16(a1[m], b1[n], acc[m][n], 0, 0, 0); }
        }
        __syncthreads();
#pragma unroll
        for (int m = 0; m < 4; ++m)
#pragma unroll
            for (int n = 0; n < 4; ++n)
#pragma unroll
                for (int j = 0; j < 4; ++j) red[wave * 4096 + (16 * m + 4 * fq + j) * 64 + 16 * n + fr] = acc[m][n][j];
        __syncthreads();
        const int row = tid >> 3, col = (tid & 7) * 8;
        f32x4 s0 = *(const LAS f32x4*)(red + row * 64 + col), s1 = *(const LAS f32x4*)(red + row * 64 + col + 4);
#pragma unroll
        for (int w = 1; w < 8; ++w) { s0 = s0 + *(const LAS f32x4*)(red + w * 4096 + row * 64 + col); s1 = s1 + *(const LAS f32x4*)(red + w * 4096 + row * 64 + col + 4); }
        E(rt * 64 + row, ct * 64 + col, s0, s1, lane);
    }
    __syncthreads();
}

#define XB_TMO      128
#define XB_XCNT(j)  (256  + 64 * (j))
#define XB_XSUB(j)  (1280 + 64 * (j))
#define XB_XGEN(j)  (2304 + 64 * (j))
#define XB_TOP      3328
#define XB_TOPGEN   3392
#define XCD_BAR_WORDS 3456
#define XB_SPIN_CAP (1u << 18)
__device__ __forceinline__ unsigned xb_ld(unsigned* p)              { return __hip_atomic_load(p, __ATOMIC_RELAXED, __HIP_MEMORY_SCOPE_AGENT); }
__device__ __forceinline__ unsigned xb_add(unsigned* p, unsigned v) { return __hip_atomic_fetch_add(p, v, __ATOMIC_RELAXED, __HIP_MEMORY_SCOPE_AGENT); }
__device__ __forceinline__ unsigned xb_xcc_id() { return (unsigned)__builtin_amdgcn_s_getreg((3 << 11) | 20) & 0xFu; }
#define XB_SPIN(cond, bar) do { unsigned _sp = 0; while (cond) { __builtin_amdgcn_s_sleep(1); \
    if ((++_sp & 255u) == 0u) { if (xb_ld(&(bar)[XB_TMO])) break; if (_sp > XB_SPIN_CAP) { atomicAdd(&(bar)[XB_TMO], 1u); break; } } } } while (0)
struct XcdBarrier { unsigned* bar; unsigned x; volatile LAS unsigned* st; };
__device__ __forceinline__ XcdBarrier xcd_barrier_post(unsigned* bar, volatile LAS unsigned* st, bool leader) {
    XcdBarrier b; b.bar = bar; b.x = xb_xcc_id(); b.st = st;
    if (leader) (void)xb_add(&bar[XB_XCNT(b.x)], 1u);
    return b;
}
__device__ __forceinline__ void xcd_barrier_complete(unsigned* bar, unsigned x, unsigned& nloc, unsigned& nx) {
    const unsigned G = gridDim.x * gridDim.y * gridDim.z;
    unsigned sum, cnt, mine, sp = 0u;
    for (;;) {
        sum = 0u; cnt = 0u; mine = 0u;
#pragma unroll
        for (unsigned j = 0; j < 16; ++j) { const unsigned c = xb_ld(&bar[XB_XCNT(j)]); sum += c; cnt += (c > 0u) ? 1u : 0u; mine = (j == x) ? c : mine; }
        if (sum == G) break;
        __builtin_amdgcn_s_sleep(1);
        if ((++sp & 255u) == 0u) { if (xb_ld(&bar[XB_TMO])) break; if (sp > XB_SPIN_CAP) { atomicAdd(&bar[XB_TMO], 1u); break; } }
    }
    nloc = mine > 0u ? mine : 1u; nx = cnt > 0u ? cnt : 1u;
}
__device__ __noinline__ void xcd_barrier(unsigned* bar_, unsigned x_, volatile LAS unsigned* st_, int wave_) {
    XcdBarrier b; b.bar = bar_; b.x = x_; b.st = st_;
    int ln_; asm volatile("v_mbcnt_lo_u32_b32 %0, -1, 0\n\tv_mbcnt_hi_u32_b32 %0, -1, %0" : "=v"(ln_)); const bool leader_ = (wave_ == 0) && (ln_ == 0);
    asm volatile("s_waitcnt vmcnt(0)" ::: "memory");
    __syncthreads();
    if (leader_) {
        unsigned* bar = b.bar;
        __builtin_amdgcn_s_waitcnt(0);
        unsigned nloc = b.st[0], nx = b.st[1];
        if (nloc == 0u) { xcd_barrier_complete(bar, b.x, nloc, nx); b.st[0] = nloc; b.st[1] = nx; }
        const unsigned old = xb_add(&bar[XB_XSUB(b.x)], 1u);
        const unsigned gen = old / nloc;
        if (old + 1u == (gen + 1u) * nloc) {
            __builtin_amdgcn_fence(__ATOMIC_RELEASE, "agent");
            asm volatile("s_waitcnt vmcnt(0)" ::: "memory");
            const unsigned og = xb_add(&bar[XB_TOP], 1u);
            const unsigned tg = og / nx;
            if (og + 1u == (tg + 1u) * nx) xb_add(&bar[XB_TOPGEN], 1u);
            else XB_SPIN(xb_ld(&bar[XB_TOPGEN]) == tg, bar);
            __builtin_amdgcn_fence(__ATOMIC_ACQUIRE, "agent");
            xb_add(&bar[XB_XGEN(b.x)], 1u);
            asm volatile("s_waitcnt vmcnt(0)" ::: "memory");
        } else {
            XB_SPIN(xb_ld(&bar[XB_XGEN(b.x)]) == gen, bar);
            __builtin_amdgcn_fence(__ATOMIC_ACQUIRE, "agent");
            asm volatile("s_waitcnt vmcnt(0)" ::: "memory");
        }
    }
    __syncthreads();
}

#define KSWZ(row, colB) ((row) * 256 + ((colB) ^ (((row) & 7) << 4)))
__device__ __forceinline__ int crow(int r, int hi) { return (r & 3) + 8 * (r >> 2) + 4 * hi; }
__device__ __forceinline__ int v_st(int k, int c) { const int kk = (k & ~0xC) | ((k & 4) << 1) | ((k & 8) >> 1); return ((kk >> 3) * 4 + (c >> 5)) * 512 + ((kk & 7) * 32 + (c & 31)) * 2; }
__device__ __forceinline__ int v_rd_base(int lane) { return ((lane & 3) << 3) | (((lane >> 2) & 3) << 6) | (((lane >> 4) & 1) << 5) | (((lane >> 5) & 1) << 8); }
constexpr int v_rd_off(int d0, int ks, int half) { return d0 * 512 + ks * 4096 + half * 2048; }
template <int OFF> __device__ __forceinline__ s16x4 tr_read(int vb) {
    s16x4 r; asm volatile("ds_read_b64_tr_b16 %0, %1 offset:%2" : "=&v"(r) : "v"(vb), "i"(OFF) : "memory"); return r;
}
#define PKLH(L, H) (bf16x8){L[0], L[1], L[2], L[3], H[0], H[1], H[2], H[3]}
template <int D0> __device__ __forceinline__ void pv_one(f32x16& od, int vb, bf16x8 pa0, bf16x8 pa1, bf16x8 pa2, bf16x8 pa3) {
    const s16x4 l0 = tr_read<v_rd_off(D0, 0, 0)>(vb), h0 = tr_read<v_rd_off(D0, 0, 1)>(vb), l1 = tr_read<v_rd_off(D0, 1, 0)>(vb), h1 = tr_read<v_rd_off(D0, 1, 1)>(vb);
    const s16x4 l2 = tr_read<v_rd_off(D0, 2, 0)>(vb), h2 = tr_read<v_rd_off(D0, 2, 1)>(vb), l3 = tr_read<v_rd_off(D0, 3, 0)>(vb), h3 = tr_read<v_rd_off(D0, 3, 1)>(vb);
    asm volatile("s_waitcnt lgkmcnt(0)" ::: "memory"); SBAR();
    od = __builtin_amdgcn_mfma_f32_32x32x16_bf16(pa0, PKLH(l0, h0), od, 0, 0, 0);
    od = __builtin_amdgcn_mfma_f32_32x32x16_bf16(pa1, PKLH(l1, h1), od, 0, 0, 0);
    od = __builtin_amdgcn_mfma_f32_32x32x16_bf16(pa2, PKLH(l2, h2), od, 0, 0, 0);
    od = __builtin_amdgcn_mfma_f32_32x32x16_bf16(pa3, PKLH(l3, h3), od, 0, 0, 0);
}
__device__ __forceinline__ void pv_d0(f32x16* o, int vb, bf16x8 pa0, bf16x8 pa1, bf16x8 pa2, bf16x8 pa3) {
    pv_one<0>(o[0], vb, pa0, pa1, pa2, pa3); pv_one<1>(o[1], vb, pa0, pa1, pa2, pa3); pv_one<2>(o[2], vb, pa0, pa1, pa2, pa3); pv_one<3>(o[3], vb, pa0, pa1, pa2, pa3);
}
template <int D0, int KS> __device__ __forceinline__ bf16x8 tr_frag(int vb) {
    const s16x4 l = tr_read<v_rd_off(D0, KS, 0)>(vb), h = tr_read<v_rd_off(D0, KS, 1)>(vb);
    return PKLH(l, h);
}
__device__ __forceinline__ void qkt(f32x16& p0, f32x16& p1, int Ks  , const bf16x8* qr, int r32, int hi) {
    p0 = f32x16{}; p1 = f32x16{};
#pragma unroll
    for (int d0 = 0; d0 < 8; ++d0) { const int cb = (d0 * 16 + hi * 8) * 2;
        const bf16x8 b0 = *(const LAS bf16x8*)(uintptr_t)(unsigned)(Ks + KSWZ(r32, cb));
        const bf16x8 b1 = *(const LAS bf16x8*)(uintptr_t)(unsigned)(Ks + KSWZ(32 + r32, cb));
        p0 = __builtin_amdgcn_mfma_f32_32x32x16_bf16(b0, qr[d0], p0, 0, 0, 0);
        p1 = __builtin_amdgcn_mfma_f32_32x32x16_bf16(b1, qr[d0], p1, 0, 0, 0); }
}
#define PK4(P, BASE, OUT) do { unsigned a0 = cvtpk(P[BASE + 0], P[BASE + 1]), a1 = cvtpk(P[BASE + 2], P[BASE + 3]);   \
    unsigned b0 = cvtpk(P[BASE + 4], P[BASE + 5]), b1 = cvtpk(P[BASE + 6], P[BASE + 7]);                              \
    auto r0 = __builtin_amdgcn_permlane32_swap(a0, b0, false, false); auto r1 = __builtin_amdgcn_permlane32_swap(a1, b1, false, false); \
    u32x4 w = {r0[0], r1[0], r0[1], r1[1]}; OUT = *reinterpret_cast<bf16x8*>(&w); } while (0)
__device__ __forceinline__ float half_swap_add(float v) { auto rr = __builtin_amdgcn_permlane32_swap(__float_as_uint(v), __float_as_uint(v), false, false); return __uint_as_float(rr[0]) + __uint_as_float(rr[1]); }
__device__ __forceinline__ float half_swap_max(float v) { auto rr = __builtin_amdgcn_permlane32_swap(__float_as_uint(v), __float_as_uint(v), false, false); return fmaxf(__uint_as_float(rr[0]), __uint_as_float(rr[1])); }

struct Args {
    const float* x_prompt; const float* x_sample; const float* cache_k; const float* cache_v; const float* state_conv; const float* state_c; const float* state_n; const float* state_m;
    const float* norm_mix_g; const float* w_in; const float* conv_w; const float* q_norm_g; const float* k_norm_g; const float* rel_bias; const float* b_igate; const float* b_fgate;
    const float* mlstm_norm_g; const float* w_out; const float* norm_mlp_g; const float* w_up; const float* w_down;
    float* out; unsigned char* ws; int ph_lo, ph_hi, rep, pad;
};
struct Ctx {
    LAS unsigned char* lds; int tid, lane, wave, G, vcu;
};
constexpr int NPH_LAYER = 8, NPHASES = DEPTH * NPH_LAYER;
__device__ __forceinline__ int hw_tid(int wave) { int ln; asm volatile("v_mbcnt_lo_u32_b32 %0, -1, 0\n\tv_mbcnt_hi_u32_b32 %0, -1, %0" : "=v"(ln)); return wave * 64 + ln; }
__device__ __forceinline__ Ctx relaunder(const Ctx& c) { Ctx d = c; const int t = hw_tid(c.wave); d.tid = t; d.lane = t & 63; return d; }

__device__ __forceinline__ void transpose_item(const float* W, int K, int ldn, int nblk, bf16* WT, LAS float* scr, int item, int lane, const float* gain = nullptr) {
    const int kb = item / nblk, nb = item % nblk, k0 = 64 * kb, n0 = 32 * nb;
    const int c = lane & 7;
    f32x4 g0 = (f32x4){1.f, 1.f, 1.f, 1.f}, g1 = g0;
    if (gain) { g0 = *(const f32x4*)(gain + k0 + 8 * c); g1 = *(const f32x4*)(gain + k0 + 8 * c + 4); }
#pragma unroll 8
    for (int i = 0; i < 32; ++i) { const int kk = 2 * i + (lane >> 5); scr[kk * 33 + (lane & 31)] = W[(size_t)(k0 + kk) * ldn + n0 + (lane & 31)]; }
    LDS_WAIT(); asm volatile("" ::: "memory");
#pragma unroll
    for (int j = 0; j < 4; ++j) { const int n = (lane >> 3) + 8 * j; const LAS float* s = scr + (8 * c) * 33 + n;
        u32x4 o; o.x = cvtpk(s[0 * 33] * g0[0], s[1 * 33] * g0[1]); o.y = cvtpk(s[2 * 33] * g0[2], s[3 * 33] * g0[3]); o.z = cvtpk(s[4 * 33] * g1[0], s[5 * 33] * g1[1]); o.w = cvtpk(s[6 * 33] * g1[2], s[7 * 33] * g1[3]);
        *(GAS u32x4*)(WT + (size_t)(n0 + n) * K + k0 + 8 * c) = o; }
    LDS_WAIT(); asm volatile("" ::: "memory");
}
__device__ __forceinline__ void convert_weights(const Args& a, const Ctx& c, int l) {
    LAS float* scr = (LAS float*)(c.lds + c.wave * 16384);
    const int gw = c.vcu * NWAVES + c.wave, NGW = c.G * NWAVES;
    constexpr int I_IN = (D / 64) * (NPROJ / 32), I_OUT = (D / 64) * (D / 32), I_UP = (D / 64) * (FF / 32), I_DN = (FF / 64) * (D / 32), I_L = I_IN + I_OUT + I_UP + I_DN;
    for (int it = gw; it < I_L; it += NGW) {
        int r = it;
        if (r < I_IN) { transpose_item(a.w_in + (size_t)l * D * IN_DIM, D, IN_DIM, NPROJ / 32, (bf16*)(a.ws + WS_WIN), scr, r, c.lane, a.norm_mix_g + (size_t)l * D); continue; } r -= I_IN;
        if (r < I_OUT) { transpose_item(a.w_out + (size_t)l * D * D, D, D, D / 32, (bf16*)(a.ws + WS_WOUT), scr, r, c.lane); continue; } r -= I_OUT;
        if (r < I_UP) { transpose_item(a.w_up + (size_t)l * D * FF, D, FF, FF / 32, (bf16*)(a.ws + WS_WUP), scr, r, c.lane, a.norm_mlp_g + (size_t)l * D); continue; } r -= I_UP;
        transpose_item(a.w_down + (size_t)l * FF * D, FF, D, D / 32, (bf16*)(a.ws + WS_WDN), scr, r, c.lane);
    }
}

__device__ __forceinline__ void build_kv_image(const Args& a, int w, int nw, int tid, int l) {
    bf16* SK = (bf16*)(a.ws + WS_SK + (size_t)(l & 1) * SKV_IMG); bf16* SV = (bf16*)(a.ws + WS_SV + (size_t)(l & 1) * SKV_IMG);
    const unsigned gt = (unsigned)w * NTHREADS + tid, NT = (unsigned)nw * NTHREADS;
    constexpr unsigned NCH = (unsigned)SBATCH * 512 * 1024 / 8;
    for (unsigned i = gt; i < 2 * NCH; i += NT) {
        const bool isv = i >= NCH; const unsigned j = isv ? i - NCH : i; const unsigned e = j * 8; const unsigned b = e / (512 * 1024); const unsigned rem = e % (512 * 1024);
        const float* src = (isv ? a.cache_v : a.cache_k) + ((size_t)(l * SBATCH + b) * 512 * 1024) + rem;
        const f32x4 x0 = *(const f32x4*)src, x1 = *(const f32x4*)(src + 4);
        u32x4 w4; w4.x = cvtpk(x0.x, x0.y); w4.y = cvtpk(x0.z, x0.w); w4.z = cvtpk(x1.x, x1.y); w4.w = cvtpk(x1.z, x1.w);
        *(u32x4*)((isv ? SV : SK) + (size_t)b * SKV_ROWS * 1024 + rem) = w4;
    }
    constexpr unsigned NZ = (unsigned)SBATCH * (SKV_ROWS - 544) * 1024 / 8;
    for (unsigned i = gt; i < 2 * NZ; i += NT) {
        const bool isv = i >= NZ; const unsigned j = isv ? i - NZ : i; const unsigned e = j * 8; const unsigned b = e / ((SKV_ROWS - 544) * 1024); const unsigned rem = e % ((SKV_ROWS - 544) * 1024);
        { const unsigned z = __float_as_uint(opaque_zero()); *(u32x4*)((isv ? SV : SK) + ((size_t)b * SKV_ROWS + 544) * 1024 + rem) = (u32x4){z, z, z, z}; }
    }
}
__device__ __forceinline__ float log_sigmoid(float x) { return fminf(x, 0.f) - fast_log(1.0f + fast_exp(-fabsf(x))); }
template <bool FIRST  >
__device__ __forceinline__ void phase_norm(const Args& a, const Ctx& c_in0, int l) {
    const Ctx c = relaunder(c_in0);
    bf16* XB = (bf16*)(a.ws + WS_XB); bf16* H = (bf16*)(a.ws + WS_H);
    const float* g = (FIRST ? a.norm_mix_g : a.norm_mlp_g) + (size_t)l * D;
    LAS float* Wg = (LAS float*)c.lds;
    if (FIRST) {
        convert_weights(a, c, l);
        __syncthreads();
        const float* wsrc = a.w_in + (size_t)l * D * IN_DIM + NPROJ;
        for (int idx = c.tid; idx < 8 * D; idx += NTHREADS) { const int k = idx >> 3, o = idx & 7; Wg[o * D + k] = wsrc[(size_t)k * IN_DIM + o]; }
        __syncthreads();
    }
    const int gw = c.vcu * NWAVES + c.wave, NGW = c.G * NWAVES;
    f32x4 gv[8];
#pragma unroll
    for (int j = 0; j < 8; ++j) gv[j] = *(const f32x4*)(g + 4 * c.lane + 256 * j);
    for (int row = gw; row < MR; row += NGW) {
        f32x4 v[8]; float s = 0.f;
        if (FIRST && l == 0) {
            const float* src = row < MP ? a.x_prompt + (size_t)row * D : a.x_sample + (size_t)(row - MP) * D;
#pragma unroll
            for (int j = 0; j < 8; ++j) v[j] = *(const f32x4*)(src + 4 * c.lane + 256 * j);
#pragma unroll
            for (int j = 0; j < 8; ++j) { u32x2 w; w.x = cvtpk(v[j].x, v[j].y); w.y = cvtpk(v[j].z, v[j].w); *(u32x2*)(XB + (size_t)row * D + 4 * c.lane + 256 * j) = w; }
        } else {
            u32x2 w[8];
#pragma unroll
            for (int j = 0; j < 8; ++j) w[j] = *(const u32x2*)(XB + (size_t)row * D + 4 * c.lane + 256 * j);
#pragma unroll
            for (int j = 0; j < 8; ++j) v[j] = (f32x4){bflo(w[j].x), bfhi(w[j].x), bflo(w[j].y), bfhi(w[j].y)};
        }
#pragma unroll
        for (int j = 0; j < 8; ++j) s += (v[j].x * v[j].x + v[j].y * v[j].y) + (v[j].z * v[j].z + v[j].w * v[j].w);
        const float rstd = fast_rsqrt(wave_sum(s, c.lane) * (1.f / D) + EPS);
        if (c.lane == 0) ((float*)(a.ws + WS_RSTD))[row] = rstd;
        if (FIRST) {
#pragma unroll
            for (int j = 0; j < 8; ++j) v[j] = v[j] * rstd * gv[j];
            float ga[8];
#pragma unroll
            for (int o = 0; o < 8; ++o) { float t = 0.f;
#pragma unroll
                for (int j = 0; j < 8; ++j) { const f32x4 w4 = *(const LAS f32x4*)(Wg + o * D + 4 * c.lane + 256 * j); t += (v[j].x * w4.x + v[j].y * w4.y) + (v[j].z * w4.z + v[j].w * w4.w); }
                ga[o] = wave_sum(t, c.lane); }
            float val = ga[0];
#pragma unroll
            for (int o = 1; o < 8; ++o) val = (c.lane == o) ? ga[o] : val;
            if (c.lane < 8) {
                float r;
                if (c.lane < 4) r = val + a.b_igate[l * MH + c.lane];
                else r = log_sigmoid(val + a.b_fgate[l * MH + c.lane - 4]);
                ((float*)(a.ws + WS_GATE))[(size_t)row * 8 + c.lane] = r;
            }
        }
    }
    if (FIRST && l == 0) build_kv_image(a, c.vcu, c.G, c.tid, 0);
}

__device__ __forceinline__ float scan256_sum(float v, int tid, int lane, int wave, LAS float* tot  ) {
#pragma unroll
    for (int o = 1; o < 64; o <<= 1) { const float t = shup(v, o, lane); if (lane >= o) v += t; }
    if (lane == 63) tot[wave] = v;
    __syncthreads();
    float off = 0.f;
#pragma unroll
    for (int w = 0; w < 3; ++w) off += (w < wave) ? tot[w] : 0.f;
    __syncthreads();
    return v + off;
}
__device__ __forceinline__ float scan256_max(float v, int tid, int lane, int wave, LAS float* tot) {
#pragma unroll
    for (int o = 1; o < 64; o <<= 1) { const float t = shup(v, o, lane); if (lane >= o) v = fmaxf(v, t); }
    if (lane == 63) tot[wave] = v;
    __syncthreads();
    float off = -3.0e38f;
#pragma unroll
    for (int w = 0; w < 3; ++w) off = (w < wave) ? fmaxf(off, tot[w]) : off;
    __syncthreads();
    return fmaxf(v, off);
}

__device__ __forceinline__ void m1_unit(const Args& a, const Ctx& c_in, int l, int unit) {
    const int g = unit & 31, bh = unit >> 5, b = bh >> 2, h = bh & 3;
    const bf16* PROJ = (const bf16*)(a.ws + WS_BIG);
    const float* GATE = (const float*)(a.ws + WS_GATE);
    Ctx c = c_in; { int t_ = c.tid; asm volatile("" : "+v"(t_)); c.tid = t_; c.lane = t_ & 63; }
    LAS float* scr = (LAS float*)(c.lds + SCR_OFF);
    LAS float* W_S = scr;
    LAS float* NACC = scr + 256;
    LAS float* TOT = scr + 384;
    LAS float* SCAL = scr + 392;
    const int row0 = b * SEQ + g * 256;
    __syncthreads();
    float li = 0.f, lf = 0.f;
    if (c.tid < 256) { li = GATE[(size_t)(row0 + c.tid) * 8 + h]; lf = GATE[(size_t)(row0 + c.tid) * 8 + 4 + h]; }
    const float bc = scan256_sum(lf, c.tid, c.lane, c.wave, TOT);
    const float as = li - bc;
    const float am = scan256_max(c.tid < 256 ? as : -3.0e38f, c.tid, c.lane, c.wave, TOT);
    if (c.tid == 255) { SCAL[0] = am; SCAL[1] = bc; }
    __syncthreads();
    const float amax = SCAL[0], blast = SCAL[1];
    if (c.tid < 256) W_S[c.tid] = fast_exp(as - amax);
    __syncthreads();
    const int sr = c.tid >> 4, sc = (c.tid & 15) * 8;
#pragma unroll
    for (int t = 0; t < 4; ++t)
#pragma unroll
        for (int hh = 0; hh < 2; ++hh) {
            const int rr = t * 64 + hh * 32 + sr; const size_t ro = (size_t)(row0 + rr) * NPROJ;
            const u32x4 kq = *(const u32x4*)(PROJ + ro + C_MK + h * HD + sc);
            const u32x4 vq = *(const u32x4*)(PROJ + ro + C_MV + h * HD + sc);
            const float w = W_S[rr] * 0.08838834764831845f;
            float kf[8] = {bflo(kq.x) * w, bfhi(kq.x) * w, bflo(kq.y) * w, bfhi(kq.y) * w, bflo(kq.z) * w, bfhi(kq.z) * w, bflo(kq.w) * w, bfhi(kq.w) * w};
            u32x4 kw; kw.x = cvtpk(kf[0], kf[1]); kw.y = cvtpk(kf[2], kf[3]); kw.z = cvtpk(kf[4], kf[5]); kw.w = cvtpk(kf[6], kf[7]);
            *(LAS u32x4*)(c.lds + t * 16384 + v_st(hh * 32 + sr, sc)) = kw;
            *(LAS u32x4*)(c.lds + 65536 + t * 16384 + v_st(hh * 32 + sr, sc)) = vq;
        }
    __syncthreads();
    if (c.tid < 128) {
        float s = 0.f;
        for (int k = 0; k < 256; ++k) s += bf2f(*(const LAS bf16*)(c.lds + (k >> 6) * 16384 + v_st(k & 63, c.tid)));
        NACC[c.tid] = s;
    }
    __syncthreads();
    const int Da = c.wave >> 1, Db0 = 2 * (c.wave & 1);
    f32x16 acc0 = f32x16{}, acc1 = f32x16{};
    const int vbk = (int)(uintptr_t)(c.lds) + v_rd_base(c.lane) + Da * 512;
    const int vbv = (int)(uintptr_t)(c.lds) + 65536 + v_rd_base(c.lane) + Db0 * 512;
#pragma unroll
    for (int t = 0; t < 4; ++t) {
        const int ak = vbk + t * 16384, av = vbv + t * 16384;
        const bf16x8 a0 = tr_frag<0, 0>(ak), a1 = tr_frag<0, 1>(ak), a2 = tr_frag<0, 2>(ak), a3 = tr_frag<0, 3>(ak);
        const bf16x8 b00 = tr_frag<0, 0>(av), b01 = tr_frag<0, 1>(av), b02 = tr_frag<0, 2>(av), b03 = tr_frag<0, 3>(av);
        const bf16x8 b10 = tr_frag<1, 0>(av), b11 = tr_frag<1, 1>(av), b12 = tr_frag<1, 2>(av), b13 = tr_frag<1, 3>(av);
        asm volatile("s_waitcnt lgkmcnt(0)" ::: "memory"); SBAR();
        acc0 = __builtin_amdgcn_mfma_f32_32x32x16_bf16(a0, b00, acc0, 0, 0, 0); acc1 = __builtin_amdgcn_mfma_f32_32x32x16_bf16(a0, b10, acc1, 0, 0, 0);
        acc0 = __builtin_amdgcn_mfma_f32_32x32x16_bf16(a1, b01, acc0, 0, 0, 0); acc1 = __builtin_amdgcn_mfma_f32_32x32x16_bf16(a1, b11, acc1, 0, 0, 0);
        acc0 = __builtin_amdgcn_mfma_f32_32x32x16_bf16(a2, b02, acc0, 0, 0, 0); acc1 = __builtin_amdgcn_mfma_f32_32x32x16_bf16(a2, b12, acc1, 0, 0, 0);
        acc0 = __builtin_amdgcn_mfma_f32_32x32x16_bf16(a3, b03, acc0, 0, 0, 0); acc1 = __builtin_amdgcn_mfma_f32_32x32x16_bf16(a3, b13, acc1, 0, 0, 0);
    }
    float* CL = (float*)(a.ws + WS_CLOC) + (size_t)unit * HD * HD;
    const int r32 = c.lane & 31, hi = c.lane >> 5;
#pragma unroll
    for (int r = 0; r < 16; ++r) { const int d = 32 * Da + crow(r, hi);
        CL[(size_t)d * HD + 32 * Db0 + r32] = acc0[r]; CL[(size_t)d * HD + 32 * (Db0 + 1) + r32] = acc1[r]; }
    if (c.tid < 128) ((float*)(a.ws + WS_NLOC))[(size_t)unit * HD + c.tid] = NACC[c.tid];
    if (c.tid == 0) { float* ms = (float*)(a.ws + WS_MSC) + (size_t)unit * 4; ms[0] = blast + amax; ms[1] = blast; }
}

template <bool WITH_QK>
__device__ __forceinline__ void phase_c(const Args& a, const Ctx& c_in0, int l) {
    const Ctx c = relaunder(c_in0);
    bf16* PROJ = (bf16*)(a.ws + WS_BIG); bf16* MIX = (bf16*)(a.ws + WS_H);
    for (int u = c.vcu; u < 16 * NGRP; u += c.G) m1_unit(a, c, l, u);
    const int gw = c.vcu * NWAVES + c.wave, NGW = c.G * NWAVES;
    if (WITH_QK) {
        const float* gq = a.q_norm_g + l * HD; const float* gk = a.k_norm_g + l * HD;
        const int gi = (16 * c.lane) & 127;
        f32x4 gqv[4], gkv[4];
#pragma unroll
        for (int j = 0; j < 4; ++j) { gqv[j] = *(const f32x4*)(gq + gi + 4 * j); gkv[j] = *(const f32x4*)(gk + gi + 4 * j); }
        bf16* SK = (bf16*)(a.ws + WS_SK + (size_t)(l & 1) * SKV_IMG); bf16* SV = (bf16*)(a.ws + WS_SV + (size_t)(l & 1) * SKV_IMG);
        constexpr int NIT = 2 * MS + NB * KEEP;
        for (int it = gw; it < NIT; it += NGW) {
            const bool samp = it < 2 * MS;
            const int row = samp ? MP + (it >> 1) : ((it - 2 * MS) / KEEP) * SEQ + (SEQ - KEEP) + ((it - 2 * MS) % KEEP);
            const int isk = samp ? (it & 1) : 1;
            bf16* p = PROJ + (size_t)row * NPROJ + (isk ? C_K : C_Q) + 16 * c.lane;
            const u32x4 w0 = *(const u32x4*)p, w1 = *(const u32x4*)(p + 8);
            float x[16] = {bflo(w0.x), bfhi(w0.x), bflo(w0.y), bfhi(w0.y), bflo(w0.z), bfhi(w0.z), bflo(w0.w), bfhi(w0.w),
                           bflo(w1.x), bfhi(w1.x), bflo(w1.y), bfhi(w1.y), bflo(w1.z), bfhi(w1.z), bflo(w1.w), bfhi(w1.w)};
            u32x4 o0 = w0, o1 = w1;
            if (samp) {
                float ss = 0.f;
#pragma unroll
                for (int i = 0; i < 16; ++i) ss += x[i] * x[i];
                ss += shx(ss, 1, c.lane); ss += shx(ss, 2, c.lane); ss += shx(ss, 4, c.lane);
                const float rstd = fast_rsqrt(ss * (1.f / HD) + EPS);
#pragma unroll
                for (int j = 0; j < 4; ++j) { const f32x4 gg = isk ? gkv[j] : gqv[j]; x[4 * j] *= rstd * gg.x; x[4 * j + 1] *= rstd * gg.y; x[4 * j + 2] *= rstd * gg.z; x[4 * j + 3] *= rstd * gg.w; }
                o0.x = cvtpk(x[0], x[1]); o0.y = cvtpk(x[2], x[3]); o0.z = cvtpk(x[4], x[5]); o0.w = cvtpk(x[6], x[7]);
                o1.x = cvtpk(x[8], x[9]); o1.y = cvtpk(x[10], x[11]); o1.z = cvtpk(x[12], x[13]); o1.w = cvtpk(x[14], x[15]);
                *(u32x4*)p = o0; *(u32x4*)(p + 8) = o1;
            }
            if (isk) {
                float* ok; float* ov; size_t imgoff = 0;
                if (!samp) { const int b = row / SEQ, t = row % SEQ; const size_t o = ((size_t)(l * NB + b) * KEEP + (t - (SEQ - KEEP))) * 1024 + 16 * c.lane; ok = a.out + O_PK + o; ov = a.out + O_PV + o; }
                else { const int sr = row - MP, b = sr / SSEQ, t = sr % SSEQ; const size_t o = ((size_t)(l * SBATCH + b) * SSEQ + t) * 1024 + 16 * c.lane; ok = a.out + O_SK + o; ov = a.out + O_SV + o;
                    imgoff = ((size_t)b * SKV_ROWS + 512 + t) * 1024 + 16 * c.lane; }
                const bf16* pv = PROJ + (size_t)row * NPROJ + C_V + 16 * c.lane;
                const u32x4 v0 = *(const u32x4*)pv, v1 = *(const u32x4*)(pv + 8);
#pragma unroll
                for (int j = 0; j < 4; ++j) *(f32x4*)(ok + 4 * j) = (f32x4){x[4 * j], x[4 * j + 1], x[4 * j + 2], x[4 * j + 3]};
                *(f32x4*)(ov + 0) = (f32x4){bflo(v0.x), bfhi(v0.x), bflo(v0.y), bfhi(v0.y)}; *(f32x4*)(ov + 4) = (f32x4){bflo(v0.z), bfhi(v0.z), bflo(v0.w), bfhi(v0.w)};
                *(f32x4*)(ov + 8) = (f32x4){bflo(v1.x), bfhi(v1.x), bflo(v1.y), bfhi(v1.y)}; *(f32x4*)(ov + 12) = (f32x4){bflo(v1.z), bfhi(v1.z), bflo(v1.w), bfhi(v1.w)};
                if (samp) { *(u32x4*)(SK + imgoff) = o0; *(u32x4*)(SK + imgoff + 8) = o1; *(u32x4*)(SV + imgoff) = v0; *(u32x4*)(SV + imgoff + 8) = v1; }
            }
        }
    }
    {
        const int ch = 8 * c.lane;
        float w0[8], w1[8], w2[8];
#pragma unroll
        for (int i = 0; i < 8; ++i) { w0[i] = a.conv_w[(size_t)(l * 3 + 0) * 512 + ch + i]; w1[i] = a.conv_w[(size_t)(l * 3 + 1) * 512 + ch + i]; w2[i] = a.conv_w[(size_t)(l * 3 + 2) * 512 + ch + i]; }
        constexpr int NSEG = SEQ / 32, NITEM = NB * NSEG + SBATCH;
        for (int it = gw; it < NITEM; it += NGW) {
            float u2[8], u1[8]; int rowb; bool samp = it >= NB * NSEG; int b, seg = 0;
            if (!samp) { b = it / NSEG; seg = it % NSEG; rowb = b * SEQ + seg * 32; } else { b = it - NB * NSEG; rowb = MP + b * SSEQ; }
#pragma unroll
            for (int i = 0; i < 8; ++i) { u2[i] = 0.f; u1[i] = 0.f; }
            if (samp) {
#pragma unroll
                for (int i = 0; i < 8; ++i) { u2[i] = a.state_conv[((size_t)(l * SBATCH + b) * 2 + 0) * 512 + ch + i]; u1[i] = a.state_conv[((size_t)(l * SBATCH + b) * 2 + 1) * 512 + ch + i]; }
            } else if (seg > 0) {
#pragma unroll
                for (int q = 0; q < 2; ++q) { const bf16* pr = PROJ + (size_t)(rowb - 2 + q) * NPROJ + ch;
                    const u32x4 xa = *(const u32x4*)(pr + C_XA), gc = *(const u32x4*)(pr + C_GC);
                    float* dst = q ? u1 : u2;
                    dst[0] = bflo(xa.x) * bflo(gc.x); dst[1] = bfhi(xa.x) * bfhi(gc.x); dst[2] = bflo(xa.y) * bflo(gc.y); dst[3] = bfhi(xa.y) * bfhi(gc.y);
                    dst[4] = bflo(xa.z) * bflo(gc.z); dst[5] = bfhi(xa.z) * bfhi(gc.z); dst[6] = bflo(xa.w) * bflo(gc.w); dst[7] = bfhi(xa.w) * bfhi(gc.w); }
            }
            for (int t0 = 0; t0 < 32; t0 += 4) {
                u32x4 xa4[4], gb4[4], gc4[4];
#pragma unroll
                for (int q = 0; q < 4; ++q) { const bf16* pr = PROJ + (size_t)(rowb + t0 + q) * NPROJ + ch; xa4[q] = *(const u32x4*)(pr + C_XA); gb4[q] = *(const u32x4*)(pr + C_GB); gc4[q] = *(const u32x4*)(pr + C_GC); }
#pragma unroll
                for (int q = 0; q < 4; ++q) { const int t = t0 + q;
                const u32x4 xa = xa4[q], gb = gb4[q], gc = gc4[q];
                float u0[8] = {bflo(xa.x) * bflo(gc.x), bfhi(xa.x) * bfhi(gc.x), bflo(xa.y) * bflo(gc.y), bfhi(xa.y) * bfhi(gc.y),
                               bflo(xa.z) * bflo(gc.z), bfhi(xa.z) * bfhi(gc.z), bflo(xa.w) * bflo(gc.w), bfhi(xa.w) * bfhi(gc.w)};
                float gbf[8] = {bflo(gb.x), bfhi(gb.x), bflo(gb.y), bfhi(gb.y), bflo(gb.z), bfhi(gb.z), bflo(gb.w), bfhi(gb.w)};
                float y[8];
#pragma unroll
                for (int i = 0; i < 8; ++i) { y[i] = gbf[i] * (w0[i] * u2[i] + w1[i] * u1[i] + w2[i] * u0[i]); u2[i] = u1[i]; u1[i] = u0[i]; }
                u32x4 o; o.x = cvtpk(y[0], y[1]); o.y = cvtpk(y[2], y[3]); o.z = cvtpk(y[4], y[5]); o.w = cvtpk(y[6], y[7]);
                *(u32x4*)(MIX + (size_t)(rowb + t) * D + ch) = o;
                }
            }
            float* oc = nullptr;
            if (samp) oc = a.out + O_SCONV + (size_t)(l * SBATCH + b) * 2 * 512 + ch;
            else if (seg == NSEG - 1) oc = a.out + O_PCONV + (size_t)(l * NB + b) * 2 * 512 + ch;
            if (oc) {
                *(f32x4*)(oc) = (f32x4){u2[0], u2[1], u2[2], u2[3]}; *(f32x4*)(oc + 4) = (f32x4){u2[4], u2[5], u2[6], u2[7]};
                *(f32x4*)(oc + 512) = (f32x4){u1[0], u1[1], u1[2], u1[3]}; *(f32x4*)(oc + 516) = (f32x4){u1[4], u1[5], u1[6], u1[7]};
            }
        }
    }
}

__device__ __forceinline__ void phase_d(const Args& a, const Ctx& c_in0, int l) {
    const Ctx c = relaunder(c_in0);
    const float* CL = (const float*)(a.ws + WS_CLOC); const float* NL = (const float*)(a.ws + WS_NLOC); float* MSC = (float*)(a.ws + WS_MSC);
    bf16* C0 = (bf16*)(a.ws + WS_C0); float* N0 = (float*)(a.ws + WS_N0);
    LAS float* DEC = (LAS float*)(c.lds + SCR_OFF);
    LAS float* WLO = DEC + 512;
    LAS float* MFIN = WLO + 512;
    LAS float* MLO = MFIN + 16;
    LAS float* BLA = MLO + 512;
    __syncthreads();
    { const int u = c.tid; MLO[u] = MSC[(size_t)u * 4 + 0]; BLA[u] = MSC[(size_t)u * 4 + 1]; }
    __syncthreads();
    if (c.tid < 16) { const int bh = c.tid; float m = 0.f;
        for (int g = 0; g < NGRP; ++g) { const size_t u = (size_t)bh * NGRP + g; const float mloc = MLO[u], blast = BLA[u];
            const float mn = fmaxf(blast + m, mloc); DEC[bh * NGRP + g] = fast_exp(blast + m - mn); WLO[bh * NGRP + g] = fast_exp(mloc - mn);
            if (c.vcu == 0) MSC[u * 4 + 2] = m;
            m = mn; }
        MFIN[bh] = m; }
    __syncthreads();
    const unsigned gt = (unsigned)c.vcu * NTHREADS + c.tid, NT = (unsigned)c.G * NTHREADS;
    constexpr unsigned PER = (unsigned)HD * HD + HD;
    for (unsigned i = gt; i < 16u * PER; i += NT) {
        const int bh = (int)(i / PER); const int e = (int)(i % PER); const bool isn = e >= HD * HD; const int en = e - HD * HD;
        const float* src = isn ? NL + (size_t)bh * NGRP * HD + en : CL + (size_t)bh * NGRP * HD * HD + e;
        const size_t sstep = isn ? HD : (size_t)HD * HD;
        float x[NGRP];
#pragma unroll
        for (int g = 0; g < NGRP; ++g) x[g] = src[(size_t)g * sstep];
        float C = 0.f;
#pragma unroll
        for (int g = 0; g < NGRP; ++g) {
            const size_t u = (size_t)bh * NGRP + g;
            if (isn) N0[u * HD + en] = C; else C0[u * HD * HD + e] = (bf16)(cvtpk(C, 0.f) & 0xffffu);
            C = DEC[bh * NGRP + g] * C + WLO[bh * NGRP + g] * x[g];
        }
        const int b = bh >> 2, h = bh & 3;
        if (isn) a.out[O_PN + ((size_t)(l * NB + b) * MH + h) * HD + en] = C;
        else a.out[O_PC + ((size_t)(l * NB + b) * MH + h) * HD * HD + e] = C;
        if (e == 0) a.out[O_PM + (size_t)(l * NB + b) * MH + h] = MFIN[bh];
    }
}

constexpr float ATT_C = 0.088388347648318440f * LOG2E;
constexpr float THR2 = 8.f * LOG2E;
struct DmaMap { unsigned k0, k1, v0, v1; };
__device__ __forceinline__ DmaMap dma_map(int lane, int wave, int LD) {
    DmaMap m; unsigned kk_[2], vv_[2];
#pragma unroll
    for (int i = 0; i < 2; ++i) { const int o = (wave + 8 * i) * 1024 + lane * 16;
        const int row = o >> 8, c16 = ((o >> 4) & 15) ^ (row & 7); kk_[i] = (unsigned)(row * LD + c16 * 8) * 2u;
        const int sub = o >> 9, kk = ((sub >> 2) << 3) | ((o >> 6) & 7), k = (kk & ~0xC) | ((kk & 4) << 1) | ((kk & 8) >> 1), cc = ((sub & 3) << 5) | ((o & 63) >> 1); vv_[i] = (unsigned)(k * LD + cc) * 2u; }
    m.k0 = kk_[0]; m.k1 = kk_[1]; m.v0 = vv_[0]; m.v1 = vv_[1]; return m;
}
__device__ __forceinline__ void glds16s(const void* sbase, unsigned voff, unsigned lds_dst) { unsigned keep;
    asm volatile("s_mov_b32 %0, m0\n\ts_mov_b32 m0, %3\n\ts_nop 0\n\tglobal_load_lds_dwordx4 %1, %2\n\ts_mov_b32 m0, %0" : "=&s"(keep) : "v"(voff), "s"(sbase), "s"(lds_dst) : "memory"); }
__device__ __forceinline__ void dma_fill(LAS unsigned char* lds, int slot, int wave, const bf16* Ta, unsigned a0, unsigned a1, const bf16* Tb, unsigned b0, unsigned b1) {
    const unsigned d = (unsigned)(uintptr_t)lds + (unsigned)(slot * 32768 + wave * 1024);
    glds16s(Ta, a0, d); glds16s(Ta, a1, d + 8192u); glds16s(Tb, b0, d + 16384u); glds16s(Tb, b1, d + 24576u);
}
#define RING_WAIT_BAR(N) do { asm volatile("s_waitcnt vmcnt(" #N ") lgkmcnt(0)" ::: "memory"); __builtin_amdgcn_s_barrier(); asm volatile("" ::: "memory"); } while (0)

#define ATT_SCORE_SOFTMAX(j, slotk)                                                                                                           \
    {   const int K_lds = ldsb + (slotk) * 16384;                                                                                              \
        f32x16 p0, p1; qkt(p0, p1, K_lds, qr, r32, hi);                                                                                       \
        const int Rl = R0 + r32 - 64 * (j);                                                                                                   \
        const int relmin = R0 - 64 * (j) - 63;                                                                                                \
        if (relmin >= 128) { const float bc = BR[0];                                                                                           \
            _Pragma("unroll") for (int r = 0; r < 16; ++r) { p0[r] = fmaf(p0[r], ATT_C, bc); p1[r] = fmaf(p1[r], ATT_C, bc); }                \
        } else {                                                                                                                               \
            const LAS float* bp = BR + (64 + 128 - Rl + 4 * hi);                                                                               \
            _Pragma("unroll") for (int r = 0; r < 16; ++r) { p0[r] = fmaf(p0[r], ATT_C, bp[(r & 3) + 8 * (r >> 2)]); p1[r] = fmaf(p1[r], ATT_C, bp[32 + (r & 3) + 8 * (r >> 2)]); } \
        }                                                                                                                                      \
        const int nvalid = kend - 64 * (j);                                                                                                    \
        if (nvalid < 64) {                                                                                                                     \
            _Pragma("unroll") for (int r = 0; r < 16; ++r) { const int kk = crow(r, hi); if (kk >= nvalid) p0[r] = -1e30f; if (kk + 32 >= nvalid) p1[r] = -1e30f; } \
        }                                                                                                                                      \
        float pmax = p0[0];                                                                                                                    \
        _Pragma("unroll") for (int r = 1; r < 16; ++r) pmax = fmaxf(pmax, p0[r]);                                                              \
        _Pragma("unroll") for (int r = 0; r < 16; ++r) pmax = fmaxf(pmax, p1[r]);                                                              \
        pmax = half_swap_max(pmax);                                                                                                            \
        if (!__all(pmax - m_reg <= THR2)) {                                                                                                    \
            const float mn = fmaxf(m_reg, pmax); const float alpha = __builtin_amdgcn_exp2f(m_reg - mn); m_reg = mn;                           \
            l_reg *= alpha;                                                                                                                    \
            if (hi == 0) al_l[r32] = alpha; asm volatile("s_waitcnt lgkmcnt(0)" ::: "memory");                                               \
            _Pragma("unroll") for (int r = 0; r < 16; ++r) { const float al = al_l[crow(r, hi)];                                               \
                _Pragma("unroll") for (int d = 0; d < 4; ++d) o[d][r] *= al; }                                                                 \
        }                                                                                                                                      \
        float ps = 0.f;                                                                                                                        \
        _Pragma("unroll") for (int r = 0; r < 16; ++r) { p0[r] = __builtin_amdgcn_exp2f(p0[r] - m_reg); p1[r] = __builtin_amdgcn_exp2f(p1[r] - m_reg); ps += p0[r] + p1[r]; } \
        l_reg += half_swap_add(ps);                                                                                                            \
        PK4(p0, 0, pa0); PK4(p0, 8, pa1); PK4(p1, 0, pa2); PK4(p1, 8, pa3);                                                                    \
    }
__device__ __forceinline__ void attn_unit(const Ctx& c, const bf16* __restrict__ Qb, int LDQ, int qrow, const bf16* __restrict__ Kh, const bf16* __restrict__ Vh, int LDK, int NT, int alo, int ahi, int kend,
                                          int R0  , const float* __restrict__ bias_g, bf16* __restrict__ Ob, int LDO, bool do_store) {
    int tid = c.tid; asm volatile("" : "+v"(tid));
    const int wid = c.wave, lane = tid & 63, r32 = lane & 31, hi = lane >> 5;
    const int ldsb = (int)(uintptr_t)c.lds;
    constexpr int VRING = 49152;
    LAS float* wsf = (LAS float*)(c.lds + 114688) + wid * 64; LAS float* li_l = wsf; LAS float* al_l = wsf + 32;
    LAS float* BR = (LAS float*)(c.lds + SCR_OFF);
    asm volatile("s_waitcnt vmcnt(0) lgkmcnt(0)" ::: "memory"); __builtin_amdgcn_s_barrier(); asm volatile("" ::: "memory");
    if (tid < 321) { const int i = tid - 64; BR[tid] = bias_g[256 - (i < 0 ? 0 : i)] * LOG2E; }
    const DmaMap dm = dma_map(lane, wid, LDK);
    const size_t tile_step = (size_t)64 * LDK;
    float m_reg = -1e30f, l_reg = 0.f; f32x16 o[4] = {f32x16{}, f32x16{}, f32x16{}, f32x16{}}; bf16x8 qr[8];
    { const bf16* Qw = Qb + (size_t)(qrow + r32) * LDQ + hi * 8;
#pragma unroll
      for (int d0 = 0; d0 < 8; ++d0) qr[d0] = *(const bf16x8*)(Qw + d0 * 16); }
    asm volatile("" ::: "memory");
    const unsigned dbase = (unsigned)ldsb + (unsigned)wid * 1024u;
#define ATT_FILL(kt_, vt_, sk_, sv_) do { const unsigned dk_ = dbase + (unsigned)(sk_) * 16384u, dv_ = dbase + VRING + (unsigned)(sv_) * 16384u; \
        glds16s(kt_, dm.k0, dk_); glds16s(kt_, dm.k1, dk_ + 8192u); glds16s(vt_, dm.v0, dv_); glds16s(vt_, dm.v1, dv_ + 8192u); } while (0)
    ATT_FILL(Kh, Vh, 0, 0);
    ATT_FILL(Kh + tile_step, Vh + tile_step, 1, 1);
    const bf16* kt = Kh + 2 * tile_step; const bf16* vt = Vh + 2 * tile_step;
    const bool skew = wid >= 4;
    bf16x8 pa0 = bf16x8{}, pa1 = bf16x8{}, pa2 = bf16x8{}, pa3 = bf16x8{};
    int sk = 0, sv = 0;
    for (int j = 0; j < NT; ++j) {
        if (j + 1 < NT) RING_WAIT_BAR(4); else RING_WAIT_BAR(0);
        if (j + 2 < NT) { const int fk = sk >= 1 ? sk - 1 : 2, fv = sv >= 2 ? sv - 2 : sv + 2; ATT_FILL(kt, vt, fk, fv); kt += tile_step; vt += tile_step; }
        const bool act = (j >= alo && j <= ahi);
        if (skew && (j - 1 >= alo && j - 1 <= ahi)) { const int svp = sv >= 1 ? sv - 1 : 3; pv_d0(o, ldsb + VRING + svp * 16384 + v_rd_base(lane), pa0, pa1, pa2, pa3); }
        if (act) { ATT_SCORE_SOFTMAX(j, sk); }
        if (!skew && act) pv_d0(o, ldsb + VRING + sv * 16384 + v_rd_base(lane), pa0, pa1, pa2, pa3);
        sk = sk == 2 ? 0 : sk + 1; sv = (sv + 1) & 3;
    }
    if (skew && (NT - 1 >= alo && NT - 1 <= ahi)) { const int svp = sv >= 1 ? sv - 1 : 3; pv_d0(o, ldsb + VRING + svp * 16384 + v_rd_base(lane), pa0, pa1, pa2, pa3); }
#undef ATT_FILL
    if (hi == 0) li_l[r32] = l_reg;
    RING_WAIT_BAR(0);
    const int ost = ldsb + wid * 8192;
#pragma unroll
    for (int r = 0; r < 16; ++r) { const int orow = crow(r, hi); const float rl = __builtin_amdgcn_rcpf(li_l[orow]);
#pragma unroll
        for (int d0 = 0; d0 < 4; ++d0) *(LAS bf16*)(uintptr_t)(unsigned)(ost + orow * 256 + (d0 * 32 + r32) * 2) = (bf16)(cvtpk(o[d0][r] * rl, 0.f) & 0xffffu); }
    asm volatile("s_waitcnt lgkmcnt(0)" ::: "memory");
    if (do_store) {
#pragma unroll
        for (int i = 0; i < 8; ++i) { const int ch = i * 64 + lane, row = ch >> 4, c16 = ch & 15;
            const u32x4 w = *(const LAS u32x4*)(uintptr_t)(unsigned)(ost + row * 256 + c16 * 16);
            *(u32x4*)(Ob + (size_t)(qrow + row) * LDO + c16 * 8) = w; }
    }
}
#undef ATT_SCORE_SOFTMAX

__device__ __forceinline__ void m3_unit(const Args& a, const Ctx& c, int l, int unit) {
    const int g = unit & 31, bh = unit >> 5, b = bh >> 2, h = bh & 3;
    const bf16* PROJ = (const bf16*)(a.ws + WS_BIG); bf16* MIX = (bf16*)(a.ws + WS_H);
    const float* GATE = (const float*)(a.ws + WS_GATE);
    int tid = c.tid; asm volatile("" : "+v"(tid));
    const int wid = c.wave, lane = tid & 63, r32 = lane & 31, hi = lane >> 5;
    LAS float* scr = (LAS float*)(c.lds + SCR_OFF);
    LAS float* A_S = scr;
    LAS float* M_T = scr + 256;
    LAS float* B_T = scr + 512;
    LAS float* N0L = scr + 768;
    LAS float* TOT = scr + 896;
    const int ldsb = (int)(uintptr_t)c.lds;
    LAS float* wsf = (LAS float*)(c.lds + 98304) + wid * 64;
    const int row0 = b * SEQ + g * 256;
    const float m0 = ((const float*)(a.ws + WS_MSC))[(size_t)unit * 4 + 2];
    asm volatile("s_waitcnt vmcnt(0) lgkmcnt(0)" ::: "memory"); __builtin_amdgcn_s_barrier(); asm volatile("" ::: "memory");
    const DmaMap dm = dma_map(lane, wid, NPROJ); const DmaMap dc = dma_map(lane, wid, HD);
    const bf16* kt = PROJ + (size_t)row0 * NPROJ + C_MK + h * HD; const bf16* vt = PROJ + (size_t)row0 * NPROJ + C_MV + h * HD;
    const bf16* C0 = (const bf16*)(a.ws + WS_C0) + (size_t)unit * HD * HD;
    const size_t tile_step = (size_t)64 * NPROJ;
    dma_fill(c.lds, 0, wid, kt, dm.k0, dm.k1, vt, dm.v0, dm.v1);
    dma_fill(c.lds, 1, wid, kt + tile_step, dm.k0, dm.k1, vt + tile_step, dm.v0, dm.v1);
    float li = 0.f, lf = 0.f;
    if (tid < 256) { li = GATE[(size_t)(row0 + tid) * 8 + h]; lf = GATE[(size_t)(row0 + tid) * 8 + 4 + h]; }
    if (tid < 128) N0L[tid] = ((const float*)(a.ws + WS_N0))[(size_t)unit * HD + tid];
    const float bc = scan256_sum(lf, tid, lane, wid, TOT);
    const float as = li - bc;
    const float cm = scan256_max(tid < 256 ? as : -3.0e38f, tid, lane, wid, TOT);
    if (tid < 256) { A_S[tid] = as; M_T[tid] = fmaxf(m0, cm); B_T[tid] = bc; }
    bf16x8 qr[8];
    const int trow = wid * 32 + r32;
    { const bf16* Qw = PROJ + (size_t)(row0 + trow) * NPROJ + C_MQ + h * HD + hi * 8;
#pragma unroll
      for (int d0 = 0; d0 < 8; ++d0) qr[d0] = *(const bf16x8*)(Qw + d0 * 16); }
    __syncthreads();
    const float Mt = M_T[trow];
    f32x16 o[4] = {f32x16{}, f32x16{}, f32x16{}, f32x16{}};
    float rowsum = 0.f, qn = 0.f;
    const float winter = fast_exp(m0 - Mt);
    const int ci = wid >> 1;
    int slot = 0;
#pragma unroll 1
    for (int j = 0; j < 4; ++j) {
        RING_WAIT_BAR(4);
        { const int fs = slot >= 1 ? slot - 1 : 2;
          if (j + 2 < 4) dma_fill(c.lds, fs, wid, kt + (size_t)(j + 2) * tile_step, dm.k0, dm.k1, vt + (size_t)(j + 2) * tile_step, dm.v0, dm.v1);
          else if (j == 2) dma_fill(c.lds, fs, wid, C0, dc.v0, dc.v1, C0 + 64 * HD, dc.v0, dc.v1); }
        const int S_lds = ldsb + slot * 32768;
        int r32l = r32; asm volatile("" : "+v"(r32l));
        if (j <= ci) {
            f32x16 p0, p1; qkt(p0, p1, S_lds, qr, r32l, hi);
#pragma unroll
            for (int r = 0; r < 16; ++r) { const int s0 = 64 * j + crow(r, hi), s1 = s0 + 32;
                const float w0 = (s0 <= trow) ? fast_exp(A_S[s0] - Mt) * 0.08838834764831845f : 0.f, w1 = (s1 <= trow) ? fast_exp(A_S[s1] - Mt) * 0.08838834764831845f : 0.f;
                p0[r] *= w0; p1[r] *= w1; rowsum += p0[r] + p1[r]; }
            bf16x8 pa0, pa1, pa2, pa3;
            PK4(p0, 0, pa0); PK4(p0, 8, pa1); PK4(p1, 0, pa2); PK4(p1, 8, pa3);
            pv_d0(o, S_lds + 16384 + v_rd_base(lane), pa0, pa1, pa2, pa3);
        }
        slot = slot == 2 ? 0 : slot + 1;
    }
    RING_WAIT_BAR(0);
    {
        const int S_lds = ldsb + slot * 32768;
#pragma unroll
        for (int hf = 0; hf < 2; ++hf) {
            bf16x8 qs[4];
#pragma unroll
            for (int dd = 0; dd < 4; ++dd) { const int d0 = hf * 4 + dd; const u32x4 w = *reinterpret_cast<const u32x4*>(&qr[d0]);
                float f[8] = {bflo(w.x), bfhi(w.x), bflo(w.y), bfhi(w.y), bflo(w.z), bfhi(w.z), bflo(w.w), bfhi(w.w)};
#pragma unroll
                for (int i = 0; i < 8; ++i) qn += f[i] * N0L[d0 * 16 + hi * 8 + i];
                u32x4 s; s.x = cvtpk(f[0] * winter, f[1] * winter); s.y = cvtpk(f[2] * winter, f[3] * winter); s.z = cvtpk(f[4] * winter, f[5] * winter); s.w = cvtpk(f[6] * winter, f[7] * winter);
                qs[dd] = *reinterpret_cast<bf16x8*>(&s); }
            pv_d0(o, S_lds + hf * 16384 + v_rd_base(lane), qs[0], qs[1], qs[2], qs[3]);
        }
    }
    rowsum = half_swap_add(rowsum);
    qn = half_swap_add(qn);
    const float den = winter * qn + rowsum;
    const float dfl = fast_exp(-(B_T[trow] + Mt));
    const float inv = 1.0f / fmaxf(fabsf(den), dfl);
    if (hi == 0) wsf[r32] = inv;
    asm volatile("s_waitcnt lgkmcnt(0)" ::: "memory");
#pragma unroll
    for (int r = 0; r < 16; ++r) { const float sc_ = wsf[crow(r, hi)];
#pragma unroll
        for (int d0 = 0; d0 < 4; ++d0) o[d0][r] *= sc_; }
    RING_WAIT_BAR(0);
    const int hst = ldsb + wid * 16384;
    { int le = lane; asm volatile("" : "+v"(le)); const int r32e = le & 31, hie = le >> 5;
#pragma unroll
    for (int r = 0; r < 16; ++r)
#pragma unroll
        for (int d0 = 0; d0 < 4; ++d0) *(LAS float*)(uintptr_t)(unsigned)(hst + crow(r, hie) * 512 + (d0 * 32 + r32e) * 4) = o[d0][r]; }
    asm volatile("s_waitcnt lgkmcnt(0)" ::: "memory");
    const float* gn = a.mlstm_norm_g + (size_t)l * 512 + h * HD;
    int le = lane; asm volatile("" : "+v"(le));
    u32x4 mo8[8];
#pragma unroll
    for (int i = 0; i < 8; ++i) { const int ch = i * 64 + le, row = ch >> 4, col = (ch & 15) * 8; mo8[i] = *(const u32x4*)(PROJ + (size_t)(row0 + wid * 32 + row) * NPROJ + C_MO + h * HD + col); }
#pragma unroll
    for (int i = 0; i < 8; ++i) { const int ch = i * 64 + le, row = ch >> 4, col = (ch & 15) * 8;
        const f32x4 a0 = *(const LAS f32x4*)(uintptr_t)(unsigned)(hst + row * 512 + col * 4), a1 = *(const LAS f32x4*)(uintptr_t)(unsigned)(hst + row * 512 + col * 4 + 16);
        float ss = (a0.x * a0.x + a0.y * a0.y) + (a0.z * a0.z + a0.w * a0.w) + (a1.x * a1.x + a1.y * a1.y) + (a1.z * a1.z + a1.w * a1.w);
        ss += shx(ss, 1, le); ss += shx(ss, 2, le); ss += shx(ss, 4, le); ss += shx(ss, 8, le);
        const float rstd = fast_rsqrt(ss * (1.f / HD) + EPS);
        const int orow = row0 + wid * 32 + row;
        const u32x4 mo = mo8[i];
        const f32x4 g0 = *(const f32x4*)(gn + col), g1 = *(const f32x4*)(gn + col + 4);
        float y[8] = {a0.x * g0.x, a0.y * g0.y, a0.z * g0.z, a0.w * g0.w, a1.x * g1.x, a1.y * g1.y, a1.z * g1.z, a1.w * g1.w};
        const float mf[8] = {bflo(mo.x), bfhi(mo.x), bflo(mo.y), bfhi(mo.y), bflo(mo.z), bfhi(mo.z), bflo(mo.w), bfhi(mo.w)};
#pragma unroll
        for (int k = 0; k < 8; ++k) y[k] = y[k] * rstd * (1.0f / (1.0f + fast_exp(-mf[k])));
        u32x4 w; w.x = cvtpk(y[0], y[1]); w.y = cvtpk(y[2], y[3]); w.z = cvtpk(y[4], y[5]); w.w = cvtpk(y[6], y[7]);
        *(u32x4*)(MIX + (size_t)orow * D + 1536 + h * HD + col) = w; }
}

__device__ __forceinline__ void ms_unit(const Args& a, const Ctx& c, int l, int unit) {
    const int b = unit >> 2, h = unit & 3; int tid = c.tid; asm volatile("" : "+v"(tid));
    const int lane = tid & 63, wid = c.wave;
    const bf16* PROJ = (const bf16*)(a.ws + WS_BIG); bf16* MIX = (bf16*)(a.ws + WS_H);
    const float* GATE = (const float*)(a.ws + WS_GATE);
    constexpr int P = 132;
    LAS float* Q = (LAS float*)c.lds;
    LAS float* Kk = Q + 32 * P;
    LAS float* V = Kk + 32 * P;
    LAS float* HB = V + 32 * P;
    LAS float* S = HB + 32 * P;
    LAS float* N0 = S + 32 * 33;
    LAS float* A_S = N0 + 128;
    LAS float* M_T = A_S + 32;
    LAS float* B_T = M_T + 32;
    LAS float* WST = B_T + 32;
    LAS float* DEN = WST + 32;
    LAS float* WIN = DEN + 32;
    LAS float* SC = WIN + 32;
    const int row0 = MP + b * SSEQ;
    const size_t sidx = (size_t)(l * SBATCH + b) * MH + h;
    const float* C0 = a.state_c + sidx * HD * HD;
    __syncthreads();
    for (int i = tid; i < 1536; i += NTHREADS) { const int which = i >> 9, r = (i >> 4) & 31, c8 = (i & 15) * 8;
        const u32x4 w = *(const u32x4*)(PROJ + (size_t)(row0 + r) * NPROJ + (which == 0 ? C_MQ : which == 1 ? C_MK : C_MV) + h * HD + c8);
        const float sc = which == 1 ? 0.08838834764831845f : 1.0f;
        LAS float* dst = (which == 0 ? Q : which == 1 ? Kk : V) + r * P + c8;
        *(LAS f32x4*)dst = (f32x4){bflo(w.x) * sc, bfhi(w.x) * sc, bflo(w.y) * sc, bfhi(w.y) * sc};
        *(LAS f32x4*)(dst + 4) = (f32x4){bflo(w.z) * sc, bfhi(w.z) * sc, bflo(w.w) * sc, bfhi(w.w) * sc}; }
    if (tid < 128) N0[tid] = a.state_n[sidx * HD + tid];
    if (wid == 0) {
        const int t = lane & 31; const float m0 = a.state_m[sidx];
        const float li = GATE[(size_t)(row0 + t) * 8 + h], lf = GATE[(size_t)(row0 + t) * 8 + 4 + h];
        float bc = lf;
#pragma unroll
        for (int o = 1; o < 32; o <<= 1) { const float x = shup(bc, o, lane); if ((lane & 31) >= o) bc += x; }
        const float as = li - bc; float cm = as;
#pragma unroll
        for (int o = 1; o < 32; o <<= 1) { const float x = shup(cm, o, lane); if ((lane & 31) >= o) cm = fmaxf(cm, x); }
        const float blast = __int_as_float(__builtin_amdgcn_ds_bpermute(31 << 2, __float_as_int(bc))), amax = __int_as_float(__builtin_amdgcn_ds_bpermute(31 << 2, __float_as_int(cm)));
        const float Mt = fmaxf(m0, cm), mnew = fmaxf(blast + m0, blast + amax);
        if (lane < 32) { A_S[t] = as; B_T[t] = bc; M_T[t] = Mt; WST[t] = fast_exp(blast + as - mnew); WIN[t] = fast_exp(m0 - Mt); }
        if (lane == 0) { SC[0] = m0; SC[1] = blast; SC[2] = mnew; SC[3] = fast_exp(blast + m0 - mnew); }
    }
    __syncthreads();
    for (int i = tid; i < 1024; i += NTHREADS) { const int t = i >> 5, s = i & 31; float d = 0.f;
        if (s <= t) {
#pragma unroll 8
            for (int k = 0; k < 128; k += 4) { const f32x4 q4 = *(const LAS f32x4*)(Q + t * P + k), k4 = *(const LAS f32x4*)(Kk + s * P + k); d += (q4.x * k4.x + q4.y * k4.y) + (q4.z * k4.z + q4.w * k4.w); }
            d *= fast_exp(A_S[s] - M_T[t]); }
        S[t * 33 + s] = d; }
    __syncthreads();
    if (tid < 32) { const int t = tid; float qn = 0.f, rs = 0.f;
        for (int k = 0; k < 128; ++k) qn += Q[t * P + k] * N0[k];
        for (int s = 0; s < 32; ++s) rs += S[t * 33 + s];
        const float den = WIN[t] * qn + rs; DEN[t] = 1.0f / fmaxf(fabsf(den), fast_exp(-(B_T[t] + M_T[t]))); }
    const int e = tid & 127, tg = tid >> 7;
    { float acc[8];
#pragma unroll
      for (int i = 0; i < 8; ++i) acc[i] = 0.f;
      for (int d0 = 0; d0 < 128; d0 += 16) { float cv[16];
#pragma unroll
          for (int j = 0; j < 16; ++j) cv[j] = C0[(size_t)(d0 + j) * HD + e];
#pragma unroll
          for (int j = 0; j < 16; j += 4)
#pragma unroll
              for (int i = 0; i < 8; ++i) { const f32x4 q4 = *(const LAS f32x4*)(Q + (tg * 8 + i) * P + d0 + j); acc[i] += (q4.x * cv[j] + q4.y * cv[j + 1]) + (q4.z * cv[j + 2] + q4.w * cv[j + 3]); } }
      __syncthreads();
#pragma unroll
      for (int i = 0; i < 8; ++i) { const int t = tg * 8 + i; float v = acc[i] * WIN[t];
          for (int s = 0; s <= t; ++s) v += S[t * 33 + s] * V[s * P + e];
          HB[t * P + e] = v * DEN[t]; } }
    __syncthreads();
    { const int t = tid >> 4, e0 = (tid & 15) * 8; float ss = 0.f;
      const f32x4 h0 = *(const LAS f32x4*)(HB + t * P + e0), h1 = *(const LAS f32x4*)(HB + t * P + e0 + 4);
      ss = (h0.x * h0.x + h0.y * h0.y) + (h0.z * h0.z + h0.w * h0.w) + (h1.x * h1.x + h1.y * h1.y) + (h1.z * h1.z + h1.w * h1.w);
      ss += shx(ss, 1, lane); ss += shx(ss, 2, lane); ss += shx(ss, 4, lane); ss += shx(ss, 8, lane);
      const float rstd = fast_rsqrt(ss * (1.f / HD) + EPS);
      const u32x4 mo = *(const u32x4*)(PROJ + (size_t)(row0 + t) * NPROJ + C_MO + h * HD + e0);
      const float* gn = a.mlstm_norm_g + (size_t)l * 512 + h * HD + e0;
      const f32x4 g0 = *(const f32x4*)gn, g1 = *(const f32x4*)(gn + 4);
      float y[8] = {h0.x * g0.x, h0.y * g0.y, h0.z * g0.z, h0.w * g0.w, h1.x * g1.x, h1.y * g1.y, h1.z * g1.z, h1.w * g1.w};
      const float mf[8] = {bflo(mo.x), bfhi(mo.x), bflo(mo.y), bfhi(mo.y), bflo(mo.z), bfhi(mo.z), bflo(mo.w), bfhi(mo.w)};
#pragma unroll
      for (int k = 0; k < 8; ++k) y[k] = y[k] * rstd * (1.0f / (1.0f + fast_exp(-mf[k])));
      u32x4 w; w.x = cvtpk(y[0], y[1]); w.y = cvtpk(y[2], y[3]); w.z = cvtpk(y[4], y[5]); w.w = cvtpk(y[6], y[7]);
      *(u32x4*)(MIX + (size_t)(row0 + t) * D + 1536 + h * HD + e0) = w; }
    { const float decay = SC[3]; const int dg = tg * 32; float acc[32];
#pragma unroll
      for (int i = 0; i < 32; ++i) acc[i] = C0[(size_t)(dg + i) * HD + e] * decay;
      for (int s = 0; s < 32; ++s) { const float vv = V[s * P + e] * WST[s];
#pragma unroll
          for (int i = 0; i < 32; i += 4) { const f32x4 k4 = *(const LAS f32x4*)(Kk + s * P + dg + i); acc[i] += k4.x * vv; acc[i + 1] += k4.y * vv; acc[i + 2] += k4.z * vv; acc[i + 3] += k4.w * vv; } }
      float* oc = a.out + O_SC + sidx * HD * HD;
#pragma unroll
      for (int i = 0; i < 32; ++i) oc[(size_t)(dg + i) * HD + e] = acc[i];
      if (tid < 128) { float v = decay * N0[tid]; for (int s = 0; s < 32; ++s) v += WST[s] * Kk[s * P + tid]; a.out[O_SN + sidx * HD + tid] = v; }
      if (tid == 0) a.out[O_SM + sidx] = SC[2]; }
}

__device__ __forceinline__ void phase_e(const Args& a, const Ctx& c_in0, int l) {
    const Ctx c = relaunder(c_in0);
    const bf16* PROJ = (const bf16*)(a.ws + WS_BIG); bf16* MIX = (bf16*)(a.ws + WS_H);
    constexpr int NATT = NB * NH * 32;
#if (PE_EN & 1)
    for (int u = c.vcu; u < NATT; u += c.G) {
        const int gq = u & 31, bhh = u >> 5, b = bhh >> 3, h = bhh & 7;
        const int c0 = 4 * gq, jstart = c0 >= 8 ? 0 : 8 - c0, NT = 12 - jstart, ci = c.wave >> 1;
        const int krow0 = b * SEQ + (c0 - 8 + jstart) * 64;
        const int alo = ci - jstart, ahi = ci + 8 - jstart;
        const int R0 = (ci + 8 - jstart) * 64 + (c.wave & 1) * 32;
        attn_unit(c, PROJ + (size_t)(b * SEQ + c0 * 64) * NPROJ + C_Q + h * HD, NPROJ, c.wave * 32, PROJ + (size_t)krow0 * NPROJ + C_K + h * HD, PROJ + (size_t)krow0 * NPROJ + C_V + h * HD, NPROJ,
                  NT, alo < 0 ? 0 : alo, ahi, NT * 64, R0, a.rel_bias + (size_t)(l * NH + h) * 257, MIX + (size_t)(b * SEQ + c0 * 64) * D + 512 + h * HD, D, true);
    }
#endif
#if (PE_EN & 4)
    for (int u = c.vcu; u < 16 * NGRP; u += c.G) m3_unit(a, c, l, u);
#endif
}
__device__ __forceinline__ void phase_d_sample(const Args& a, const Ctx& c_in0, int l) {
    const Ctx c = relaunder(c_in0);
    const bf16* PROJ = (const bf16*)(a.ws + WS_BIG); bf16* MIX = (bf16*)(a.ws + WS_H);
#if (PE_EN & 2)
    for (int su = c.vcu; su < SBATCH * NH; su += c.G) {
        const int b = su >> 3, h = su & 7;
        const bf16* SK = (const bf16*)(a.ws + WS_SK + (size_t)(l & 1) * SKV_IMG) + (size_t)b * SKV_ROWS * 1024 + h * HD; const bf16* SV = (const bf16*)(a.ws + WS_SV + (size_t)(l & 1) * SKV_IMG) + (size_t)b * SKV_ROWS * 1024 + h * HD;
        attn_unit(c, PROJ + (size_t)(MP + b * SSEQ) * NPROJ + C_Q + h * HD, NPROJ, 0, SK, SV, 1024, 10, 0, 8, 544, 512, a.rel_bias + (size_t)(l * NH + h) * 257,
                  MIX + (size_t)(MP + b * SSEQ) * D + 512 + h * HD, D, c.wave == 0);
    }
#endif
#if (PE_EN & 8)
    for (int u = c.vcu - SBATCH * NH; u >= 0 && u < SBATCH * MH; u += c.G) ms_unit(a, c, l, u);
#endif
    if (l + 1 < DEPTH) { constexpr int W0 = SBATCH * NH + SBATCH * MH;
        if (c.G > W0) { if (c.vcu >= W0) build_kv_image(a, c.vcu - W0, c.G - W0, c.tid, l + 1); }
        else build_kv_image(a, c.vcu, c.G, c.tid, l + 1); }
    __syncthreads();
}
typedef const __attribute__((address_space(4))) Args* KArgP;
#if defined(__HIP_DEVICE_COMPILE__)
__device__ __forceinline__ Args get_args() { KArgP p = (KArgP)__builtin_amdgcn_kernarg_segment_ptr(); asm volatile("" : "+s"(p)); return *p; }
#else
__device__ Args get_args();
#endif
__global__ void __launch_bounds__(NTHREADS, 2) fwd(Args args) {
    extern __shared__ __attribute__((aligned(16))) unsigned char lds_raw[];
    Ctx c; c.lds = (LAS unsigned char*)lds_raw; c.wave = __builtin_amdgcn_readfirstlane((int)threadIdx.x >> 6); c.tid = hw_tid(c.wave); c.lane = c.tid & 63;
    c.G = gridDim.x; { const int bx = blockIdx.x; c.vcu = (c.G % 8 == 0) ? (bx % 8) * (c.G / 8) + bx / 8 : bx; }
    volatile LAS unsigned* MISC = (volatile LAS unsigned*)(c.lds + MISC_OFF);
    { const int t0 = hw_tid(c.wave); if (t0 < 16) MISC[t0] = 0u; }
    __syncthreads();
    unsigned* barw = (unsigned*)(get_args().ws + WS_CTL) + 4096;
    XcdBarrier bar; bar.bar = barw; bar.x = 0; bar.st = nullptr;
    const int lo = args.ph_lo, hi = args.ph_hi;
    const bool multi = (hi - lo) > 1;
    if (multi) bar = xcd_barrier_post(barw, MISC + 8, hw_tid(c.wave) == 0);
#define IN(k) (lo <= (k) && (k) < hi)
#define SEAM(k) do { if (IN(k) && IN((k) + 1)) xcd_barrier(bar.bar, bar.x, bar.st, c.wave); } while (0)
    for (int l = 0; l < DEPTH; ++l) {
        const int pb = l * NPH_LAYER;
        if (IN(pb + 0)) {
#if (PH_EN >> 1) & 1
            { const Args A_ = get_args(); phase_norm<true>(A_, c, l); }
#if (PH_DUP >> 1) & 1
            { __syncthreads(); const Args A_ = get_args(); phase_norm<true>(A_, c, l); }
#endif
#endif
 __syncthreads(); SEAM(pb + 0); }
        if (IN(pb + 1)) {
            const Args A_ = get_args(); bf16* H = (bf16*)(A_.ws + WS_H); bf16* BIG = (bf16*)(A_.ws + WS_BIG);
            bf16* XBp = (bf16*)(A_.ws + WS_XB); const float* RS = (const float*)(A_.ws + WS_RSTD);
            pg8::Gemm g{XBp, (const bf16*)(A_.ws + WS_WIN), MP, NPROJ, D}; pg8::StaticOrder S; S.init(MP, NPROJ, c.G, (int)blockIdx.x, WGM_B);
            pg8::EpiProj E{BIG, NPROJ, A_.q_norm_g + l * HD, A_.k_norm_g + l * HD, (LAS float*)(c.lds + SCR_OFF), RS};

#if (PH_EN >> 2) & 1
            for (int rep_ = 0, nrep_ = ((PH_DUP >> 2) & 1) ? A_.rep : 1; rep_ < nrep_; ++rep_) pg8::gemm_phase<pg8::EpiProj, pg8::StaticOrder, true, true>(c.lds, g, S, E, c.wave);
            { SEpiBf16 SE{BIG + (size_t)MP * NPROJ, NPROJ, 0, RS + MP}; sample_gemm(c.lds, c.wave, c.vcu, c.G, XBp + (size_t)MP * D, g.Bt, NPROJ, D, SE); }
#endif

            SEAM(pb + 1);
        }
        if (IN(pb + 2)) {
#if (PH_EN >> 3) & 1
            { const Args A_ = get_args(); phase_c<true>(A_, c, l); }
#if (PH_DUP >> 3) & 1
            { __syncthreads(); const Args A_ = get_args(); phase_c<false>(A_, c, l); }
#endif
#endif
 SEAM(pb + 2); }
        if (IN(pb + 3)) {
#if (PH_EN >> 4) & 1
            { const Args A_ = get_args(); phase_d(A_, c, l); }
            { const Args A_ = get_args(); phase_d_sample(A_, c, l); }
#if (PH_DUP >> 4) & 1
            { __syncthreads(); const Args A_ = get_args(); phase_d(A_, c, l); }
#endif
#endif
 SEAM(pb + 3); }
        if (IN(pb + 4)) {
#if (PH_EN >> 5) & 1
            { const Args A_ = get_args(); phase_e(A_, c, l); }
#if (PH_DUP >> 5) & 1
            { __syncthreads(); const Args A_ = get_args(); phase_e(A_, c, l); }
#endif
#endif
 __syncthreads(); SEAM(pb + 4); }
        if (IN(pb + 5)) {
            const Args A_ = get_args(); bf16* H = (bf16*)(A_.ws + WS_H);
            pg8::Gemm g{H, (const bf16*)(A_.ws + WS_WOUT), MP, D, D}; pg8::StaticOrder S; S.init(MP, D, c.G, (int)blockIdx.x, WGM_F);
            pg8::EpiResAdd E{(bf16*)(A_.ws + WS_XB), A_.out, D, false, (float*)(A_.ws + WS_PART), (LAS float*)(c.lds + SCR_OFF)};

#if (PH_EN >> 6) & 1
            pg8::gemm_phase<pg8::EpiResAdd, pg8::StaticOrder, true, true>(c.lds, g, S, E, c.wave);
            { SEpiResAdd SE{(bf16*)(A_.ws + WS_XB) + (size_t)MP * D, A_.out + (size_t)MP * D, D, false, (float*)(A_.ws + WS_PARTS)}; sample_gemm(c.lds, c.wave, c.vcu, c.G, H + (size_t)MP * D, g.Bt, D, D, SE); }
#if (PH_DUP >> 6) & 1
            { pg8::EpiBf16<0> E2{(bf16*)(A_.ws + WS_BIG), D, nullptr, (LAS float*)(c.lds + SCR_OFF), 0}; pg8::gemm_phase<pg8::EpiBf16<0>, pg8::StaticOrder, true, true>(c.lds, g, S, E2, c.wave); }
#endif
#endif

            SEAM(pb + 5);
        }
        if (IN(pb + 6)) {
            const Args A_ = get_args(); bf16* H = (bf16*)(A_.ws + WS_H); bf16* BIG = (bf16*)(A_.ws + WS_BIG);
            bf16* XBp = (bf16*)(A_.ws + WS_XB); const float* RS = (const float*)(A_.ws + WS_PART);
            pg8::Gemm g{XBp, (const bf16*)(A_.ws + WS_WUP), MP, FF, D}; pg8::StaticOrder S; S.init(MP, FF, c.G, (int)blockIdx.x, WGM_H);
            pg8::EpiBf16<1> E{BIG, FF, RS, (LAS float*)(c.lds + SCR_OFF), 8};

#if (PH_EN >> 8) & 1
            for (int rep_ = 0, nrep_ = ((PH_DUP >> 8) & 1) ? A_.rep : 1; rep_ < nrep_; ++rep_) pg8::gemm_phase<pg8::EpiBf16<1>, pg8::StaticOrder, true, true>(c.lds, g, S, E, c.wave);
            { LAS float* tb = (LAS float*)(c.lds + SCR_OFF) + 3072;
              { const int t_ = hw_tid(c.wave); if (t_ < MS) { const float* ps = (const float*)(A_.ws + WS_PARTS); float s = 0.f; for (int q = 0; q < 32; ++q) s += ps[q * MS + t_]; tb[t_] = fast_rsqrt(s * (1.0f / D) + EPS); } }
              __syncthreads();
              SEpiBf16 SE{BIG + (size_t)MP * FF, FF, 1, (const float*)tb}; sample_gemm(c.lds, c.wave, c.vcu, c.G, XBp + (size_t)MP * D, g.Bt, FF, D, SE); }
#endif

            SEAM(pb + 6);
        }
        if (IN(pb + 7)) {
            const Args A_ = get_args(); bf16* BIG = (bf16*)(A_.ws + WS_BIG);
            pg8::Gemm g{BIG, (const bf16*)(A_.ws + WS_WDN), MP, D, FF}; pg8::StaticOrder S; S.init(MP, D, c.G, (int)blockIdx.x, WGM_I);
            pg8::EpiResAdd E{(bf16*)(A_.ws + WS_XB), A_.out, D, l == DEPTH - 1, nullptr, (LAS float*)(c.lds + SCR_OFF)};

#if (PH_EN >> 9) & 1
            pg8::gemm_phase<pg8::EpiResAdd, pg8::StaticOrder, true, true>(c.lds, g, S, E, c.wave);
            { SEpiResAdd SE{(bf16*)(A_.ws + WS_XB) + (size_t)MP * D, A_.out + (size_t)MP * D, D, l == DEPTH - 1, nullptr}; sample_gemm(c.lds, c.wave, c.vcu, c.G, BIG + (size_t)MP * FF, g.Bt, D, FF, SE); }
#if (PH_DUP >> 9) & 1
            { pg8::EpiBf16<0> E2{(bf16*)(A_.ws + WS_H), D, nullptr, (LAS float*)(c.lds + SCR_OFF), 0}; pg8::gemm_phase<pg8::EpiBf16<0>, pg8::StaticOrder, true, true>(c.lds, g, S, E2, c.wave); }
#endif
#endif

            SEAM(pb + 7);
        }
    }
#undef IN
#undef SEAM
}

extern "C" void kernel_launch(void* const* d_in, const int* in_sizes, int n_in, void* d_out, int out_size, void* d_ws, size_t ws_size, hipStream_t stream) {
    static int grid = 0;
    if (grid == 0) {
        if (n_in != 21 || (size_t)out_size != O_END || ws_size < WS_END) { fprintf(stderr, "kernel_launch: shape mismatch n_in %d out %d ws %zu (need %zu)\n", n_in, out_size, ws_size, (size_t)WS_END); grid = -1; return; }
        int dev = 0, cus = 0, per_cu = 0;
        if (hipGetDevice(&dev) != hipSuccess || hipDeviceGetAttribute(&cus, hipDeviceAttributeMultiprocessorCount, dev) != hipSuccess) { grid = -1; return; }
        if (hipFuncSetAttribute((const void*)fwd, hipFuncAttributeMaxDynamicSharedMemorySize, LDS_BYTES) != hipSuccess) { fprintf(stderr, "kernel_launch: hipFuncSetAttribute failed\n"); grid = -1; return; }
        if (hipOccupancyMaxActiveBlocksPerMultiprocessor(&per_cu, (const void*)fwd, NTHREADS, LDS_BYTES) != hipSuccess || per_cu < 1) { fprintf(stderr, "kernel_launch: occupancy query says %d\n", per_cu); }
        (void)hipGetLastError();
        grid = cus;
    }
    if (grid < 0) return;
    (void)hipMemsetAsync((char*)d_ws + WS_CTL, 0, CTL_BYTES, stream);
    Args a{};
    a.x_prompt = (const float*)d_in[0]; a.x_sample = (const float*)d_in[1]; a.cache_k = (const float*)d_in[2]; a.cache_v = (const float*)d_in[3]; a.state_conv = (const float*)d_in[4];
    a.state_c = (const float*)d_in[5]; a.state_n = (const float*)d_in[6]; a.state_m = (const float*)d_in[7]; a.norm_mix_g = (const float*)d_in[8]; a.w_in = (const float*)d_in[9];
    a.conv_w = (const float*)d_in[10]; a.q_norm_g = (const float*)d_in[11]; a.k_norm_g = (const float*)d_in[12]; a.rel_bias = (const float*)d_in[13]; a.b_igate = (const float*)d_in[14];
    a.b_fgate = (const float*)d_in[15]; a.mlstm_norm_g = (const float*)d_in[16]; a.w_out = (const float*)d_in[17]; a.norm_mlp_g = (const float*)d_in[18]; a.w_up = (const float*)d_in[19];
    a.w_down = (const float*)d_in[20]; a.out = (float*)d_out; a.ws = (unsigned char*)d_ws;
#if MK_PER_PHASE
    for (int p = 0; p < NPHASES; ++p) { a.ph_lo = p; a.ph_hi = p + 1; a.rep = 2; hipLaunchKernelGGL(fwd, dim3(grid), dim3(NTHREADS), LDS_BYTES, stream, a); }
#else
    a.ph_lo = 0; a.ph_hi = NPHASES; a.rep = 2; hipLaunchKernelGGL(fwd, dim3(grid), dim3(NTHREADS), LDS_BYTES, stream, a);
#endif
    const hipError_t le = hipPeekAtLastError();
    if (le != hipSuccess) fprintf(stderr, "kernel_launch: launch failed: %s\n", hipGetErrorName(le));
}
```

```cpp
#include <hip/hip_runtime.h>
#include <cstdio>
#include <cstdint>

#ifndef MK_PER_PHASE
#define MK_PER_PHASE 0
#endif

#ifndef PH_EN
#define PH_EN 0x3ff
#endif
#ifndef PE_EN
#define PE_EN 0xf
#endif
#ifndef WGM_B
#define WGM_B 4
#endif
#ifndef WGM_F
#define WGM_F 4
#endif
#ifndef WGM_H
#define WGM_H 4
#endif
#ifndef WGM_I
#define WGM_I 4
#endif
#ifndef PH_DUP
#define PH_DUP 0
#endif
#define LAS __attribute__((address_space(3)))
#define GAS __attribute__((address_space(1)))
typedef unsigned short bf16;
typedef short bf16x8 __attribute__((ext_vector_type(8)));
typedef short s16x4 __attribute__((ext_vector_type(4)));
typedef float f32x2 __attribute__((ext_vector_type(2)));
typedef float f32x4 __attribute__((ext_vector_type(4)));
typedef float f32x16 __attribute__((ext_vector_type(16)));
typedef unsigned u32x2 __attribute__((ext_vector_type(2)));
typedef unsigned u32x4 __attribute__((ext_vector_type(4)));

constexpr int D = 2048, NB = 4, SEQ = 8192, DEPTH = 4, SBATCH = 8, SSEQ = 32;
constexpr int MP = NB * SEQ, MS = SBATCH * SSEQ, MR = MP + MS;
constexpr int NH = 8, HD = 128, MH = 4;
constexpr int NPROJ = 6656, IN_DIM = 6664, FF = 8192;
constexpr int C_XA = 0, C_GB = 512, C_GC = 1024, C_Q = 1536, C_K = 2560, C_V = 3584, C_MQ = 4608, C_MK = 5120, C_MV = 5632, C_MO = 6144;
constexpr int KEEP = 512;
constexpr int SKV_ROWS = 640;
constexpr float EPS = 1e-6f;
constexpr float LOG2E = 1.4426950408889634f;
constexpr int NGRP = SEQ / 256;

constexpr size_t O_YP = 0, O_YS = O_YP + (size_t)MP * D, O_PCONV = O_YS + (size_t)MS * D, O_PK = O_PCONV + (size_t)DEPTH * NB * 2 * 512,
                 O_PV = O_PK + (size_t)DEPTH * NB * KEEP * 1024, O_PC = O_PV + (size_t)DEPTH * NB * KEEP * 1024, O_PN = O_PC + (size_t)DEPTH * NB * MH * HD * HD,
                 O_PM = O_PN + (size_t)DEPTH * NB * MH * HD, O_SCONV = O_PM + (size_t)DEPTH * NB * MH, O_SK = O_SCONV + (size_t)DEPTH * SBATCH * 2 * 512,
                 O_SV = O_SK + (size_t)DEPTH * SBATCH * SSEQ * 1024, O_SC = O_SV + (size_t)DEPTH * SBATCH * SSEQ * 1024, O_SN = O_SC + (size_t)DEPTH * SBATCH * MH * HD * HD,
                 O_SM = O_SN + (size_t)DEPTH * SBATCH * MH * HD, O_END = O_SM + (size_t)DEPTH * SBATCH * MH;

constexpr size_t al256(size_t x) { return (x + 255) / 256 * 256; }
constexpr size_t WS_CTL = 0, CTL_BYTES = 1u << 20;
constexpr size_t WS_WIN = CTL_BYTES;
constexpr size_t WS_WOUT = WS_WIN + (size_t)NPROJ * D * 2;
constexpr size_t WS_WUP = WS_WOUT + (size_t)D * D * 2;
constexpr size_t WS_WDN = WS_WUP + (size_t)FF * D * 2;
constexpr size_t WS_H = WS_WDN + (size_t)D * FF * 2;
constexpr size_t WS_XB = WS_H + (size_t)MR * D * 2;
constexpr size_t WS_BIG = WS_XB + (size_t)MR * D * 2;
constexpr size_t BIG_BYTES = (size_t)MR * FF * 2;
constexpr size_t WS_CLOC = WS_BIG + al256((size_t)MR * NPROJ * 2);
constexpr size_t WS_C0 = WS_CLOC + (size_t)16 * NGRP * HD * HD * 4;
constexpr size_t WS_NLOC = WS_C0 + (size_t)16 * NGRP * HD * HD * 2;
constexpr size_t WS_N0 = WS_NLOC + (size_t)16 * NGRP * HD * 4;
constexpr size_t WS_MSC = WS_N0 + (size_t)16 * NGRP * HD * 4;
constexpr size_t WS_MIX_END = WS_MSC + (size_t)16 * NGRP * 4 * 4;
static_assert(WS_MIX_END <= WS_BIG + BIG_BYTES, "mLSTM scratch fits in the free top of BIG");
constexpr size_t WS_GATE = WS_BIG + BIG_BYTES;
constexpr size_t SKV_IMG = (size_t)SBATCH * SKV_ROWS * 1024 * 2;
constexpr size_t WS_SK = WS_GATE + (size_t)MR * 8 * 4;
constexpr size_t WS_SV = WS_SK + 2 * SKV_IMG;
constexpr size_t WS_RSTD = WS_SV + 2 * SKV_IMG;
constexpr size_t WS_END = WS_RSTD + (size_t)MR * 4;
static_assert(WS_END <= 1235000000ull, "workspace budget");

constexpr int RING_BYTES = 131072;
constexpr int MISC_OFF = RING_BYTES;
constexpr int SCR_OFF = MISC_OFF + 256;
constexpr int LDS_BYTES = 147456;
constexpr int NWAVES = 8, NTHREADS = 512;

__device__ __forceinline__ unsigned cvtpk(float lo, float hi) { unsigned r; asm volatile("v_cvt_pk_bf16_f32 %0, %1, %2" : "=v"(r) : "v"(lo), "v"(hi)); return r; }
__device__ __forceinline__ float bflo(unsigned w) { return __uint_as_float(w << 16); }
__device__ __forceinline__ float bfhi(unsigned w) { return __uint_as_float(w & 0xffff0000u); }
__device__ __forceinline__ float bf2f(bf16 b) { return __uint_as_float(((unsigned)b) << 16); }
__device__ __forceinline__ float shx(float v, int o, int lane) { return __int_as_float(__builtin_amdgcn_ds_bpermute((lane ^ o) << 2, __float_as_int(v))); }
__device__ __forceinline__ float shup(float v, int o, int lane) { const int s = lane - o; return __int_as_float(__builtin_amdgcn_ds_bpermute((s < 0 ? lane : s) << 2, __float_as_int(v))); }
__device__ __forceinline__ float wave_sum(float v, int lane) {
#pragma unroll
    for (int o = 1; o < 64; o <<= 1) v += shx(v, o, lane);
    return v;
}
__device__ __forceinline__ float fast_rsqrt(float x) { return __builtin_amdgcn_rsqf(x); }
__device__ __forceinline__ float fast_exp(float x) { return __builtin_amdgcn_exp2f(x * 1.4426950408889634f); }
__device__ __forceinline__ float fast_log(float x) { return __builtin_amdgcn_logf(x) * 0.6931471805599453f; }
__device__ __forceinline__ float opaque_zero() { float z; asm volatile("v_mov_b32 %0, 0" : "=v"(z)); return z; }
#define LDS_WAIT() asm volatile("s_waitcnt lgkmcnt(0)" ::: "memory")
#define VM_WAIT() asm volatile("s_waitcnt vmcnt(0)" ::: "memory")
#define SBAR() __builtin_amdgcn_sched_barrier(0)

namespace pg8 {
typedef unsigned short bf16_t;
constexpr int BM = 256, BK = 64, HALF = 128, HTB = HALF * BK * 2, STAGE_BYTES = 8 * HTB, NXCD = 8, WGM = 4;
__host__ __device__ __forceinline__ int lds_byte(int r, int c) { const int st = (r >> 4) * 2 + (c >> 5), rr = r & 15, cc = c & 31, ob = rr * 64 + cc * 2; return st * 1024 + (ob ^ (((ob >> 9) & 1) << 5)); }
__host__ __device__ __forceinline__ void stage_rc(int b, int& R, int& C) { const int st = b / 1024, sb = b % 1024, swz = sb ^ (((sb >> 9) & 1) << 5); R = (st >> 1) * 16 + swz / 64; C = (st & 1) * 32 + (swz % 64) / 2; }
__host__ __device__ __forceinline__ int perm32(int rho) { const int n = rho >> 4, i = rho & 15; return 8 * (i >> 2) + 4 * n + (i & 3); }
struct Unit { int pm, pn; };
struct Gemm { const bf16_t* A; const bf16_t* Bt; int M, N, K; };
struct StaticOrder {
    int nM, nN, nwg, G, c, wgm;
    __host__ __device__ void init(int M, int N, int G_, int c_, int wgm_ = WGM) { nM = M / BM; nN = N / BM; nwg = nM * nN; G = G_; c = c_; wgm = wgm_; }
    __host__ __device__ bool next(int i, Unit& u) const {
        const long L = (long)i * G + c; if (L >= nwg) return false;
        int wgid = (int)L; { const int q = nwg / NXCD, r = nwg % NXCD, xcd = wgid % NXCD, off = wgid / NXCD; wgid = (xcd < r ? xcd * (q + 1) : r * (q + 1) + (xcd - r) * q) + off; }
        const int nig = wgm * nN, gid = wgid / nig, fm = gid * wgm, gsz = (nM - fm) < wgm ? (nM - fm) : wgm;
        u.pm = fm + ((wgid % nig) % gsz); u.pn = (wgid % nig) / gsz; return true;
    }
    __device__ __forceinline__ void a_ready(const Unit&) const {}
    __device__ __forceinline__ void done(const Unit&) const {}
};
template <int ACT  > struct EpiBf16 {
    static constexpr bool PERM = true, AFTER_DRAIN = false;
    static constexpr bool RSL = true;
    bf16_t* O; int ldc; const float* rstd; LAS float* T;
    __device__ __forceinline__ void rs_fetch(const Unit& u, int tid, int par) const { if (rstd && tid < BM) (T + 2048 + par * BM)[tid] = rstd[u.pm * BM + tid]; }
    __device__ __forceinline__ void operator()(const f32x4 (&acc)[2][2][4][2], const Unit& u, int wr, int wc, int fr, int fq, int par) const {
        const int row0 = u.pm * BM + wr * 64 + fr; const int col0 = u.pn * BM + wc * 32 + 8 * fq;
#pragma unroll
        for (int ai = 0; ai < 2; ++ai)
#pragma unroll
            for (int m = 0; m < 4; ++m) { bf16_t* rowp = O + (size_t)(row0 + ai * HALF + m * 16) * ldc + col0; const float rsv = rstd ? (T + 2048 + par * BM)[wr * 64 + fr + ai * HALF + m * 16] : 1.0f;
#pragma unroll
                for (int bj = 0; bj < 2; ++bj) { f32x4 v0 = acc[ai][bj][m][0] * rsv, v1 = acc[ai][bj][m][1] * rsv;
                    if (ACT == 1) {
#pragma unroll
                        for (int j = 0; j < 4; ++j) { const float a = fmaxf(v0[j], 0.f), b = fmaxf(v1[j], 0.f); v0[j] = a * a; v1[j] = b * b; } }
                    u32x4 w; w.x = cvtpk(v0[0], v0[1]); w.y = cvtpk(v0[2], v0[3]); w.z = cvtpk(v1[0], v1[1]); w.w = cvtpk(v1[2], v1[3]);
                    *(u32x4*)(rowp + bj * HALF) = w; } }
    }
};
struct EpiProj {
    static constexpr bool PERM = true, AFTER_DRAIN = false;
    static constexpr bool RSL = true;
    bf16_t* O; int ldc; const float* gq; const float* gk; LAS float* T; const float* rstd;
    __device__ __forceinline__ void rs_fetch(const Unit& u, int tid, int par) const { if (tid < BM) (T + 2048 + par * BM)[tid] = rstd[u.pm * BM + tid]; }
    __device__ __forceinline__ void operator()(const f32x4 (&acc)[2][2][4][2], const Unit& u, int wr, int wc, int fr, int fq, int par) const {
        const int row0 = u.pm * BM + wr * 64 + fr; const int col0 = u.pn * BM + wc * 32 + 8 * fq;
        const bool isqk = (u.pn >= 6) && (u.pn < 14);
        float rs[2][4];
#pragma unroll
        for (int ai = 0; ai < 2; ++ai)
#pragma unroll
            for (int m = 0; m < 4; ++m) rs[ai][m] = (T + 2048 + par * BM)[wr * 64 + fr + ai * HALF + m * 16];
        if (!isqk) {
#pragma unroll
            for (int ai = 0; ai < 2; ++ai)
#pragma unroll
                for (int m = 0; m < 4; ++m) { bf16_t* rowp = O + (size_t)(row0 + ai * HALF + m * 16) * ldc + col0;
#pragma unroll
                    for (int bj = 0; bj < 2; ++bj) { const f32x4 v0 = acc[ai][bj][m][0] * rs[ai][m], v1 = acc[ai][bj][m][1] * rs[ai][m];
                        u32x4 w; w.x = cvtpk(v0[0], v0[1]); w.y = cvtpk(v0[2], v0[3]); w.z = cvtpk(v1[0], v1[1]); w.w = cvtpk(v1[2], v1[3]);
                        *(u32x4*)(rowp + bj * HALF) = w; } }
            return;
        }
        const int lane = fr + 16 * fq;
        float ss[2][4][2];
#pragma unroll
        for (int ai = 0; ai < 2; ++ai)
#pragma unroll
            for (int m = 0; m < 4; ++m)
#pragma unroll
                for (int bj = 0; bj < 2; ++bj) { const f32x4 v0 = acc[ai][bj][m][0] * rs[ai][m], v1 = acc[ai][bj][m][1] * rs[ai][m];
                    float s = (v0[0] * v0[0] + v0[1] * v0[1]) + (v0[2] * v0[2] + v0[3] * v0[3]) + (v1[0] * v1[0] + v1[1] * v1[1]) + (v1[2] * v1[2] + v1[3] * v1[3]);
                    s += shx(s, 16, lane); s += shx(s, 32, lane); ss[ai][m][bj] = s; }
        if (fq == 0) {
#pragma unroll
            for (int ai = 0; ai < 2; ++ai)
#pragma unroll
                for (int m = 0; m < 4; ++m)
#pragma unroll
                    for (int bj = 0; bj < 2; ++bj) T[(ai * HALF + wr * 64 + m * 16 + fr) * 8 + bj * 4 + wc] = ss[ai][m][bj];
        }
        asm volatile("s_waitcnt lgkmcnt(0)" ::: "memory"); __builtin_amdgcn_s_barrier(); asm volatile("" ::: "memory");
        const float* gg = ((u.pn < 10) ? gq : gk) + wc * 32 + 8 * fq;
        const f32x4 g0 = *(const f32x4*)gg, g1 = *(const f32x4*)(gg + 4);
#pragma unroll
        for (int ai = 0; ai < 2; ++ai)
#pragma unroll
            for (int m = 0; m < 4; ++m) { bf16_t* rowp = O + (size_t)(row0 + ai * HALF + m * 16) * ldc + col0;
#pragma unroll
                for (int bj = 0; bj < 2; ++bj) { const f32x4 t = *(const LAS f32x4*)(T + (ai * HALF + wr * 64 + m * 16 + fr) * 8 + bj * 4);
                    const float rq = fast_rsqrt(((t[0] + t[1]) + (t[2] + t[3])) * (1.0f / 128.0f) + 1e-6f) * rs[ai][m];
                    const f32x4 v0 = acc[ai][bj][m][0] * rq * g0, v1 = acc[ai][bj][m][1] * rq * g1;
                    u32x4 w; w.x = cvtpk(v0[0], v0[1]); w.y = cvtpk(v0[2], v0[3]); w.z = cvtpk(v1[0], v1[1]); w.w = cvtpk(v1[2], v1[3]);
                    *(u32x4*)(rowp + bj * HALF) = w; } }
    }
};
struct EpiResAdd {
    static constexpr bool RSL = false;
    static constexpr bool PERM = true, AFTER_DRAIN = false;
    bf16_t* XB; float* Y; int ldc; bool fin;
    __device__ __forceinline__ void operator()(const f32x4 (&acc)[2][2][4][2], const Unit& u, int wr, int wc, int fr, int fq, int) const {
        const int row0 = u.pm * BM + wr * 64 + fr, col0 = u.pn * BM + wc * 32 + 8 * fq;
        u32x4 r[2][4][2];
#pragma unroll
        for (int ai = 0; ai < 2; ++ai)
#pragma unroll
            for (int m = 0; m < 4; ++m)
#pragma unroll
                for (int bj = 0; bj < 2; ++bj) r[ai][m][bj] = *(const u32x4*)(XB + (size_t)(row0 + ai * HALF + m * 16) * ldc + col0 + bj * HALF);
#pragma unroll
        for (int ai = 0; ai < 2; ++ai)
#pragma unroll
            for (int m = 0; m < 4; ++m)
#pragma unroll
                for (int bj = 0; bj < 2; ++bj) { const u32x4 w = r[ai][m][bj]; const f32x4 a0 = acc[ai][bj][m][0], a1 = acc[ai][bj][m][1];
                    const f32x4 v0 = (f32x4){bflo(w.x) + a0[0], bfhi(w.x) + a0[1], bflo(w.y) + a0[2], bfhi(w.y) + a0[3]}, v1 = (f32x4){bflo(w.z) + a1[0], bfhi(w.z) + a1[1], bflo(w.w) + a1[2], bfhi(w.w) + a1[3]};
                    const size_t off = (size_t)(row0 + ai * HALF + m * 16) * ldc + col0 + bj * HALF;
                    if (fin) { *(f32x4*)(Y + off) = v0; *(f32x4*)(Y + off + 4) = v1; }
                    else { u32x4 o; o.x = cvtpk(v0[0], v0[1]); o.y = cvtpk(v0[2], v0[3]); o.z = cvtpk(v1[0], v1[1]); o.w = cvtpk(v1[2], v1[3]); *(u32x4*)(XB + off) = o; } }
    }
};

template <class Epi, class Sched, bool ALIGN_EPI = false, bool SP2 = false>
__device__ __forceinline__ void gemm_phase(LAS unsigned char* lds, const Gemm g, const Sched& S, const Epi& E, const int wave_) {
    int ln_; asm volatile("v_mbcnt_lo_u32_b32 %0, -1, 0\n\tv_mbcnt_hi_u32_b32 %0, -1, %0" : "=v"(ln_)); const int tid = wave_ * 64 + ln_;
    const int wid = __builtin_amdgcn_readfirstlane(tid >> 6), lane = tid & 63, wr = wid >> 2, wc = wid & 3, fr = lane & 15, fq = lane >> 4;
    const int K = g.K, nt = K / BK;
    unsigned voffA[2], voffB[2];
#pragma unroll
    for (int i = 0; i < 2; ++i) { int R, C; stage_rc(tid * 16 + i * 8192, R, C); const int Rb = Epi::PERM ? ((R & ~31) + perm32(R & 31)) : R;
        voffA[i] = (unsigned)(R * K + C) * 2u; voffB[i] = (unsigned)(Rb * K + C) * 2u; }
    const size_t kstep = (size_t)(BK * 2);
    const size_t hstep = (size_t)HALF * K * 2;
    const size_t tstep = 2 * hstep;
    const unsigned ldsw = (unsigned)wid * 1024u;
    const int aoff = lds_byte(wr * 64 + fr, fq * 8), boff = lds_byte(wc * 32 + fr, fq * 8);
#define PG8_SA(b, h) (((b) * 2 + (h)) * HTB)
#define PG8_SB(b, h) ((4 + (b) * 2 + (h)) * HTB)
#define PG8_STAGE(bufoff, gbase, voff) do { _Pragma("unroll") for (int _i = 0; _i < 2; ++_i) \
        __builtin_amdgcn_global_load_lds((const unsigned*)((const char*)(gbase) + (voff)[_i]), (LAS unsigned*)(lds + (bufoff) + ldsw + _i * 8192), 16, 0, 0); } while (0)
#define PG8_LDA(dst, b, h) do { _Pragma("unroll") for (int m = 0; m < 4; ++m) _Pragma("unroll") for (int k = 0; k < 2; ++k) dst[m][k] = *(const LAS bf16x8*)(lds + PG8_SA(b, h) + aoff + m * 2048 + k * 1024); } while (0)
#define PG8_LDB(dst, b, h) do { _Pragma("unroll") for (int n = 0; n < 2; ++n) _Pragma("unroll") for (int k = 0; k < 2; ++k) dst[n][k] = *(const LAS bf16x8*)(lds + PG8_SB(b, h) + boff + n * 2048 + k * 1024); } while (0)
#define PG8_MMA(ai, bj, At, Bt) do { __builtin_amdgcn_s_setprio(1); _Pragma("unroll") for (int m = 0; m < 4; ++m) _Pragma("unroll") for (int n = 0; n < 2; ++n) _Pragma("unroll") for (int k = 0; k < 2; ++k) \
        acc[ai][bj][m][n] = __builtin_amdgcn_mfma_f32_16x16x32_bf16(Bt[n][k], At[m][k], acc[ai][bj][m][n], 0, 0, 0); __builtin_amdgcn_s_setprio(0); } while (0)
#define PG8_WAIT_V(n) asm volatile("s_waitcnt vmcnt(" #n ")" ::: "memory")
#define PG8_WAIT_L(n) asm volatile("s_waitcnt lgkmcnt(" #n ")" ::: "memory")
#define PG8_BAR __builtin_amdgcn_s_barrier()
#define PG8_SCHED __builtin_amdgcn_sched_barrier(0)
    Unit cur, nxt; int ui = 0;
    if (!S.next(0, cur)) return;
    f32x4 acc[2][2][4][2];
    { const float z = opaque_zero();
#pragma unroll
    for (int a = 0; a < 2; ++a)
#pragma unroll
        for (int b = 0; b < 2; ++b)
#pragma unroll
            for (int m = 0; m < 4; ++m)
#pragma unroll
                for (int n = 0; n < 2; ++n) acc[a][b][m][n] = (f32x4){z, z, z, z}; }
    bf16x8 At[4][2], B0[2][2], B1[2][2];
    const char* cA = (const char*)g.A + (size_t)cur.pm * tstep; const char* cB = (const char*)g.Bt + (size_t)cur.pn * tstep;
    S.a_ready(cur);
    if constexpr (Epi::RSL) E.rs_fetch(cur, tid, 0);
    if constexpr (SP2) {
        PG8_STAGE(PG8_SB(0, 0), cB, voffB); PG8_STAGE(PG8_SB(0, 1), cB + hstep, voffB); PG8_STAGE(PG8_SA(0, 0), cA, voffA); PG8_STAGE(PG8_SA(0, 1), cA + hstep, voffA);
        if (wr == 1) PG8_BAR;
        PG8_WAIT_V(2); PG8_BAR;
        PG8_STAGE(PG8_SB(1, 0), cB + kstep, voffB); PG8_STAGE(PG8_SA(1, 0), cA + kstep, voffA); PG8_STAGE(PG8_SB(1, 1), cB + hstep + kstep, voffB);
        PG8_WAIT_V(6); PG8_BAR;
    } else {
        PG8_STAGE(PG8_SB(0, 0), cB, voffB); PG8_STAGE(PG8_SA(0, 0), cA, voffA); PG8_STAGE(PG8_SB(0, 1), cB + hstep, voffB); PG8_STAGE(PG8_SA(0, 1), cA + hstep, voffA);
        if (wr == 1) PG8_BAR;
        PG8_WAIT_V(4); PG8_BAR;
        PG8_STAGE(PG8_SB(1, 0), cB + kstep, voffB); PG8_STAGE(PG8_SA(1, 0), cA + kstep, voffA); PG8_STAGE(PG8_SB(1, 1), cB + hstep + kstep, voffB);
        PG8_WAIT_V(6); PG8_BAR;
    }
    for (;;) {
        const bool has_next = S.next(ui + 1, nxt);
        const char* nA = has_next ? (const char*)g.A + (size_t)nxt.pm * tstep : cA; const char* nB = has_next ? (const char*)g.Bt + (size_t)nxt.pn * tstep : cB;
        for (int t = 0; t < nt; t += 2) {
            const bool last = (t == nt - 2);
            const char* a1 = cA + (size_t)(t + 1) * kstep;
            const char* a2 = last ? nA : cA + (size_t)(t + 2) * kstep; const char* b2 = last ? nB : cB + (size_t)(t + 2) * kstep;
            const char* a3 = a2 + kstep; const char* b3 = b2 + kstep;
            if (last && has_next) S.a_ready(nxt);
            if constexpr (SP2) {
            PG8_LDB(B0, 0, 0); PG8_LDB(B1, 0, 1); PG8_SCHED; PG8_LDA(At, 0, 0); PG8_STAGE(PG8_SA(1, 1), a1 + hstep, voffA);
            PG8_WAIT_V(8); PG8_WAIT_L(0); PG8_BAR; PG8_MMA(0, 0, At, B0); PG8_MMA(0, 1, At, B1); PG8_BAR; PG8_SCHED;
            PG8_LDA(At, 0, 1); PG8_STAGE(PG8_SB(0, 0), b2, voffB); PG8_STAGE(PG8_SB(0, 1), b2 + hstep, voffB); PG8_STAGE(PG8_SA(0, 0), a2, voffA);
            PG8_WAIT_V(8); PG8_WAIT_L(0); PG8_BAR; PG8_MMA(1, 0, At, B0); PG8_MMA(1, 1, At, B1); PG8_BAR; PG8_SCHED;
            PG8_LDB(B0, 1, 0); PG8_LDB(B1, 1, 1); PG8_SCHED; PG8_LDA(At, 1, 0); PG8_STAGE(PG8_SA(0, 1), a2 + hstep, voffA);
            PG8_WAIT_V(8); PG8_WAIT_L(0); PG8_BAR; PG8_MMA(0, 0, At, B0); PG8_MMA(0, 1, At, B1); PG8_BAR; PG8_SCHED;
            PG8_LDA(At, 1, 1); PG8_STAGE(PG8_SB(1, 0), b3, voffB); PG8_STAGE(PG8_SB(1, 1), b3 + hstep, voffB); PG8_STAGE(PG8_SA(1, 0), a3, voffA);
            PG8_WAIT_V(8); PG8_WAIT_L(0); PG8_BAR; PG8_MMA(1, 0, At, B0); PG8_MMA(1, 1, At, B1); PG8_BAR; PG8_SCHED;
            } else {
            PG8_LDB(B0, 0, 0); PG8_SCHED; PG8_LDA(At, 0, 0); PG8_STAGE(PG8_SA(1, 1), a1 + hstep, voffA);
            PG8_WAIT_L(8); PG8_BAR; PG8_WAIT_L(0); PG8_MMA(0, 0, At, B0); PG8_BAR; PG8_SCHED;
            PG8_LDB(B1, 0, 1); PG8_STAGE(PG8_SB(0, 0), b2, voffB);
            PG8_BAR; PG8_WAIT_L(0); PG8_MMA(0, 1, At, B1); PG8_BAR;
            PG8_LDA(At, 0, 1); PG8_STAGE(PG8_SA(0, 0), a2, voffA);
            PG8_BAR; PG8_WAIT_L(0); PG8_MMA(1, 0, At, B0); PG8_BAR; PG8_SCHED;
            PG8_STAGE(PG8_SB(0, 1), b2 + hstep, voffB);
            PG8_WAIT_V(6); PG8_BAR; PG8_MMA(1, 1, At, B1); PG8_BAR;
            PG8_LDB(B0, 1, 0); PG8_SCHED; PG8_LDA(At, 1, 0); PG8_STAGE(PG8_SA(0, 1), a2 + hstep, voffA);
            PG8_WAIT_L(8); PG8_BAR; PG8_WAIT_L(0); PG8_MMA(0, 0, At, B0); PG8_BAR; PG8_SCHED;
            PG8_LDB(B1, 1, 1); PG8_STAGE(PG8_SB(1, 0), b3, voffB);
            PG8_BAR; PG8_WAIT_L(0); PG8_MMA(0, 1, At, B1); PG8_BAR;
            PG8_LDA(At, 1, 1); PG8_STAGE(PG8_SA(1, 0), a3, voffA);
            PG8_BAR; PG8_WAIT_L(0); PG8_MMA(1, 0, At, B0); PG8_BAR; PG8_SCHED;
            PG8_STAGE(PG8_SB(1, 1), b3 + hstep, voffB);
            PG8_WAIT_V(6); PG8_BAR; PG8_MMA(1, 1, At, B1); PG8_BAR;
            }
        }
        if constexpr (ALIGN_EPI) { if (wr == 0) PG8_BAR; }
        if constexpr (!Epi::AFTER_DRAIN) { E(acc, cur, wr, wc, fr, fq, ui & 1); S.done(cur); if constexpr (Epi::RSL) { if (has_next) E.rs_fetch(nxt, tid, (ui + 1) & 1); } }
        if (!has_next) break;
        { const float z = opaque_zero();
#pragma unroll
        for (int a = 0; a < 2; ++a)
#pragma unroll
            for (int b = 0; b < 2; ++b)
#pragma unroll
                for (int m = 0; m < 4; ++m)
#pragma unroll
                    for (int n = 0; n < 2; ++n) acc[a][b][m][n] = (f32x4){z, z, z, z}; }
        cur = nxt; cA = nA; cB = nB; ++ui;
        if constexpr (ALIGN_EPI) { if (wr == 1) PG8_BAR; }
    }
    PG8_WAIT_V(0);
    if constexpr (!ALIGN_EPI) { if (wr == 0) PG8_BAR; }
    PG8_BAR;
#undef PG8_SA
#undef PG8_SB
#undef PG8_STAGE
#undef PG8_LDA
#undef PG8_LDB
#undef PG8_MMA
#undef PG8_WAIT_V
#undef PG8_WAIT_L
#undef PG8_BAR
#undef PG8_SCHED
}
}

struct SEpiBf16 { bf16* O; int ldc; int act; const float* rstd;
    __device__ __forceinline__ void operator()(int row, int col, f32x4 s0, f32x4 s1) const {
        { const float r_ = rstd[row]; s0 = s0 * r_; s1 = s1 * r_; }
        if (act) {
#pragma unroll
            for (int j = 0; j < 4; ++j) { const float a = fmaxf(s0[j], 0.f), b = fmaxf(s1[j], 0.f); s0[j] = a * a; s1[j] = b * b; } }
        u32x4 w; w.x = cvtpk(s0[0], s0[1]); w.y = cvtpk(s0[2], s0[3]); w.z = cvtpk(s1[0], s1[1]); w.w = cvtpk(s1[2], s1[3]);
        *(u32x4*)(O + (size_t)row * ldc + col) = w; } };
struct SEpiResAdd { bf16* XB; float* Y; int ldc; bool fin;
    __device__ __forceinline__ void operator()(int row, int col, f32x4 s0, f32x4 s1) const {
        const size_t off = (size_t)row * ldc + col; const u32x4 w = *(const u32x4*)(XB + off);
        const f32x4 v0 = (f32x4){bflo(w.x) + s0[0], bfhi(w.x) + s0[1], bflo(w.y) + s0[2], bfhi(w.y) + s0[3]}, v1 = (f32x4){bflo(w.z) + s1[0], bfhi(w.z) + s1[1], bflo(w.w) + s1[2], bfhi(w.w) + s1[3]};
        if (fin) { *(f32x4*)(Y + off) = v0; *(f32x4*)(Y + off + 4) = v1; }
        else { u32x4 o; o.x = cvtpk(v0[0], v0[1]); o.y = cvtpk(v0[2], v0[3]); o.z = cvtpk(v1[0], v1[1]); o.w = cvtpk(v1[2], v1[3]); *(u32x4*)(XB + off) = o; } } };
template <class Epi>
__device__ __forceinline__ void sample_gemm(LAS unsigned char* lds, int wave, int vcu, int G, const bf16* __restrict__ A, const bf16* __restrict__ Bt, int N, int K, const Epi& E) {
    int ln_; asm volatile("v_mbcnt_lo_u32_b32 %0, -1, 0\n\tv_mbcnt_hi_u32_b32 %0, -1, %0" : "=v"(ln_)); const int tid = wave * 64 + ln_;
    const int lane = tid & 63, fr = lane & 15, fq = lane >> 4;
    const int ntiles = 4 * (N >> 6), kslice = K >> 3, kb = wave * kslice;
    LAS float* red = (LAS float*)lds;
    for (int t = vcu; t < ntiles; t += G) {
        const int rt = t & 3, ct = t >> 2;
        f32x4 acc[4][4];
        { const float z = opaque_zero();
#pragma unroll
          for (int m = 0; m < 4; ++m)
#pragma unroll
              for (int n = 0; n < 4; ++n) acc[m][n] = (f32x4){z, z, z, z}; }
        const bf16* ap = A + (size_t)(rt * 64 + fr) * K + kb + 8 * fq;
        const bf16* bp = Bt + (size_t)(ct * 64 + fr) * K + kb + 8 * fq;
        const size_t r16 = (size_t)16 * K;
#pragma unroll 4
        for (int k = 0; k < kslice; k += 64) {
            bf16x8 a0[4], a1[4], b0[4], b1[4];
#pragma unroll
            for (int m = 0; m < 4; ++m) { a0[m] = *(const bf16x8*)(ap + m * r16 + k); a1[m] = *(const bf16x8*)(ap + m * r16 + k + 32); }
#pragma unroll
            for (int n = 0; n < 4; ++n) { b0[n] = *(const bf16x8*)(bp + n * r16 + k); b1[n] = *(const bf16x8*)(bp + n * r16 + k + 32); }
#pragma unroll
            for (int m = 0; m < 4; ++m)
#pragma unroll
                for (int n = 0; n < 4; ++n) { acc[m][n] = __builtin_amdgcn_mfma_f32_16x16x32_bf16(a0[m], b0[n], acc[m][n], 0, 0, 0);
                                              acc[m][n] = __builtin_amdgcn_mfma_f32_16x16x32_bf16(a1[m], b1[n], acc[m][n], 0, 0, 0); }
        }
        __syncthreads();
#pragma unroll
        for (int m = 0; m < 4; ++m)
#pragma unroll
            for (int n = 0; n < 4; ++n)
#pragma unroll
                for (int j = 0; j < 4; ++j) red[wave * 4096 + (16 * m + 4 * fq + j) * 64 + 16 * n + fr] = acc[m][n][j];
        __syncthreads();
        const int row = tid >> 3, col = (tid & 7) * 8;
        f32x4 s0 = *(const LAS f32x4*)(red + row * 64 + col), s1 = *(const LAS f32x4*)(red + row * 64 + col + 4);
#pragma unroll
        for (int w = 1; w < 8; ++w) { s0 = s0 + *(const LAS f32x4*)(red + w * 4096 + row * 64 + col); s1 = s1 + *(const LAS f32x4*)(red + w * 4096 + row * 64 + col + 4); }
        E(rt * 64 + row, ct * 64 + col, s0, s1);
    }
    __syncthreads();
}

#define XB_TMO      128
#define XB_XCNT(j)  (256  + 64 * (j))
#define XB_XSUB(j)  (1280 + 64 * (j))
#define XB_XGEN(j)  (2304 + 64 * (j))
#define XB_TOP      3328
#define XB_TOPGEN   3392
#define XCD_BAR_WORDS 3456
#define XB_SPIN_CAP (1u << 18)
__device__ __forceinline__ unsigned xb_ld(unsigned* p)              { return __hip_atomic_load(p, __ATOMIC_RELAXED, __HIP_MEMORY_SCOPE_AGENT); }
__device__ __forceinline__ unsigned xb_add(unsigned* p, unsigned v) { return __hip_atomic_fetch_add(p, v, __ATOMIC_RELAXED, __HIP_MEMORY_SCOPE_AGENT); }
__device__ __forceinline__ unsigned xb_xcc_id() { return (unsigned)__builtin_amdgcn_s_getreg((3 << 11) | 20) & 0xFu; }
#define XB_SPIN(cond, bar) do { unsigned _sp = 0; while (cond) { __builtin_amdgcn_s_sleep(1); \
    if ((++_sp & 255u) == 0u) { if (xb_ld(&(bar)[XB_TMO])) break; if (_sp > XB_SPIN_CAP) { atomicAdd(&(bar)[XB_TMO], 1u); break; } } } } while (0)
struct XcdBarrier { unsigned* bar; unsigned x; volatile LAS unsigned* st; };
__device__ __forceinline__ XcdBarrier xcd_barrier_post(unsigned* bar, volatile LAS unsigned* st, bool leader) {
    XcdBarrier b; b.bar = bar; b.x = xb_xcc_id(); b.st = st;
    if (leader) (void)xb_add(&bar[XB_XCNT(b.x)], 1u);
    return b;
}
__device__ __forceinline__ void xcd_barrier_complete(unsigned* bar, unsigned x, unsigned& nloc, unsigned& nx) {
    const unsigned G = gridDim.x * gridDim.y * gridDim.z;
    unsigned sum, cnt, mine, sp = 0u;
    for (;;) {
        sum = 0u; cnt = 0u; mine = 0u;
#pragma unroll
        for (unsigned j = 0; j < 16; ++j) { const unsigned c = xb_ld(&bar[XB_XCNT(j)]); sum += c; cnt += (c > 0u) ? 1u : 0u; mine = (j == x) ? c : mine; }
        if (sum == G) break;
        __builtin_amdgcn_s_sleep(1);
        if ((++sp & 255u) == 0u) { if (xb_ld(&bar[XB_TMO])) break; if (sp > XB_SPIN_CAP) { atomicAdd(&bar[XB_TMO], 1u); break; } }
    }
    nloc = mine > 0u ? mine : 1u; nx = cnt > 0u ? cnt : 1u;
}
__device__ __noinline__ void xcd_barrier(unsigned* bar_, unsigned x_, volatile LAS unsigned* st_, int wave_) {
    XcdBarrier b; b.bar = bar_; b.x = x_; b.st = st_;
    int ln_; asm volatile("v_mbcnt_lo_u32_b32 %0, -1, 0\n\tv_mbcnt_hi_u32_b32 %0, -1, %0" : "=v"(ln_)); const bool leader_ = (wave_ == 0) && (ln_ == 0);
    asm volatile("s_waitcnt vmcnt(0)" ::: "memory");
    __syncthreads();
    if (leader_) {
        unsigned* bar = b.bar;
        __builtin_amdgcn_s_waitcnt(0);
        unsigned nloc = b.st[0], nx = b.st[1];
        if (nloc == 0u) { xcd_barrier_complete(bar, b.x, nloc, nx); b.st[0] = nloc; b.st[1] = nx; }
        const unsigned old = xb_add(&bar[XB_XSUB(b.x)], 1u);
        const unsigned gen = old / nloc;
        if (old + 1u == (gen + 1u) * nloc) {
            __builtin_amdgcn_fence(__ATOMIC_RELEASE, "agent");
            asm volatile("s_waitcnt vmcnt(0)" ::: "memory");
            const unsigned og = xb_add(&bar[XB_TOP], 1u);
            const unsigned tg = og / nx;
            if (og + 1u == (tg + 1u) * nx) xb_add(&bar[XB_TOPGEN], 1u);
            else XB_SPIN(xb_ld(&bar[XB_TOPGEN]) == tg, bar);
            __builtin_amdgcn_fence(__ATOMIC_ACQUIRE, "agent");
            xb_add(&bar[XB_XGEN(b.x)], 1u);
            asm volatile("s_waitcnt vmcnt(0)" ::: "memory");
        } else {
            XB_SPIN(xb_ld(&bar[XB_XGEN(b.x)]) == gen, bar);
            __builtin_amdgcn_fence(__ATOMIC_ACQUIRE, "agent");
            asm volatile("s_waitcnt vmcnt(0)" ::: "memory");
        }
    }
    __syncthreads();
}

#define KSWZ(row, colB) ((row) * 256 + ((colB) ^ (((row) & 7) << 4)))
__device__ __forceinline__ int crow(int r, int hi) { return (r & 3) + 8 * (r >> 2) + 4 * hi; }
__device__ __forceinline__ int v_st(int k, int c) { const int kk = (k & ~0xC) | ((k & 4) << 1) | ((k & 8) >> 1); return ((kk >> 3) * 4 + (c >> 5)) * 512 + ((kk & 7) * 32 + (c & 31)) * 2; }
__device__ __forceinline__ int v_rd_base(int lane) { return ((lane & 3) << 3) | (((lane >> 2) & 3) << 6) | (((lane >> 4) & 1) << 5) | (((lane >> 5) & 1) << 8); }
constexpr int v_rd_off(int d0, int ks, int half) { return d0 * 512 + ks * 4096 + half * 2048; }
template <int OFF> __device__ __forceinline__ s16x4 tr_read(int vb) {
    s16x4 r; asm volatile("ds_read_b64_tr_b16 %0, %1 offset:%2" : "=&v"(r) : "v"(vb), "i"(OFF) : "memory"); return r;
}
#define PKLH(L, H) (bf16x8){L[0], L[1], L[2], L[3], H[0], H[1], H[2], H[3]}
template <int D0> __device__ __forceinline__ void pv_one(f32x16& od, int vb, bf16x8 pa0, bf16x8 pa1, bf16x8 pa2, bf16x8 pa3) {
    const s16x4 l0 = tr_read<v_rd_off(D0, 0, 0)>(vb), h0 = tr_read<v_rd_off(D0, 0, 1)>(vb), l1 = tr_read<v_rd_off(D0, 1, 0)>(vb), h1 = tr_read<v_rd_off(D0, 1, 1)>(vb);
    const s16x4 l2 = tr_read<v_rd_off(D0, 2, 0)>(vb), h2 = tr_read<v_rd_off(D0, 2, 1)>(vb), l3 = tr_read<v_rd_off(D0, 3, 0)>(vb), h3 = tr_read<v_rd_off(D0, 3, 1)>(vb);
    asm volatile("s_waitcnt lgkmcnt(0)" ::: "memory"); SBAR();
    od = __builtin_amdgcn_mfma_f32_32x32x16_bf16(pa0, PKLH(l0, h0), od, 0, 0, 0);
    od = __builtin_amdgcn_mfma_f32_32x32x16_bf16(pa1, PKLH(l1, h1), od, 0, 0, 0);
    od = __builtin_amdgcn_mfma_f32_32x32x16_bf16(pa2, PKLH(l2, h2), od, 0, 0, 0);
    od = __builtin_amdgcn_mfma_f32_32x32x16_bf16(pa3, PKLH(l3, h3), od, 0, 0, 0);
}
__device__ __forceinline__ void pv_d0(f32x16* o, int vb, bf16x8 pa0, bf16x8 pa1, bf16x8 pa2, bf16x8 pa3) {
    pv_one<0>(o[0], vb, pa0, pa1, pa2, pa3); pv_one<1>(o[1], vb, pa0, pa1, pa2, pa3); pv_one<2>(o[2], vb, pa0, pa1, pa2, pa3); pv_one<3>(o[3], vb, pa0, pa1, pa2, pa3);
}
template <int D0, int KS> __device__ __forceinline__ bf16x8 tr_frag(int vb) {
    const s16x4 l = tr_read<v_rd_off(D0, KS, 0)>(vb), h = tr_read<v_rd_off(D0, KS, 1)>(vb);
    return PKLH(l, h);
}
__device__ __forceinline__ void qkt(f32x16& p0, f32x16& p1, int Ks  , const bf16x8* qr, int r32, int hi) {
    p0 = f32x16{}; p1 = f32x16{};
#pragma unroll
    for (int d0 = 0; d0 < 8; ++d0) { const int cb = (d0 * 16 + hi * 8) * 2;
        const bf16x8 b0 = *(const LAS bf16x8*)(uintptr_t)(unsigned)(Ks + KSWZ(r32, cb));
        const bf16x8 b1 = *(const LAS bf16x8*)(uintptr_t)(unsigned)(Ks + KSWZ(32 + r32, cb));
        p0 = __builtin_amdgcn_mfma_f32_32x32x16_bf16(b0, qr[d0], p0, 0, 0, 0);
        p1 = __builtin_amdgcn_mfma_f32_32x32x16_bf16(b1, qr[d0], p1, 0, 0, 0); }
}
#define PK4(P, BASE, OUT) do { unsigned a0 = cvtpk(P[BASE + 0], P[BASE + 1]), a1 = cvtpk(P[BASE + 2], P[BASE + 3]);   \
    unsigned b0 = cvtpk(P[BASE + 4], P[BASE + 5]), b1 = cvtpk(P[BASE + 6], P[BASE + 7]);                              \
    auto r0 = __builtin_amdgcn_permlane32_swap(a0, b0, false, false); auto r1 = __builtin_amdgcn_permlane32_swap(a1, b1, false, false); \
    u32x4 w = {r0[0], r1[0], r0[1], r1[1]}; OUT = *reinterpret_cast<bf16x8*>(&w); } while (0)
__device__ __forceinline__ float half_swap_add(float v) { auto rr = __builtin_amdgcn_permlane32_swap(__float_as_uint(v), __float_as_uint(v), false, false); return __uint_as_float(rr[0]) + __uint_as_float(rr[1]); }
__device__ __forceinline__ float half_swap_max(float v) { auto rr = __builtin_amdgcn_permlane32_swap(__float_as_uint(v), __float_as_uint(v), false, false); return fmaxf(__uint_as_float(rr[0]), __uint_as_float(rr[1])); }

struct Args {
    const float* x_prompt; const float* x_sample; const float* cache_k; const float* cache_v; const float* state_conv; const float* state_c; const float* state_n; const float* state_m;
    const float* norm_mix_g; const float* w_in; const float* conv_w; const float* q_norm_g; const float* k_norm_g; const float* rel_bias; const float* b_igate; const float* b_fgate;
    const float* mlstm_norm_g; const float* w_out; const float* norm_mlp_g; const float* w_up; const float* w_down;
    float* out; unsigned char* ws; int ph_lo, ph_hi, rep, pad;
};
struct Ctx {
    LAS unsigned char* lds; int tid, lane, wave, G, vcu;
};
constexpr int NPH_LAYER = 9, NPHASES = DEPTH * NPH_LAYER;
__device__ __forceinline__ int hw_tid(int wave) { int ln; asm volatile("v_mbcnt_lo_u32_b32 %0, -1, 0\n\tv_mbcnt_hi_u32_b32 %0, -1, %0" : "=v"(ln)); return wave * 64 + ln; }
__device__ __forceinline__ Ctx relaunder(const Ctx& c) { Ctx d = c; const int t = hw_tid(c.wave); d.tid = t; d.lane = t & 63; return d; }

__device__ __forceinline__ void transpose_item(const float* W, int K, int ldn, int nblk, bf16* WT, LAS float* scr, int item, int lane, const float* gain = nullptr) {
    const int kb = item / nblk, nb = item % nblk, k0 = 64 * kb, n0 = 32 * nb;
    const int c = lane & 7;
    f32x4 g0 = (f32x4){1.f, 1.f, 1.f, 1.f}, g1 = g0;
    if (gain) { g0 = *(const f32x4*)(gain + k0 + 8 * c); g1 = *(const f32x4*)(gain + k0 + 8 * c + 4); }
#pragma unroll 8
    for (int i = 0; i < 32; ++i) { const int kk = 2 * i + (lane >> 5); scr[kk * 33 + (lane & 31)] = W[(size_t)(k0 + kk) * ldn + n0 + (lane & 31)]; }
    LDS_WAIT(); asm volatile("" ::: "memory");
#pragma unroll
    for (int j = 0; j < 4; ++j) { const int n = (lane >> 3) + 8 * j; const LAS float* s = scr + (8 * c) * 33 + n;
        u32x4 o; o.x = cvtpk(s[0 * 33] * g0[0], s[1 * 33] * g0[1]); o.y = cvtpk(s[2 * 33] * g0[2], s[3 * 33] * g0[3]); o.z = cvtpk(s[4 * 33] * g1[0], s[5 * 33] * g1[1]); o.w = cvtpk(s[6 * 33] * g1[2], s[7 * 33] * g1[3]);
        *(GAS u32x4*)(WT + (size_t)(n0 + n) * K + k0 + 8 * c) = o; }
    LDS_WAIT(); asm volatile("" ::: "memory");
}
__device__ __forceinline__ void convert_weights(const Args& a, const Ctx& c, int l) {
    LAS float* scr = (LAS float*)(c.lds + c.wave * 16384);
    const int gw = c.vcu * NWAVES + c.wave, NGW = c.G * NWAVES;
    constexpr int I_IN = (D / 64) * (NPROJ / 32), I_OUT = (D / 64) * (D / 32), I_UP = (D / 64) * (FF / 32), I_DN = (FF / 64) * (D / 32), I_L = I_IN + I_OUT + I_UP + I_DN;
    for (int it = gw; it < I_L; it += NGW) {
        int r = it;
        if (r < I_IN) { transpose_item(a.w_in + (size_t)l * D * IN_DIM, D, IN_DIM, NPROJ / 32, (bf16*)(a.ws + WS_WIN), scr, r, c.lane, a.norm_mix_g + (size_t)l * D); continue; } r -= I_IN;
        if (r < I_OUT) { transpose_item(a.w_out + (size_t)l * D * D, D, D, D / 32, (bf16*)(a.ws + WS_WOUT), scr, r, c.lane); continue; } r -= I_OUT;
        if (r < I_UP) { transpose_item(a.w_up + (size_t)l * D * FF, D, FF, FF / 32, (bf16*)(a.ws + WS_WUP), scr, r, c.lane, a.norm_mlp_g + (size_t)l * D); continue; } r -= I_UP;
        transpose_item(a.w_down + (size_t)l * FF * D, FF, D, D / 32, (bf16*)(a.ws + WS_WDN), scr, r, c.lane);
    }
}

__device__ __forceinline__ void build_kv_image(const Args& a, int w, int nw, int tid, int l) {
    bf16* SK = (bf16*)(a.ws + WS_SK + (size_t)(l & 1) * SKV_IMG); bf16* SV = (bf16*)(a.ws + WS_SV + (size_t)(l & 1) * SKV_IMG);
    const unsigned gt = (unsigned)w * NTHREADS + tid, NT = (unsigned)nw * NTHREADS;
    constexpr unsigned NCH = (unsigned)SBATCH * 512 * 1024 / 8;
    for (unsigned i = gt; i < 2 * NCH; i += NT) {
        const bool isv = i >= NCH; const unsigned j = isv ? i - NCH : i; const unsigned e = j * 8; const unsigned b = e / (512 * 1024); const unsigned rem = e % (512 * 1024);
        const float* src = (isv ? a.cache_v : a.cache_k) + ((size_t)(l * SBATCH + b) * 512 * 1024) + rem;
        const f32x4 x0 = *(const f32x4*)src, x1 = *(const f32x4*)(src + 4);
        u32x4 w4; w4.x = cvtpk(x0.x, x0.y); w4.y = cvtpk(x0.z, x0.w); w4.z = cvtpk(x1.x, x1.y); w4.w = cvtpk(x1.z, x1.w);
        *(u32x4*)((isv ? SV : SK) + (size_t)b * SKV_ROWS * 1024 + rem) = w4;
    }
    constexpr unsigned NZ = (unsigned)SBATCH * (SKV_ROWS - 544) * 1024 / 8;
    for (unsigned i = gt; i < 2 * NZ; i += NT) {
        const bool isv = i >= NZ; const unsigned j = isv ? i - NZ : i; const unsigned e = j * 8; const unsigned b = e / ((SKV_ROWS - 544) * 1024); const unsigned rem = e % ((SKV_ROWS - 544) * 1024);
        { const unsigned z = __float_as_uint(opaque_zero()); *(u32x4*)((isv ? SV : SK) + ((size_t)b * SKV_ROWS + 544) * 1024 + rem) = (u32x4){z, z, z, z}; }
    }
}
__device__ __forceinline__ float log_sigmoid(float x) { return fminf(x, 0.f) - fast_log(1.0f + fast_exp(-fabsf(x))); }
template <bool FIRST  >
__device__ __forceinline__ void phase_norm(const Args& a, const Ctx& c_in0, int l) {
    const Ctx c = relaunder(c_in0);
    bf16* XB = (bf16*)(a.ws + WS_XB); bf16* H = (bf16*)(a.ws + WS_H);
    const float* g = (FIRST ? a.norm_mix_g : a.norm_mlp_g) + (size_t)l * D;
    LAS float* Wg = (LAS float*)c.lds;
    if (FIRST) {
        convert_weights(a, c, l);
        __syncthreads();
        const float* wsrc = a.w_in + (size_t)l * D * IN_DIM + NPROJ;
        for (int idx = c.tid; idx < 8 * D; idx += NTHREADS) { const int k = idx >> 3, o = idx & 7; Wg[o * D + k] = wsrc[(size_t)k * IN_DIM + o]; }
        __syncthreads();
    }
    const int gw = c.vcu * NWAVES + c.wave, NGW = c.G * NWAVES;
    f32x4 gv[8];
#pragma unroll
    for (int j = 0; j < 8; ++j) gv[j] = *(const f32x4*)(g + 4 * c.lane + 256 * j);
    for (int row = gw; row < MR; row += NGW) {
        f32x4 v[8]; float s = 0.f;
        if (FIRST && l == 0) {
            const float* src = row < MP ? a.x_prompt + (size_t)row * D : a.x_sample + (size_t)(row - MP) * D;
#pragma unroll
            for (int j = 0; j < 8; ++j) v[j] = *(const f32x4*)(src + 4 * c.lane + 256 * j);
#pragma unroll
            for (int j = 0; j < 8; ++j) { u32x2 w; w.x = cvtpk(v[j].x, v[j].y); w.y = cvtpk(v[j].z, v[j].w); *(u32x2*)(XB + (size_t)row * D + 4 * c.lane + 256 * j) = w; }
        } else {
            u32x2 w[8];
#pragma unroll
            for (int j = 0; j < 8; ++j) w[j] = *(const u32x2*)(XB + (size_t)row * D + 4 * c.lane + 256 * j);
#pragma unroll
            for (int j = 0; j < 8; ++j) v[j] = (f32x4){bflo(w[j].x), bfhi(w[j].x), bflo(w[j].y), bfhi(w[j].y)};
        }
#pragma unroll
        for (int j = 0; j < 8; ++j) s += (v[j].x * v[j].x + v[j].y * v[j].y) + (v[j].z * v[j].z + v[j].w * v[j].w);
        const float rstd = fast_rsqrt(wave_sum(s, c.lane) * (1.f / D) + EPS);
        if (c.lane == 0) ((float*)(a.ws + WS_RSTD))[row] = rstd;
        if (FIRST) {
#pragma unroll
            for (int j = 0; j < 8; ++j) v[j] = v[j] * rstd * gv[j];
            float ga[8];
#pragma unroll
            for (int o = 0; o < 8; ++o) { float t = 0.f;
#pragma unroll
                for (int j = 0; j < 8; ++j) { const f32x4 w4 = *(const LAS f32x4*)(Wg + o * D + 4 * c.lane + 256 * j); t += (v[j].x * w4.x + v[j].y * w4.y) + (v[j].z * w4.z + v[j].w * w4.w); }
                ga[o] = wave_sum(t, c.lane); }
            float val = ga[0];
#pragma unroll
            for (int o = 1; o < 8; ++o) val = (c.lane == o) ? ga[o] : val;
            if (c.lane < 8) {
                float r;
                if (c.lane < 4) r = val + a.b_igate[l * MH + c.lane];
                else r = log_sigmoid(val + a.b_fgate[l * MH + c.lane - 4]);
                ((float*)(a.ws + WS_GATE))[(size_t)row * 8 + c.lane] = r;
            }
        }
    }
    if (FIRST && l == 0) build_kv_image(a, c.vcu, c.G, c.tid, 0);
}

__device__ __forceinline__ float scan256_sum(float v, int tid, int lane, int wave, LAS float* tot  ) {
#pragma unroll
    for (int o = 1; o < 64; o <<= 1) { const float t = shup(v, o, lane); if (lane >= o) v += t; }
    if (lane == 63) tot[wave] = v;
    __syncthreads();
    float off = 0.f;
#pragma unroll
    for (int w = 0; w < 3; ++w) off += (w < wave) ? tot[w] : 0.f;
    __syncthreads();
    return v + off;
}
__device__ __forceinline__ float scan256_max(float v, int tid, int lane, int wave, LAS float* tot) {
#pragma unroll
    for (int o = 1; o < 64; o <<= 1) { const float t = shup(v, o, lane); if (lane >= o) v = fmaxf(v, t); }
    if (lane == 63) tot[wave] = v;
    __syncthreads();
    float off = -3.0e38f;
#pragma unroll
    for (int w = 0; w < 3; ++w) off = (w < wave) ? fmaxf(off, tot[w]) : off;
    __syncthreads();
    return fmaxf(v, off);
}

__device__ __forceinline__ void m1_unit(const Args& a, const Ctx& c_in, int l, int unit) {
    const int g = unit & 31, bh = unit >> 5, b = bh >> 2, h = bh & 3;
    const bf16* PROJ = (const bf16*)(a.ws + WS_BIG);
    const float* GATE = (const float*)(a.ws + WS_GATE);
    Ctx c = c_in; { int t_ = c.tid; asm volatile("" : "+v"(t_)); c.tid = t_; c.lane = t_ & 63; }
    LAS float* scr = (LAS float*)(c.lds + SCR_OFF);
    LAS float* W_S = scr;
    LAS float* NACC = scr + 256;
    LAS float* TOT = scr + 384;
    LAS float* SCAL = scr + 392;
    const int row0 = b * SEQ + g * 256;
    __syncthreads();
    float li = 0.f, lf = 0.f;
    if (c.tid < 256) { li = GATE[(size_t)(row0 + c.tid) * 8 + h]; lf = GATE[(size_t)(row0 + c.tid) * 8 + 4 + h]; }
    const float bc = scan256_sum(lf, c.tid, c.lane, c.wave, TOT);
    const float as = li - bc;
    const float am = scan256_max(c.tid < 256 ? as : -3.0e38f, c.tid, c.lane, c.wave, TOT);
    if (c.tid == 255) { SCAL[0] = am; SCAL[1] = bc; }
    __syncthreads();
    const float amax = SCAL[0], blast = SCAL[1];
    if (c.tid < 256) W_S[c.tid] = fast_exp(as - amax);
    __syncthreads();
    const int sr = c.tid >> 4, sc = (c.tid & 15) * 8;
#pragma unroll
    for (int t = 0; t < 4; ++t)
#pragma unroll
        for (int hh = 0; hh < 2; ++hh) {
            const int rr = t * 64 + hh * 32 + sr; const size_t ro = (size_t)(row0 + rr) * NPROJ;
            const u32x4 kq = *(const u32x4*)(PROJ + ro + C_MK + h * HD + sc);
            const u32x4 vq = *(const u32x4*)(PROJ + ro + C_MV + h * HD + sc);
            const float w = W_S[rr] * 0.08838834764831845f;
            float kf[8] = {bflo(kq.x) * w, bfhi(kq.x) * w, bflo(kq.y) * w, bfhi(kq.y) * w, bflo(kq.z) * w, bfhi(kq.z) * w, bflo(kq.w) * w, bfhi(kq.w) * w};
            u32x4 kw; kw.x = cvtpk(kf[0], kf[1]); kw.y = cvtpk(kf[2], kf[3]); kw.z = cvtpk(kf[4], kf[5]); kw.w = cvtpk(kf[6], kf[7]);
            *(LAS u32x4*)(c.lds + t * 16384 + v_st(hh * 32 + sr, sc)) = kw;
            *(LAS u32x4*)(c.lds + 65536 + t * 16384 + v_st(hh * 32 + sr, sc)) = vq;
        }
    __syncthreads();
    if (c.tid < 128) {
        float s = 0.f;
        for (int k = 0; k < 256; ++k) s += bf2f(*(const LAS bf16*)(c.lds + (k >> 6) * 16384 + v_st(k & 63, c.tid)));
        NACC[c.tid] = s;
    }
    __syncthreads();
    const int Da = c.wave >> 1, Db0 = 2 * (c.wave & 1);
    f32x16 acc0 = f32x16{}, acc1 = f32x16{};
    const int vbk = (int)(uintptr_t)(c.lds) + v_rd_base(c.lane) + Da * 512;
    const int vbv = (int)(uintptr_t)(c.lds) + 65536 + v_rd_base(c.lane) + Db0 * 512;
#pragma unroll
    for (int t = 0; t < 4; ++t) {
        const int ak = vbk + t * 16384, av = vbv + t * 16384;
        const bf16x8 a0 = tr_frag<0, 0>(ak), a1 = tr_frag<0, 1>(ak), a2 = tr_frag<0, 2>(ak), a3 = tr_frag<0, 3>(ak);
        const bf16x8 b00 = tr_frag<0, 0>(av), b01 = tr_frag<0, 1>(av), b02 = tr_frag<0, 2>(av), b03 = tr_frag<0, 3>(av);
        const bf16x8 b10 = tr_frag<1, 0>(av), b11 = tr_frag<1, 1>(av), b12 = tr_frag<1, 2>(av), b13 = tr_frag<1, 3>(av);
        asm volatile("s_waitcnt lgkmcnt(0)" ::: "memory"); SBAR();
        acc0 = __builtin_amdgcn_mfma_f32_32x32x16_bf16(a0, b00, acc0, 0, 0, 0); acc1 = __builtin_amdgcn_mfma_f32_32x32x16_bf16(a0, b10, acc1, 0, 0, 0);
        acc0 = __builtin_amdgcn_mfma_f32_32x32x16_bf16(a1, b01, acc0, 0, 0, 0); acc1 = __builtin_amdgcn_mfma_f32_32x32x16_bf16(a1, b11, acc1, 0, 0, 0);
        acc0 = __builtin_amdgcn_mfma_f32_32x32x16_bf16(a2, b02, acc0, 0, 0, 0); acc1 = __builtin_amdgcn_mfma_f32_32x32x16_bf16(a2, b12, acc1, 0, 0, 0);
        acc0 = __builtin_amdgcn_mfma_f32_32x32x16_bf16(a3, b03, acc0, 0, 0, 0); acc1 = __builtin_amdgcn_mfma_f32_32x32x16_bf16(a3, b13, acc1, 0, 0, 0);
    }
    float* CL = (float*)(a.ws + WS_CLOC) + (size_t)unit * HD * HD;
    const int r32 = c.lane & 31, hi = c.lane >> 5;
#pragma unroll
    for (int r = 0; r < 16; ++r) { const int d = 32 * Da + crow(r, hi);
        CL[(size_t)d * HD + 32 * Db0 + r32] = acc0[r]; CL[(size_t)d * HD + 32 * (Db0 + 1) + r32] = acc1[r]; }
    if (c.tid < 128) ((float*)(a.ws + WS_NLOC))[(size_t)unit * HD + c.tid] = NACC[c.tid];
    if (c.tid == 0) { float* ms = (float*)(a.ws + WS_MSC) + (size_t)unit * 4; ms[0] = blast + amax; ms[1] = blast; }
}

__device__ __forceinline__ void sample_mixers(const Args& a, const Ctx& c, int l);
template <bool WITH_QK>
__device__ __forceinline__ void phase_c(const Args& a, const Ctx& c_in0, int l) {
    const Ctx c = relaunder(c_in0);
    bf16* PROJ = (bf16*)(a.ws + WS_BIG); bf16* MIX = (bf16*)(a.ws + WS_H);
    constexpr int WSMP = SBATCH * NH + SBATCH * MH;
    const bool split = c.G > 2 * WSMP;
    if (WITH_QK && (!split || c.vcu < WSMP)) sample_mixers(a, c, l);
    for (int u = c.vcu; u < 16 * NGRP; u += c.G) m1_unit(a, c, l, u);
    const int gw = c.vcu * NWAVES + c.wave, NGW = c.G * NWAVES;
    if (WITH_QK) {
        const float* gq = a.q_norm_g + l * HD; const float* gk = a.k_norm_g + l * HD;
        const int gi = (16 * c.lane) & 127;
        f32x4 gqv[4], gkv[4];
#pragma unroll
        for (int j = 0; j < 4; ++j) { gqv[j] = *(const f32x4*)(gq + gi + 4 * j); gkv[j] = *(const f32x4*)(gk + gi + 4 * j); }
        bf16* SK = (bf16*)(a.ws + WS_SK + (size_t)(l & 1) * SKV_IMG); bf16* SV = (bf16*)(a.ws + WS_SV + (size_t)(l & 1) * SKV_IMG);
        constexpr int NIT = NB * KEEP;
        for (int it = gw; it < NIT; it += NGW) {
            const int row = (it / KEEP) * SEQ + (SEQ - KEEP) + (it % KEEP);
            const bf16* p = PROJ + (size_t)row * NPROJ + C_K + 16 * c.lane;
            const u32x4 w0 = *(const u32x4*)p, w1 = *(const u32x4*)(p + 8);
            const bf16* pv = PROJ + (size_t)row * NPROJ + C_V + 16 * c.lane;
            const u32x4 v0 = *(const u32x4*)pv, v1 = *(const u32x4*)(pv + 8);
            const int b = row / SEQ, t = row % SEQ; const size_t o = ((size_t)(l * NB + b) * KEEP + (t - (SEQ - KEEP))) * 1024 + 16 * c.lane;
            float* ok = a.out + O_PK + o; float* ov = a.out + O_PV + o;
            *(f32x4*)(ok + 0) = (f32x4){bflo(w0.x), bfhi(w0.x), bflo(w0.y), bfhi(w0.y)}; *(f32x4*)(ok + 4) = (f32x4){bflo(w0.z), bfhi(w0.z), bflo(w0.w), bfhi(w0.w)};
            *(f32x4*)(ok + 8) = (f32x4){bflo(w1.x), bfhi(w1.x), bflo(w1.y), bfhi(w1.y)}; *(f32x4*)(ok + 12) = (f32x4){bflo(w1.z), bfhi(w1.z), bflo(w1.w), bfhi(w1.w)};
            *(f32x4*)(ov + 0) = (f32x4){bflo(v0.x), bfhi(v0.x), bflo(v0.y), bfhi(v0.y)}; *(f32x4*)(ov + 4) = (f32x4){bflo(v0.z), bfhi(v0.z), bflo(v0.w), bfhi(v0.w)};
            *(f32x4*)(ov + 8) = (f32x4){bflo(v1.x), bfhi(v1.x), bflo(v1.y), bfhi(v1.y)}; *(f32x4*)(ov + 12) = (f32x4){bflo(v1.z), bfhi(v1.z), bflo(v1.w), bfhi(v1.w)};
        }
    }
    {
        const int ch = 8 * c.lane;
        float w0[8], w1[8], w2[8];
#pragma unroll
        for (int i = 0; i < 8; ++i) { w0[i] = a.conv_w[(size_t)(l * 3 + 0) * 512 + ch + i]; w1[i] = a.conv_w[(size_t)(l * 3 + 1) * 512 + ch + i]; w2[i] = a.conv_w[(size_t)(l * 3 + 2) * 512 + ch + i]; }
        constexpr int NSEG = SEQ / 32, NITEM = NB * NSEG + SBATCH;
        const int gwc = split ? (c.vcu - WSMP) * NWAVES + c.wave : gw, NGWc = split ? (c.G - WSMP) * NWAVES : NGW;
        for (int it = gwc; it >= 0 && it < NITEM; it += NGWc) {
            float u2[8], u1[8]; int rowb; bool samp = it >= NB * NSEG; int b, seg = 0;
            if (!samp) { b = it / NSEG; seg = it % NSEG; rowb = b * SEQ + seg * 32; } else { b = it - NB * NSEG; rowb = MP + b * SSEQ; }
#pragma unroll
            for (int i = 0; i < 8; ++i) { u2[i] = 0.f; u1[i] = 0.f; }
            if (samp) {
#pragma unroll
                for (int i = 0; i < 8; ++i) { u2[i] = a.state_conv[((size_t)(l * SBATCH + b) * 2 + 0) * 512 + ch + i]; u1[i] = a.state_conv[((size_t)(l * SBATCH + b) * 2 + 1) * 512 + ch + i]; }
            } else if (seg > 0) {
#pragma unroll
                for (int q = 0; q < 2; ++q) { const bf16* pr = PROJ + (size_t)(rowb - 2 + q) * NPROJ + ch;
                    const u32x4 xa = *(const u32x4*)(pr + C_XA), gc = *(const u32x4*)(pr + C_GC);
                    float* dst = q ? u1 : u2;
                    dst[0] = bflo(xa.x) * bflo(gc.x); dst[1] = bfhi(xa.x) * bfhi(gc.x); dst[2] = bflo(xa.y) * bflo(gc.y); dst[3] = bfhi(xa.y) * bfhi(gc.y);
                    dst[4] = bflo(xa.z) * bflo(gc.z); dst[5] = bfhi(xa.z) * bfhi(gc.z); dst[6] = bflo(xa.w) * bflo(gc.w); dst[7] = bfhi(xa.w) * bfhi(gc.w); }
            }
            for (int t0 = 0; t0 < 32; t0 += 4) {
                u32x4 xa4[4], gb4[4], gc4[4];
#pragma unroll
                for (int q = 0; q < 4; ++q) { const bf16* pr = PROJ + (size_t)(rowb + t0 + q) * NPROJ + ch; xa4[q] = *(const u32x4*)(pr + C_XA); gb4[q] = *(const u32x4*)(pr + C_GB); gc4[q] = *(const u32x4*)(pr + C_GC); }
#pragma unroll
                for (int q = 0; q < 4; ++q) { const int t = t0 + q;
                const u32x4 xa = xa4[q], gb = gb4[q], gc = gc4[q];
                float u0[8] = {bflo(xa.x) * bflo(gc.x), bfhi(xa.x) * bfhi(gc.x), bflo(xa.y) * bflo(gc.y), bfhi(xa.y) * bfhi(gc.y),
                               bflo(xa.z) * bflo(gc.z), bfhi(xa.z) * bfhi(gc.z), bflo(xa.w) * bflo(gc.w), bfhi(xa.w) * bfhi(gc.w)};
                float gbf[8] = {bflo(gb.x), bfhi(gb.x), bflo(gb.y), bfhi(gb.y), bflo(gb.z), bfhi(gb.z), bflo(gb.w), bfhi(gb.w)};
                float y[8];
#pragma unroll
                for (int i = 0; i < 8; ++i) { y[i] = gbf[i] * (w0[i] * u2[i] + w1[i] * u1[i] + w2[i] * u0[i]); u2[i] = u1[i]; u1[i] = u0[i]; }
                u32x4 o; o.x = cvtpk(y[0], y[1]); o.y = cvtpk(y[2], y[3]); o.z = cvtpk(y[4], y[5]); o.w = cvtpk(y[6], y[7]);
                *(u32x4*)(MIX + (size_t)(rowb + t) * D + ch) = o;
                }
            }
            float* oc = nullptr;
            if (samp) oc = a.out + O_SCONV + (size_t)(l * SBATCH + b) * 2 * 512 + ch;
            else if (seg == NSEG - 1) oc = a.out + O_PCONV + (size_t)(l * NB + b) * 2 * 512 + ch;
            if (oc) {
                *(f32x4*)(oc) = (f32x4){u2[0], u2[1], u2[2], u2[3]}; *(f32x4*)(oc + 4) = (f32x4){u2[4], u2[5], u2[6], u2[7]};
                *(f32x4*)(oc + 512) = (f32x4){u1[0], u1[1], u1[2], u1[3]}; *(f32x4*)(oc + 516) = (f32x4){u1[4], u1[5], u1[6], u1[7]};
            }
        }
    }
}

__device__ __forceinline__ void phase_d(const Args& a, const Ctx& c_in0, int l) {
    const Ctx c = relaunder(c_in0);
    const float* CL = (const float*)(a.ws + WS_CLOC); const float* NL = (const float*)(a.ws + WS_NLOC); float* MSC = (float*)(a.ws + WS_MSC);
    bf16* C0 = (bf16*)(a.ws + WS_C0); float* N0 = (float*)(a.ws + WS_N0);
    LAS float* DEC = (LAS float*)(c.lds + SCR_OFF);
    LAS float* WLO = DEC + 512;
    LAS float* MFIN = WLO + 512;
    LAS float* MLO = MFIN + 16;
    LAS float* BLA = MLO + 512;
    __syncthreads();
    { const int u = c.tid; MLO[u] = MSC[(size_t)u * 4 + 0]; BLA[u] = MSC[(size_t)u * 4 + 1]; }
    __syncthreads();
    if (c.tid < 16) { const int bh = c.tid; float m = 0.f;
        for (int g = 0; g < NGRP; ++g) { const size_t u = (size_t)bh * NGRP + g; const float mloc = MLO[u], blast = BLA[u];
            const float mn = fmaxf(blast + m, mloc); DEC[bh * NGRP + g] = fast_exp(blast + m - mn); WLO[bh * NGRP + g] = fast_exp(mloc - mn);
            if (c.vcu == 0) MSC[u * 4 + 2] = m;
            m = mn; }
        MFIN[bh] = m; }
    __syncthreads();
    const unsigned gt = (unsigned)c.vcu * NTHREADS + c.tid, NT = (unsigned)c.G * NTHREADS;
    constexpr unsigned PER = (unsigned)HD * HD + HD;
    for (unsigned i = gt; i < 16u * PER; i += NT) {
        const int bh = (int)(i / PER); const int e = (int)(i % PER); const bool isn = e >= HD * HD; const int en = e - HD * HD;
        const float* src = isn ? NL + (size_t)bh * NGRP * HD + en : CL + (size_t)bh * NGRP * HD * HD + e;
        const size_t sstep = isn ? HD : (size_t)HD * HD;
        float x[NGRP];
#pragma unroll
        for (int g = 0; g < NGRP; ++g) x[g] = src[(size_t)g * sstep];
        float C = 0.f;
#pragma unroll
        for (int g = 0; g < NGRP; ++g) {
            const size_t u = (size_t)bh * NGRP + g;
            if (isn) N0[u * HD + en] = C; else C0[u * HD * HD + e] = (bf16)(cvtpk(C, 0.f) & 0xffffu);
            C = DEC[bh * NGRP + g] * C + WLO[bh * NGRP + g] * x[g];
        }
        const int b = bh >> 2, h = bh & 3;
        if (isn) a.out[O_PN + ((size_t)(l * NB + b) * MH + h) * HD + en] = C;
        else a.out[O_PC + ((size_t)(l * NB + b) * MH + h) * HD * HD + e] = C;
        if (e == 0) a.out[O_PM + (size_t)(l * NB + b) * MH + h] = MFIN[bh];
    }
}

constexpr float ATT_C = 0.088388347648318440f * LOG2E;
constexpr float THR2 = 8.f * LOG2E;
struct DmaMap { unsigned k0, k1, v0, v1; };
__device__ __forceinline__ DmaMap dma_map(int lane, int wave, int LD) {
    DmaMap m; unsigned kk_[2], vv_[2];
#pragma unroll
    for (int i = 0; i < 2; ++i) { const int o = (wave + 8 * i) * 1024 + lane * 16;
        const int row = o >> 8, c16 = ((o >> 4) & 15) ^ (row & 7); kk_[i] = (unsigned)(row * LD + c16 * 8) * 2u;
        const int sub = o >> 9, kk = ((sub >> 2) << 3) | ((o >> 6) & 7), k = (kk & ~0xC) | ((kk & 4) << 1) | ((kk & 8) >> 1), cc = ((sub & 3) << 5) | ((o & 63) >> 1); vv_[i] = (unsigned)(k * LD + cc) * 2u; }
    m.k0 = kk_[0]; m.k1 = kk_[1]; m.v0 = vv_[0]; m.v1 = vv_[1]; return m;
}
__device__ __forceinline__ void glds16s(const void* sbase, unsigned voff, unsigned lds_dst) { unsigned keep;
    asm volatile("s_mov_b32 %0, m0\n\ts_mov_b32 m0, %3\n\ts_nop 0\n\tglobal_load_lds_dwordx4 %1, %2\n\ts_mov_b32 m0, %0" : "=&s"(keep) : "v"(voff), "s"(sbase), "s"(lds_dst) : "memory"); }
__device__ __forceinline__ void dma_fill(LAS unsigned char* lds, int slot, int wave, const bf16* Ta, unsigned a0, unsigned a1, const bf16* Tb, unsigned b0, unsigned b1) {
    const unsigned d = (unsigned)(uintptr_t)lds + (unsigned)(slot * 32768 + wave * 1024);
    glds16s(Ta, a0, d); glds16s(Ta, a1, d + 8192u); glds16s(Tb, b0, d + 16384u); glds16s(Tb, b1, d + 24576u);
}
#define RING_WAIT_BAR(N) do { asm volatile("s_waitcnt vmcnt(" #N ") lgkmcnt(0)" ::: "memory"); __builtin_amdgcn_s_barrier(); asm volatile("" ::: "memory"); } while (0)

#define ATT_SCORE_SOFTMAX(j, slotk)                                                                                                           \
    {   const int K_lds = ldsb + (slotk) * 16384;                                                                                              \
        f32x16 p0, p1; qkt(p0, p1, K_lds, qr, r32, hi);                                                                                       \
        const int Rl = R0 + r32 - 64 * (j);                                                                                                   \
        const int relmin = R0 - 64 * (j) - 63;                                                                                                \
        if (relmin >= 128) { const float bc = BR[0];                                                                                           \
            _Pragma("unroll") for (int r = 0; r < 16; ++r) { p0[r] = fmaf(p0[r], ATT_C, bc); p1[r] = fmaf(p1[r], ATT_C, bc); }                \
        } else {                                                                                                                               \
            const LAS float* bp = BR + (64 + 128 - Rl + 4 * hi);                                                                               \
            _Pragma("unroll") for (int r = 0; r < 16; ++r) { p0[r] = fmaf(p0[r], ATT_C, bp[(r & 3) + 8 * (r >> 2)]); p1[r] = fmaf(p1[r], ATT_C, bp[32 + (r & 3) + 8 * (r >> 2)]); } \
        }                                                                                                                                      \
        const int nvalid = kend - 64 * (j);                                                                                                    \
        if (nvalid < 64) {                                                                                                                     \
            _Pragma("unroll") for (int r = 0; r < 16; ++r) { const int kk = crow(r, hi); if (kk >= nvalid) p0[r] = -1e30f; if (kk + 32 >= nvalid) p1[r] = -1e30f; } \
        }                                                                                                                                      \
        float pmax = p0[0];                                                                                                                    \
        _Pragma("unroll") for (int r = 1; r < 16; ++r) pmax = fmaxf(pmax, p0[r]);                                                              \
        _Pragma("unroll") for (int r = 0; r < 16; ++r) pmax = fmaxf(pmax, p1[r]);                                                              \
        pmax = half_swap_max(pmax);                                                                                                            \
        if (!__all(pmax - m_reg <= THR2)) {                                                                                                    \
            const float mn = fmaxf(m_reg, pmax); const float alpha = __builtin_amdgcn_exp2f(m_reg - mn); m_reg = mn;                           \
            l_reg *= alpha;                                                                                                                    \
            if (hi == 0) al_l[r32] = alpha; asm volatile("s_waitcnt lgkmcnt(0)" ::: "memory");                                               \
            _Pragma("unroll") for (int r = 0; r < 16; ++r) { const float al = al_l[crow(r, hi)];                                               \
                _Pragma("unroll") for (int d = 0; d < 4; ++d) o[d][r] *= al; }                                                                 \
        }                                                                                                                                      \
        float ps = 0.f;                                                                                                                        \
        _Pragma("unroll") for (int r = 0; r < 16; ++r) { p0[r] = __builtin_amdgcn_exp2f(p0[r] - m_reg); p1[r] = __builtin_amdgcn_exp2f(p1[r] - m_reg); ps += p0[r] + p1[r]; } \
        l_reg += half_swap_add(ps);                                                                                                            \
        PK4(p0, 0, pa0); PK4(p0, 8, pa1); PK4(p1, 0, pa2); PK4(p1, 8, pa3);                                                                    \
    }
__device__ __forceinline__ void attn_unit(const Ctx& c, const bf16* __restrict__ Qb, int LDQ, int qrow, const bf16* __restrict__ Kh, const bf16* __restrict__ Vh, int LDK, int NT, int alo, int ahi, int kend,
                                          int R0  , const float* __restrict__ bias_g, bf16* __restrict__ Ob, int LDO, bool do_store, const float* __restrict__ qgain = nullptr) {
    int tid = c.tid; asm volatile("" : "+v"(tid));
    const int wid = c.wave, lane = tid & 63, r32 = lane & 31, hi = lane >> 5;
    const int ldsb = (int)(uintptr_t)c.lds;
    constexpr int VRING = 49152;
    LAS float* wsf = (LAS float*)(c.lds + 114688) + wid * 64; LAS float* li_l = wsf; LAS float* al_l = wsf + 32;
    LAS float* BR = (LAS float*)(c.lds + SCR_OFF);
    asm volatile("s_waitcnt vmcnt(0) lgkmcnt(0)" ::: "memory"); __builtin_amdgcn_s_barrier(); asm volatile("" ::: "memory");
    if (tid < 321) { const int i = tid - 64; BR[tid] = bias_g[256 - (i < 0 ? 0 : i)] * LOG2E; }
    const DmaMap dm = dma_map(lane, wid, LDK);
    const size_t tile_step = (size_t)64 * LDK;
    float m_reg = -1e30f, l_reg = 0.f; f32x16 o[4] = {f32x16{}, f32x16{}, f32x16{}, f32x16{}}; bf16x8 qr[8];
    { const bf16* Qw = Qb + (size_t)(qrow + r32) * LDQ + hi * 8;
#pragma unroll
      for (int d0 = 0; d0 < 8; ++d0) qr[d0] = *(const bf16x8*)(Qw + d0 * 16); }
    if (qgain) {
        float f[8][8]; float ss = 0.f;
#pragma unroll
        for (int d0 = 0; d0 < 8; ++d0) { const u32x4 w = *reinterpret_cast<const u32x4*>(&qr[d0]);
            f[d0][0] = bflo(w.x); f[d0][1] = bfhi(w.x); f[d0][2] = bflo(w.y); f[d0][3] = bfhi(w.y); f[d0][4] = bflo(w.z); f[d0][5] = bfhi(w.z); f[d0][6] = bflo(w.w); f[d0][7] = bfhi(w.w);
#pragma unroll
            for (int i = 0; i < 8; ++i) ss += f[d0][i] * f[d0][i]; }
        ss = half_swap_add(ss);
        const float rq = fast_rsqrt(ss * (1.f / HD) + EPS);
#pragma unroll
        for (int d0 = 0; d0 < 8; ++d0) { const f32x4 g0 = *(const f32x4*)(qgain + d0 * 16 + hi * 8), g1 = *(const f32x4*)(qgain + d0 * 16 + hi * 8 + 4);
            u32x4 s; s.x = cvtpk(f[d0][0] * rq * g0[0], f[d0][1] * rq * g0[1]); s.y = cvtpk(f[d0][2] * rq * g0[2], f[d0][3] * rq * g0[3]);
            s.z = cvtpk(f[d0][4] * rq * g1[0], f[d0][5] * rq * g1[1]); s.w = cvtpk(f[d0][6] * rq * g1[2], f[d0][7] * rq * g1[3]);
            qr[d0] = *reinterpret_cast<bf16x8*>(&s); }
    }
    asm volatile("" ::: "memory");
    const unsigned dbase = (unsigned)ldsb + (unsigned)wid * 1024u;
#define ATT_FILL(kt_, vt_, sk_, sv_) do { const unsigned dk_ = dbase + (unsigned)(sk_) * 16384u, dv_ = dbase + VRING + (unsigned)(sv_) * 16384u; \
        glds16s(kt_, dm.k0, dk_); glds16s(kt_, dm.k1, dk_ + 8192u); glds16s(vt_, dm.v0, dv_); glds16s(vt_, dm.v1, dv_ + 8192u); } while (0)
    ATT_FILL(Kh, Vh, 0, 0);
    ATT_FILL(Kh + tile_step, Vh + tile_step, 1, 1);
    const bf16* kt = Kh + 2 * tile_step; const bf16* vt = Vh + 2 * tile_step;
    const bool skew = wid >= 4;
    bf16x8 pa0 = bf16x8{}, pa1 = bf16x8{}, pa2 = bf16x8{}, pa3 = bf16x8{};
    int sk = 0, sv = 0;
    for (int j = 0; j < NT; ++j) {
        if (j + 1 < NT) RING_WAIT_BAR(4); else RING_WAIT_BAR(0);
        if (j + 2 < NT) { const int fk = sk >= 1 ? sk - 1 : 2, fv = sv >= 2 ? sv - 2 : sv + 2; ATT_FILL(kt, vt, fk, fv); kt += tile_step; vt += tile_step; }
        const bool act = (j >= alo && j <= ahi);
        if (skew && (j - 1 >= alo && j - 1 <= ahi)) { const int svp = sv >= 1 ? sv - 1 : 3; pv_d0(o, ldsb + VRING + svp * 16384 + v_rd_base(lane), pa0, pa1, pa2, pa3); }
        if (act) { ATT_SCORE_SOFTMAX(j, sk); }
        if (!skew && act) pv_d0(o, ldsb + VRING + sv * 16384 + v_rd_base(lane), pa0, pa1, pa2, pa3);
        sk = sk == 2 ? 0 : sk + 1; sv = (sv + 1) & 3;
    }
    if (skew && (NT - 1 >= alo && NT - 1 <= ahi)) { const int svp = sv >= 1 ? sv - 1 : 3; pv_d0(o, ldsb + VRING + svp * 16384 + v_rd_base(lane), pa0, pa1, pa2, pa3); }
#undef ATT_FILL
    if (hi == 0) li_l[r32] = l_reg;
    RING_WAIT_BAR(0);
    const int ost = ldsb + wid * 8192;
#pragma unroll
    for (int r = 0; r < 16; ++r) { const int orow = crow(r, hi); const float rl = __builtin_amdgcn_rcpf(li_l[orow]);
#pragma unroll
        for (int d0 = 0; d0 < 4; ++d0) *(LAS bf16*)(uintptr_t)(unsigned)(ost + orow * 256 + (d0 * 32 + r32) * 2) = (bf16)(cvtpk(o[d0][r] * rl, 0.f) & 0xffffu); }
    asm volatile("s_waitcnt lgkmcnt(0)" ::: "memory");
    if (do_store) {
#pragma unroll
        for (int i = 0; i < 8; ++i) { const int ch = i * 64 + lane, row = ch >> 4, c16 = ch & 15;
            const u32x4 w = *(const LAS u32x4*)(uintptr_t)(unsigned)(ost + row * 256 + c16 * 16);
            *(u32x4*)(Ob + (size_t)(qrow + row) * LDO + c16 * 8) = w; }
    }
}
#undef ATT_SCORE_SOFTMAX

__device__ __forceinline__ void m3_unit(const Args& a, const Ctx& c, int l, int unit) {
    const int g = unit & 31, bh = unit >> 5, b = bh >> 2, h = bh & 3;
    const bf16* PROJ = (const bf16*)(a.ws + WS_BIG); bf16* MIX = (bf16*)(a.ws + WS_H);
    const float* GATE = (const float*)(a.ws + WS_GATE);
    int tid = c.tid; asm volatile("" : "+v"(tid));
    const int wid = c.wave, lane = tid & 63, r32 = lane & 31, hi = lane >> 5;
    LAS float* scr = (LAS float*)(c.lds + SCR_OFF);
    LAS float* A_S = scr;
    LAS float* M_T = scr + 256;
    LAS float* B_T = scr + 512;
    LAS float* N0L = scr + 768;
    LAS float* TOT = scr + 896;
    const int ldsb = (int)(uintptr_t)c.lds;
    LAS float* wsf = (LAS float*)(c.lds + 98304) + wid * 64;
    const int row0 = b * SEQ + g * 256;
    const float m0 = ((const float*)(a.ws + WS_MSC))[(size_t)unit * 4 + 2];
    asm volatile("s_waitcnt vmcnt(0) lgkmcnt(0)" ::: "memory"); __builtin_amdgcn_s_barrier(); asm volatile("" ::: "memory");
    const DmaMap dm = dma_map(lane, wid, NPROJ); const DmaMap dc = dma_map(lane, wid, HD);
    const bf16* kt = PROJ + (size_t)row0 * NPROJ + C_MK + h * HD; const bf16* vt = PROJ + (size_t)row0 * NPROJ + C_MV + h * HD;
    const bf16* C0 = (const bf16*)(a.ws + WS_C0) + (size_t)unit * HD * HD;
    const size_t tile_step = (size_t)64 * NPROJ;
    dma_fill(c.lds, 0, wid, kt, dm.k0, dm.k1, vt, dm.v0, dm.v1);
    dma_fill(c.lds, 1, wid, kt + tile_step, dm.k0, dm.k1, vt + tile_step, dm.v0, dm.v1);
    float li = 0.f, lf = 0.f;
    if (tid < 256) { li = GATE[(size_t)(row0 + tid) * 8 + h]; lf = GATE[(size_t)(row0 + tid) * 8 + 4 + h]; }
    if (tid < 128) N0L[tid] = ((const float*)(a.ws + WS_N0))[(size_t)unit * HD + tid];
    const float bc = scan256_sum(lf, tid, lane, wid, TOT);
    const float as = li - bc;
    const float cm = scan256_max(tid < 256 ? as : -3.0e38f, tid, lane, wid, TOT);
    if (tid < 256) { A_S[tid] = as; M_T[tid] = fmaxf(m0, cm); B_T[tid] = bc; }
    bf16x8 qr[8];
    const int trow = wid * 32 + r32;
    { const bf16* Qw = PROJ + (size_t)(row0 + trow) * NPROJ + C_MQ + h * HD + hi * 8;
#pragma unroll
      for (int d0 = 0; d0 < 8; ++d0) qr[d0] = *(const bf16x8*)(Qw + d0 * 16); }
    __syncthreads();
    const float Mt = M_T[trow];
    f32x16 o[4] = {f32x16{}, f32x16{}, f32x16{}, f32x16{}};
    float rowsum = 0.f, qn = 0.f;
    const float winter = fast_exp(m0 - Mt);
    const int ci = wid >> 1;
    int slot = 0;
#pragma unroll 1
    for (int j = 0; j < 4; ++j) {
        RING_WAIT_BAR(4);
        { const int fs = slot >= 1 ? slot - 1 : 2;
          if (j + 2 < 4) dma_fill(c.lds, fs, wid, kt + (size_t)(j + 2) * tile_step, dm.k0, dm.k1, vt + (size_t)(j + 2) * tile_step, dm.v0, dm.v1);
          else if (j == 2) dma_fill(c.lds, fs, wid, C0, dc.v0, dc.v1, C0 + 64 * HD, dc.v0, dc.v1); }
        const int S_lds = ldsb + slot * 32768;
        int r32l = r32; asm volatile("" : "+v"(r32l));
        if (j <= ci) {
            f32x16 p0, p1; qkt(p0, p1, S_lds, qr, r32l, hi);
#pragma unroll
            for (int r = 0; r < 16; ++r) { const int s0 = 64 * j + crow(r, hi), s1 = s0 + 32;
                const float w0 = (s0 <= trow) ? fast_exp(A_S[s0] - Mt) * 0.08838834764831845f : 0.f, w1 = (s1 <= trow) ? fast_exp(A_S[s1] - Mt) * 0.08838834764831845f : 0.f;
                p0[r] *= w0; p1[r] *= w1; rowsum += p0[r] + p1[r]; }
            bf16x8 pa0, pa1, pa2, pa3;
            PK4(p0, 0, pa0); PK4(p0, 8, pa1); PK4(p1, 0, pa2); PK4(p1, 8, pa3);
            pv_d0(o, S_lds + 16384 + v_rd_base(lane), pa0, pa1, pa2, pa3);
        }
        slot = slot == 2 ? 0 : slot + 1;
    }
    RING_WAIT_BAR(0);
    {
        const int S_lds = ldsb + slot * 32768;
#pragma unroll
        for (int hf = 0; hf < 2; ++hf) {
            bf16x8 qs[4];
#pragma unroll
            for (int dd = 0; dd < 4; ++dd) { const int d0 = hf * 4 + dd; const u32x4 w = *reinterpret_cast<const u32x4*>(&qr[d0]);
                float f[8] = {bflo(w.x), bfhi(w.x), bflo(w.y), bfhi(w.y), bflo(w.z), bfhi(w.z), bflo(w.w), bfhi(w.w)};
#pragma unroll
                for (int i = 0; i < 8; ++i) qn += f[i] * N0L[d0 * 16 + hi * 8 + i];
                u32x4 s; s.x = cvtpk(f[0] * winter, f[1] * winter); s.y = cvtpk(f[2] * winter, f[3] * winter); s.z = cvtpk(f[4] * winter, f[5] * winter); s.w = cvtpk(f[6] * winter, f[7] * winter);
                qs[dd] = *reinterpret_cast<bf16x8*>(&s); }
            pv_d0(o, S_lds + hf * 16384 + v_rd_base(lane), qs[0], qs[1], qs[2], qs[3]);
        }
    }
    rowsum = half_swap_add(rowsum);
    qn = half_swap_add(qn);
    const float den = winter * qn + rowsum;
    const float dfl = fast_exp(-(B_T[trow] + Mt));
    const float inv = 1.0f / fmaxf(fabsf(den), dfl);
    if (hi == 0) wsf[r32] = inv;
    asm volatile("s_waitcnt lgkmcnt(0)" ::: "memory");
#pragma unroll
    for (int r = 0; r < 16; ++r) { const float sc_ = wsf[crow(r, hi)];
#pragma unroll
        for (int d0 = 0; d0 < 4; ++d0) o[d0][r] *= sc_; }
    RING_WAIT_BAR(0);
    const int hst = ldsb + wid * 16384;
    { int le = lane; asm volatile("" : "+v"(le)); const int r32e = le & 31, hie = le >> 5;
#pragma unroll
    for (int r = 0; r < 16; ++r)
#pragma unroll
        for (int d0 = 0; d0 < 4; ++d0) *(LAS float*)(uintptr_t)(unsigned)(hst + crow(r, hie) * 512 + (d0 * 32 + r32e) * 4) = o[d0][r]; }
    asm volatile("s_waitcnt lgkmcnt(0)" ::: "memory");
    const float* gn = a.mlstm_norm_g + (size_t)l * 512 + h * HD;
    int le = lane; asm volatile("" : "+v"(le));
    u32x4 mo8[8];
#pragma unroll
    for (int i = 0; i < 8; ++i) { const int ch = i * 64 + le, row = ch >> 4, col = (ch & 15) * 8; mo8[i] = *(const u32x4*)(PROJ + (size_t)(row0 + wid * 32 + row) * NPROJ + C_MO + h * HD + col); }
#pragma unroll
    for (int i = 0; i < 8; ++i) { const int ch = i * 64 + le, row = ch >> 4, col = (ch & 15) * 8;
        const f32x4 a0 = *(const LAS f32x4*)(uintptr_t)(unsigned)(hst + row * 512 + col * 4), a1 = *(const LAS f32x4*)(uintptr_t)(unsigned)(hst + row * 512 + col * 4 + 16);
        float ss = (a0.x * a0.x + a0.y * a0.y) + (a0.z * a0.z + a0.w * a0.w) + (a1.x * a1.x + a1.y * a1.y) + (a1.z * a1.z + a1.w * a1.w);
        ss += shx(ss, 1, le); ss += shx(ss, 2, le); ss += shx(ss, 4, le); ss += shx(ss, 8, le);
        const float rstd = fast_rsqrt(ss * (1.f / HD) + EPS);
        const int orow = row0 + wid * 32 + row;
        const u32x4 mo = mo8[i];
        const f32x4 g0 = *(const f32x4*)(gn + col), g1 = *(const f32x4*)(gn + col + 4);
        float y[8] = {a0.x * g0.x, a0.y * g0.y, a0.z * g0.z, a0.w * g0.w, a1.x * g1.x, a1.y * g1.y, a1.z * g1.z, a1.w * g1.w};
        const float mf[8] = {bflo(mo.x), bfhi(mo.x), bflo(mo.y), bfhi(mo.y), bflo(mo.z), bfhi(mo.z), bflo(mo.w), bfhi(mo.w)};
#pragma unroll
        for (int k = 0; k < 8; ++k) y[k] = y[k] * rstd * (1.0f / (1.0f + fast_exp(-mf[k])));
        u32x4 w; w.x = cvtpk(y[0], y[1]); w.y = cvtpk(y[2], y[3]); w.z = cvtpk(y[4], y[5]); w.w = cvtpk(y[6], y[7]);
        *(u32x4*)(MIX + (size_t)orow * D + 1536 + h * HD + col) = w; }
}

__device__ __forceinline__ void ms_unit(const Args& a, const Ctx& c, int l, int unit) {
    const int b = unit >> 2, h = unit & 3; int tid = c.tid; asm volatile("" : "+v"(tid));
    const int lane = tid & 63, wid = c.wave;
    const bf16* PROJ = (const bf16*)(a.ws + WS_BIG); bf16* MIX = (bf16*)(a.ws + WS_H);
    const float* GATE = (const float*)(a.ws + WS_GATE);
    constexpr int P = 132;
    LAS float* Q = (LAS float*)c.lds;
    LAS float* Kk = Q + 32 * P;
    LAS float* V = Kk + 32 * P;
    LAS float* HB = V + 32 * P;
    LAS float* S = HB + 32 * P;
    LAS float* N0 = S + 32 * 33;
    LAS float* A_S = N0 + 128;
    LAS float* M_T = A_S + 32;
    LAS float* B_T = M_T + 32;
    LAS float* WST = B_T + 32;
    LAS float* DEN = WST + 32;
    LAS float* WIN = DEN + 32;
    LAS float* SC = WIN + 32;
    const int row0 = MP + b * SSEQ;
    const size_t sidx = (size_t)(l * SBATCH + b) * MH + h;
    const float* C0 = a.state_c + sidx * HD * HD;
    __syncthreads();
    for (int i = tid; i < 1536; i += NTHREADS) { const int which = i >> 9, r = (i >> 4) & 31, c8 = (i & 15) * 8;
        const u32x4 w = *(const u32x4*)(PROJ + (size_t)(row0 + r) * NPROJ + (which == 0 ? C_MQ : which == 1 ? C_MK : C_MV) + h * HD + c8);
        const float sc = which == 1 ? 0.08838834764831845f : 1.0f;
        LAS float* dst = (which == 0 ? Q : which == 1 ? Kk : V) + r * P + c8;
        *(LAS f32x4*)dst = (f32x4){bflo(w.x) * sc, bfhi(w.x) * sc, bflo(w.y) * sc, bfhi(w.y) * sc};
        *(LAS f32x4*)(dst + 4) = (f32x4){bflo(w.z) * sc, bfhi(w.z) * sc, bflo(w.w) * sc, bfhi(w.w) * sc}; }
    if (tid < 128) N0[tid] = a.state_n[sidx * HD + tid];
    if (wid == 0) {
        const int t = lane & 31; const float m0 = a.state_m[sidx];
        const float li = GATE[(size_t)(row0 + t) * 8 + h], lf = GATE[(size_t)(row0 + t) * 8 + 4 + h];
        float bc = lf;
#pragma unroll
        for (int o = 1; o < 32; o <<= 1) { const float x = shup(bc, o, lane); if ((lane & 31) >= o) bc += x; }
        const float as = li - bc; float cm = as;
#pragma unroll
        for (int o = 1; o < 32; o <<= 1) { const float x = shup(cm, o, lane); if ((lane & 31) >= o) cm = fmaxf(cm, x); }
        const float blast = __int_as_float(__builtin_amdgcn_ds_bpermute(31 << 2, __float_as_int(bc))), amax = __int_as_float(__builtin_amdgcn_ds_bpermute(31 << 2, __float_as_int(cm)));
        const float Mt = fmaxf(m0, cm), mnew = fmaxf(blast + m0, blast + amax);
        if (lane < 32) { A_S[t] = as; B_T[t] = bc; M_T[t] = Mt; WST[t] = fast_exp(blast + as - mnew); WIN[t] = fast_exp(m0 - Mt); }
        if (lane == 0) { SC[0] = m0; SC[1] = blast; SC[2] = mnew; SC[3] = fast_exp(blast + m0 - mnew); }
    }
    __syncthreads();
    for (int i = tid; i < 1024; i += NTHREADS) { const int t = i >> 5, s = i & 31; float d = 0.f;
        if (s <= t) {
#pragma unroll 8
            for (int k = 0; k < 128; k += 4) { const f32x4 q4 = *(const LAS f32x4*)(Q + t * P + k), k4 = *(const LAS f32x4*)(Kk + s * P + k); d += (q4.x * k4.x + q4.y * k4.y) + (q4.z * k4.z + q4.w * k4.w); }
            d *= fast_exp(A_S[s] - M_T[t]); }
        S[t * 33 + s] = d; }
    __syncthreads();
    if (tid < 32) { const int t = tid; float qn = 0.f, rs = 0.f;
        for (int k = 0; k < 128; ++k) qn += Q[t * P + k] * N0[k];
        for (int s = 0; s < 32; ++s) rs += S[t * 33 + s];
        const float den = WIN[t] * qn + rs; DEN[t] = 1.0f / fmaxf(fabsf(den), fast_exp(-(B_T[t] + M_T[t]))); }
    const int e = tid & 127, tg = tid >> 7;
    { float acc[8];
#pragma unroll
      for (int i = 0; i < 8; ++i) acc[i] = 0.f;
      for (int d0 = 0; d0 < 128; d0 += 16) { float cv[16];
#pragma unroll
          for (int j = 0; j < 16; ++j) cv[j] = C0[(size_t)(d0 + j) * HD + e];
#pragma unroll
          for (int j = 0; j < 16; j += 4)
#pragma unroll
              for (int i = 0; i < 8; ++i) { const f32x4 q4 = *(const LAS f32x4*)(Q + (tg * 8 + i) * P + d0 + j); acc[i] += (q4.x * cv[j] + q4.y * cv[j + 1]) + (q4.z * cv[j + 2] + q4.w * cv[j + 3]); } }
      __syncthreads();
#pragma unroll
      for (int i = 0; i < 8; ++i) { const int t = tg * 8 + i; float v = acc[i] * WIN[t];
          for (int s = 0; s <= t; ++s) v += S[t * 33 + s] * V[s * P + e];
          HB[t * P + e] = v * DEN[t]; } }
    __syncthreads();
    { const int t = tid >> 4, e0 = (tid & 15) * 8; float ss = 0.f;
      const f32x4 h0 = *(const LAS f32x4*)(HB + t * P + e0), h1 = *(const LAS f32x4*)(HB + t * P + e0 + 4);
      ss = (h0.x * h0.x + h0.y * h0.y) + (h0.z * h0.z + h0.w * h0.w) + (h1.x * h1.x + h1.y * h1.y) + (h1.z * h1.z + h1.w * h1.w);
      ss += shx(ss, 1, lane); ss += shx(ss, 2, lane); ss += shx(ss, 4, lane); ss += shx(ss, 8, lane);
      const float rstd = fast_rsqrt(ss * (1.f / HD) + EPS);
      const u32x4 mo = *(const u32x4*)(PROJ + (size_t)(row0 + t) * NPROJ + C_MO + h * HD + e0);
      const float* gn = a.mlstm_norm_g + (size_t)l * 512 + h * HD + e0;
      const f32x4 g0 = *(const f32x4*)gn, g1 = *(const f32x4*)(gn + 4);
      float y[8] = {h0.x * g0.x, h0.y * g0.y, h0.z * g0.z, h0.w * g0.w, h1.x * g1.x, h1.y * g1.y, h1.z * g1.z, h1.w * g1.w};
      const float mf[8] = {bflo(mo.x), bfhi(mo.x), bflo(mo.y), bfhi(mo.y), bflo(mo.z), bfhi(mo.z), bflo(mo.w), bfhi(mo.w)};
#pragma unroll
      for (int k = 0; k < 8; ++k) y[k] = y[k] * rstd * (1.0f / (1.0f + fast_exp(-mf[k])));
      u32x4 w; w.x = cvtpk(y[0], y[1]); w.y = cvtpk(y[2], y[3]); w.z = cvtpk(y[4], y[5]); w.w = cvtpk(y[6], y[7]);
      *(u32x4*)(MIX + (size_t)(row0 + t) * D + 1536 + h * HD + e0) = w; }
    { const float decay = SC[3]; const int dg = tg * 32; float acc[32];
#pragma unroll
      for (int i = 0; i < 32; ++i) acc[i] = C0[(size_t)(dg + i) * HD + e] * decay;
      for (int s = 0; s < 32; ++s) { const float vv = V[s * P + e] * WST[s];
#pragma unroll
          for (int i = 0; i < 32; i += 4) { const f32x4 k4 = *(const LAS f32x4*)(Kk + s * P + dg + i); acc[i] += k4.x * vv; acc[i + 1] += k4.y * vv; acc[i + 2] += k4.z * vv; acc[i + 3] += k4.w * vv; } }
      float* oc = a.out + O_SC + sidx * HD * HD;
#pragma unroll
      for (int i = 0; i < 32; ++i) oc[(size_t)(dg + i) * HD + e] = acc[i];
      if (tid < 128) { float v = decay * N0[tid]; for (int s = 0; s < 32; ++s) v += WST[s] * Kk[s * P + tid]; a.out[O_SN + sidx * HD + tid] = v; }
      if (tid == 0) a.out[O_SM + sidx] = SC[2]; }
}

__device__ __forceinline__ void phase_e(const Args& a, const Ctx& c_in0, int l) {
    const Ctx c = relaunder(c_in0);
    const bf16* PROJ = (const bf16*)(a.ws + WS_BIG); bf16* MIX = (bf16*)(a.ws + WS_H);
    constexpr int NATT = NB * NH * 32;
#if (PE_EN & 1)
    for (int u = c.vcu; u < NATT; u += c.G) {
        const int gq = u & 31, bhh = u >> 5, b = bhh >> 3, h = bhh & 7;
        const int c0 = 4 * gq, jstart = c0 >= 8 ? 0 : 8 - c0, NT = 12 - jstart, ci = c.wave >> 1;
        const int krow0 = b * SEQ + (c0 - 8 + jstart) * 64;
        const int alo = ci - jstart, ahi = ci + 8 - jstart;
        const int R0 = (ci + 8 - jstart) * 64 + (c.wave & 1) * 32;
        attn_unit(c, PROJ + (size_t)(b * SEQ + c0 * 64) * NPROJ + C_Q + h * HD, NPROJ, c.wave * 32, PROJ + (size_t)krow0 * NPROJ + C_K + h * HD, PROJ + (size_t)krow0 * NPROJ + C_V + h * HD, NPROJ,
                  NT, alo < 0 ? 0 : alo, ahi, NT * 64, R0, a.rel_bias + (size_t)(l * NH + h) * 257, MIX + (size_t)(b * SEQ + c0 * 64) * D + 512 + h * HD, D, true);
    }
#endif
#if (PE_EN & 4)
    for (int u = c.vcu; u < 16 * NGRP; u += c.G) m3_unit(a, c, l, u);
#endif
}
__device__ __forceinline__ void sample_kv_prep(const Args& a, const Ctx& c, int l, int b, int h) {
    int tid = c.tid; asm volatile("" : "+v"(tid));
    const int lane = tid & 63, row = tid >> 4, c8 = (tid & 15) * 8;
    const bf16* PROJ = (const bf16*)(a.ws + WS_BIG);
    bf16* SK = (bf16*)(a.ws + WS_SK + (size_t)(l & 1) * SKV_IMG); bf16* SV = (bf16*)(a.ws + WS_SV + (size_t)(l & 1) * SKV_IMG);
    const size_t ro = (size_t)(MP + b * SSEQ + row) * NPROJ + h * HD + c8;
    const u32x4 kq = *(const u32x4*)(PROJ + ro + C_K), vq = *(const u32x4*)(PROJ + ro + C_V);
    float x[8] = {bflo(kq.x), bfhi(kq.x), bflo(kq.y), bfhi(kq.y), bflo(kq.z), bfhi(kq.z), bflo(kq.w), bfhi(kq.w)};
    float ss = 0.f;
#pragma unroll
    for (int i = 0; i < 8; ++i) ss += x[i] * x[i];
    ss += shx(ss, 1, lane); ss += shx(ss, 2, lane); ss += shx(ss, 4, lane); ss += shx(ss, 8, lane);
    const float rk = fast_rsqrt(ss * (1.f / HD) + EPS);
    const float* gk = a.k_norm_g + l * HD + c8; const f32x4 g0 = *(const f32x4*)gk, g1 = *(const f32x4*)(gk + 4);
    x[0] *= rk * g0[0]; x[1] *= rk * g0[1]; x[2] *= rk * g0[2]; x[3] *= rk * g0[3]; x[4] *= rk * g1[0]; x[5] *= rk * g1[1]; x[6] *= rk * g1[2]; x[7] *= rk * g1[3];
    u32x4 o; o.x = cvtpk(x[0], x[1]); o.y = cvtpk(x[2], x[3]); o.z = cvtpk(x[4], x[5]); o.w = cvtpk(x[6], x[7]);
    const size_t io = ((size_t)b * SKV_ROWS + 512 + row) * 1024 + h * HD + c8;
    *(u32x4*)(SK + io) = o; *(u32x4*)(SV + io) = vq;
    const size_t oo = ((size_t)(l * SBATCH + b) * SSEQ + row) * 1024 + h * HD + c8;
    float* ok = a.out + O_SK + oo; float* ov = a.out + O_SV + oo;
    *(f32x4*)ok = (f32x4){x[0], x[1], x[2], x[3]}; *(f32x4*)(ok + 4) = (f32x4){x[4], x[5], x[6], x[7]};
    *(f32x4*)ov = (f32x4){bflo(vq.x), bfhi(vq.x), bflo(vq.y), bfhi(vq.y)}; *(f32x4*)(ov + 4) = (f32x4){bflo(vq.z), bfhi(vq.z), bflo(vq.w), bfhi(vq.w)};
    asm volatile("s_waitcnt vmcnt(0)" ::: "memory"); __syncthreads();
}
__device__ __forceinline__ void sample_mixers(const Args& a, const Ctx& c, int l) {
    const bf16* PROJ = (const bf16*)(a.ws + WS_BIG); bf16* MIX = (bf16*)(a.ws + WS_H);
#if (PE_EN & 2)
    for (int su = c.vcu; su < SBATCH * NH; su += c.G) {
        const int b = su >> 3, h = su & 7;
        sample_kv_prep(a, c, l, b, h);
        const bf16* SK = (const bf16*)(a.ws + WS_SK + (size_t)(l & 1) * SKV_IMG) + (size_t)b * SKV_ROWS * 1024 + h * HD; const bf16* SV = (const bf16*)(a.ws + WS_SV + (size_t)(l & 1) * SKV_IMG) + (size_t)b * SKV_ROWS * 1024 + h * HD;
        attn_unit(c, PROJ + (size_t)(MP + b * SSEQ) * NPROJ + C_Q + h * HD, NPROJ, 0, SK, SV, 1024, 9, 0, 8, 544, 512, a.rel_bias + (size_t)(l * NH + h) * 257,
                  MIX + (size_t)(MP + b * SSEQ) * D + 512 + h * HD, D, c.wave == 0, a.q_norm_g + l * HD);
    }
#endif
#if (PE_EN & 8)
    for (int u = c.vcu - SBATCH * NH; u >= 0 && u < SBATCH * MH; u += c.G) ms_unit(a, c, l, u);
#endif
    __syncthreads();
}
typedef const __attribute__((address_space(4))) Args* KArgP;
#if defined(__HIP_DEVICE_COMPILE__)
__device__ __forceinline__ Args get_args() { KArgP p = (KArgP)__builtin_amdgcn_kernarg_segment_ptr(); asm volatile("" : "+s"(p)); return *p; }
#else
__device__ Args get_args();
#endif
__global__ void __launch_bounds__(NTHREADS, 2) fwd(Args args) {
    extern __shared__ __attribute__((aligned(16))) unsigned char lds_raw[];
    Ctx c; c.lds = (LAS unsigned char*)lds_raw; c.wave = __builtin_amdgcn_readfirstlane((int)threadIdx.x >> 6); c.tid = hw_tid(c.wave); c.lane = c.tid & 63;
    c.G = gridDim.x; { const int bx = blockIdx.x; c.vcu = (c.G % 8 == 0) ? (bx % 8) * (c.G / 8) + bx / 8 : bx; }
    volatile LAS unsigned* MISC = (volatile LAS unsigned*)(c.lds + MISC_OFF);
    { const int t0 = hw_tid(c.wave); if (t0 < 16) MISC[t0] = 0u; }
    __syncthreads();
    unsigned* barw = (unsigned*)(get_args().ws + WS_CTL) + 4096;
    XcdBarrier bar; bar.bar = barw; bar.x = 0; bar.st = nullptr;
    const int lo = args.ph_lo, hi = args.ph_hi;
    const bool multi = (hi - lo) > 1;
    if (multi) bar = xcd_barrier_post(barw, MISC + 8, hw_tid(c.wave) == 0);
#define IN(k) (lo <= (k) && (k) < hi)
#define SEAM(k) do { if (IN(k) && IN((k) + 1)) xcd_barrier(bar.bar, bar.x, bar.st, c.wave); } while (0)
    for (int l = 0; l < DEPTH; ++l) {
        const int pb = l * NPH_LAYER;
        if (IN(pb + 0)) {
#if (PH_EN >> 1) & 1
            { const Args A_ = get_args(); phase_norm<true>(A_, c, l); }
#if (PH_DUP >> 1) & 1
            { __syncthreads(); const Args A_ = get_args(); phase_norm<true>(A_, c, l); }
#endif
#endif
 __syncthreads(); SEAM(pb + 0); }
        if (IN(pb + 1)) {
            const Args A_ = get_args(); bf16* H = (bf16*)(A_.ws + WS_H); bf16* BIG = (bf16*)(A_.ws + WS_BIG);
            bf16* XBp = (bf16*)(A_.ws + WS_XB); const float* RS = (const float*)(A_.ws + WS_RSTD);
            pg8::Gemm g{XBp, (const bf16*)(A_.ws + WS_WIN), MP, NPROJ, D}; pg8::StaticOrder S; S.init(MP, NPROJ, c.G, (int)blockIdx.x, WGM_B);
            pg8::EpiProj E{BIG, NPROJ, A_.q_norm_g + l * HD, A_.k_norm_g + l * HD, (LAS float*)(c.lds + SCR_OFF), RS};

#if (PH_EN >> 2) & 1
            for (int rep_ = 0, nrep_ = ((PH_DUP >> 2) & 1) ? A_.rep : 1; rep_ < nrep_; ++rep_) pg8::gemm_phase<pg8::EpiProj, pg8::StaticOrder, true, true>(c.lds, g, S, E, c.wave);
            { SEpiBf16 SE{BIG + (size_t)MP * NPROJ, NPROJ, 0, RS + MP}; sample_gemm(c.lds, c.wave, c.vcu, c.G, XBp + (size_t)MP * D, g.Bt, NPROJ, D, SE); }
#endif

            SEAM(pb + 1);
        }
        if (IN(pb + 2)) {
#if (PH_EN >> 3) & 1
            { const Args A_ = get_args(); phase_c<true>(A_, c, l); }
#if (PH_DUP >> 3) & 1
            { __syncthreads(); const Args A_ = get_args(); phase_c<false>(A_, c, l); }
#endif
#endif
 SEAM(pb + 2); }
        if (IN(pb + 3)) {
#if (PH_EN >> 4) & 1
            { const Args A_ = get_args(); phase_d(A_, c, l); }
            { const Args A_ = get_args(); if (l + 1 < DEPTH) build_kv_image(A_, c.vcu, c.G, hw_tid(c.wave), l + 1); }
#if (PH_DUP >> 4) & 1
            { __syncthreads(); const Args A_ = get_args(); phase_d(A_, c, l); }
#endif
#endif
 SEAM(pb + 3); }
        if (IN(pb + 4)) {
#if (PH_EN >> 5) & 1
            { const Args A_ = get_args(); phase_e(A_, c, l); }
#if (PH_DUP >> 5) & 1
            { __syncthreads(); const Args A_ = get_args(); phase_e(A_, c, l); }
#endif
#endif
 __syncthreads(); SEAM(pb + 4); }
        if (IN(pb + 5)) {
            const Args A_ = get_args(); bf16* H = (bf16*)(A_.ws + WS_H);
            pg8::Gemm g{H, (const bf16*)(A_.ws + WS_WOUT), MP, D, D}; pg8::StaticOrder S; S.init(MP, D, c.G, (int)blockIdx.x, WGM_F);
            pg8::EpiResAdd E{(bf16*)(A_.ws + WS_XB), A_.out, D, false};

#if (PH_EN >> 6) & 1
            pg8::gemm_phase<pg8::EpiResAdd, pg8::StaticOrder, true, true>(c.lds, g, S, E, c.wave);
            { SEpiResAdd SE{(bf16*)(A_.ws + WS_XB) + (size_t)MP * D, A_.out + (size_t)MP * D, D, false}; sample_gemm(c.lds, c.wave, c.vcu, c.G, H + (size_t)MP * D, g.Bt, D, D, SE); }
#if (PH_DUP >> 6) & 1
            { pg8::EpiBf16<0> E2{(bf16*)(A_.ws + WS_BIG), D, nullptr, (LAS float*)(c.lds + SCR_OFF)}; pg8::gemm_phase<pg8::EpiBf16<0>, pg8::StaticOrder, true, true>(c.lds, g, S, E2, c.wave); }
#endif
#endif

            SEAM(pb + 5);
        }
        if (IN(pb + 6)) {
#if (PH_EN >> 7) & 1
            { const Args A_ = get_args(); phase_norm<false>(A_, c, l); }
#if (PH_DUP >> 7) & 1
            { __syncthreads(); const Args A_ = get_args(); phase_norm<false>(A_, c, l); }
#endif
#endif
 SEAM(pb + 6); }
        if (IN(pb + 7)) {
            const Args A_ = get_args(); bf16* H = (bf16*)(A_.ws + WS_H); bf16* BIG = (bf16*)(A_.ws + WS_BIG);
            bf16* XBp = (bf16*)(A_.ws + WS_XB); const float* RS = (const float*)(A_.ws + WS_RSTD);
            pg8::Gemm g{XBp, (const bf16*)(A_.ws + WS_WUP), MP, FF, D}; pg8::StaticOrder S; S.init(MP, FF, c.G, (int)blockIdx.x, WGM_H);
            pg8::EpiBf16<1> E{BIG, FF, RS, (LAS float*)(c.lds + SCR_OFF)};

#if (PH_EN >> 8) & 1
            for (int rep_ = 0, nrep_ = ((PH_DUP >> 8) & 1) ? A_.rep : 1; rep_ < nrep_; ++rep_) pg8::gemm_phase<pg8::EpiBf16<1>, pg8::StaticOrder, true, true>(c.lds, g, S, E, c.wave);
            { SEpiBf16 SE{BIG + (size_t)MP * FF, FF, 1, RS + MP}; sample_gemm(c.lds, c.wave, c.vcu, c.G, XBp + (size_t)MP * D, g.Bt, FF, D, SE); }
#endif

            SEAM(pb + 7);
        }
        if (IN(pb + 8)) {
            const Args A_ = get_args(); bf16* BIG = (bf16*)(A_.ws + WS_BIG);
            pg8::Gemm g{BIG, (const bf16*)(A_.ws + WS_WDN), MP, D, FF}; pg8::StaticOrder S; S.init(MP, D, c.G, (int)blockIdx.x, WGM_I);
            pg8::EpiResAdd E{(bf16*)(A_.ws + WS_XB), A_.out, D, l == DEPTH - 1};

#if (PH_EN >> 9) & 1
            pg8::gemm_phase<pg8::EpiResAdd, pg8::StaticOrder, true, true>(c.lds, g, S, E, c.wave);
            { SEpiResAdd SE{(bf16*)(A_.ws + WS_XB) + (size_t)MP * D, A_.out + (size_t)MP * D, D, l == DEPTH - 1}; sample_gemm(c.lds, c.wave, c.vcu, c.G, BIG + (size_t)MP * FF, g.Bt, D, FF, SE); }
#if (PH_DUP >> 9) & 1
            { pg8::EpiBf16<0> E2{(bf16*)(A_.ws + WS_H), D, nullptr, (LAS float*)(c.lds + SCR_OFF)}; pg8::gemm_phase<pg8::EpiBf16<0>, pg8::StaticOrder, true, true>(c.lds, g, S, E2, c.wave); }
#endif
#endif

            SEAM(pb + 8);
        }
    }
#undef IN
#undef SEAM
}

extern "C" void kernel_launch(void* const* d_in, const int* in_sizes, int n_in, void* d_out, int out_size, void* d_ws, size_t ws_size, hipStream_t stream) {
    static int grid = 0;
    if (grid == 0) {
        if (n_in != 21 || (size_t)out_size != O_END || ws_size < WS_END) { fprintf(stderr, "kernel_launch: shape mismatch n_in %d out %d ws %zu (need %zu)\n", n_in, out_size, ws_size, (size_t)WS_END); grid = -1; return; }
        int dev = 0, cus = 0, per_cu = 0;
        if (hipGetDevice(&dev) != hipSuccess || hipDeviceGetAttribute(&cus, hipDeviceAttributeMultiprocessorCount, dev) != hipSuccess) { grid = -1; return; }
        if (hipFuncSetAttribute((const void*)fwd, hipFuncAttributeMaxDynamicSharedMemorySize, LDS_BYTES) != hipSuccess) { fprintf(stderr, "kernel_launch: hipFuncSetAttribute failed\n"); grid = -1; return; }
        if (hipOccupancyMaxActiveBlocksPerMultiprocessor(&per_cu, (const void*)fwd, NTHREADS, LDS_BYTES) != hipSuccess || per_cu < 1) { fprintf(stderr, "kernel_launch: occupancy query says %d\n", per_cu); }
        (void)hipGetLastError();
        grid = cus;
    }
    if (grid < 0) return;
    (void)hipMemsetAsync((char*)d_ws + WS_CTL, 0, CTL_BYTES, stream);
    Args a{};
    a.x_prompt = (const float*)d_in[0]; a.x_sample = (const float*)d_in[1]; a.cache_k = (const float*)d_in[2]; a.cache_v = (const float*)d_in[3]; a.state_conv = (const float*)d_in[4];
    a.state_c = (const float*)d_in[5]; a.state_n = (const float*)d_in[6]; a.state_m = (const float*)d_in[7]; a.norm_mix_g = (const float*)d_in[8]; a.w_in = (const float*)d_in[9];
    a.conv_w = (const float*)d_in[10]; a.q_norm_g = (const float*)d_in[11]; a.k_norm_g = (const float*)d_in[12]; a.rel_bias = (const float*)d_in[13]; a.b_igate = (const float*)d_in[14];
    a.b_fgate = (const float*)d_in[15]; a.mlstm_norm_g = (const float*)d_in[16]; a.w_out = (const float*)d_in[17]; a.norm_mlp_g = (const float*)d_in[18]; a.w_up = (const float*)d_in[19];
    a.w_down = (const float*)d_in[20]; a.out = (float*)d_out; a.ws = (unsigned char*)d_ws;
#if MK_PER_PHASE
    for (int p = 0; p < NPHASES; ++p) { a.ph_lo = p; a.ph_hi = p + 1; a.rep = 2; hipLaunchKernelGGL(fwd, dim3(grid), dim3(NTHREADS), LDS_BYTES, stream, a); }
#else
    a.ph_lo = 0; a.ph_hi = NPHASES; a.rep = 2; hipLaunchKernelGGL(fwd, dim3(grid), dim3(NTHREADS), LDS_BYTES, stream, a);
#endif
    const hipError_t le = hipPeekAtLastError();
    if (le != hipSuccess) fprintf(stderr, "kernel_launch: launch failed: %s\n", hipGetErrorName(le));
}
```

```cpp
#include <hip/hip_runtime.h>
#include <cstdio>
#include <cstdint>

#ifndef MK_PER_PHASE
#define MK_PER_PHASE 0
#endif

#ifndef PH_EN
#define PH_EN 0x3ff
#endif
#ifndef PE_EN
#define PE_EN 0xf
#endif
#ifndef WGM_B
#define WGM_B 4
#endif
#ifndef WGM_F
#define WGM_F 4
#endif
#ifndef WGM_H
#define WGM_H 4
#endif
#ifndef WGM_I
#define WGM_I 4
#endif
#ifndef PH_DUP
#define PH_DUP 0
#endif
#define LAS __attribute__((address_space(3)))
#define GAS __attribute__((address_space(1)))
typedef unsigned short bf16;
typedef short bf16x8 __attribute__((ext_vector_type(8)));
typedef short s16x4 __attribute__((ext_vector_type(4)));
typedef float f32x2 __attribute__((ext_vector_type(2)));
typedef float f32x4 __attribute__((ext_vector_type(4)));
typedef float f32x16 __attribute__((ext_vector_type(16)));
typedef unsigned u32x2 __attribute__((ext_vector_type(2)));
typedef unsigned u32x4 __attribute__((ext_vector_type(4)));

constexpr int D = 2048, NB = 4, SEQ = 8192, DEPTH = 4, SBATCH = 8, SSEQ = 32;
constexpr int MP = NB * SEQ, MS = SBATCH * SSEQ, MR = MP + MS;
constexpr int NH = 8, HD = 128, MH = 4;
constexpr int NPROJ = 6656, IN_DIM = 6664, FF = 8192;
constexpr int C_XA = 0, C_GB = 512, C_GC = 1024, C_Q = 1536, C_K = 2560, C_V = 3584, C_MQ = 4608, C_MK = 5120, C_MV = 5632, C_MO = 6144;
constexpr int KEEP = 512;
constexpr int SKV_ROWS = 640;
constexpr float EPS = 1e-6f;
constexpr float LOG2E = 1.4426950408889634f;
constexpr int NGRP = SEQ / 256;

constexpr size_t O_YP = 0, O_YS = O_YP + (size_t)MP * D, O_PCONV = O_YS + (size_t)MS * D, O_PK = O_PCONV + (size_t)DEPTH * NB * 2 * 512,
                 O_PV = O_PK + (size_t)DEPTH * NB * KEEP * 1024, O_PC = O_PV + (size_t)DEPTH * NB * KEEP * 1024, O_PN = O_PC + (size_t)DEPTH * NB * MH * HD * HD,
                 O_PM = O_PN + (size_t)DEPTH * NB * MH * HD, O_SCONV = O_PM + (size_t)DEPTH * NB * MH, O_SK = O_SCONV + (size_t)DEPTH * SBATCH * 2 * 512,
                 O_SV = O_SK + (size_t)DEPTH * SBATCH * SSEQ * 1024, O_SC = O_SV + (size_t)DEPTH * SBATCH * SSEQ * 1024, O_SN = O_SC + (size_t)DEPTH * SBATCH * MH * HD * HD,
                 O_SM = O_SN + (size_t)DEPTH * SBATCH * MH * HD, O_END = O_SM + (size_t)DEPTH * SBATCH * MH;

constexpr size_t al256(size_t x) { return (x + 255) / 256 * 256; }
constexpr size_t WS_CTL = 0, CTL_BYTES = 1u << 20;
constexpr size_t WS_WIN = CTL_BYTES;
constexpr size_t WS_WOUT = WS_WIN + (size_t)NPROJ * D * 2;
constexpr size_t WS_WUP = WS_WOUT + (size_t)D * D * 2;
constexpr size_t WS_WDN = WS_WUP + (size_t)FF * D * 2;
constexpr size_t WS_H = WS_WDN + (size_t)D * FF * 2;
constexpr size_t WS_XB = WS_H + (size_t)MR * D * 2;
constexpr size_t WS_BIG = WS_XB + (size_t)MR * D * 2;
constexpr size_t BIG_BYTES = (size_t)MR * FF * 2;
constexpr size_t WS_CLOC = WS_BIG + al256((size_t)MR * NPROJ * 2);
constexpr size_t WS_C0 = WS_CLOC + (size_t)16 * NGRP * HD * HD * 4;
constexpr size_t WS_NLOC = WS_C0 + (size_t)16 * NGRP * HD * HD * 2;
constexpr size_t WS_N0 = WS_NLOC + (size_t)16 * NGRP * HD * 4;
constexpr size_t WS_MSC = WS_N0 + (size_t)16 * NGRP * HD * 4;
constexpr size_t WS_MIX_END = WS_MSC + (size_t)16 * NGRP * 4 * 4;
static_assert(WS_MIX_END <= WS_BIG + BIG_BYTES, "mLSTM scratch fits in the free top of BIG");
constexpr size_t WS_GATE = WS_BIG + BIG_BYTES;
constexpr size_t SKV_IMG = (size_t)SBATCH * SKV_ROWS * 1024 * 2;
constexpr size_t WS_SK = WS_GATE + (size_t)MR * 8 * 4;
constexpr size_t WS_SV = WS_SK + 2 * SKV_IMG;
constexpr size_t WS_RSTD = WS_SV + 2 * SKV_IMG;
constexpr size_t WS_END = WS_RSTD + (size_t)MR * 4;
static_assert(WS_END <= 1235000000ull, "workspace budget");

constexpr int RING_BYTES = 131072;
constexpr int MISC_OFF = RING_BYTES;
constexpr int SCR_OFF = MISC_OFF + 256;
constexpr int LDS_BYTES = 147456;
constexpr int NWAVES = 8, NTHREADS = 512;

__device__ __forceinline__ unsigned cvtpk(float lo, float hi) { unsigned r; asm volatile("v_cvt_pk_bf16_f32 %0, %1, %2" : "=v"(r) : "v"(lo), "v"(hi)); return r; }
__device__ __forceinline__ float bflo(unsigned w) { return __uint_as_float(w << 16); }
__device__ __forceinline__ float bfhi(unsigned w) { return __uint_as_float(w & 0xffff0000u); }
__device__ __forceinline__ float bf2f(bf16 b) { return __uint_as_float(((unsigned)b) << 16); }
__device__ __forceinline__ float shx(float v, int o, int lane) { return __int_as_float(__builtin_amdgcn_ds_bpermute((lane ^ o) << 2, __float_as_int(v))); }
__device__ __forceinline__ float shup(float v, int o, int lane) { const int s = lane - o; return __int_as_float(__builtin_amdgcn_ds_bpermute((s < 0 ? lane : s) << 2, __float_as_int(v))); }
__device__ __forceinline__ float wave_sum(float v, int lane) {
#pragma unroll
    for (int o = 1; o < 64; o <<= 1) v += shx(v, o, lane);
    return v;
}
__device__ __forceinline__ float fast_rsqrt(float x) { return __builtin_amdgcn_rsqf(x); }
__device__ __forceinline__ float fast_exp(float x) { return __builtin_amdgcn_exp2f(x * 1.4426950408889634f); }
__device__ __forceinline__ float fast_log(float x) { return __builtin_amdgcn_logf(x) * 0.6931471805599453f; }
__device__ __forceinline__ float opaque_zero() { float z; asm volatile("v_mov_b32 %0, 0" : "=v"(z)); return z; }
#define LDS_WAIT() asm volatile("s_waitcnt lgkmcnt(0)" ::: "memory")
#define VM_WAIT() asm volatile("s_waitcnt vmcnt(0)" ::: "memory")
#define SBAR() __builtin_amdgcn_sched_barrier(0)

namespace pg8 {
typedef unsigned short bf16_t;
constexpr int BM = 256, BK = 64, HALF = 128, HTB = HALF * BK * 2, STAGE_BYTES = 8 * HTB, NXCD = 8, WGM = 4;
__host__ __device__ __forceinline__ int lds_byte(int r, int c) { const int st = (r >> 4) * 2 + (c >> 5), rr = r & 15, cc = c & 31, ob = rr * 64 + cc * 2; return st * 1024 + (ob ^ (((ob >> 9) & 1) << 5)); }
__host__ __device__ __forceinline__ void stage_rc(int b, int& R, int& C) { const int st = b / 1024, sb = b % 1024, swz = sb ^ (((sb >> 9) & 1) << 5); R = (st >> 1) * 16 + swz / 64; C = (st & 1) * 32 + (swz % 64) / 2; }
__host__ __device__ __forceinline__ int perm32(int rho) { const int n = rho >> 4, i = rho & 15; return 8 * (i >> 2) + 4 * n + (i & 3); }
struct Unit { int pm, pn; };
struct Gemm { const bf16_t* A; const bf16_t* Bt; int M, N, K; };
struct StaticOrder {
    int nM, nN, nwg, G, c, wgm;
    __host__ __device__ void init(int M, int N, int G_, int c_, int wgm_ = WGM) { nM = M / BM; nN = N / BM; nwg = nM * nN; G = G_; c = c_; wgm = wgm_; }
    __host__ __device__ bool next(int i, Unit& u) const {
        const long L = (long)i * G + c; if (L >= nwg) return false;
        int wgid = (int)L; { const int q = nwg / NXCD, r = nwg % NXCD, xcd = wgid % NXCD, off = wgid / NXCD; wgid = (xcd < r ? xcd * (q + 1) : r * (q + 1) + (xcd - r) * q) + off; }
        const int nig = wgm * nN, gid = wgid / nig, fm = gid * wgm, gsz = (nM - fm) < wgm ? (nM - fm) : wgm;
        u.pm = fm + ((wgid % nig) % gsz); u.pn = (wgid % nig) / gsz; return true;
    }
    __device__ __forceinline__ void a_ready(const Unit&) const {}
    __device__ __forceinline__ void done(const Unit&) const {}
};
template <int ACT  > struct EpiBf16 {
    static constexpr bool PERM = true, AFTER_DRAIN = false;
    static constexpr bool RSL = true;
    bf16_t* O; int ldc; const float* rstd; LAS float* T;
    __device__ __forceinline__ void rs_fetch(const Unit& u, int tid, int par) const { if (rstd && tid < BM) (T + 2048 + par * BM)[tid] = rstd[u.pm * BM + tid]; }
    __device__ __forceinline__ void operator()(const f32x4 (&acc)[2][2][4][2], const Unit& u, int wr, int wc, int fr, int fq, int par) const {
        const int row0 = u.pm * BM + wr * 64 + fr; const int col0 = u.pn * BM + wc * 32 + 8 * fq;
#pragma unroll
        for (int ai = 0; ai < 2; ++ai)
#pragma unroll
            for (int m = 0; m < 4; ++m) { bf16_t* rowp = O + (size_t)(row0 + ai * HALF + m * 16) * ldc + col0; const float rsv = rstd ? (T + 2048 + par * BM)[wr * 64 + fr + ai * HALF + m * 16] : 1.0f;
#pragma unroll
                for (int bj = 0; bj < 2; ++bj) { f32x4 v0 = acc[ai][bj][m][0] * rsv, v1 = acc[ai][bj][m][1] * rsv;
                    if (ACT == 1) {
#pragma unroll
                        for (int j = 0; j < 4; ++j) { const float a = fmaxf(v0[j], 0.f), b = fmaxf(v1[j], 0.f); v0[j] = a * a; v1[j] = b * b; } }
                    u32x4 w; w.x = cvtpk(v0[0], v0[1]); w.y = cvtpk(v0[2], v0[3]); w.z = cvtpk(v1[0], v1[1]); w.w = cvtpk(v1[2], v1[3]);
                    *(u32x4*)(rowp + bj * HALF) = w; } }
    }
};
struct EpiProj {
    static constexpr bool PERM = true, AFTER_DRAIN = false;
    static constexpr bool RSL = true;
    bf16_t* O; int ldc; const float* gq; const float* gk; LAS float* T; const float* rstd;
    __device__ __forceinline__ void rs_fetch(const Unit& u, int tid, int par) const { if (tid < BM) (T + 2048 + par * BM)[tid] = rstd[u.pm * BM + tid]; }
    __device__ __forceinline__ void operator()(const f32x4 (&acc)[2][2][4][2], const Unit& u, int wr, int wc, int fr, int fq, int par) const {
        const int row0 = u.pm * BM + wr * 64 + fr; const int col0 = u.pn * BM + wc * 32 + 8 * fq;
        const bool isqk = (u.pn >= 6) && (u.pn < 14);
        float rs[2][4];
#pragma unroll
        for (int ai = 0; ai < 2; ++ai)
#pragma unroll
            for (int m = 0; m < 4; ++m) rs[ai][m] = (T + 2048 + par * BM)[wr * 64 + fr + ai * HALF + m * 16];
        if (!isqk) {
#pragma unroll
            for (int ai = 0; ai < 2; ++ai)
#pragma unroll
                for (int m = 0; m < 4; ++m) { bf16_t* rowp = O + (size_t)(row0 + ai * HALF + m * 16) * ldc + col0;
#pragma unroll
                    for (int bj = 0; bj < 2; ++bj) { const f32x4 v0 = acc[ai][bj][m][0] * rs[ai][m], v1 = acc[ai][bj][m][1] * rs[ai][m];
                        u32x4 w; w.x = cvtpk(v0[0], v0[1]); w.y = cvtpk(v0[2], v0[3]); w.z = cvtpk(v1[0], v1[1]); w.w = cvtpk(v1[2], v1[3]);
                        *(u32x4*)(rowp + bj * HALF) = w; } }
            return;
        }
        const int lane = fr + 16 * fq;
        float ss[2][4][2];
#pragma unroll
        for (int ai = 0; ai < 2; ++ai)
#pragma unroll
            for (int m = 0; m < 4; ++m)
#pragma unroll
                for (int bj = 0; bj < 2; ++bj) { const f32x4 v0 = acc[ai][bj][m][0] * rs[ai][m], v1 = acc[ai][bj][m][1] * rs[ai][m];
                    float s = (v0[0] * v0[0] + v0[1] * v0[1]) + (v0[2] * v0[2] + v0[3] * v0[3]) + (v1[0] * v1[0] + v1[1] * v1[1]) + (v1[2] * v1[2] + v1[3] * v1[3]);
                    s += shx(s, 16, lane); s += shx(s, 32, lane); ss[ai][m][bj] = s; }
        if (fq == 0) {
#pragma unroll
            for (int ai = 0; ai < 2; ++ai)
#pragma unroll
                for (int m = 0; m < 4; ++m)
#pragma unroll
                    for (int bj = 0; bj < 2; ++bj) T[(ai * HALF + wr * 64 + m * 16 + fr) * 8 + bj * 4 + wc] = ss[ai][m][bj];
        }
        asm volatile("s_waitcnt lgkmcnt(0)" ::: "memory"); __builtin_amdgcn_s_barrier(); asm volatile("" ::: "memory");
        const float* gg = ((u.pn < 10) ? gq : gk) + wc * 32 + 8 * fq;
        const f32x4 g0 = *(const f32x4*)gg, g1 = *(const f32x4*)(gg + 4);
#pragma unroll
        for (int ai = 0; ai < 2; ++ai)
#pragma unroll
            for (int m = 0; m < 4; ++m) { bf16_t* rowp = O + (size_t)(row0 + ai * HALF + m * 16) * ldc + col0;
#pragma unroll
                for (int bj = 0; bj < 2; ++bj) { const f32x4 t = *(const LAS f32x4*)(T + (ai * HALF + wr * 64 + m * 16 + fr) * 8 + bj * 4);
                    const float rq = fast_rsqrt(((t[0] + t[1]) + (t[2] + t[3])) * (1.0f / 128.0f) + 1e-6f) * rs[ai][m];
                    const f32x4 v0 = acc[ai][bj][m][0] * rq * g0, v1 = acc[ai][bj][m][1] * rq * g1;
                    u32x4 w; w.x = cvtpk(v0[0], v0[1]); w.y = cvtpk(v0[2], v0[3]); w.z = cvtpk(v1[0], v1[1]); w.w = cvtpk(v1[2], v1[3]);
                    *(u32x4*)(rowp + bj * HALF) = w; } }
    }
};
struct EpiResAdd {
    static constexpr bool RSL = false;
    static constexpr bool PERM = true, AFTER_DRAIN = false;
    bf16_t* XB; float* Y; int ldc; bool fin;
    __device__ __forceinline__ void operator()(const f32x4 (&acc)[2][2][4][2], const Unit& u, int wr, int wc, int fr, int fq, int) const {
        const int row0 = u.pm * BM + wr * 64 + fr, col0 = u.pn * BM + wc * 32 + 8 * fq;
        u32x4 r[2][4][2];
#pragma unroll
        for (int ai = 0; ai < 2; ++ai)
#pragma unroll
            for (int m = 0; m < 4; ++m)
#pragma unroll
                for (int bj = 0; bj < 2; ++bj) r[ai][m][bj] = *(const u32x4*)(XB + (size_t)(row0 + ai * HALF + m * 16) * ldc + col0 + bj * HALF);
#pragma unroll
        for (int ai = 0; ai < 2; ++ai)
#pragma unroll
            for (int m = 0; m < 4; ++m)
#pragma unroll
                for (int bj = 0; bj < 2; ++bj) { const u32x4 w = r[ai][m][bj]; const f32x4 a0 = acc[ai][bj][m][0], a1 = acc[ai][bj][m][1];
                    const f32x4 v0 = (f32x4){bflo(w.x) + a0[0], bfhi(w.x) + a0[1], bflo(w.y) + a0[2], bfhi(w.y) + a0[3]}, v1 = (f32x4){bflo(w.z) + a1[0], bfhi(w.z) + a1[1], bflo(w.w) + a1[2], bfhi(w.w) + a1[3]};
                    const size_t off = (size_t)(row0 + ai * HALF + m * 16) * ldc + col0 + bj * HALF;
                    if (fin) { *(f32x4*)(Y + off) = v0; *(f32x4*)(Y + off + 4) = v1; }
                    else { u32x4 o; o.x = cvtpk(v0[0], v0[1]); o.y = cvtpk(v0[2], v0[3]); o.z = cvtpk(v1[0], v1[1]); o.w = cvtpk(v1[2], v1[3]); *(u32x4*)(XB + off) = o; } }
    }
};

template <class Epi, class Sched, bool ALIGN_EPI = false, bool SP2 = false>
__device__ __forceinline__ void gemm_phase(LAS unsigned char* lds, const Gemm g, const Sched& S, const Epi& E, const int wave_) {
    int ln_; asm volatile("v_mbcnt_lo_u32_b32 %0, -1, 0\n\tv_mbcnt_hi_u32_b32 %0, -1, %0" : "=v"(ln_)); const int tid = wave_ * 64 + ln_;
    const int wid = __builtin_amdgcn_readfirstlane(tid >> 6), lane = tid & 63, wr = wid >> 2, wc = wid & 3, fr = lane & 15, fq = lane >> 4;
    const int K = g.K, nt = K / BK;
    unsigned voffA[2], voffB[2];
#pragma unroll
    for (int i = 0; i < 2; ++i) { int R, C; stage_rc(tid * 16 + i * 8192, R, C); const int Rb = Epi::PERM ? ((R & ~31) + perm32(R & 31)) : R;
        voffA[i] = (unsigned)(R * K + C) * 2u; voffB[i] = (unsigned)(Rb * K + C) * 2u; }
    const size_t kstep = (size_t)(BK * 2);
    const size_t hstep = (size_t)HALF * K * 2;
    const size_t tstep = 2 * hstep;
    const unsigned ldsw = (unsigned)wid * 1024u;
    const int aoff = lds_byte(wr * 64 + fr, fq * 8), boff = lds_byte(wc * 32 + fr, fq * 8);
#define PG8_SA(b, h) (((b) * 2 + (h)) * HTB)
#define PG8_SB(b, h) ((4 + (b) * 2 + (h)) * HTB)
#define PG8_STAGE(bufoff, gbase, voff) do { _Pragma("unroll") for (int _i = 0; _i < 2; ++_i) \
        __builtin_amdgcn_global_load_lds((const unsigned*)((const char*)(gbase) + (voff)[_i]), (LAS unsigned*)(lds + (bufoff) + ldsw + _i * 8192), 16, 0, 0); } while (0)
#define PG8_LDA(dst, b, h) do { _Pragma("unroll") for (int m = 0; m < 4; ++m) _Pragma("unroll") for (int k = 0; k < 2; ++k) dst[m][k] = *(const LAS bf16x8*)(lds + PG8_SA(b, h) + aoff + m * 2048 + k * 1024); } while (0)
#define PG8_LDB(dst, b, h) do { _Pragma("unroll") for (int n = 0; n < 2; ++n) _Pragma("unroll") for (int k = 0; k < 2; ++k) dst[n][k] = *(const LAS bf16x8*)(lds + PG8_SB(b, h) + boff + n * 2048 + k * 1024); } while (0)
#define PG8_MMA(ai, bj, At, Bt) do { __builtin_amdgcn_s_setprio(1); _Pragma("unroll") for (int m = 0; m < 4; ++m) _Pragma("unroll") for (int n = 0; n < 2; ++n) _Pragma("unroll") for (int k = 0; k < 2; ++k) \
        acc[ai][bj][m][n] = __builtin_amdgcn_mfma_f32_16x16x32_bf16(Bt[n][k], At[m][k], acc[ai][bj][m][n], 0, 0, 0); __builtin_amdgcn_s_setprio(0); } while (0)
#define PG8_WAIT_V(n) asm volatile("s_waitcnt vmcnt(" #n ")" ::: "memory")
#define PG8_WAIT_L(n) asm volatile("s_waitcnt lgkmcnt(" #n ")" ::: "memory")
#define PG8_BAR __builtin_amdgcn_s_barrier()
#define PG8_SCHED __builtin_amdgcn_sched_barrier(0)
    Unit cur, nxt; int ui = 0;
    if (!S.next(0, cur)) return;
    f32x4 acc[2][2][4][2];
    { const float z = opaque_zero();
#pragma unroll
    for (int a = 0; a < 2; ++a)
#pragma unroll
        for (int b = 0; b < 2; ++b)
#pragma unroll
            for (int m = 0; m < 4; ++m)
#pragma unroll
                for (int n = 0; n < 2; ++n) acc[a][b][m][n] = (f32x4){z, z, z, z}; }
    bf16x8 At[4][2], B0[2][2], B1[2][2];
    const char* cA = (const char*)g.A + (size_t)cur.pm * tstep; const char* cB = (const char*)g.Bt + (size_t)cur.pn * tstep;
    S.a_ready(cur);
    if constexpr (Epi::RSL) E.rs_fetch(cur, tid, 0);
    if constexpr (SP2) {
        PG8_STAGE(PG8_SB(0, 0), cB, voffB); PG8_STAGE(PG8_SB(0, 1), cB + hstep, voffB); PG8_STAGE(PG8_SA(0, 0), cA, voffA); PG8_STAGE(PG8_SA(0, 1), cA + hstep, voffA);
        if (wr == 1) PG8_BAR;
        PG8_WAIT_V(2); PG8_BAR;
        PG8_STAGE(PG8_SB(1, 0), cB + kstep, voffB); PG8_STAGE(PG8_SA(1, 0), cA + kstep, voffA); PG8_STAGE(PG8_SB(1, 1), cB + hstep + kstep, voffB);
        PG8_WAIT_V(6); PG8_BAR;
    } else {
        PG8_STAGE(PG8_SB(0, 0), cB, voffB); PG8_STAGE(PG8_SA(0, 0), cA, voffA); PG8_STAGE(PG8_SB(0, 1), cB + hstep, voffB); PG8_STAGE(PG8_SA(0, 1), cA + hstep, voffA);
        if (wr == 1) PG8_BAR;
        PG8_WAIT_V(4); PG8_BAR;
        PG8_STAGE(PG8_SB(1, 0), cB + kstep, voffB); PG8_STAGE(PG8_SA(1, 0), cA + kstep, voffA); PG8_STAGE(PG8_SB(1, 1), cB + hstep + kstep, voffB);
        PG8_WAIT_V(6); PG8_BAR;
    }
    for (;;) {
        const bool has_next = S.next(ui + 1, nxt);
        const char* nA = has_next ? (const char*)g.A + (size_t)nxt.pm * tstep : cA; const char* nB = has_next ? (const char*)g.Bt + (size_t)nxt.pn * tstep : cB;
        for (int t = 0; t < nt; t += 2) {
            const bool last = (t == nt - 2);
            const char* a1 = cA + (size_t)(t + 1) * kstep;
            const char* a2 = last ? nA : cA + (size_t)(t + 2) * kstep; const char* b2 = last ? nB : cB + (size_t)(t + 2) * kstep;
            const char* a3 = a2 + kstep; const char* b3 = b2 + kstep;
            if (last && has_next) S.a_ready(nxt);
            if constexpr (SP2) {
            PG8_LDB(B0, 0, 0); PG8_LDB(B1, 0, 1); PG8_SCHED; PG8_LDA(At, 0, 0); PG8_STAGE(PG8_SA(1, 1), a1 + hstep, voffA);
            PG8_WAIT_V(8); PG8_WAIT_L(0); PG8_BAR; PG8_MMA(0, 0, At, B0); PG8_MMA(0, 1, At, B1); PG8_BAR; PG8_SCHED;
            PG8_LDA(At, 0, 1); PG8_STAGE(PG8_SB(0, 0), b2, voffB); PG8_STAGE(PG8_SB(0, 1), b2 + hstep, voffB); PG8_STAGE(PG8_SA(0, 0), a2, voffA);
            PG8_WAIT_V(8); PG8_WAIT_L(0); PG8_BAR; PG8_MMA(1, 0, At, B0); PG8_MMA(1, 1, At, B1); PG8_BAR; PG8_SCHED;
            PG8_LDB(B0, 1, 0); PG8_LDB(B1, 1, 1); PG8_SCHED; PG8_LDA(At, 1, 0); PG8_STAGE(PG8_SA(0, 1), a2 + hstep, voffA);
            PG8_WAIT_V(8); PG8_WAIT_L(0); PG8_BAR; PG8_MMA(0, 0, At, B0); PG8_MMA(0, 1, At, B1); PG8_BAR; PG8_SCHED;
            PG8_LDA(At, 1, 1); PG8_STAGE(PG8_SB(1, 0), b3, voffB); PG8_STAGE(PG8_SB(1, 1), b3 + hstep, voffB); PG8_STAGE(PG8_SA(1, 0), a3, voffA);
            PG8_WAIT_V(8); PG8_WAIT_L(0); PG8_BAR; PG8_MMA(1, 0, At, B0); PG8_MMA(1, 1, At, B1); PG8_BAR; PG8_SCHED;
            } else {
            PG8_LDB(B0, 0, 0); PG8_SCHED; PG8_LDA(At, 0, 0); PG8_STAGE(PG8_SA(1, 1), a1 + hstep, voffA);
            PG8_WAIT_L(8); PG8_BAR; PG8_WAIT_L(0); PG8_MMA(0, 0, At, B0); PG8_BAR; PG8_SCHED;
            PG8_LDB(B1, 0, 1); PG8_STAGE(PG8_SB(0, 0), b2, voffB);
            PG8_BAR; PG8_WAIT_L(0); PG8_MMA(0, 1, At, B1); PG8_BAR;
            PG8_LDA(At, 0, 1); PG8_STAGE(PG8_SA(0, 0), a2, voffA);
            PG8_BAR; PG8_WAIT_L(0); PG8_MMA(1, 0, At, B0); PG8_BAR; PG8_SCHED;
            PG8_STAGE(PG8_SB(0, 1), b2 + hstep, voffB);
            PG8_WAIT_V(6); PG8_BAR; PG8_MMA(1, 1, At, B1); PG8_BAR;
            PG8_LDB(B0, 1, 0); PG8_SCHED; PG8_LDA(At, 1, 0); PG8_STAGE(PG8_SA(0, 1), a2 + hstep, voffA);
            PG8_WAIT_L(8); PG8_BAR; PG8_WAIT_L(0); PG8_MMA(0, 0, At, B0); PG8_BAR; PG8_SCHED;
            PG8_LDB(B1, 1, 1); PG8_STAGE(PG8_SB(1, 0), b3, voffB);
            PG8_BAR; PG8_WAIT_L(0); PG8_MMA(0, 1, At, B1); PG8_BAR;
            PG8_LDA(At, 1, 1); PG8_STAGE(PG8_SA(1, 0), a3, voffA);
            PG8_BAR; PG8_WAIT_L(0); PG8_MMA(1, 0, At, B0); PG8_BAR; PG8_SCHED;
            PG8_STAGE(PG8_SB(1, 1), b3 + hstep, voffB);
            PG8_WAIT_V(6); PG8_BAR; PG8_MMA(1, 1, At, B1); PG8_BAR;
            }
        }
        if constexpr (ALIGN_EPI) { if (wr == 0) PG8_BAR; }
        if constexpr (!Epi::AFTER_DRAIN) { E(acc, cur, wr, wc, fr, fq, ui & 1); S.done(cur); if constexpr (Epi::RSL) { if (has_next) E.rs_fetch(nxt, tid, (ui + 1) & 1); } }
        if (!has_next) break;
        { const float z = opaque_zero();
#pragma unroll
        for (int a = 0; a < 2; ++a)
#pragma unroll
            for (int b = 0; b < 2; ++b)
#pragma unroll
                for (int m = 0; m < 4; ++m)
#pragma unroll
                    for (int n = 0; n < 2; ++n) acc[a][b][m][n] = (f32x4){z, z, z, z}; }
        cur = nxt; cA = nA; cB = nB; ++ui;
        if constexpr (ALIGN_EPI) { if (wr == 1) PG8_BAR; }
    }
    PG8_WAIT_V(0);
    if constexpr (!ALIGN_EPI) { if (wr == 0) PG8_BAR; }
    PG8_BAR;
#undef PG8_SA
#undef PG8_SB
#undef PG8_STAGE
#undef PG8_LDA
#undef PG8_LDB
#undef PG8_MMA
#undef PG8_WAIT_V
#undef PG8_WAIT_L
#undef PG8_BAR
#undef PG8_SCHED
}
}

struct SEpiBf16 { bf16* O; int ldc; int act; const float* rstd;
    __device__ __forceinline__ void operator()(int row, int col, f32x4 s0, f32x4 s1) const {
        { const float r_ = rstd[row]; s0 = s0 * r_; s1 = s1 * r_; }
        if (act) {
#pragma unroll
            for (int j = 0; j < 4; ++j) { const float a = fmaxf(s0[j], 0.f), b = fmaxf(s1[j], 0.f); s0[j] = a * a; s1[j] = b * b; } }
        u32x4 w; w.x = cvtpk(s0[0], s0[1]); w.y = cvtpk(s0[2], s0[3]); w.z = cvtpk(s1[0], s1[1]); w.w = cvtpk(s1[2], s1[3]);
        *(u32x4*)(O + (size_t)row * ldc + col) = w; } };
struct SEpiResAdd { bf16* XB; float* Y; int ldc; bool fin;
    __device__ __forceinline__ void operator()(int row, int col, f32x4 s0, f32x4 s1) const {
        const size_t off = (size_t)row * ldc + col; const u32x4 w = *(const u32x4*)(XB + off);
        const f32x4 v0 = (f32x4){bflo(w.x) + s0[0], bfhi(w.x) + s0[1], bflo(w.y) + s0[2], bfhi(w.y) + s0[3]}, v1 = (f32x4){bflo(w.z) + s1[0], bfhi(w.z) + s1[1], bflo(w.w) + s1[2], bfhi(w.w) + s1[3]};
        if (fin) { *(f32x4*)(Y + off) = v0; *(f32x4*)(Y + off + 4) = v1; }
        else { u32x4 o; o.x = cvtpk(v0[0], v0[1]); o.y = cvtpk(v0[2], v0[3]); o.z = cvtpk(v1[0], v1[1]); o.w = cvtpk(v1[2], v1[3]); *(u32x4*)(XB + off) = o; } } };
template <class Epi>
__device__ __forceinline__ void sample_gemm(LAS unsigned char* lds, int wave, int vcu, int G, const bf16* __restrict__ A, const bf16* __restrict__ Bt, int N, int K, const Epi& E) {
    int ln_; asm volatile("v_mbcnt_lo_u32_b32 %0, -1, 0\n\tv_mbcnt_hi_u32_b32 %0, -1, %0" : "=v"(ln_)); const int tid = wave * 64 + ln_;
    const int lane = tid & 63, fr = lane & 15, fq = lane >> 4;
    const int ntiles = 4 * (N >> 6), kslice = K >> 3, kb = wave * kslice;
    LAS float* red = (LAS float*)lds;
    for (int t = vcu; t < ntiles; t += G) {
        const int rt = t & 3, ct = t >> 2;
        f32x4 acc[4][4];
        { const float z = opaque_zero();
#pragma unroll
          for (int m = 0; m < 4; ++m)
#pragma unroll
              for (int n = 0; n < 4; ++n) acc[m][n] = (f32x4){z, z, z, z}; }
        const bf16* ap = A + (size_t)(rt * 64 + fr) * K + kb + 8 * fq;
        const bf16* bp = Bt + (size_t)(ct * 64 + fr) * K + kb + 8 * fq;
        const size_t r16 = (size_t)16 * K;
#pragma unroll 4
        for (int k = 0; k < kslice; k += 64) {
            bf16x8 a0[4], a1[4], b0[4], b1[4];
#pragma unroll
            for (int m = 0; m < 4; ++m) { a0[m] = *(const bf16x8*)(ap + m * r16 + k); a1[m] = *(const bf16x8*)(ap + m * r16 + k + 32); }
#pragma unroll
            for (int n = 0; n < 4; ++n) { b0[n] = *(const bf16x8*)(bp + n * r16 + k); b1[n] = *(const bf16x8*)(bp + n * r16 + k + 32); }
#pragma unroll
            for (int m = 0; m < 4; ++m)
#pragma unroll
                for (int n = 0; n < 4; ++n) { acc[m][n] = __builtin_amdgcn_mfma_f32_16x16x32_bf16(a0[m], b0[n], acc[m][n], 0, 0, 0);
                                              acc[m][n] = __builtin_amdgcn_mfma_f32_16x16x32_bf16(a1[m], b1[n], acc[m][n], 0, 0, 0); }
        }
        __syncthreads();
#pragma unroll
        for (int m = 0; m < 4; ++m)
#pragma unroll
            for (int n = 0; n < 4; ++n)
#pragma unroll
                for (int j = 0; j < 4; ++j) red[wave * 4096 + (16 * m + 4 * fq + j) * 64 + 16 * n + fr] = acc[m][n][j];
        __syncthreads();
        const int row = tid >> 3, col = (tid & 7) * 8;
        f32x4 s0 = *(const LAS f32x4*)(red + row * 64 + col), s1 = *(const LAS f32x4*)(red + row * 64 + col + 4);
#pragma unroll
        for (int w = 1; w < 8; ++w) { s0 = s0 + *(const LAS f32x4*)(red + w * 4096 + row * 64 + col); s1 = s1 + *(const LAS f32x4*)(red + w * 4096 + row * 64 + col + 4); }
        E(rt * 64 + row, ct * 64 + col, s0, s1);
    }
    __syncthreads();
}

#define XB_TMO      128
#define XB_XCNT(j)  (256  + 64 * (j))
#define XB_XSUB(j)  (1280 + 64 * (j))
#define XB_XGEN(j)  (2304 + 64 * (j))
#define XB_TOP      3328
#define XB_TOPGEN   3392
#define XCD_BAR_WORDS 3456
#define XB_SPIN_CAP (1u << 18)
__device__ __forceinline__ unsigned xb_ld(unsigned* p)              { return __hip_atomic_load(p, __ATOMIC_RELAXED, __HIP_MEMORY_SCOPE_AGENT); }
__device__ __forceinline__ unsigned xb_add(unsigned* p, unsigned v) { return __hip_atomic_fetch_add(p, v, __ATOMIC_RELAXED, __HIP_MEMORY_SCOPE_AGENT); }
__device__ __forceinline__ unsigned xb_xcc_id() { return (unsigned)__builtin_amdgcn_s_getreg((3 << 11) | 20) & 0xFu; }
#define XB_SPIN(cond, bar) do { unsigned _sp = 0; while (cond) { __builtin_amdgcn_s_sleep(1); \
    if ((++_sp & 255u) == 0u) { if (xb_ld(&(bar)[XB_TMO])) break; if (_sp > XB_SPIN_CAP) { atomicAdd(&(bar)[XB_TMO], 1u); break; } } } } while (0)
struct XcdBarrier { unsigned* bar; unsigned x; volatile LAS unsigned* st; };
__device__ __forceinline__ XcdBarrier xcd_barrier_post(unsigned* bar, volatile LAS unsigned* st, bool leader) {
    XcdBarrier b; b.bar = bar; b.x = xb_xcc_id(); b.st = st;
    if (leader) (void)xb_add(&bar[XB_XCNT(b.x)], 1u);
    return b;
}
__device__ __forceinline__ void xcd_barrier_complete(unsigned* bar, unsigned x, unsigned& nloc, unsigned& nx) {
    const unsigned G = gridDim.x * gridDim.y * gridDim.z;
    unsigned sum, cnt, mine, sp = 0u;
    for (;;) {
        sum = 0u; cnt = 0u; mine = 0u;
#pragma unroll
        for (unsigned j = 0; j < 16; ++j) { const unsigned c = xb_ld(&bar[XB_XCNT(j)]); sum += c; cnt += (c > 0u) ? 1u : 0u; mine = (j == x) ? c : mine; }
        if (sum == G) break;
        __builtin_amdgcn_s_sleep(1);
        if ((++sp & 255u) == 0u) { if (xb_ld(&bar[XB_TMO])) break; if (sp > XB_SPIN_CAP) { atomicAdd(&bar[XB_TMO], 1u); break; } }
    }
    nloc = mine > 0u ? mine : 1u; nx = cnt > 0u ? cnt : 1u;
}
__device__ __noinline__ void xcd_barrier(unsigned* bar_, unsigned x_, volatile LAS unsigned* st_, int wave_) {
    XcdBarrier b; b.bar = bar_; b.x = x_; b.st = st_;
    int ln_; asm volatile("v_mbcnt_lo_u32_b32 %0, -1, 0\n\tv_mbcnt_hi_u32_b32 %0, -1, %0" : "=v"(ln_)); const bool leader_ = (wave_ == 0) && (ln_ == 0);
    asm volatile("s_waitcnt vmcnt(0)" ::: "memory");
    __syncthreads();
    if (leader_) {
        unsigned* bar = b.bar;
        __builtin_amdgcn_s_waitcnt(0);
        unsigned nloc = b.st[0], nx = b.st[1];
        if (nloc == 0u) { xcd_barrier_complete(bar, b.x, nloc, nx); b.st[0] = nloc; b.st[1] = nx; }
        const unsigned old = xb_add(&bar[XB_XSUB(b.x)], 1u);
        const unsigned gen = old / nloc;
        if (old + 1u == (gen + 1u) * nloc) {
            __builtin_amdgcn_fence(__ATOMIC_RELEASE, "agent");
            asm volatile("s_waitcnt vmcnt(0)" ::: "memory");
            const unsigned og = xb_add(&bar[XB_TOP], 1u);
            const unsigned tg = og / nx;
            if (og + 1u == (tg + 1u) * nx) xb_add(&bar[XB_TOPGEN], 1u);
            else XB_SPIN(xb_ld(&bar[XB_TOPGEN]) == tg, bar);
            __builtin_amdgcn_fence(__ATOMIC_ACQUIRE, "agent");
            xb_add(&bar[XB_XGEN(b.x)], 1u);
            asm volatile("s_waitcnt vmcnt(0)" ::: "memory");
        } else {
            XB_SPIN(xb_ld(&bar[XB_XGEN(b.x)]) == gen, bar);
            __builtin_amdgcn_fence(__ATOMIC_ACQUIRE, "agent");
            asm volatile("s_waitcnt vmcnt(0)" ::: "memory");
        }
    }
    __syncthreads();
}

#define KSWZ(row, colB) ((row) * 256 + ((colB) ^ (((row) & 7) << 4)))
__device__ __forceinline__ int crow(int r, int hi) { return (r & 3) + 8 * (r >> 2) + 4 * hi; }
__device__ __forceinline__ int v_st(int k, int c) { const int kk = (k & ~0xC) | ((k & 4) << 1) | ((k & 8) >> 1); return ((kk >> 3) * 4 + (c >> 5)) * 512 + ((kk & 7) * 32 + (c & 31)) * 2; }
__device__ __forceinline__ int v_rd_base(int lane) { return ((lane & 3) << 3) | (((lane >> 2) & 3) << 6) | (((lane >> 4) & 1) << 5) | (((lane >> 5) & 1) << 8); }
constexpr int v_rd_off(int d0, int ks, int half) { return d0 * 512 + ks * 4096 + half * 2048; }
template <int OFF> __device__ __forceinline__ s16x4 tr_read(int vb) {
    s16x4 r; asm volatile("ds_read_b64_tr_b16 %0, %1 offset:%2" : "=&v"(r) : "v"(vb), "i"(OFF) : "memory"); return r;
}
#define PKLH(L, H) (bf16x8){L[0], L[1], L[2], L[3], H[0], H[1], H[2], H[3]}
template <int D0> __device__ __forceinline__ void pv_one(f32x16& od, int vb, bf16x8 pa0, bf16x8 pa1, bf16x8 pa2, bf16x8 pa3) {
    const s16x4 l0 = tr_read<v_rd_off(D0, 0, 0)>(vb), h0 = tr_read<v_rd_off(D0, 0, 1)>(vb), l1 = tr_read<v_rd_off(D0, 1, 0)>(vb), h1 = tr_read<v_rd_off(D0, 1, 1)>(vb);
    const s16x4 l2 = tr_read<v_rd_off(D0, 2, 0)>(vb), h2 = tr_read<v_rd_off(D0, 2, 1)>(vb), l3 = tr_read<v_rd_off(D0, 3, 0)>(vb), h3 = tr_read<v_rd_off(D0, 3, 1)>(vb);
    asm volatile("s_waitcnt lgkmcnt(0)" ::: "memory"); SBAR();
    od = __builtin_amdgcn_mfma_f32_32x32x16_bf16(pa0, PKLH(l0, h0), od, 0, 0, 0);
    od = __builtin_amdgcn_mfma_f32_32x32x16_bf16(pa1, PKLH(l1, h1), od, 0, 0, 0);
    od = __builtin_amdgcn_mfma_f32_32x32x16_bf16(pa2, PKLH(l2, h2), od, 0, 0, 0);
    od = __builtin_amdgcn_mfma_f32_32x32x16_bf16(pa3, PKLH(l3, h3), od, 0, 0, 0);
}
__device__ __forceinline__ void pv_d0(f32x16* o, int vb, bf16x8 pa0, bf16x8 pa1, bf16x8 pa2, bf16x8 pa3) {
    pv_one<0>(o[0], vb, pa0, pa1, pa2, pa3); pv_one<1>(o[1], vb, pa0, pa1, pa2, pa3); pv_one<2>(o[2], vb, pa0, pa1, pa2, pa3); pv_one<3>(o[3], vb, pa0, pa1, pa2, pa3);
}
template <int D0, int KS> __device__ __forceinline__ bf16x8 tr_frag(int vb) {
    const s16x4 l = tr_read<v_rd_off(D0, KS, 0)>(vb), h = tr_read<v_rd_off(D0, KS, 1)>(vb);
    return PKLH(l, h);
}
__device__ __forceinline__ void qkt(f32x16& p0, f32x16& p1, int Ks  , const bf16x8* qr, int r32, int hi) {
    p0 = f32x16{}; p1 = f32x16{};
#pragma unroll
    for (int d0 = 0; d0 < 8; ++d0) { const int cb = (d0 * 16 + hi * 8) * 2;
        const bf16x8 b0 = *(const LAS bf16x8*)(uintptr_t)(unsigned)(Ks + KSWZ(r32, cb));
        const bf16x8 b1 = *(const LAS bf16x8*)(uintptr_t)(unsigned)(Ks + KSWZ(32 + r32, cb));
        p0 = __builtin_amdgcn_mfma_f32_32x32x16_bf16(b0, qr[d0], p0, 0, 0, 0);
        p1 = __builtin_amdgcn_mfma_f32_32x32x16_bf16(b1, qr[d0], p1, 0, 0, 0); }
}
#define PK4(P, BASE, OUT) do { unsigned a0 = cvtpk(P[BASE + 0], P[BASE + 1]), a1 = cvtpk(P[BASE + 2], P[BASE + 3]);   \
    unsigned b0 = cvtpk(P[BASE + 4], P[BASE + 5]), b1 = cvtpk(P[BASE + 6], P[BASE + 7]);                              \
    auto r0 = __builtin_amdgcn_permlane32_swap(a0, b0, false, false); auto r1 = __builtin_amdgcn_permlane32_swap(a1, b1, false, false); \
    u32x4 w = {r0[0], r1[0], r0[1], r1[1]}; OUT = *reinterpret_cast<bf16x8*>(&w); } while (0)
__device__ __forceinline__ float half_swap_add(float v) { auto rr = __builtin_amdgcn_permlane32_swap(__float_as_uint(v), __float_as_uint(v), false, false); return __uint_as_float(rr[0]) + __uint_as_float(rr[1]); }
__device__ __forceinline__ float half_swap_max(float v) { auto rr = __builtin_amdgcn_permlane32_swap(__float_as_uint(v), __float_as_uint(v), false, false); return fmaxf(__uint_as_float(rr[0]), __uint_as_float(rr[1])); }

struct Args {
    const float* x_prompt; const float* x_sample; const float* cache_k; const float* cache_v; const float* state_conv; const float* state_c; const float* state_n; const float* state_m;
    const float* norm_mix_g; const float* w_in; const float* conv_w; const float* q_norm_g; const float* k_norm_g; const float* rel_bias; const float* b_igate; const float* b_fgate;
    const float* mlstm_norm_g; const float* w_out; const float* norm_mlp_g; const float* w_up; const float* w_down;
    float* out; unsigned char* ws; int ph_lo, ph_hi, rep, pad;
};
struct Ctx {
    LAS unsigned char* lds; int tid, lane, wave, G, vcu;
};
constexpr int NPH_LAYER = 9, NPHASES = DEPTH * NPH_LAYER;
__device__ __forceinline__ int hw_tid(int wave) { int ln; asm volatile("v_mbcnt_lo_u32_b32 %0, -1, 0\n\tv_mbcnt_hi_u32_b32 %0, -1, %0" : "=v"(ln)); return wave * 64 + ln; }
__device__ __forceinline__ Ctx relaunder(const Ctx& c) { Ctx d = c; const int t = hw_tid(c.wave); d.tid = t; d.lane = t & 63; return d; }

__device__ __forceinline__ void transpose_item(const float* W, int K, int ldn, int nblk, bf16* WT, LAS float* scr, int item, int lane, const float* gain = nullptr) {
    const int kb = item / nblk, nb = item % nblk, k0 = 64 * kb, n0 = 32 * nb;
    const int c = lane & 7;
    f32x4 g0 = (f32x4){1.f, 1.f, 1.f, 1.f}, g1 = g0;
    if (gain) { g0 = *(const f32x4*)(gain + k0 + 8 * c); g1 = *(const f32x4*)(gain + k0 + 8 * c + 4); }
#pragma unroll 8
    for (int i = 0; i < 32; ++i) { const int kk = 2 * i + (lane >> 5); scr[kk * 33 + (lane & 31)] = W[(size_t)(k0 + kk) * ldn + n0 + (lane & 31)]; }
    LDS_WAIT(); asm volatile("" ::: "memory");
#pragma unroll
    for (int j = 0; j < 4; ++j) { const int n = (lane >> 3) + 8 * j; const LAS float* s = scr + (8 * c) * 33 + n;
        u32x4 o; o.x = cvtpk(s[0 * 33] * g0[0], s[1 * 33] * g0[1]); o.y = cvtpk(s[2 * 33] * g0[2], s[3 * 33] * g0[3]); o.z = cvtpk(s[4 * 33] * g1[0], s[5 * 33] * g1[1]); o.w = cvtpk(s[6 * 33] * g1[2], s[7 * 33] * g1[3]);
        *(GAS u32x4*)(WT + (size_t)(n0 + n) * K + k0 + 8 * c) = o; }
    LDS_WAIT(); asm volatile("" ::: "memory");
}
__device__ __forceinline__ void convert_weights(const Args& a, const Ctx& c, int l) {
    LAS float* scr = (LAS float*)(c.lds + c.wave * 16384);
    const int gw = c.vcu * NWAVES + c.wave, NGW = c.G * NWAVES;
    constexpr int I_IN = (D / 64) * (NPROJ / 32), I_OUT = (D / 64) * (D / 32), I_UP = (D / 64) * (FF / 32), I_DN = (FF / 64) * (D / 32), I_L = I_IN + I_OUT + I_UP + I_DN;
    for (int it = gw; it < I_L; it += NGW) {
        int r = it;
        if (r < I_IN) { transpose_item(a.w_in + (size_t)l * D * IN_DIM, D, IN_DIM, NPROJ / 32, (bf16*)(a.ws + WS_WIN), scr, r, c.lane, a.norm_mix_g + (size_t)l * D); continue; } r -= I_IN;
        if (r < I_OUT) { transpose_item(a.w_out + (size_t)l * D * D, D, D, D / 32, (bf16*)(a.ws + WS_WOUT), scr, r, c.lane); continue; } r -= I_OUT;
        if (r < I_UP) { transpose_item(a.w_up + (size_t)l * D * FF, D, FF, FF / 32, (bf16*)(a.ws + WS_WUP), scr, r, c.lane, a.norm_mlp_g + (size_t)l * D); continue; } r -= I_UP;
        transpose_item(a.w_down + (size_t)l * FF * D, FF, D, D / 32, (bf16*)(a.ws + WS_WDN), scr, r, c.lane);
    }
}

__device__ __forceinline__ void build_kv_image(const Args& a, int w, int nw, int tid, int l) {
    bf16* SK = (bf16*)(a.ws + WS_SK + (size_t)(l & 1) * SKV_IMG); bf16* SV = (bf16*)(a.ws + WS_SV + (size_t)(l & 1) * SKV_IMG);
    const unsigned gt = (unsigned)w * NTHREADS + tid, NT = (unsigned)nw * NTHREADS;
    constexpr unsigned NCH = (unsigned)SBATCH * 512 * 1024 / 8;
    for (unsigned i = gt; i < 2 * NCH; i += NT) {
        const bool isv = i >= NCH; const unsigned j = isv ? i - NCH : i; const unsigned e = j * 8; const unsigned b = e / (512 * 1024); const unsigned rem = e % (512 * 1024);
        const float* src = (isv ? a.cache_v : a.cache_k) + ((size_t)(l * SBATCH + b) * 512 * 1024) + rem;
        const f32x4 x0 = *(const f32x4*)src, x1 = *(const f32x4*)(src + 4);
        u32x4 w4; w4.x = cvtpk(x0.x, x0.y); w4.y = cvtpk(x0.z, x0.w); w4.z = cvtpk(x1.x, x1.y); w4.w = cvtpk(x1.z, x1.w);
        *(u32x4*)((isv ? SV : SK) + (size_t)b * SKV_ROWS * 1024 + rem) = w4;
    }
    constexpr unsigned NZ = (unsigned)SBATCH * (SKV_ROWS - 544) * 1024 / 8;
    for (unsigned i = gt; i < 2 * NZ; i += NT) {
        const bool isv = i >= NZ; const unsigned j = isv ? i - NZ : i; const unsigned e = j * 8; const unsigned b = e / ((SKV_ROWS - 544) * 1024); const unsigned rem = e % ((SKV_ROWS - 544) * 1024);
        { const unsigned z = __float_as_uint(opaque_zero()); *(u32x4*)((isv ? SV : SK) + ((size_t)b * SKV_ROWS + 544) * 1024 + rem) = (u32x4){z, z, z, z}; }
    }
}
__device__ __forceinline__ float log_sigmoid(float x) { return fminf(x, 0.f) - fast_log(1.0f + fast_exp(-fabsf(x))); }
template <bool FIRST  >
__device__ __forceinline__ void phase_norm(const Args& a, const Ctx& c_in0, int l) {
    const Ctx c = relaunder(c_in0);
    bf16* XB = (bf16*)(a.ws + WS_XB); bf16* H = (bf16*)(a.ws + WS_H);
    const float* g = (FIRST ? a.norm_mix_g : a.norm_mlp_g) + (size_t)l * D;
    LAS float* Wg = (LAS float*)c.lds;
    if (FIRST) {
        convert_weights(a, c, l);
        __syncthreads();
        const float* wsrc = a.w_in + (size_t)l * D * IN_DIM + NPROJ;
        for (int idx = c.tid; idx < 8 * D; idx += NTHREADS) { const int k = idx >> 3, o = idx & 7; Wg[o * D + k] = wsrc[(size_t)k * IN_DIM + o]; }
        __syncthreads();
    }
    const int gw = c.vcu * NWAVES + c.wave, NGW = c.G * NWAVES;
    f32x4 gv[8];
#pragma unroll
    for (int j = 0; j < 8; ++j) gv[j] = *(const f32x4*)(g + 4 * c.lane + 256 * j);
    for (int row = gw; row < MR; row += NGW) {
        f32x4 v[8]; float s = 0.f;
        if (FIRST && l == 0) {
            const float* src = row < MP ? a.x_prompt + (size_t)row * D : a.x_sample + (size_t)(row - MP) * D;
#pragma unroll
            for (int j = 0; j < 8; ++j) v[j] = *(const f32x4*)(src + 4 * c.lane + 256 * j);
#pragma unroll
            for (int j = 0; j < 8; ++j) { u32x2 w; w.x = cvtpk(v[j].x, v[j].y); w.y = cvtpk(v[j].z, v[j].w); *(u32x2*)(XB + (size_t)row * D + 4 * c.lane + 256 * j) = w; }
        } else {
            u32x2 w[8];
#pragma unroll
            for (int j = 0; j < 8; ++j) w[j] = *(const u32x2*)(XB + (size_t)row * D + 4 * c.lane + 256 * j);
#pragma unroll
            for (int j = 0; j < 8; ++j) v[j] = (f32x4){bflo(w[j].x), bfhi(w[j].x), bflo(w[j].y), bfhi(w[j].y)};
        }
#pragma unroll
        for (int j = 0; j < 8; ++j) s += (v[j].x * v[j].x + v[j].y * v[j].y) + (v[j].z * v[j].z + v[j].w * v[j].w);
        const float rstd = fast_rsqrt(wave_sum(s, c.lane) * (1.f / D) + EPS);
        if (c.lane == 0) ((float*)(a.ws + WS_RSTD))[row] = rstd;
        if (FIRST) {
#pragma unroll
            for (int j = 0; j < 8; ++j) v[j] = v[j] * rstd * gv[j];
            float ga[8];
#pragma unroll
            for (int o = 0; o < 8; ++o) { float t = 0.f;
#pragma unroll
                for (int j = 0; j < 8; ++j) { const f32x4 w4 = *(const LAS f32x4*)(Wg + o * D + 4 * c.lane + 256 * j); t += (v[j].x * w4.x + v[j].y * w4.y) + (v[j].z * w4.z + v[j].w * w4.w); }
                ga[o] = wave_sum(t, c.lane); }
            float val = ga[0];
#pragma unroll
            for (int o = 1; o < 8; ++o) val = (c.lane == o) ? ga[o] : val;
            if (c.lane < 8) {
                float r;
                if (c.lane < 4) r = val + a.b_igate[l * MH + c.lane];
                else r = log_sigmoid(val + a.b_fgate[l * MH + c.lane - 4]);
                ((float*)(a.ws + WS_GATE))[(size_t)row * 8 + c.lane] = r;
            }
        }
    }
    if (FIRST && l == 0) build_kv_image(a, c.vcu, c.G, c.tid, 0);
}

__device__ __forceinline__ float scan256_sum(float v, int tid, int lane, int wave, LAS float* tot  ) {
#pragma unroll
    for (int o = 1; o < 64; o <<= 1) { const float t = shup(v, o, lane); if (lane >= o) v += t; }
    if (lane == 63) tot[wave] = v;
    __syncthreads();
    float off = 0.f;
#pragma unroll
    for (int w = 0; w < 3; ++w) off += (w < wave) ? tot[w] : 0.f;
    __syncthreads();
    return v + off;
}
__device__ __forceinline__ float scan256_max(float v, int tid, int lane, int wave, LAS float* tot) {
#pragma unroll
    for (int o = 1; o < 64; o <<= 1) { const float t = shup(v, o, lane); if (lane >= o) v = fmaxf(v, t); }
    if (lane == 63) tot[wave] = v;
    __syncthreads();
    float off = -3.0e38f;
#pragma unroll
    for (int w = 0; w < 3; ++w) off = (w < wave) ? fmaxf(off, tot[w]) : off;
    __syncthreads();
    return fmaxf(v, off);
}

__device__ __forceinline__ void m1_unit(const Args& a, const Ctx& c_in, int l, int unit) {
    const int g = unit & 31, bh = unit >> 5, b = bh >> 2, h = bh & 3;
    const bf16* PROJ = (const bf16*)(a.ws + WS_BIG);
    const float* GATE = (const float*)(a.ws + WS_GATE);
    Ctx c = c_in; { int t_ = c.tid; asm volatile("" : "+v"(t_)); c.tid = t_; c.lane = t_ & 63; }
    LAS float* scr = (LAS float*)(c.lds + SCR_OFF);
    LAS float* W_S = scr;
    LAS float* NACC = scr + 256;
    LAS float* TOT = scr + 384;
    LAS float* SCAL = scr + 392;
    const int row0 = b * SEQ + g * 256;
    __syncthreads();
    float li = 0.f, lf = 0.f;
    if (c.tid < 256) { li = GATE[(size_t)(row0 + c.tid) * 8 + h]; lf = GATE[(size_t)(row0 + c.tid) * 8 + 4 + h]; }
    const float bc = scan256_sum(lf, c.tid, c.lane, c.wave, TOT);
    const float as = li - bc;
    const float am = scan256_max(c.tid < 256 ? as : -3.0e38f, c.tid, c.lane, c.wave, TOT);
    if (c.tid == 255) { SCAL[0] = am; SCAL[1] = bc; }
    __syncthreads();
    const float amax = SCAL[0], blast = SCAL[1];
    if (c.tid < 256) W_S[c.tid] = fast_exp(as - amax);
    __syncthreads();
    const int sr = c.tid >> 4, sc = (c.tid & 15) * 8;
#pragma unroll
    for (int t = 0; t < 4; ++t)
#pragma unroll
        for (int hh = 0; hh < 2; ++hh) {
            const int rr = t * 64 + hh * 32 + sr; const size_t ro = (size_t)(row0 + rr) * NPROJ;
            const u32x4 kq = *(const u32x4*)(PROJ + ro + C_MK + h * HD + sc);
            const u32x4 vq = *(const u32x4*)(PROJ + ro + C_MV + h * HD + sc);
            const float w = W_S[rr] * 0.08838834764831845f;
            float kf[8] = {bflo(kq.x) * w, bfhi(kq.x) * w, bflo(kq.y) * w, bfhi(kq.y) * w, bflo(kq.z) * w, bfhi(kq.z) * w, bflo(kq.w) * w, bfhi(kq.w) * w};
            u32x4 kw; kw.x = cvtpk(kf[0], kf[1]); kw.y = cvtpk(kf[2], kf[3]); kw.z = cvtpk(kf[4], kf[5]); kw.w = cvtpk(kf[6], kf[7]);
            *(LAS u32x4*)(c.lds + t * 16384 + v_st(hh * 32 + sr, sc)) = kw;
            *(LAS u32x4*)(c.lds + 65536 + t * 16384 + v_st(hh * 32 + sr, sc)) = vq;
        }
    __syncthreads();
    if (c.tid < 128) {
        float s = 0.f;
        for (int k = 0; k < 256; ++k) s += bf2f(*(const LAS bf16*)(c.lds + (k >> 6) * 16384 + v_st(k & 63, c.tid)));
        NACC[c.tid] = s;
    }
    __syncthreads();
    const int Da = c.wave >> 1, Db0 = 2 * (c.wave & 1);
    f32x16 acc0 = f32x16{}, acc1 = f32x16{};
    const int vbk = (int)(uintptr_t)(c.lds) + v_rd_base(c.lane) + Da * 512;
    const int vbv = (int)(uintptr_t)(c.lds) + 65536 + v_rd_base(c.lane) + Db0 * 512;
#pragma unroll
    for (int t = 0; t < 4; ++t) {
        const int ak = vbk + t * 16384, av = vbv + t * 16384;
        const bf16x8 a0 = tr_frag<0, 0>(ak), a1 = tr_frag<0, 1>(ak), a2 = tr_frag<0, 2>(ak), a3 = tr_frag<0, 3>(ak);
        const bf16x8 b00 = tr_frag<0, 0>(av), b01 = tr_frag<0, 1>(av), b02 = tr_frag<0, 2>(av), b03 = tr_frag<0, 3>(av);
        const bf16x8 b10 = tr_frag<1, 0>(av), b11 = tr_frag<1, 1>(av), b12 = tr_frag<1, 2>(av), b13 = tr_frag<1, 3>(av);
        asm volatile("s_waitcnt lgkmcnt(0)" ::: "memory"); SBAR();
        acc0 = __builtin_amdgcn_mfma_f32_32x32x16_bf16(a0, b00, acc0, 0, 0, 0); acc1 = __builtin_amdgcn_mfma_f32_32x32x16_bf16(a0, b10, acc1, 0, 0, 0);
        acc0 = __builtin_amdgcn_mfma_f32_32x32x16_bf16(a1, b01, acc0, 0, 0, 0); acc1 = __builtin_amdgcn_mfma_f32_32x32x16_bf16(a1, b11, acc1, 0, 0, 0);
        acc0 = __builtin_amdgcn_mfma_f32_32x32x16_bf16(a2, b02, acc0, 0, 0, 0); acc1 = __builtin_amdgcn_mfma_f32_32x32x16_bf16(a2, b12, acc1, 0, 0, 0);
        acc0 = __builtin_amdgcn_mfma_f32_32x32x16_bf16(a3, b03, acc0, 0, 0, 0); acc1 = __builtin_amdgcn_mfma_f32_32x32x16_bf16(a3, b13, acc1, 0, 0, 0);
    }
    float* CL = (float*)(a.ws + WS_CLOC) + (size_t)unit * HD * HD;
    const int r32 = c.lane & 31, hi = c.lane >> 5;
#pragma unroll
    for (int r = 0; r < 16; ++r) { const int d = 32 * Da + crow(r, hi);
        CL[(size_t)d * HD + 32 * Db0 + r32] = acc0[r]; CL[(size_t)d * HD + 32 * (Db0 + 1) + r32] = acc1[r]; }
    if (c.tid < 128) ((float*)(a.ws + WS_NLOC))[(size_t)unit * HD + c.tid] = NACC[c.tid];
    if (c.tid == 0) { float* ms = (float*)(a.ws + WS_MSC) + (size_t)unit * 4; ms[0] = blast + amax; ms[1] = blast; }
}

__device__ __forceinline__ void sample_mixers(const Args& a, const Ctx& c, int l);
template <bool WITH_QK>
__device__ __forceinline__ void phase_c(const Args& a, const Ctx& c_in0, int l) {
    const Ctx c = relaunder(c_in0);
    bf16* PROJ = (bf16*)(a.ws + WS_BIG); bf16* MIX = (bf16*)(a.ws + WS_H);
    constexpr int WSMP = SBATCH * NH + SBATCH * MH;
    const bool split = c.G > 2 * WSMP;
    if (WITH_QK && (!split || c.vcu < WSMP)) sample_mixers(a, c, l);
    for (int u = c.vcu; u < 16 * NGRP; u += c.G) m1_unit(a, c, l, u);
    const int gw = c.vcu * NWAVES + c.wave, NGW = c.G * NWAVES;
    if (WITH_QK) {
        const float* gq = a.q_norm_g + l * HD; const float* gk = a.k_norm_g + l * HD;
        const int gi = (16 * c.lane) & 127;
        f32x4 gqv[4], gkv[4];
#pragma unroll
        for (int j = 0; j < 4; ++j) { gqv[j] = *(const f32x4*)(gq + gi + 4 * j); gkv[j] = *(const f32x4*)(gk + gi + 4 * j); }
        bf16* SK = (bf16*)(a.ws + WS_SK + (size_t)(l & 1) * SKV_IMG); bf16* SV = (bf16*)(a.ws + WS_SV + (size_t)(l & 1) * SKV_IMG);
        constexpr int NIT = NB * KEEP;
        for (int it = gw; it < NIT; it += NGW) {
            const int row = (it / KEEP) * SEQ + (SEQ - KEEP) + (it % KEEP);
            const bf16* p = PROJ + (size_t)row * NPROJ + C_K + 16 * c.lane;
            const u32x4 w0 = *(const u32x4*)p, w1 = *(const u32x4*)(p + 8);
            const bf16* pv = PROJ + (size_t)row * NPROJ + C_V + 16 * c.lane;
            const u32x4 v0 = *(const u32x4*)pv, v1 = *(const u32x4*)(pv + 8);
            const int b = row / SEQ, t = row % SEQ; const size_t o = ((size_t)(l * NB + b) * KEEP + (t - (SEQ - KEEP))) * 1024 + 16 * c.lane;
            float* ok = a.out + O_PK + o; float* ov = a.out + O_PV + o;
            *(f32x4*)(ok + 0) = (f32x4){bflo(w0.x), bfhi(w0.x), bflo(w0.y), bfhi(w0.y)}; *(f32x4*)(ok + 4) = (f32x4){bflo(w0.z), bfhi(w0.z), bflo(w0.w), bfhi(w0.w)};
            *(f32x4*)(ok + 8) = (f32x4){bflo(w1.x), bfhi(w1.x), bflo(w1.y), bfhi(w1.y)}; *(f32x4*)(ok + 12) = (f32x4){bflo(w1.z), bfhi(w1.z), bflo(w1.w), bfhi(w1.w)};
            *(f32x4*)(ov + 0) = (f32x4){bflo(v0.x), bfhi(v0.x), bflo(v0.y), bfhi(v0.y)}; *(f32x4*)(ov + 4) = (f32x4){bflo(v0.z), bfhi(v0.z), bflo(v0.w), bfhi(v0.w)};
            *(f32x4*)(ov + 8) = (f32x4){bflo(v1.x), bfhi(v1.x), bflo(v1.y), bfhi(v1.y)}; *(f32x4*)(ov + 12) = (f32x4){bflo(v1.z), bfhi(v1.z), bflo(v1.w), bfhi(v1.w)};
        }
    }
    {
        const int ch = 8 * c.lane;
        float w0[8], w1[8], w2[8];
#pragma unroll
        for (int i = 0; i < 8; ++i) { w0[i] = a.conv_w[(size_t)(l * 3 + 0) * 512 + ch + i]; w1[i] = a.conv_w[(size_t)(l * 3 + 1) * 512 + ch + i]; w2[i] = a.conv_w[(size_t)(l * 3 + 2) * 512 + ch + i]; }
        constexpr int NSEG = SEQ / 32, NITEM = NB * NSEG + SBATCH;
        const int gwc = split ? (c.vcu - WSMP) * NWAVES + c.wave : gw, NGWc = split ? (c.G - WSMP) * NWAVES : NGW;
        for (int it = gwc; it >= 0 && it < NITEM; it += NGWc) {
            float u2[8], u1[8]; int rowb; bool samp = it >= NB * NSEG; int b, seg = 0;
            if (!samp) { b = it / NSEG; seg = it % NSEG; rowb = b * SEQ + seg * 32; } else { b = it - NB * NSEG; rowb = MP + b * SSEQ; }
#pragma unroll
            for (int i = 0; i < 8; ++i) { u2[i] = 0.f; u1[i] = 0.f; }
            if (samp) {
#pragma unroll
                for (int i = 0; i < 8; ++i) { u2[i] = a.state_conv[((size_t)(l * SBATCH + b) * 2 + 0) * 512 + ch + i]; u1[i] = a.state_conv[((size_t)(l * SBATCH + b) * 2 + 1) * 512 + ch + i]; }
            } else if (seg > 0) {
#pragma unroll
                for (int q = 0; q < 2; ++q) { const bf16* pr = PROJ + (size_t)(rowb - 2 + q) * NPROJ + ch;
                    const u32x4 xa = *(const u32x4*)(pr + C_XA), gc = *(const u32x4*)(pr + C_GC);
                    float* dst = q ? u1 : u2;
                    dst[0] = bflo(xa.x) * bflo(gc.x); dst[1] = bfhi(xa.x) * bfhi(gc.x); dst[2] = bflo(xa.y) * bflo(gc.y); dst[3] = bfhi(xa.y) * bfhi(gc.y);
                    dst[4] = bflo(xa.z) * bflo(gc.z); dst[5] = bfhi(xa.z) * bfhi(gc.z); dst[6] = bflo(xa.w) * bflo(gc.w); dst[7] = bfhi(xa.w) * bfhi(gc.w); }
            }
            for (int t0 = 0; t0 < 32; t0 += 4) {
                u32x4 xa4[4], gb4[4], gc4[4];
#pragma unroll
                for (int q = 0; q < 4; ++q) { const bf16* pr = PROJ + (size_t)(rowb + t0 + q) * NPROJ + ch; xa4[q] = *(const u32x4*)(pr + C_XA); gb4[q] = *(const u32x4*)(pr + C_GB); gc4[q] = *(const u32x4*)(pr + C_GC); }
#pragma unroll
                for (int q = 0; q < 4; ++q) { const int t = t0 + q;
                const u32x4 xa = xa4[q], gb = gb4[q], gc = gc4[q];
                float u0[8] = {bflo(xa.x) * bflo(gc.x), bfhi(xa.x) * bfhi(gc.x), bflo(xa.y) * bflo(gc.y), bfhi(xa.y) * bfhi(gc.y),
                               bflo(xa.z) * bflo(gc.z), bfhi(xa.z) * bfhi(gc.z), bflo(xa.w) * bflo(gc.w), bfhi(xa.w) * bfhi(gc.w)};
                float gbf[8] = {bflo(gb.x), bfhi(gb.x), bflo(gb.y), bfhi(gb.y), bflo(gb.z), bfhi(gb.z), bflo(gb.w), bfhi(gb.w)};
                float y[8];
#pragma unroll
                for (int i = 0; i < 8; ++i) { y[i] = gbf[i] * (w0[i] * u2[i] + w1[i] * u1[i] + w2[i] * u0[i]); u2[i] = u1[i]; u1[i] = u0[i]; }
                u32x4 o; o.x = cvtpk(y[0], y[1]); o.y = cvtpk(y[2], y[3]); o.z = cvtpk(y[4], y[5]); o.w = cvtpk(y[6], y[7]);
                *(u32x4*)(MIX + (size_t)(rowb + t) * D + ch) = o;
                }
            }
            float* oc = nullptr;
            if (samp) oc = a.out + O_SCONV + (size_t)(l * SBATCH + b) * 2 * 512 + ch;
            else if (seg == NSEG - 1) oc = a.out + O_PCONV + (size_t)(l * NB + b) * 2 * 512 + ch;
            if (oc) {
                *(f32x4*)(oc) = (f32x4){u2[0], u2[1], u2[2], u2[3]}; *(f32x4*)(oc + 4) = (f32x4){u2[4], u2[5], u2[6], u2[7]};
                *(f32x4*)(oc + 512) = (f32x4){u1[0], u1[1], u1[2], u1[3]}; *(f32x4*)(oc + 516) = (f32x4){u1[4], u1[5], u1[6], u1[7]};
            }
        }
    }
}

__device__ __forceinline__ void phase_d(const Args& a, const Ctx& c_in0, int l) {
    const Ctx c = relaunder(c_in0);
    const float* CL = (const float*)(a.ws + WS_CLOC); const float* NL = (const float*)(a.ws + WS_NLOC); float* MSC = (float*)(a.ws + WS_MSC);
    bf16* C0 = (bf16*)(a.ws + WS_C0); float* N0 = (float*)(a.ws + WS_N0);
    LAS float* DEC = (LAS float*)(c.lds + SCR_OFF);
    LAS float* WLO = DEC + 512;
    LAS float* MFIN = WLO + 512;
    LAS float* MLO = MFIN + 16;
    LAS float* BLA = MLO + 512;
    __syncthreads();
    { const int u = c.tid; MLO[u] = MSC[(size_t)u * 4 + 0]; BLA[u] = MSC[(size_t)u * 4 + 1]; }
    __syncthreads();
    if (c.tid < 16) { const int bh = c.tid; float m = 0.f;
        for (int g = 0; g < NGRP; ++g) { const size_t u = (size_t)bh * NGRP + g; const float mloc = MLO[u], blast = BLA[u];
            const float mn = fmaxf(blast + m, mloc); DEC[bh * NGRP + g] = fast_exp(blast + m - mn); WLO[bh * NGRP + g] = fast_exp(mloc - mn);
            if (c.vcu == 0) MSC[u * 4 + 2] = m;
            m = mn; }
        MFIN[bh] = m; }
    __syncthreads();
    const unsigned gt = (unsigned)c.vcu * NTHREADS + c.tid, NT = (unsigned)c.G * NTHREADS;
    constexpr unsigned PER = (unsigned)HD * HD + HD;
    for (unsigned i = gt; i < 16u * PER; i += NT) {
        const int bh = (int)(i / PER); const int e = (int)(i % PER); const bool isn = e >= HD * HD; const int en = e - HD * HD;
        const float* src = isn ? NL + (size_t)bh * NGRP * HD + en : CL + (size_t)bh * NGRP * HD * HD + e;
        const size_t sstep = isn ? HD : (size_t)HD * HD;
        float x[NGRP];
#pragma unroll
        for (int g = 0; g < NGRP; ++g) x[g] = src[(size_t)g * sstep];
        float C = 0.f;
#pragma unroll
        for (int g = 0; g < NGRP; ++g) {
            const size_t u = (size_t)bh * NGRP + g;
            if (isn) N0[u * HD + en] = C; else C0[u * HD * HD + e] = (bf16)(cvtpk(C, 0.f) & 0xffffu);
            C = DEC[bh * NGRP + g] * C + WLO[bh * NGRP + g] * x[g];
        }
        const int b = bh >> 2, h = bh & 3;
        if (isn) a.out[O_PN + ((size_t)(l * NB + b) * MH + h) * HD + en] = C;
        else a.out[O_PC + ((size_t)(l * NB + b) * MH + h) * HD * HD + e] = C;
        if (e == 0) a.out[O_PM + (size_t)(l * NB + b) * MH + h] = MFIN[bh];
    }
}

constexpr float ATT_C = 0.088388347648318440f * LOG2E;
constexpr float THR2 = 8.f * LOG2E;
struct DmaMap { unsigned k0, k1, v0, v1; };
__device__ __forceinline__ DmaMap dma_map(int lane, int wave, int LD) {
    DmaMap m; unsigned kk_[2], vv_[2];
#pragma unroll
    for (int i = 0; i < 2; ++i) { const int o = (wave + 8 * i) * 1024 + lane * 16;
        const int row = o >> 8, c16 = ((o >> 4) & 15) ^ (row & 7); kk_[i] = (unsigned)(row * LD + c16 * 8) * 2u;
        const int sub = o >> 9, kk = ((sub >> 2) << 3) | ((o >> 6) & 7), k = (kk & ~0xC) | ((kk & 4) << 1) | ((kk & 8) >> 1), cc = ((sub & 3) << 5) | ((o & 63) >> 1); vv_[i] = (unsigned)(k * LD + cc) * 2u; }
    m.k0 = kk_[0]; m.k1 = kk_[1]; m.v0 = vv_[0]; m.v1 = vv_[1]; return m;
}
__device__ __forceinline__ void glds16s(const void* sbase, unsigned voff, unsigned lds_dst) { unsigned keep;
    asm volatile("s_mov_b32 %0, m0\n\ts_mov_b32 m0, %3\n\ts_nop 0\n\tglobal_load_lds_dwordx4 %1, %2\n\ts_mov_b32 m0, %0" : "=&s"(keep) : "v"(voff), "s"(sbase), "s"(lds_dst) : "memory"); }
__device__ __forceinline__ void dma_fill(LAS unsigned char* lds, int slot, int wave, const bf16* Ta, unsigned a0, unsigned a1, const bf16* Tb, unsigned b0, unsigned b1) {
    const unsigned d = (unsigned)(uintptr_t)lds + (unsigned)(slot * 32768 + wave * 1024);
    glds16s(Ta, a0, d); glds16s(Ta, a1, d + 8192u); glds16s(Tb, b0, d + 16384u); glds16s(Tb, b1, d + 24576u);
}
#define RING_WAIT_BAR(N) do { asm volatile("s_waitcnt vmcnt(" #N ") lgkmcnt(0)" ::: "memory"); __builtin_amdgcn_s_barrier(); asm volatile("" ::: "memory"); } while (0)

__device__ __forceinline__ float fma_s(float a, float b, float c) { float d; asm("v_fma_f32 %0, %1, %2, %3" : "=v"(d) : "v"(a), "v"(b), "v"(c)); return d; }
__device__ __forceinline__ float add_s(float a, float b) { float d; asm("v_add_f32 %0, %1, %2" : "=v"(d) : "v"(a), "v"(b)); return d; }
#define ATT_SCORE_SOFTMAX(j, slotk)                                                                                                           \
    {   const int K_lds = ldsb + (slotk) * 16384;                                                                                              \
        f32x16 p0, p1; qkt(p0, p1, K_lds, qr, r32, hi);                                                                                       \
        STEP_FILL();                                                             \
        const int Rl = R0 + r32 - 64 * (j);                                                                                                   \
        const int relmin = R0 - 64 * (j) - 63;                                                                                                \
        if (relmin >= 128) { const float bc = BR[0];                                                                                           \
            _Pragma("unroll") for (int r = 0; r < 16; ++r) { p0[r] = fma_s(p0[r], ATT_C, bc); p1[r] = fma_s(p1[r], ATT_C, bc); }                \
        } else {                                                                                                                               \
            const LAS float* bp = BR + (64 + 128 - Rl + 4 * hi);                                                                               \
            _Pragma("unroll") for (int r = 0; r < 16; ++r) { p0[r] = fma_s(p0[r], ATT_C, bp[(r & 3) + 8 * (r >> 2)]); p1[r] = fma_s(p1[r], ATT_C, bp[32 + (r & 3) + 8 * (r >> 2)]); } \
        }                                                                                                                                      \
        const int nvalid = kend - 64 * (j);                                                                                                    \
        if (nvalid < 64) { asm volatile("" ::: "memory");                           \
            _Pragma("unroll") for (int r = 0; r < 16; ++r) { const int kk = crow(r, hi); if (kk >= nvalid) p0[r] = -1e30f; if (kk + 32 >= nvalid) p1[r] = -1e30f; } \
        }                                                                                                                                      \
        float pmax = p0[0];                                                                                                                    \
        _Pragma("unroll") for (int r = 1; r < 16; ++r) pmax = fmaxf(pmax, p0[r]);                                                              \
        _Pragma("unroll") for (int r = 0; r < 16; ++r) pmax = fmaxf(pmax, p1[r]);                                                              \
        pmax = half_swap_max(pmax);                                                                                                            \
        if (!__all(pmax - m_reg <= THR2)) {                                                                                                    \
            const float mn = fmaxf(m_reg, pmax); const float alpha = __builtin_amdgcn_exp2f(m_reg - mn); m_reg = mn;                           \
            l_reg *= alpha;                                                                                                                    \
            if (hi == 0) al_l[r32] = alpha; asm volatile("s_waitcnt lgkmcnt(0)" ::: "memory");                                               \
            _Pragma("unroll") for (int r = 0; r < 16; ++r) { const float al = al_l[crow(r, hi)];                                               \
                _Pragma("unroll") for (int d = 0; d < 4; ++d) o[d][r] *= al; }                                                                 \
        }                                                                                                                                      \
        float ps = 0.f;                                                                                                                        \
        _Pragma("unroll") for (int r = 0; r < 16; ++r) { p0[r] = __builtin_amdgcn_exp2f(p0[r] - m_reg); p1[r] = __builtin_amdgcn_exp2f(p1[r] - m_reg); ps = add_s(ps, add_s(p0[r], p1[r])); } \
        l_reg += half_swap_add(ps);                                                                                                            \
        PK4(p0, 0, pa0); PK4(p0, 8, pa1); PK4(p1, 0, pa2); PK4(p1, 8, pa3);                                                                    \
    }
__device__ __forceinline__ void attn_unit(const Ctx& c, const bf16* __restrict__ Qb, int LDQ, int qrow, const bf16* __restrict__ Kh, const bf16* __restrict__ Vh, int LDK, int NT, int alo, int ahi, int kend,
                                          int R0  , const float* __restrict__ bias_g, bf16* __restrict__ Ob, int LDO, bool do_store, const float* __restrict__ qgain = nullptr, int rot = 0) {
    int tid = c.tid; asm volatile("" : "+v"(tid));
    const int wid = c.wave, lane = tid & 63, r32 = lane & 31, hi = lane >> 5;
    const int ldsb = (int)(uintptr_t)c.lds;
    constexpr int VRING = 49152;
    LAS float* wsf = (LAS float*)(c.lds + 114688) + wid * 64; LAS float* li_l = wsf; LAS float* al_l = wsf + 32;
    LAS float* BR = (LAS float*)(c.lds + SCR_OFF);
    asm volatile("s_waitcnt lgkmcnt(0)" ::: "memory"); __builtin_amdgcn_s_barrier(); asm volatile("" ::: "memory");
    const DmaMap dm = dma_map(lane, wid, LDK);
    const size_t tile_step = (size_t)64 * LDK;
    const unsigned dbase = (unsigned)ldsb + (unsigned)wid * 1024u;
#define ATT_FILL(kt_, vt_, sk_, sv_) do { const unsigned dk_ = dbase + (unsigned)(sk_) * 16384u, dv_ = dbase + VRING + (unsigned)(sv_) * 16384u; \
        glds16s(kt_, dm.k0, dk_); glds16s(kt_, dm.k1, dk_ + 8192u); glds16s(vt_, dm.v0, dv_); glds16s(vt_, dm.v1, dv_ + 8192u); } while (0)
#define TIDX(s_) ((s_) + rot - (((s_) + rot) >= NT ? NT : 0))
    { const int t0_ = TIDX(0), t1_ = TIDX(1);
      ATT_FILL(Kh + t0_ * tile_step, Vh + t0_ * tile_step, 0, 0);
      ATT_FILL(Kh + t1_ * tile_step, Vh + t1_ * tile_step, 1, 1); }
    if (tid < 321) { const int i = tid - 64; BR[tid] = bias_g[256 - (i < 0 ? 0 : i)] * LOG2E; }
    float m_reg = -1e30f, l_reg = 0.f; f32x16 o[4] = {f32x16{}, f32x16{}, f32x16{}, f32x16{}}; bf16x8 qr[8];
    { const bf16* Qw = Qb + (size_t)(qrow + r32) * LDQ + hi * 8;
#pragma unroll
      for (int d0 = 0; d0 < 8; ++d0) qr[d0] = *(const bf16x8*)(Qw + d0 * 16); }
    if (qgain) {
        float f[8][8]; float ss = 0.f;
#pragma unroll
        for (int d0 = 0; d0 < 8; ++d0) { const u32x4 w = *reinterpret_cast<const u32x4*>(&qr[d0]);
            f[d0][0] = bflo(w.x); f[d0][1] = bfhi(w.x); f[d0][2] = bflo(w.y); f[d0][3] = bfhi(w.y); f[d0][4] = bflo(w.z); f[d0][5] = bfhi(w.z); f[d0][6] = bflo(w.w); f[d0][7] = bfhi(w.w);
#pragma unroll
            for (int i = 0; i < 8; ++i) ss += f[d0][i] * f[d0][i]; }
        ss = half_swap_add(ss);
        const float rq = fast_rsqrt(ss * (1.f / HD) + EPS);
#pragma unroll
        for (int d0 = 0; d0 < 8; ++d0) { const f32x4 g0 = *(const f32x4*)(qgain + d0 * 16 + hi * 8), g1 = *(const f32x4*)(qgain + d0 * 16 + hi * 8 + 4);
            u32x4 s; s.x = cvtpk(f[d0][0] * rq * g0[0], f[d0][1] * rq * g0[1]); s.y = cvtpk(f[d0][2] * rq * g0[2], f[d0][3] * rq * g0[3]);
            s.z = cvtpk(f[d0][4] * rq * g1[0], f[d0][5] * rq * g1[1]); s.w = cvtpk(f[d0][6] * rq * g1[2], f[d0][7] * rq * g1[3]);
            qr[d0] = *reinterpret_cast<bf16x8*>(&s); }
    }
#pragma unroll
    for (int d0 = 0; d0 < 8; ++d0) { u32x4 w = *reinterpret_cast<u32x4*>(&qr[d0]); asm volatile("" : "+v"(w)); qr[d0] = *reinterpret_cast<bf16x8*>(&w); }
    asm volatile("" ::: "memory");
    const bool skew = wid >= 4;
    bf16x8 pa0 = bf16x8{}, pa1 = bf16x8{}, pa2 = bf16x8{}, pa3 = bf16x8{};
    int sk = 0, sv = 0;
    bool pact = false;
    for (int j = 0; j < NT; ++j) {
        if (j + 1 < NT) RING_WAIT_BAR(4); else RING_WAIT_BAR(0);
#define STEP_FILL() do { if (j + 2 < NT) { const int fk = sk >= 1 ? sk - 1 : 2, fv = sv >= 2 ? sv - 2 : sv + 2; const int tf = TIDX(j + 2); ATT_FILL(Kh + tf * tile_step, Vh + tf * tile_step, fk, fv); } } while (0)
        const int jt = TIDX(j);
        const bool act = (jt >= alo && jt <= ahi);
        if (skew && pact) { const int svp = sv >= 1 ? sv - 1 : 3; pv_d0(o, ldsb + VRING + svp * 16384 + v_rd_base(lane), pa0, pa1, pa2, pa3); }
        pact = act;
        if (act) { ATT_SCORE_SOFTMAX(jt, sk); } else STEP_FILL();
        if (!skew && act) pv_d0(o, ldsb + VRING + sv * 16384 + v_rd_base(lane), pa0, pa1, pa2, pa3);
        sk = sk == 2 ? 0 : sk + 1; sv = (sv + 1) & 3;
    }
    if (skew && pact) { const int svp = sv >= 1 ? sv - 1 : 3; pv_d0(o, ldsb + VRING + svp * 16384 + v_rd_base(lane), pa0, pa1, pa2, pa3); }
#undef STEP_FILL
#undef TIDX
#undef ATT_FILL
    if (hi == 0) li_l[r32] = l_reg;
    RING_WAIT_BAR(0);
    const int ost = ldsb + wid * 8192;
#pragma unroll
    for (int r = 0; r < 16; ++r) { const int orow = crow(r, hi); const float rl = __builtin_amdgcn_rcpf(li_l[orow]);
#pragma unroll
        for (int d0 = 0; d0 < 4; ++d0) *(LAS bf16*)(uintptr_t)(unsigned)(ost + orow * 256 + (d0 * 32 + r32) * 2) = (bf16)(cvtpk(o[d0][r] * rl, 0.f) & 0xffffu); }
    asm volatile("s_waitcnt lgkmcnt(0)" ::: "memory");
    if (do_store) {
#pragma unroll
        for (int i = 0; i < 8; ++i) { const int ch = i * 64 + lane, row = ch >> 4, c16 = ch & 15;
            const u32x4 w = *(const LAS u32x4*)(uintptr_t)(unsigned)(ost + row * 256 + c16 * 16);
            *(u32x4*)(Ob + (size_t)(qrow + row) * LDO + c16 * 8) = w; }
    }
}
#undef ATT_SCORE_SOFTMAX

__device__ __forceinline__ void m3_unit(const Args& a, const Ctx& c, int l, int unit) {
    const int g = unit & 31, bh = unit >> 5, b = bh >> 2, h = bh & 3;
    const bf16* PROJ = (const bf16*)(a.ws + WS_BIG); bf16* MIX = (bf16*)(a.ws + WS_H);
    const float* GATE = (const float*)(a.ws + WS_GATE);
    int tid = c.tid; asm volatile("" : "+v"(tid));
    const int wid = c.wave, lane = tid & 63, r32 = lane & 31, hi = lane >> 5;
    LAS float* scr = (LAS float*)(c.lds + SCR_OFF);
    LAS float* A_S = scr;
    LAS float* M_T = scr + 256;
    LAS float* B_T = scr + 512;
    LAS float* N0L = scr + 768;
    LAS float* TOT = scr + 896;
    const int ldsb = (int)(uintptr_t)c.lds;
    LAS float* wsf = (LAS float*)(c.lds + 98304) + wid * 64;
    const int row0 = b * SEQ + g * 256;
    const float m0 = ((const float*)(a.ws + WS_MSC))[(size_t)unit * 4 + 2];
    asm volatile("s_waitcnt vmcnt(0) lgkmcnt(0)" ::: "memory"); __builtin_amdgcn_s_barrier(); asm volatile("" ::: "memory");
    const DmaMap dm = dma_map(lane, wid, NPROJ); const DmaMap dc = dma_map(lane, wid, HD);
    const bf16* kt = PROJ + (size_t)row0 * NPROJ + C_MK + h * HD; const bf16* vt = PROJ + (size_t)row0 * NPROJ + C_MV + h * HD;
    const bf16* C0 = (const bf16*)(a.ws + WS_C0) + (size_t)unit * HD * HD;
    const size_t tile_step = (size_t)64 * NPROJ;
    dma_fill(c.lds, 0, wid, kt, dm.k0, dm.k1, vt, dm.v0, dm.v1);
    dma_fill(c.lds, 1, wid, kt + tile_step, dm.k0, dm.k1, vt + tile_step, dm.v0, dm.v1);
    float li = 0.f, lf = 0.f;
    if (tid < 256) { li = GATE[(size_t)(row0 + tid) * 8 + h]; lf = GATE[(size_t)(row0 + tid) * 8 + 4 + h]; }
    if (tid < 128) N0L[tid] = ((const float*)(a.ws + WS_N0))[(size_t)unit * HD + tid];
    const float bc = scan256_sum(lf, tid, lane, wid, TOT);
    const float as = li - bc;
    const float cm = scan256_max(tid < 256 ? as : -3.0e38f, tid, lane, wid, TOT);
    if (tid < 256) { A_S[tid] = as; M_T[tid] = fmaxf(m0, cm); B_T[tid] = bc; }
    bf16x8 qr[8];
    const int trow = wid * 32 + r32;
    { const bf16* Qw = PROJ + (size_t)(row0 + trow) * NPROJ + C_MQ + h * HD + hi * 8;
#pragma unroll
      for (int d0 = 0; d0 < 8; ++d0) qr[d0] = *(const bf16x8*)(Qw + d0 * 16); }
    __syncthreads();
    const float Mt = M_T[trow];
    f32x16 o[4] = {f32x16{}, f32x16{}, f32x16{}, f32x16{}};
    float rowsum = 0.f, qn = 0.f;
    const float winter = fast_exp(m0 - Mt);
    const int ci = wid >> 1;
    int slot = 0;
#pragma unroll 1
    for (int j = 0; j < 4; ++j) {
        RING_WAIT_BAR(4);
        { const int fs = slot >= 1 ? slot - 1 : 2;
          if (j + 2 < 4) dma_fill(c.lds, fs, wid, kt + (size_t)(j + 2) * tile_step, dm.k0, dm.k1, vt + (size_t)(j + 2) * tile_step, dm.v0, dm.v1);
          else if (j == 2) dma_fill(c.lds, fs, wid, C0, dc.v0, dc.v1, C0 + 64 * HD, dc.v0, dc.v1); }
        const int S_lds = ldsb + slot * 32768;
        int r32l = r32; asm volatile("" : "+v"(r32l));
        if (j <= ci) {
            f32x16 p0, p1; qkt(p0, p1, S_lds, qr, r32l, hi);
#pragma unroll
            for (int r = 0; r < 16; ++r) { const int s0 = 64 * j + crow(r, hi), s1 = s0 + 32;
                const float w0 = (s0 <= trow) ? fast_exp(A_S[s0] - Mt) * 0.08838834764831845f : 0.f, w1 = (s1 <= trow) ? fast_exp(A_S[s1] - Mt) * 0.08838834764831845f : 0.f;
                p0[r] *= w0; p1[r] *= w1; rowsum += p0[r] + p1[r]; }
            bf16x8 pa0, pa1, pa2, pa3;
            PK4(p0, 0, pa0); PK4(p0, 8, pa1); PK4(p1, 0, pa2); PK4(p1, 8, pa3);
            pv_d0(o, S_lds + 16384 + v_rd_base(lane), pa0, pa1, pa2, pa3);
        }
        slot = slot == 2 ? 0 : slot + 1;
    }
    RING_WAIT_BAR(0);
    {
        const int S_lds = ldsb + slot * 32768;
#pragma unroll
        for (int hf = 0; hf < 2; ++hf) {
            bf16x8 qs[4];
#pragma unroll
            for (int dd = 0; dd < 4; ++dd) { const int d0 = hf * 4 + dd; const u32x4 w = *reinterpret_cast<const u32x4*>(&qr[d0]);
                float f[8] = {bflo(w.x), bfhi(w.x), bflo(w.y), bfhi(w.y), bflo(w.z), bfhi(w.z), bflo(w.w), bfhi(w.w)};
#pragma unroll
                for (int i = 0; i < 8; ++i) qn += f[i] * N0L[d0 * 16 + hi * 8 + i];
                u32x4 s; s.x = cvtpk(f[0] * winter, f[1] * winter); s.y = cvtpk(f[2] * winter, f[3] * winter); s.z = cvtpk(f[4] * winter, f[5] * winter); s.w = cvtpk(f[6] * winter, f[7] * winter);
                qs[dd] = *reinterpret_cast<bf16x8*>(&s); }
            pv_d0(o, S_lds + hf * 16384 + v_rd_base(lane), qs[0], qs[1], qs[2], qs[3]);
        }
    }
    rowsum = half_swap_add(rowsum);
    qn = half_swap_add(qn);
    const float den = winter * qn + rowsum;
    const float dfl = fast_exp(-(B_T[trow] + Mt));
    const float inv = 1.0f / fmaxf(fabsf(den), dfl);
    if (hi == 0) wsf[r32] = inv;
    asm volatile("s_waitcnt lgkmcnt(0)" ::: "memory");
#pragma unroll
    for (int r = 0; r < 16; ++r) { const float sc_ = wsf[crow(r, hi)];
#pragma unroll
        for (int d0 = 0; d0 < 4; ++d0) o[d0][r] *= sc_; }
    RING_WAIT_BAR(0);
    const int hst = ldsb + wid * 16384;
    { int le = lane; asm volatile("" : "+v"(le)); const int r32e = le & 31, hie = le >> 5;
#pragma unroll
    for (int r = 0; r < 16; ++r)
#pragma unroll
        for (int d0 = 0; d0 < 4; ++d0) *(LAS float*)(uintptr_t)(unsigned)(hst + crow(r, hie) * 512 + (d0 * 32 + r32e) * 4) = o[d0][r]; }
    asm volatile("s_waitcnt lgkmcnt(0)" ::: "memory");
    const float* gn = a.mlstm_norm_g + (size_t)l * 512 + h * HD;
    int le = lane; asm volatile("" : "+v"(le));
    u32x4 mo8[8];
#pragma unroll
    for (int i = 0; i < 8; ++i) { const int ch = i * 64 + le, row = ch >> 4, col = (ch & 15) * 8; mo8[i] = *(const u32x4*)(PROJ + (size_t)(row0 + wid * 32 + row) * NPROJ + C_MO + h * HD + col); }
#pragma unroll
    for (int i = 0; i < 8; ++i) { const int ch = i * 64 + le, row = ch >> 4, col = (ch & 15) * 8;
        const f32x4 a0 = *(const LAS f32x4*)(uintptr_t)(unsigned)(hst + row * 512 + col * 4), a1 = *(const LAS f32x4*)(uintptr_t)(unsigned)(hst + row * 512 + col * 4 + 16);
        float ss = (a0.x * a0.x + a0.y * a0.y) + (a0.z * a0.z + a0.w * a0.w) + (a1.x * a1.x + a1.y * a1.y) + (a1.z * a1.z + a1.w * a1.w);
        ss += shx(ss, 1, le); ss += shx(ss, 2, le); ss += shx(ss, 4, le); ss += shx(ss, 8, le);
        const float rstd = fast_rsqrt(ss * (1.f / HD) + EPS);
        const int orow = row0 + wid * 32 + row;
        const u32x4 mo = mo8[i];
        const f32x4 g0 = *(const f32x4*)(gn + col), g1 = *(const f32x4*)(gn + col + 4);
        float y[8] = {a0.x * g0.x, a0.y * g0.y, a0.z * g0.z, a0.w * g0.w, a1.x * g1.x, a1.y * g1.y, a1.z * g1.z, a1.w * g1.w};
        const float mf[8] = {bflo(mo.x), bfhi(mo.x), bflo(mo.y), bfhi(mo.y), bflo(mo.z), bfhi(mo.z), bflo(mo.w), bfhi(mo.w)};
#pragma unroll
        for (int k = 0; k < 8; ++k) y[k] = y[k] * rstd * (1.0f / (1.0f + fast_exp(-mf[k])));
        u32x4 w; w.x = cvtpk(y[0], y[1]); w.y = cvtpk(y[2], y[3]); w.z = cvtpk(y[4], y[5]); w.w = cvtpk(y[6], y[7]);
        *(u32x4*)(MIX + (size_t)orow * D + 1536 + h * HD + col) = w; }
}

__device__ __forceinline__ void ms_unit(const Args& a, const Ctx& c, int l, int unit) {
    const int b = unit >> 2, h = unit & 3; int tid = c.tid; asm volatile("" : "+v"(tid));
    const int lane = tid & 63, wid = c.wave;
    const bf16* PROJ = (const bf16*)(a.ws + WS_BIG); bf16* MIX = (bf16*)(a.ws + WS_H);
    const float* GATE = (const float*)(a.ws + WS_GATE);
    constexpr int P = 132;
    LAS float* Q = (LAS float*)c.lds;
    LAS float* Kk = Q + 32 * P;
    LAS float* V = Kk + 32 * P;
    LAS float* HB = V + 32 * P;
    LAS float* S = HB + 32 * P;
    LAS float* N0 = S + 32 * 33;
    LAS float* A_S = N0 + 128;
    LAS float* M_T = A_S + 32;
    LAS float* B_T = M_T + 32;
    LAS float* WST = B_T + 32;
    LAS float* DEN = WST + 32;
    LAS float* WIN = DEN + 32;
    LAS float* SC = WIN + 32;
    const int row0 = MP + b * SSEQ;
    const size_t sidx = (size_t)(l * SBATCH + b) * MH + h;
    const float* C0 = a.state_c + sidx * HD * HD;
    __syncthreads();
    for (int i = tid; i < 1536; i += NTHREADS) { const int which = i >> 9, r = (i >> 4) & 31, c8 = (i & 15) * 8;
        const u32x4 w = *(const u32x4*)(PROJ + (size_t)(row0 + r) * NPROJ + (which == 0 ? C_MQ : which == 1 ? C_MK : C_MV) + h * HD + c8);
        const float sc = which == 1 ? 0.08838834764831845f : 1.0f;
        LAS float* dst = (which == 0 ? Q : which == 1 ? Kk : V) + r * P + c8;
        *(LAS f32x4*)dst = (f32x4){bflo(w.x) * sc, bfhi(w.x) * sc, bflo(w.y) * sc, bfhi(w.y) * sc};
        *(LAS f32x4*)(dst + 4) = (f32x4){bflo(w.z) * sc, bfhi(w.z) * sc, bflo(w.w) * sc, bfhi(w.w) * sc}; }
    if (tid < 128) N0[tid] = a.state_n[sidx * HD + tid];
    if (wid == 0) {
        const int t = lane & 31; const float m0 = a.state_m[sidx];
        const float li = GATE[(size_t)(row0 + t) * 8 + h], lf = GATE[(size_t)(row0 + t) * 8 + 4 + h];
        float bc = lf;
#pragma unroll
        for (int o = 1; o < 32; o <<= 1) { const float x = shup(bc, o, lane); if ((lane & 31) >= o) bc += x; }
        const float as = li - bc; float cm = as;
#pragma unroll
        for (int o = 1; o < 32; o <<= 1) { const float x = shup(cm, o, lane); if ((lane & 31) >= o) cm = fmaxf(cm, x); }
        const float blast = __int_as_float(__builtin_amdgcn_ds_bpermute(31 << 2, __float_as_int(bc))), amax = __int_as_float(__builtin_amdgcn_ds_bpermute(31 << 2, __float_as_int(cm)));
        const float Mt = fmaxf(m0, cm), mnew = fmaxf(blast + m0, blast + amax);
        if (lane < 32) { A_S[t] = as; B_T[t] = bc; M_T[t] = Mt; WST[t] = fast_exp(blast + as - mnew); WIN[t] = fast_exp(m0 - Mt); }
        if (lane == 0) { SC[0] = m0; SC[1] = blast; SC[2] = mnew; SC[3] = fast_exp(blast + m0 - mnew); }
    }
    __syncthreads();
    for (int i = tid; i < 1024; i += NTHREADS) { const int t = i >> 5, s = i & 31; float d = 0.f;
        if (s <= t) {
#pragma unroll 8
            for (int k = 0; k < 128; k += 4) { const f32x4 q4 = *(const LAS f32x4*)(Q + t * P + k), k4 = *(const LAS f32x4*)(Kk + s * P + k); d += (q4.x * k4.x + q4.y * k4.y) + (q4.z * k4.z + q4.w * k4.w); }
            d *= fast_exp(A_S[s] - M_T[t]); }
        S[t * 33 + s] = d; }
    __syncthreads();
    if (tid < 32) { const int t = tid; float qn = 0.f, rs = 0.f;
        for (int k = 0; k < 128; ++k) qn += Q[t * P + k] * N0[k];
        for (int s = 0; s < 32; ++s) rs += S[t * 33 + s];
        const float den = WIN[t] * qn + rs; DEN[t] = 1.0f / fmaxf(fabsf(den), fast_exp(-(B_T[t] + M_T[t]))); }
    const int e = tid & 127, tg = tid >> 7;
    { float acc[8];
#pragma unroll
      for (int i = 0; i < 8; ++i) acc[i] = 0.f;
      for (int d0 = 0; d0 < 128; d0 += 16) { float cv[16];
#pragma unroll
          for (int j = 0; j < 16; ++j) cv[j] = C0[(size_t)(d0 + j) * HD + e];
#pragma unroll
          for (int j = 0; j < 16; j += 4)
#pragma unroll
              for (int i = 0; i < 8; ++i) { const f32x4 q4 = *(const LAS f32x4*)(Q + (tg * 8 + i) * P + d0 + j); acc[i] += (q4.x * cv[j] + q4.y * cv[j + 1]) + (q4.z * cv[j + 2] + q4.w * cv[j + 3]); } }
      __syncthreads();
#pragma unroll
      for (int i = 0; i < 8; ++i) { const int t = tg * 8 + i; float v = acc[i] * WIN[t];
          for (int s = 0; s <= t; ++s) v += S[t * 33 + s] * V[s * P + e];
          HB[t * P + e] = v * DEN[t]; } }
    __syncthreads();
    { const int t = tid >> 4, e0 = (tid & 15) * 8; float ss = 0.f;
      const f32x4 h0 = *(const LAS f32x4*)(HB + t * P + e0), h1 = *(const LAS f32x4*)(HB + t * P + e0 + 4);
      ss = (h0.x * h0.x + h0.y * h0.y) + (h0.z * h0.z + h0.w * h0.w) + (h1.x * h1.x + h1.y * h1.y) + (h1.z * h1.z + h1.w * h1.w);
      ss += shx(ss, 1, lane); ss += shx(ss, 2, lane); ss += shx(ss, 4, lane); ss += shx(ss, 8, lane);
      const float rstd = fast_rsqrt(ss * (1.f / HD) + EPS);
      const u32x4 mo = *(const u32x4*)(PROJ + (size_t)(row0 + t) * NPROJ + C_MO + h * HD + e0);
      const float* gn = a.mlstm_norm_g + (size_t)l * 512 + h * HD + e0;
      const f32x4 g0 = *(const f32x4*)gn, g1 = *(const f32x4*)(gn + 4);
      float y[8] = {h0.x * g0.x, h0.y * g0.y, h0.z * g0.z, h0.w * g0.w, h1.x * g1.x, h1.y * g1.y, h1.z * g1.z, h1.w * g1.w};
      const float mf[8] = {bflo(mo.x), bfhi(mo.x), bflo(mo.y), bfhi(mo.y), bflo(mo.z), bfhi(mo.z), bflo(mo.w), bfhi(mo.w)};
#pragma unroll
      for (int k = 0; k < 8; ++k) y[k] = y[k] * rstd * (1.0f / (1.0f + fast_exp(-mf[k])));
      u32x4 w; w.x = cvtpk(y[0], y[1]); w.y = cvtpk(y[2], y[3]); w.z = cvtpk(y[4], y[5]); w.w = cvtpk(y[6], y[7]);
      *(u32x4*)(MIX + (size_t)(row0 + t) * D + 1536 + h * HD + e0) = w; }
    { const float decay = SC[3]; const int dg = tg * 32; float acc[32];
#pragma unroll
      for (int i = 0; i < 32; ++i) acc[i] = C0[(size_t)(dg + i) * HD + e] * decay;
      for (int s = 0; s < 32; ++s) { const float vv = V[s * P + e] * WST[s];
#pragma unroll
          for (int i = 0; i < 32; i += 4) { const f32x4 k4 = *(const LAS f32x4*)(Kk + s * P + dg + i); acc[i] += k4.x * vv; acc[i + 1] += k4.y * vv; acc[i + 2] += k4.z * vv; acc[i + 3] += k4.w * vv; } }
      float* oc = a.out + O_SC + sidx * HD * HD;
#pragma unroll
      for (int i = 0; i < 32; ++i) oc[(size_t)(dg + i) * HD + e] = acc[i];
      if (tid < 128) { float v = decay * N0[tid]; for (int s = 0; s < 32; ++s) v += WST[s] * Kk[s * P + tid]; a.out[O_SN + sidx * HD + tid] = v; }
      if (tid == 0) a.out[O_SM + sidx] = SC[2]; }
}

__device__ __forceinline__ void phase_e(const Args& a, const Ctx& c_in0, int l) {
    const Ctx c = relaunder(c_in0);
    const bf16* PROJ = (const bf16*)(a.ws + WS_BIG); bf16* MIX = (bf16*)(a.ws + WS_H);
    constexpr int NATT = NB * NH * 32;
#if (PE_EN & 1)
    for (int u = c.vcu; u < NATT; u += c.G) {
        const int gq = u & 31, bhh = u >> 5, b = bhh >> 3, h = bhh & 7;
        const int c0 = 4 * gq, jstart = c0 >= 8 ? 0 : 8 - c0, NT = 12 - jstart, ci = c.wave >> 1;
        const int krow0 = b * SEQ + (c0 - 8 + jstart) * 64;
        const int alo = ci - jstart, ahi = ci + 8 - jstart;
        const int R0 = (ci + 8 - jstart) * 64 + (c.wave & 1) * 32;
        attn_unit(c, PROJ + (size_t)(b * SEQ + c0 * 64) * NPROJ + C_Q + h * HD, NPROJ, c.wave * 32, PROJ + (size_t)krow0 * NPROJ + C_K + h * HD, PROJ + (size_t)krow0 * NPROJ + C_V + h * HD, NPROJ,
                  NT, alo < 0 ? 0 : alo, ahi, NT * 64, R0, a.rel_bias + (size_t)(l * NH + h) * 257, MIX + (size_t)(b * SEQ + c0 * 64) * D + 512 + h * HD, D, true, nullptr,
                  gq >= 2 ? (8 * gq + 8) % 12 : 0);
    }
#endif
#if (PE_EN & 4)
    for (int u = c.vcu; u < 16 * NGRP; u += c.G) m3_unit(a, c, l, u);
#endif
}
__device__ __forceinline__ void sample_kv_prep(const Args& a, const Ctx& c, int l, int b, int h) {
    int tid = c.tid; asm volatile("" : "+v"(tid));
    const int lane = tid & 63, row = tid >> 4, c8 = (tid & 15) * 8;
    const bf16* PROJ = (const bf16*)(a.ws + WS_BIG);
    bf16* SK = (bf16*)(a.ws + WS_SK + (size_t)(l & 1) * SKV_IMG); bf16* SV = (bf16*)(a.ws + WS_SV + (size_t)(l & 1) * SKV_IMG);
    const size_t ro = (size_t)(MP + b * SSEQ + row) * NPROJ + h * HD + c8;
    const u32x4 kq = *(const u32x4*)(PROJ + ro + C_K), vq = *(const u32x4*)(PROJ + ro + C_V);
    float x[8] = {bflo(kq.x), bfhi(kq.x), bflo(kq.y), bfhi(kq.y), bflo(kq.z), bfhi(kq.z), bflo(kq.w), bfhi(kq.w)};
    float ss = 0.f;
#pragma unroll
    for (int i = 0; i < 8; ++i) ss += x[i] * x[i];
    ss += shx(ss, 1, lane); ss += shx(ss, 2, lane); ss += shx(ss, 4, lane); ss += shx(ss, 8, lane);
    const float rk = fast_rsqrt(ss * (1.f / HD) + EPS);
    const float* gk = a.k_norm_g + l * HD + c8; const f32x4 g0 = *(const f32x4*)gk, g1 = *(const f32x4*)(gk + 4);
    x[0] *= rk * g0[0]; x[1] *= rk * g0[1]; x[2] *= rk * g0[2]; x[3] *= rk * g0[3]; x[4] *= rk * g1[0]; x[5] *= rk * g1[1]; x[6] *= rk * g1[2]; x[7] *= rk * g1[3];
    u32x4 o; o.x = cvtpk(x[0], x[1]); o.y = cvtpk(x[2], x[3]); o.z = cvtpk(x[4], x[5]); o.w = cvtpk(x[6], x[7]);
    const size_t io = ((size_t)b * SKV_ROWS + 512 + row) * 1024 + h * HD + c8;
    *(u32x4*)(SK + io) = o; *(u32x4*)(SV + io) = vq;
    const size_t oo = ((size_t)(l * SBATCH + b) * SSEQ + row) * 1024 + h * HD + c8;
    float* ok = a.out + O_SK + oo; float* ov = a.out + O_SV + oo;
    *(f32x4*)ok = (f32x4){x[0], x[1], x[2], x[3]}; *(f32x4*)(ok + 4) = (f32x4){x[4], x[5], x[6], x[7]};
    *(f32x4*)ov = (f32x4){bflo(vq.x), bfhi(vq.x), bflo(vq.y), bfhi(vq.y)}; *(f32x4*)(ov + 4) = (f32x4){bflo(vq.z), bfhi(vq.z), bflo(vq.w), bfhi(vq.w)};
    asm volatile("s_waitcnt vmcnt(0)" ::: "memory"); __syncthreads();
}
__device__ __forceinline__ void sample_mixers(const Args& a, const Ctx& c, int l) {
    const bf16* PROJ = (const bf16*)(a.ws + WS_BIG); bf16* MIX = (bf16*)(a.ws + WS_H);
#if (PE_EN & 2)
    for (int su = c.vcu; su < SBATCH * NH; su += c.G) {
        const int b = su >> 3, h = su & 7;
        sample_kv_prep(a, c, l, b, h);
        const bf16* SK = (const bf16*)(a.ws + WS_SK + (size_t)(l & 1) * SKV_IMG) + (size_t)b * SKV_ROWS * 1024 + h * HD; const bf16* SV = (const bf16*)(a.ws + WS_SV + (size_t)(l & 1) * SKV_IMG) + (size_t)b * SKV_ROWS * 1024 + h * HD;
        attn_unit(c, PROJ + (size_t)(MP + b * SSEQ) * NPROJ + C_Q + h * HD, NPROJ, 0, SK, SV, 1024, 9, 0, 8, 544, 512, a.rel_bias + (size_t)(l * NH + h) * 257,
                  MIX + (size_t)(MP + b * SSEQ) * D + 512 + h * HD, D, c.wave == 0, a.q_norm_g + l * HD);
    }
#endif
#if (PE_EN & 8)
    for (int u = c.vcu - SBATCH * NH; u >= 0 && u < SBATCH * MH; u += c.G) ms_unit(a, c, l, u);
#endif
    __syncthreads();
}
typedef const __attribute__((address_space(4))) Args* KArgP;
#if defined(__HIP_DEVICE_COMPILE__)
__device__ __forceinline__ Args get_args() { KArgP p = (KArgP)__builtin_amdgcn_kernarg_segment_ptr(); asm volatile("" : "+s"(p)); return *p; }
#else
__device__ Args get_args();
#endif
__global__ void __launch_bounds__(NTHREADS, 2) fwd(Args args) {
    extern __shared__ __attribute__((aligned(16))) unsigned char lds_raw[];
    Ctx c; c.lds = (LAS unsigned char*)lds_raw; c.wave = __builtin_amdgcn_readfirstlane((int)threadIdx.x >> 6); c.tid = hw_tid(c.wave); c.lane = c.tid & 63;
    c.G = gridDim.x; { const int bx = blockIdx.x; c.vcu = (c.G % 8 == 0) ? (bx % 8) * (c.G / 8) + bx / 8 : bx; }
    volatile LAS unsigned* MISC = (volatile LAS unsigned*)(c.lds + MISC_OFF);
    { const int t0 = hw_tid(c.wave); if (t0 < 16) MISC[t0] = 0u; }
    __syncthreads();
    unsigned* barw = (unsigned*)(get_args().ws + WS_CTL) + 4096;
    XcdBarrier bar; bar.bar = barw; bar.x = 0; bar.st = nullptr;
    const int lo = args.ph_lo, hi = args.ph_hi;
    const bool multi = (hi - lo) > 1;
    if (multi) bar = xcd_barrier_post(barw, MISC + 8, hw_tid(c.wave) == 0);
#define IN(k) (lo <= (k) && (k) < hi)
#define SEAM(k) do { if (IN(k) && IN((k) + 1)) xcd_barrier(bar.bar, bar.x, bar.st, c.wave); } while (0)
    for (int l = 0; l < DEPTH; ++l) {
        const int pb = l * NPH_LAYER;
        if (IN(pb + 0)) {
#if (PH_EN >> 1) & 1
            { const Args A_ = get_args(); phase_norm<true>(A_, c, l); }
#if (PH_DUP >> 1) & 1
            { __syncthreads(); const Args A_ = get_args(); phase_norm<true>(A_, c, l); }
#endif
#endif
 __syncthreads(); SEAM(pb + 0); }
        if (IN(pb + 1)) {
            const Args A_ = get_args(); bf16* H = (bf16*)(A_.ws + WS_H); bf16* BIG = (bf16*)(A_.ws + WS_BIG);
            bf16* XBp = (bf16*)(A_.ws + WS_XB); const float* RS = (const float*)(A_.ws + WS_RSTD);
            pg8::Gemm g{XBp, (const bf16*)(A_.ws + WS_WIN), MP, NPROJ, D}; pg8::StaticOrder S; S.init(MP, NPROJ, c.G, (int)blockIdx.x, WGM_B);
            pg8::EpiProj E{BIG, NPROJ, A_.q_norm_g + l * HD, A_.k_norm_g + l * HD, (LAS float*)(c.lds + SCR_OFF), RS};

#if (PH_EN >> 2) & 1
            for (int rep_ = 0, nrep_ = ((PH_DUP >> 2) & 1) ? A_.rep : 1; rep_ < nrep_; ++rep_) pg8::gemm_phase<pg8::EpiProj, pg8::StaticOrder, true, true>(c.lds, g, S, E, c.wave);
            { SEpiBf16 SE{BIG + (size_t)MP * NPROJ, NPROJ, 0, RS + MP}; sample_gemm(c.lds, c.wave, c.vcu, c.G, XBp + (size_t)MP * D, g.Bt, NPROJ, D, SE); }
#endif

            SEAM(pb + 1);
        }
        if (IN(pb + 2)) {
#if (PH_EN >> 3) & 1
            { const Args A_ = get_args(); phase_c<true>(A_, c, l); }
#if (PH_DUP >> 3) & 1
            { __syncthreads(); const Args A_ = get_args(); phase_c<false>(A_, c, l); }
#endif
#endif
 SEAM(pb + 2); }
        if (IN(pb + 3)) {
#if (PH_EN >> 4) & 1
            { const Args A_ = get_args(); phase_d(A_, c, l); }
            { const Args A_ = get_args(); if (l + 1 < DEPTH) build_kv_image(A_, c.vcu, c.G, hw_tid(c.wave), l + 1); }
#if (PH_DUP >> 4) & 1
            { __syncthreads(); const Args A_ = get_args(); phase_d(A_, c, l); }
#endif
#endif
 SEAM(pb + 3); }
        if (IN(pb + 4)) {
#if (PH_EN >> 5) & 1
            { const Args A_ = get_args(); phase_e(A_, c, l); }
#if (PH_DUP >> 5) & 1
            { __syncthreads(); const Args A_ = get_args(); phase_e(A_, c, l); }
#endif
#endif
 __syncthreads(); SEAM(pb + 4); }
        if (IN(pb + 5)) {
            const Args A_ = get_args(); bf16* H = (bf16*)(A_.ws + WS_H);
            pg8::Gemm g{H, (const bf16*)(A_.ws + WS_WOUT), MP, D, D}; pg8::StaticOrder S; S.init(MP, D, c.G, (int)blockIdx.x, WGM_F);
            pg8::EpiResAdd E{(bf16*)(A_.ws + WS_XB), A_.out, D, false};

#if (PH_EN >> 6) & 1
            pg8::gemm_phase<pg8::EpiResAdd, pg8::StaticOrder, true, true>(c.lds, g, S, E, c.wave);
            { SEpiResAdd SE{(bf16*)(A_.ws + WS_XB) + (size_t)MP * D, A_.out + (size_t)MP * D, D, false}; sample_gemm(c.lds, c.wave, c.vcu, c.G, H + (size_t)MP * D, g.Bt, D, D, SE); }
#if (PH_DUP >> 6) & 1
            { pg8::EpiBf16<0> E2{(bf16*)(A_.ws + WS_BIG), D, nullptr, (LAS float*)(c.lds + SCR_OFF)}; pg8::gemm_phase<pg8::EpiBf16<0>, pg8::StaticOrder, true, true>(c.lds, g, S, E2, c.wave); }
#endif
#endif

            SEAM(pb + 5);
        }
        if (IN(pb + 6)) {
#if (PH_EN >> 7) & 1
            { const Args A_ = get_args(); phase_norm<false>(A_, c, l); }
#if (PH_DUP >> 7) & 1
            { __syncthreads(); const Args A_ = get_args(); phase_norm<false>(A_, c, l); }
#endif
#endif
 SEAM(pb + 6); }
        if (IN(pb + 7)) {
            const Args A_ = get_args(); bf16* H = (bf16*)(A_.ws + WS_H); bf16* BIG = (bf16*)(A_.ws + WS_BIG);
            bf16* XBp = (bf16*)(A_.ws + WS_XB); const float* RS = (const float*)(A_.ws + WS_RSTD);
            pg8::Gemm g{XBp, (const bf16*)(A_.ws + WS_WUP), MP, FF, D}; pg8::StaticOrder S; S.init(MP, FF, c.G, (int)blockIdx.x, WGM_H);
            pg8::EpiBf16<1> E{BIG, FF, RS, (LAS float*)(c.lds + SCR_OFF)};

#if (PH_EN >> 8) & 1
            for (int rep_ = 0, nrep_ = ((PH_DUP >> 8) & 1) ? A_.rep : 1; rep_ < nrep_; ++rep_) pg8::gemm_phase<pg8::EpiBf16<1>, pg8::StaticOrder, true, true>(c.lds, g, S, E, c.wave);
            { SEpiBf16 SE{BIG + (size_t)MP * FF, FF, 1, RS + MP}; sample_gemm(c.lds, c.wave, c.vcu, c.G, XBp + (size_t)MP * D, g.Bt, FF, D, SE); }
#endif

            SEAM(pb + 7);
        }
        if (IN(pb + 8)) {
            const Args A_ = get_args(); bf16* BIG = (bf16*)(A_.ws + WS_BIG);
            pg8::Gemm g{BIG, (const bf16*)(A_.ws + WS_WDN), MP, D, FF}; pg8::StaticOrder S; S.init(MP, D, c.G, (int)blockIdx.x, WGM_I);
            pg8::EpiResAdd E{(bf16*)(A_.ws + WS_XB), A_.out, D, l == DEPTH - 1};

#if (PH_EN >> 9) & 1
            pg8::gemm_phase<pg8::EpiResAdd, pg8::StaticOrder, true, true>(c.lds, g, S, E, c.wave);
            { SEpiResAdd SE{(bf16*)(A_.ws + WS_XB) + (size_t)MP * D, A_.out + (size_t)MP * D, D, l == DEPTH - 1}; sample_gemm(c.lds, c.wave, c.vcu, c.G, BIG + (size_t)MP * FF, g.Bt, D, FF, SE); }
#if (PH_DUP >> 9) & 1
            { pg8::EpiBf16<0> E2{(bf16*)(A_.ws + WS_H), D, nullptr, (LAS float*)(c.lds + SCR_OFF)}; pg8::gemm_phase<pg8::EpiBf16<0>, pg8::StaticOrder, true, true>(c.lds, g, S, E2, c.wave); }
#endif
#endif

            SEAM(pb + 8);
        }
    }
#undef IN
#undef SEAM
}

extern "C" void kernel_launch(void* const* d_in, const int* in_sizes, int n_in, void* d_out, int out_size, void* d_ws, size_t ws_size, hipStream_t stream) {
    static int grid = 0;
    if (grid == 0) {
        if (n_in != 21 || (size_t)out_size != O_END || ws_size < WS_END) { fprintf(stderr, "kernel_launch: shape mismatch n_in %d out %d ws %zu (need %zu)\n", n_in, out_size, ws_size, (size_t)WS_END); grid = -1; return; }
        int dev = 0, cus = 0, per_cu = 0;
        if (hipGetDevice(&dev) != hipSuccess || hipDeviceGetAttribute(&cus, hipDeviceAttributeMultiprocessorCount, dev) != hipSuccess) { grid = -1; return; }
        if (hipFuncSetAttribute((const void*)fwd, hipFuncAttributeMaxDynamicSharedMemorySize, LDS_BYTES) != hipSuccess) { fprintf(stderr, "kernel_launch: hipFuncSetAttribute failed\n"); grid = -1; return; }
        if (hipOccupancyMaxActiveBlocksPerMultiprocessor(&per_cu, (const void*)fwd, NTHREADS, LDS_BYTES) != hipSuccess || per_cu < 1) { fprintf(stderr, "kernel_launch: occupancy query says %d\n", per_cu); }
        (void)hipGetLastError();
        grid = cus;
    }
    if (grid < 0) return;
    (void)hipMemsetAsync((char*)d_ws + WS_CTL, 0, CTL_BYTES, stream);
    Args a{};
    a.x_prompt = (const float*)d_in[0]; a.x_sample = (const float*)d_in[1]; a.cache_k = (const float*)d_in[2]; a.cache_v = (const float*)d_in[3]; a.state_conv = (const float*)d_in[4];
    a.state_c = (const float*)d_in[5]; a.state_n = (const float*)d_in[6]; a.state_m = (const float*)d_in[7]; a.norm_mix_g = (const float*)d_in[8]; a.w_in = (const float*)d_in[9];
    a.conv_w = (const float*)d_in[10]; a.q_norm_g = (const float*)d_in[11]; a.k_norm_g = (const float*)d_in[12]; a.rel_bias = (const float*)d_in[13]; a.b_igate = (const float*)d_in[14];
    a.b_fgate = (const float*)d_in[15]; a.mlstm_norm_g = (const float*)d_in[16]; a.w_out = (const float*)d_in[17]; a.norm_mlp_g = (const float*)d_in[18]; a.w_up = (const float*)d_in[19];
    a.w_down = (const float*)d_in[20]; a.out = (float*)d_out; a.ws = (unsigned char*)d_ws;
#if MK_PER_PHASE
    for (int p = 0; p < NPHASES; ++p) { a.ph_lo = p; a.ph_hi = p + 1; a.rep = 2; hipLaunchKernelGGL(fwd, dim3(grid), dim3(NTHREADS), LDS_BYTES, stream, a); }
#else
    a.ph_lo = 0; a.ph_hi = NPHASES; a.rep = 2; hipLaunchKernelGGL(fwd, dim3(grid), dim3(NTHREADS), LDS_BYTES, stream, a);
#endif
    const hipError_t le = hipPeekAtLastError();
    if (le != hipSuccess) fprintf(stderr, "kernel_launch: launch failed: %s\n", hipGetErrorName(le));
}
```

```cpp
#include <hip/hip_runtime.h>
#include <cstdio>
#include <cstdint>

#ifndef MK_PER_PHASE
#define MK_PER_PHASE 0
#endif

#ifndef PH_EN
#define PH_EN 0x3ff
#endif
#ifndef PE_EN
#define PE_EN 0xf
#endif
#ifndef WGM_B
#define WGM_B 4
#endif
#ifndef WGM_F
#define WGM_F 4
#endif
#ifndef WGM_H
#define WGM_H 4
#endif
#ifndef WGM_I
#define WGM_I 4
#endif
#ifndef PH_DUP
#define PH_DUP 0
#endif
#define LAS __attribute__((address_space(3)))
#define GAS __attribute__((address_space(1)))
typedef unsigned short bf16;
typedef short bf16x8 __attribute__((ext_vector_type(8)));
typedef short s16x4 __attribute__((ext_vector_type(4)));
typedef float f32x2 __attribute__((ext_vector_type(2)));
typedef float f32x4 __attribute__((ext_vector_type(4)));
typedef float f32x16 __attribute__((ext_vector_type(16)));
typedef unsigned u32x2 __attribute__((ext_vector_type(2)));
typedef unsigned u32x4 __attribute__((ext_vector_type(4)));

constexpr int D = 2048, NB = 4, SEQ = 8192, DEPTH = 4, SBATCH = 8, SSEQ = 32;
constexpr int MP = NB * SEQ, MS = SBATCH * SSEQ, MR = MP + MS;
constexpr int NH = 8, HD = 128, MH = 4;
constexpr int NPROJ = 6656, IN_DIM = 6664, FF = 8192;
constexpr int C_XA = 0, C_GB = 512, C_GC = 1024, C_Q = 1536, C_K = 2560, C_V = 3584, C_MQ = 4608, C_MK = 5120, C_MV = 5632, C_MO = 6144;
constexpr int KEEP = 512;
constexpr int SKV_ROWS = 640;
constexpr float EPS = 1e-6f;
constexpr float LOG2E = 1.4426950408889634f;
constexpr int NGRP = SEQ / 256;

constexpr size_t O_YP = 0, O_YS = O_YP + (size_t)MP * D, O_PCONV = O_YS + (size_t)MS * D, O_PK = O_PCONV + (size_t)DEPTH * NB * 2 * 512,
                 O_PV = O_PK + (size_t)DEPTH * NB * KEEP * 1024, O_PC = O_PV + (size_t)DEPTH * NB * KEEP * 1024, O_PN = O_PC + (size_t)DEPTH * NB * MH * HD * HD,
                 O_PM = O_PN + (size_t)DEPTH * NB * MH * HD, O_SCONV = O_PM + (size_t)DEPTH * NB * MH, O_SK = O_SCONV + (size_t)DEPTH * SBATCH * 2 * 512,
                 O_SV = O_SK + (size_t)DEPTH * SBATCH * SSEQ * 1024, O_SC = O_SV + (size_t)DEPTH * SBATCH * SSEQ * 1024, O_SN = O_SC + (size_t)DEPTH * SBATCH * MH * HD * HD,
                 O_SM = O_SN + (size_t)DEPTH * SBATCH * MH * HD, O_END = O_SM + (size_t)DEPTH * SBATCH * MH;

constexpr size_t al256(size_t x) { return (x + 255) / 256 * 256; }
constexpr size_t WS_CTL = 0, CTL_BYTES = 1u << 20;
constexpr size_t WS_WIN = CTL_BYTES;
constexpr size_t WS_WOUT = WS_WIN + (size_t)NPROJ * D * 2;
constexpr size_t WS_WUP = WS_WOUT + (size_t)D * D * 2;
constexpr size_t WS_WDN = WS_WUP + (size_t)FF * D * 2;
constexpr size_t WS_H = WS_WDN + (size_t)D * FF * 2;
constexpr size_t WS_XB = WS_H + (size_t)MR * D * 2;
constexpr size_t WS_BIG = WS_XB + (size_t)MR * D * 2;
constexpr size_t BIG_BYTES = (size_t)MR * FF * 2;
constexpr size_t WS_CLOC = WS_BIG + al256((size_t)MR * NPROJ * 2);
constexpr size_t WS_C0 = WS_CLOC + (size_t)16 * NGRP * HD * HD * 4;
constexpr size_t WS_NLOC = WS_C0 + (size_t)16 * NGRP * HD * HD * 2;
constexpr size_t WS_N0 = WS_NLOC + (size_t)16 * NGRP * HD * 4;
constexpr size_t WS_MSC = WS_N0 + (size_t)16 * NGRP * HD * 4;
constexpr size_t WS_MIX_END = WS_MSC + (size_t)16 * NGRP * 4 * 4;
static_assert(WS_MIX_END <= WS_BIG + BIG_BYTES, "mLSTM scratch fits in the free top of BIG");
constexpr size_t WS_GATE = WS_BIG + BIG_BYTES;
constexpr size_t SKV_IMG = (size_t)SBATCH * SKV_ROWS * 1024 * 2;
constexpr size_t WS_SK = WS_GATE + (size_t)MR * 8 * 4;
constexpr size_t WS_SV = WS_SK + 2 * SKV_IMG;
constexpr size_t WS_RSTD = WS_SV + 2 * SKV_IMG;
constexpr size_t WS_END = WS_RSTD + (size_t)MR * 4;
static_assert(WS_END <= 1235000000ull, "workspace budget");

constexpr int RING_BYTES = 131072;
constexpr int MISC_OFF = RING_BYTES;
constexpr int SCR_OFF = MISC_OFF + 256;
constexpr int LDS_BYTES = 147456;
constexpr int NWAVES = 8, NTHREADS = 512;

__device__ __forceinline__ unsigned cvtpk(float lo, float hi) { unsigned r; asm volatile("v_cvt_pk_bf16_f32 %0, %1, %2" : "=v"(r) : "v"(lo), "v"(hi)); return r; }
__device__ __forceinline__ float bflo(unsigned w) { return __uint_as_float(w << 16); }
__device__ __forceinline__ float bfhi(unsigned w) { return __uint_as_float(w & 0xffff0000u); }
__device__ __forceinline__ float bf2f(bf16 b) { return __uint_as_float(((unsigned)b) << 16); }
__device__ __forceinline__ float shx(float v, int o, int lane) { return __int_as_float(__builtin_amdgcn_ds_bpermute((lane ^ o) << 2, __float_as_int(v))); }
__device__ __forceinline__ float shup(float v, int o, int lane) { const int s = lane - o; return __int_as_float(__builtin_amdgcn_ds_bpermute((s < 0 ? lane : s) << 2, __float_as_int(v))); }
__device__ __forceinline__ float wave_sum(float v, int lane) {
#pragma unroll
    for (int o = 1; o < 64; o <<= 1) v += shx(v, o, lane);
    return v;
}
__device__ __forceinline__ float fast_rsqrt(float x) { return __builtin_amdgcn_rsqf(x); }
__device__ __forceinline__ float fast_exp(float x) { return __builtin_amdgcn_exp2f(x * 1.4426950408889634f); }
__device__ __forceinline__ float fast_log(float x) { return __builtin_amdgcn_logf(x) * 0.6931471805599453f; }
__device__ __forceinline__ float opaque_zero() { float z; asm volatile("v_mov_b32 %0, 0" : "=v"(z)); return z; }
#define LDS_WAIT() asm volatile("s_waitcnt lgkmcnt(0)" ::: "memory")
#define VM_WAIT() asm volatile("s_waitcnt vmcnt(0)" ::: "memory")
#define SBAR() __builtin_amdgcn_sched_barrier(0)

namespace pg8 {
typedef unsigned short bf16_t;
constexpr int BM = 256, BK = 64, HALF = 128, HTB = HALF * BK * 2, STAGE_BYTES = 8 * HTB, NXCD = 8, WGM = 4;
__host__ __device__ __forceinline__ int lds_byte(int r, int c) { const int st = (r >> 4) * 2 + (c >> 5), rr = r & 15, cc = c & 31, ob = rr * 64 + cc * 2; return st * 1024 + (ob ^ (((ob >> 9) & 1) << 5)); }
__host__ __device__ __forceinline__ void stage_rc(int b, int& R, int& C) { const int st = b / 1024, sb = b % 1024, swz = sb ^ (((sb >> 9) & 1) << 5); R = (st >> 1) * 16 + swz / 64; C = (st & 1) * 32 + (swz % 64) / 2; }
__host__ __device__ __forceinline__ int perm32(int rho) { const int n = rho >> 4, i = rho & 15; return 8 * (i >> 2) + 4 * n + (i & 3); }
struct Unit { int pm, pn; };
struct Gemm { const bf16_t* A; const bf16_t* Bt; int M, N, K; };
struct StaticOrder {
    int nM, nN, nwg, G, c, wgm;
    __host__ __device__ void init(int M, int N, int G_, int c_, int wgm_ = WGM) { nM = M / BM; nN = N / BM; nwg = nM * nN; G = G_; c = c_; wgm = wgm_; }
    __host__ __device__ bool next(int i, Unit& u) const {
        const long L = (long)i * G + c; if (L >= nwg) return false;
        int wgid = (int)L; { const int q = nwg / NXCD, r = nwg % NXCD, xcd = wgid % NXCD, off = wgid / NXCD; wgid = (xcd < r ? xcd * (q + 1) : r * (q + 1) + (xcd - r) * q) + off; }
        const int nig = wgm * nN, gid = wgid / nig, fm = gid * wgm, gsz = (nM - fm) < wgm ? (nM - fm) : wgm;
        u.pm = fm + ((wgid % nig) % gsz); u.pn = (wgid % nig) / gsz; return true;
    }
    __device__ __forceinline__ void a_ready(const Unit&) const {}
    __device__ __forceinline__ void done(const Unit&) const {}
};
template <int ACT  > struct EpiBf16 {
    static constexpr bool PERM = true, AFTER_DRAIN = false;
    static constexpr bool RSL = true;
    bf16_t* O; int ldc; const float* rstd; LAS float* T;
    __device__ __forceinline__ void rs_fetch(const Unit& u, int tid, int par) const { if (rstd && tid < BM) (T + 2048 + par * BM)[tid] = rstd[u.pm * BM + tid]; }
    __device__ __forceinline__ void operator()(const f32x4 (&acc)[2][2][4][2], const Unit& u, int wr, int wc, int fr, int fq, int par) const {
        const int row0 = u.pm * BM + wr * 64 + fr; const int col0 = u.pn * BM + wc * 32 + 8 * fq;
#pragma unroll
        for (int ai = 0; ai < 2; ++ai)
#pragma unroll
            for (int m = 0; m < 4; ++m) { bf16_t* rowp = O + (size_t)(row0 + ai * HALF + m * 16) * ldc + col0; const float rsv = rstd ? (T + 2048 + par * BM)[wr * 64 + fr + ai * HALF + m * 16] : 1.0f;
#pragma unroll
                for (int bj = 0; bj < 2; ++bj) { f32x4 v0 = acc[ai][bj][m][0] * rsv, v1 = acc[ai][bj][m][1] * rsv;
                    if (ACT == 1) {
#pragma unroll
                        for (int j = 0; j < 4; ++j) { const float a = fmaxf(v0[j], 0.f), b = fmaxf(v1[j], 0.f); v0[j] = a * a; v1[j] = b * b; } }
                    u32x4 w; w.x = cvtpk(v0[0], v0[1]); w.y = cvtpk(v0[2], v0[3]); w.z = cvtpk(v1[0], v1[1]); w.w = cvtpk(v1[2], v1[3]);
                    *(u32x4*)(rowp + bj * HALF) = w; } }
    }
};
struct EpiProj {
    static constexpr bool PERM = true, AFTER_DRAIN = false;
    static constexpr bool RSL = true;
    bf16_t* O; int ldc; const float* gq; const float* gk; LAS float* T; const float* rstd;
    __device__ __forceinline__ void rs_fetch(const Unit& u, int tid, int par) const { if (tid < BM) (T + 2048 + par * BM)[tid] = rstd[u.pm * BM + tid]; }
    __device__ __forceinline__ void operator()(const f32x4 (&acc)[2][2][4][2], const Unit& u, int wr, int wc, int fr, int fq, int par) const {
        const int row0 = u.pm * BM + wr * 64 + fr; const int col0 = u.pn * BM + wc * 32 + 8 * fq;
        const bool isqk = (u.pn >= 6) && (u.pn < 14);
        float rs[2][4];
#pragma unroll
        for (int ai = 0; ai < 2; ++ai)
#pragma unroll
            for (int m = 0; m < 4; ++m) rs[ai][m] = (T + 2048 + par * BM)[wr * 64 + fr + ai * HALF + m * 16];
        if (!isqk) {
#pragma unroll
            for (int ai = 0; ai < 2; ++ai)
#pragma unroll
                for (int m = 0; m < 4; ++m) { bf16_t* rowp = O + (size_t)(row0 + ai * HALF + m * 16) * ldc + col0;
#pragma unroll
                    for (int bj = 0; bj < 2; ++bj) { const f32x4 v0 = acc[ai][bj][m][0] * rs[ai][m], v1 = acc[ai][bj][m][1] * rs[ai][m];
                        u32x4 w; w.x = cvtpk(v0[0], v0[1]); w.y = cvtpk(v0[2], v0[3]); w.z = cvtpk(v1[0], v1[1]); w.w = cvtpk(v1[2], v1[3]);
                        *(u32x4*)(rowp + bj * HALF) = w; } }
            return;
        }
        const int lane = fr + 16 * fq;
        float ss[2][4][2];
#pragma unroll
        for (int ai = 0; ai < 2; ++ai)
#pragma unroll
            for (int m = 0; m < 4; ++m)
#pragma unroll
                for (int bj = 0; bj < 2; ++bj) { const f32x4 v0 = acc[ai][bj][m][0] * rs[ai][m], v1 = acc[ai][bj][m][1] * rs[ai][m];
                    float s = (v0[0] * v0[0] + v0[1] * v0[1]) + (v0[2] * v0[2] + v0[3] * v0[3]) + (v1[0] * v1[0] + v1[1] * v1[1]) + (v1[2] * v1[2] + v1[3] * v1[3]);
                    s += shx(s, 16, lane); s += shx(s, 32, lane); ss[ai][m][bj] = s; }
        if (fq == 0) {
#pragma unroll
            for (int ai = 0; ai < 2; ++ai)
#pragma unroll
                for (int m = 0; m < 4; ++m)
#pragma unroll
                    for (int bj = 0; bj < 2; ++bj) T[(ai * HALF + wr * 64 + m * 16 + fr) * 8 + bj * 4 + wc] = ss[ai][m][bj];
        }
        asm volatile("s_waitcnt lgkmcnt(0)" ::: "memory"); __builtin_amdgcn_s_barrier(); asm volatile("" ::: "memory");
        const float* gg = ((u.pn < 10) ? gq : gk) + wc * 32 + 8 * fq;
        const f32x4 g0 = *(const f32x4*)gg, g1 = *(const f32x4*)(gg + 4);
#pragma unroll
        for (int ai = 0; ai < 2; ++ai)
#pragma unroll
            for (int m = 0; m < 4; ++m) { bf16_t* rowp = O + (size_t)(row0 + ai * HALF + m * 16) * ldc + col0;
#pragma unroll
                for (int bj = 0; bj < 2; ++bj) { const f32x4 t = *(const LAS f32x4*)(T + (ai * HALF + wr * 64 + m * 16 + fr) * 8 + bj * 4);
                    const float rq = fast_rsqrt(((t[0] + t[1]) + (t[2] + t[3])) * (1.0f / 128.0f) + 1e-6f) * rs[ai][m];
                    const f32x4 v0 = acc[ai][bj][m][0] * rq * g0, v1 = acc[ai][bj][m][1] * rq * g1;
                    u32x4 w; w.x = cvtpk(v0[0], v0[1]); w.y = cvtpk(v0[2], v0[3]); w.z = cvtpk(v1[0], v1[1]); w.w = cvtpk(v1[2], v1[3]);
                    *(u32x4*)(rowp + bj * HALF) = w; } }
    }
};
struct EpiResAdd {
    static constexpr bool RSL = false;
    static constexpr bool PERM = true, AFTER_DRAIN = false;
    bf16_t* XB; float* Y; int ldc; bool fin;
    __device__ __forceinline__ void operator()(const f32x4 (&acc)[2][2][4][2], const Unit& u, int wr, int wc, int fr, int fq, int) const {
        const int row0 = u.pm * BM + wr * 64 + fr, col0 = u.pn * BM + wc * 32 + 8 * fq;
        u32x4 r[2][4][2];
#pragma unroll
        for (int ai = 0; ai < 2; ++ai)
#pragma unroll
            for (int m = 0; m < 4; ++m)
#pragma unroll
                for (int bj = 0; bj < 2; ++bj) r[ai][m][bj] = *(const u32x4*)(XB + (size_t)(row0 + ai * HALF + m * 16) * ldc + col0 + bj * HALF);
#pragma unroll
        for (int ai = 0; ai < 2; ++ai)
#pragma unroll
            for (int m = 0; m < 4; ++m)
#pragma unroll
                for (int bj = 0; bj < 2; ++bj) { const u32x4 w = r[ai][m][bj]; const f32x4 a0 = acc[ai][bj][m][0], a1 = acc[ai][bj][m][1];
                    const f32x4 v0 = (f32x4){bflo(w.x) + a0[0], bfhi(w.x) + a0[1], bflo(w.y) + a0[2], bfhi(w.y) + a0[3]}, v1 = (f32x4){bflo(w.z) + a1[0], bfhi(w.z) + a1[1], bflo(w.w) + a1[2], bfhi(w.w) + a1[3]};
                    const size_t off = (size_t)(row0 + ai * HALF + m * 16) * ldc + col0 + bj * HALF;
                    if (fin) { *(f32x4*)(Y + off) = v0; *(f32x4*)(Y + off + 4) = v1; }
                    else { u32x4 o; o.x = cvtpk(v0[0], v0[1]); o.y = cvtpk(v0[2], v0[3]); o.z = cvtpk(v1[0], v1[1]); o.w = cvtpk(v1[2], v1[3]); *(u32x4*)(XB + off) = o; } }
    }
};

template <class Epi, class Sched, bool ALIGN_EPI = false, bool SP2 = false>
__device__ __forceinline__ void gemm_phase(LAS unsigned char* lds, const Gemm g, const Sched& S, const Epi& E, const int wave_) {
    int ln_; asm volatile("v_mbcnt_lo_u32_b32 %0, -1, 0\n\tv_mbcnt_hi_u32_b32 %0, -1, %0" : "=v"(ln_)); const int tid = wave_ * 64 + ln_;
    const int wid = __builtin_amdgcn_readfirstlane(tid >> 6), lane = tid & 63, wr = wid >> 2, wc = wid & 3, fr = lane & 15, fq = lane >> 4;
    const int K = g.K, nt = K / BK;
    unsigned voffA[2], voffB[2];
#pragma unroll
    for (int i = 0; i < 2; ++i) { int R, C; stage_rc(tid * 16 + i * 8192, R, C); const int Rb = Epi::PERM ? ((R & ~31) + perm32(R & 31)) : R;
        voffA[i] = (unsigned)(R * K + C) * 2u; voffB[i] = (unsigned)(Rb * K + C) * 2u; }
    const size_t kstep = (size_t)(BK * 2);
    const size_t hstep = (size_t)HALF * K * 2;
    const size_t tstep = 2 * hstep;
    const unsigned ldsw = (unsigned)wid * 1024u;
    const int aoff = lds_byte(wr * 64 + fr, fq * 8), boff = lds_byte(wc * 32 + fr, fq * 8);
#define PG8_SA(b, h) (((b) * 2 + (h)) * HTB)
#define PG8_SB(b, h) ((4 + (b) * 2 + (h)) * HTB)
#define PG8_STAGE(bufoff, gbase, voff) do { _Pragma("unroll") for (int _i = 0; _i < 2; ++_i) \
        __builtin_amdgcn_global_load_lds((const unsigned*)((const char*)(gbase) + (voff)[_i]), (LAS unsigned*)(lds + (bufoff) + ldsw + _i * 8192), 16, 0, 0); } while (0)
#define PG8_LDA(dst, b, h) do { _Pragma("unroll") for (int m = 0; m < 4; ++m) _Pragma("unroll") for (int k = 0; k < 2; ++k) dst[m][k] = *(const LAS bf16x8*)(lds + PG8_SA(b, h) + aoff + m * 2048 + k * 1024); } while (0)
#define PG8_LDB(dst, b, h) do { _Pragma("unroll") for (int n = 0; n < 2; ++n) _Pragma("unroll") for (int k = 0; k < 2; ++k) dst[n][k] = *(const LAS bf16x8*)(lds + PG8_SB(b, h) + boff + n * 2048 + k * 1024); } while (0)
#define PG8_MMA(ai, bj, At, Bt) do { __builtin_amdgcn_s_setprio(1); _Pragma("unroll") for (int m = 0; m < 4; ++m) _Pragma("unroll") for (int n = 0; n < 2; ++n) _Pragma("unroll") for (int k = 0; k < 2; ++k) \
        acc[ai][bj][m][n] = __builtin_amdgcn_mfma_f32_16x16x32_bf16(Bt[n][k], At[m][k], acc[ai][bj][m][n], 0, 0, 0); __builtin_amdgcn_s_setprio(0); } while (0)
#define PG8_WAIT_V(n) asm volatile("s_waitcnt vmcnt(" #n ")" ::: "memory")
#define PG8_WAIT_L(n) asm volatile("s_waitcnt lgkmcnt(" #n ")" ::: "memory")
#define PG8_BAR __builtin_amdgcn_s_barrier()
#define PG8_SCHED __builtin_amdgcn_sched_barrier(0)
    Unit cur, nxt; int ui = 0;
    if (!S.next(0, cur)) return;
    f32x4 acc[2][2][4][2];
    { const float z = opaque_zero();
#pragma unroll
    for (int a = 0; a < 2; ++a)
#pragma unroll
        for (int b = 0; b < 2; ++b)
#pragma unroll
            for (int m = 0; m < 4; ++m)
#pragma unroll
                for (int n = 0; n < 2; ++n) acc[a][b][m][n] = (f32x4){z, z, z, z}; }
    bf16x8 At[4][2], B0[2][2], B1[2][2];
    const char* cA = (const char*)g.A + (size_t)cur.pm * tstep; const char* cB = (const char*)g.Bt + (size_t)cur.pn * tstep;
    S.a_ready(cur);
    if constexpr (Epi::RSL) E.rs_fetch(cur, tid, 0);
    if constexpr (SP2) {
        PG8_STAGE(PG8_SB(0, 0), cB, voffB); PG8_STAGE(PG8_SB(0, 1), cB + hstep, voffB); PG8_STAGE(PG8_SA(0, 0), cA, voffA); PG8_STAGE(PG8_SA(0, 1), cA + hstep, voffA);
        if (wr == 1) PG8_BAR;
        PG8_WAIT_V(2); PG8_BAR;
        PG8_STAGE(PG8_SB(1, 0), cB + kstep, voffB); PG8_STAGE(PG8_SA(1, 0), cA + kstep, voffA); PG8_STAGE(PG8_SB(1, 1), cB + hstep + kstep, voffB);
        PG8_WAIT_V(6); PG8_BAR;
    } else {
        PG8_STAGE(PG8_SB(0, 0), cB, voffB); PG8_STAGE(PG8_SA(0, 0), cA, voffA); PG8_STAGE(PG8_SB(0, 1), cB + hstep, voffB); PG8_STAGE(PG8_SA(0, 1), cA + hstep, voffA);
        if (wr == 1) PG8_BAR;
        PG8_WAIT_V(4); PG8_BAR;
        PG8_STAGE(PG8_SB(1, 0), cB + kstep, voffB); PG8_STAGE(PG8_SA(1, 0), cA + kstep, voffA); PG8_STAGE(PG8_SB(1, 1), cB + hstep + kstep, voffB);
        PG8_WAIT_V(6); PG8_BAR;
    }
    for (;;) {
        const bool has_next = S.next(ui + 1, nxt);
        const char* nA = has_next ? (const char*)g.A + (size_t)nxt.pm * tstep : cA; const char* nB = has_next ? (const char*)g.Bt + (size_t)nxt.pn * tstep : cB;
        for (int t = 0; t < nt; t += 2) {
            const bool last = (t == nt - 2);
            const char* a1 = cA + (size_t)(t + 1) * kstep;
            const char* a2 = last ? nA : cA + (size_t)(t + 2) * kstep; const char* b2 = last ? nB : cB + (size_t)(t + 2) * kstep;
            const char* a3 = a2 + kstep; const char* b3 = b2 + kstep;
            if (last && has_next) S.a_ready(nxt);
            if constexpr (SP2) {
            PG8_LDB(B0, 0, 0); PG8_LDB(B1, 0, 1); PG8_SCHED; PG8_LDA(At, 0, 0); PG8_STAGE(PG8_SA(1, 1), a1 + hstep, voffA);
            PG8_WAIT_V(8); PG8_WAIT_L(0); PG8_BAR; PG8_MMA(0, 0, At, B0); PG8_MMA(0, 1, At, B1); PG8_BAR; PG8_SCHED;
            PG8_LDA(At, 0, 1); PG8_STAGE(PG8_SB(0, 0), b2, voffB); PG8_STAGE(PG8_SB(0, 1), b2 + hstep, voffB); PG8_STAGE(PG8_SA(0, 0), a2, voffA);
            PG8_WAIT_V(8); PG8_WAIT_L(0); PG8_BAR; PG8_MMA(1, 0, At, B0); PG8_MMA(1, 1, At, B1); PG8_BAR; PG8_SCHED;
            PG8_LDB(B0, 1, 0); PG8_LDB(B1, 1, 1); PG8_SCHED; PG8_LDA(At, 1, 0); PG8_STAGE(PG8_SA(0, 1), a2 + hstep, voffA);
            PG8_WAIT_V(8); PG8_WAIT_L(0); PG8_BAR; PG8_MMA(0, 0, At, B0); PG8_MMA(0, 1, At, B1); PG8_BAR; PG8_SCHED;
            PG8_LDA(At, 1, 1); PG8_STAGE(PG8_SB(1, 0), b3, voffB); PG8_STAGE(PG8_SB(1, 1), b3 + hstep, voffB); PG8_STAGE(PG8_SA(1, 0), a3, voffA);
            PG8_WAIT_V(8); PG8_WAIT_L(0); PG8_BAR; PG8_MMA(1, 0, At, B0); PG8_MMA(1, 1, At, B1); PG8_BAR; PG8_SCHED;
            } else {
            PG8_LDB(B0, 0, 0); PG8_SCHED; PG8_LDA(At, 0, 0); PG8_STAGE(PG8_SA(1, 1), a1 + hstep, voffA);
            PG8_WAIT_L(8); PG8_BAR; PG8_WAIT_L(0); PG8_MMA(0, 0, At, B0); PG8_BAR; PG8_SCHED;
            PG8_LDB(B1, 0, 1); PG8_STAGE(PG8_SB(0, 0), b2, voffB);
            PG8_BAR; PG8_WAIT_L(0); PG8_MMA(0, 1, At, B1); PG8_BAR;
            PG8_LDA(At, 0, 1); PG8_STAGE(PG8_SA(0, 0), a2, voffA);
            PG8_BAR; PG8_WAIT_L(0); PG8_MMA(1, 0, At, B0); PG8_BAR; PG8_SCHED;
            PG8_STAGE(PG8_SB(0, 1), b2 + hstep, voffB);
            PG8_WAIT_V(6); PG8_BAR; PG8_MMA(1, 1, At, B1); PG8_BAR;
            PG8_LDB(B0, 1, 0); PG8_SCHED; PG8_LDA(At, 1, 0); PG8_STAGE(PG8_SA(0, 1), a2 + hstep, voffA);
            PG8_WAIT_L(8); PG8_BAR; PG8_WAIT_L(0); PG8_MMA(0, 0, At, B0); PG8_BAR; PG8_SCHED;
            PG8_LDB(B1, 1, 1); PG8_STAGE(PG8_SB(1, 0), b3, voffB);
            PG8_BAR; PG8_WAIT_L(0); PG8_MMA(0, 1, At, B1); PG8_BAR;
            PG8_LDA(At, 1, 1); PG8_STAGE(PG8_SA(1, 0), a3, voffA);
            PG8_BAR; PG8_WAIT_L(0); PG8_MMA(1, 0, At, B0); PG8_BAR; PG8_SCHED;
            PG8_STAGE(PG8_SB(1, 1), b3 + hstep, voffB);
            PG8_WAIT_V(6); PG8_BAR; PG8_MMA(1, 1, At, B1); PG8_BAR;
            }
        }
        if constexpr (ALIGN_EPI) { if (wr == 0) PG8_BAR; }
        if constexpr (!Epi::AFTER_DRAIN) { E(acc, cur, wr, wc, fr, fq, ui & 1); S.done(cur); if constexpr (Epi::RSL) { if (has_next) E.rs_fetch(nxt, tid, (ui + 1) & 1); } }
        if (!has_next) break;
        { const float z = opaque_zero();
#pragma unroll
        for (int a = 0; a < 2; ++a)
#pragma unroll
            for (int b = 0; b < 2; ++b)
#pragma unroll
                for (int m = 0; m < 4; ++m)
#pragma unroll
                    for (int n = 0; n < 2; ++n) acc[a][b][m][n] = (f32x4){z, z, z, z}; }
        cur = nxt; cA = nA; cB = nB; ++ui;
        if constexpr (ALIGN_EPI) { if (wr == 1) PG8_BAR; }
    }
    PG8_WAIT_V(0);
    if constexpr (!ALIGN_EPI) { if (wr == 0) PG8_BAR; }
    PG8_BAR;
#undef PG8_SA
#undef PG8_SB
#undef PG8_STAGE
#undef PG8_LDA
#undef PG8_LDB
#undef PG8_MMA
#undef PG8_WAIT_V
#undef PG8_WAIT_L
#undef PG8_BAR
#undef PG8_SCHED
}
}

struct SEpiBf16 { bf16* O; int ldc; int act; const float* rstd;
    __device__ __forceinline__ void operator()(int row, int col, f32x4 s0, f32x4 s1) const {
        { const float r_ = rstd[row]; s0 = s0 * r_; s1 = s1 * r_; }
        if (act) {
#pragma unroll
            for (int j = 0; j < 4; ++j) { const float a = fmaxf(s0[j], 0.f), b = fmaxf(s1[j], 0.f); s0[j] = a * a; s1[j] = b * b; } }
        u32x4 w; w.x = cvtpk(s0[0], s0[1]); w.y = cvtpk(s0[2], s0[3]); w.z = cvtpk(s1[0], s1[1]); w.w = cvtpk(s1[2], s1[3]);
        *(u32x4*)(O + (size_t)row * ldc + col) = w; } };
struct SEpiResAdd { bf16* XB; float* Y; int ldc; bool fin;
    __device__ __forceinline__ void operator()(int row, int col, f32x4 s0, f32x4 s1) const {
        const size_t off = (size_t)row * ldc + col; const u32x4 w = *(const u32x4*)(XB + off);
        const f32x4 v0 = (f32x4){bflo(w.x) + s0[0], bfhi(w.x) + s0[1], bflo(w.y) + s0[2], bfhi(w.y) + s0[3]}, v1 = (f32x4){bflo(w.z) + s1[0], bfhi(w.z) + s1[1], bflo(w.w) + s1[2], bfhi(w.w) + s1[3]};
        if (fin) { *(f32x4*)(Y + off) = v0; *(f32x4*)(Y + off + 4) = v1; }
        else { u32x4 o; o.x = cvtpk(v0[0], v0[1]); o.y = cvtpk(v0[2], v0[3]); o.z = cvtpk(v1[0], v1[1]); o.w = cvtpk(v1[2], v1[3]); *(u32x4*)(XB + off) = o; } } };
template <class Epi>
__device__ __forceinline__ void sample_gemm(LAS unsigned char* lds, int wave, int vcu, int G, const bf16* __restrict__ A, const bf16* __restrict__ Bt, int N, int K, const Epi& E) {
    int ln_; asm volatile("v_mbcnt_lo_u32_b32 %0, -1, 0\n\tv_mbcnt_hi_u32_b32 %0, -1, %0" : "=v"(ln_)); const int tid = wave * 64 + ln_;
    const int lane = tid & 63, fr = lane & 15, fq = lane >> 4;
    const int ntiles = 4 * (N >> 6), kslice = K >> 3, kb = wave * kslice;
    LAS float* red = (LAS float*)lds;
    for (int t = vcu; t < ntiles; t += G) {
        const int rt = t & 3, ct = t >> 2;
        f32x4 acc[4][4];
        { const float z = opaque_zero();
#pragma unroll
          for (int m = 0; m < 4; ++m)
#pragma unroll
              for (int n = 0; n < 4; ++n) acc[m][n] = (f32x4){z, z, z, z}; }
        const bf16* ap = A + (size_t)(rt * 64 + fr) * K + kb + 8 * fq;
        const bf16* bp = Bt + (size_t)(ct * 64 + fr) * K + kb + 8 * fq;
        const size_t r16 = (size_t)16 * K;
#pragma unroll 4
        for (int k = 0; k < kslice; k += 64) {
            bf16x8 a0[4], a1[4], b0[4], b1[4];
#pragma unroll
            for (int m = 0; m < 4; ++m) { a0[m] = *(const bf16x8*)(ap + m * r16 + k); a1[m] = *(const bf16x8*)(ap + m * r16 + k + 32); }
#pragma unroll
            for (int n = 0; n < 4; ++n) { b0[n] = *(const bf16x8*)(bp + n * r16 + k); b1[n] = *(const bf16x8*)(bp + n * r16 + k + 32); }
#pragma unroll
            for (int m = 0; m < 4; ++m)
#pragma unroll
                for (int n = 0; n < 4; ++n) { acc[m][n] = __builtin_amdgcn_mfma_f32_16x16x32_bf16(a0[m], b0[n], acc[m][n], 0, 0, 0);
                                              acc[m][n] = __builtin_amdgcn_mfma_f32_16x16x32_bf16(a1[m], b1[n], acc[m][n], 0, 0, 0); }
        }
        __syncthreads();
#pragma unroll
        for (int m = 0; m < 4; ++m)
#pragma unroll
            for (int n = 0; n < 4; ++n)
#pragma unroll
                for (int j = 0; j < 4; ++j) red[wave * 4096 + (16 * m + 4 * fq + j) * 64 + 16 * n + fr] = acc[m][n][j];
        __syncthreads();
        const int row = tid >> 3, col = (tid & 7) * 8;
        f32x4 s0 = *(const LAS f32x4*)(red + row * 64 + col), s1 = *(const LAS f32x4*)(red + row * 64 + col + 4);
#pragma unroll
        for (int w = 1; w < 8; ++w) { s0 = s0 + *(const LAS f32x4*)(red + w * 4096 + row * 64 + col); s1 = s1 + *(const LAS f32x4*)(red + w * 4096 + row * 64 + col + 4); }
        E(rt * 64 + row, ct * 64 + col, s0, s1);
    }
    __syncthreads();
}

#define XB_TMO      128
#define XB_XCNT(j)  (256  + 64 * (j))
#define XB_XSUB(j)  (1280 + 64 * (j))
#define XB_XGEN(j)  (2304 + 64 * (j))
#define XB_TOP      3328
#define XB_TOPGEN   3392
#define XCD_BAR_WORDS 3456
#define XB_SPIN_CAP (1u << 18)
__device__ __forceinline__ unsigned xb_ld(unsigned* p)              { return __hip_atomic_load(p, __ATOMIC_RELAXED, __HIP_MEMORY_SCOPE_AGENT); }
__device__ __forceinline__ unsigned xb_add(unsigned* p, unsigned v) { return __hip_atomic_fetch_add(p, v, __ATOMIC_RELAXED, __HIP_MEMORY_SCOPE_AGENT); }
__device__ __forceinline__ unsigned xb_xcc_id() { return (unsigned)__builtin_amdgcn_s_getreg((3 << 11) | 20) & 0xFu; }
#define XB_SPIN(cond, bar) do { unsigned _sp = 0; while (cond) { __builtin_amdgcn_s_sleep(1); \
    if ((++_sp & 255u) == 0u) { if (xb_ld(&(bar)[XB_TMO])) break; if (_sp > XB_SPIN_CAP) { atomicAdd(&(bar)[XB_TMO], 1u); break; } } } } while (0)
struct XcdBarrier { unsigned* bar; unsigned x; volatile LAS unsigned* st; };
__device__ __forceinline__ XcdBarrier xcd_barrier_post(unsigned* bar, volatile LAS unsigned* st, bool leader) {
    XcdBarrier b; b.bar = bar; b.x = xb_xcc_id(); b.st = st;
    if (leader) (void)xb_add(&bar[XB_XCNT(b.x)], 1u);
    return b;
}
__device__ __forceinline__ void xcd_barrier_complete(unsigned* bar, unsigned x, unsigned& nloc, unsigned& nx) {
    const unsigned G = gridDim.x * gridDim.y * gridDim.z;
    unsigned sum, cnt, mine, sp = 0u;
    for (;;) {
        sum = 0u; cnt = 0u; mine = 0u;
#pragma unroll
        for (unsigned j = 0; j < 16; ++j) { const unsigned c = xb_ld(&bar[XB_XCNT(j)]); sum += c; cnt += (c > 0u) ? 1u : 0u; mine = (j == x) ? c : mine; }
        if (sum == G) break;
        __builtin_amdgcn_s_sleep(1);
        if ((++sp & 255u) == 0u) { if (xb_ld(&bar[XB_TMO])) break; if (sp > XB_SPIN_CAP) { atomicAdd(&bar[XB_TMO], 1u); break; } }
    }
    nloc = mine > 0u ? mine : 1u; nx = cnt > 0u ? cnt : 1u;
}
__device__ __noinline__ void xcd_barrier(unsigned* bar_, unsigned x_, volatile LAS unsigned* st_, int wave_) {
    XcdBarrier b; b.bar = bar_; b.x = x_; b.st = st_;
    int ln_; asm volatile("v_mbcnt_lo_u32_b32 %0, -1, 0\n\tv_mbcnt_hi_u32_b32 %0, -1, %0" : "=v"(ln_)); const bool leader_ = (wave_ == 0) && (ln_ == 0);
    asm volatile("s_waitcnt vmcnt(0)" ::: "memory");
    __syncthreads();
    if (leader_) {
        unsigned* bar = b.bar;
        __builtin_amdgcn_s_waitcnt(0);
        unsigned nloc = b.st[0], nx = b.st[1];
        if (nloc == 0u) { xcd_barrier_complete(bar, b.x, nloc, nx); b.st[0] = nloc; b.st[1] = nx; }
        const unsigned old = xb_add(&bar[XB_XSUB(b.x)], 1u);
        const unsigned gen = old / nloc;
        if (old + 1u == (gen + 1u) * nloc) {
            __builtin_amdgcn_fence(__ATOMIC_RELEASE, "agent");
            asm volatile("s_waitcnt vmcnt(0)" ::: "memory");
            const unsigned og = xb_add(&bar[XB_TOP], 1u);
            const unsigned tg = og / nx;
            if (og + 1u == (tg + 1u) * nx) xb_add(&bar[XB_TOPGEN], 1u);
            else XB_SPIN(xb_ld(&bar[XB_TOPGEN]) == tg, bar);
            __builtin_amdgcn_fence(__ATOMIC_ACQUIRE, "agent");
            xb_add(&bar[XB_XGEN(b.x)], 1u);
            asm volatile("s_waitcnt vmcnt(0)" ::: "memory");
        } else {
            XB_SPIN(xb_ld(&bar[XB_XGEN(b.x)]) == gen, bar);
            __builtin_amdgcn_fence(__ATOMIC_ACQUIRE, "agent");
            asm volatile("s_waitcnt vmcnt(0)" ::: "memory");
        }
    }
    __syncthreads();
}

#define KSWZ(row, colB) ((row) * 256 + ((colB) ^ (((row) & 7) << 4)))
__device__ __forceinline__ int crow(int r, int hi) { return (r & 3) + 8 * (r >> 2) + 4 * hi; }
__device__ __forceinline__ int v_st(int k, int c) { const int kk = (k & ~0xC) | ((k & 4) << 1) | ((k & 8) >> 1); return ((kk >> 3) * 4 + (c >> 5)) * 512 + ((kk & 7) * 32 + (c & 31)) * 2; }
__device__ __forceinline__ int v_rd_base(int lane) { return ((lane & 3) << 3) | (((lane >> 2) & 3) << 6) | (((lane >> 4) & 1) << 5) | (((lane >> 5) & 1) << 8); }
constexpr int v_rd_off(int d0, int ks, int half) { return d0 * 512 + ks * 4096 + half * 2048; }
template <int OFF> __device__ __forceinline__ s16x4 tr_read(int vb) {
    s16x4 r; asm volatile("ds_read_b64_tr_b16 %0, %1 offset:%2" : "=&v"(r) : "v"(vb), "i"(OFF) : "memory"); return r;
}
#define PKLH(L, H) (bf16x8){L[0], L[1], L[2], L[3], H[0], H[1], H[2], H[3]}
template <int D0> __device__ __forceinline__ void pv_one(f32x16& od, int vb, bf16x8 pa0, bf16x8 pa1, bf16x8 pa2, bf16x8 pa3) {
    const s16x4 l0 = tr_read<v_rd_off(D0, 0, 0)>(vb), h0 = tr_read<v_rd_off(D0, 0, 1)>(vb), l1 = tr_read<v_rd_off(D0, 1, 0)>(vb), h1 = tr_read<v_rd_off(D0, 1, 1)>(vb);
    const s16x4 l2 = tr_read<v_rd_off(D0, 2, 0)>(vb), h2 = tr_read<v_rd_off(D0, 2, 1)>(vb), l3 = tr_read<v_rd_off(D0, 3, 0)>(vb), h3 = tr_read<v_rd_off(D0, 3, 1)>(vb);
    asm volatile("s_waitcnt lgkmcnt(0)" ::: "memory"); SBAR();
    od = __builtin_amdgcn_mfma_f32_32x32x16_bf16(pa0, PKLH(l0, h0), od, 0, 0, 0);
    od = __builtin_amdgcn_mfma_f32_32x32x16_bf16(pa1, PKLH(l1, h1), od, 0, 0, 0);
    od = __builtin_amdgcn_mfma_f32_32x32x16_bf16(pa2, PKLH(l2, h2), od, 0, 0, 0);
    od = __builtin_amdgcn_mfma_f32_32x32x16_bf16(pa3, PKLH(l3, h3), od, 0, 0, 0);
}
__device__ __forceinline__ void pv_d0(f32x16* o, int vb, bf16x8 pa0, bf16x8 pa1, bf16x8 pa2, bf16x8 pa3) {
    pv_one<0>(o[0], vb, pa0, pa1, pa2, pa3); pv_one<1>(o[1], vb, pa0, pa1, pa2, pa3); pv_one<2>(o[2], vb, pa0, pa1, pa2, pa3); pv_one<3>(o[3], vb, pa0, pa1, pa2, pa3);
}
template <int D0, int KS> __device__ __forceinline__ bf16x8 tr_frag(int vb) {
    const s16x4 l = tr_read<v_rd_off(D0, KS, 0)>(vb), h = tr_read<v_rd_off(D0, KS, 1)>(vb);
    return PKLH(l, h);
}
__device__ __forceinline__ void qkt(f32x16& p0, f32x16& p1, int Ks  , const bf16x8* qr, int r32, int hi) {
    p0 = f32x16{}; p1 = f32x16{};
#pragma unroll
    for (int d0 = 0; d0 < 8; ++d0) { const int cb = (d0 * 16 + hi * 8) * 2;
        const bf16x8 b0 = *(const LAS bf16x8*)(uintptr_t)(unsigned)(Ks + KSWZ(r32, cb));
        const bf16x8 b1 = *(const LAS bf16x8*)(uintptr_t)(unsigned)(Ks + KSWZ(32 + r32, cb));
        p0 = __builtin_amdgcn_mfma_f32_32x32x16_bf16(b0, qr[d0], p0, 0, 0, 0);
        p1 = __builtin_amdgcn_mfma_f32_32x32x16_bf16(b1, qr[d0], p1, 0, 0, 0); }
}
#define PK4(P, BASE, OUT) do { unsigned a0 = cvtpk(P[BASE + 0], P[BASE + 1]), a1 = cvtpk(P[BASE + 2], P[BASE + 3]);   \
    unsigned b0 = cvtpk(P[BASE + 4], P[BASE + 5]), b1 = cvtpk(P[BASE + 6], P[BASE + 7]);                              \
    auto r0 = __builtin_amdgcn_permlane32_swap(a0, b0, false, false); auto r1 = __builtin_amdgcn_permlane32_swap(a1, b1, false, false); \
    u32x4 w = {r0[0], r1[0], r0[1], r1[1]}; OUT = *reinterpret_cast<bf16x8*>(&w); } while (0)
__device__ __forceinline__ float half_swap_add(float v) { auto rr = __builtin_amdgcn_permlane32_swap(__float_as_uint(v), __float_as_uint(v), false, false); return __uint_as_float(rr[0]) + __uint_as_float(rr[1]); }
__device__ __forceinline__ float half_swap_max(float v) { auto rr = __builtin_amdgcn_permlane32_swap(__float_as_uint(v), __float_as_uint(v), false, false); return fmaxf(__uint_as_float(rr[0]), __uint_as_float(rr[1])); }

struct Args {
    const float* x_prompt; const float* x_sample; const float* cache_k; const float* cache_v; const float* state_conv; const float* state_c; const float* state_n; const float* state_m;
    const float* norm_mix_g; const float* w_in; const float* conv_w; const float* q_norm_g; const float* k_norm_g; const float* rel_bias; const float* b_igate; const float* b_fgate;
    const float* mlstm_norm_g; const float* w_out; const float* norm_mlp_g; const float* w_up; const float* w_down;
    float* out; unsigned char* ws; int ph_lo, ph_hi, rep, pad;
};
struct Ctx {
    LAS unsigned char* lds; int tid, lane, wave, G, vcu;
};
constexpr int NPH_LAYER = 9, NPHASES = DEPTH * NPH_LAYER;
__device__ __forceinline__ int hw_tid(int wave) { int ln; asm volatile("v_mbcnt_lo_u32_b32 %0, -1, 0\n\tv_mbcnt_hi_u32_b32 %0, -1, %0" : "=v"(ln)); return wave * 64 + ln; }
__device__ __forceinline__ Ctx relaunder(const Ctx& c) { Ctx d = c; const int t = hw_tid(c.wave); d.tid = t; d.lane = t & 63; return d; }

__device__ __forceinline__ void transpose_item(const float* W, int K, int ldn, int nblk, bf16* WT, LAS float* scr, int item, int lane, const float* gain = nullptr) {
    const int kb = item / nblk, nb = item % nblk, k0 = 64 * kb, n0 = 32 * nb;
    const int c = lane & 7;
    f32x4 g0 = (f32x4){1.f, 1.f, 1.f, 1.f}, g1 = g0;
    if (gain) { g0 = *(const f32x4*)(gain + k0 + 8 * c); g1 = *(const f32x4*)(gain + k0 + 8 * c + 4); }
#pragma unroll 8
    for (int i = 0; i < 32; ++i) { const int kk = 2 * i + (lane >> 5); scr[kk * 33 + (lane & 31)] = W[(size_t)(k0 + kk) * ldn + n0 + (lane & 31)]; }
    LDS_WAIT(); asm volatile("" ::: "memory");
#pragma unroll
    for (int j = 0; j < 4; ++j) { const int n = (lane >> 3) + 8 * j; const LAS float* s = scr + (8 * c) * 33 + n;
        u32x4 o; o.x = cvtpk(s[0 * 33] * g0[0], s[1 * 33] * g0[1]); o.y = cvtpk(s[2 * 33] * g0[2], s[3 * 33] * g0[3]); o.z = cvtpk(s[4 * 33] * g1[0], s[5 * 33] * g1[1]); o.w = cvtpk(s[6 * 33] * g1[2], s[7 * 33] * g1[3]);
        *(GAS u32x4*)(WT + (size_t)(n0 + n) * K + k0 + 8 * c) = o; }
    LDS_WAIT(); asm volatile("" ::: "memory");
}
__device__ __forceinline__ void convert_weights(const Args& a, const Ctx& c, int l) {
    LAS float* scr = (LAS float*)(c.lds + c.wave * 16384);
    const int gw = c.vcu * NWAVES + c.wave, NGW = c.G * NWAVES;
    constexpr int I_IN = (D / 64) * (NPROJ / 32), I_OUT = (D / 64) * (D / 32), I_UP = (D / 64) * (FF / 32), I_DN = (FF / 64) * (D / 32), I_L = I_IN + I_OUT + I_UP + I_DN;
    for (int it = gw; it < I_L; it += NGW) {
        int r = it;
        if (r < I_IN) { transpose_item(a.w_in + (size_t)l * D * IN_DIM, D, IN_DIM, NPROJ / 32, (bf16*)(a.ws + WS_WIN), scr, r, c.lane, a.norm_mix_g + (size_t)l * D); continue; } r -= I_IN;
        if (r < I_OUT) { transpose_item(a.w_out + (size_t)l * D * D, D, D, D / 32, (bf16*)(a.ws + WS_WOUT), scr, r, c.lane); continue; } r -= I_OUT;
        if (r < I_UP) { transpose_item(a.w_up + (size_t)l * D * FF, D, FF, FF / 32, (bf16*)(a.ws + WS_WUP), scr, r, c.lane, a.norm_mlp_g + (size_t)l * D); continue; } r -= I_UP;
        transpose_item(a.w_down + (size_t)l * FF * D, FF, D, D / 32, (bf16*)(a.ws + WS_WDN), scr, r, c.lane);
    }
}

__device__ __forceinline__ void build_kv_image(const Args& a, int w, int nw, int tid, int l) {
    bf16* SK = (bf16*)(a.ws + WS_SK + (size_t)(l & 1) * SKV_IMG); bf16* SV = (bf16*)(a.ws + WS_SV + (size_t)(l & 1) * SKV_IMG);
    const unsigned gt = (unsigned)w * NTHREADS + tid, NT = (unsigned)nw * NTHREADS;
    constexpr unsigned NCH = (unsigned)SBATCH * 512 * 1024 / 8;
    for (unsigned i = gt; i < 2 * NCH; i += NT) {
        const bool isv = i >= NCH; const unsigned j = isv ? i - NCH : i; const unsigned e = j * 8; const unsigned b = e / (512 * 1024); const unsigned rem = e % (512 * 1024);
        const float* src = (isv ? a.cache_v : a.cache_k) + ((size_t)(l * SBATCH + b) * 512 * 1024) + rem;
        const f32x4 x0 = *(const f32x4*)src, x1 = *(const f32x4*)(src + 4);
        u32x4 w4; w4.x = cvtpk(x0.x, x0.y); w4.y = cvtpk(x0.z, x0.w); w4.z = cvtpk(x1.x, x1.y); w4.w = cvtpk(x1.z, x1.w);
        *(u32x4*)((isv ? SV : SK) + (size_t)b * SKV_ROWS * 1024 + rem) = w4;
    }
    constexpr unsigned NZ = (unsigned)SBATCH * (SKV_ROWS - 544) * 1024 / 8;
    for (unsigned i = gt; i < 2 * NZ; i += NT) {
        const bool isv = i >= NZ; const unsigned j = isv ? i - NZ : i; const unsigned e = j * 8; const unsigned b = e / ((SKV_ROWS - 544) * 1024); const unsigned rem = e % ((SKV_ROWS - 544) * 1024);
        { const unsigned z = __float_as_uint(opaque_zero()); *(u32x4*)((isv ? SV : SK) + ((size_t)b * SKV_ROWS + 544) * 1024 + rem) = (u32x4){z, z, z, z}; }
    }
}
__device__ __forceinline__ float log_sigmoid(float x) { return fminf(x, 0.f) - fast_log(1.0f + fast_exp(-fabsf(x))); }
template <bool FIRST  >
__device__ __forceinline__ void phase_norm(const Args& a, const Ctx& c_in0, int l) {
    const Ctx c = relaunder(c_in0);
    bf16* XB = (bf16*)(a.ws + WS_XB); bf16* H = (bf16*)(a.ws + WS_H);
    const float* g = (FIRST ? a.norm_mix_g : a.norm_mlp_g) + (size_t)l * D;
    LAS float* Wg = (LAS float*)c.lds;
    if (FIRST) {
        convert_weights(a, c, l);
        __syncthreads();
        const float* wsrc = a.w_in + (size_t)l * D * IN_DIM + NPROJ;
        for (int idx = c.tid; idx < 8 * D; idx += NTHREADS) { const int k = idx >> 3, o = idx & 7; Wg[o * D + k] = wsrc[(size_t)k * IN_DIM + o]; }
        __syncthreads();
    }
    const int gw = c.vcu * NWAVES + c.wave, NGW = c.G * NWAVES;
    f32x4 gv[8];
#pragma unroll
    for (int j = 0; j < 8; ++j) gv[j] = *(const f32x4*)(g + 4 * c.lane + 256 * j);
    for (int row = gw; row < MR; row += NGW) {
        f32x4 v[8]; float s = 0.f;
        if (FIRST && l == 0) {
            const float* src = row < MP ? a.x_prompt + (size_t)row * D : a.x_sample + (size_t)(row - MP) * D;
#pragma unroll
            for (int j = 0; j < 8; ++j) v[j] = *(const f32x4*)(src + 4 * c.lane + 256 * j);
#pragma unroll
            for (int j = 0; j < 8; ++j) { u32x2 w; w.x = cvtpk(v[j].x, v[j].y); w.y = cvtpk(v[j].z, v[j].w); *(u32x2*)(XB + (size_t)row * D + 4 * c.lane + 256 * j) = w; }
        } else {
            u32x2 w[8];
#pragma unroll
            for (int j = 0; j < 8; ++j) w[j] = *(const u32x2*)(XB + (size_t)row * D + 4 * c.lane + 256 * j);
#pragma unroll
            for (int j = 0; j < 8; ++j) v[j] = (f32x4){bflo(w[j].x), bfhi(w[j].x), bflo(w[j].y), bfhi(w[j].y)};
        }
#pragma unroll
        for (int j = 0; j < 8; ++j) s += (v[j].x * v[j].x + v[j].y * v[j].y) + (v[j].z * v[j].z + v[j].w * v[j].w);
        const float rstd = fast_rsqrt(wave_sum(s, c.lane) * (1.f / D) + EPS);
        if (c.lane == 0) ((float*)(a.ws + WS_RSTD))[row] = rstd;
        if (FIRST) {
#pragma unroll
            for (int j = 0; j < 8; ++j) v[j] = v[j] * rstd * gv[j];
            float ga[8];
#pragma unroll
            for (int o = 0; o < 8; ++o) { float t = 0.f;
#pragma unroll
                for (int j = 0; j < 8; ++j) { const f32x4 w4 = *(const LAS f32x4*)(Wg + o * D + 4 * c.lane + 256 * j); t += (v[j].x * w4.x + v[j].y * w4.y) + (v[j].z * w4.z + v[j].w * w4.w); }
                ga[o] = wave_sum(t, c.lane); }
            float val = ga[0];
#pragma unroll
            for (int o = 1; o < 8; ++o) val = (c.lane == o) ? ga[o] : val;
            if (c.lane < 8) {
                float r;
                if (c.lane < 4) r = val + a.b_igate[l * MH + c.lane];
                else r = log_sigmoid(val + a.b_fgate[l * MH + c.lane - 4]);
                ((float*)(a.ws + WS_GATE))[(size_t)row * 8 + c.lane] = r;
            }
        }
    }
    if (FIRST && l == 0) build_kv_image(a, c.vcu, c.G, c.tid, 0);
}

__device__ __forceinline__ float scan256_sum(float v, int tid, int lane, int wave, LAS float* tot  ) {
#pragma unroll
    for (int o = 1; o < 64; o <<= 1) { const float t = shup(v, o, lane); if (lane >= o) v += t; }
    if (lane == 63) tot[wave] = v;
    __syncthreads();
    float off = 0.f;
#pragma unroll
    for (int w = 0; w < 3; ++w) off += (w < wave) ? tot[w] : 0.f;
    __syncthreads();
    return v + off;
}
__device__ __forceinline__ float scan256_max(float v, int tid, int lane, int wave, LAS float* tot) {
#pragma unroll
    for (int o = 1; o < 64; o <<= 1) { const float t = shup(v, o, lane); if (lane >= o) v = fmaxf(v, t); }
    if (lane == 63) tot[wave] = v;
    __syncthreads();
    float off = -3.0e38f;
#pragma unroll
    for (int w = 0; w < 3; ++w) off = (w < wave) ? fmaxf(off, tot[w]) : off;
    __syncthreads();
    return fmaxf(v, off);
}

__device__ __forceinline__ void m1_unit(const Args& a, const Ctx& c_in, int l, int unit) {
    const int g = unit & 31, bh = unit >> 5, b = bh >> 2, h = bh & 3;
    const bf16* PROJ = (const bf16*)(a.ws + WS_BIG);
    const float* GATE = (const float*)(a.ws + WS_GATE);
    Ctx c = c_in; { int t_ = c.tid; asm volatile("" : "+v"(t_)); c.tid = t_; c.lane = t_ & 63; }
    LAS float* scr = (LAS float*)(c.lds + SCR_OFF);
    LAS float* W_S = scr;
    LAS float* NACC = scr + 256;
    LAS float* TOT = scr + 384;
    LAS float* SCAL = scr + 392;
    const int row0 = b * SEQ + g * 256;
    __syncthreads();
    float li = 0.f, lf = 0.f;
    if (c.tid < 256) { li = GATE[(size_t)(row0 + c.tid) * 8 + h]; lf = GATE[(size_t)(row0 + c.tid) * 8 + 4 + h]; }
    const float bc = scan256_sum(lf, c.tid, c.lane, c.wave, TOT);
    const float as = li - bc;
    const float am = scan256_max(c.tid < 256 ? as : -3.0e38f, c.tid, c.lane, c.wave, TOT);
    if (c.tid == 255) { SCAL[0] = am; SCAL[1] = bc; }
    __syncthreads();
    const float amax = SCAL[0], blast = SCAL[1];
    if (c.tid < 256) W_S[c.tid] = fast_exp(as - amax);
    __syncthreads();
    const int sr = c.tid >> 4, sc = (c.tid & 15) * 8;
#pragma unroll
    for (int t = 0; t < 4; ++t)
#pragma unroll
        for (int hh = 0; hh < 2; ++hh) {
            const int rr = t * 64 + hh * 32 + sr; const size_t ro = (size_t)(row0 + rr) * NPROJ;
            const u32x4 kq = *(const u32x4*)(PROJ + ro + C_MK + h * HD + sc);
            const u32x4 vq = *(const u32x4*)(PROJ + ro + C_MV + h * HD + sc);
            const float w = W_S[rr] * 0.08838834764831845f;
            float kf[8] = {bflo(kq.x) * w, bfhi(kq.x) * w, bflo(kq.y) * w, bfhi(kq.y) * w, bflo(kq.z) * w, bfhi(kq.z) * w, bflo(kq.w) * w, bfhi(kq.w) * w};
            u32x4 kw; kw.x = cvtpk(kf[0], kf[1]); kw.y = cvtpk(kf[2], kf[3]); kw.z = cvtpk(kf[4], kf[5]); kw.w = cvtpk(kf[6], kf[7]);
            *(LAS u32x4*)(c.lds + t * 16384 + v_st(hh * 32 + sr, sc)) = kw;
            *(LAS u32x4*)(c.lds + 65536 + t * 16384 + v_st(hh * 32 + sr, sc)) = vq;
        }
    __syncthreads();
    if (c.tid < 128) {
        float s = 0.f;
        for (int k = 0; k < 256; ++k) s += bf2f(*(const LAS bf16*)(c.lds + (k >> 6) * 16384 + v_st(k & 63, c.tid)));
        NACC[c.tid] = s;
    }
    __syncthreads();
    const int Da = c.wave >> 1, Db0 = 2 * (c.wave & 1);
    f32x16 acc0 = f32x16{}, acc1 = f32x16{};
    const int vbk = (int)(uintptr_t)(c.lds) + v_rd_base(c.lane) + Da * 512;
    const int vbv = (int)(uintptr_t)(c.lds) + 65536 + v_rd_base(c.lane) + Db0 * 512;
#pragma unroll
    for (int t = 0; t < 4; ++t) {
        const int ak = vbk + t * 16384, av = vbv + t * 16384;
        const bf16x8 a0 = tr_frag<0, 0>(ak), a1 = tr_frag<0, 1>(ak), a2 = tr_frag<0, 2>(ak), a3 = tr_frag<0, 3>(ak);
        const bf16x8 b00 = tr_frag<0, 0>(av), b01 = tr_frag<0, 1>(av), b02 = tr_frag<0, 2>(av), b03 = tr_frag<0, 3>(av);
        const bf16x8 b10 = tr_frag<1, 0>(av), b11 = tr_frag<1, 1>(av), b12 = tr_frag<1, 2>(av), b13 = tr_frag<1, 3>(av);
        asm volatile("s_waitcnt lgkmcnt(0)" ::: "memory"); SBAR();
        acc0 = __builtin_amdgcn_mfma_f32_32x32x16_bf16(a0, b00, acc0, 0, 0, 0); acc1 = __builtin_amdgcn_mfma_f32_32x32x16_bf16(a0, b10, acc1, 0, 0, 0);
        acc0 = __builtin_amdgcn_mfma_f32_32x32x16_bf16(a1, b01, acc0, 0, 0, 0); acc1 = __builtin_amdgcn_mfma_f32_32x32x16_bf16(a1, b11, acc1, 0, 0, 0);
        acc0 = __builtin_amdgcn_mfma_f32_32x32x16_bf16(a2, b02, acc0, 0, 0, 0); acc1 = __builtin_amdgcn_mfma_f32_32x32x16_bf16(a2, b12, acc1, 0, 0, 0);
        acc0 = __builtin_amdgcn_mfma_f32_32x32x16_bf16(a3, b03, acc0, 0, 0, 0); acc1 = __builtin_amdgcn_mfma_f32_32x32x16_bf16(a3, b13, acc1, 0, 0, 0);
    }
    float* CL = (float*)(a.ws + WS_CLOC) + (size_t)unit * HD * HD;
    const int r32 = c.lane & 31, hi = c.lane >> 5;
#pragma unroll
    for (int r = 0; r < 16; ++r) { const int d = 32 * Da + crow(r, hi);
        CL[(size_t)d * HD + 32 * Db0 + r32] = acc0[r]; CL[(size_t)d * HD + 32 * (Db0 + 1) + r32] = acc1[r]; }
    if (c.tid < 128) ((float*)(a.ws + WS_NLOC))[(size_t)unit * HD + c.tid] = NACC[c.tid];
    if (c.tid == 0) { float* ms = (float*)(a.ws + WS_MSC) + (size_t)unit * 4; ms[0] = blast + amax; ms[1] = blast; }
}

__device__ __forceinline__ void sample_mixers(const Args& a, const Ctx& c, int l);
template <bool WITH_QK>
__device__ __forceinline__ void phase_c(const Args& a, const Ctx& c_in0, int l) {
    const Ctx c = relaunder(c_in0);
    bf16* PROJ = (bf16*)(a.ws + WS_BIG); bf16* MIX = (bf16*)(a.ws + WS_H);
    constexpr int WSMP = SBATCH * NH + SBATCH * MH;
    const bool split = c.G > 2 * WSMP;
    if (WITH_QK && (!split || c.vcu < WSMP)) sample_mixers(a, c, l);
    for (int u = c.vcu; u < 16 * NGRP; u += c.G) m1_unit(a, c, l, u);
    const int gw = c.vcu * NWAVES + c.wave, NGW = c.G * NWAVES;
    if (WITH_QK) {
        const float* gq = a.q_norm_g + l * HD; const float* gk = a.k_norm_g + l * HD;
        const int gi = (16 * c.lane) & 127;
        f32x4 gqv[4], gkv[4];
#pragma unroll
        for (int j = 0; j < 4; ++j) { gqv[j] = *(const f32x4*)(gq + gi + 4 * j); gkv[j] = *(const f32x4*)(gk + gi + 4 * j); }
        bf16* SK = (bf16*)(a.ws + WS_SK + (size_t)(l & 1) * SKV_IMG); bf16* SV = (bf16*)(a.ws + WS_SV + (size_t)(l & 1) * SKV_IMG);
        constexpr int NIT = NB * KEEP;
        for (int it = gw; it < NIT; it += NGW) {
            const int row = (it / KEEP) * SEQ + (SEQ - KEEP) + (it % KEEP);
            const bf16* p = PROJ + (size_t)row * NPROJ + C_K + 16 * c.lane;
            const u32x4 w0 = *(const u32x4*)p, w1 = *(const u32x4*)(p + 8);
            const bf16* pv = PROJ + (size_t)row * NPROJ + C_V + 16 * c.lane;
            const u32x4 v0 = *(const u32x4*)pv, v1 = *(const u32x4*)(pv + 8);
            const int b = row / SEQ, t = row % SEQ; const size_t o = ((size_t)(l * NB + b) * KEEP + (t - (SEQ - KEEP))) * 1024 + 16 * c.lane;
            float* ok = a.out + O_PK + o; float* ov = a.out + O_PV + o;
            *(f32x4*)(ok + 0) = (f32x4){bflo(w0.x), bfhi(w0.x), bflo(w0.y), bfhi(w0.y)}; *(f32x4*)(ok + 4) = (f32x4){bflo(w0.z), bfhi(w0.z), bflo(w0.w), bfhi(w0.w)};
            *(f32x4*)(ok + 8) = (f32x4){bflo(w1.x), bfhi(w1.x), bflo(w1.y), bfhi(w1.y)}; *(f32x4*)(ok + 12) = (f32x4){bflo(w1.z), bfhi(w1.z), bflo(w1.w), bfhi(w1.w)};
            *(f32x4*)(ov + 0) = (f32x4){bflo(v0.x), bfhi(v0.x), bflo(v0.y), bfhi(v0.y)}; *(f32x4*)(ov + 4) = (f32x4){bflo(v0.z), bfhi(v0.z), bflo(v0.w), bfhi(v0.w)};
            *(f32x4*)(ov + 8) = (f32x4){bflo(v1.x), bfhi(v1.x), bflo(v1.y), bfhi(v1.y)}; *(f32x4*)(ov + 12) = (f32x4){bflo(v1.z), bfhi(v1.z), bflo(v1.w), bfhi(v1.w)};
        }
    }
    {
        const int ch = 8 * c.lane;
        float w0[8], w1[8], w2[8];
#pragma unroll
        for (int i = 0; i < 8; ++i) { w0[i] = a.conv_w[(size_t)(l * 3 + 0) * 512 + ch + i]; w1[i] = a.conv_w[(size_t)(l * 3 + 1) * 512 + ch + i]; w2[i] = a.conv_w[(size_t)(l * 3 + 2) * 512 + ch + i]; }
        constexpr int NSEG = SEQ / 32, NITEM = NB * NSEG + SBATCH;
        const int gwc = split ? (c.vcu - WSMP) * NWAVES + c.wave : gw, NGWc = split ? (c.G - WSMP) * NWAVES : NGW;
        for (int it = gwc; it >= 0 && it < NITEM; it += NGWc) {
            float u2[8], u1[8]; int rowb; bool samp = it >= NB * NSEG; int b, seg = 0;
            if (!samp) { b = it / NSEG; seg = it % NSEG; rowb = b * SEQ + seg * 32; } else { b = it - NB * NSEG; rowb = MP + b * SSEQ; }
#pragma unroll
            for (int i = 0; i < 8; ++i) { u2[i] = 0.f; u1[i] = 0.f; }
            if (samp) {
#pragma unroll
                for (int i = 0; i < 8; ++i) { u2[i] = a.state_conv[((size_t)(l * SBATCH + b) * 2 + 0) * 512 + ch + i]; u1[i] = a.state_conv[((size_t)(l * SBATCH + b) * 2 + 1) * 512 + ch + i]; }
            } else if (seg > 0) {
#pragma unroll
                for (int q = 0; q < 2; ++q) { const bf16* pr = PROJ + (size_t)(rowb - 2 + q) * NPROJ + ch;
                    const u32x4 xa = *(const u32x4*)(pr + C_XA), gc = *(const u32x4*)(pr + C_GC);
                    float* dst = q ? u1 : u2;
                    dst[0] = bflo(xa.x) * bflo(gc.x); dst[1] = bfhi(xa.x) * bfhi(gc.x); dst[2] = bflo(xa.y) * bflo(gc.y); dst[3] = bfhi(xa.y) * bfhi(gc.y);
                    dst[4] = bflo(xa.z) * bflo(gc.z); dst[5] = bfhi(xa.z) * bfhi(gc.z); dst[6] = bflo(xa.w) * bflo(gc.w); dst[7] = bfhi(xa.w) * bfhi(gc.w); }
            }
            for (int t0 = 0; t0 < 32; t0 += 4) {
                u32x4 xa4[4], gb4[4], gc4[4];
#pragma unroll
                for (int q = 0; q < 4; ++q) { const bf16* pr = PROJ + (size_t)(rowb + t0 + q) * NPROJ + ch; xa4[q] = *(const u32x4*)(pr + C_XA); gb4[q] = *(const u32x4*)(pr + C_GB); gc4[q] = *(const u32x4*)(pr + C_GC); }
#pragma unroll
                for (int q = 0; q < 4; ++q) { const int t = t0 + q;
                const u32x4 xa = xa4[q], gb = gb4[q], gc = gc4[q];
                float u0[8] = {bflo(xa.x) * bflo(gc.x), bfhi(xa.x) * bfhi(gc.x), bflo(xa.y) * bflo(gc.y), bfhi(xa.y) * bfhi(gc.y),
                               bflo(xa.z) * bflo(gc.z), bfhi(xa.z) * bfhi(gc.z), bflo(xa.w) * bflo(gc.w), bfhi(xa.w) * bfhi(gc.w)};
                float gbf[8] = {bflo(gb.x), bfhi(gb.x), bflo(gb.y), bfhi(gb.y), bflo(gb.z), bfhi(gb.z), bflo(gb.w), bfhi(gb.w)};
                float y[8];
#pragma unroll
                for (int i = 0; i < 8; ++i) { y[i] = gbf[i] * (w0[i] * u2[i] + w1[i] * u1[i] + w2[i] * u0[i]); u2[i] = u1[i]; u1[i] = u0[i]; }
                u32x4 o; o.x = cvtpk(y[0], y[1]); o.y = cvtpk(y[2], y[3]); o.z = cvtpk(y[4], y[5]); o.w = cvtpk(y[6], y[7]);
                *(u32x4*)(MIX + (size_t)(rowb + t) * D + ch) = o;
                }
            }
            float* oc = nullptr;
            if (samp) oc = a.out + O_SCONV + (size_t)(l * SBATCH + b) * 2 * 512 + ch;
            else if (seg == NSEG - 1) oc = a.out + O_PCONV + (size_t)(l * NB + b) * 2 * 512 + ch;
            if (oc) {
                *(f32x4*)(oc) = (f32x4){u2[0], u2[1], u2[2], u2[3]}; *(f32x4*)(oc + 4) = (f32x4){u2[4], u2[5], u2[6], u2[7]};
                *(f32x4*)(oc + 512) = (f32x4){u1[0], u1[1], u1[2], u1[3]}; *(f32x4*)(oc + 516) = (f32x4){u1[4], u1[5], u1[6], u1[7]};
            }
        }
    }
}

__device__ __forceinline__ void phase_d(const Args& a, const Ctx& c_in0, int l) {
    const Ctx c = relaunder(c_in0);
    const float* CL = (const float*)(a.ws + WS_CLOC); const float* NL = (const float*)(a.ws + WS_NLOC); float* MSC = (float*)(a.ws + WS_MSC);
    bf16* C0 = (bf16*)(a.ws + WS_C0); float* N0 = (float*)(a.ws + WS_N0);
    LAS float* DEC = (LAS float*)(c.lds + SCR_OFF);
    LAS float* WLO = DEC + 512;
    LAS float* MFIN = WLO + 512;
    LAS float* MLO = MFIN + 16;
    LAS float* BLA = MLO + 512;
    __syncthreads();
    { const int u = c.tid; MLO[u] = MSC[(size_t)u * 4 + 0]; BLA[u] = MSC[(size_t)u * 4 + 1]; }
    __syncthreads();
    if (c.tid < 16) { const int bh = c.tid; float m = 0.f;
        for (int g = 0; g < NGRP; ++g) { const size_t u = (size_t)bh * NGRP + g; const float mloc = MLO[u], blast = BLA[u];
            const float mn = fmaxf(blast + m, mloc); DEC[bh * NGRP + g] = fast_exp(blast + m - mn); WLO[bh * NGRP + g] = fast_exp(mloc - mn);
            if (c.vcu == 0) MSC[u * 4 + 2] = m;
            m = mn; }
        MFIN[bh] = m; }
    __syncthreads();
    const unsigned gt = (unsigned)c.vcu * NTHREADS + c.tid, NT = (unsigned)c.G * NTHREADS;
    constexpr unsigned PER = (unsigned)HD * HD + HD;
    for (unsigned i = gt; i < 16u * PER; i += NT) {
        const int bh = (int)(i / PER); const int e = (int)(i % PER); const bool isn = e >= HD * HD; const int en = e - HD * HD;
        const float* src = isn ? NL + (size_t)bh * NGRP * HD + en : CL + (size_t)bh * NGRP * HD * HD + e;
        const size_t sstep = isn ? HD : (size_t)HD * HD;
        float x[NGRP];
#pragma unroll
        for (int g = 0; g < NGRP; ++g) x[g] = src[(size_t)g * sstep];
        float C = 0.f;
#pragma unroll
        for (int g = 0; g < NGRP; ++g) {
            const size_t u = (size_t)bh * NGRP + g;
            if (isn) N0[u * HD + en] = C; else C0[u * HD * HD + e] = (bf16)(cvtpk(C, 0.f) & 0xffffu);
            C = DEC[bh * NGRP + g] * C + WLO[bh * NGRP + g] * x[g];
        }
        const int b = bh >> 2, h = bh & 3;
        if (isn) a.out[O_PN + ((size_t)(l * NB + b) * MH + h) * HD + en] = C;
        else a.out[O_PC + ((size_t)(l * NB + b) * MH + h) * HD * HD + e] = C;
        if (e == 0) a.out[O_PM + (size_t)(l * NB + b) * MH + h] = MFIN[bh];
    }
}

constexpr float ATT_C = 0.088388347648318440f * LOG2E;
constexpr float THR2 = 8.f * LOG2E;
struct DmaMap { unsigned k0, k1, v0, v1; };
__device__ __forceinline__ DmaMap dma_map(int lane, int wave, int LD) {
    DmaMap m; unsigned kk_[2], vv_[2];
#pragma unroll
    for (int i = 0; i < 2; ++i) { const int o = (wave + 8 * i) * 1024 + lane * 16;
        const int row = o >> 8, c16 = ((o >> 4) & 15) ^ (row & 7); kk_[i] = (unsigned)(row * LD + c16 * 8) * 2u;
        const int sub = o >> 9, kk = ((sub >> 2) << 3) | ((o >> 6) & 7), k = (kk & ~0xC) | ((kk & 4) << 1) | ((kk & 8) >> 1), cc = ((sub & 3) << 5) | ((o & 63) >> 1); vv_[i] = (unsigned)(k * LD + cc) * 2u; }
    m.k0 = kk_[0]; m.k1 = kk_[1]; m.v0 = vv_[0]; m.v1 = vv_[1]; return m;
}
__device__ __forceinline__ void glds16s(const void* sbase, unsigned voff, unsigned lds_dst) { unsigned keep;
    asm volatile("s_mov_b32 %0, m0\n\ts_mov_b32 m0, %3\n\ts_nop 0\n\tglobal_load_lds_dwordx4 %1, %2\n\ts_mov_b32 m0, %0" : "=&s"(keep) : "v"(voff), "s"(sbase), "s"(lds_dst) : "memory"); }
__device__ __forceinline__ void dma_fill(LAS unsigned char* lds, int slot, int wave, const bf16* Ta, unsigned a0, unsigned a1, const bf16* Tb, unsigned b0, unsigned b1) {
    const unsigned d = (unsigned)(uintptr_t)lds + (unsigned)(slot * 32768 + wave * 1024);
    glds16s(Ta, a0, d); glds16s(Ta, a1, d + 8192u); glds16s(Tb, b0, d + 16384u); glds16s(Tb, b1, d + 24576u);
}
#define RING_WAIT_BAR(N) do { asm volatile("s_waitcnt vmcnt(" #N ") lgkmcnt(0)" ::: "memory"); __builtin_amdgcn_s_barrier(); asm volatile("" ::: "memory"); } while (0)

__device__ __forceinline__ float fma_s(float a, float b, float c) { float d; asm("v_fma_f32 %0, %1, %2, %3" : "=v"(d) : "v"(a), "v"(b), "v"(c)); return d; }
__device__ __forceinline__ float add_s(float a, float b) { float d; asm("v_add_f32 %0, %1, %2" : "=v"(d) : "v"(a), "v"(b)); return d; }
#define ATT_SCORE_SOFTMAX(j, slotk)                                                                                                           \
    {   const int K_lds = ldsb + (slotk) * 16384;                                                                                              \
        f32x16 p0, p1; qkt(p0, p1, K_lds, qr, r32, hi);                                                                                       \
        STEP_FILL();                                                             \
        const int Rl = R0 + r32 - 64 * (j);                                                                                                   \
        const int relmin = R0 - 64 * (j) - 63;                                                                                                \
        if (relmin >= 128) { const float bc = BR[0];                                                                                           \
            _Pragma("unroll") for (int r = 0; r < 16; ++r) { p0[r] = fma_s(p0[r], ATT_C, bc); p1[r] = fma_s(p1[r], ATT_C, bc); }                \
        } else {                                                                                                                               \
            const LAS float* bp = BR + (64 + 128 - Rl + 4 * hi);                                                                               \
            _Pragma("unroll") for (int r = 0; r < 16; ++r) { p0[r] = fma_s(p0[r], ATT_C, bp[(r & 3) + 8 * (r >> 2)]); p1[r] = fma_s(p1[r], ATT_C, bp[32 + (r & 3) + 8 * (r >> 2)]); } \
        }                                                                                                                                      \
        const int nvalid = kend - 64 * (j);                                                                                                    \
        if (nvalid < 64) { asm volatile("" ::: "memory");                           \
            _Pragma("unroll") for (int r = 0; r < 16; ++r) { const int kk = crow(r, hi); if (kk >= nvalid) p0[r] = -1e30f; if (kk + 32 >= nvalid) p1[r] = -1e30f; } \
        }                                                                                                                                      \
        float pmax = p0[0];                                                                                                                    \
        _Pragma("unroll") for (int r = 1; r < 16; ++r) pmax = fmaxf(pmax, p0[r]);                                                              \
        _Pragma("unroll") for (int r = 0; r < 16; ++r) pmax = fmaxf(pmax, p1[r]);                                                              \
        pmax = half_swap_max(pmax);                                                                                                            \
        if (!__all(pmax - m_reg <= THR2)) {                                                                                                    \
            const float mn = fmaxf(m_reg, pmax); const float alpha = __builtin_amdgcn_exp2f(m_reg - mn); m_reg = mn;                           \
            l_reg *= alpha;                                                                                                                    \
            if (hi == 0) al_l[r32] = alpha; asm volatile("s_waitcnt lgkmcnt(0)" ::: "memory");                                               \
            _Pragma("unroll") for (int r = 0; r < 16; ++r) { const float al = al_l[crow(r, hi)];                                               \
                _Pragma("unroll") for (int d = 0; d < 4; ++d) o[d][r] *= al; }                                                                 \
        }                                                                                                                                      \
        float ps = 0.f;                                                                                                                        \
        _Pragma("unroll") for (int r = 0; r < 16; ++r) { p0[r] = __builtin_amdgcn_exp2f(p0[r] - m_reg); p1[r] = __builtin_amdgcn_exp2f(p1[r] - m_reg); ps = add_s(ps, add_s(p0[r], p1[r])); } \
        l_reg += half_swap_add(ps);                                                                                                            \
        PK4(p0, 0, pa0); PK4(p0, 8, pa1); PK4(p1, 0, pa2); PK4(p1, 8, pa3);                                                                    \
    }
__device__ __forceinline__ void attn_unit(const Ctx& c, const bf16* __restrict__ Qb, int LDQ, int qrow, const bf16* __restrict__ Kh, const bf16* __restrict__ Vh, int LDK, int NT, int alo, int ahi, int kend,
                                          int R0  , const float* __restrict__ bias_g, bf16* __restrict__ Ob, int LDO, bool do_store, const float* __restrict__ qgain = nullptr, int rot = 0) {
    int tid = c.tid; asm volatile("" : "+v"(tid));
    const int wid = c.wave, lane = tid & 63, r32 = lane & 31, hi = lane >> 5;
    const int ldsb = (int)(uintptr_t)c.lds;
    constexpr int VRING = 49152;
    LAS float* wsf = (LAS float*)(c.lds + 114688) + wid * 64; LAS float* li_l = wsf; LAS float* al_l = wsf + 32;
    LAS float* BR = (LAS float*)(c.lds + SCR_OFF);
    asm volatile("s_waitcnt lgkmcnt(0)" ::: "memory"); __builtin_amdgcn_s_barrier(); asm volatile("" ::: "memory");
    const DmaMap dm = dma_map(lane, wid, LDK);
    const size_t tile_step = (size_t)64 * LDK;
    const unsigned dbase = (unsigned)ldsb + (unsigned)wid * 1024u;
#define ATT_FILL(kt_, vt_, sk_, sv_) do { const unsigned dk_ = dbase + (unsigned)(sk_) * 16384u, dv_ = dbase + VRING + (unsigned)(sv_) * 16384u; \
        glds16s(kt_, dm.k0, dk_); glds16s(kt_, dm.k1, dk_ + 8192u); glds16s(vt_, dm.v0, dv_); glds16s(vt_, dm.v1, dv_ + 8192u); } while (0)
#define TIDX(s_) ((s_) + rot - (((s_) + rot) >= NT ? NT : 0))
    { const int t0_ = TIDX(0), t1_ = TIDX(1);
      ATT_FILL(Kh + t0_ * tile_step, Vh + t0_ * tile_step, 0, 0);
      ATT_FILL(Kh + t1_ * tile_step, Vh + t1_ * tile_step, 1, 1); }
    if (tid < 321) { const int i = tid - 64; BR[tid] = bias_g[256 - (i < 0 ? 0 : i)] * LOG2E; }
    float m_reg = -1e30f, l_reg = 0.f; f32x16 o[4] = {f32x16{}, f32x16{}, f32x16{}, f32x16{}}; bf16x8 qr[8];
    { const bf16* Qw = Qb + (size_t)(qrow + r32) * LDQ + hi * 8;
#pragma unroll
      for (int d0 = 0; d0 < 8; ++d0) qr[d0] = *(const bf16x8*)(Qw + d0 * 16); }
    if (qgain) {
        float f[8][8]; float ss = 0.f;
#pragma unroll
        for (int d0 = 0; d0 < 8; ++d0) { const u32x4 w = *reinterpret_cast<const u32x4*>(&qr[d0]);
            f[d0][0] = bflo(w.x); f[d0][1] = bfhi(w.x); f[d0][2] = bflo(w.y); f[d0][3] = bfhi(w.y); f[d0][4] = bflo(w.z); f[d0][5] = bfhi(w.z); f[d0][6] = bflo(w.w); f[d0][7] = bfhi(w.w);
#pragma unroll
            for (int i = 0; i < 8; ++i) ss += f[d0][i] * f[d0][i]; }
        ss = half_swap_add(ss);
        const float rq = fast_rsqrt(ss * (1.f / HD) + EPS);
#pragma unroll
        for (int d0 = 0; d0 < 8; ++d0) { const f32x4 g0 = *(const f32x4*)(qgain + d0 * 16 + hi * 8), g1 = *(const f32x4*)(qgain + d0 * 16 + hi * 8 + 4);
            u32x4 s; s.x = cvtpk(f[d0][0] * rq * g0[0], f[d0][1] * rq * g0[1]); s.y = cvtpk(f[d0][2] * rq * g0[2], f[d0][3] * rq * g0[3]);
            s.z = cvtpk(f[d0][4] * rq * g1[0], f[d0][5] * rq * g1[1]); s.w = cvtpk(f[d0][6] * rq * g1[2], f[d0][7] * rq * g1[3]);
            qr[d0] = *reinterpret_cast<bf16x8*>(&s); }
    }
#pragma unroll
    for (int d0 = 0; d0 < 8; ++d0) { u32x4 w = *reinterpret_cast<u32x4*>(&qr[d0]); asm volatile("" : "+v"(w)); qr[d0] = *reinterpret_cast<bf16x8*>(&w); }
    asm volatile("" ::: "memory");
    const bool skew = wid >= 4;
    bf16x8 pa0 = bf16x8{}, pa1 = bf16x8{}, pa2 = bf16x8{}, pa3 = bf16x8{};
    int sk = 0, sv = 0;
    bool pact = false;
    for (int j = 0; j < NT; ++j) {
        if (j + 1 < NT) RING_WAIT_BAR(4); else RING_WAIT_BAR(0);
#define STEP_FILL() do { if (j + 2 < NT) { const int fk = sk >= 1 ? sk - 1 : 2, fv = sv >= 2 ? sv - 2 : sv + 2; const int tf = TIDX(j + 2); ATT_FILL(Kh + tf * tile_step, Vh + tf * tile_step, fk, fv); } } while (0)
        const int jt = TIDX(j);
        const bool act = (jt >= alo && jt <= ahi);
        if (skew && pact) { const int svp = sv >= 1 ? sv - 1 : 3; pv_d0(o, ldsb + VRING + svp * 16384 + v_rd_base(lane), pa0, pa1, pa2, pa3); }
        pact = act;
        if (act) { ATT_SCORE_SOFTMAX(jt, sk); } else STEP_FILL();
        if (!skew && act) pv_d0(o, ldsb + VRING + sv * 16384 + v_rd_base(lane), pa0, pa1, pa2, pa3);
        sk = sk == 2 ? 0 : sk + 1; sv = (sv + 1) & 3;
    }
    if (skew && pact) { const int svp = sv >= 1 ? sv - 1 : 3; pv_d0(o, ldsb + VRING + svp * 16384 + v_rd_base(lane), pa0, pa1, pa2, pa3); }
#undef STEP_FILL
#undef TIDX
#undef ATT_FILL
    if (hi == 0) li_l[r32] = l_reg;
    RING_WAIT_BAR(0);
    const int ost = ldsb + wid * 8192;
#pragma unroll
    for (int r = 0; r < 16; ++r) { const int orow = crow(r, hi); const float rl = __builtin_amdgcn_rcpf(li_l[orow]);
#pragma unroll
        for (int d0 = 0; d0 < 4; ++d0) *(LAS bf16*)(uintptr_t)(unsigned)(ost + orow * 256 + (d0 * 32 + r32) * 2) = (bf16)(cvtpk(o[d0][r] * rl, 0.f) & 0xffffu); }
    asm volatile("s_waitcnt lgkmcnt(0)" ::: "memory");
    if (do_store) {
#pragma unroll
        for (int i = 0; i < 8; ++i) { const int ch = i * 64 + lane, row = ch >> 4, c16 = ch & 15;
            const u32x4 w = *(const LAS u32x4*)(uintptr_t)(unsigned)(ost + row * 256 + c16 * 16);
            *(u32x4*)(Ob + (size_t)(qrow + row) * LDO + c16 * 8) = w; }
    }
}
__device__ __forceinline__ void attn_stream(const Args& a, const Ctx& c, int l) {
    constexpr int NATT = NB * NH * 32;
    if (c.vcu >= NATT) return;
    int tid = c.tid; asm volatile("" : "+v"(tid));
    const int wid = c.wave, lane = tid & 63, r32 = lane & 31, hi = lane >> 5;
    const int ldsb = (int)(uintptr_t)c.lds;
    constexpr int VRING = 49152;
    LAS float* wsf = (LAS float*)(c.lds + 114688) + wid * 64; LAS float* li_l = wsf; LAS float* al_l = wsf + 32;
    LAS float* BR = (LAS float*)(c.lds + SCR_OFF);
    const bf16* PROJ = (const bf16*)(a.ws + WS_BIG); bf16* MIX = (bf16*)(a.ws + WS_H);
    const int gq = c.vcu & 31, h = (c.vcu >> 5) & 7, b0 = c.vcu >> 8, db = c.G >> 8, nun = (NB - b0 + db - 1) / db;
    const int c0 = 4 * gq, jstart = c0 >= 8 ? 0 : 8 - c0, NT = 12 - jstart, ci = wid >> 1;
    const int alo = ci - jstart < 0 ? 0 : ci - jstart, ahi = ci + 8 - jstart, kend = NT * 64;
    const int R0 = (ci + 8 - jstart) * 64 + (wid & 1) * 32, rot = gq >= 2 ? (8 * gq + 8) % 12 : 0, qrow = wid * 32;
    const float* bias_g = a.rel_bias + (size_t)(l * NH + h) * 257;
    constexpr int LDK = NPROJ, LDO = D;
    asm volatile("s_waitcnt lgkmcnt(0)" ::: "memory"); __builtin_amdgcn_s_barrier(); asm volatile("" ::: "memory");
    const DmaMap dm = dma_map(lane, wid, LDK);
    const size_t tile_step = (size_t)64 * LDK;
    const unsigned dbase = (unsigned)ldsb + (unsigned)wid * 1024u;
#define ATT_FILL(kt_, vt_, sk_, sv_) do { const unsigned dk_ = dbase + (unsigned)(sk_) * 16384u, dv_ = dbase + VRING + (unsigned)(sv_) * 16384u; \
        glds16s(kt_, dm.k0, dk_); glds16s(kt_, dm.k1, dk_ + 8192u); glds16s(vt_, dm.v0, dv_); glds16s(vt_, dm.v1, dv_ + 8192u); } while (0)
#define TIDX(s_) ((s_) + rot - (((s_) + rot) >= NT ? NT : 0))
    const bf16* Qb = PROJ + (size_t)(b0 * SEQ + c0 * 64) * NPROJ + C_Q + h * HD;
    const bf16* Kh = PROJ + (size_t)(b0 * SEQ + (c0 - 8 + jstart) * 64) * NPROJ + C_K + h * HD;
    const bf16* Vh = PROJ + (size_t)(b0 * SEQ + (c0 - 8 + jstart) * 64) * NPROJ + C_V + h * HD;
    bf16* Ob = MIX + (size_t)(b0 * SEQ + c0 * 64) * D + 512 + h * HD;
    const size_t dproj = (size_t)db * SEQ * NPROJ, dmix = (size_t)db * SEQ * D;
    { const int t0_ = TIDX(0), t1_ = TIDX(1);
      ATT_FILL(Kh + t0_ * tile_step, Vh + t0_ * tile_step, 0, 0);
      ATT_FILL(Kh + t1_ * tile_step, Vh + t1_ * tile_step, 1, 1); }
    if (tid < 321) { const int i = tid - 64; BR[tid] = bias_g[256 - (i < 0 ? 0 : i)] * LOG2E; }
    bf16x8 qr[8];
    { const bf16* Qw = Qb + (size_t)(qrow + r32) * NPROJ + hi * 8;
#pragma unroll
      for (int d0 = 0; d0 < 8; ++d0) qr[d0] = *(const bf16x8*)(Qw + d0 * 16); }
    const bool skew = wid >= 4;
    int sk = 0, sv = 0;
#pragma unroll 1
    for (int ui = 0; ui < nun; ++ui) {
        const bool has_next = ui + 1 < nun;
        const bf16* Khn = Kh + dproj; const bf16* Vhn = Vh + dproj;
#pragma unroll
        for (int d0 = 0; d0 < 8; ++d0) { u32x4 w = *reinterpret_cast<u32x4*>(&qr[d0]); asm volatile("" : "+v"(w)); qr[d0] = *reinterpret_cast<bf16x8*>(&w); }
        asm volatile("" ::: "memory");
        float m_reg = -1e30f, l_reg = 0.f; f32x16 o[4] = {f32x16{}, f32x16{}, f32x16{}, f32x16{}};
        bf16x8 pa0 = bf16x8{}, pa1 = bf16x8{}, pa2 = bf16x8{}, pa3 = bf16x8{};
        bool pact = false;
        for (int j = 0; j < NT; ++j) {
            if (j + 1 < NT || has_next) RING_WAIT_BAR(4); else RING_WAIT_BAR(0);
#define STEP_FILL() do { const int fk = sk >= 1 ? sk - 1 : 2, fv = sv >= 2 ? sv - 2 : sv + 2;                                                                  \
                if (j + 2 < NT) { const int tf = TIDX(j + 2); ATT_FILL(Kh + tf * tile_step, Vh + tf * tile_step, fk, fv); }                                         \
                else if (has_next) { const int tf = TIDX(j + 2 - NT); ATT_FILL(Khn + tf * tile_step, Vhn + tf * tile_step, fk, fv); } } while (0)
            const int jt = TIDX(j);
            const bool act = (jt >= alo && jt <= ahi);
            if (skew && pact) { const int svp = sv >= 1 ? sv - 1 : 3; pv_d0(o, ldsb + VRING + svp * 16384 + v_rd_base(lane), pa0, pa1, pa2, pa3); }
            pact = act;
            if (act) { ATT_SCORE_SOFTMAX(jt, sk); } else STEP_FILL();
            if (!skew && act) pv_d0(o, ldsb + VRING + sv * 16384 + v_rd_base(lane), pa0, pa1, pa2, pa3);
            sk = sk == 2 ? 0 : sk + 1; sv = (sv + 1) & 3;
        }
        if (skew && pact) { const int svp = sv >= 1 ? sv - 1 : 3; pv_d0(o, ldsb + VRING + svp * 16384 + v_rd_base(lane), pa0, pa1, pa2, pa3); }
#undef STEP_FILL
        if (has_next) { const bf16* Qw = Qb + dproj + (size_t)(qrow + r32) * NPROJ + hi * 8;
#pragma unroll
            for (int d0 = 0; d0 < 8; ++d0) qr[d0] = *(const bf16x8*)(Qw + d0 * 16); }
        if (hi == 0) li_l[r32] = l_reg;
        asm volatile("s_waitcnt lgkmcnt(0)" ::: "memory"); __builtin_amdgcn_s_barrier(); asm volatile("" ::: "memory");
        const int ost = ldsb + VRING + (((wid < 4 ? sv + 2 : sv + 3) & 3) * 16384) + (wid & 3) * 4096;
#pragma unroll
        for (int hf = 0; hf < 2; ++hf) {
#pragma unroll
            for (int r = 0; r < 16; ++r) { const int orow = crow(r, hi); const float rl = __builtin_amdgcn_rcpf(li_l[orow]);
#pragma unroll
                for (int dd = 0; dd < 2; ++dd) *(LAS bf16*)(uintptr_t)(unsigned)(ost + orow * 128 + (dd * 32 + r32) * 2) = (bf16)(cvtpk(o[2 * hf + dd][r] * rl, 0.f) & 0xffffu); }
            asm volatile("s_waitcnt lgkmcnt(0)" ::: "memory");
#pragma unroll
            for (int i = 0; i < 4; ++i) { const int ch = i * 64 + lane, row = ch >> 3, c16 = ch & 7;
                const u32x4 w = *(const LAS u32x4*)(uintptr_t)(unsigned)(ost + row * 128 + c16 * 16);
                *(u32x4*)(Ob + (size_t)(qrow + row) * LDO + hf * 64 + c16 * 8) = w; }
            asm volatile("s_waitcnt lgkmcnt(0)" ::: "memory");
        }
        Qb += dproj; Kh += dproj; Vh += dproj; Ob += dmix;
    }
#undef TIDX
#undef ATT_FILL
}
#undef ATT_SCORE_SOFTMAX

__device__ __forceinline__ void m3_unit(const Args& a, const Ctx& c, int l, int unit) {
    const int g = unit & 31, bh = unit >> 5, b = bh >> 2, h = bh & 3;
    const bf16* PROJ = (const bf16*)(a.ws + WS_BIG); bf16* MIX = (bf16*)(a.ws + WS_H);
    const float* GATE = (const float*)(a.ws + WS_GATE);
    int tid = c.tid; asm volatile("" : "+v"(tid));
    const int wid = c.wave, lane = tid & 63, r32 = lane & 31, hi = lane >> 5;
    LAS float* scr = (LAS float*)(c.lds + SCR_OFF);
    LAS float* A_S = scr;
    LAS float* M_T = scr + 256;
    LAS float* B_T = scr + 512;
    LAS float* N0L = scr + 768;
    LAS float* TOT = scr + 896;
    const int ldsb = (int)(uintptr_t)c.lds;
    LAS float* wsf = (LAS float*)(c.lds + 98304) + wid * 64;
    const int row0 = b * SEQ + g * 256;
    const float m0 = ((const float*)(a.ws + WS_MSC))[(size_t)unit * 4 + 2];
    asm volatile("s_waitcnt vmcnt(0) lgkmcnt(0)" ::: "memory"); __builtin_amdgcn_s_barrier(); asm volatile("" ::: "memory");
    const DmaMap dm = dma_map(lane, wid, NPROJ); const DmaMap dc = dma_map(lane, wid, HD);
    const bf16* kt = PROJ + (size_t)row0 * NPROJ + C_MK + h * HD; const bf16* vt = PROJ + (size_t)row0 * NPROJ + C_MV + h * HD;
    const bf16* C0 = (const bf16*)(a.ws + WS_C0) + (size_t)unit * HD * HD;
    const size_t tile_step = (size_t)64 * NPROJ;
    dma_fill(c.lds, 0, wid, kt, dm.k0, dm.k1, vt, dm.v0, dm.v1);
    dma_fill(c.lds, 1, wid, kt + tile_step, dm.k0, dm.k1, vt + tile_step, dm.v0, dm.v1);
    float li = 0.f, lf = 0.f;
    if (tid < 256) { li = GATE[(size_t)(row0 + tid) * 8 + h]; lf = GATE[(size_t)(row0 + tid) * 8 + 4 + h]; }
    if (tid < 128) N0L[tid] = ((const float*)(a.ws + WS_N0))[(size_t)unit * HD + tid];
    const float bc = scan256_sum(lf, tid, lane, wid, TOT);
    const float as = li - bc;
    const float cm = scan256_max(tid < 256 ? as : -3.0e38f, tid, lane, wid, TOT);
    if (tid < 256) { A_S[tid] = as; M_T[tid] = fmaxf(m0, cm); B_T[tid] = bc; }
    bf16x8 qr[8];
    const int trow = wid * 32 + r32;
    { const bf16* Qw = PROJ + (size_t)(row0 + trow) * NPROJ + C_MQ + h * HD + hi * 8;
#pragma unroll
      for (int d0 = 0; d0 < 8; ++d0) qr[d0] = *(const bf16x8*)(Qw + d0 * 16); }
    __syncthreads();
    const float Mt = M_T[trow];
    f32x16 o[4] = {f32x16{}, f32x16{}, f32x16{}, f32x16{}};
    float rowsum = 0.f, qn = 0.f;
    const float winter = fast_exp(m0 - Mt);
    const int ci = wid >> 1;
    int slot = 0;
#pragma unroll 1
    for (int j = 0; j < 4; ++j) {
        RING_WAIT_BAR(4);
        { const int fs = slot >= 1 ? slot - 1 : 2;
          if (j + 2 < 4) dma_fill(c.lds, fs, wid, kt + (size_t)(j + 2) * tile_step, dm.k0, dm.k1, vt + (size_t)(j + 2) * tile_step, dm.v0, dm.v1);
          else if (j == 2) dma_fill(c.lds, fs, wid, C0, dc.v0, dc.v1, C0 + 64 * HD, dc.v0, dc.v1); }
        const int S_lds = ldsb + slot * 32768;
        int r32l = r32; asm volatile("" : "+v"(r32l));
        if (j <= ci) {
            f32x16 p0, p1; qkt(p0, p1, S_lds, qr, r32l, hi);
#pragma unroll
            for (int r = 0; r < 16; ++r) { const int s0 = 64 * j + crow(r, hi), s1 = s0 + 32;
                const float w0 = (s0 <= trow) ? fast_exp(A_S[s0] - Mt) * 0.08838834764831845f : 0.f, w1 = (s1 <= trow) ? fast_exp(A_S[s1] - Mt) * 0.08838834764831845f : 0.f;
                p0[r] *= w0; p1[r] *= w1; rowsum += p0[r] + p1[r]; }
            bf16x8 pa0, pa1, pa2, pa3;
            PK4(p0, 0, pa0); PK4(p0, 8, pa1); PK4(p1, 0, pa2); PK4(p1, 8, pa3);
            pv_d0(o, S_lds + 16384 + v_rd_base(lane), pa0, pa1, pa2, pa3);
        }
        slot = slot == 2 ? 0 : slot + 1;
    }
    RING_WAIT_BAR(0);
    {
        const int S_lds = ldsb + slot * 32768;
#pragma unroll
        for (int hf = 0; hf < 2; ++hf) {
            bf16x8 qs[4];
#pragma unroll
            for (int dd = 0; dd < 4; ++dd) { const int d0 = hf * 4 + dd; const u32x4 w = *reinterpret_cast<const u32x4*>(&qr[d0]);
                float f[8] = {bflo(w.x), bfhi(w.x), bflo(w.y), bfhi(w.y), bflo(w.z), bfhi(w.z), bflo(w.w), bfhi(w.w)};
#pragma unroll
                for (int i = 0; i < 8; ++i) qn += f[i] * N0L[d0 * 16 + hi * 8 + i];
                u32x4 s; s.x = cvtpk(f[0] * winter, f[1] * winter); s.y = cvtpk(f[2] * winter, f[3] * winter); s.z = cvtpk(f[4] * winter, f[5] * winter); s.w = cvtpk(f[6] * winter, f[7] * winter);
                qs[dd] = *reinterpret_cast<bf16x8*>(&s); }
            pv_d0(o, S_lds + hf * 16384 + v_rd_base(lane), qs[0], qs[1], qs[2], qs[3]);
        }
    }
    rowsum = half_swap_add(rowsum);
    qn = half_swap_add(qn);
    const float den = winter * qn + rowsum;
    const float dfl = fast_exp(-(B_T[trow] + Mt));
    const float inv = 1.0f / fmaxf(fabsf(den), dfl);
    if (hi == 0) wsf[r32] = inv;
    asm volatile("s_waitcnt lgkmcnt(0)" ::: "memory");
#pragma unroll
    for (int r = 0; r < 16; ++r) { const float sc_ = wsf[crow(r, hi)];
#pragma unroll
        for (int d0 = 0; d0 < 4; ++d0) o[d0][r] *= sc_; }
    RING_WAIT_BAR(0);
    const int hst = ldsb + wid * 16384;
    { int le = lane; asm volatile("" : "+v"(le)); const int r32e = le & 31, hie = le >> 5;
#pragma unroll
    for (int r = 0; r < 16; ++r)
#pragma unroll
        for (int d0 = 0; d0 < 4; ++d0) *(LAS float*)(uintptr_t)(unsigned)(hst + crow(r, hie) * 512 + (d0 * 32 + r32e) * 4) = o[d0][r]; }
    asm volatile("s_waitcnt lgkmcnt(0)" ::: "memory");
    const float* gn = a.mlstm_norm_g + (size_t)l * 512 + h * HD;
    int le = lane; asm volatile("" : "+v"(le));
    u32x4 mo8[8];
#pragma unroll
    for (int i = 0; i < 8; ++i) { const int ch = i * 64 + le, row = ch >> 4, col = (ch & 15) * 8; mo8[i] = *(const u32x4*)(PROJ + (size_t)(row0 + wid * 32 + row) * NPROJ + C_MO + h * HD + col); }
#pragma unroll
    for (int i = 0; i < 8; ++i) { const int ch = i * 64 + le, row = ch >> 4, col = (ch & 15) * 8;
        const f32x4 a0 = *(const LAS f32x4*)(uintptr_t)(unsigned)(hst + row * 512 + col * 4), a1 = *(const LAS f32x4*)(uintptr_t)(unsigned)(hst + row * 512 + col * 4 + 16);
        float ss = (a0.x * a0.x + a0.y * a0.y) + (a0.z * a0.z + a0.w * a0.w) + (a1.x * a1.x + a1.y * a1.y) + (a1.z * a1.z + a1.w * a1.w);
        ss += shx(ss, 1, le); ss += shx(ss, 2, le); ss += shx(ss, 4, le); ss += shx(ss, 8, le);
        const float rstd = fast_rsqrt(ss * (1.f / HD) + EPS);
        const int orow = row0 + wid * 32 + row;
        const u32x4 mo = mo8[i];
        const f32x4 g0 = *(const f32x4*)(gn + col), g1 = *(const f32x4*)(gn + col + 4);
        float y[8] = {a0.x * g0.x, a0.y * g0.y, a0.z * g0.z, a0.w * g0.w, a1.x * g1.x, a1.y * g1.y, a1.z * g1.z, a1.w * g1.w};
        const float mf[8] = {bflo(mo.x), bfhi(mo.x), bflo(mo.y), bfhi(mo.y), bflo(mo.z), bfhi(mo.z), bflo(mo.w), bfhi(mo.w)};
#pragma unroll
        for (int k = 0; k < 8; ++k) y[k] = y[k] * rstd * (1.0f / (1.0f + fast_exp(-mf[k])));
        u32x4 w; w.x = cvtpk(y[0], y[1]); w.y = cvtpk(y[2], y[3]); w.z = cvtpk(y[4], y[5]); w.w = cvtpk(y[6], y[7]);
        *(u32x4*)(MIX + (size_t)orow * D + 1536 + h * HD + col) = w; }
}

__device__ __forceinline__ void ms_unit(const Args& a, const Ctx& c, int l, int unit) {
    const int b = unit >> 2, h = unit & 3; int tid = c.tid; asm volatile("" : "+v"(tid));
    const int lane = tid & 63, wid = c.wave;
    const bf16* PROJ = (const bf16*)(a.ws + WS_BIG); bf16* MIX = (bf16*)(a.ws + WS_H);
    const float* GATE = (const float*)(a.ws + WS_GATE);
    constexpr int P = 132;
    LAS float* Q = (LAS float*)c.lds;
    LAS float* Kk = Q + 32 * P;
    LAS float* V = Kk + 32 * P;
    LAS float* HB = V + 32 * P;
    LAS float* S = HB + 32 * P;
    LAS float* N0 = S + 32 * 33;
    LAS float* A_S = N0 + 128;
    LAS float* M_T = A_S + 32;
    LAS float* B_T = M_T + 32;
    LAS float* WST = B_T + 32;
    LAS float* DEN = WST + 32;
    LAS float* WIN = DEN + 32;
    LAS float* SC = WIN + 32;
    const int row0 = MP + b * SSEQ;
    const size_t sidx = (size_t)(l * SBATCH + b) * MH + h;
    const float* C0 = a.state_c + sidx * HD * HD;
    __syncthreads();
    for (int i = tid; i < 1536; i += NTHREADS) { const int which = i >> 9, r = (i >> 4) & 31, c8 = (i & 15) * 8;
        const u32x4 w = *(const u32x4*)(PROJ + (size_t)(row0 + r) * NPROJ + (which == 0 ? C_MQ : which == 1 ? C_MK : C_MV) + h * HD + c8);
        const float sc = which == 1 ? 0.08838834764831845f : 1.0f;
        LAS float* dst = (which == 0 ? Q : which == 1 ? Kk : V) + r * P + c8;
        *(LAS f32x4*)dst = (f32x4){bflo(w.x) * sc, bfhi(w.x) * sc, bflo(w.y) * sc, bfhi(w.y) * sc};
        *(LAS f32x4*)(dst + 4) = (f32x4){bflo(w.z) * sc, bfhi(w.z) * sc, bflo(w.w) * sc, bfhi(w.w) * sc}; }
    if (tid < 128) N0[tid] = a.state_n[sidx * HD + tid];
    if (wid == 0) {
        const int t = lane & 31; const float m0 = a.state_m[sidx];
        const float li = GATE[(size_t)(row0 + t) * 8 + h], lf = GATE[(size_t)(row0 + t) * 8 + 4 + h];
        float bc = lf;
#pragma unroll
        for (int o = 1; o < 32; o <<= 1) { const float x = shup(bc, o, lane); if ((lane & 31) >= o) bc += x; }
        const float as = li - bc; float cm = as;
#pragma unroll
        for (int o = 1; o < 32; o <<= 1) { const float x = shup(cm, o, lane); if ((lane & 31) >= o) cm = fmaxf(cm, x); }
        const float blast = __int_as_float(__builtin_amdgcn_ds_bpermute(31 << 2, __float_as_int(bc))), amax = __int_as_float(__builtin_amdgcn_ds_bpermute(31 << 2, __float_as_int(cm)));
        const float Mt = fmaxf(m0, cm), mnew = fmaxf(blast + m0, blast + amax);
        if (lane < 32) { A_S[t] = as; B_T[t] = bc; M_T[t] = Mt; WST[t] = fast_exp(blast + as - mnew); WIN[t] = fast_exp(m0 - Mt); }
        if (lane == 0) { SC[0] = m0; SC[1] = blast; SC[2] = mnew; SC[3] = fast_exp(blast + m0 - mnew); }
    }
    __syncthreads();
    for (int i = tid; i < 1024; i += NTHREADS) { const int t = i >> 5, s = i & 31; float d = 0.f;
        if (s <= t) {
#pragma unroll 8
            for (int k = 0; k < 128; k += 4) { const f32x4 q4 = *(const LAS f32x4*)(Q + t * P + k), k4 = *(const LAS f32x4*)(Kk + s * P + k); d += (q4.x * k4.x + q4.y * k4.y) + (q4.z * k4.z + q4.w * k4.w); }
            d *= fast_exp(A_S[s] - M_T[t]); }
        S[t * 33 + s] = d; }
    __syncthreads();
    if (tid < 32) { const int t = tid; float qn = 0.f, rs = 0.f;
        for (int k = 0; k < 128; ++k) qn += Q[t * P + k] * N0[k];
        for (int s = 0; s < 32; ++s) rs += S[t * 33 + s];
        const float den = WIN[t] * qn + rs; DEN[t] = 1.0f / fmaxf(fabsf(den), fast_exp(-(B_T[t] + M_T[t]))); }
    const int e = tid & 127, tg = tid >> 7;
    { float acc[8];
#pragma unroll
      for (int i = 0; i < 8; ++i) acc[i] = 0.f;
      for (int d0 = 0; d0 < 128; d0 += 16) { float cv[16];
#pragma unroll
          for (int j = 0; j < 16; ++j) cv[j] = C0[(size_t)(d0 + j) * HD + e];
#pragma unroll
          for (int j = 0; j < 16; j += 4)
#pragma unroll
              for (int i = 0; i < 8; ++i) { const f32x4 q4 = *(const LAS f32x4*)(Q + (tg * 8 + i) * P + d0 + j); acc[i] += (q4.x * cv[j] + q4.y * cv[j + 1]) + (q4.z * cv[j + 2] + q4.w * cv[j + 3]); } }
      __syncthreads();
#pragma unroll
      for (int i = 0; i < 8; ++i) { const int t = tg * 8 + i; float v = acc[i] * WIN[t];
          for (int s = 0; s <= t; ++s) v += S[t * 33 + s] * V[s * P + e];
          HB[t * P + e] = v * DEN[t]; } }
    __syncthreads();
    { const int t = tid >> 4, e0 = (tid & 15) * 8; float ss = 0.f;
      const f32x4 h0 = *(const LAS f32x4*)(HB + t * P + e0), h1 = *(const LAS f32x4*)(HB + t * P + e0 + 4);
      ss = (h0.x * h0.x + h0.y * h0.y) + (h0.z * h0.z + h0.w * h0.w) + (h1.x * h1.x + h1.y * h1.y) + (h1.z * h1.z + h1.w * h1.w);
      ss += shx(ss, 1, lane); ss += shx(ss, 2, lane); ss += shx(ss, 4, lane); ss += shx(ss, 8, lane);
      const float rstd = fast_rsqrt(ss * (1.f / HD) + EPS);
      const u32x4 mo = *(const u32x4*)(PROJ + (size_t)(row0 + t) * NPROJ + C_MO + h * HD + e0);
      const float* gn = a.mlstm_norm_g + (size_t)l * 512 + h * HD + e0;
      const f32x4 g0 = *(const f32x4*)gn, g1 = *(const f32x4*)(gn + 4);
      float y[8] = {h0.x * g0.x, h0.y * g0.y, h0.z * g0.z, h0.w * g0.w, h1.x * g1.x, h1.y * g1.y, h1.z * g1.z, h1.w * g1.w};
      const float mf[8] = {bflo(mo.x), bfhi(mo.x), bflo(mo.y), bfhi(mo.y), bflo(mo.z), bfhi(mo.z), bflo(mo.w), bfhi(mo.w)};
#pragma unroll
      for (int k = 0; k < 8; ++k) y[k] = y[k] * rstd * (1.0f / (1.0f + fast_exp(-mf[k])));
      u32x4 w; w.x = cvtpk(y[0], y[1]); w.y = cvtpk(y[2], y[3]); w.z = cvtpk(y[4], y[5]); w.w = cvtpk(y[6], y[7]);
      *(u32x4*)(MIX + (size_t)(row0 + t) * D + 1536 + h * HD + e0) = w; }
    { const float decay = SC[3]; const int dg = tg * 32; float acc[32];
#pragma unroll
      for (int i = 0; i < 32; ++i) acc[i] = C0[(size_t)(dg + i) * HD + e] * decay;
      for (int s = 0; s < 32; ++s) { const float vv = V[s * P + e] * WST[s];
#pragma unroll
          for (int i = 0; i < 32; i += 4) { const f32x4 k4 = *(const LAS f32x4*)(Kk + s * P + dg + i); acc[i] += k4.x * vv; acc[i + 1] += k4.y * vv; acc[i + 2] += k4.z * vv; acc[i + 3] += k4.w * vv; } }
      float* oc = a.out + O_SC + sidx * HD * HD;
#pragma unroll
      for (int i = 0; i < 32; ++i) oc[(size_t)(dg + i) * HD + e] = acc[i];
      if (tid < 128) { float v = decay * N0[tid]; for (int s = 0; s < 32; ++s) v += WST[s] * Kk[s * P + tid]; a.out[O_SN + sidx * HD + tid] = v; }
      if (tid == 0) a.out[O_SM + sidx] = SC[2]; }
}

__device__ __forceinline__ void phase_e(const Args& a, const Ctx& c_in0, int l) {
    const Ctx c = relaunder(c_in0);
    const bf16* PROJ = (const bf16*)(a.ws + WS_BIG); bf16* MIX = (bf16*)(a.ws + WS_H);
    constexpr int NATT = NB * NH * 32;
#if (PE_EN & 1)
    if ((c.G & 255) == 0) attn_stream(a, c, l);
    else
    for (int u = c.vcu; u < NATT; u += c.G) {
        const int gq = u & 31, bhh = u >> 5, b = bhh >> 3, h = bhh & 7;
        const int c0 = 4 * gq, jstart = c0 >= 8 ? 0 : 8 - c0, NT = 12 - jstart, ci = c.wave >> 1;
        const int krow0 = b * SEQ + (c0 - 8 + jstart) * 64;
        const int alo = ci - jstart, ahi = ci + 8 - jstart;
        const int R0 = (ci + 8 - jstart) * 64 + (c.wave & 1) * 32;
        attn_unit(c, PROJ + (size_t)(b * SEQ + c0 * 64) * NPROJ + C_Q + h * HD, NPROJ, c.wave * 32, PROJ + (size_t)krow0 * NPROJ + C_K + h * HD, PROJ + (size_t)krow0 * NPROJ + C_V + h * HD, NPROJ,
                  NT, alo < 0 ? 0 : alo, ahi, NT * 64, R0, a.rel_bias + (size_t)(l * NH + h) * 257, MIX + (size_t)(b * SEQ + c0 * 64) * D + 512 + h * HD, D, true, nullptr,
                  gq >= 2 ? (8 * gq + 8) % 12 : 0);
    }
#endif
#if (PE_EN & 4)
    for (int u = c.vcu; u < 16 * NGRP; u += c.G) m3_unit(a, c, l, u);
#endif
}
__device__ __forceinline__ void sample_kv_prep(const Args& a, const Ctx& c, int l, int b, int h) {
    int tid = c.tid; asm volatile("" : "+v"(tid));
    const int lane = tid & 63, row = tid >> 4, c8 = (tid & 15) * 8;
    const bf16* PROJ = (const bf16*)(a.ws + WS_BIG);
    bf16* SK = (bf16*)(a.ws + WS_SK + (size_t)(l & 1) * SKV_IMG); bf16* SV = (bf16*)(a.ws + WS_SV + (size_t)(l & 1) * SKV_IMG);
    const size_t ro = (size_t)(MP + b * SSEQ + row) * NPROJ + h * HD + c8;
    const u32x4 kq = *(const u32x4*)(PROJ + ro + C_K), vq = *(const u32x4*)(PROJ + ro + C_V);
    float x[8] = {bflo(kq.x), bfhi(kq.x), bflo(kq.y), bfhi(kq.y), bflo(kq.z), bfhi(kq.z), bflo(kq.w), bfhi(kq.w)};
    float ss = 0.f;
#pragma unroll
    for (int i = 0; i < 8; ++i) ss += x[i] * x[i];
    ss += shx(ss, 1, lane); ss += shx(ss, 2, lane); ss += shx(ss, 4, lane); ss += shx(ss, 8, lane);
    const float rk = fast_rsqrt(ss * (1.f / HD) + EPS);
    const float* gk = a.k_norm_g + l * HD + c8; const f32x4 g0 = *(const f32x4*)gk, g1 = *(const f32x4*)(gk + 4);
    x[0] *= rk * g0[0]; x[1] *= rk * g0[1]; x[2] *= rk * g0[2]; x[3] *= rk * g0[3]; x[4] *= rk * g1[0]; x[5] *= rk * g1[1]; x[6] *= rk * g1[2]; x[7] *= rk * g1[3];
    u32x4 o; o.x = cvtpk(x[0], x[1]); o.y = cvtpk(x[2], x[3]); o.z = cvtpk(x[4], x[5]); o.w = cvtpk(x[6], x[7]);
    const size_t io = ((size_t)b * SKV_ROWS + 512 + row) * 1024 + h * HD + c8;
    *(u32x4*)(SK + io) = o; *(u32x4*)(SV + io) = vq;
    const size_t oo = ((size_t)(l * SBATCH + b) * SSEQ + row) * 1024 + h * HD + c8;
    float* ok = a.out + O_SK + oo; float* ov = a.out + O_SV + oo;
    *(f32x4*)ok = (f32x4){x[0], x[1], x[2], x[3]}; *(f32x4*)(ok + 4) = (f32x4){x[4], x[5], x[6], x[7]};
    *(f32x4*)ov = (f32x4){bflo(vq.x), bfhi(vq.x), bflo(vq.y), bfhi(vq.y)}; *(f32x4*)(ov + 4) = (f32x4){bflo(vq.z), bfhi(vq.z), bflo(vq.w), bfhi(vq.w)};
    asm volatile("s_waitcnt vmcnt(0)" ::: "memory"); __syncthreads();
}
__device__ __forceinline__ void sample_mixers(const Args& a, const Ctx& c, int l) {
    const bf16* PROJ = (const bf16*)(a.ws + WS_BIG); bf16* MIX = (bf16*)(a.ws + WS_H);
#if (PE_EN & 2)
    for (int su = c.vcu; su < SBATCH * NH; su += c.G) {
        const int b = su >> 3, h = su & 7;
        sample_kv_prep(a, c, l, b, h);
        const bf16* SK = (const bf16*)(a.ws + WS_SK + (size_t)(l & 1) * SKV_IMG) + (size_t)b * SKV_ROWS * 1024 + h * HD; const bf16* SV = (const bf16*)(a.ws + WS_SV + (size_t)(l & 1) * SKV_IMG) + (size_t)b * SKV_ROWS * 1024 + h * HD;
        attn_unit(c, PROJ + (size_t)(MP + b * SSEQ) * NPROJ + C_Q + h * HD, NPROJ, 0, SK, SV, 1024, 9, 0, 8, 544, 512, a.rel_bias + (size_t)(l * NH + h) * 257,
                  MIX + (size_t)(MP + b * SSEQ) * D + 512 + h * HD, D, c.wave == 0, a.q_norm_g + l * HD);
    }
#endif
#if (PE_EN & 8)
    for (int u = c.vcu - SBATCH * NH; u >= 0 && u < SBATCH * MH; u += c.G) ms_unit(a, c, l, u);
#endif
    __syncthreads();
}
typedef const __attribute__((address_space(4))) Args* KArgP;
#if defined(__HIP_DEVICE_COMPILE__)
__device__ __forceinline__ Args get_args() { KArgP p = (KArgP)__builtin_amdgcn_kernarg_segment_ptr(); asm volatile("" : "+s"(p)); return *p; }
#else
__device__ Args get_args();
#endif
__global__ void __launch_bounds__(NTHREADS, 2) fwd(Args args) {
    extern __shared__ __attribute__((aligned(16))) unsigned char lds_raw[];
    Ctx c; c.lds = (LAS unsigned char*)lds_raw; c.wave = __builtin_amdgcn_readfirstlane((int)threadIdx.x >> 6); c.tid = hw_tid(c.wave); c.lane = c.tid & 63;
    c.G = gridDim.x; { const int bx = blockIdx.x; c.vcu = (c.G % 8 == 0) ? (bx % 8) * (c.G / 8) + bx / 8 : bx; }
    volatile LAS unsigned* MISC = (volatile LAS unsigned*)(c.lds + MISC_OFF);
    { const int t0 = hw_tid(c.wave); if (t0 < 16) MISC[t0] = 0u; }
    __syncthreads();
    unsigned* barw = (unsigned*)(get_args().ws + WS_CTL) + 4096;
    XcdBarrier bar; bar.bar = barw; bar.x = 0; bar.st = nullptr;
    const int lo = args.ph_lo, hi = args.ph_hi;
    const bool multi = (hi - lo) > 1;
    if (multi) bar = xcd_barrier_post(barw, MISC + 8, hw_tid(c.wave) == 0);
#define IN(k) (lo <= (k) && (k) < hi)
#define SEAM(k) do { if (IN(k) && IN((k) + 1)) xcd_barrier(bar.bar, bar.x, bar.st, c.wave); } while (0)
    for (int l = 0; l < DEPTH; ++l) {
        const int pb = l * NPH_LAYER;
        if (IN(pb + 0)) {
#if (PH_EN >> 1) & 1
            { const Args A_ = get_args(); phase_norm<true>(A_, c, l); }
#if (PH_DUP >> 1) & 1
            { __syncthreads(); const Args A_ = get_args(); phase_norm<true>(A_, c, l); }
#endif
#endif
 __syncthreads(); SEAM(pb + 0); }
        if (IN(pb + 1)) {
            const Args A_ = get_args(); bf16* H = (bf16*)(A_.ws + WS_H); bf16* BIG = (bf16*)(A_.ws + WS_BIG);
            bf16* XBp = (bf16*)(A_.ws + WS_XB); const float* RS = (const float*)(A_.ws + WS_RSTD);
            pg8::Gemm g{XBp, (const bf16*)(A_.ws + WS_WIN), MP, NPROJ, D}; pg8::StaticOrder S; S.init(MP, NPROJ, c.G, (int)blockIdx.x, WGM_B);
            pg8::EpiProj E{BIG, NPROJ, A_.q_norm_g + l * HD, A_.k_norm_g + l * HD, (LAS float*)(c.lds + SCR_OFF), RS};

#if (PH_EN >> 2) & 1
            for (int rep_ = 0, nrep_ = ((PH_DUP >> 2) & 1) ? A_.rep : 1; rep_ < nrep_; ++rep_) pg8::gemm_phase<pg8::EpiProj, pg8::StaticOrder, true, true>(c.lds, g, S, E, c.wave);
            { SEpiBf16 SE{BIG + (size_t)MP * NPROJ, NPROJ, 0, RS + MP}; sample_gemm(c.lds, c.wave, c.vcu, c.G, XBp + (size_t)MP * D, g.Bt, NPROJ, D, SE); }
#endif

            SEAM(pb + 1);
        }
        if (IN(pb + 2)) {
#if (PH_EN >> 3) & 1
            { const Args A_ = get_args(); phase_c<true>(A_, c, l); }
#if (PH_DUP >> 3) & 1
            { __syncthreads(); const Args A_ = get_args(); phase_c<false>(A_, c, l); }
#endif
#endif
 SEAM(pb + 2); }
        if (IN(pb + 3)) {
#if (PH_EN >> 4) & 1
            { const Args A_ = get_args(); phase_d(A_, c, l); }
            { const Args A_ = get_args(); if (l + 1 < DEPTH) build_kv_image(A_, c.vcu, c.G, hw_tid(c.wave), l + 1); }
#if (PH_DUP >> 4) & 1
            { __syncthreads(); const Args A_ = get_args(); phase_d(A_, c, l); }
#endif
#endif
 SEAM(pb + 3); }
        if (IN(pb + 4)) {
#if (PH_EN >> 5) & 1
            { const Args A_ = get_args(); phase_e(A_, c, l); }
#if (PH_DUP >> 5) & 1
            { __syncthreads(); const Args A_ = get_args(); phase_e(A_, c, l); }
#endif
#endif
 __syncthreads(); SEAM(pb + 4); }
        if (IN(pb + 5)) {
            const Args A_ = get_args(); bf16* H = (bf16*)(A_.ws + WS_H);
            pg8::Gemm g{H, (const bf16*)(A_.ws + WS_WOUT), MP, D, D}; pg8::StaticOrder S; S.init(MP, D, c.G, (int)blockIdx.x, WGM_F);
            pg8::EpiResAdd E{(bf16*)(A_.ws + WS_XB), A_.out, D, false};

#if (PH_EN >> 6) & 1
            pg8::gemm_phase<pg8::EpiResAdd, pg8::StaticOrder, true, true>(c.lds, g, S, E, c.wave);
            { SEpiResAdd SE{(bf16*)(A_.ws + WS_XB) + (size_t)MP * D, A_.out + (size_t)MP * D, D, false}; sample_gemm(c.lds, c.wave, c.vcu, c.G, H + (size_t)MP * D, g.Bt, D, D, SE); }
#if (PH_DUP >> 6) & 1
            { pg8::EpiBf16<0> E2{(bf16*)(A_.ws + WS_BIG), D, nullptr, (LAS float*)(c.lds + SCR_OFF)}; pg8::gemm_phase<pg8::EpiBf16<0>, pg8::StaticOrder, true, true>(c.lds, g, S, E2, c.wave); }
#endif
#endif

            SEAM(pb + 5);
        }
        if (IN(pb + 6)) {
#if (PH_EN >> 7) & 1
            { const Args A_ = get_args(); phase_norm<false>(A_, c, l); }
#if (PH_DUP >> 7) & 1
            { __syncthreads(); const Args A_ = get_args(); phase_norm<false>(A_, c, l); }
#endif
#endif
 SEAM(pb + 6); }
        if (IN(pb + 7)) {
            const Args A_ = get_args(); bf16* H = (bf16*)(A_.ws + WS_H); bf16* BIG = (bf16*)(A_.ws + WS_BIG);
            bf16* XBp = (bf16*)(A_.ws + WS_XB); const float* RS = (const float*)(A_.ws + WS_RSTD);
            pg8::Gemm g{XBp, (const bf16*)(A_.ws + WS_WUP), MP, FF, D}; pg8::StaticOrder S; S.init(MP, FF, c.G, (int)blockIdx.x, WGM_H);
            pg8::EpiBf16<1> E{BIG, FF, RS, (LAS float*)(c.lds + SCR_OFF)};

#if (PH_EN >> 8) & 1
            for (int rep_ = 0, nrep_ = ((PH_DUP >> 8) & 1) ? A_.rep : 1; rep_ < nrep_; ++rep_) pg8::gemm_phase<pg8::EpiBf16<1>, pg8::StaticOrder, true, true>(c.lds, g, S, E, c.wave);
            { SEpiBf16 SE{BIG + (size_t)MP * FF, FF, 1, RS + MP}; sample_gemm(c.lds, c.wave, c.vcu, c.G, XBp + (size_t)MP * D, g.Bt, FF, D, SE); }
#endif

            SEAM(pb + 7);
        }
        if (IN(pb + 8)) {
            const Args A_ = get_args(); bf16* BIG = (bf16*)(A_.ws + WS_BIG);
            pg8::Gemm g{BIG, (const bf16*)(A_.ws + WS_WDN), MP, D, FF}; pg8::StaticOrder S; S.init(MP, D, c.G, (int)blockIdx.x, WGM_I);
            pg8::EpiResAdd E{(bf16*)(A_.ws + WS_XB), A_.out, D, l == DEPTH - 1};

#if (PH_EN >> 9) & 1
            pg8::gemm_phase<pg8::EpiResAdd, pg8::StaticOrder, true, true>(c.lds, g, S, E, c.wave);
            { SEpiResAdd SE{(bf16*)(A_.ws + WS_XB) + (size_t)MP * D, A_.out + (size_t)MP * D, D, l == DEPTH - 1}; sample_gemm(c.lds, c.wave, c.vcu, c.G, BIG + (size_t)MP * FF, g.Bt, D, FF, SE); }
#if (PH_DUP >> 9) & 1
            { pg8::EpiBf16<0> E2{(bf16*)(A_.ws + WS_H), D, nullptr, (LAS float*)(c.lds + SCR_OFF)}; pg8::gemm_phase<pg8::EpiBf16<0>, pg8::StaticOrder, true, true>(c.lds, g, S, E2, c.wave); }
#endif
#endif

            SEAM(pb + 8);
        }
    }
#undef IN
#undef SEAM
}

extern "C" void kernel_launch(void* const* d_in, const int* in_sizes, int n_in, void* d_out, int out_size, void* d_ws, size_t ws_size, hipStream_t stream) {
    static int grid = 0;
    if (grid == 0) {
        if (n_in != 21 || (size_t)out_size != O_END || ws_size < WS_END) { fprintf(stderr, "kernel_launch: shape mismatch n_in %d out %d ws %zu (need %zu)\n", n_in, out_size, ws_size, (size_t)WS_END); grid = -1; return; }
        int dev = 0, cus = 0, per_cu = 0;
        if (hipGetDevice(&dev) != hipSuccess || hipDeviceGetAttribute(&cus, hipDeviceAttributeMultiprocessorCount, dev) != hipSuccess) { grid = -1; return; }
        if (hipFuncSetAttribute((const void*)fwd, hipFuncAttributeMaxDynamicSharedMemorySize, LDS_BYTES) != hipSuccess) { fprintf(stderr, "kernel_launch: hipFuncSetAttribute failed\n"); grid = -1; return; }
        if (hipOccupancyMaxActiveBlocksPerMultiprocessor(&per_cu, (const void*)fwd, NTHREADS, LDS_BYTES) != hipSuccess || per_cu < 1) { fprintf(stderr, "kernel_launch: occupancy query says %d\n", per_cu); }
        (void)hipGetLastError();
        grid = cus;
    }
    if (grid < 0) return;
    (void)hipMemsetAsync((char*)d_ws + WS_CTL, 0, CTL_BYTES, stream);
    Args a{};
    a.x_prompt = (const float*)d_in[0]; a.x_sample = (const float*)d_in[1]; a.cache_k = (const float*)d_in[2]; a.cache_v = (const float*)d_in[3]; a.state_conv = (const float*)d_in[4];
    a.state_c = (const float*)d_in[5]; a.state_n = (const float*)d_in[6]; a.state_m = (const float*)d_in[7]; a.norm_mix_g = (const float*)d_in[8]; a.w_in = (const float*)d_in[9];
    a.conv_w = (const float*)d_in[10]; a.q_norm_g = (const float*)d_in[11]; a.k_norm_g = (const float*)d_in[12]; a.rel_bias = (const float*)d_in[13]; a.b_igate = (const float*)d_in[14];
    a.b_fgate = (const float*)d_in[15]; a.mlstm_norm_g = (const float*)d_in[16]; a.w_out = (const float*)d_in[17]; a.norm_mlp_g = (const float*)d_in[18]; a.w_up = (const float*)d_in[19];
    a.w_down = (const float*)d_in[20]; a.out = (float*)d_out; a.ws = (unsigned char*)d_ws;
#if MK_PER_PHASE
    for (int p = 0; p < NPHASES; ++p) { a.ph_lo = p; a.ph_hi = p + 1; a.rep = 2; hipLaunchKernelGGL(fwd, dim3(grid), dim3(NTHREADS), LDS_BYTES, stream, a); }
#else
    a.ph_lo = 0; a.ph_hi = NPHASES; a.rep = 2; hipLaunchKernelGGL(fwd, dim3(grid), dim3(NTHREADS), LDS_BYTES, stream, a);
#endif
    const hipError_t le = hipPeekAtLastError();
    if (le != hipSuccess) fprintf(stderr, "kernel_launch: launch failed: %s\n", hipGetErrorName(le));
}
```

```cpp
#include <hip/hip_runtime.h>
#include <cstdio>
#include <cstdint>

#ifndef MK_PER_PHASE
#define MK_PER_PHASE 0
#endif

#ifndef PH_EN
#define PH_EN 0x3ff
#endif
#ifndef PE_EN
#define PE_EN 0xf
#endif
#ifndef WGM_B
#define WGM_B 4
#endif
#ifndef WGM_F
#define WGM_F 4
#endif
#ifndef WGM_H
#define WGM_H 4
#endif
#ifndef WGM_I
#define WGM_I 4
#endif
#ifndef PH_DUP
#define PH_DUP 0
#endif
#define LAS __attribute__((address_space(3)))
#define GAS __attribute__((address_space(1)))
typedef unsigned short bf16;
typedef short bf16x8 __attribute__((ext_vector_type(8)));
typedef short s16x4 __attribute__((ext_vector_type(4)));
typedef float f32x2 __attribute__((ext_vector_type(2)));
typedef float f32x4 __attribute__((ext_vector_type(4)));
typedef float f32x16 __attribute__((ext_vector_type(16)));
typedef unsigned u32x2 __attribute__((ext_vector_type(2)));
typedef unsigned u32x4 __attribute__((ext_vector_type(4)));

constexpr int D = 2048, NB = 4, SEQ = 8192, DEPTH = 4, SBATCH = 8, SSEQ = 32;
constexpr int MP = NB * SEQ, MS = SBATCH * SSEQ, MR = MP + MS;
constexpr int NH = 8, HD = 128, MH = 4;
constexpr int NPROJ = 6656, IN_DIM = 6664, FF = 8192;
constexpr int C_XA = 0, C_GB = 512, C_GC = 1024, C_Q = 1536, C_K = 2560, C_V = 3584, C_MQ = 4608, C_MK = 5120, C_MV = 5632, C_MO = 6144;
constexpr int KEEP = 512;
constexpr int SKV_ROWS = 640;
constexpr float EPS = 1e-6f;
constexpr float LOG2E = 1.4426950408889634f;
constexpr int NGRP = SEQ / 256;

constexpr size_t O_YP = 0, O_YS = O_YP + (size_t)MP * D, O_PCONV = O_YS + (size_t)MS * D, O_PK = O_PCONV + (size_t)DEPTH * NB * 2 * 512,
                 O_PV = O_PK + (size_t)DEPTH * NB * KEEP * 1024, O_PC = O_PV + (size_t)DEPTH * NB * KEEP * 1024, O_PN = O_PC + (size_t)DEPTH * NB * MH * HD * HD,
                 O_PM = O_PN + (size_t)DEPTH * NB * MH * HD, O_SCONV = O_PM + (size_t)DEPTH * NB * MH, O_SK = O_SCONV + (size_t)DEPTH * SBATCH * 2 * 512,
                 O_SV = O_SK + (size_t)DEPTH * SBATCH * SSEQ * 1024, O_SC = O_SV + (size_t)DEPTH * SBATCH * SSEQ * 1024, O_SN = O_SC + (size_t)DEPTH * SBATCH * MH * HD * HD,
                 O_SM = O_SN + (size_t)DEPTH * SBATCH * MH * HD, O_END = O_SM + (size_t)DEPTH * SBATCH * MH;

constexpr size_t al256(size_t x) { return (x + 255) / 256 * 256; }
constexpr size_t WS_CTL = 0, CTL_BYTES = 1u << 20;
constexpr size_t WS_WIN = CTL_BYTES;
constexpr size_t WS_WOUT = WS_WIN + (size_t)NPROJ * D * 2;
constexpr size_t WS_WUP = WS_WOUT + (size_t)D * D * 2;
constexpr size_t WS_WDN = WS_WUP + (size_t)FF * D * 2;
constexpr size_t WS_H = WS_WDN + (size_t)D * FF * 2;
constexpr size_t WS_XB = WS_H + (size_t)MR * D * 2;
constexpr size_t WS_BIG = WS_XB + (size_t)MR * D * 2;
constexpr size_t BIG_BYTES = (size_t)MR * FF * 2;
constexpr size_t WS_CLOC = WS_BIG + al256((size_t)MR * NPROJ * 2);
constexpr size_t WS_C0 = WS_CLOC + (size_t)16 * NGRP * HD * HD * 4;
constexpr size_t WS_NLOC = WS_C0 + (size_t)16 * NGRP * HD * HD * 2;
constexpr size_t WS_N0 = WS_NLOC + (size_t)16 * NGRP * HD * 4;
constexpr size_t WS_MSC = WS_N0 + (size_t)16 * NGRP * HD * 4;
constexpr size_t WS_MIX_END = WS_MSC + (size_t)16 * NGRP * 4 * 4;
static_assert(WS_MIX_END <= WS_BIG + BIG_BYTES, "mLSTM scratch fits in the free top of BIG");
constexpr size_t WS_GATE = WS_BIG + BIG_BYTES;
constexpr size_t SKV_IMG = (size_t)SBATCH * SKV_ROWS * 1024 * 2;
constexpr size_t WS_SK = WS_GATE + (size_t)MR * 8 * 4;
constexpr size_t WS_SV = WS_SK + 2 * SKV_IMG;
constexpr size_t WS_RSTD = WS_SV + 2 * SKV_IMG;
constexpr size_t WS_END = WS_RSTD + (size_t)MR * 4;
static_assert(WS_END <= 1235000000ull, "workspace budget");

constexpr int RING_BYTES = 131072;
constexpr int MISC_OFF = RING_BYTES;
constexpr int SCR_OFF = MISC_OFF + 256;
constexpr int LDS_BYTES = 147456;
constexpr int NWAVES = 8, NTHREADS = 512;

__device__ __forceinline__ unsigned cvtpk(float lo, float hi) { unsigned r; asm volatile("v_cvt_pk_bf16_f32 %0, %1, %2" : "=v"(r) : "v"(lo), "v"(hi)); return r; }
__device__ __forceinline__ float bflo(unsigned w) { return __uint_as_float(w << 16); }
__device__ __forceinline__ float bfhi(unsigned w) { return __uint_as_float(w & 0xffff0000u); }
__device__ __forceinline__ float bf2f(bf16 b) { return __uint_as_float(((unsigned)b) << 16); }
__device__ __forceinline__ float shx(float v, int o, int lane) { return __int_as_float(__builtin_amdgcn_ds_bpermute((lane ^ o) << 2, __float_as_int(v))); }
__device__ __forceinline__ float shup(float v, int o, int lane) { const int s = lane - o; return __int_as_float(__builtin_amdgcn_ds_bpermute((s < 0 ? lane : s) << 2, __float_as_int(v))); }
__device__ __forceinline__ float wave_sum(float v, int lane) {
#pragma unroll
    for (int o = 1; o < 64; o <<= 1) v += shx(v, o, lane);
    return v;
}
__device__ __forceinline__ float fast_rsqrt(float x) { return __builtin_amdgcn_rsqf(x); }
__device__ __forceinline__ float fast_exp(float x) { return __builtin_amdgcn_exp2f(x * 1.4426950408889634f); }
__device__ __forceinline__ float fast_log(float x) { return __builtin_amdgcn_logf(x) * 0.6931471805599453f; }
__device__ __forceinline__ float opaque_zero() { float z; asm volatile("v_mov_b32 %0, 0" : "=v"(z)); return z; }
#define LDS_WAIT() asm volatile("s_waitcnt lgkmcnt(0)" ::: "memory")
#define VM_WAIT() asm volatile("s_waitcnt vmcnt(0)" ::: "memory")
#define SBAR() __builtin_amdgcn_sched_barrier(0)

namespace pg8 {
typedef unsigned short bf16_t;
constexpr int BM = 256, BK = 64, HALF = 128, HTB = HALF * BK * 2, STAGE_BYTES = 8 * HTB, NXCD = 8, WGM = 4;
__host__ __device__ __forceinline__ int lds_byte(int r, int c) { const int st = (r >> 4) * 2 + (c >> 5), rr = r & 15, cc = c & 31, ob = rr * 64 + cc * 2; return st * 1024 + (ob ^ (((ob >> 9) & 1) << 5)); }
__host__ __device__ __forceinline__ void stage_rc(int b, int& R, int& C) { const int st = b / 1024, sb = b % 1024, swz = sb ^ (((sb >> 9) & 1) << 5); R = (st >> 1) * 16 + swz / 64; C = (st & 1) * 32 + (swz % 64) / 2; }
__host__ __device__ __forceinline__ int perm32(int rho) { const int n = rho >> 4, i = rho & 15; return 8 * (i >> 2) + 4 * n + (i & 3); }
struct Unit { int pm, pn; };
struct Gemm { const bf16_t* A; const bf16_t* Bt; int M, N, K; };
struct StaticOrder {
    int nM, nN, nwg, G, c, wgm;
    __host__ __device__ void init(int M, int N, int G_, int c_, int wgm_ = WGM) { nM = M / BM; nN = N / BM; nwg = nM * nN; G = G_; c = c_; wgm = wgm_; }
    __host__ __device__ bool next(int i, Unit& u) const {
        const long L = (long)i * G + c; if (L >= nwg) return false;
        int wgid = (int)L; { const int q = nwg / NXCD, r = nwg % NXCD, xcd = wgid % NXCD, off = wgid / NXCD; wgid = (xcd < r ? xcd * (q + 1) : r * (q + 1) + (xcd - r) * q) + off; }
        const int nig = wgm * nN, gid = wgid / nig, fm = gid * wgm, gsz = (nM - fm) < wgm ? (nM - fm) : wgm;
        u.pm = fm + ((wgid % nig) % gsz); u.pn = (wgid % nig) / gsz; return true;
    }
    __device__ __forceinline__ void a_ready(const Unit&) const {}
    __device__ __forceinline__ void done(const Unit&) const {}
};
template <int ACT  > struct EpiBf16 {
    static constexpr bool PERM = true, AFTER_DRAIN = false;
    static constexpr bool RSL = true;
    bf16_t* O; int ldc; const float* rstd; LAS float* T;
    __device__ __forceinline__ void rs_fetch(const Unit& u, int tid, int par) const { if (rstd && tid < BM) (T + 2048 + par * BM)[tid] = rstd[u.pm * BM + tid]; }
    __device__ __forceinline__ void operator()(const f32x4 (&acc)[2][2][4][2], const Unit& u, int wr, int wc, int fr, int fq, int par) const {
        const int row0 = u.pm * BM + wr * 64 + fr; const int col0 = u.pn * BM + wc * 32 + 8 * fq;
#pragma unroll
        for (int ai = 0; ai < 2; ++ai)
#pragma unroll
            for (int m = 0; m < 4; ++m) { bf16_t* rowp = O + (size_t)(row0 + ai * HALF + m * 16) * ldc + col0; const float rsv = rstd ? (T + 2048 + par * BM)[wr * 64 + fr + ai * HALF + m * 16] : 1.0f;
#pragma unroll
                for (int bj = 0; bj < 2; ++bj) { f32x4 v0 = acc[ai][bj][m][0] * rsv, v1 = acc[ai][bj][m][1] * rsv;
                    if (ACT == 1) {
#pragma unroll
                        for (int j = 0; j < 4; ++j) { const float a = fmaxf(v0[j], 0.f), b = fmaxf(v1[j], 0.f); v0[j] = a * a; v1[j] = b * b; } }
                    u32x4 w; w.x = cvtpk(v0[0], v0[1]); w.y = cvtpk(v0[2], v0[3]); w.z = cvtpk(v1[0], v1[1]); w.w = cvtpk(v1[2], v1[3]);
                    *(u32x4*)(rowp + bj * HALF) = w; } }
    }
};
struct EpiProj {
    static constexpr bool PERM = true, AFTER_DRAIN = false;
    static constexpr bool RSL = true;
    bf16_t* O; int ldc; const float* gq; const float* gk; LAS float* T; const float* rstd;
    __device__ __forceinline__ void rs_fetch(const Unit& u, int tid, int par) const { if (tid < BM) (T + 2048 + par * BM)[tid] = rstd[u.pm * BM + tid]; }
    __device__ __forceinline__ void operator()(const f32x4 (&acc)[2][2][4][2], const Unit& u, int wr, int wc, int fr, int fq, int par) const {
        const int row0 = u.pm * BM + wr * 64 + fr; const int col0 = u.pn * BM + wc * 32 + 8 * fq;
        const bool isqk = (u.pn >= 6) && (u.pn < 14);
        float rs[2][4];
#pragma unroll
        for (int ai = 0; ai < 2; ++ai)
#pragma unroll
            for (int m = 0; m < 4; ++m) rs[ai][m] = (T + 2048 + par * BM)[wr * 64 + fr + ai * HALF + m * 16];
        if (!isqk) {
#pragma unroll
            for (int ai = 0; ai < 2; ++ai)
#pragma unroll
                for (int m = 0; m < 4; ++m) { bf16_t* rowp = O + (size_t)(row0 + ai * HALF + m * 16) * ldc + col0;
#pragma unroll
                    for (int bj = 0; bj < 2; ++bj) { const f32x4 v0 = acc[ai][bj][m][0] * rs[ai][m], v1 = acc[ai][bj][m][1] * rs[ai][m];
                        u32x4 w; w.x = cvtpk(v0[0], v0[1]); w.y = cvtpk(v0[2], v0[3]); w.z = cvtpk(v1[0], v1[1]); w.w = cvtpk(v1[2], v1[3]);
                        *(u32x4*)(rowp + bj * HALF) = w; } }
            return;
        }
        const int lane = fr + 16 * fq;
        float ss[2][4][2];
#pragma unroll
        for (int ai = 0; ai < 2; ++ai)
#pragma unroll
            for (int m = 0; m < 4; ++m)
#pragma unroll
                for (int bj = 0; bj < 2; ++bj) { const f32x4 v0 = acc[ai][bj][m][0] * rs[ai][m], v1 = acc[ai][bj][m][1] * rs[ai][m];
                    float s = (v0[0] * v0[0] + v0[1] * v0[1]) + (v0[2] * v0[2] + v0[3] * v0[3]) + (v1[0] * v1[0] + v1[1] * v1[1]) + (v1[2] * v1[2] + v1[3] * v1[3]);
                    s += shx(s, 16, lane); s += shx(s, 32, lane); ss[ai][m][bj] = s; }
        if (fq == 0) {
#pragma unroll
            for (int ai = 0; ai < 2; ++ai)
#pragma unroll
                for (int m = 0; m < 4; ++m)
#pragma unroll
                    for (int bj = 0; bj < 2; ++bj) T[(ai * HALF + wr * 64 + m * 16 + fr) * 8 + bj * 4 + wc] = ss[ai][m][bj];
        }
        asm volatile("s_waitcnt lgkmcnt(0)" ::: "memory"); __builtin_amdgcn_s_barrier(); asm volatile("" ::: "memory");
        const float* gg = ((u.pn < 10) ? gq : gk) + wc * 32 + 8 * fq;
        const f32x4 g0 = *(const f32x4*)gg, g1 = *(const f32x4*)(gg + 4);
#pragma unroll
        for (int ai = 0; ai < 2; ++ai)
#pragma unroll
            for (int m = 0; m < 4; ++m) { bf16_t* rowp = O + (size_t)(row0 + ai * HALF + m * 16) * ldc + col0;
#pragma unroll
                for (int bj = 0; bj < 2; ++bj) { const f32x4 t = *(const LAS f32x4*)(T + (ai * HALF + wr * 64 + m * 16 + fr) * 8 + bj * 4);
                    const float rq = fast_rsqrt(((t[0] + t[1]) + (t[2] + t[3])) * (1.0f / 128.0f) + 1e-6f) * rs[ai][m];
                    const f32x4 v0 = acc[ai][bj][m][0] * rq * g0, v1 = acc[ai][bj][m][1] * rq * g1;
                    u32x4 w; w.x = cvtpk(v0[0], v0[1]); w.y = cvtpk(v0[2], v0[3]); w.z = cvtpk(v1[0], v1[1]); w.w = cvtpk(v1[2], v1[3]);
                    *(u32x4*)(rowp + bj * HALF) = w; } }
    }
};
struct EpiResAdd {
    static constexpr bool RSL = false;
    static constexpr bool PERM = true, AFTER_DRAIN = false;
    bf16_t* XB; float* Y; int ldc; bool fin;
    __device__ __forceinline__ void operator()(const f32x4 (&acc)[2][2][4][2], const Unit& u, int wr, int wc, int fr, int fq, int) const {
        const int row0 = u.pm * BM + wr * 64 + fr, col0 = u.pn * BM + wc * 32 + 8 * fq;
        u32x4 r[2][4][2];
#pragma unroll
        for (int ai = 0; ai < 2; ++ai)
#pragma unroll
            for (int m = 0; m < 4; ++m)
#pragma unroll
                for (int bj = 0; bj < 2; ++bj) r[ai][m][bj] = *(const u32x4*)(XB + (size_t)(row0 + ai * HALF + m * 16) * ldc + col0 + bj * HALF);
#pragma unroll
        for (int ai = 0; ai < 2; ++ai)
#pragma unroll
            for (int m = 0; m < 4; ++m)
#pragma unroll
                for (int bj = 0; bj < 2; ++bj) { const u32x4 w = r[ai][m][bj]; const f32x4 a0 = acc[ai][bj][m][0], a1 = acc[ai][bj][m][1];
                    const f32x4 v0 = (f32x4){bflo(w.x) + a0[0], bfhi(w.x) + a0[1], bflo(w.y) + a0[2], bfhi(w.y) + a0[3]}, v1 = (f32x4){bflo(w.z) + a1[0], bfhi(w.z) + a1[1], bflo(w.w) + a1[2], bfhi(w.w) + a1[3]};
                    const size_t off = (size_t)(row0 + ai * HALF + m * 16) * ldc + col0 + bj * HALF;
                    if (fin) { *(f32x4*)(Y + off) = v0; *(f32x4*)(Y + off + 4) = v1; }
                    else { u32x4 o; o.x = cvtpk(v0[0], v0[1]); o.y = cvtpk(v0[2], v0[3]); o.z = cvtpk(v1[0], v1[1]); o.w = cvtpk(v1[2], v1[3]); *(u32x4*)(XB + off) = o; } }
    }
};

template <class Epi, class Sched, bool ALIGN_EPI = false, bool SP2 = false>
__device__ __forceinline__ void gemm_phase(LAS unsigned char* lds, const Gemm g, const Sched& S, const Epi& E, const int wave_) {
    int ln_; asm volatile("v_mbcnt_lo_u32_b32 %0, -1, 0\n\tv_mbcnt_hi_u32_b32 %0, -1, %0" : "=v"(ln_)); const int tid = wave_ * 64 + ln_;
    const int wid = __builtin_amdgcn_readfirstlane(tid >> 6), lane = tid & 63, wr = wid >> 2, wc = wid & 3, fr = lane & 15, fq = lane >> 4;
    const int K = g.K, nt = K / BK;
    unsigned voffA[2], voffB[2];
#pragma unroll
    for (int i = 0; i < 2; ++i) { int R, C; stage_rc(tid * 16 + i * 8192, R, C); const int Rb = Epi::PERM ? ((R & ~31) + perm32(R & 31)) : R;
        voffA[i] = (unsigned)(R * K + C) * 2u; voffB[i] = (unsigned)(Rb * K + C) * 2u; }
    const size_t kstep = (size_t)(BK * 2);
    const size_t hstep = (size_t)HALF * K * 2;
    const size_t tstep = 2 * hstep;
    const unsigned ldsw = (unsigned)wid * 1024u;
    const int aoff = lds_byte(wr * 64 + fr, fq * 8), boff = lds_byte(wc * 32 + fr, fq * 8);
#define PG8_SA(b, h) (((b) * 2 + (h)) * HTB)
#define PG8_SB(b, h) ((4 + (b) * 2 + (h)) * HTB)
#define PG8_STAGE(bufoff, gbase, voff) do { _Pragma("unroll") for (int _i = 0; _i < 2; ++_i) \
        __builtin_amdgcn_global_load_lds((const unsigned*)((const char*)(gbase) + (voff)[_i]), (LAS unsigned*)(lds + (bufoff) + ldsw + _i * 8192), 16, 0, 0); } while (0)
#define PG8_LDA(dst, b, h) do { _Pragma("unroll") for (int m = 0; m < 4; ++m) _Pragma("unroll") for (int k = 0; k < 2; ++k) dst[m][k] = *(const LAS bf16x8*)(lds + PG8_SA(b, h) + aoff + m * 2048 + k * 1024); } while (0)
#define PG8_LDB(dst, b, h) do { _Pragma("unroll") for (int n = 0; n < 2; ++n) _Pragma("unroll") for (int k = 0; k < 2; ++k) dst[n][k] = *(const LAS bf16x8*)(lds + PG8_SB(b, h) + boff + n * 2048 + k * 1024); } while (0)
#define PG8_MMA(ai, bj, At, Bt) do { __builtin_amdgcn_s_setprio(1); _Pragma("unroll") for (int m = 0; m < 4; ++m) _Pragma("unroll") for (int n = 0; n < 2; ++n) _Pragma("unroll") for (int k = 0; k < 2; ++k) \
        acc[ai][bj][m][n] = __builtin_amdgcn_mfma_f32_16x16x32_bf16(Bt[n][k], At[m][k], acc[ai][bj][m][n], 0, 0, 0); __builtin_amdgcn_s_setprio(0); } while (0)
#define PG8_WAIT_V(n) asm volatile("s_waitcnt vmcnt(" #n ")" ::: "memory")
#define PG8_WAIT_L(n) asm volatile("s_waitcnt lgkmcnt(" #n ")" ::: "memory")
#define PG8_BAR __builtin_amdgcn_s_barrier()
#define PG8_SCHED __builtin_amdgcn_sched_barrier(0)
    Unit cur, nxt; int ui = 0;
    if (!S.next(0, cur)) return;
    f32x4 acc[2][2][4][2];
    { const float z = opaque_zero();
#pragma unroll
    for (int a = 0; a < 2; ++a)
#pragma unroll
        for (int b = 0; b < 2; ++b)
#pragma unroll
            for (int m = 0; m < 4; ++m)
#pragma unroll
                for (int n = 0; n < 2; ++n) acc[a][b][m][n] = (f32x4){z, z, z, z}; }
    bf16x8 At[4][2], B0[2][2], B1[2][2];
    const char* cA = (const char*)g.A + (size_t)cur.pm * tstep; const char* cB = (const char*)g.Bt + (size_t)cur.pn * tstep;
    S.a_ready(cur);
    if constexpr (Epi::RSL) E.rs_fetch(cur, tid, 0);
    if constexpr (SP2) {
        PG8_STAGE(PG8_SB(0, 0), cB, voffB); PG8_STAGE(PG8_SB(0, 1), cB + hstep, voffB); PG8_STAGE(PG8_SA(0, 0), cA, voffA); PG8_STAGE(PG8_SA(0, 1), cA + hstep, voffA);
        if (wr == 1) PG8_BAR;
        PG8_WAIT_V(2); PG8_BAR;
        PG8_STAGE(PG8_SB(1, 0), cB + kstep, voffB); PG8_STAGE(PG8_SA(1, 0), cA + kstep, voffA); PG8_STAGE(PG8_SB(1, 1), cB + hstep + kstep, voffB);
        PG8_WAIT_V(6); PG8_BAR;
    } else {
        PG8_STAGE(PG8_SB(0, 0), cB, voffB); PG8_STAGE(PG8_SA(0, 0), cA, voffA); PG8_STAGE(PG8_SB(0, 1), cB + hstep, voffB); PG8_STAGE(PG8_SA(0, 1), cA + hstep, voffA);
        if (wr == 1) PG8_BAR;
        PG8_WAIT_V(4); PG8_BAR;
        PG8_STAGE(PG8_SB(1, 0), cB + kstep, voffB); PG8_STAGE(PG8_SA(1, 0), cA + kstep, voffA); PG8_STAGE(PG8_SB(1, 1), cB + hstep + kstep, voffB);
        PG8_WAIT_V(6); PG8_BAR;
    }
    for (;;) {
        const bool has_next = S.next(ui + 1, nxt);
        const char* nA = has_next ? (const char*)g.A + (size_t)nxt.pm * tstep : cA; const char* nB = has_next ? (const char*)g.Bt + (size_t)nxt.pn * tstep : cB;
        for (int t = 0; t < nt; t += 2) {
            const bool last = (t == nt - 2);
            const char* a1 = cA + (size_t)(t + 1) * kstep;
            const char* a2 = last ? nA : cA + (size_t)(t + 2) * kstep; const char* b2 = last ? nB : cB + (size_t)(t + 2) * kstep;
            const char* a3 = a2 + kstep; const char* b3 = b2 + kstep;
            if (last && has_next) S.a_ready(nxt);
            if constexpr (SP2) {
            PG8_LDB(B0, 0, 0); PG8_LDB(B1, 0, 1); PG8_SCHED; PG8_LDA(At, 0, 0); PG8_STAGE(PG8_SA(1, 1), a1 + hstep, voffA);
            PG8_WAIT_V(8); PG8_WAIT_L(0); PG8_BAR; PG8_MMA(0, 0, At, B0); PG8_MMA(0, 1, At, B1); PG8_BAR; PG8_SCHED;
            PG8_LDA(At, 0, 1); PG8_STAGE(PG8_SB(0, 0), b2, voffB); PG8_STAGE(PG8_SB(0, 1), b2 + hstep, voffB); PG8_STAGE(PG8_SA(0, 0), a2, voffA);
            PG8_WAIT_V(8); PG8_WAIT_L(0); PG8_BAR; PG8_MMA(1, 0, At, B0); PG8_MMA(1, 1, At, B1); PG8_BAR; PG8_SCHED;
            PG8_LDB(B0, 1, 0); PG8_LDB(B1, 1, 1); PG8_SCHED; PG8_LDA(At, 1, 0); PG8_STAGE(PG8_SA(0, 1), a2 + hstep, voffA);
            PG8_WAIT_V(8); PG8_WAIT_L(0); PG8_BAR; PG8_MMA(0, 0, At, B0); PG8_MMA(0, 1, At, B1); PG8_BAR; PG8_SCHED;
            PG8_LDA(At, 1, 1); PG8_STAGE(PG8_SB(1, 0), b3, voffB); PG8_STAGE(PG8_SB(1, 1), b3 + hstep, voffB); PG8_STAGE(PG8_SA(1, 0), a3, voffA);
            PG8_WAIT_V(8); PG8_WAIT_L(0); PG8_BAR; PG8_MMA(1, 0, At, B0); PG8_MMA(1, 1, At, B1); PG8_BAR; PG8_SCHED;
            } else {
            PG8_LDB(B0, 0, 0); PG8_SCHED; PG8_LDA(At, 0, 0); PG8_STAGE(PG8_SA(1, 1), a1 + hstep, voffA);
            PG8_WAIT_L(8); PG8_BAR; PG8_WAIT_L(0); PG8_MMA(0, 0, At, B0); PG8_BAR; PG8_SCHED;
            PG8_LDB(B1, 0, 1); PG8_STAGE(PG8_SB(0, 0), b2, voffB);
            PG8_BAR; PG8_WAIT_L(0); PG8_MMA(0, 1, At, B1); PG8_BAR;
            PG8_LDA(At, 0, 1); PG8_STAGE(PG8_SA(0, 0), a2, voffA);
            PG8_BAR; PG8_WAIT_L(0); PG8_MMA(1, 0, At, B0); PG8_BAR; PG8_SCHED;
            PG8_STAGE(PG8_SB(0, 1), b2 + hstep, voffB);
            PG8_WAIT_V(6); PG8_BAR; PG8_MMA(1, 1, At, B1); PG8_BAR;
            PG8_LDB(B0, 1, 0); PG8_SCHED; PG8_LDA(At, 1, 0); PG8_STAGE(PG8_SA(0, 1), a2 + hstep, voffA);
            PG8_WAIT_L(8); PG8_BAR; PG8_WAIT_L(0); PG8_MMA(0, 0, At, B0); PG8_BAR; PG8_SCHED;
            PG8_LDB(B1, 1, 1); PG8_STAGE(PG8_SB(1, 0), b3, voffB);
            PG8_BAR; PG8_WAIT_L(0); PG8_MMA(0, 1, At, B1); PG8_BAR;
            PG8_LDA(At, 1, 1); PG8_STAGE(PG8_SA(1, 0), a3, voffA);
            PG8_BAR; PG8_WAIT_L(0); PG8_MMA(1, 0, At, B0); PG8_BAR; PG8_SCHED;
            PG8_STAGE(PG8_SB(1, 1), b3 + hstep, voffB);
            PG8_WAIT_V(6); PG8_BAR; PG8_MMA(1, 1, At, B1); PG8_BAR;
            }
        }
        if constexpr (ALIGN_EPI) { if (wr == 0) PG8_BAR; }
        if constexpr (!Epi::AFTER_DRAIN) { E(acc, cur, wr, wc, fr, fq, ui & 1); S.done(cur); if constexpr (Epi::RSL) { if (has_next) E.rs_fetch(nxt, tid, (ui + 1) & 1); } }
        if (!has_next) break;
        { const float z = opaque_zero();
#pragma unroll
        for (int a = 0; a < 2; ++a)
#pragma unroll
            for (int b = 0; b < 2; ++b)
#pragma unroll
                for (int m = 0; m < 4; ++m)
#pragma unroll
                    for (int n = 0; n < 2; ++n) acc[a][b][m][n] = (f32x4){z, z, z, z}; }
        cur = nxt; cA = nA; cB = nB; ++ui;
        if constexpr (ALIGN_EPI) { if (wr == 1) PG8_BAR; }
    }
    PG8_WAIT_V(0);
    if constexpr (!ALIGN_EPI) { if (wr == 0) PG8_BAR; }
    PG8_BAR;
#undef PG8_SA
#undef PG8_SB
#undef PG8_STAGE
#undef PG8_LDA
#undef PG8_LDB
#undef PG8_MMA
#undef PG8_WAIT_V
#undef PG8_WAIT_L
#undef PG8_BAR
#undef PG8_SCHED
}
}

struct SEpiBf16 { bf16* O; int ldc; int act; const float* rstd;
    __device__ __forceinline__ void operator()(int row, int col, f32x4 s0, f32x4 s1) const {
        { const float r_ = rstd[row]; s0 = s0 * r_; s1 = s1 * r_; }
        if (act) {
#pragma unroll
            for (int j = 0; j < 4; ++j) { const float a = fmaxf(s0[j], 0.f), b = fmaxf(s1[j], 0.f); s0[j] = a * a; s1[j] = b * b; } }
        u32x4 w; w.x = cvtpk(s0[0], s0[1]); w.y = cvtpk(s0[2], s0[3]); w.z = cvtpk(s1[0], s1[1]); w.w = cvtpk(s1[2], s1[3]);
        *(u32x4*)(O + (size_t)row * ldc + col) = w; } };
struct SEpiResAdd { bf16* XB; float* Y; int ldc; bool fin;
    __device__ __forceinline__ void operator()(int row, int col, f32x4 s0, f32x4 s1) const {
        const size_t off = (size_t)row * ldc + col; const u32x4 w = *(const u32x4*)(XB + off);
        const f32x4 v0 = (f32x4){bflo(w.x) + s0[0], bfhi(w.x) + s0[1], bflo(w.y) + s0[2], bfhi(w.y) + s0[3]}, v1 = (f32x4){bflo(w.z) + s1[0], bfhi(w.z) + s1[1], bflo(w.w) + s1[2], bfhi(w.w) + s1[3]};
        if (fin) { *(f32x4*)(Y + off) = v0; *(f32x4*)(Y + off + 4) = v1; }
        else { u32x4 o; o.x = cvtpk(v0[0], v0[1]); o.y = cvtpk(v0[2], v0[3]); o.z = cvtpk(v1[0], v1[1]); o.w = cvtpk(v1[2], v1[3]); *(u32x4*)(XB + off) = o; } } };
template <class Epi>
__device__ __forceinline__ void sample_gemm(LAS unsigned char* lds, int wave, int vcu, int G, const bf16* __restrict__ A, const bf16* __restrict__ Bt, int N, int K, const Epi& E) {
    int ln_; asm volatile("v_mbcnt_lo_u32_b32 %0, -1, 0\n\tv_mbcnt_hi_u32_b32 %0, -1, %0" : "=v"(ln_)); const int tid = wave * 64 + ln_;
    const int lane = tid & 63, fr = lane & 15, fq = lane >> 4;
    const int ntiles = 4 * (N >> 6), kslice = K >> 3, kb = wave * kslice;
    LAS float* red = (LAS float*)lds;
    for (int t = vcu; t < ntiles; t += G) {
        const int rt = t & 3, ct = t >> 2;
        f32x4 acc[4][4];
        { const float z = opaque_zero();
#pragma unroll
          for (int m = 0; m < 4; ++m)
#pragma unroll
              for (int n = 0; n < 4; ++n) acc[m][n] = (f32x4){z, z, z, z}; }
        const bf16* ap = A + (size_t)(rt * 64 + fr) * K + kb + 8 * fq;
        const bf16* bp = Bt + (size_t)(ct * 64 + fr) * K + kb + 8 * fq;
        const size_t r16 = (size_t)16 * K;
#pragma unroll 4
        for (int k = 0; k < kslice; k += 64) {
            bf16x8 a0[4], a1[4], b0[4], b1[4];
#pragma unroll
            for (int m = 0; m < 4; ++m) { a0[m] = *(const bf16x8*)(ap + m * r16 + k); a1[m] = *(const bf16x8*)(ap + m * r16 + k + 32); }
#pragma unroll
            for (int n = 0; n < 4; ++n) { b0[n] = *(const bf16x8*)(bp + n * r16 + k); b1[n] = *(const bf16x8*)(bp + n * r16 + k + 32); }
#pragma unroll
            for (int m = 0; m < 4; ++m)
#pragma unroll
                for (int n = 0; n < 4; ++n) { acc[m][n] = __builtin_amdgcn_mfma_f32_16x16x32_bf16(a0[m], b0[n], acc[m][n], 0, 0, 0);
                                              acc[m][n] = __builtin_amdgcn_mfma_f32_16x16x32_bf16(a1[m], b1[n], acc[m][n], 0, 0, 0); }
        }
        __syncthreads();
#pragma unroll
        for (int m = 0; m < 4; ++m)
#pragma unroll
            for (int n = 0; n < 4; ++n)
#pragma unroll
                for (int j = 0; j < 4; ++j) red[wave * 4096 + (16 * m + 4 * fq + j) * 64 + 16 * n + fr] = acc[m][n][j];
        __syncthreads();
        const int row = tid >> 3, col = (tid & 7) * 8;
        f32x4 s0 = *(const LAS f32x4*)(red + row * 64 + col), s1 = *(const LAS f32x4*)(red + row * 64 + col + 4);
#pragma unroll
        for (int w = 1; w < 8; ++w) { s0 = s0 + *(const LAS f32x4*)(red + w * 4096 + row * 64 + col); s1 = s1 + *(const LAS f32x4*)(red + w * 4096 + row * 64 + col + 4); }
        E(rt * 64 + row, ct * 64 + col, s0, s1);
    }
    __syncthreads();
}

#define XB_TMO      128
#define XB_XCNT(j)  (256  + 64 * (j))
#define XB_XSUB(j)  (1280 + 64 * (j))
#define XB_XGEN(j)  (2304 + 64 * (j))
#define XB_TOP      3328
#define XB_TOPGEN   3392
#define XCD_BAR_WORDS 3456
#define XB_SPIN_CAP (1u << 18)
__device__ __forceinline__ unsigned xb_ld(unsigned* p)              { return __hip_atomic_load(p, __ATOMIC_RELAXED, __HIP_MEMORY_SCOPE_AGENT); }
__device__ __forceinline__ unsigned xb_add(unsigned* p, unsigned v) { return __hip_atomic_fetch_add(p, v, __ATOMIC_RELAXED, __HIP_MEMORY_SCOPE_AGENT); }
__device__ __forceinline__ unsigned xb_xcc_id() { return (unsigned)__builtin_amdgcn_s_getreg((3 << 11) | 20) & 0xFu; }
#define XB_SPIN(cond, bar) do { unsigned _sp = 0; while (cond) { __builtin_amdgcn_s_sleep(1); \
    if ((++_sp & 255u) == 0u) { if (xb_ld(&(bar)[XB_TMO])) break; if (_sp > XB_SPIN_CAP) { atomicAdd(&(bar)[XB_TMO], 1u); break; } } } } while (0)
struct XcdBarrier { unsigned* bar; unsigned x; volatile LAS unsigned* st; };
__device__ __forceinline__ XcdBarrier xcd_barrier_post(unsigned* bar, volatile LAS unsigned* st, bool leader) {
    XcdBarrier b; b.bar = bar; b.x = xb_xcc_id(); b.st = st;
    if (leader) (void)xb_add(&bar[XB_XCNT(b.x)], 1u);
    return b;
}
__device__ __forceinline__ void xcd_barrier_complete(unsigned* bar, unsigned x, unsigned& nloc, unsigned& nx) {
    const unsigned G = gridDim.x * gridDim.y * gridDim.z;
    unsigned sum, cnt, mine, sp = 0u;
    for (;;) {
        sum = 0u; cnt = 0u; mine = 0u;
#pragma unroll
        for (unsigned j = 0; j < 16; ++j) { const unsigned c = xb_ld(&bar[XB_XCNT(j)]); sum += c; cnt += (c > 0u) ? 1u : 0u; mine = (j == x) ? c : mine; }
        if (sum == G) break;
        __builtin_amdgcn_s_sleep(1);
        if ((++sp & 255u) == 0u) { if (xb_ld(&bar[XB_TMO])) break; if (sp > XB_SPIN_CAP) { atomicAdd(&bar[XB_TMO], 1u); break; } }
    }
    nloc = mine > 0u ? mine : 1u; nx = cnt > 0u ? cnt : 1u;
}
__device__ __noinline__ void xcd_barrier(unsigned* bar_, unsigned x_, volatile LAS unsigned* st_, int wave_) {
    XcdBarrier b; b.bar = bar_; b.x = x_; b.st = st_;
    int ln_; asm volatile("v_mbcnt_lo_u32_b32 %0, -1, 0\n\tv_mbcnt_hi_u32_b32 %0, -1, %0" : "=v"(ln_)); const bool leader_ = (wave_ == 0) && (ln_ == 0);
    asm volatile("s_waitcnt vmcnt(0)" ::: "memory");
    __syncthreads();
    if (leader_) {
        unsigned* bar = b.bar;
        __builtin_amdgcn_s_waitcnt(0);
        unsigned nloc = b.st[0], nx = b.st[1];
        if (nloc == 0u) { xcd_barrier_complete(bar, b.x, nloc, nx); b.st[0] = nloc; b.st[1] = nx; }
        const unsigned old = xb_add(&bar[XB_XSUB(b.x)], 1u);
        const unsigned gen = old / nloc;
        if (old + 1u == (gen + 1u) * nloc) {
            __builtin_amdgcn_fence(__ATOMIC_RELEASE, "agent");
            asm volatile("s_waitcnt vmcnt(0)" ::: "memory");
            const unsigned og = xb_add(&bar[XB_TOP], 1u);
            const unsigned tg = og / nx;
            if (og + 1u == (tg + 1u) * nx) xb_add(&bar[XB_TOPGEN], 1u);
            else XB_SPIN(xb_ld(&bar[XB_TOPGEN]) == tg, bar);
            __builtin_amdgcn_fence(__ATOMIC_ACQUIRE, "agent");
            xb_add(&bar[XB_XGEN(b.x)], 1u);
            asm volatile("s_waitcnt vmcnt(0)" ::: "memory");
        } else {
            XB_SPIN(xb_ld(&bar[XB_XGEN(b.x)]) == gen, bar);
            __builtin_amdgcn_fence(__ATOMIC_ACQUIRE, "agent");
            asm volatile("s_waitcnt vmcnt(0)" ::: "memory");
        }
    }
    __syncthreads();
}

#define KSWZ(row, colB) ((row) * 256 + ((colB) ^ (((row) & 7) << 4)))
__device__ __forceinline__ int crow(int r, int hi) { return (r & 3) + 8 * (r >> 2) + 4 * hi; }
__device__ __forceinline__ int v_st(int k, int c) { const int kk = (k & ~0xC) | ((k & 4) << 1) | ((k & 8) >> 1); return ((kk >> 3) * 4 + (c >> 5)) * 512 + ((kk & 7) * 32 + (c & 31)) * 2; }
__device__ __forceinline__ int v_rd_base(int lane) { return ((lane & 3) << 3) | (((lane >> 2) & 3) << 6) | (((lane >> 4) & 1) << 5) | (((lane >> 5) & 1) << 8); }
constexpr int v_rd_off(int d0, int ks, int half) { return d0 * 512 + ks * 4096 + half * 2048; }
template <int OFF> __device__ __forceinline__ s16x4 tr_read(int vb) {
    s16x4 r; asm volatile("ds_read_b64_tr_b16 %0, %1 offset:%2" : "=&v"(r) : "v"(vb), "i"(OFF) : "memory"); return r;
}
#define PKLH(L, H) (bf16x8){L[0], L[1], L[2], L[3], H[0], H[1], H[2], H[3]}
template <int D0> __device__ __forceinline__ void pv_one(f32x16& od, int vb, bf16x8 pa0, bf16x8 pa1, bf16x8 pa2, bf16x8 pa3) {
    const s16x4 l0 = tr_read<v_rd_off(D0, 0, 0)>(vb), h0 = tr_read<v_rd_off(D0, 0, 1)>(vb), l1 = tr_read<v_rd_off(D0, 1, 0)>(vb), h1 = tr_read<v_rd_off(D0, 1, 1)>(vb);
    const s16x4 l2 = tr_read<v_rd_off(D0, 2, 0)>(vb), h2 = tr_read<v_rd_off(D0, 2, 1)>(vb), l3 = tr_read<v_rd_off(D0, 3, 0)>(vb), h3 = tr_read<v_rd_off(D0, 3, 1)>(vb);
    asm volatile("s_waitcnt lgkmcnt(0)" ::: "memory"); SBAR();
    od = __builtin_amdgcn_mfma_f32_32x32x16_bf16(pa0, PKLH(l0, h0), od, 0, 0, 0);
    od = __builtin_amdgcn_mfma_f32_32x32x16_bf16(pa1, PKLH(l1, h1), od, 0, 0, 0);
    od = __builtin_amdgcn_mfma_f32_32x32x16_bf16(pa2, PKLH(l2, h2), od, 0, 0, 0);
    od = __builtin_amdgcn_mfma_f32_32x32x16_bf16(pa3, PKLH(l3, h3), od, 0, 0, 0);
}
__device__ __forceinline__ void pv_d0(f32x16* o, int vb, bf16x8 pa0, bf16x8 pa1, bf16x8 pa2, bf16x8 pa3) {
    pv_one<0>(o[0], vb, pa0, pa1, pa2, pa3); pv_one<1>(o[1], vb, pa0, pa1, pa2, pa3); pv_one<2>(o[2], vb, pa0, pa1, pa2, pa3); pv_one<3>(o[3], vb, pa0, pa1, pa2, pa3);
}
template <int D0, int KS> __device__ __forceinline__ bf16x8 tr_frag(int vb) {
    const s16x4 l = tr_read<v_rd_off(D0, KS, 0)>(vb), h = tr_read<v_rd_off(D0, KS, 1)>(vb);
    return PKLH(l, h);
}
__device__ __forceinline__ void qkt(f32x16& p0, f32x16& p1, int Ks  , const bf16x8* qr, int r32, int hi) {
    p0 = f32x16{}; p1 = f32x16{};
#pragma unroll
    for (int d0 = 0; d0 < 8; ++d0) { const int cb = (d0 * 16 + hi * 8) * 2;
        const bf16x8 b0 = *(const LAS bf16x8*)(uintptr_t)(unsigned)(Ks + KSWZ(r32, cb));
        const bf16x8 b1 = *(const LAS bf16x8*)(uintptr_t)(unsigned)(Ks + KSWZ(32 + r32, cb));
        p0 = __builtin_amdgcn_mfma_f32_32x32x16_bf16(b0, qr[d0], p0, 0, 0, 0);
        p1 = __builtin_amdgcn_mfma_f32_32x32x16_bf16(b1, qr[d0], p1, 0, 0, 0); }
}
#define PK4(P, BASE, OUT) do { unsigned a0 = cvtpk(P[BASE + 0], P[BASE + 1]), a1 = cvtpk(P[BASE + 2], P[BASE + 3]);   \
    unsigned b0 = cvtpk(P[BASE + 4], P[BASE + 5]), b1 = cvtpk(P[BASE + 6], P[BASE + 7]);                              \
    auto r0 = __builtin_amdgcn_permlane32_swap(a0, b0, false, false); auto r1 = __builtin_amdgcn_permlane32_swap(a1, b1, false, false); \
    u32x4 w = {r0[0], r1[0], r0[1], r1[1]}; OUT = *reinterpret_cast<bf16x8*>(&w); } while (0)
__device__ __forceinline__ float half_swap_add(float v) { auto rr = __builtin_amdgcn_permlane32_swap(__float_as_uint(v), __float_as_uint(v), false, false); return __uint_as_float(rr[0]) + __uint_as_float(rr[1]); }
__device__ __forceinline__ float half_swap_max(float v) { auto rr = __builtin_amdgcn_permlane32_swap(__float_as_uint(v), __float_as_uint(v), false, false); return fmaxf(__uint_as_float(rr[0]), __uint_as_float(rr[1])); }

struct Args {
    const float* x_prompt; const float* x_sample; const float* cache_k; const float* cache_v; const float* state_conv; const float* state_c; const float* state_n; const float* state_m;
    const float* norm_mix_g; const float* w_in; const float* conv_w; const float* q_norm_g; const float* k_norm_g; const float* rel_bias; const float* b_igate; const float* b_fgate;
    const float* mlstm_norm_g; const float* w_out; const float* norm_mlp_g; const float* w_up; const float* w_down;
    float* out; unsigned char* ws; int ph_lo, ph_hi, rep, pad;
};
struct Ctx {
    LAS unsigned char* lds; int tid, lane, wave, G, vcu;
};
constexpr int NPH_LAYER = 9, NPHASES = DEPTH * NPH_LAYER;
__device__ __forceinline__ int hw_tid(int wave) { int ln; asm volatile("v_mbcnt_lo_u32_b32 %0, -1, 0\n\tv_mbcnt_hi_u32_b32 %0, -1, %0" : "=v"(ln)); return wave * 64 + ln; }
__device__ __forceinline__ Ctx relaunder(const Ctx& c) { Ctx d = c; const int t = hw_tid(c.wave); d.tid = t; d.lane = t & 63; return d; }

__device__ __forceinline__ void transpose_item(const float* W, int K, int ldn, int nblk, bf16* WT, LAS float* scr, int item, int lane, const float* gain = nullptr) {
    const int kb = item / nblk, nb = item % nblk, k0 = 64 * kb, n0 = 32 * nb;
    const int c = lane & 7;
    f32x4 g0 = (f32x4){1.f, 1.f, 1.f, 1.f}, g1 = g0;
    if (gain) { g0 = *(const f32x4*)(gain + k0 + 8 * c); g1 = *(const f32x4*)(gain + k0 + 8 * c + 4); }
#pragma unroll 8
    for (int i = 0; i < 32; ++i) { const int kk = 2 * i + (lane >> 5); scr[kk * 33 + (lane & 31)] = W[(size_t)(k0 + kk) * ldn + n0 + (lane & 31)]; }
    LDS_WAIT(); asm volatile("" ::: "memory");
#pragma unroll
    for (int j = 0; j < 4; ++j) { const int n = (lane >> 3) + 8 * j; const LAS float* s = scr + (8 * c) * 33 + n;
        u32x4 o; o.x = cvtpk(s[0 * 33] * g0[0], s[1 * 33] * g0[1]); o.y = cvtpk(s[2 * 33] * g0[2], s[3 * 33] * g0[3]); o.z = cvtpk(s[4 * 33] * g1[0], s[5 * 33] * g1[1]); o.w = cvtpk(s[6 * 33] * g1[2], s[7 * 33] * g1[3]);
        *(GAS u32x4*)(WT + (size_t)(n0 + n) * K + k0 + 8 * c) = o; }
    LDS_WAIT(); asm volatile("" ::: "memory");
}
__device__ __forceinline__ void convert_weights(const Args& a, const Ctx& c, int l) {
    LAS float* scr = (LAS float*)(c.lds + c.wave * 16384);
    const int gw = c.vcu * NWAVES + c.wave, NGW = c.G * NWAVES;
    constexpr int I_IN = (D / 64) * (NPROJ / 32), I_OUT = (D / 64) * (D / 32), I_UP = (D / 64) * (FF / 32), I_DN = (FF / 64) * (D / 32), I_L = I_IN + I_OUT + I_UP + I_DN;
    for (int it = gw; it < I_L; it += NGW) {
        int r = it;
        if (r < I_IN) { transpose_item(a.w_in + (size_t)l * D * IN_DIM, D, IN_DIM, NPROJ / 32, (bf16*)(a.ws + WS_WIN), scr, r, c.lane, a.norm_mix_g + (size_t)l * D); continue; } r -= I_IN;
        if (r < I_OUT) { transpose_item(a.w_out + (size_t)l * D * D, D, D, D / 32, (bf16*)(a.ws + WS_WOUT), scr, r, c.lane); continue; } r -= I_OUT;
        if (r < I_UP) { transpose_item(a.w_up + (size_t)l * D * FF, D, FF, FF / 32, (bf16*)(a.ws + WS_WUP), scr, r, c.lane, a.norm_mlp_g + (size_t)l * D); continue; } r -= I_UP;
        transpose_item(a.w_down + (size_t)l * FF * D, FF, D, D / 32, (bf16*)(a.ws + WS_WDN), scr, r, c.lane);
    }
}

__device__ __forceinline__ void build_kv_image(const Args& a, int w, int nw, int tid, int l) {
    bf16* SK = (bf16*)(a.ws + WS_SK + (size_t)(l & 1) * SKV_IMG); bf16* SV = (bf16*)(a.ws + WS_SV + (size_t)(l & 1) * SKV_IMG);
    const unsigned gt = (unsigned)w * NTHREADS + tid, NT = (unsigned)nw * NTHREADS;
    constexpr unsigned NCH = (unsigned)SBATCH * 512 * 1024 / 8;
    for (unsigned i = gt; i < 2 * NCH; i += NT) {
        const bool isv = i >= NCH; const unsigned j = isv ? i - NCH : i; const unsigned e = j * 8; const unsigned b = e / (512 * 1024); const unsigned rem = e % (512 * 1024);
        const float* src = (isv ? a.cache_v : a.cache_k) + ((size_t)(l * SBATCH + b) * 512 * 1024) + rem;
        const f32x4 x0 = *(const f32x4*)src, x1 = *(const f32x4*)(src + 4);
        u32x4 w4; w4.x = cvtpk(x0.x, x0.y); w4.y = cvtpk(x0.z, x0.w); w4.z = cvtpk(x1.x, x1.y); w4.w = cvtpk(x1.z, x1.w);
        *(u32x4*)((isv ? SV : SK) + (size_t)b * SKV_ROWS * 1024 + rem) = w4;
    }
    constexpr unsigned NZ = (unsigned)SBATCH * (SKV_ROWS - 544) * 1024 / 8;
    for (unsigned i = gt; i < 2 * NZ; i += NT) {
        const bool isv = i >= NZ; const unsigned j = isv ? i - NZ : i; const unsigned e = j * 8; const unsigned b = e / ((SKV_ROWS - 544) * 1024); const unsigned rem = e % ((SKV_ROWS - 544) * 1024);
        { const unsigned z = __float_as_uint(opaque_zero()); *(u32x4*)((isv ? SV : SK) + ((size_t)b * SKV_ROWS + 544) * 1024 + rem) = (u32x4){z, z, z, z}; }
    }
}
__device__ __forceinline__ float log_sigmoid(float x) { return fminf(x, 0.f) - fast_log(1.0f + fast_exp(-fabsf(x))); }
template <bool FIRST  >
__device__ __forceinline__ void phase_norm(const Args& a, const Ctx& c_in0, int l) {
    const Ctx c = relaunder(c_in0);
    bf16* XB = (bf16*)(a.ws + WS_XB); bf16* H = (bf16*)(a.ws + WS_H);
    const float* g = (FIRST ? a.norm_mix_g : a.norm_mlp_g) + (size_t)l * D;
    LAS float* Wg = (LAS float*)c.lds;
    if (FIRST) {
        convert_weights(a, c, l);
        __syncthreads();
        const float* wsrc = a.w_in + (size_t)l * D * IN_DIM + NPROJ;
        for (int idx = c.tid; idx < 8 * D; idx += NTHREADS) { const int k = idx >> 3, o = idx & 7; Wg[o * D + k] = wsrc[(size_t)k * IN_DIM + o]; }
        __syncthreads();
    }
    const int gw = c.vcu * NWAVES + c.wave, NGW = c.G * NWAVES;
    f32x4 gv[8];
#pragma unroll
    for (int j = 0; j < 8; ++j) gv[j] = *(const f32x4*)(g + 4 * c.lane + 256 * j);
    for (int row = gw; row < MR; row += NGW) {
        f32x4 v[8]; float s = 0.f;
        if (FIRST && l == 0) {
            const float* src = row < MP ? a.x_prompt + (size_t)row * D : a.x_sample + (size_t)(row - MP) * D;
#pragma unroll
            for (int j = 0; j < 8; ++j) v[j] = *(const f32x4*)(src + 4 * c.lane + 256 * j);
#pragma unroll
            for (int j = 0; j < 8; ++j) { u32x2 w; w.x = cvtpk(v[j].x, v[j].y); w.y = cvtpk(v[j].z, v[j].w); *(u32x2*)(XB + (size_t)row * D + 4 * c.lane + 256 * j) = w; }
        } else {
            u32x2 w[8];
#pragma unroll
            for (int j = 0; j < 8; ++j) w[j] = *(const u32x2*)(XB + (size_t)row * D + 4 * c.lane + 256 * j);
#pragma unroll
            for (int j = 0; j < 8; ++j) v[j] = (f32x4){bflo(w[j].x), bfhi(w[j].x), bflo(w[j].y), bfhi(w[j].y)};
        }
#pragma unroll
        for (int j = 0; j < 8; ++j) s += (v[j].x * v[j].x + v[j].y * v[j].y) + (v[j].z * v[j].z + v[j].w * v[j].w);
        const float rstd = fast_rsqrt(wave_sum(s, c.lane) * (1.f / D) + EPS);
        if (c.lane == 0) ((float*)(a.ws + WS_RSTD))[row] = rstd;
        if (FIRST) {
#pragma unroll
            for (int j = 0; j < 8; ++j) v[j] = v[j] * rstd * gv[j];
            float ga[8];
#pragma unroll
            for (int o = 0; o < 8; ++o) { float t = 0.f;
#pragma unroll
                for (int j = 0; j < 8; ++j) { const f32x4 w4 = *(const LAS f32x4*)(Wg + o * D + 4 * c.lane + 256 * j); t += (v[j].x * w4.x + v[j].y * w4.y) + (v[j].z * w4.z + v[j].w * w4.w); }
                ga[o] = wave_sum(t, c.lane); }
            float val = ga[0];
#pragma unroll
            for (int o = 1; o < 8; ++o) val = (c.lane == o) ? ga[o] : val;
            if (c.lane < 8) {
                float r;
                if (c.lane < 4) r = val + a.b_igate[l * MH + c.lane];
                else r = log_sigmoid(val + a.b_fgate[l * MH + c.lane - 4]);
                ((float*)(a.ws + WS_GATE))[(size_t)row * 8 + c.lane] = r;
            }
        }
    }
    if (FIRST && l == 0) build_kv_image(a, c.vcu, c.G, c.tid, 0);
}

__device__ __forceinline__ float scan256_sum(float v, int tid, int lane, int wave, LAS float* tot  ) {
#pragma unroll
    for (int o = 1; o < 64; o <<= 1) { const float t = shup(v, o, lane); if (lane >= o) v += t; }
    if (lane == 63) tot[wave] = v;
    __syncthreads();
    float off = 0.f;
#pragma unroll
    for (int w = 0; w < 3; ++w) off += (w < wave) ? tot[w] : 0.f;
    __syncthreads();
    return v + off;
}
__device__ __forceinline__ float scan256_max(float v, int tid, int lane, int wave, LAS float* tot) {
#pragma unroll
    for (int o = 1; o < 64; o <<= 1) { const float t = shup(v, o, lane); if (lane >= o) v = fmaxf(v, t); }
    if (lane == 63) tot[wave] = v;
    __syncthreads();
    float off = -3.0e38f;
#pragma unroll
    for (int w = 0; w < 3; ++w) off = (w < wave) ? fmaxf(off, tot[w]) : off;
    __syncthreads();
    return fmaxf(v, off);
}

__device__ __forceinline__ void m1_unit(const Args& a, const Ctx& c_in, int l, int unit) {
    const int g = unit & 31, bh = unit >> 5, b = bh >> 2, h = bh & 3;
    const bf16* PROJ = (const bf16*)(a.ws + WS_BIG);
    const float* GATE = (const float*)(a.ws + WS_GATE);
    Ctx c = c_in; { int t_ = c.tid; asm volatile("" : "+v"(t_)); c.tid = t_; c.lane = t_ & 63; }
    LAS float* scr = (LAS float*)(c.lds + SCR_OFF);
    LAS float* W_S = scr;
    LAS float* NACC = scr + 256;
    LAS float* TOT = scr + 384;
    LAS float* SCAL = scr + 392;
    const int row0 = b * SEQ + g * 256;
    __syncthreads();
    float li = 0.f, lf = 0.f;
    if (c.tid < 256) { li = GATE[(size_t)(row0 + c.tid) * 8 + h]; lf = GATE[(size_t)(row0 + c.tid) * 8 + 4 + h]; }
    const float bc = scan256_sum(lf, c.tid, c.lane, c.wave, TOT);
    const float as = li - bc;
    const float am = scan256_max(c.tid < 256 ? as : -3.0e38f, c.tid, c.lane, c.wave, TOT);
    if (c.tid == 255) { SCAL[0] = am; SCAL[1] = bc; }
    __syncthreads();
    const float amax = SCAL[0], blast = SCAL[1];
    if (c.tid < 256) W_S[c.tid] = fast_exp(as - amax);
    __syncthreads();
    const int sr = c.tid >> 4, sc = (c.tid & 15) * 8;
#pragma unroll
    for (int t = 0; t < 4; ++t)
#pragma unroll
        for (int hh = 0; hh < 2; ++hh) {
            const int rr = t * 64 + hh * 32 + sr; const size_t ro = (size_t)(row0 + rr) * NPROJ;
            const u32x4 kq = *(const u32x4*)(PROJ + ro + C_MK + h * HD + sc);
            const u32x4 vq = *(const u32x4*)(PROJ + ro + C_MV + h * HD + sc);
            const float w = W_S[rr] * 0.08838834764831845f;
            float kf[8] = {bflo(kq.x) * w, bfhi(kq.x) * w, bflo(kq.y) * w, bfhi(kq.y) * w, bflo(kq.z) * w, bfhi(kq.z) * w, bflo(kq.w) * w, bfhi(kq.w) * w};
            u32x4 kw; kw.x = cvtpk(kf[0], kf[1]); kw.y = cvtpk(kf[2], kf[3]); kw.z = cvtpk(kf[4], kf[5]); kw.w = cvtpk(kf[6], kf[7]);
            *(LAS u32x4*)(c.lds + t * 16384 + v_st(hh * 32 + sr, sc)) = kw;
            *(LAS u32x4*)(c.lds + 65536 + t * 16384 + v_st(hh * 32 + sr, sc)) = vq;
        }
    __syncthreads();
    if (c.tid < 128) {
        float s = 0.f;
        for (int k = 0; k < 256; ++k) s += bf2f(*(const LAS bf16*)(c.lds + (k >> 6) * 16384 + v_st(k & 63, c.tid)));
        NACC[c.tid] = s;
    }
    __syncthreads();
    const int Da = c.wave >> 1, Db0 = 2 * (c.wave & 1);
    f32x16 acc0 = f32x16{}, acc1 = f32x16{};
    const int vbk = (int)(uintptr_t)(c.lds) + v_rd_base(c.lane) + Da * 512;
    const int vbv = (int)(uintptr_t)(c.lds) + 65536 + v_rd_base(c.lane) + Db0 * 512;
#pragma unroll
    for (int t = 0; t < 4; ++t) {
        const int ak = vbk + t * 16384, av = vbv + t * 16384;
        const bf16x8 a0 = tr_frag<0, 0>(ak), a1 = tr_frag<0, 1>(ak), a2 = tr_frag<0, 2>(ak), a3 = tr_frag<0, 3>(ak);
        const bf16x8 b00 = tr_frag<0, 0>(av), b01 = tr_frag<0, 1>(av), b02 = tr_frag<0, 2>(av), b03 = tr_frag<0, 3>(av);
        const bf16x8 b10 = tr_frag<1, 0>(av), b11 = tr_frag<1, 1>(av), b12 = tr_frag<1, 2>(av), b13 = tr_frag<1, 3>(av);
        asm volatile("s_waitcnt lgkmcnt(0)" ::: "memory"); SBAR();
        acc0 = __builtin_amdgcn_mfma_f32_32x32x16_bf16(a0, b00, acc0, 0, 0, 0); acc1 = __builtin_amdgcn_mfma_f32_32x32x16_bf16(a0, b10, acc1, 0, 0, 0);
        acc0 = __builtin_amdgcn_mfma_f32_32x32x16_bf16(a1, b01, acc0, 0, 0, 0); acc1 = __builtin_amdgcn_mfma_f32_32x32x16_bf16(a1, b11, acc1, 0, 0, 0);
        acc0 = __builtin_amdgcn_mfma_f32_32x32x16_bf16(a2, b02, acc0, 0, 0, 0); acc1 = __builtin_amdgcn_mfma_f32_32x32x16_bf16(a2, b12, acc1, 0, 0, 0);
        acc0 = __builtin_amdgcn_mfma_f32_32x32x16_bf16(a3, b03, acc0, 0, 0, 0); acc1 = __builtin_amdgcn_mfma_f32_32x32x16_bf16(a3, b13, acc1, 0, 0, 0);
    }
    float* CL = (float*)(a.ws + WS_CLOC) + (size_t)unit * HD * HD;
    const int r32 = c.lane & 31, hi = c.lane >> 5;
#pragma unroll
    for (int r = 0; r < 16; ++r) { const int d = 32 * Da + crow(r, hi);
        CL[(size_t)d * HD + 32 * Db0 + r32] = acc0[r]; CL[(size_t)d * HD + 32 * (Db0 + 1) + r32] = acc1[r]; }
    if (c.tid < 128) ((float*)(a.ws + WS_NLOC))[(size_t)unit * HD + c.tid] = NACC[c.tid];
    if (c.tid == 0) { float* ms = (float*)(a.ws + WS_MSC) + (size_t)unit * 4; ms[0] = blast + amax; ms[1] = blast; }
}

__device__ __forceinline__ void sample_mixers(const Args& a, const Ctx& c, int l);
template <bool WITH_QK>
__device__ __forceinline__ void phase_c(const Args& a, const Ctx& c_in0, int l) {
    const Ctx c = relaunder(c_in0);
    bf16* PROJ = (bf16*)(a.ws + WS_BIG); bf16* MIX = (bf16*)(a.ws + WS_H);
    constexpr int WSMP = SBATCH * NH + SBATCH * MH;
    const bool split = c.G > 2 * WSMP;
    if (WITH_QK && (!split || c.vcu < WSMP)) sample_mixers(a, c, l);
    for (int u = c.vcu; u < 16 * NGRP; u += c.G) m1_unit(a, c, l, u);
    const int gw = c.vcu * NWAVES + c.wave, NGW = c.G * NWAVES;
    if (WITH_QK) {
        const float* gq = a.q_norm_g + l * HD; const float* gk = a.k_norm_g + l * HD;
        const int gi = (16 * c.lane) & 127;
        f32x4 gqv[4], gkv[4];
#pragma unroll
        for (int j = 0; j < 4; ++j) { gqv[j] = *(const f32x4*)(gq + gi + 4 * j); gkv[j] = *(const f32x4*)(gk + gi + 4 * j); }
        bf16* SK = (bf16*)(a.ws + WS_SK + (size_t)(l & 1) * SKV_IMG); bf16* SV = (bf16*)(a.ws + WS_SV + (size_t)(l & 1) * SKV_IMG);
        constexpr int NIT = NB * KEEP;
        for (int it = gw; it < NIT; it += NGW) {
            const int row = (it / KEEP) * SEQ + (SEQ - KEEP) + (it % KEEP);
            const bf16* p = PROJ + (size_t)row * NPROJ + C_K + 16 * c.lane;
            const u32x4 w0 = *(const u32x4*)p, w1 = *(const u32x4*)(p + 8);
            const bf16* pv = PROJ + (size_t)row * NPROJ + C_V + 16 * c.lane;
            const u32x4 v0 = *(const u32x4*)pv, v1 = *(const u32x4*)(pv + 8);
            const int b = row / SEQ, t = row % SEQ; const size_t o = ((size_t)(l * NB + b) * KEEP + (t - (SEQ - KEEP))) * 1024 + 16 * c.lane;
            float* ok = a.out + O_PK + o; float* ov = a.out + O_PV + o;
            *(f32x4*)(ok + 0) = (f32x4){bflo(w0.x), bfhi(w0.x), bflo(w0.y), bfhi(w0.y)}; *(f32x4*)(ok + 4) = (f32x4){bflo(w0.z), bfhi(w0.z), bflo(w0.w), bfhi(w0.w)};
            *(f32x4*)(ok + 8) = (f32x4){bflo(w1.x), bfhi(w1.x), bflo(w1.y), bfhi(w1.y)}; *(f32x4*)(ok + 12) = (f32x4){bflo(w1.z), bfhi(w1.z), bflo(w1.w), bfhi(w1.w)};
            *(f32x4*)(ov + 0) = (f32x4){bflo(v0.x), bfhi(v0.x), bflo(v0.y), bfhi(v0.y)}; *(f32x4*)(ov + 4) = (f32x4){bflo(v0.z), bfhi(v0.z), bflo(v0.w), bfhi(v0.w)};
            *(f32x4*)(ov + 8) = (f32x4){bflo(v1.x), bfhi(v1.x), bflo(v1.y), bfhi(v1.y)}; *(f32x4*)(ov + 12) = (f32x4){bflo(v1.z), bfhi(v1.z), bflo(v1.w), bfhi(v1.w)};
        }
    }
    {
        const int ch = 8 * c.lane;
        float w0[8], w1[8], w2[8];
#pragma unroll
        for (int i = 0; i < 8; ++i) { w0[i] = a.conv_w[(size_t)(l * 3 + 0) * 512 + ch + i]; w1[i] = a.conv_w[(size_t)(l * 3 + 1) * 512 + ch + i]; w2[i] = a.conv_w[(size_t)(l * 3 + 2) * 512 + ch + i]; }
        constexpr int NSEG = SEQ / 32, NITEM = NB * NSEG + SBATCH;
        const int gwc = split ? (c.vcu - WSMP) * NWAVES + c.wave : gw, NGWc = split ? (c.G - WSMP) * NWAVES : NGW;
        for (int it = gwc; it >= 0 && it < NITEM; it += NGWc) {
            float u2[8], u1[8]; int rowb; bool samp = it >= NB * NSEG; int b, seg = 0;
            if (!samp) { b = it / NSEG; seg = it % NSEG; rowb = b * SEQ + seg * 32; } else { b = it - NB * NSEG; rowb = MP + b * SSEQ; }
#pragma unroll
            for (int i = 0; i < 8; ++i) { u2[i] = 0.f; u1[i] = 0.f; }
            if (samp) {
#pragma unroll
                for (int i = 0; i < 8; ++i) { u2[i] = a.state_conv[((size_t)(l * SBATCH + b) * 2 + 0) * 512 + ch + i]; u1[i] = a.state_conv[((size_t)(l * SBATCH + b) * 2 + 1) * 512 + ch + i]; }
            } else if (seg > 0) {
#pragma unroll
                for (int q = 0; q < 2; ++q) { const bf16* pr = PROJ + (size_t)(rowb - 2 + q) * NPROJ + ch;
                    const u32x4 xa = *(const u32x4*)(pr + C_XA), gc = *(const u32x4*)(pr + C_GC);
                    float* dst = q ? u1 : u2;
                    dst[0] = bflo(xa.x) * bflo(gc.x); dst[1] = bfhi(xa.x) * bfhi(gc.x); dst[2] = bflo(xa.y) * bflo(gc.y); dst[3] = bfhi(xa.y) * bfhi(gc.y);
                    dst[4] = bflo(xa.z) * bflo(gc.z); dst[5] = bfhi(xa.z) * bfhi(gc.z); dst[6] = bflo(xa.w) * bflo(gc.w); dst[7] = bfhi(xa.w) * bfhi(gc.w); }
            }
            for (int t0 = 0; t0 < 32; t0 += 4) {
                u32x4 xa4[4], gb4[4], gc4[4];
#pragma unroll
                for (int q = 0; q < 4; ++q) { const bf16* pr = PROJ + (size_t)(rowb + t0 + q) * NPROJ + ch; xa4[q] = *(const u32x4*)(pr + C_XA); gb4[q] = *(const u32x4*)(pr + C_GB); gc4[q] = *(const u32x4*)(pr + C_GC); }
#pragma unroll
                for (int q = 0; q < 4; ++q) { const int t = t0 + q;
                const u32x4 xa = xa4[q], gb = gb4[q], gc = gc4[q];
                float u0[8] = {bflo(xa.x) * bflo(gc.x), bfhi(xa.x) * bfhi(gc.x), bflo(xa.y) * bflo(gc.y), bfhi(xa.y) * bfhi(gc.y),
                               bflo(xa.z) * bflo(gc.z), bfhi(xa.z) * bfhi(gc.z), bflo(xa.w) * bflo(gc.w), bfhi(xa.w) * bfhi(gc.w)};
                float gbf[8] = {bflo(gb.x), bfhi(gb.x), bflo(gb.y), bfhi(gb.y), bflo(gb.z), bfhi(gb.z), bflo(gb.w), bfhi(gb.w)};
                float y[8];
#pragma unroll
                for (int i = 0; i < 8; ++i) { y[i] = gbf[i] * (w0[i] * u2[i] + w1[i] * u1[i] + w2[i] * u0[i]); u2[i] = u1[i]; u1[i] = u0[i]; }
                u32x4 o; o.x = cvtpk(y[0], y[1]); o.y = cvtpk(y[2], y[3]); o.z = cvtpk(y[4], y[5]); o.w = cvtpk(y[6], y[7]);
                *(u32x4*)(MIX + (size_t)(rowb + t) * D + ch) = o;
                }
            }
            float* oc = nullptr;
            if (samp) oc = a.out + O_SCONV + (size_t)(l * SBATCH + b) * 2 * 512 + ch;
            else if (seg == NSEG - 1) oc = a.out + O_PCONV + (size_t)(l * NB + b) * 2 * 512 + ch;
            if (oc) {
                *(f32x4*)(oc) = (f32x4){u2[0], u2[1], u2[2], u2[3]}; *(f32x4*)(oc + 4) = (f32x4){u2[4], u2[5], u2[6], u2[7]};
                *(f32x4*)(oc + 512) = (f32x4){u1[0], u1[1], u1[2], u1[3]}; *(f32x4*)(oc + 516) = (f32x4){u1[4], u1[5], u1[6], u1[7]};
            }
        }
    }
}

__device__ __forceinline__ void phase_d(const Args& a, const Ctx& c_in0, int l) {
    const Ctx c = relaunder(c_in0);
    const float* CL = (const float*)(a.ws + WS_CLOC); const float* NL = (const float*)(a.ws + WS_NLOC); float* MSC = (float*)(a.ws + WS_MSC);
    bf16* C0 = (bf16*)(a.ws + WS_C0); float* N0 = (float*)(a.ws + WS_N0);
    LAS float* DEC = (LAS float*)(c.lds + SCR_OFF);
    LAS float* WLO = DEC + 512;
    LAS float* MFIN = WLO + 512;
    LAS float* MLO = MFIN + 16;
    LAS float* BLA = MLO + 512;
    __syncthreads();
    { const int u = c.tid; MLO[u] = MSC[(size_t)u * 4 + 0]; BLA[u] = MSC[(size_t)u * 4 + 1]; }
    __syncthreads();
    if (c.tid < 16) { const int bh = c.tid; float m = 0.f;
        for (int g = 0; g < NGRP; ++g) { const size_t u = (size_t)bh * NGRP + g; const float mloc = MLO[u], blast = BLA[u];
            const float mn = fmaxf(blast + m, mloc); DEC[bh * NGRP + g] = fast_exp(blast + m - mn); WLO[bh * NGRP + g] = fast_exp(mloc - mn);
            if (c.vcu == 0) MSC[u * 4 + 2] = m;
            m = mn; }
        MFIN[bh] = m; }
    __syncthreads();
    const unsigned gt = (unsigned)c.vcu * NTHREADS + c.tid, NT = (unsigned)c.G * NTHREADS;
    constexpr unsigned PER = (unsigned)HD * HD + HD;
    for (unsigned i = gt; i < 16u * PER; i += NT) {
        const int bh = (int)(i / PER); const int e = (int)(i % PER); const bool isn = e >= HD * HD; const int en = e - HD * HD;
        const float* src = isn ? NL + (size_t)bh * NGRP * HD + en : CL + (size_t)bh * NGRP * HD * HD + e;
        const size_t sstep = isn ? HD : (size_t)HD * HD;
        float x[NGRP];
#pragma unroll
        for (int g = 0; g < NGRP; ++g) x[g] = src[(size_t)g * sstep];
        float C = 0.f;
#pragma unroll
        for (int g = 0; g < NGRP; ++g) {
            const size_t u = (size_t)bh * NGRP + g;
            if (isn) N0[u * HD + en] = C; else C0[u * HD * HD + e] = (bf16)(cvtpk(C, 0.f) & 0xffffu);
            C = DEC[bh * NGRP + g] * C + WLO[bh * NGRP + g] * x[g];
        }
        const int b = bh >> 2, h = bh & 3;
        if (isn) a.out[O_PN + ((size_t)(l * NB + b) * MH + h) * HD + en] = C;
        else a.out[O_PC + ((size_t)(l * NB + b) * MH + h) * HD * HD + e] = C;
        if (e == 0) a.out[O_PM + (size_t)(l * NB + b) * MH + h] = MFIN[bh];
    }
}

constexpr float ATT_C = 0.088388347648318440f * LOG2E;
constexpr float THR2 = 8.f * LOG2E;
struct DmaMap { unsigned k0, k1, v0, v1; };
__device__ __forceinline__ DmaMap dma_map(int lane, int wave, int LD) {
    DmaMap m; unsigned kk_[2], vv_[2];
#pragma unroll
    for (int i = 0; i < 2; ++i) { const int o = (wave + 8 * i) * 1024 + lane * 16;
        const int row = o >> 8, c16 = ((o >> 4) & 15) ^ (row & 7); kk_[i] = (unsigned)(row * LD + c16 * 8) * 2u;
        const int sub = o >> 9, kk = ((sub >> 2) << 3) | ((o >> 6) & 7), k = (kk & ~0xC) | ((kk & 4) << 1) | ((kk & 8) >> 1), cc = ((sub & 3) << 5) | ((o & 63) >> 1); vv_[i] = (unsigned)(k * LD + cc) * 2u; }
    m.k0 = kk_[0]; m.k1 = kk_[1]; m.v0 = vv_[0]; m.v1 = vv_[1]; return m;
}
__device__ __forceinline__ void glds16s(const void* sbase, unsigned voff, unsigned lds_dst) { unsigned keep;
    asm volatile("s_mov_b32 %0, m0\n\ts_mov_b32 m0, %3\n\ts_nop 0\n\tglobal_load_lds_dwordx4 %1, %2\n\ts_mov_b32 m0, %0" : "=&s"(keep) : "v"(voff), "s"(sbase), "s"(lds_dst) : "memory"); }
__device__ __forceinline__ void dma_fill(LAS unsigned char* lds, int slot, int wave, const bf16* Ta, unsigned a0, unsigned a1, const bf16* Tb, unsigned b0, unsigned b1) {
    const unsigned d = (unsigned)(uintptr_t)lds + (unsigned)(slot * 32768 + wave * 1024);
    glds16s(Ta, a0, d); glds16s(Ta, a1, d + 8192u); glds16s(Tb, b0, d + 16384u); glds16s(Tb, b1, d + 24576u);
}
#define RING_WAIT_BAR(N) do { asm volatile("s_waitcnt vmcnt(" #N ") lgkmcnt(0)" ::: "memory"); __builtin_amdgcn_s_barrier(); asm volatile("" ::: "memory"); } while (0)

__device__ __forceinline__ float fma_s(float a, float b, float c) { float d; asm("v_fma_f32 %0, %1, %2, %3" : "=v"(d) : "v"(a), "v"(b), "v"(c)); return d; }
__device__ __forceinline__ float add_s(float a, float b) { float d; asm("v_add_f32 %0, %1, %2" : "=v"(d) : "v"(a), "v"(b)); return d; }
#define ATT_SCORE_SOFTMAX(j, slotk)                                                                                                           \
    {   const int K_lds = ldsb + (slotk) * 16384;                                                                                              \
        f32x16 p0, p1; qkt(p0, p1, K_lds, qr, r32, hi);                                                                                       \
        STEP_FILL();                                                             \
        const int Rl = R0 + r32 - 64 * (j);                                                                                                   \
        const int relmin = R0 - 64 * (j) - 63;                                                                                                \
        if (relmin >= 128) { const float bc = BR[0];                                                                                           \
            _Pragma("unroll") for (int r = 0; r < 16; ++r) { p0[r] = fma_s(p0[r], ATT_C, bc); p1[r] = fma_s(p1[r], ATT_C, bc); }                \
        } else {                                                                                                                               \
            const LAS float* bp = BR + (64 + 128 - Rl + 4 * hi);                                                                               \
            _Pragma("unroll") for (int r = 0; r < 16; ++r) { p0[r] = fma_s(p0[r], ATT_C, bp[(r & 3) + 8 * (r >> 2)]); p1[r] = fma_s(p1[r], ATT_C, bp[32 + (r & 3) + 8 * (r >> 2)]); } \
        }                                                                                                                                      \
        const int nvalid = kend - 64 * (j);                                                                                                    \
        if (nvalid < 64) { asm volatile("" ::: "memory");                           \
            _Pragma("unroll") for (int r = 0; r < 16; ++r) { const int kk = crow(r, hi); if (kk >= nvalid) p0[r] = -1e30f; if (kk + 32 >= nvalid) p1[r] = -1e30f; } \
        }                                                                                                                                      \
        float pmax = p0[0];                                                                                                                    \
        _Pragma("unroll") for (int r = 1; r < 16; ++r) pmax = fmaxf(pmax, p0[r]);                                                              \
        _Pragma("unroll") for (int r = 0; r < 16; ++r) pmax = fmaxf(pmax, p1[r]);                                                              \
        pmax = half_swap_max(pmax);                                                                                                            \
        if (!__all(pmax - m_reg <= THR2)) {                                                                                                    \
            const float mn = fmaxf(m_reg, pmax); const float alpha = __builtin_amdgcn_exp2f(m_reg - mn); m_reg = mn;                           \
            l_reg *= alpha;                                                                                                                    \
            if (hi == 0) al_l[r32] = alpha; asm volatile("s_waitcnt lgkmcnt(0)" ::: "memory");                                               \
            _Pragma("unroll") for (int r = 0; r < 16; ++r) { const float al = al_l[crow(r, hi)];                                               \
                _Pragma("unroll") for (int d = 0; d < 4; ++d) o[d][r] *= al; }                                                                 \
        }                                                                                                                                      \
        float ps = 0.f;                                                                                                                        \
        _Pragma("unroll") for (int r = 0; r < 16; ++r) { p0[r] = __builtin_amdgcn_exp2f(p0[r] - m_reg); p1[r] = __builtin_amdgcn_exp2f(p1[r] - m_reg); ps = add_s(ps, add_s(p0[r], p1[r])); } \
        l_reg += half_swap_add(ps);                                                                                                            \
        PK4(p0, 0, pa0); PK4(p0, 8, pa1); PK4(p1, 0, pa2); PK4(p1, 8, pa3);                                                                    \
    }
__device__ __forceinline__ void attn_unit(const Ctx& c, const bf16* __restrict__ Qb, int LDQ, int qrow, const bf16* __restrict__ Kh, const bf16* __restrict__ Vh, int LDK, int NT, int alo, int ahi, int kend,
                                          int R0  , const float* __restrict__ bias_g, bf16* __restrict__ Ob, int LDO, bool do_store, const float* __restrict__ qgain = nullptr, int rot = 0) {
    int tid = c.tid; asm volatile("" : "+v"(tid));
    const int wid = c.wave, lane = tid & 63, r32 = lane & 31, hi = lane >> 5;
    const int ldsb = (int)(uintptr_t)c.lds;
    constexpr int VRING = 49152;
    LAS float* wsf = (LAS float*)(c.lds + 114688) + wid * 64; LAS float* li_l = wsf; LAS float* al_l = wsf + 32;
    LAS float* BR = (LAS float*)(c.lds + SCR_OFF);
    asm volatile("s_waitcnt lgkmcnt(0)" ::: "memory"); __builtin_amdgcn_s_barrier(); asm volatile("" ::: "memory");
    const DmaMap dm = dma_map(lane, wid, LDK);
    const size_t tile_step = (size_t)64 * LDK;
    const unsigned dbase = (unsigned)ldsb + (unsigned)wid * 1024u;
#define ATT_FILL(kt_, vt_, sk_, sv_) do { const unsigned dk_ = dbase + (unsigned)(sk_) * 16384u, dv_ = dbase + VRING + (unsigned)(sv_) * 16384u; \
        glds16s(kt_, dm.k0, dk_); glds16s(kt_, dm.k1, dk_ + 8192u); glds16s(vt_, dm.v0, dv_); glds16s(vt_, dm.v1, dv_ + 8192u); } while (0)
#define TIDX(s_) ((s_) + rot - (((s_) + rot) >= NT ? NT : 0))
    { const int t0_ = TIDX(0), t1_ = TIDX(1);
      ATT_FILL(Kh + t0_ * tile_step, Vh + t0_ * tile_step, 0, 0);
      ATT_FILL(Kh + t1_ * tile_step, Vh + t1_ * tile_step, 1, 1); }
    if (tid < 321) { const int i = tid - 64; BR[tid] = bias_g[256 - (i < 0 ? 0 : i)] * LOG2E; }
    float m_reg = -1e30f, l_reg = 0.f; f32x16 o[4] = {f32x16{}, f32x16{}, f32x16{}, f32x16{}}; bf16x8 qr[8];
    { const bf16* Qw = Qb + (size_t)(qrow + r32) * LDQ + hi * 8;
#pragma unroll
      for (int d0 = 0; d0 < 8; ++d0) qr[d0] = *(const bf16x8*)(Qw + d0 * 16); }
    if (qgain) {
        float f[8][8]; float ss = 0.f;
#pragma unroll
        for (int d0 = 0; d0 < 8; ++d0) { const u32x4 w = *reinterpret_cast<const u32x4*>(&qr[d0]);
            f[d0][0] = bflo(w.x); f[d0][1] = bfhi(w.x); f[d0][2] = bflo(w.y); f[d0][3] = bfhi(w.y); f[d0][4] = bflo(w.z); f[d0][5] = bfhi(w.z); f[d0][6] = bflo(w.w); f[d0][7] = bfhi(w.w);
#pragma unroll
            for (int i = 0; i < 8; ++i) ss += f[d0][i] * f[d0][i]; }
        ss = half_swap_add(ss);
        const float rq = fast_rsqrt(ss * (1.f / HD) + EPS);
#pragma unroll
        for (int d0 = 0; d0 < 8; ++d0) { const f32x4 g0 = *(const f32x4*)(qgain + d0 * 16 + hi * 8), g1 = *(const f32x4*)(qgain + d0 * 16 + hi * 8 + 4);
            u32x4 s; s.x = cvtpk(f[d0][0] * rq * g0[0], f[d0][1] * rq * g0[1]); s.y = cvtpk(f[d0][2] * rq * g0[2], f[d0][3] * rq * g0[3]);
            s.z = cvtpk(f[d0][4] * rq * g1[0], f[d0][5] * rq * g1[1]); s.w = cvtpk(f[d0][6] * rq * g1[2], f[d0][7] * rq * g1[3]);
            qr[d0] = *reinterpret_cast<bf16x8*>(&s); }
    }
#pragma unroll
    for (int d0 = 0; d0 < 8; ++d0) { u32x4 w = *reinterpret_cast<u32x4*>(&qr[d0]); asm volatile("" : "+v"(w)); qr[d0] = *reinterpret_cast<bf16x8*>(&w); }
    asm volatile("" ::: "memory");
    const bool skew = wid >= 4;
    bf16x8 pa0 = bf16x8{}, pa1 = bf16x8{}, pa2 = bf16x8{}, pa3 = bf16x8{};
    int sk = 0, sv = 0;
    bool pact = false;
    for (int j = 0; j < NT; ++j) {
        if (j + 1 < NT) RING_WAIT_BAR(4); else RING_WAIT_BAR(0);
#define STEP_FILL() do { if (j + 2 < NT) { const int fk = sk >= 1 ? sk - 1 : 2, fv = sv >= 2 ? sv - 2 : sv + 2; const int tf = TIDX(j + 2); ATT_FILL(Kh + tf * tile_step, Vh + tf * tile_step, fk, fv); } } while (0)
        const int jt = TIDX(j);
        const bool act = (jt >= alo && jt <= ahi);
        if (skew && pact) { const int svp = sv >= 1 ? sv - 1 : 3; pv_d0(o, ldsb + VRING + svp * 16384 + v_rd_base(lane), pa0, pa1, pa2, pa3); }
        pact = act;
        if (act) { ATT_SCORE_SOFTMAX(jt, sk); } else STEP_FILL();
        if (!skew && act) pv_d0(o, ldsb + VRING + sv * 16384 + v_rd_base(lane), pa0, pa1, pa2, pa3);
        sk = sk == 2 ? 0 : sk + 1; sv = (sv + 1) & 3;
    }
    if (skew && pact) { const int svp = sv >= 1 ? sv - 1 : 3; pv_d0(o, ldsb + VRING + svp * 16384 + v_rd_base(lane), pa0, pa1, pa2, pa3); }
#undef STEP_FILL
#undef TIDX
#undef ATT_FILL
    if (hi == 0) li_l[r32] = l_reg;
    RING_WAIT_BAR(0);
    const int ost = ldsb + wid * 8192;
#pragma unroll
    for (int r = 0; r < 16; ++r) { const int orow = crow(r, hi); const float rl = __builtin_amdgcn_rcpf(li_l[orow]);
#pragma unroll
        for (int d0 = 0; d0 < 4; ++d0) *(LAS bf16*)(uintptr_t)(unsigned)(ost + orow * 256 + (d0 * 32 + r32) * 2) = (bf16)(cvtpk(o[d0][r] * rl, 0.f) & 0xffffu); }
    asm volatile("s_waitcnt lgkmcnt(0)" ::: "memory");
    if (do_store) {
#pragma unroll
        for (int i = 0; i < 8; ++i) { const int ch = i * 64 + lane, row = ch >> 4, c16 = ch & 15;
            const u32x4 w = *(const LAS u32x4*)(uintptr_t)(unsigned)(ost + row * 256 + c16 * 16);
            *(u32x4*)(Ob + (size_t)(qrow + row) * LDO + c16 * 8) = w; }
    }
}
__device__ __forceinline__ void attn_stream(const Args& a, const Ctx& c, int l) {
    constexpr int NATT = NB * NH * 32;
    if (c.vcu >= NATT) return;
    int tid = c.tid; asm volatile("" : "+v"(tid));
    const int wid = c.wave, lane = tid & 63, r32 = lane & 31, hi = lane >> 5;
    const int ldsb = (int)(uintptr_t)c.lds;
    constexpr int VRING = 49152;
    LAS float* wsf = (LAS float*)(c.lds + 114688) + wid * 64; LAS float* li_l = wsf; LAS float* al_l = wsf + 32;
    LAS float* BR = (LAS float*)(c.lds + SCR_OFF);
    const bf16* PROJ = (const bf16*)(a.ws + WS_BIG); bf16* MIX = (bf16*)(a.ws + WS_H);
    const int gq = c.vcu & 31, h = (c.vcu >> 5) & 7, b0 = c.vcu >> 8, db = c.G >> 8, nun = (NB - b0 + db - 1) / db;
    const int c0 = 4 * gq, jstart = c0 >= 8 ? 0 : 8 - c0, NT = 12 - jstart, ci = wid >> 1;
    const int alo = ci - jstart < 0 ? 0 : ci - jstart, ahi = ci + 8 - jstart, kend = NT * 64;
    const int R0 = (ci + 8 - jstart) * 64 + (wid & 1) * 32, rot = gq >= 2 ? (8 * gq + 8) % 12 : 0, qrow = wid * 32;
    const float* bias_g = a.rel_bias + (size_t)(l * NH + h) * 257;
    constexpr int LDK = NPROJ, LDO = D;
    asm volatile("s_waitcnt lgkmcnt(0)" ::: "memory"); __builtin_amdgcn_s_barrier(); asm volatile("" ::: "memory");
    const DmaMap dm = dma_map(lane, wid, LDK);
    const size_t tile_step = (size_t)64 * LDK;
    const unsigned dbase = (unsigned)ldsb + (unsigned)wid * 1024u;
#define ATT_FILL(kt_, vt_, sk_, sv_) do { const unsigned dk_ = dbase + (unsigned)(sk_) * 16384u, dv_ = dbase + VRING + (unsigned)(sv_) * 16384u; \
        glds16s(kt_, dm.k0, dk_); glds16s(kt_, dm.k1, dk_ + 8192u); glds16s(vt_, dm.v0, dv_); glds16s(vt_, dm.v1, dv_ + 8192u); } while (0)
#define TIDX(s_) ((s_) + rot - (((s_) + rot) >= NT ? NT : 0))
    const bf16* Qb = PROJ + (size_t)(b0 * SEQ + c0 * 64) * NPROJ + C_Q + h * HD;
    const bf16* Kh = PROJ + (size_t)(b0 * SEQ + (c0 - 8 + jstart) * 64) * NPROJ + C_K + h * HD;
    const bf16* Vh = PROJ + (size_t)(b0 * SEQ + (c0 - 8 + jstart) * 64) * NPROJ + C_V + h * HD;
    bf16* Ob = MIX + (size_t)(b0 * SEQ + c0 * 64) * D + 512 + h * HD;
    const size_t dproj = (size_t)db * SEQ * NPROJ, dmix = (size_t)db * SEQ * D;
    { const int t0_ = TIDX(0), t1_ = TIDX(1);
      ATT_FILL(Kh + t0_ * tile_step, Vh + t0_ * tile_step, 0, 0);
      ATT_FILL(Kh + t1_ * tile_step, Vh + t1_ * tile_step, 1, 1); }
    if (tid < 321) { const int i = tid - 64; BR[tid] = bias_g[256 - (i < 0 ? 0 : i)] * LOG2E; }
    bf16x8 qr[8];
    { const bf16* Qw = Qb + (size_t)(qrow + r32) * NPROJ + hi * 8;
#pragma unroll
      for (int d0 = 0; d0 < 8; ++d0) qr[d0] = *(const bf16x8*)(Qw + d0 * 16); }
    const bool skew = wid >= 4;
    int sk = 0, sv = 0;
#pragma unroll 1
    for (int ui = 0; ui < nun; ++ui) {
        const bool has_next = ui + 1 < nun;
        const bf16* Khn = Kh + dproj; const bf16* Vhn = Vh + dproj;
#pragma unroll
        for (int d0 = 0; d0 < 8; ++d0) { u32x4 w = *reinterpret_cast<u32x4*>(&qr[d0]); asm volatile("" : "+v"(w)); qr[d0] = *reinterpret_cast<bf16x8*>(&w); }
        asm volatile("" ::: "memory");
        float m_reg = -1e30f, l_reg = 0.f; f32x16 o[4] = {f32x16{}, f32x16{}, f32x16{}, f32x16{}};
        bf16x8 pa0 = bf16x8{}, pa1 = bf16x8{}, pa2 = bf16x8{}, pa3 = bf16x8{};
        bool pact = false;
        for (int j = 0; j < NT; ++j) {
            if (j + 1 < NT || has_next) RING_WAIT_BAR(4); else RING_WAIT_BAR(0);
#define STEP_FILL() do { const int fk = sk >= 1 ? sk - 1 : 2, fv = sv >= 2 ? sv - 2 : sv + 2;                                                                  \
                if (j + 2 < NT) { const int tf = TIDX(j + 2); ATT_FILL(Kh + tf * tile_step, Vh + tf * tile_step, fk, fv); }                                         \
                else if (has_next) { const int tf = TIDX(j + 2 - NT); ATT_FILL(Khn + tf * tile_step, Vhn + tf * tile_step, fk, fv); } } while (0)
            const int jt = TIDX(j);
            const bool act = (jt >= alo && jt <= ahi);
            if (skew && pact) { const int svp = sv >= 1 ? sv - 1 : 3; pv_d0(o, ldsb + VRING + svp * 16384 + v_rd_base(lane), pa0, pa1, pa2, pa3); }
            pact = act;
            if (act) { ATT_SCORE_SOFTMAX(jt, sk); } else STEP_FILL();
            if (!skew && act) pv_d0(o, ldsb + VRING + sv * 16384 + v_rd_base(lane), pa0, pa1, pa2, pa3);
            sk = sk == 2 ? 0 : sk + 1; sv = (sv + 1) & 3;
        }
        if (skew && pact) { const int svp = sv >= 1 ? sv - 1 : 3; pv_d0(o, ldsb + VRING + svp * 16384 + v_rd_base(lane), pa0, pa1, pa2, pa3); }
#undef STEP_FILL
        if (has_next) { const bf16* Qw = Qb + dproj + (size_t)(qrow + r32) * NPROJ + hi * 8;
#pragma unroll
            for (int d0 = 0; d0 < 8; ++d0) qr[d0] = *(const bf16x8*)(Qw + d0 * 16); }
        if (hi == 0) li_l[r32] = l_reg;
        asm volatile("s_waitcnt lgkmcnt(0)" ::: "memory"); __builtin_amdgcn_s_barrier(); asm volatile("" ::: "memory");
        const int ost = ldsb + VRING + (((wid < 4 ? sv + 2 : sv + 3) & 3) * 16384) + (wid & 3) * 4096;
#pragma unroll
        for (int hf = 0; hf < 2; ++hf) {
#pragma unroll
            for (int r = 0; r < 16; ++r) { const int orow = crow(r, hi); const float rl = __builtin_amdgcn_rcpf(li_l[orow]);
#pragma unroll
                for (int dd = 0; dd < 2; ++dd) *(LAS bf16*)(uintptr_t)(unsigned)(ost + orow * 128 + (dd * 32 + r32) * 2) = (bf16)(cvtpk(o[2 * hf + dd][r] * rl, 0.f) & 0xffffu); }
            asm volatile("s_waitcnt lgkmcnt(0)" ::: "memory");
#pragma unroll
            for (int i = 0; i < 4; ++i) { const int ch = i * 64 + lane, row = ch >> 3, c16 = ch & 7;
                const u32x4 w = *(const LAS u32x4*)(uintptr_t)(unsigned)(ost + row * 128 + c16 * 16);
                *(u32x4*)(Ob + (size_t)(qrow + row) * LDO + hf * 64 + c16 * 8) = w; }
            asm volatile("s_waitcnt lgkmcnt(0)" ::: "memory");
        }
        Qb += dproj; Kh += dproj; Vh += dproj; Ob += dmix;
    }
#undef TIDX
#undef ATT_FILL
}
#undef ATT_SCORE_SOFTMAX

__device__ __forceinline__ void m3_unit(const Args& a, const Ctx& c, int l, int unit) {
    const int g = unit & 31, bh = unit >> 5, b = bh >> 2, h = bh & 3;
    const bf16* PROJ = (const bf16*)(a.ws + WS_BIG); bf16* MIX = (bf16*)(a.ws + WS_H);
    const float* GATE = (const float*)(a.ws + WS_GATE);
    int tid = c.tid; asm volatile("" : "+v"(tid));
    const int wid = c.wave, lane = tid & 63, r32 = lane & 31, hi = lane >> 5;
    LAS float* scr = (LAS float*)(c.lds + SCR_OFF);
    LAS float* A_S = scr;
    LAS float* M_T = scr + 256;
    LAS float* B_T = scr + 512;
    LAS float* N0L = scr + 768;
    LAS float* TOT = scr + 896;
    const int ldsb = (int)(uintptr_t)c.lds;
    LAS float* wsf = (LAS float*)(c.lds + 98304) + wid * 64;
    const int row0 = b * SEQ + g * 256;
    const float m0 = ((const float*)(a.ws + WS_MSC))[(size_t)unit * 4 + 2];
    asm volatile("s_waitcnt vmcnt(0) lgkmcnt(0)" ::: "memory"); __builtin_amdgcn_s_barrier(); asm volatile("" ::: "memory");
    const DmaMap dm = dma_map(lane, wid, NPROJ); const DmaMap dc = dma_map(lane, wid, HD);
    const bf16* kt = PROJ + (size_t)row0 * NPROJ + C_MK + h * HD; const bf16* vt = PROJ + (size_t)row0 * NPROJ + C_MV + h * HD;
    const bf16* C0 = (const bf16*)(a.ws + WS_C0) + (size_t)unit * HD * HD;
    const size_t tile_step = (size_t)64 * NPROJ;
    dma_fill(c.lds, 0, wid, kt, dm.k0, dm.k1, vt, dm.v0, dm.v1);
    dma_fill(c.lds, 1, wid, kt + tile_step, dm.k0, dm.k1, vt + tile_step, dm.v0, dm.v1);
    bf16x8 qr[8];
    const int trow = wid * 32 + r32;
    { const bf16* Qw = PROJ + (size_t)(row0 + trow) * NPROJ + C_MQ + h * HD + hi * 8;
#pragma unroll
      for (int d0 = 0; d0 < 8; ++d0) qr[d0] = *(const bf16x8*)(Qw + d0 * 16); }
    u32x4 mo8[8];
#pragma unroll
    for (int i = 0; i < 8; ++i) { const int ch = i * 64 + lane, row = ch >> 4, col = (ch & 15) * 8; mo8[i] = *(const u32x4*)(PROJ + (size_t)(row0 + wid * 32 + row) * NPROJ + C_MO + h * HD + col); }
    float li = 0.f, lf = 0.f;
    if (tid < 256) { li = GATE[(size_t)(row0 + tid) * 8 + h]; lf = GATE[(size_t)(row0 + tid) * 8 + 4 + h]; }
    if (tid < 128) N0L[tid] = ((const float*)(a.ws + WS_N0))[(size_t)unit * HD + tid];
    const float bc = scan256_sum(lf, tid, lane, wid, TOT);
    const float as = li - bc;
    const float cm = scan256_max(tid < 256 ? as : -3.0e38f, tid, lane, wid, TOT);
    if (tid < 256) { A_S[tid] = as; M_T[tid] = fmaxf(m0, cm); B_T[tid] = bc; }
    __syncthreads();
    const float Mt = M_T[trow];
    f32x16 o[4] = {f32x16{}, f32x16{}, f32x16{}, f32x16{}};
    float rowsum = 0.f, qn = 0.f;
    const float winter = fast_exp(m0 - Mt);
    const int ci = wid >> 1;
    int slot = 0;
#pragma unroll 1
    for (int j = 0; j < 4; ++j) {
        RING_WAIT_BAR(4);
        { const int fs = slot >= 1 ? slot - 1 : 2;
          if (j + 2 < 4) dma_fill(c.lds, fs, wid, kt + (size_t)(j + 2) * tile_step, dm.k0, dm.k1, vt + (size_t)(j + 2) * tile_step, dm.v0, dm.v1);
          else if (j == 2) dma_fill(c.lds, fs, wid, C0, dc.v0, dc.v1, C0 + 64 * HD, dc.v0, dc.v1); }
        const int S_lds = ldsb + slot * 32768;
        int r32l = r32; asm volatile("" : "+v"(r32l));
        if (j <= ci) {
            f32x16 p0, p1; qkt(p0, p1, S_lds, qr, r32l, hi);
#pragma unroll
            for (int r = 0; r < 16; ++r) { const int s0 = 64 * j + crow(r, hi), s1 = s0 + 32;
                const float w0 = (s0 <= trow) ? fast_exp(A_S[s0] - Mt) * 0.08838834764831845f : 0.f, w1 = (s1 <= trow) ? fast_exp(A_S[s1] - Mt) * 0.08838834764831845f : 0.f;
                p0[r] *= w0; p1[r] *= w1; rowsum += p0[r] + p1[r]; }
            bf16x8 pa0, pa1, pa2, pa3;
            PK4(p0, 0, pa0); PK4(p0, 8, pa1); PK4(p1, 0, pa2); PK4(p1, 8, pa3);
            pv_d0(o, S_lds + 16384 + v_rd_base(lane), pa0, pa1, pa2, pa3);
        }
        slot = slot == 2 ? 0 : slot + 1;
    }
    RING_WAIT_BAR(0);
    {
        const int S_lds = ldsb + slot * 32768;
#pragma unroll
        for (int hf = 0; hf < 2; ++hf) {
            bf16x8 qs[4];
#pragma unroll
            for (int dd = 0; dd < 4; ++dd) { const int d0 = hf * 4 + dd; const u32x4 w = *reinterpret_cast<const u32x4*>(&qr[d0]);
                float f[8] = {bflo(w.x), bfhi(w.x), bflo(w.y), bfhi(w.y), bflo(w.z), bfhi(w.z), bflo(w.w), bfhi(w.w)};
#pragma unroll
                for (int i = 0; i < 8; ++i) qn += f[i] * N0L[d0 * 16 + hi * 8 + i];
                u32x4 s; s.x = cvtpk(f[0] * winter, f[1] * winter); s.y = cvtpk(f[2] * winter, f[3] * winter); s.z = cvtpk(f[4] * winter, f[5] * winter); s.w = cvtpk(f[6] * winter, f[7] * winter);
                qs[dd] = *reinterpret_cast<bf16x8*>(&s); }
            pv_d0(o, S_lds + hf * 16384 + v_rd_base(lane), qs[0], qs[1], qs[2], qs[3]);
        }
    }
    rowsum = half_swap_add(rowsum);
    qn = half_swap_add(qn);
    const float den = winter * qn + rowsum;
    const float dfl = fast_exp(-(B_T[trow] + Mt));
    const float inv = 1.0f / fmaxf(fabsf(den), dfl);
    if (hi == 0) wsf[r32] = inv;
    asm volatile("s_waitcnt lgkmcnt(0)" ::: "memory");
#pragma unroll
    for (int r = 0; r < 16; ++r) { const float sc_ = wsf[crow(r, hi)];
#pragma unroll
        for (int d0 = 0; d0 < 4; ++d0) o[d0][r] *= sc_; }
    RING_WAIT_BAR(0);
    const int hst = ldsb + wid * 16384;
    { int le = lane; asm volatile("" : "+v"(le)); const int r32e = le & 31, hie = le >> 5;
#pragma unroll
    for (int r = 0; r < 16; ++r)
#pragma unroll
        for (int d0 = 0; d0 < 4; ++d0) *(LAS float*)(uintptr_t)(unsigned)(hst + crow(r, hie) * 512 + (d0 * 32 + r32e) * 4) = o[d0][r]; }
    asm volatile("s_waitcnt lgkmcnt(0)" ::: "memory");
    const float* gn = a.mlstm_norm_g + (size_t)l * 512 + h * HD;
    int le = lane; asm volatile("" : "+v"(le));
#pragma unroll
    for (int i = 0; i < 8; ++i) { const int ch = i * 64 + le, row = ch >> 4, col = (ch & 15) * 8;
        const f32x4 a0 = *(const LAS f32x4*)(uintptr_t)(unsigned)(hst + row * 512 + col * 4), a1 = *(const LAS f32x4*)(uintptr_t)(unsigned)(hst + row * 512 + col * 4 + 16);
        float ss = (a0.x * a0.x + a0.y * a0.y) + (a0.z * a0.z + a0.w * a0.w) + (a1.x * a1.x + a1.y * a1.y) + (a1.z * a1.z + a1.w * a1.w);
        ss += shx(ss, 1, le); ss += shx(ss, 2, le); ss += shx(ss, 4, le); ss += shx(ss, 8, le);
        const float rstd = fast_rsqrt(ss * (1.f / HD) + EPS);
        const int orow = row0 + wid * 32 + row;
        const u32x4 mo = mo8[i];
        const f32x4 g0 = *(const f32x4*)(gn + col), g1 = *(const f32x4*)(gn + col + 4);
        float y[8] = {a0.x * g0.x, a0.y * g0.y, a0.z * g0.z, a0.w * g0.w, a1.x * g1.x, a1.y * g1.y, a1.z * g1.z, a1.w * g1.w};
        const float mf[8] = {bflo(mo.x), bfhi(mo.x), bflo(mo.y), bfhi(mo.y), bflo(mo.z), bfhi(mo.z), bflo(mo.w), bfhi(mo.w)};
#pragma unroll
        for (int k = 0; k < 8; ++k) y[k] = y[k] * rstd * (1.0f / (1.0f + fast_exp(-mf[k])));
        u32x4 w; w.x = cvtpk(y[0], y[1]); w.y = cvtpk(y[2], y[3]); w.z = cvtpk(y[4], y[5]); w.w = cvtpk(y[6], y[7]);
        *(u32x4*)(MIX + (size_t)orow * D + 1536 + h * HD + col) = w; }
}

__device__ __forceinline__ void ms_unit(const Args& a, const Ctx& c, int l, int unit) {
    const int b = unit >> 2, h = unit & 3; int tid = c.tid; asm volatile("" : "+v"(tid));
    const int lane = tid & 63, wid = c.wave;
    const bf16* PROJ = (const bf16*)(a.ws + WS_BIG); bf16* MIX = (bf16*)(a.ws + WS_H);
    const float* GATE = (const float*)(a.ws + WS_GATE);
    constexpr int P = 132;
    LAS float* Q = (LAS float*)c.lds;
    LAS float* Kk = Q + 32 * P;
    LAS float* V = Kk + 32 * P;
    LAS float* HB = V + 32 * P;
    LAS float* S = HB + 32 * P;
    LAS float* N0 = S + 32 * 33;
    LAS float* A_S = N0 + 128;
    LAS float* M_T = A_S + 32;
    LAS float* B_T = M_T + 32;
    LAS float* WST = B_T + 32;
    LAS float* DEN = WST + 32;
    LAS float* WIN = DEN + 32;
    LAS float* SC = WIN + 32;
    const int row0 = MP + b * SSEQ;
    const size_t sidx = (size_t)(l * SBATCH + b) * MH + h;
    const float* C0 = a.state_c + sidx * HD * HD;
    __syncthreads();
    for (int i = tid; i < 1536; i += NTHREADS) { const int which = i >> 9, r = (i >> 4) & 31, c8 = (i & 15) * 8;
        const u32x4 w = *(const u32x4*)(PROJ + (size_t)(row0 + r) * NPROJ + (which == 0 ? C_MQ : which == 1 ? C_MK : C_MV) + h * HD + c8);
        const float sc = which == 1 ? 0.08838834764831845f : 1.0f;
        LAS float* dst = (which == 0 ? Q : which == 1 ? Kk : V) + r * P + c8;
        *(LAS f32x4*)dst = (f32x4){bflo(w.x) * sc, bfhi(w.x) * sc, bflo(w.y) * sc, bfhi(w.y) * sc};
        *(LAS f32x4*)(dst + 4) = (f32x4){bflo(w.z) * sc, bfhi(w.z) * sc, bflo(w.w) * sc, bfhi(w.w) * sc}; }
    if (tid < 128) N0[tid] = a.state_n[sidx * HD + tid];
    if (wid == 0) {
        const int t = lane & 31; const float m0 = a.state_m[sidx];
        const float li = GATE[(size_t)(row0 + t) * 8 + h], lf = GATE[(size_t)(row0 + t) * 8 + 4 + h];
        float bc = lf;
#pragma unroll
        for (int o = 1; o < 32; o <<= 1) { const float x = shup(bc, o, lane); if ((lane & 31) >= o) bc += x; }
        const float as = li - bc; float cm = as;
#pragma unroll
        for (int o = 1; o < 32; o <<= 1) { const float x = shup(cm, o, lane); if ((lane & 31) >= o) cm = fmaxf(cm, x); }
        const float blast = __int_as_float(__builtin_amdgcn_ds_bpermute(31 << 2, __float_as_int(bc))), amax = __int_as_float(__builtin_amdgcn_ds_bpermute(31 << 2, __float_as_int(cm)));
        const float Mt = fmaxf(m0, cm), mnew = fmaxf(blast + m0, blast + amax);
        if (lane < 32) { A_S[t] = as; B_T[t] = bc; M_T[t] = Mt; WST[t] = fast_exp(blast + as - mnew); WIN[t] = fast_exp(m0 - Mt); }
        if (lane == 0) { SC[0] = m0; SC[1] = blast; SC[2] = mnew; SC[3] = fast_exp(blast + m0 - mnew); }
    }
    __syncthreads();
    for (int i = tid; i < 1024; i += NTHREADS) { const int t = i >> 5, s = i & 31; float d = 0.f;
        if (s <= t) {
#pragma unroll 8
            for (int k = 0; k < 128; k += 4) { const f32x4 q4 = *(const LAS f32x4*)(Q + t * P + k), k4 = *(const LAS f32x4*)(Kk + s * P + k); d += (q4.x * k4.x + q4.y * k4.y) + (q4.z * k4.z + q4.w * k4.w); }
            d *= fast_exp(A_S[s] - M_T[t]); }
        S[t * 33 + s] = d; }
    __syncthreads();
    if (tid < 32) { const int t = tid; float qn = 0.f, rs = 0.f;
        for (int k = 0; k < 128; ++k) qn += Q[t * P + k] * N0[k];
        for (int s = 0; s < 32; ++s) rs += S[t * 33 + s];
        const float den = WIN[t] * qn + rs; DEN[t] = 1.0f / fmaxf(fabsf(den), fast_exp(-(B_T[t] + M_T[t]))); }
    const int e = tid & 127, tg = tid >> 7;
    { float acc[8];
#pragma unroll
      for (int i = 0; i < 8; ++i) acc[i] = 0.f;
      for (int d0 = 0; d0 < 128; d0 += 16) { float cv[16];
#pragma unroll
          for (int j = 0; j < 16; ++j) cv[j] = C0[(size_t)(d0 + j) * HD + e];
#pragma unroll
          for (int j = 0; j < 16; j += 4)
#pragma unroll
              for (int i = 0; i < 8; ++i) { const f32x4 q4 = *(const LAS f32x4*)(Q + (tg * 8 + i) * P + d0 + j); acc[i] += (q4.x * cv[j] + q4.y * cv[j + 1]) + (q4.z * cv[j + 2] + q4.w * cv[j + 3]); } }
      __syncthreads();
#pragma unroll
      for (int i = 0; i < 8; ++i) { const int t = tg * 8 + i; float v = acc[i] * WIN[t];
          for (int s = 0; s <= t; ++s) v += S[t * 33 + s] * V[s * P + e];
          HB[t * P + e] = v * DEN[t]; } }
    __syncthreads();
    { const int t = tid >> 4, e0 = (tid & 15) * 8; float ss = 0.f;
      const f32x4 h0 = *(const LAS f32x4*)(HB + t * P + e0), h1 = *(const LAS f32x4*)(HB + t * P + e0 + 4);
      ss = (h0.x * h0.x + h0.y * h0.y) + (h0.z * h0.z + h0.w * h0.w) + (h1.x * h1.x + h1.y * h1.y) + (h1.z * h1.z + h1.w * h1.w);
      ss += shx(ss, 1, lane); ss += shx(ss, 2, lane); ss += shx(ss, 4, lane); ss += shx(ss, 8, lane);
      const float rstd = fast_rsqrt(ss * (1.f / HD) + EPS);
      const u32x4 mo = *(const u32x4*)(PROJ + (size_t)(row0 + t) * NPROJ + C_MO + h * HD + e0);
      const float* gn = a.mlstm_norm_g + (size_t)l * 512 + h * HD + e0;
      const f32x4 g0 = *(const f32x4*)gn, g1 = *(const f32x4*)(gn + 4);
      float y[8] = {h0.x * g0.x, h0.y * g0.y, h0.z * g0.z, h0.w * g0.w, h1.x * g1.x, h1.y * g1.y, h1.z * g1.z, h1.w * g1.w};
      const float mf[8] = {bflo(mo.x), bfhi(mo.x), bflo(mo.y), bfhi(mo.y), bflo(mo.z), bfhi(mo.z), bflo(mo.w), bfhi(mo.w)};
#pragma unroll
      for (int k = 0; k < 8; ++k) y[k] = y[k] * rstd * (1.0f / (1.0f + fast_exp(-mf[k])));
      u32x4 w; w.x = cvtpk(y[0], y[1]); w.y = cvtpk(y[2], y[3]); w.z = cvtpk(y[4], y[5]); w.w = cvtpk(y[6], y[7]);
      *(u32x4*)(MIX + (size_t)(row0 + t) * D + 1536 + h * HD + e0) = w; }
    { const float decay = SC[3]; const int dg = tg * 32; float acc[32];
#pragma unroll
      for (int i = 0; i < 32; ++i) acc[i] = C0[(size_t)(dg + i) * HD + e] * decay;
      for (int s = 0; s < 32; ++s) { const float vv = V[s * P + e] * WST[s];
#pragma unroll
          for (int i = 0; i < 32; i += 4) { const f32x4 k4 = *(const LAS f32x4*)(Kk + s * P + dg + i); acc[i] += k4.x * vv; acc[i + 1] += k4.y * vv; acc[i + 2] += k4.z * vv; acc[i + 3] += k4.w * vv; } }
      float* oc = a.out + O_SC + sidx * HD * HD;
#pragma unroll
      for (int i = 0; i < 32; ++i) oc[(size_t)(dg + i) * HD + e] = acc[i];
      if (tid < 128) { float v = decay * N0[tid]; for (int s = 0; s < 32; ++s) v += WST[s] * Kk[s * P + tid]; a.out[O_SN + sidx * HD + tid] = v; }
      if (tid == 0) a.out[O_SM + sidx] = SC[2]; }
}

__device__ __forceinline__ void phase_e(const Args& a, const Ctx& c_in0, int l) {
    const Ctx c = relaunder(c_in0);
    const bf16* PROJ = (const bf16*)(a.ws + WS_BIG); bf16* MIX = (bf16*)(a.ws + WS_H);
    constexpr int NATT = NB * NH * 32;
#if (PE_EN & 1)
    if ((c.G & 255) == 0) attn_stream(a, c, l);
    else
    for (int u = c.vcu; u < NATT; u += c.G) {
        const int gq = u & 31, bhh = u >> 5, b = bhh >> 3, h = bhh & 7;
        const int c0 = 4 * gq, jstart = c0 >= 8 ? 0 : 8 - c0, NT = 12 - jstart, ci = c.wave >> 1;
        const int krow0 = b * SEQ + (c0 - 8 + jstart) * 64;
        const int alo = ci - jstart, ahi = ci + 8 - jstart;
        const int R0 = (ci + 8 - jstart) * 64 + (c.wave & 1) * 32;
        attn_unit(c, PROJ + (size_t)(b * SEQ + c0 * 64) * NPROJ + C_Q + h * HD, NPROJ, c.wave * 32, PROJ + (size_t)krow0 * NPROJ + C_K + h * HD, PROJ + (size_t)krow0 * NPROJ + C_V + h * HD, NPROJ,
                  NT, alo < 0 ? 0 : alo, ahi, NT * 64, R0, a.rel_bias + (size_t)(l * NH + h) * 257, MIX + (size_t)(b * SEQ + c0 * 64) * D + 512 + h * HD, D, true, nullptr,
                  gq >= 2 ? (8 * gq + 8) % 12 : 0);
    }
#endif
#if (PE_EN & 4)
    for (int u = c.vcu; u < 16 * NGRP; u += c.G) m3_unit(a, c, l, u);
#endif
}
__device__ __forceinline__ void sample_kv_prep(const Args& a, const Ctx& c, int l, int b, int h) {
    int tid = c.tid; asm volatile("" : "+v"(tid));
    const int lane = tid & 63, row = tid >> 4, c8 = (tid & 15) * 8;
    const bf16* PROJ = (const bf16*)(a.ws + WS_BIG);
    bf16* SK = (bf16*)(a.ws + WS_SK + (size_t)(l & 1) * SKV_IMG); bf16* SV = (bf16*)(a.ws + WS_SV + (size_t)(l & 1) * SKV_IMG);
    const size_t ro = (size_t)(MP + b * SSEQ + row) * NPROJ + h * HD + c8;
    const u32x4 kq = *(const u32x4*)(PROJ + ro + C_K), vq = *(const u32x4*)(PROJ + ro + C_V);
    float x[8] = {bflo(kq.x), bfhi(kq.x), bflo(kq.y), bfhi(kq.y), bflo(kq.z), bfhi(kq.z), bflo(kq.w), bfhi(kq.w)};
    float ss = 0.f;
#pragma unroll
    for (int i = 0; i < 8; ++i) ss += x[i] * x[i];
    ss += shx(ss, 1, lane); ss += shx(ss, 2, lane); ss += shx(ss, 4, lane); ss += shx(ss, 8, lane);
    const float rk = fast_rsqrt(ss * (1.f / HD) + EPS);
    const float* gk = a.k_norm_g + l * HD + c8; const f32x4 g0 = *(const f32x4*)gk, g1 = *(const f32x4*)(gk + 4);
    x[0] *= rk * g0[0]; x[1] *= rk * g0[1]; x[2] *= rk * g0[2]; x[3] *= rk * g0[3]; x[4] *= rk * g1[0]; x[5] *= rk * g1[1]; x[6] *= rk * g1[2]; x[7] *= rk * g1[3];
    u32x4 o; o.x = cvtpk(x[0], x[1]); o.y = cvtpk(x[2], x[3]); o.z = cvtpk(x[4], x[5]); o.w = cvtpk(x[6], x[7]);
    const size_t io = ((size_t)b * SKV_ROWS + 512 + row) * 1024 + h * HD + c8;
    *(u32x4*)(SK + io) = o; *(u32x4*)(SV + io) = vq;
    const size_t oo = ((size_t)(l * SBATCH + b) * SSEQ + row) * 1024 + h * HD + c8;
    float* ok = a.out + O_SK + oo; float* ov = a.out + O_SV + oo;
    *(f32x4*)ok = (f32x4){x[0], x[1], x[2], x[3]}; *(f32x4*)(ok + 4) = (f32x4){x[4], x[5], x[6], x[7]};
    *(f32x4*)ov = (f32x4){bflo(vq.x), bfhi(vq.x), bflo(vq.y), bfhi(vq.y)}; *(f32x4*)(ov + 4) = (f32x4){bflo(vq.z), bfhi(vq.z), bflo(vq.w), bfhi(vq.w)};
    asm volatile("s_waitcnt vmcnt(0)" ::: "memory"); __syncthreads();
}
__device__ __forceinline__ void sample_mixers(const Args& a, const Ctx& c, int l) {
    const bf16* PROJ = (const bf16*)(a.ws + WS_BIG); bf16* MIX = (bf16*)(a.ws + WS_H);
#if (PE_EN & 2)
    for (int su = c.vcu; su < SBATCH * NH; su += c.G) {
        const int b = su >> 3, h = su & 7;
        sample_kv_prep(a, c, l, b, h);
        const bf16* SK = (const bf16*)(a.ws + WS_SK + (size_t)(l & 1) * SKV_IMG) + (size_t)b * SKV_ROWS * 1024 + h * HD; const bf16* SV = (const bf16*)(a.ws + WS_SV + (size_t)(l & 1) * SKV_IMG) + (size_t)b * SKV_ROWS * 1024 + h * HD;
        attn_unit(c, PROJ + (size_t)(MP + b * SSEQ) * NPROJ + C_Q + h * HD, NPROJ, 0, SK, SV, 1024, 9, 0, 8, 544, 512, a.rel_bias + (size_t)(l * NH + h) * 257,
                  MIX + (size_t)(MP + b * SSEQ) * D + 512 + h * HD, D, c.wave == 0, a.q_norm_g + l * HD);
    }
#endif
#if (PE_EN & 8)
    for (int u = c.vcu - SBATCH * NH; u >= 0 && u < SBATCH * MH; u += c.G) ms_unit(a, c, l, u);
#endif
    __syncthreads();
}
typedef const __attribute__((address_space(4))) Args* KArgP;
#if defined(__HIP_DEVICE_COMPILE__)
__device__ __forceinline__ Args get_args() { KArgP p = (KArgP)__builtin_amdgcn_kernarg_segment_ptr(); asm volatile("" : "+s"(p)); return *p; }
#else
__device__ Args get_args();
#endif
__global__ void __launch_bounds__(NTHREADS, 2) fwd(Args args) {
    extern __shared__ __attribute__((aligned(16))) unsigned char lds_raw[];
    Ctx c; c.lds = (LAS unsigned char*)lds_raw; c.wave = __builtin_amdgcn_readfirstlane((int)threadIdx.x >> 6); c.tid = hw_tid(c.wave); c.lane = c.tid & 63;
    c.G = gridDim.x; { const int bx = blockIdx.x; c.vcu = (c.G % 8 == 0) ? (bx % 8) * (c.G / 8) + bx / 8 : bx; }
    volatile LAS unsigned* MISC = (volatile LAS unsigned*)(c.lds + MISC_OFF);
    { const int t0 = hw_tid(c.wave); if (t0 < 16) MISC[t0] = 0u; }
    __syncthreads();
    unsigned* barw = (unsigned*)(get_args().ws + WS_CTL) + 4096;
    XcdBarrier bar; bar.bar = barw; bar.x = 0; bar.st = nullptr;
    const int lo = args.ph_lo, hi = args.ph_hi;
    const bool multi = (hi - lo) > 1;
    if (multi) bar = xcd_barrier_post(barw, MISC + 8, hw_tid(c.wave) == 0);
#define IN(k) (lo <= (k) && (k) < hi)
#define SEAM(k) do { if (IN(k) && IN((k) + 1)) xcd_barrier(bar.bar, bar.x, bar.st, c.wave); } while (0)
    for (int l = 0; l < DEPTH; ++l) {
        const int pb = l * NPH_LAYER;
        if (IN(pb + 0)) {
#if (PH_EN >> 1) & 1
            { const Args A_ = get_args(); phase_norm<true>(A_, c, l); }
#if (PH_DUP >> 1) & 1
            { __syncthreads(); const Args A_ = get_args(); phase_norm<true>(A_, c, l); }
#endif
#endif
 __syncthreads(); SEAM(pb + 0); }
        if (IN(pb + 1)) {
            const Args A_ = get_args(); bf16* H = (bf16*)(A_.ws + WS_H); bf16* BIG = (bf16*)(A_.ws + WS_BIG);
            bf16* XBp = (bf16*)(A_.ws + WS_XB); const float* RS = (const float*)(A_.ws + WS_RSTD);
            pg8::Gemm g{XBp, (const bf16*)(A_.ws + WS_WIN), MP, NPROJ, D}; pg8::StaticOrder S; S.init(MP, NPROJ, c.G, (int)blockIdx.x, WGM_B);
            pg8::EpiProj E{BIG, NPROJ, A_.q_norm_g + l * HD, A_.k_norm_g + l * HD, (LAS float*)(c.lds + SCR_OFF), RS};

#if (PH_EN >> 2) & 1
            for (int rep_ = 0, nrep_ = ((PH_DUP >> 2) & 1) ? A_.rep : 1; rep_ < nrep_; ++rep_) pg8::gemm_phase<pg8::EpiProj, pg8::StaticOrder, true, true>(c.lds, g, S, E, c.wave);
            { SEpiBf16 SE{BIG + (size_t)MP * NPROJ, NPROJ, 0, RS + MP}; sample_gemm(c.lds, c.wave, c.vcu, c.G, XBp + (size_t)MP * D, g.Bt, NPROJ, D, SE); }
#endif

            SEAM(pb + 1);
        }
        if (IN(pb + 2)) {
#if (PH_EN >> 3) & 1
            { const Args A_ = get_args(); phase_c<true>(A_, c, l); }
#if (PH_DUP >> 3) & 1
            { __syncthreads(); const Args A_ = get_args(); phase_c<false>(A_, c, l); }
#endif
#endif
 SEAM(pb + 2); }
        if (IN(pb + 3)) {
#if (PH_EN >> 4) & 1
            { const Args A_ = get_args(); phase_d(A_, c, l); }
            { const Args A_ = get_args(); if (l + 1 < DEPTH) build_kv_image(A_, c.vcu, c.G, hw_tid(c.wave), l + 1); }
#if (PH_DUP >> 4) & 1
            { __syncthreads(); const Args A_ = get_args(); phase_d(A_, c, l); }
#endif
#endif
 SEAM(pb + 3); }
        if (IN(pb + 4)) {
#if (PH_EN >> 5) & 1
            { const Args A_ = get_args(); phase_e(A_, c, l); }
#if (PH_DUP >> 5) & 1
            { __syncthreads(); const Args A_ = get_args(); phase_e(A_, c, l); }
#endif
#endif
 __syncthreads(); SEAM(pb + 4); }
        if (IN(pb + 5)) {
            const Args A_ = get_args(); bf16* H = (bf16*)(A_.ws + WS_H);
            pg8::Gemm g{H, (const bf16*)(A_.ws + WS_WOUT), MP, D, D}; pg8::StaticOrder S; S.init(MP, D, c.G, (int)blockIdx.x, WGM_F);
            pg8::EpiResAdd E{(bf16*)(A_.ws + WS_XB), A_.out, D, false};

#if (PH_EN >> 6) & 1
            pg8::gemm_phase<pg8::EpiResAdd, pg8::StaticOrder, true, true>(c.lds, g, S, E, c.wave);
            { SEpiResAdd SE{(bf16*)(A_.ws + WS_XB) + (size_t)MP * D, A_.out + (size_t)MP * D, D, false}; sample_gemm(c.lds, c.wave, c.vcu, c.G, H + (size_t)MP * D, g.Bt, D, D, SE); }
#if (PH_DUP >> 6) & 1
            { pg8::EpiBf16<0> E2{(bf16*)(A_.ws + WS_BIG), D, nullptr, (LAS float*)(c.lds + SCR_OFF)}; pg8::gemm_phase<pg8::EpiBf16<0>, pg8::StaticOrder, true, true>(c.lds, g, S, E2, c.wave); }
#endif
#endif

            SEAM(pb + 5);
        }
        if (IN(pb + 6)) {
#if (PH_EN >> 7) & 1
            { const Args A_ = get_args(); phase_norm<false>(A_, c, l); }
#if (PH_DUP >> 7) & 1
            { __syncthreads(); const Args A_ = get_args(); phase_norm<false>(A_, c, l); }
#endif
#endif
 SEAM(pb + 6); }
        if (IN(pb + 7)) {
            const Args A_ = get_args(); bf16* H = (bf16*)(A_.ws + WS_H); bf16* BIG = (bf16*)(A_.ws + WS_BIG);
            bf16* XBp = (bf16*)(A_.ws + WS_XB); const float* RS = (const float*)(A_.ws + WS_RSTD);
            pg8::Gemm g{XBp, (const bf16*)(A_.ws + WS_WUP), MP, FF, D}; pg8::StaticOrder S; S.init(MP, FF, c.G, (int)blockIdx.x, WGM_H);
            pg8::EpiBf16<1> E{BIG, FF, RS, (LAS float*)(c.lds + SCR_OFF)};

#if (PH_EN >> 8) & 1
            for (int rep_ = 0, nrep_ = ((PH_DUP >> 8) & 1) ? A_.rep : 1; rep_ < nrep_; ++rep_) pg8::gemm_phase<pg8::EpiBf16<1>, pg8::StaticOrder, true, true>(c.lds, g, S, E, c.wave);
            { SEpiBf16 SE{BIG + (size_t)MP * FF, FF, 1, RS + MP}; sample_gemm(c.lds, c.wave, c.vcu, c.G, XBp + (size_t)MP * D, g.Bt, FF, D, SE); }
#endif

            SEAM(pb + 7);
        }
        if (IN(pb + 8)) {
            const Args A_ = get_args(); bf16* BIG = (bf16*)(A_.ws + WS_BIG);
            pg8::Gemm g{BIG, (const bf16*)(A_.ws + WS_WDN), MP, D, FF}; pg8::StaticOrder S; S.init(MP, D, c.G, (int)blockIdx.x, WGM_I);
            pg8::EpiResAdd E{(bf16*)(A_.ws + WS_XB), A_.out, D, l == DEPTH - 1};

#if (PH_EN >> 9) & 1
            pg8::gemm_phase<pg8::EpiResAdd, pg8::StaticOrder, true, true>(c.lds, g, S, E, c.wave);
            { SEpiResAdd SE{(bf16*)(A_.ws + WS_XB) + (size_t)MP * D, A_.out + (size_t)MP * D, D, l == DEPTH - 1}; sample_gemm(c.lds, c.wave, c.vcu, c.G, BIG + (size_t)MP * FF, g.Bt, D, FF, SE); }
#if (PH_DUP >> 9) & 1
            { pg8::EpiBf16<0> E2{(bf16*)(A_.ws + WS_H), D, nullptr, (LAS float*)(c.lds + SCR_OFF)}; pg8::gemm_phase<pg8::EpiBf16<0>, pg8::StaticOrder, true, true>(c.lds, g, S, E2, c.wave); }
#endif
#endif

            SEAM(pb + 8);
        }
    }
#undef IN
#undef SEAM
}

extern "C" void kernel_launch(void* const* d_in, const int* in_sizes, int n_in, void* d_out, int out_size, void* d_ws, size_t ws_size, hipStream_t stream) {
    static int grid = 0;
    if (grid == 0) {
        if (n_in != 21 || (size_t)out_size != O_END || ws_size < WS_END) { fprintf(stderr, "kernel_launch: shape mismatch n_in %d out %d ws %zu (need %zu)\n", n_in, out_size, ws_size, (size_t)WS_END); grid = -1; return; }
        int dev = 0, cus = 0, per_cu = 0;
        if (hipGetDevice(&dev) != hipSuccess || hipDeviceGetAttribute(&cus, hipDeviceAttributeMultiprocessorCount, dev) != hipSuccess) { grid = -1; return; }
        if (hipFuncSetAttribute((const void*)fwd, hipFuncAttributeMaxDynamicSharedMemorySize, LDS_BYTES) != hipSuccess) { fprintf(stderr, "kernel_launch: hipFuncSetAttribute failed\n"); grid = -1; return; }
        if (hipOccupancyMaxActiveBlocksPerMultiprocessor(&per_cu, (const void*)fwd, NTHREADS, LDS_BYTES) != hipSuccess || per_cu < 1) { fprintf(stderr, "kernel_launch: occupancy query says %d\n", per_cu); }
        (void)hipGetLastError();
        grid = cus;
    }
    if (grid < 0) return;
    (void)hipMemsetAsync((char*)d_ws + WS_CTL, 0, CTL_BYTES, stream);
    Args a{};
    a.x_prompt = (const float*)d_in[0]; a.x_sample = (const float*)d_in[1]; a.cache_k = (const float*)d_in[2]; a.cache_v = (const float*)d_in[3]; a.state_conv = (const float*)d_in[4];
    a.state_c = (const float*)d_in[5]; a.state_n = (const float*)d_in[6]; a.state_m = (const float*)d_in[7]; a.norm_mix_g = (const float*)d_in[8]; a.w_in = (const float*)d_in[9];
    a.conv_w = (const float*)d_in[10]; a.q_norm_g = (const float*)d_in[11]; a.k_norm_g = (const float*)d_in[12]; a.rel_bias = (const float*)d_in[13]; a.b_igate = (const float*)d_in[14];
    a.b_fgate = (const float*)d_in[15]; a.mlstm_norm_g = (const float*)d_in[16]; a.w_out = (const float*)d_in[17]; a.norm_mlp_g = (const float*)d_in[18]; a.w_up = (const float*)d_in[19];
    a.w_down = (const float*)d_in[20]; a.out = (float*)d_out; a.ws = (unsigned char*)d_ws;
#if MK_PER_PHASE
    for (int p = 0; p < NPHASES; ++p) { a.ph_lo = p; a.ph_hi = p + 1; a.rep = 2; hipLaunchKernelGGL(fwd, dim3(grid), dim3(NTHREADS), LDS_BYTES, stream, a); }
#else
    a.ph_lo = 0; a.ph_hi = NPHASES; a.rep = 2; hipLaunchKernelGGL(fwd, dim3(grid), dim3(NTHREADS), LDS_BYTES, stream, a);
#endif
    const hipError_t le = hipPeekAtLastError();
    if (le != hipSuccess) fprintf(stderr, "kernel_launch: launch failed: %s\n", hipGetErrorName(le));
}
```

```cpp
#include <hip/hip_runtime.h>
#include <cstdio>
#include <cstdint>

#ifndef MK_PER_PHASE
#define MK_PER_PHASE 0
#endif

#ifndef PH_EN
#define PH_EN 0x3ff
#endif
#ifndef PE_EN
#define PE_EN 0xf
#endif
#ifndef WGM_B
#define WGM_B 4
#endif
#ifndef WGM_F
#define WGM_F 4
#endif
#ifndef WGM_H
#define WGM_H 4
#endif
#ifndef WGM_I
#define WGM_I 4
#endif
#ifndef PH_DUP
#define PH_DUP 0
#endif
#define LAS __attribute__((address_space(3)))
#define GAS __attribute__((address_space(1)))
typedef unsigned short bf16;
typedef short bf16x8 __attribute__((ext_vector_type(8)));
typedef short s16x4 __attribute__((ext_vector_type(4)));
typedef float f32x2 __attribute__((ext_vector_type(2)));
typedef float f32x4 __attribute__((ext_vector_type(4)));
typedef float f32x16 __attribute__((ext_vector_type(16)));
typedef unsigned u32x2 __attribute__((ext_vector_type(2)));
typedef unsigned u32x4 __attribute__((ext_vector_type(4)));

constexpr int D = 2048, NB = 4, SEQ = 8192, DEPTH = 4, SBATCH = 8, SSEQ = 32;
constexpr int MP = NB * SEQ, MS = SBATCH * SSEQ, MR = MP + MS;
constexpr int NH = 8, HD = 128, MH = 4;
constexpr int NPROJ = 6656, IN_DIM = 6664, FF = 8192;
constexpr int C_XA = 0, C_GB = 512, C_GC = 1024, C_Q = 1536, C_K = 2560, C_V = 3584, C_MQ = 4608, C_MK = 5120, C_MV = 5632, C_MO = 6144;
constexpr int KEEP = 512;
constexpr int SKV_ROWS = 640;
constexpr float EPS = 1e-6f;
constexpr float LOG2E = 1.4426950408889634f;
constexpr int NGRP = SEQ / 256;

constexpr size_t O_YP = 0, O_YS = O_YP + (size_t)MP * D, O_PCONV = O_YS + (size_t)MS * D, O_PK = O_PCONV + (size_t)DEPTH * NB * 2 * 512,
                 O_PV = O_PK + (size_t)DEPTH * NB * KEEP * 1024, O_PC = O_PV + (size_t)DEPTH * NB * KEEP * 1024, O_PN = O_PC + (size_t)DEPTH * NB * MH * HD * HD,
                 O_PM = O_PN + (size_t)DEPTH * NB * MH * HD, O_SCONV = O_PM + (size_t)DEPTH * NB * MH, O_SK = O_SCONV + (size_t)DEPTH * SBATCH * 2 * 512,
                 O_SV = O_SK + (size_t)DEPTH * SBATCH * SSEQ * 1024, O_SC = O_SV + (size_t)DEPTH * SBATCH * SSEQ * 1024, O_SN = O_SC + (size_t)DEPTH * SBATCH * MH * HD * HD,
                 O_SM = O_SN + (size_t)DEPTH * SBATCH * MH * HD, O_END = O_SM + (size_t)DEPTH * SBATCH * MH;

constexpr size_t al256(size_t x) { return (x + 255) / 256 * 256; }
constexpr size_t WS_CTL = 0, CTL_BYTES = 1u << 20;
constexpr size_t WS_WIN = CTL_BYTES;
constexpr size_t WS_WOUT = WS_WIN + (size_t)NPROJ * D * 2;
constexpr size_t WS_WUP = WS_WOUT + (size_t)D * D * 2;
constexpr size_t WS_WDN = WS_WUP + (size_t)FF * D * 2;
constexpr size_t WS_H = WS_WDN + (size_t)D * FF * 2;
constexpr size_t WS_XB = WS_H + (size_t)MR * D * 2;
constexpr size_t WS_BIG = WS_XB + (size_t)MR * D * 2;
constexpr size_t BIG_BYTES = (size_t)MR * FF * 2;
constexpr size_t WS_CLOC = WS_BIG + al256((size_t)MR * NPROJ * 2);
constexpr size_t WS_C0 = WS_CLOC + (size_t)16 * NGRP * HD * HD * 4;
constexpr size_t WS_NLOC = WS_C0 + (size_t)16 * NGRP * HD * HD * 2;
constexpr size_t WS_N0 = WS_NLOC + (size_t)16 * NGRP * HD * 4;
constexpr size_t WS_MSC = WS_N0 + (size_t)16 * NGRP * HD * 4;
constexpr size_t WS_MIX_END = WS_MSC + (size_t)16 * NGRP * 4 * 4;
static_assert(WS_MIX_END <= WS_BIG + BIG_BYTES, "mLSTM scratch fits in the free top of BIG");
constexpr size_t WS_GATE = WS_BIG + BIG_BYTES;
constexpr size_t SKV_IMG = (size_t)SBATCH * SKV_ROWS * 1024 * 2;
constexpr size_t WS_SK = WS_GATE + (size_t)MR * 8 * 4;
constexpr size_t WS_SV = WS_SK + 2 * SKV_IMG;
constexpr size_t WS_RSTD = WS_SV + 2 * SKV_IMG;
constexpr size_t WS_END = WS_RSTD + (size_t)MR * 4;
static_assert(WS_END <= 1235000000ull, "workspace budget");

constexpr int RING_BYTES = 131072;
constexpr int MISC_OFF = RING_BYTES;
constexpr int SCR_OFF = MISC_OFF + 256;
constexpr int LDS_BYTES = 147456;
constexpr int NWAVES = 8, NTHREADS = 512;

__device__ __forceinline__ unsigned cvtpk(float lo, float hi) { unsigned r; asm volatile("v_cvt_pk_bf16_f32 %0, %1, %2" : "=v"(r) : "v"(lo), "v"(hi)); return r; }
__device__ __forceinline__ float bflo(unsigned w) { return __uint_as_float(w << 16); }
__device__ __forceinline__ float bfhi(unsigned w) { return __uint_as_float(w & 0xffff0000u); }
__device__ __forceinline__ float bf2f(bf16 b) { return __uint_as_float(((unsigned)b) << 16); }
__device__ __forceinline__ float shx(float v, int o, int lane) { return __int_as_float(__builtin_amdgcn_ds_bpermute((lane ^ o) << 2, __float_as_int(v))); }
__device__ __forceinline__ float shup(float v, int o, int lane) { const int s = lane - o; return __int_as_float(__builtin_amdgcn_ds_bpermute((s < 0 ? lane : s) << 2, __float_as_int(v))); }
__device__ __forceinline__ float wave_sum(float v, int lane) {
#pragma unroll
    for (int o = 1; o < 64; o <<= 1) v += shx(v, o, lane);
    return v;
}
__device__ __forceinline__ float fast_rsqrt(float x) { return __builtin_amdgcn_rsqf(x); }
__device__ __forceinline__ float fast_exp(float x) { return __builtin_amdgcn_exp2f(x * 1.4426950408889634f); }
__device__ __forceinline__ float fast_log(float x) { return __builtin_amdgcn_logf(x) * 0.6931471805599453f; }
__device__ __forceinline__ float opaque_zero() { float z; asm volatile("v_mov_b32 %0, 0" : "=v"(z)); return z; }
#define LDS_WAIT() asm volatile("s_waitcnt lgkmcnt(0)" ::: "memory")
#define VM_WAIT() asm volatile("s_waitcnt vmcnt(0)" ::: "memory")
#define SBAR() __builtin_amdgcn_sched_barrier(0)

namespace pg8 {
typedef unsigned short bf16_t;
constexpr int BM = 256, BK = 64, HALF = 128, HTB = HALF * BK * 2, STAGE_BYTES = 8 * HTB, NXCD = 8, WGM = 4;
__host__ __device__ __forceinline__ int lds_byte(int r, int c) { const int st = (r >> 4) * 2 + (c >> 5), rr = r & 15, cc = c & 31, ob = rr * 64 + cc * 2; return st * 1024 + (ob ^ (((ob >> 9) & 1) << 5)); }
__host__ __device__ __forceinline__ void stage_rc(int b, int& R, int& C) { const int st = b / 1024, sb = b % 1024, swz = sb ^ (((sb >> 9) & 1) << 5); R = (st >> 1) * 16 + swz / 64; C = (st & 1) * 32 + (swz % 64) / 2; }
__host__ __device__ __forceinline__ int perm32(int rho) { const int n = rho >> 4, i = rho & 15; return 8 * (i >> 2) + 4 * n + (i & 3); }
struct Unit { int pm, pn; };
struct Gemm { const bf16_t* A; const bf16_t* Bt; int M, N, K; };
struct StaticOrder {
    int nM, nN, nwg, G, c, wgm;
    __host__ __device__ void init(int M, int N, int G_, int c_, int wgm_ = WGM) { nM = M / BM; nN = N / BM; nwg = nM * nN; G = G_; c = c_; wgm = wgm_; }
    __host__ __device__ bool next(int i, Unit& u) const {
        const long L = (long)i * G + c; if (L >= nwg) return false;
        int wgid = (int)L; { const int q = nwg / NXCD, r = nwg % NXCD, xcd = wgid % NXCD, off = wgid / NXCD; wgid = (xcd < r ? xcd * (q + 1) : r * (q + 1) + (xcd - r) * q) + off; }
        const int nig = wgm * nN, gid = wgid / nig, fm = gid * wgm, gsz = (nM - fm) < wgm ? (nM - fm) : wgm;
        u.pm = fm + ((wgid % nig) % gsz); u.pn = (wgid % nig) / gsz; return true;
    }
    __device__ __forceinline__ void a_ready(const Unit&) const {}
    __device__ __forceinline__ void done(const Unit&) const {}
};
template <int ACT  > struct EpiBf16 {
    static constexpr bool PERM = true, AFTER_DRAIN = false;
    static constexpr bool RSL = true;
    bf16_t* O; int ldc; const float* rstd; LAS float* T;
    __device__ __forceinline__ void rs_fetch(const Unit& u, int tid, int par) const { if (rstd && tid < BM) (T + 2048 + par * BM)[tid] = rstd[u.pm * BM + tid]; }
    __device__ __forceinline__ void operator()(const f32x4 (&acc)[2][2][4][2], const Unit& u, int wr, int wc, int fr, int fq, int par) const {
        const int row0 = u.pm * BM + wr * 64 + fr; const int col0 = u.pn * BM + wc * 32 + 8 * fq;
#pragma unroll
        for (int ai = 0; ai < 2; ++ai)
#pragma unroll
            for (int m = 0; m < 4; ++m) { bf16_t* rowp = O + (size_t)(row0 + ai * HALF + m * 16) * ldc + col0; const float rsv = rstd ? (T + 2048 + par * BM)[wr * 64 + fr + ai * HALF + m * 16] : 1.0f;
#pragma unroll
                for (int bj = 0; bj < 2; ++bj) { f32x4 v0 = acc[ai][bj][m][0] * rsv, v1 = acc[ai][bj][m][1] * rsv;
                    if (ACT == 1) {
#pragma unroll
                        for (int j = 0; j < 4; ++j) { const float a = fmaxf(v0[j], 0.f), b = fmaxf(v1[j], 0.f); v0[j] = a * a; v1[j] = b * b; } }
                    u32x4 w; w.x = cvtpk(v0[0], v0[1]); w.y = cvtpk(v0[2], v0[3]); w.z = cvtpk(v1[0], v1[1]); w.w = cvtpk(v1[2], v1[3]);
                    *(u32x4*)(rowp + bj * HALF) = w; } }
    }
};
struct EpiProj {
    static constexpr bool PERM = true, AFTER_DRAIN = false;
    static constexpr bool RSL = true;
    bf16_t* O; int ldc; const float* gq; const float* gk; LAS float* T; const float* rstd;
    __device__ __forceinline__ void rs_fetch(const Unit& u, int tid, int par) const { if (tid < BM) (T + 2048 + par * BM)[tid] = rstd[u.pm * BM + tid]; }
    __device__ __forceinline__ void operator()(const f32x4 (&acc)[2][2][4][2], const Unit& u, int wr, int wc, int fr, int fq, int par) const {
        const int row0 = u.pm * BM + wr * 64 + fr; const int col0 = u.pn * BM + wc * 32 + 8 * fq;
        const bool isqk = (u.pn >= 6) && (u.pn < 14);
        float rs[2][4];
#pragma unroll
        for (int ai = 0; ai < 2; ++ai)
#pragma unroll
            for (int m = 0; m < 4; ++m) rs[ai][m] = (T + 2048 + par * BM)[wr * 64 + fr + ai * HALF + m * 16];
        if (!isqk) {
#pragma unroll
            for (int ai = 0; ai < 2; ++ai)
#pragma unroll
                for (int m = 0; m < 4; ++m) { bf16_t* rowp = O + (size_t)(row0 + ai * HALF + m * 16) * ldc + col0;
#pragma unroll
                    for (int bj = 0; bj < 2; ++bj) { const f32x4 v0 = acc[ai][bj][m][0] * rs[ai][m], v1 = acc[ai][bj][m][1] * rs[ai][m];
                        u32x4 w; w.x = cvtpk(v0[0], v0[1]); w.y = cvtpk(v0[2], v0[3]); w.z = cvtpk(v1[0], v1[1]); w.w = cvtpk(v1[2], v1[3]);
                        *(u32x4*)(rowp + bj * HALF) = w; } }
            return;
        }
        const int lane = fr + 16 * fq;
        float ss[2][4][2];
#pragma unroll
        for (int ai = 0; ai < 2; ++ai)
#pragma unroll
            for (int m = 0; m < 4; ++m)
#pragma unroll
                for (int bj = 0; bj < 2; ++bj) { const f32x4 v0 = acc[ai][bj][m][0] * rs[ai][m], v1 = acc[ai][bj][m][1] * rs[ai][m];
                    float s = (v0[0] * v0[0] + v0[1] * v0[1]) + (v0[2] * v0[2] + v0[3] * v0[3]) + (v1[0] * v1[0] + v1[1] * v1[1]) + (v1[2] * v1[2] + v1[3] * v1[3]);
                    s += shx(s, 16, lane); s += shx(s, 32, lane); ss[ai][m][bj] = s; }
        if (fq == 0) {
#pragma unroll
            for (int ai = 0; ai < 2; ++ai)
#pragma unroll
                for (int m = 0; m < 4; ++m)
#pragma unroll
                    for (int bj = 0; bj < 2; ++bj) T[(ai * HALF + wr * 64 + m * 16 + fr) * 8 + bj * 4 + wc] = ss[ai][m][bj];
        }
        asm volatile("s_waitcnt lgkmcnt(0)" ::: "memory"); __builtin_amdgcn_s_barrier(); asm volatile("" ::: "memory");
        const float* gg = ((u.pn < 10) ? gq : gk) + wc * 32 + 8 * fq;
        const f32x4 g0 = *(const f32x4*)gg, g1 = *(const f32x4*)(gg + 4);
#pragma unroll
        for (int ai = 0; ai < 2; ++ai)
#pragma unroll
            for (int m = 0; m < 4; ++m) { bf16_t* rowp = O + (size_t)(row0 + ai * HALF + m * 16) * ldc + col0;
#pragma unroll
                for (int bj = 0; bj < 2; ++bj) { const f32x4 t = *(const LAS f32x4*)(T + (ai * HALF + wr * 64 + m * 16 + fr) * 8 + bj * 4);
                    const float rq = fast_rsqrt(((t[0] + t[1]) + (t[2] + t[3])) * (1.0f / 128.0f) + 1e-6f) * rs[ai][m];
                    const f32x4 v0 = acc[ai][bj][m][0] * rq * g0, v1 = acc[ai][bj][m][1] * rq * g1;
                    u32x4 w; w.x = cvtpk(v0[0], v0[1]); w.y = cvtpk(v0[2], v0[3]); w.z = cvtpk(v1[0], v1[1]); w.w = cvtpk(v1[2], v1[3]);
                    *(u32x4*)(rowp + bj * HALF) = w; } }
    }
};
struct EpiResAdd {
    static constexpr bool RSL = false;
    static constexpr bool PERM = true, AFTER_DRAIN = false;
    bf16_t* XB; float* Y; int ldc; bool fin;
    __device__ __forceinline__ void operator()(const f32x4 (&acc)[2][2][4][2], const Unit& u, int wr, int wc, int fr, int fq, int) const {
        const int row0 = u.pm * BM + wr * 64 + fr, col0 = u.pn * BM + wc * 32 + 8 * fq;
        u32x4 r[2][4][2];
#pragma unroll
        for (int ai = 0; ai < 2; ++ai)
#pragma unroll
            for (int m = 0; m < 4; ++m)
#pragma unroll
                for (int bj = 0; bj < 2; ++bj) r[ai][m][bj] = *(const u32x4*)(XB + (size_t)(row0 + ai * HALF + m * 16) * ldc + col0 + bj * HALF);
#pragma unroll
        for (int ai = 0; ai < 2; ++ai)
#pragma unroll
            for (int m = 0; m < 4; ++m)
#pragma unroll
                for (int bj = 0; bj < 2; ++bj) { const u32x4 w = r[ai][m][bj]; const f32x4 a0 = acc[ai][bj][m][0], a1 = acc[ai][bj][m][1];
                    const f32x4 v0 = (f32x4){bflo(w.x) + a0[0], bfhi(w.x) + a0[1], bflo(w.y) + a0[2], bfhi(w.y) + a0[3]}, v1 = (f32x4){bflo(w.z) + a1[0], bfhi(w.z) + a1[1], bflo(w.w) + a1[2], bfhi(w.w) + a1[3]};
                    const size_t off = (size_t)(row0 + ai * HALF + m * 16) * ldc + col0 + bj * HALF;
                    if (fin) { *(f32x4*)(Y + off) = v0; *(f32x4*)(Y + off + 4) = v1; }
                    else { u32x4 o; o.x = cvtpk(v0[0], v0[1]); o.y = cvtpk(v0[2], v0[3]); o.z = cvtpk(v1[0], v1[1]); o.w = cvtpk(v1[2], v1[3]); *(u32x4*)(XB + off) = o; } }
    }
};

template <class Epi, class Sched, bool ALIGN_EPI = false, bool SP2 = false>
__device__ __forceinline__ void gemm_phase(LAS unsigned char* lds, const Gemm g, const Sched& S, const Epi& E, const int wave_) {
    int ln_; asm volatile("v_mbcnt_lo_u32_b32 %0, -1, 0\n\tv_mbcnt_hi_u32_b32 %0, -1, %0" : "=v"(ln_)); const int tid = wave_ * 64 + ln_;
    const int wid = __builtin_amdgcn_readfirstlane(tid >> 6), lane = tid & 63, wr = wid >> 2, wc = wid & 3, fr = lane & 15, fq = lane >> 4;
    const int K = g.K, nt = K / BK;
    unsigned voffA[2], voffB[2];
#pragma unroll
    for (int i = 0; i < 2; ++i) { int R, C; stage_rc(tid * 16 + i * 8192, R, C); const int Rb = Epi::PERM ? ((R & ~31) + perm32(R & 31)) : R;
        voffA[i] = (unsigned)(R * K + C) * 2u; voffB[i] = (unsigned)(Rb * K + C) * 2u; }
    const size_t kstep = (size_t)(BK * 2);
    const size_t hstep = (size_t)HALF * K * 2;
    const size_t tstep = 2 * hstep;
    const unsigned ldsw = (unsigned)wid * 1024u;
    const int aoff = lds_byte(wr * 64 + fr, fq * 8), boff = lds_byte(wc * 32 + fr, fq * 8);
#define PG8_SA(b, h) (((b) * 2 + (h)) * HTB)
#define PG8_SB(b, h) ((4 + (b) * 2 + (h)) * HTB)
#define PG8_STAGE(bufoff, gbase, voff) do { _Pragma("unroll") for (int _i = 0; _i < 2; ++_i) \
        __builtin_amdgcn_global_load_lds((const unsigned*)((const char*)(gbase) + (voff)[_i]), (LAS unsigned*)(lds + (bufoff) + ldsw + _i * 8192), 16, 0, 0); } while (0)
#define PG8_LDA(dst, b, h) do { _Pragma("unroll") for (int m = 0; m < 4; ++m) _Pragma("unroll") for (int k = 0; k < 2; ++k) dst[m][k] = *(const LAS bf16x8*)(lds + PG8_SA(b, h) + aoff + m * 2048 + k * 1024); } while (0)
#define PG8_LDB(dst, b, h) do { _Pragma("unroll") for (int n = 0; n < 2; ++n) _Pragma("unroll") for (int k = 0; k < 2; ++k) dst[n][k] = *(const LAS bf16x8*)(lds + PG8_SB(b, h) + boff + n * 2048 + k * 1024); } while (0)
#define PG8_MMA(ai, bj, At, Bt) do { __builtin_amdgcn_s_setprio(1); _Pragma("unroll") for (int m = 0; m < 4; ++m) _Pragma("unroll") for (int n = 0; n < 2; ++n) _Pragma("unroll") for (int k = 0; k < 2; ++k) \
        acc[ai][bj][m][n] = __builtin_amdgcn_mfma_f32_16x16x32_bf16(Bt[n][k], At[m][k], acc[ai][bj][m][n], 0, 0, 0); __builtin_amdgcn_s_setprio(0); } while (0)
#define PG8_WAIT_V(n) asm volatile("s_waitcnt vmcnt(" #n ")" ::: "memory")
#define PG8_WAIT_L(n) asm volatile("s_waitcnt lgkmcnt(" #n ")" ::: "memory")
#define PG8_BAR __builtin_amdgcn_s_barrier()
#define PG8_SCHED __builtin_amdgcn_sched_barrier(0)
    Unit cur, nxt; int ui = 0;
    if (!S.next(0, cur)) return;
    f32x4 acc[2][2][4][2];
    { const float z = opaque_zero();
#pragma unroll
    for (int a = 0; a < 2; ++a)
#pragma unroll
        for (int b = 0; b < 2; ++b)
#pragma unroll
            for (int m = 0; m < 4; ++m)
#pragma unroll
                for (int n = 0; n < 2; ++n) acc[a][b][m][n] = (f32x4){z, z, z, z}; }
    bf16x8 At[4][2], B0[2][2], B1[2][2];
    const char* cA = (const char*)g.A + (size_t)cur.pm * tstep; const char* cB = (const char*)g.Bt + (size_t)cur.pn * tstep;
    S.a_ready(cur);
    if constexpr (Epi::RSL) E.rs_fetch(cur, tid, 0);
    if constexpr (SP2) {
        PG8_STAGE(PG8_SB(0, 0), cB, voffB); PG8_STAGE(PG8_SB(0, 1), cB + hstep, voffB); PG8_STAGE(PG8_SA(0, 0), cA, voffA); PG8_STAGE(PG8_SA(0, 1), cA + hstep, voffA);
        if (wr == 1) PG8_BAR;
        PG8_WAIT_V(2); PG8_BAR;
        PG8_STAGE(PG8_SB(1, 0), cB + kstep, voffB); PG8_STAGE(PG8_SA(1, 0), cA + kstep, voffA); PG8_STAGE(PG8_SB(1, 1), cB + hstep + kstep, voffB);
        PG8_WAIT_V(6); PG8_BAR;
    } else {
        PG8_STAGE(PG8_SB(0, 0), cB, voffB); PG8_STAGE(PG8_SA(0, 0), cA, voffA); PG8_STAGE(PG8_SB(0, 1), cB + hstep, voffB); PG8_STAGE(PG8_SA(0, 1), cA + hstep, voffA);
        if (wr == 1) PG8_BAR;
        PG8_WAIT_V(4); PG8_BAR;
        PG8_STAGE(PG8_SB(1, 0), cB + kstep, voffB); PG8_STAGE(PG8_SA(1, 0), cA + kstep, voffA); PG8_STAGE(PG8_SB(1, 1), cB + hstep + kstep, voffB);
        PG8_WAIT_V(6); PG8_BAR;
    }
    for (;;) {
        const bool has_next = S.next(ui + 1, nxt);
        const char* nA = has_next ? (const char*)g.A + (size_t)nxt.pm * tstep : cA; const char* nB = has_next ? (const char*)g.Bt + (size_t)nxt.pn * tstep : cB;
        for (int t = 0; t < nt; t += 2) {
            const bool last = (t == nt - 2);
            const char* a1 = cA + (size_t)(t + 1) * kstep;
            const char* a2 = last ? nA : cA + (size_t)(t + 2) * kstep; const char* b2 = last ? nB : cB + (size_t)(t + 2) * kstep;
            const char* a3 = a2 + kstep; const char* b3 = b2 + kstep;
            if (last && has_next) S.a_ready(nxt);
            if constexpr (SP2) {
            PG8_LDB(B0, 0, 0); PG8_LDB(B1, 0, 1); PG8_SCHED; PG8_LDA(At, 0, 0); PG8_STAGE(PG8_SA(1, 1), a1 + hstep, voffA);
            PG8_WAIT_V(8); PG8_WAIT_L(0); PG8_BAR; PG8_MMA(0, 0, At, B0); PG8_MMA(0, 1, At, B1); PG8_BAR; PG8_SCHED;
            PG8_LDA(At, 0, 1); PG8_STAGE(PG8_SB(0, 0), b2, voffB); PG8_STAGE(PG8_SB(0, 1), b2 + hstep, voffB); PG8_STAGE(PG8_SA(0, 0), a2, voffA);
            PG8_WAIT_V(8); PG8_WAIT_L(0); PG8_BAR; PG8_MMA(1, 0, At, B0); PG8_MMA(1, 1, At, B1); PG8_BAR; PG8_SCHED;
            PG8_LDB(B0, 1, 0); PG8_LDB(B1, 1, 1); PG8_SCHED; PG8_LDA(At, 1, 0); PG8_STAGE(PG8_SA(0, 1), a2 + hstep, voffA);
            PG8_WAIT_V(8); PG8_WAIT_L(0); PG8_BAR; PG8_MMA(0, 0, At, B0); PG8_MMA(0, 1, At, B1); PG8_BAR; PG8_SCHED;
            PG8_LDA(At, 1, 1); PG8_STAGE(PG8_SB(1, 0), b3, voffB); PG8_STAGE(PG8_SB(1, 1), b3 + hstep, voffB); PG8_STAGE(PG8_SA(1, 0), a3, voffA);
            PG8_WAIT_V(8); PG8_WAIT_L(0); PG8_BAR; PG8_MMA(1, 0, At, B0); PG8_MMA(1, 1, At, B1); PG8_BAR; PG8_SCHED;
            } else {
            PG8_LDB(B0, 0, 0); PG8_SCHED; PG8_LDA(At, 0, 0); PG8_STAGE(PG8_SA(1, 1), a1 + hstep, voffA);
            PG8_WAIT_L(8); PG8_BAR; PG8_WAIT_L(0); PG8_MMA(0, 0, At, B0); PG8_BAR; PG8_SCHED;
            PG8_LDB(B1, 0, 1); PG8_STAGE(PG8_SB(0, 0), b2, voffB);
            PG8_BAR; PG8_WAIT_L(0); PG8_MMA(0, 1, At, B1); PG8_BAR;
            PG8_LDA(At, 0, 1); PG8_STAGE(PG8_SA(0, 0), a2, voffA);
            PG8_BAR; PG8_WAIT_L(0); PG8_MMA(1, 0, At, B0); PG8_BAR; PG8_SCHED;
            PG8_STAGE(PG8_SB(0, 1), b2 + hstep, voffB);
            PG8_WAIT_V(6); PG8_BAR; PG8_MMA(1, 1, At, B1); PG8_BAR;
            PG8_LDB(B0, 1, 0); PG8_SCHED; PG8_LDA(At, 1, 0); PG8_STAGE(PG8_SA(0, 1), a2 + hstep, voffA);
            PG8_WAIT_L(8); PG8_BAR; PG8_WAIT_L(0); PG8_MMA(0, 0, At, B0); PG8_BAR; PG8_SCHED;
            PG8_LDB(B1, 1, 1); PG8_STAGE(PG8_SB(1, 0), b3, voffB);
            PG8_BAR; PG8_WAIT_L(0); PG8_MMA(0, 1, At, B1); PG8_BAR;
            PG8_LDA(At, 1, 1); PG8_STAGE(PG8_SA(1, 0), a3, voffA);
            PG8_BAR; PG8_WAIT_L(0); PG8_MMA(1, 0, At, B0); PG8_BAR; PG8_SCHED;
            PG8_STAGE(PG8_SB(1, 1), b3 + hstep, voffB);
            PG8_WAIT_V(6); PG8_BAR; PG8_MMA(1, 1, At, B1); PG8_BAR;
            }
        }
        if constexpr (ALIGN_EPI) { if (wr == 0) PG8_BAR; }
        if constexpr (!Epi::AFTER_DRAIN) { E(acc, cur, wr, wc, fr, fq, ui & 1); S.done(cur); if constexpr (Epi::RSL) { if (has_next) E.rs_fetch(nxt, tid, (ui + 1) & 1); } }
        if (!has_next) break;
        { const float z = opaque_zero();
#pragma unroll
        for (int a = 0; a < 2; ++a)
#pragma unroll
            for (int b = 0; b < 2; ++b)
#pragma unroll
                for (int m = 0; m < 4; ++m)
#pragma unroll
                    for (int n = 0; n < 2; ++n) acc[a][b][m][n] = (f32x4){z, z, z, z}; }
        cur = nxt; cA = nA; cB = nB; ++ui;
        if constexpr (ALIGN_EPI) { if (wr == 1) PG8_BAR; }
    }
    PG8_WAIT_V(0);
    if constexpr (!ALIGN_EPI) { if (wr == 0) PG8_BAR; }
    PG8_BAR;
#undef PG8_SA
#undef PG8_SB
#undef PG8_STAGE
#undef PG8_LDA
#undef PG8_LDB
#undef PG8_MMA
#undef PG8_WAIT_V
#undef PG8_WAIT_L
#undef PG8_BAR
#undef PG8_SCHED
}
}

struct SEpiBf16 { bf16* O; int ldc; int act; const float* rstd;
    __device__ __forceinline__ void operator()(int row, int col, f32x4 s0, f32x4 s1) const {
        { const float r_ = rstd[row]; s0 = s0 * r_; s1 = s1 * r_; }
        if (act) {
#pragma unroll
            for (int j = 0; j < 4; ++j) { const float a = fmaxf(s0[j], 0.f), b = fmaxf(s1[j], 0.f); s0[j] = a * a; s1[j] = b * b; } }
        u32x4 w; w.x = cvtpk(s0[0], s0[1]); w.y = cvtpk(s0[2], s0[3]); w.z = cvtpk(s1[0], s1[1]); w.w = cvtpk(s1[2], s1[3]);
        *(u32x4*)(O + (size_t)row * ldc + col) = w; } };
struct SEpiResAdd { bf16* XB; float* Y; int ldc; bool fin;
    __device__ __forceinline__ void operator()(int row, int col, f32x4 s0, f32x4 s1) const {
        const size_t off = (size_t)row * ldc + col; const u32x4 w = *(const u32x4*)(XB + off);
        const f32x4 v0 = (f32x4){bflo(w.x) + s0[0], bfhi(w.x) + s0[1], bflo(w.y) + s0[2], bfhi(w.y) + s0[3]}, v1 = (f32x4){bflo(w.z) + s1[0], bfhi(w.z) + s1[1], bflo(w.w) + s1[2], bfhi(w.w) + s1[3]};
        if (fin) { *(f32x4*)(Y + off) = v0; *(f32x4*)(Y + off + 4) = v1; }
        else { u32x4 o; o.x = cvtpk(v0[0], v0[1]); o.y = cvtpk(v0[2], v0[3]); o.z = cvtpk(v1[0], v1[1]); o.w = cvtpk(v1[2], v1[3]); *(u32x4*)(XB + off) = o; } } };
template <class Epi>
__device__ __forceinline__ void sample_gemm(LAS unsigned char* lds, int wave, int vcu, int G, const bf16* __restrict__ A, const bf16* __restrict__ Bt, int N, int K, const Epi& E) {
    int ln_; asm volatile("v_mbcnt_lo_u32_b32 %0, -1, 0\n\tv_mbcnt_hi_u32_b32 %0, -1, %0" : "=v"(ln_)); const int tid = wave * 64 + ln_;
    const int lane = tid & 63, fr = lane & 15, fq = lane >> 4;
    const int ntiles = 4 * (N >> 6), kslice = K >> 3, kb = wave * kslice;
    LAS float* red = (LAS float*)lds;
    for (int t = vcu; t < ntiles; t += G) {
        const int rt = t & 3, ct = t >> 2;
        f32x4 acc[4][4];
        { const float z = opaque_zero();
#pragma unroll
          for (int m = 0; m < 4; ++m)
#pragma unroll
              for (int n = 0; n < 4; ++n) acc[m][n] = (f32x4){z, z, z, z}; }
        const bf16* ap = A + (size_t)(rt * 64 + fr) * K + kb + 8 * fq;
        const bf16* bp = Bt + (size_t)(ct * 64 + fr) * K + kb + 8 * fq;
        const size_t r16 = (size_t)16 * K;
#pragma unroll 4
        for (int k = 0; k < kslice; k += 64) {
            bf16x8 a0[4], a1[4], b0[4], b1[4];
#pragma unroll
            for (int m = 0; m < 4; ++m) { a0[m] = *(const bf16x8*)(ap + m * r16 + k); a1[m] = *(const bf16x8*)(ap + m * r16 + k + 32); }
#pragma unroll
            for (int n = 0; n < 4; ++n) { b0[n] = *(const bf16x8*)(bp + n * r16 + k); b1[n] = *(const bf16x8*)(bp + n * r16 + k + 32); }
#pragma unroll
            for (int m = 0; m < 4; ++m)
#pragma unroll
                for (int n = 0; n < 4; ++n) { acc[m][n] = __builtin_amdgcn_mfma_f32_16x16x32_bf16(a0[m], b0[n], acc[m][n], 0, 0, 0);
                                              acc[m][n] = __builtin_amdgcn_mfma_f32_16x16x32_bf16(a1[m], b1[n], acc[m][n], 0, 0, 0); }
        }
        __syncthreads();
#pragma unroll
        for (int m = 0; m < 4; ++m)
#pragma unroll
            for (int n = 0; n < 4; ++n)
#pragma unroll
                for (int j = 0; j < 4; ++j) red[wave * 4096 + (16 * m + 4 * fq + j) * 64 + 16 * n + fr] = acc[m][n][j];
        __syncthreads();
        const int row = tid >> 3, col = (tid & 7) * 8;
        f32x4 s0 = *(const LAS f32x4*)(red + row * 64 + col), s1 = *(const LAS f32x4*)(red + row * 64 + col + 4);
#pragma unroll
        for (int w = 1; w < 8; ++w) { s0 = s0 + *(const LAS f32x4*)(red + w * 4096 + row * 64 + col); s1 = s1 + *(const LAS f32x4*)(red + w * 4096 + row * 64 + col + 4); }
        E(rt * 64 + row, ct * 64 + col, s0, s1);
    }
    __syncthreads();
}

#define XB_TMO      128
#define XB_XCNT(j)  (256  + 64 * (j))
#define XB_XSUB(j)  (1280 + 64 * (j))
#define XB_XGEN(j)  (2304 + 64 * (j))
#define XB_TOP      3328
#define XB_TOPGEN   3392
#define XCD_BAR_WORDS 3456
#define XB_SPIN_CAP (1u << 18)
__device__ __forceinline__ unsigned xb_ld(unsigned* p)              { return __hip_atomic_load(p, __ATOMIC_RELAXED, __HIP_MEMORY_SCOPE_AGENT); }
__device__ __forceinline__ unsigned xb_add(unsigned* p, unsigned v) { return __hip_atomic_fetch_add(p, v, __ATOMIC_RELAXED, __HIP_MEMORY_SCOPE_AGENT); }
__device__ __forceinline__ unsigned xb_xcc_id() { return (unsigned)__builtin_amdgcn_s_getreg((3 << 11) | 20) & 0xFu; }
#define XB_SPIN(cond, bar) do { unsigned _sp = 0; while (cond) { __builtin_amdgcn_s_sleep(1); \
    if ((++_sp & 255u) == 0u) { if (xb_ld(&(bar)[XB_TMO])) break; if (_sp > XB_SPIN_CAP) { atomicAdd(&(bar)[XB_TMO], 1u); break; } } } } while (0)
struct XcdBarrier { unsigned* bar; unsigned x; volatile LAS unsigned* st; };
__device__ __forceinline__ XcdBarrier xcd_barrier_post(unsigned* bar, volatile LAS unsigned* st, bool leader) {
    XcdBarrier b; b.bar = bar; b.x = xb_xcc_id(); b.st = st;
    if (leader) (void)xb_add(&bar[XB_XCNT(b.x)], 1u);
    return b;
}
__device__ __forceinline__ void xcd_barrier_complete(unsigned* bar, unsigned x, unsigned& nloc, unsigned& nx) {
    const unsigned G = gridDim.x * gridDim.y * gridDim.z;
    unsigned sum, cnt, mine, sp = 0u;
    for (;;) {
        sum = 0u; cnt = 0u; mine = 0u;
#pragma unroll
        for (unsigned j = 0; j < 16; ++j) { const unsigned c = xb_ld(&bar[XB_XCNT(j)]); sum += c; cnt += (c > 0u) ? 1u : 0u; mine = (j == x) ? c : mine; }
        if (sum == G) break;
        __builtin_amdgcn_s_sleep(1);
        if ((++sp & 255u) == 0u) { if (xb_ld(&bar[XB_TMO])) break; if (sp > XB_SPIN_CAP) { atomicAdd(&bar[XB_TMO], 1u); break; } }
    }
    nloc = mine > 0u ? mine : 1u; nx = cnt > 0u ? cnt : 1u;
}
__device__ __noinline__ void xcd_barrier(unsigned* bar_, unsigned x_, volatile LAS unsigned* st_, int wave_) {
    XcdBarrier b; b.bar = bar_; b.x = x_; b.st = st_;
    int ln_; asm volatile("v_mbcnt_lo_u32_b32 %0, -1, 0\n\tv_mbcnt_hi_u32_b32 %0, -1, %0" : "=v"(ln_)); const bool leader_ = (wave_ == 0) && (ln_ == 0);
    asm volatile("s_waitcnt vmcnt(0)" ::: "memory");
    __syncthreads();
    if (leader_) {
        unsigned* bar = b.bar;
        __builtin_amdgcn_s_waitcnt(0);
        unsigned nloc = b.st[0], nx = b.st[1];
        if (nloc == 0u) { xcd_barrier_complete(bar, b.x, nloc, nx); b.st[0] = nloc; b.st[1] = nx; }
        const unsigned old = xb_add(&bar[XB_XSUB(b.x)], 1u);
        const unsigned gen = old / nloc;
        if (old + 1u == (gen + 1u) * nloc) {
            __builtin_amdgcn_fence(__ATOMIC_RELEASE, "agent");
            asm volatile("s_waitcnt vmcnt(0)" ::: "memory");
            const unsigned og = xb_add(&bar[XB_TOP], 1u);
            const unsigned tg = og / nx;
            if (og + 1u == (tg + 1u) * nx) xb_add(&bar[XB_TOPGEN], 1u);
            else XB_SPIN(xb_ld(&bar[XB_TOPGEN]) == tg, bar);
            __builtin_amdgcn_fence(__ATOMIC_ACQUIRE, "agent");
            xb_add(&bar[XB_XGEN(b.x)], 1u);
            asm volatile("s_waitcnt vmcnt(0)" ::: "memory");
        } else {
            XB_SPIN(xb_ld(&bar[XB_XGEN(b.x)]) == gen, bar);
            __builtin_amdgcn_fence(__ATOMIC_ACQUIRE, "agent");
            asm volatile("s_waitcnt vmcnt(0)" ::: "memory");
        }
    }
    __syncthreads();
}

#define KSWZ(row, colB) ((row) * 256 + ((colB) ^ (((row) & 7) << 4)))
__device__ __forceinline__ int crow(int r, int hi) { return (r & 3) + 8 * (r >> 2) + 4 * hi; }
__device__ __forceinline__ int v_st(int k, int c) { const int kk = (k & ~0xC) | ((k & 4) << 1) | ((k & 8) >> 1); return ((kk >> 3) * 4 + (c >> 5)) * 512 + ((kk & 7) * 32 + (c & 31)) * 2; }
__device__ __forceinline__ int v_rd_base(int lane) { return ((lane & 3) << 3) | (((lane >> 2) & 3) << 6) | (((lane >> 4) & 1) << 5) | (((lane >> 5) & 1) << 8); }
constexpr int v_rd_off(int d0, int ks, int half) { return d0 * 512 + ks * 4096 + half * 2048; }
template <int OFF> __device__ __forceinline__ s16x4 tr_read(int vb) {
    s16x4 r; asm volatile("ds_read_b64_tr_b16 %0, %1 offset:%2" : "=&v"(r) : "v"(vb), "i"(OFF) : "memory"); return r;
}
#define PKLH(L, H) (bf16x8){L[0], L[1], L[2], L[3], H[0], H[1], H[2], H[3]}
template <int D0> __device__ __forceinline__ void pv_one(f32x16& od, int vb, bf16x8 pa0, bf16x8 pa1, bf16x8 pa2, bf16x8 pa3) {
    const s16x4 l0 = tr_read<v_rd_off(D0, 0, 0)>(vb), h0 = tr_read<v_rd_off(D0, 0, 1)>(vb), l1 = tr_read<v_rd_off(D0, 1, 0)>(vb), h1 = tr_read<v_rd_off(D0, 1, 1)>(vb);
    const s16x4 l2 = tr_read<v_rd_off(D0, 2, 0)>(vb), h2 = tr_read<v_rd_off(D0, 2, 1)>(vb), l3 = tr_read<v_rd_off(D0, 3, 0)>(vb), h3 = tr_read<v_rd_off(D0, 3, 1)>(vb);
    asm volatile("s_waitcnt lgkmcnt(0)" ::: "memory"); SBAR();
    od = __builtin_amdgcn_mfma_f32_32x32x16_bf16(pa0, PKLH(l0, h0), od, 0, 0, 0);
    od = __builtin_amdgcn_mfma_f32_32x32x16_bf16(pa1, PKLH(l1, h1), od, 0, 0, 0);
    od = __builtin_amdgcn_mfma_f32_32x32x16_bf16(pa2, PKLH(l2, h2), od, 0, 0, 0);
    od = __builtin_amdgcn_mfma_f32_32x32x16_bf16(pa3, PKLH(l3, h3), od, 0, 0, 0);
}
__device__ __forceinline__ void pv_d0(f32x16* o, int vb, bf16x8 pa0, bf16x8 pa1, bf16x8 pa2, bf16x8 pa3) {
    pv_one<0>(o[0], vb, pa0, pa1, pa2, pa3); pv_one<1>(o[1], vb, pa0, pa1, pa2, pa3); pv_one<2>(o[2], vb, pa0, pa1, pa2, pa3); pv_one<3>(o[3], vb, pa0, pa1, pa2, pa3);
}
template <int D0, int KS> __device__ __forceinline__ bf16x8 tr_frag(int vb) {
    const s16x4 l = tr_read<v_rd_off(D0, KS, 0)>(vb), h = tr_read<v_rd_off(D0, KS, 1)>(vb);
    return PKLH(l, h);
}
__device__ __forceinline__ void qkt(f32x16& p0, f32x16& p1, int Ks  , const bf16x8* qr, int r32, int hi) {
    p0 = f32x16{}; p1 = f32x16{};
#pragma unroll
    for (int d0 = 0; d0 < 8; ++d0) { const int cb = (d0 * 16 + hi * 8) * 2;
        const bf16x8 b0 = *(const LAS bf16x8*)(uintptr_t)(unsigned)(Ks + KSWZ(r32, cb));
        const bf16x8 b1 = *(const LAS bf16x8*)(uintptr_t)(unsigned)(Ks + KSWZ(32 + r32, cb));
        p0 = __builtin_amdgcn_mfma_f32_32x32x16_bf16(b0, qr[d0], p0, 0, 0, 0);
        p1 = __builtin_amdgcn_mfma_f32_32x32x16_bf16(b1, qr[d0], p1, 0, 0, 0); }
}
#define PK4(P, BASE, OUT) do { unsigned a0 = cvtpk(P[BASE + 0], P[BASE + 1]), a1 = cvtpk(P[BASE + 2], P[BASE + 3]);   \
    unsigned b0 = cvtpk(P[BASE + 4], P[BASE + 5]), b1 = cvtpk(P[BASE + 6], P[BASE + 7]);                              \
    auto r0 = __builtin_amdgcn_permlane32_swap(a0, b0, false, false); auto r1 = __builtin_amdgcn_permlane32_swap(a1, b1, false, false); \
    u32x4 w = {r0[0], r1[0], r0[1], r1[1]}; OUT = *reinterpret_cast<bf16x8*>(&w); } while (0)
__device__ __forceinline__ float half_swap_add(float v) { auto rr = __builtin_amdgcn_permlane32_swap(__float_as_uint(v), __float_as_uint(v), false, false); return __uint_as_float(rr[0]) + __uint_as_float(rr[1]); }
__device__ __forceinline__ float half_swap_max(float v) { auto rr = __builtin_amdgcn_permlane32_swap(__float_as_uint(v), __float_as_uint(v), false, false); return fmaxf(__uint_as_float(rr[0]), __uint_as_float(rr[1])); }

struct Args {
    const float* x_prompt; const float* x_sample; const float* cache_k; const float* cache_v; const float* state_conv; const float* state_c; const float* state_n; const float* state_m;
    const float* norm_mix_g; const float* w_in; const float* conv_w; const float* q_norm_g; const float* k_norm_g; const float* rel_bias; const float* b_igate; const float* b_fgate;
    const float* mlstm_norm_g; const float* w_out; const float* norm_mlp_g; const float* w_up; const float* w_down;
    float* out; unsigned char* ws; int ph_lo, ph_hi, rep, pad;
};
struct Ctx {
    LAS unsigned char* lds; int tid, lane, wave, G, vcu;
};
constexpr int NPH_LAYER = 9, NPHASES = DEPTH * NPH_LAYER;
__device__ __forceinline__ int hw_tid(int wave) { int ln; asm volatile("v_mbcnt_lo_u32_b32 %0, -1, 0\n\tv_mbcnt_hi_u32_b32 %0, -1, %0" : "=v"(ln)); return wave * 64 + ln; }
__device__ __forceinline__ Ctx relaunder(const Ctx& c) { Ctx d = c; const int t = hw_tid(c.wave); d.tid = t; d.lane = t & 63; return d; }

__device__ __forceinline__ void transpose_item(const float* W, int K, int ldn, int nblk, bf16* WT, LAS float* scr, int item, int lane, const float* gain = nullptr) {
    const int kb = item / nblk, nb = item % nblk, k0 = 64 * kb, n0 = 32 * nb;
    const int c = lane & 7;
    f32x4 g0 = (f32x4){1.f, 1.f, 1.f, 1.f}, g1 = g0;
    if (gain) { g0 = *(const f32x4*)(gain + k0 + 8 * c); g1 = *(const f32x4*)(gain + k0 + 8 * c + 4); }
#pragma unroll 8
    for (int i = 0; i < 32; ++i) { const int kk = 2 * i + (lane >> 5); scr[kk * 33 + (lane & 31)] = W[(size_t)(k0 + kk) * ldn + n0 + (lane & 31)]; }
    LDS_WAIT(); asm volatile("" ::: "memory");
#pragma unroll
    for (int j = 0; j < 4; ++j) { const int n = (lane >> 3) + 8 * j; const LAS float* s = scr + (8 * c) * 33 + n;
        u32x4 o; o.x = cvtpk(s[0 * 33] * g0[0], s[1 * 33] * g0[1]); o.y = cvtpk(s[2 * 33] * g0[2], s[3 * 33] * g0[3]); o.z = cvtpk(s[4 * 33] * g1[0], s[5 * 33] * g1[1]); o.w = cvtpk(s[6 * 33] * g1[2], s[7 * 33] * g1[3]);
        *(GAS u32x4*)(WT + (size_t)(n0 + n) * K + k0 + 8 * c) = o; }
    LDS_WAIT(); asm volatile("" ::: "memory");
}
__device__ __forceinline__ void convert_weights(const Args& a, const Ctx& c, int l) {
    LAS float* scr = (LAS float*)(c.lds + c.wave * 16384);
    const int gw = c.vcu * NWAVES + c.wave, NGW = c.G * NWAVES;
    constexpr int I_IN = (D / 64) * (NPROJ / 32), I_OUT = (D / 64) * (D / 32), I_UP = (D / 64) * (FF / 32), I_DN = (FF / 64) * (D / 32), I_L = I_IN + I_OUT + I_UP + I_DN;
    for (int it = gw; it < I_L; it += NGW) {
        int r = it;
        if (r < I_IN) { transpose_item(a.w_in + (size_t)l * D * IN_DIM, D, IN_DIM, NPROJ / 32, (bf16*)(a.ws + WS_WIN), scr, r, c.lane, a.norm_mix_g + (size_t)l * D); continue; } r -= I_IN;
        if (r < I_OUT) { transpose_item(a.w_out + (size_t)l * D * D, D, D, D / 32, (bf16*)(a.ws + WS_WOUT), scr, r, c.lane); continue; } r -= I_OUT;
        if (r < I_UP) { transpose_item(a.w_up + (size_t)l * D * FF, D, FF, FF / 32, (bf16*)(a.ws + WS_WUP), scr, r, c.lane, a.norm_mlp_g + (size_t)l * D); continue; } r -= I_UP;
        transpose_item(a.w_down + (size_t)l * FF * D, FF, D, D / 32, (bf16*)(a.ws + WS_WDN), scr, r, c.lane);
    }
}

__device__ __forceinline__ void build_kv_image(const Args& a, int w, int nw, int tid, int l) {
    bf16* SK = (bf16*)(a.ws + WS_SK + (size_t)(l & 1) * SKV_IMG); bf16* SV = (bf16*)(a.ws + WS_SV + (size_t)(l & 1) * SKV_IMG);
    const unsigned gt = (unsigned)w * NTHREADS + tid, NT = (unsigned)nw * NTHREADS;
    constexpr unsigned NCH = (unsigned)SBATCH * 512 * 1024 / 8;
    for (unsigned i = gt; i < 2 * NCH; i += NT) {
        const bool isv = i >= NCH; const unsigned j = isv ? i - NCH : i; const unsigned e = j * 8; const unsigned b = e / (512 * 1024); const unsigned rem = e % (512 * 1024);
        const float* src = (isv ? a.cache_v : a.cache_k) + ((size_t)(l * SBATCH + b) * 512 * 1024) + rem;
        const f32x4 x0 = *(const f32x4*)src, x1 = *(const f32x4*)(src + 4);
        u32x4 w4; w4.x = cvtpk(x0.x, x0.y); w4.y = cvtpk(x0.z, x0.w); w4.z = cvtpk(x1.x, x1.y); w4.w = cvtpk(x1.z, x1.w);
        *(u32x4*)((isv ? SV : SK) + (size_t)b * SKV_ROWS * 1024 + rem) = w4;
    }
    constexpr unsigned NZ = (unsigned)SBATCH * (SKV_ROWS - 544) * 1024 / 8;
    for (unsigned i = gt; i < 2 * NZ; i += NT) {
        const bool isv = i >= NZ; const unsigned j = isv ? i - NZ : i; const unsigned e = j * 8; const unsigned b = e / ((SKV_ROWS - 544) * 1024); const unsigned rem = e % ((SKV_ROWS - 544) * 1024);
        { const unsigned z = __float_as_uint(opaque_zero()); *(u32x4*)((isv ? SV : SK) + ((size_t)b * SKV_ROWS + 544) * 1024 + rem) = (u32x4){z, z, z, z}; }
    }
}
__device__ __forceinline__ float log_sigmoid(float x) { return fminf(x, 0.f) - fast_log(1.0f + fast_exp(-fabsf(x))); }
template <bool FIRST  >
__device__ __forceinline__ void phase_norm(const Args& a, const Ctx& c_in0, int l) {
    const Ctx c = relaunder(c_in0);
    bf16* XB = (bf16*)(a.ws + WS_XB); bf16* H = (bf16*)(a.ws + WS_H);
    const float* g = (FIRST ? a.norm_mix_g : a.norm_mlp_g) + (size_t)l * D;
    LAS float* Wg = (LAS float*)c.lds;
    if (FIRST) {
        convert_weights(a, c, l);
        __syncthreads();
        const float* wsrc = a.w_in + (size_t)l * D * IN_DIM + NPROJ;
        for (int idx = c.tid; idx < 8 * D; idx += NTHREADS) { const int k = idx >> 3, o = idx & 7; Wg[o * D + k] = wsrc[(size_t)k * IN_DIM + o]; }
        __syncthreads();
    }
    const int gw = c.vcu * NWAVES + c.wave, NGW = c.G * NWAVES;
    f32x4 gv[8];
#pragma unroll
    for (int j = 0; j < 8; ++j) gv[j] = *(const f32x4*)(g + 4 * c.lane + 256 * j);
    for (int row = gw; row < MR; row += NGW) {
        f32x4 v[8]; float s = 0.f;
        if (FIRST && l == 0) {
            const float* src = row < MP ? a.x_prompt + (size_t)row * D : a.x_sample + (size_t)(row - MP) * D;
#pragma unroll
            for (int j = 0; j < 8; ++j) v[j] = *(const f32x4*)(src + 4 * c.lane + 256 * j);
#pragma unroll
            for (int j = 0; j < 8; ++j) { u32x2 w; w.x = cvtpk(v[j].x, v[j].y); w.y = cvtpk(v[j].z, v[j].w); *(u32x2*)(XB + (size_t)row * D + 4 * c.lane + 256 * j) = w; }
        } else {
            u32x2 w[8];
#pragma unroll
            for (int j = 0; j < 8; ++j) w[j] = *(const u32x2*)(XB + (size_t)row * D + 4 * c.lane + 256 * j);
#pragma unroll
            for (int j = 0; j < 8; ++j) v[j] = (f32x4){bflo(w[j].x), bfhi(w[j].x), bflo(w[j].y), bfhi(w[j].y)};
        }
#pragma unroll
        for (int j = 0; j < 8; ++j) s += (v[j].x * v[j].x + v[j].y * v[j].y) + (v[j].z * v[j].z + v[j].w * v[j].w);
        const float rstd = fast_rsqrt(wave_sum(s, c.lane) * (1.f / D) + EPS);
        if (c.lane == 0) ((float*)(a.ws + WS_RSTD))[row] = rstd;
        if (FIRST) {
#pragma unroll
            for (int j = 0; j < 8; ++j) v[j] = v[j] * rstd * gv[j];
            float ga[8];
#pragma unroll
            for (int o = 0; o < 8; ++o) { float t = 0.f;
#pragma unroll
                for (int j = 0; j < 8; ++j) { const f32x4 w4 = *(const LAS f32x4*)(Wg + o * D + 4 * c.lane + 256 * j); t += (v[j].x * w4.x + v[j].y * w4.y) + (v[j].z * w4.z + v[j].w * w4.w); }
                ga[o] = wave_sum(t, c.lane); }
            float val = ga[0];
#pragma unroll
            for (int o = 1; o < 8; ++o) val = (c.lane == o) ? ga[o] : val;
            if (c.lane < 8) {
                float r;
                if (c.lane < 4) r = val + a.b_igate[l * MH + c.lane];
                else r = log_sigmoid(val + a.b_fgate[l * MH + c.lane - 4]);
                ((float*)(a.ws + WS_GATE))[(size_t)row * 8 + c.lane] = r;
            }
        }
    }
    if (FIRST && l == 0) build_kv_image(a, c.vcu, c.G, c.tid, 0);
}

__device__ __forceinline__ float scan256_sum(float v, int tid, int lane, int wave, LAS float* tot  ) {
#pragma unroll
    for (int o = 1; o < 64; o <<= 1) { const float t = shup(v, o, lane); if (lane >= o) v += t; }
    if (lane == 63) tot[wave] = v;
    __syncthreads();
    float off = 0.f;
#pragma unroll
    for (int w = 0; w < 3; ++w) off += (w < wave) ? tot[w] : 0.f;
    __syncthreads();
    return v + off;
}
__device__ __forceinline__ float scan256_max(float v, int tid, int lane, int wave, LAS float* tot) {
#pragma unroll
    for (int o = 1; o < 64; o <<= 1) { const float t = shup(v, o, lane); if (lane >= o) v = fmaxf(v, t); }
    if (lane == 63) tot[wave] = v;
    __syncthreads();
    float off = -3.0e38f;
#pragma unroll
    for (int w = 0; w < 3; ++w) off = (w < wave) ? fmaxf(off, tot[w]) : off;
    __syncthreads();
    return fmaxf(v, off);
}

__device__ __forceinline__ void m1_unit(const Args& a, const Ctx& c_in, int l, int unit) {
    const int g = unit & 31, bh = unit >> 5, b = bh >> 2, h = bh & 3;
    const bf16* PROJ = (const bf16*)(a.ws + WS_BIG);
    const float* GATE = (const float*)(a.ws + WS_GATE);
    Ctx c = c_in; { int t_ = c.tid; asm volatile("" : "+v"(t_)); c.tid = t_; c.lane = t_ & 63; }
    LAS float* scr = (LAS float*)(c.lds + SCR_OFF);
    LAS float* W_S = scr;
    LAS float* NACC = scr + 256;
    LAS float* TOT = scr + 384;
    LAS float* SCAL = scr + 392;
    const int row0 = b * SEQ + g * 256;
    LAS float* PART = scr + 400;
    const int sr = c.tid >> 4, sc = (c.tid & 15) * 8;
    u32x4 kq8[8], vq8[8];
#pragma unroll
    for (int t = 0; t < 4; ++t)
#pragma unroll
        for (int hh = 0; hh < 2; ++hh) { const int rr = t * 64 + hh * 32 + sr; const size_t ro = (size_t)(row0 + rr) * NPROJ;
            kq8[t * 2 + hh] = *(const u32x4*)(PROJ + ro + C_MK + h * HD + sc); vq8[t * 2 + hh] = *(const u32x4*)(PROJ + ro + C_MV + h * HD + sc); }
    __syncthreads();
    float li = 0.f, lf = 0.f;
    if (c.tid < 256) { li = GATE[(size_t)(row0 + c.tid) * 8 + h]; lf = GATE[(size_t)(row0 + c.tid) * 8 + 4 + h]; }
    const float bc = scan256_sum(lf, c.tid, c.lane, c.wave, TOT);
    const float as = li - bc;
    const float am = scan256_max(c.tid < 256 ? as : -3.0e38f, c.tid, c.lane, c.wave, TOT);
    if (c.tid == 255) { SCAL[0] = am; SCAL[1] = bc; }
    __syncthreads();
    const float amax = SCAL[0], blast = SCAL[1];
    if (c.tid < 256) W_S[c.tid] = fast_exp(as - amax);
    __syncthreads();
#pragma unroll
    for (int t = 0; t < 4; ++t)
#pragma unroll
        for (int hh = 0; hh < 2; ++hh) {
            const int rr = t * 64 + hh * 32 + sr;
            const u32x4 kq = kq8[t * 2 + hh];
            const u32x4 vq = vq8[t * 2 + hh];
            const float w = W_S[rr] * 0.08838834764831845f;
            float kf[8] = {bflo(kq.x) * w, bfhi(kq.x) * w, bflo(kq.y) * w, bfhi(kq.y) * w, bflo(kq.z) * w, bfhi(kq.z) * w, bflo(kq.w) * w, bfhi(kq.w) * w};
            u32x4 kw; kw.x = cvtpk(kf[0], kf[1]); kw.y = cvtpk(kf[2], kf[3]); kw.z = cvtpk(kf[4], kf[5]); kw.w = cvtpk(kf[6], kf[7]);
            *(LAS u32x4*)(c.lds + t * 16384 + v_st(hh * 32 + sr, sc)) = kw;
            *(LAS u32x4*)(c.lds + 65536 + t * 16384 + v_st(hh * 32 + sr, sc)) = vq;
        }
    __syncthreads();
    {
        const int col = c.tid & 127, t = c.tid >> 7; float s = 0.f;
        for (int k = 0; k < 64; ++k) s += bf2f(*(const LAS bf16*)(c.lds + t * 16384 + v_st(k, col)));
        PART[c.tid] = s;
    }
    __syncthreads();
    const int Da = c.wave >> 1, Db0 = 2 * (c.wave & 1);
    f32x16 acc0 = f32x16{}, acc1 = f32x16{};
    const int vbk = (int)(uintptr_t)(c.lds) + v_rd_base(c.lane) + Da * 512;
    const int vbv = (int)(uintptr_t)(c.lds) + 65536 + v_rd_base(c.lane) + Db0 * 512;
#pragma unroll
    for (int t = 0; t < 4; ++t) {
        const int ak = vbk + t * 16384, av = vbv + t * 16384;
        const bf16x8 a0 = tr_frag<0, 0>(ak), a1 = tr_frag<0, 1>(ak), a2 = tr_frag<0, 2>(ak), a3 = tr_frag<0, 3>(ak);
        const bf16x8 b00 = tr_frag<0, 0>(av), b01 = tr_frag<0, 1>(av), b02 = tr_frag<0, 2>(av), b03 = tr_frag<0, 3>(av);
        const bf16x8 b10 = tr_frag<1, 0>(av), b11 = tr_frag<1, 1>(av), b12 = tr_frag<1, 2>(av), b13 = tr_frag<1, 3>(av);
        asm volatile("s_waitcnt lgkmcnt(0)" ::: "memory"); SBAR();
        acc0 = __builtin_amdgcn_mfma_f32_32x32x16_bf16(a0, b00, acc0, 0, 0, 0); acc1 = __builtin_amdgcn_mfma_f32_32x32x16_bf16(a0, b10, acc1, 0, 0, 0);
        acc0 = __builtin_amdgcn_mfma_f32_32x32x16_bf16(a1, b01, acc0, 0, 0, 0); acc1 = __builtin_amdgcn_mfma_f32_32x32x16_bf16(a1, b11, acc1, 0, 0, 0);
        acc0 = __builtin_amdgcn_mfma_f32_32x32x16_bf16(a2, b02, acc0, 0, 0, 0); acc1 = __builtin_amdgcn_mfma_f32_32x32x16_bf16(a2, b12, acc1, 0, 0, 0);
        acc0 = __builtin_amdgcn_mfma_f32_32x32x16_bf16(a3, b03, acc0, 0, 0, 0); acc1 = __builtin_amdgcn_mfma_f32_32x32x16_bf16(a3, b13, acc1, 0, 0, 0);
    }
    float* CL = (float*)(a.ws + WS_CLOC) + (size_t)unit * HD * HD;
    const int r32 = c.lane & 31, hi = c.lane >> 5;
#pragma unroll
    for (int r = 0; r < 16; ++r) { const int d = 32 * Da + crow(r, hi);
        CL[(size_t)d * HD + 32 * Db0 + r32] = acc0[r]; CL[(size_t)d * HD + 32 * (Db0 + 1) + r32] = acc1[r]; }
    if (c.tid < 128) ((float*)(a.ws + WS_NLOC))[(size_t)unit * HD + c.tid] = (PART[c.tid] + PART[128 + c.tid]) + (PART[256 + c.tid] + PART[384 + c.tid]);
    if (c.tid == 0) { float* ms = (float*)(a.ws + WS_MSC) + (size_t)unit * 4; ms[0] = blast + amax; ms[1] = blast; }
}

__device__ __forceinline__ void sample_mixers(const Args& a, const Ctx& c, int l);
template <bool WITH_QK>
__device__ __forceinline__ void phase_c(const Args& a, const Ctx& c_in0, int l) {
    const Ctx c = relaunder(c_in0);
    bf16* PROJ = (bf16*)(a.ws + WS_BIG); bf16* MIX = (bf16*)(a.ws + WS_H);
    constexpr int WSMP = SBATCH * NH + SBATCH * MH;
    const bool split = c.G > 2 * WSMP;
    if (WITH_QK && (!split || c.vcu < WSMP)) sample_mixers(a, c, l);
    for (int u = c.vcu; u < 16 * NGRP; u += c.G) m1_unit(a, c, l, u);
    const int gw = c.vcu * NWAVES + c.wave, NGW = c.G * NWAVES;
    if (WITH_QK) {
        const float* gq = a.q_norm_g + l * HD; const float* gk = a.k_norm_g + l * HD;
        const int gi = (16 * c.lane) & 127;
        f32x4 gqv[4], gkv[4];
#pragma unroll
        for (int j = 0; j < 4; ++j) { gqv[j] = *(const f32x4*)(gq + gi + 4 * j); gkv[j] = *(const f32x4*)(gk + gi + 4 * j); }
        bf16* SK = (bf16*)(a.ws + WS_SK + (size_t)(l & 1) * SKV_IMG); bf16* SV = (bf16*)(a.ws + WS_SV + (size_t)(l & 1) * SKV_IMG);
        constexpr int NIT = NB * KEEP;
        for (int it = gw; it < NIT; it += NGW) {
            const int row = (it / KEEP) * SEQ + (SEQ - KEEP) + (it % KEEP);
            const bf16* p = PROJ + (size_t)row * NPROJ + C_K + 16 * c.lane;
            const u32x4 w0 = *(const u32x4*)p, w1 = *(const u32x4*)(p + 8);
            const bf16* pv = PROJ + (size_t)row * NPROJ + C_V + 16 * c.lane;
            const u32x4 v0 = *(const u32x4*)pv, v1 = *(const u32x4*)(pv + 8);
            const int b = row / SEQ, t = row % SEQ; const size_t o = ((size_t)(l * NB + b) * KEEP + (t - (SEQ - KEEP))) * 1024 + 16 * c.lane;
            float* ok = a.out + O_PK + o; float* ov = a.out + O_PV + o;
            *(f32x4*)(ok + 0) = (f32x4){bflo(w0.x), bfhi(w0.x), bflo(w0.y), bfhi(w0.y)}; *(f32x4*)(ok + 4) = (f32x4){bflo(w0.z), bfhi(w0.z), bflo(w0.w), bfhi(w0.w)};
            *(f32x4*)(ok + 8) = (f32x4){bflo(w1.x), bfhi(w1.x), bflo(w1.y), bfhi(w1.y)}; *(f32x4*)(ok + 12) = (f32x4){bflo(w1.z), bfhi(w1.z), bflo(w1.w), bfhi(w1.w)};
            *(f32x4*)(ov + 0) = (f32x4){bflo(v0.x), bfhi(v0.x), bflo(v0.y), bfhi(v0.y)}; *(f32x4*)(ov + 4) = (f32x4){bflo(v0.z), bfhi(v0.z), bflo(v0.w), bfhi(v0.w)};
            *(f32x4*)(ov + 8) = (f32x4){bflo(v1.x), bfhi(v1.x), bflo(v1.y), bfhi(v1.y)}; *(f32x4*)(ov + 12) = (f32x4){bflo(v1.z), bfhi(v1.z), bflo(v1.w), bfhi(v1.w)};
        }
    }
    {
        const int ch = 8 * c.lane;
        float w0[8], w1[8], w2[8];
#pragma unroll
        for (int i = 0; i < 8; ++i) { w0[i] = a.conv_w[(size_t)(l * 3 + 0) * 512 + ch + i]; w1[i] = a.conv_w[(size_t)(l * 3 + 1) * 512 + ch + i]; w2[i] = a.conv_w[(size_t)(l * 3 + 2) * 512 + ch + i]; }
        constexpr int NSEG = SEQ / 32, NITEM = NB * NSEG + SBATCH;
        const int gwc = split ? (c.vcu - WSMP) * NWAVES + c.wave : gw, NGWc = split ? (c.G - WSMP) * NWAVES : NGW;
        for (int it = gwc; it >= 0 && it < NITEM; it += NGWc) {
            float u2[8], u1[8]; int rowb; bool samp = it >= NB * NSEG; int b, seg = 0;
            if (!samp) { b = it / NSEG; seg = it % NSEG; rowb = b * SEQ + seg * 32; } else { b = it - NB * NSEG; rowb = MP + b * SSEQ; }
#pragma unroll
            for (int i = 0; i < 8; ++i) { u2[i] = 0.f; u1[i] = 0.f; }
            if (samp) {
#pragma unroll
                for (int i = 0; i < 8; ++i) { u2[i] = a.state_conv[((size_t)(l * SBATCH + b) * 2 + 0) * 512 + ch + i]; u1[i] = a.state_conv[((size_t)(l * SBATCH + b) * 2 + 1) * 512 + ch + i]; }
            } else if (seg > 0) {
#pragma unroll
                for (int q = 0; q < 2; ++q) { const bf16* pr = PROJ + (size_t)(rowb - 2 + q) * NPROJ + ch;
                    const u32x4 xa = *(const u32x4*)(pr + C_XA), gc = *(const u32x4*)(pr + C_GC);
                    float* dst = q ? u1 : u2;
                    dst[0] = bflo(xa.x) * bflo(gc.x); dst[1] = bfhi(xa.x) * bfhi(gc.x); dst[2] = bflo(xa.y) * bflo(gc.y); dst[3] = bfhi(xa.y) * bfhi(gc.y);
                    dst[4] = bflo(xa.z) * bflo(gc.z); dst[5] = bfhi(xa.z) * bfhi(gc.z); dst[6] = bflo(xa.w) * bflo(gc.w); dst[7] = bfhi(xa.w) * bfhi(gc.w); }
            }
            for (int t0 = 0; t0 < 32; t0 += 4) {
                u32x4 xa4[4], gb4[4], gc4[4];
#pragma unroll
                for (int q = 0; q < 4; ++q) { const bf16* pr = PROJ + (size_t)(rowb + t0 + q) * NPROJ + ch; xa4[q] = *(const u32x4*)(pr + C_XA); gb4[q] = *(const u32x4*)(pr + C_GB); gc4[q] = *(const u32x4*)(pr + C_GC); }
#pragma unroll
                for (int q = 0; q < 4; ++q) { const int t = t0 + q;
                const u32x4 xa = xa4[q], gb = gb4[q], gc = gc4[q];
                float u0[8] = {bflo(xa.x) * bflo(gc.x), bfhi(xa.x) * bfhi(gc.x), bflo(xa.y) * bflo(gc.y), bfhi(xa.y) * bfhi(gc.y),
                               bflo(xa.z) * bflo(gc.z), bfhi(xa.z) * bfhi(gc.z), bflo(xa.w) * bflo(gc.w), bfhi(xa.w) * bfhi(gc.w)};
                float gbf[8] = {bflo(gb.x), bfhi(gb.x), bflo(gb.y), bfhi(gb.y), bflo(gb.z), bfhi(gb.z), bflo(gb.w), bfhi(gb.w)};
                float y[8];
#pragma unroll
                for (int i = 0; i < 8; ++i) { y[i] = gbf[i] * (w0[i] * u2[i] + w1[i] * u1[i] + w2[i] * u0[i]); u2[i] = u1[i]; u1[i] = u0[i]; }
                u32x4 o; o.x = cvtpk(y[0], y[1]); o.y = cvtpk(y[2], y[3]); o.z = cvtpk(y[4], y[5]); o.w = cvtpk(y[6], y[7]);
                *(u32x4*)(MIX + (size_t)(rowb + t) * D + ch) = o;
                }
            }
            float* oc = nullptr;
            if (samp) oc = a.out + O_SCONV + (size_t)(l * SBATCH + b) * 2 * 512 + ch;
            else if (seg == NSEG - 1) oc = a.out + O_PCONV + (size_t)(l * NB + b) * 2 * 512 + ch;
            if (oc) {
                *(f32x4*)(oc) = (f32x4){u2[0], u2[1], u2[2], u2[3]}; *(f32x4*)(oc + 4) = (f32x4){u2[4], u2[5], u2[6], u2[7]};
                *(f32x4*)(oc + 512) = (f32x4){u1[0], u1[1], u1[2], u1[3]}; *(f32x4*)(oc + 516) = (f32x4){u1[4], u1[5], u1[6], u1[7]};
            }
        }
    }
}

__device__ __forceinline__ void phase_d(const Args& a, const Ctx& c_in0, int l) {
    const Ctx c = relaunder(c_in0);
    const float* CL = (const float*)(a.ws + WS_CLOC); const float* NL = (const float*)(a.ws + WS_NLOC); float* MSC = (float*)(a.ws + WS_MSC);
    bf16* C0 = (bf16*)(a.ws + WS_C0); float* N0 = (float*)(a.ws + WS_N0);
    LAS float* DEC = (LAS float*)(c.lds + SCR_OFF);
    LAS float* WLO = DEC + 512;
    LAS float* MFIN = WLO + 512;
    LAS float* MLO = MFIN + 16;
    LAS float* BLA = MLO + 512;
    __syncthreads();
    { const int u = c.tid; MLO[u] = MSC[(size_t)u * 4 + 0]; BLA[u] = MSC[(size_t)u * 4 + 1]; }
    __syncthreads();
    if (c.tid < 16) { const int bh = c.tid; float m = 0.f;
        for (int g = 0; g < NGRP; ++g) { const size_t u = (size_t)bh * NGRP + g; const float mloc = MLO[u], blast = BLA[u];
            const float mn = fmaxf(blast + m, mloc); DEC[bh * NGRP + g] = fast_exp(blast + m - mn); WLO[bh * NGRP + g] = fast_exp(mloc - mn);
            if (c.vcu == 0) MSC[u * 4 + 2] = m;
            m = mn; }
        MFIN[bh] = m; }
    __syncthreads();
    const unsigned gt = (unsigned)c.vcu * NTHREADS + c.tid, NT = (unsigned)c.G * NTHREADS;
    constexpr unsigned PER = (unsigned)HD * HD + HD;
    for (unsigned i = gt; i < 16u * PER; i += NT) {
        const int bh = (int)(i / PER); const int e = (int)(i % PER); const bool isn = e >= HD * HD; const int en = e - HD * HD;
        const float* src = isn ? NL + (size_t)bh * NGRP * HD + en : CL + (size_t)bh * NGRP * HD * HD + e;
        const size_t sstep = isn ? HD : (size_t)HD * HD;
        float x[NGRP];
#pragma unroll
        for (int g = 0; g < NGRP; ++g) x[g] = src[(size_t)g * sstep];
        float C = 0.f;
#pragma unroll
        for (int g = 0; g < NGRP; ++g) {
            const size_t u = (size_t)bh * NGRP + g;
            if (isn) N0[u * HD + en] = C; else C0[u * HD * HD + e] = (bf16)(cvtpk(C, 0.f) & 0xffffu);
            C = DEC[bh * NGRP + g] * C + WLO[bh * NGRP + g] * x[g];
        }
        const int b = bh >> 2, h = bh & 3;
        if (isn) a.out[O_PN + ((size_t)(l * NB + b) * MH + h) * HD + en] = C;
        else a.out[O_PC + ((size_t)(l * NB + b) * MH + h) * HD * HD + e] = C;
        if (e == 0) a.out[O_PM + (size_t)(l * NB + b) * MH + h] = MFIN[bh];
    }
}

constexpr float ATT_C = 0.088388347648318440f * LOG2E;
constexpr float THR2 = 8.f * LOG2E;
struct DmaMap { unsigned k0, k1, v0, v1; };
__device__ __forceinline__ DmaMap dma_map(int lane, int wave, int LD) {
    DmaMap m; unsigned kk_[2], vv_[2];
#pragma unroll
    for (int i = 0; i < 2; ++i) { const int o = (wave + 8 * i) * 1024 + lane * 16;
        const int row = o >> 8, c16 = ((o >> 4) & 15) ^ (row & 7); kk_[i] = (unsigned)(row * LD + c16 * 8) * 2u;
        const int sub = o >> 9, kk = ((sub >> 2) << 3) | ((o >> 6) & 7), k = (kk & ~0xC) | ((kk & 4) << 1) | ((kk & 8) >> 1), cc = ((sub & 3) << 5) | ((o & 63) >> 1); vv_[i] = (unsigned)(k * LD + cc) * 2u; }
    m.k0 = kk_[0]; m.k1 = kk_[1]; m.v0 = vv_[0]; m.v1 = vv_[1]; return m;
}
__device__ __forceinline__ void glds16s(const void* sbase, unsigned voff, unsigned lds_dst) { unsigned keep;
    asm volatile("s_mov_b32 %0, m0\n\ts_mov_b32 m0, %3\n\ts_nop 0\n\tglobal_load_lds_dwordx4 %1, %2\n\ts_mov_b32 m0, %0" : "=&s"(keep) : "v"(voff), "s"(sbase), "s"(lds_dst) : "memory"); }
__device__ __forceinline__ void dma_fill(LAS unsigned char* lds, int slot, int wave, const bf16* Ta, unsigned a0, unsigned a1, const bf16* Tb, unsigned b0, unsigned b1) {
    const unsigned d = (unsigned)(uintptr_t)lds + (unsigned)(slot * 32768 + wave * 1024);
    glds16s(Ta, a0, d); glds16s(Ta, a1, d + 8192u); glds16s(Tb, b0, d + 16384u); glds16s(Tb, b1, d + 24576u);
}
#define RING_WAIT_BAR(N) do { asm volatile("s_waitcnt vmcnt(" #N ") lgkmcnt(0)" ::: "memory"); __builtin_amdgcn_s_barrier(); asm volatile("" ::: "memory"); } while (0)

__device__ __forceinline__ float fma_s(float a, float b, float c) { float d; asm("v_fma_f32 %0, %1, %2, %3" : "=v"(d) : "v"(a), "v"(b), "v"(c)); return d; }
__device__ __forceinline__ float add_s(float a, float b) { float d; asm("v_add_f32 %0, %1, %2" : "=v"(d) : "v"(a), "v"(b)); return d; }
#define ATT_SCORE_SOFTMAX(j, slotk)                                                                                                           \
    {   const int K_lds = ldsb + (slotk) * 16384;                                                                                              \
        f32x16 p0, p1; qkt(p0, p1, K_lds, qr, r32, hi);                                                                                       \
        STEP_FILL();                                                             \
        const int Rl = R0 + r32 - 64 * (j);                                                                                                   \
        const int relmin = R0 - 64 * (j) - 63;                                                                                                \
        if (relmin >= 128) { const float bc = BR[0];                                                                                           \
            _Pragma("unroll") for (int r = 0; r < 16; ++r) { p0[r] = fma_s(p0[r], ATT_C, bc); p1[r] = fma_s(p1[r], ATT_C, bc); }                \
        } else {                                                                                                                               \
            const LAS float* bp = BR + (64 + 128 - Rl + 4 * hi);                                                                               \
            _Pragma("unroll") for (int r = 0; r < 16; ++r) { p0[r] = fma_s(p0[r], ATT_C, bp[(r & 3) + 8 * (r >> 2)]); p1[r] = fma_s(p1[r], ATT_C, bp[32 + (r & 3) + 8 * (r >> 2)]); } \
        }                                                                                                                                      \
        const int nvalid = kend - 64 * (j);                                                                                                    \
        if (nvalid < 64) { asm volatile("" ::: "memory");                           \
            _Pragma("unroll") for (int r = 0; r < 16; ++r) { const int kk = crow(r, hi); if (kk >= nvalid) p0[r] = -1e30f; if (kk + 32 >= nvalid) p1[r] = -1e30f; } \
        }                                                                                                                                      \
        float pmax = p0[0];                                                                                                                    \
        _Pragma("unroll") for (int r = 1; r < 16; ++r) pmax = fmaxf(pmax, p0[r]);                                                              \
        _Pragma("unroll") for (int r = 0; r < 16; ++r) pmax = fmaxf(pmax, p1[r]);                                                              \
        pmax = half_swap_max(pmax);                                                                                                            \
        if (!__all(pmax - m_reg <= THR2)) {                                                                                                    \
            const float mn = fmaxf(m_reg, pmax); const float alpha = __builtin_amdgcn_exp2f(m_reg - mn); m_reg = mn;                           \
            l_reg *= alpha;                                                                                                                    \
            if (hi == 0) al_l[r32] = alpha; asm volatile("s_waitcnt lgkmcnt(0)" ::: "memory");                                               \
            _Pragma("unroll") for (int r = 0; r < 16; ++r) { const float al = al_l[crow(r, hi)];                                               \
                _Pragma("unroll") for (int d = 0; d < 4; ++d) o[d][r] *= al; }                                                                 \
        }                                                                                                                                      \
        float ps = 0.f;                                                                                                                        \
        _Pragma("unroll") for (int r = 0; r < 16; ++r) { p0[r] = __builtin_amdgcn_exp2f(p0[r] - m_reg); p1[r] = __builtin_amdgcn_exp2f(p1[r] - m_reg); ps = add_s(ps, add_s(p0[r], p1[r])); } \
        l_reg += half_swap_add(ps);                                                                                                            \
        PK4(p0, 0, pa0); PK4(p0, 8, pa1); PK4(p1, 0, pa2); PK4(p1, 8, pa3);                                                                    \
    }
__device__ __forceinline__ void attn_unit(const Ctx& c, const bf16* __restrict__ Qb, int LDQ, int qrow, const bf16* __restrict__ Kh, const bf16* __restrict__ Vh, int LDK, int NT, int alo, int ahi, int kend,
                                          int R0  , const float* __restrict__ bias_g, bf16* __restrict__ Ob, int LDO, bool do_store, const float* __restrict__ qgain = nullptr, int rot = 0) {
    int tid = c.tid; asm volatile("" : "+v"(tid));
    const int wid = c.wave, lane = tid & 63, r32 = lane & 31, hi = lane >> 5;
    const int ldsb = (int)(uintptr_t)c.lds;
    constexpr int VRING = 49152;
    LAS float* wsf = (LAS float*)(c.lds + 114688) + wid * 64; LAS float* li_l = wsf; LAS float* al_l = wsf + 32;
    LAS float* BR = (LAS float*)(c.lds + SCR_OFF);
    asm volatile("s_waitcnt lgkmcnt(0)" ::: "memory"); __builtin_amdgcn_s_barrier(); asm volatile("" ::: "memory");
    const DmaMap dm = dma_map(lane, wid, LDK);
    const size_t tile_step = (size_t)64 * LDK;
    const unsigned dbase = (unsigned)ldsb + (unsigned)wid * 1024u;
#define ATT_FILL(kt_, vt_, sk_, sv_) do { const unsigned dk_ = dbase + (unsigned)(sk_) * 16384u, dv_ = dbase + VRING + (unsigned)(sv_) * 16384u; \
        glds16s(kt_, dm.k0, dk_); glds16s(kt_, dm.k1, dk_ + 8192u); glds16s(vt_, dm.v0, dv_); glds16s(vt_, dm.v1, dv_ + 8192u); } while (0)
#define TIDX(s_) ((s_) + rot - (((s_) + rot) >= NT ? NT : 0))
    { const int t0_ = TIDX(0), t1_ = TIDX(1);
      ATT_FILL(Kh + t0_ * tile_step, Vh + t0_ * tile_step, 0, 0);
      ATT_FILL(Kh + t1_ * tile_step, Vh + t1_ * tile_step, 1, 1); }
    if (tid < 321) { const int i = tid - 64; BR[tid] = bias_g[256 - (i < 0 ? 0 : i)] * LOG2E; }
    float m_reg = -1e30f, l_reg = 0.f; f32x16 o[4] = {f32x16{}, f32x16{}, f32x16{}, f32x16{}}; bf16x8 qr[8];
    { const bf16* Qw = Qb + (size_t)(qrow + r32) * LDQ + hi * 8;
#pragma unroll
      for (int d0 = 0; d0 < 8; ++d0) qr[d0] = *(const bf16x8*)(Qw + d0 * 16); }
    if (qgain) {
        float f[8][8]; float ss = 0.f;
#pragma unroll
        for (int d0 = 0; d0 < 8; ++d0) { const u32x4 w = *reinterpret_cast<const u32x4*>(&qr[d0]);
            f[d0][0] = bflo(w.x); f[d0][1] = bfhi(w.x); f[d0][2] = bflo(w.y); f[d0][3] = bfhi(w.y); f[d0][4] = bflo(w.z); f[d0][5] = bfhi(w.z); f[d0][6] = bflo(w.w); f[d0][7] = bfhi(w.w);
#pragma unroll
            for (int i = 0; i < 8; ++i) ss += f[d0][i] * f[d0][i]; }
        ss = half_swap_add(ss);
        const float rq = fast_rsqrt(ss * (1.f / HD) + EPS);
#pragma unroll
        for (int d0 = 0; d0 < 8; ++d0) { const f32x4 g0 = *(const f32x4*)(qgain + d0 * 16 + hi * 8), g1 = *(const f32x4*)(qgain + d0 * 16 + hi * 8 + 4);
            u32x4 s; s.x = cvtpk(f[d0][0] * rq * g0[0], f[d0][1] * rq * g0[1]); s.y = cvtpk(f[d0][2] * rq * g0[2], f[d0][3] * rq * g0[3]);
            s.z = cvtpk(f[d0][4] * rq * g1[0], f[d0][5] * rq * g1[1]); s.w = cvtpk(f[d0][6] * rq * g1[2], f[d0][7] * rq * g1[3]);
            qr[d0] = *reinterpret_cast<bf16x8*>(&s); }
    }
#pragma unroll
    for (int d0 = 0; d0 < 8; ++d0) { u32x4 w = *reinterpret_cast<u32x4*>(&qr[d0]); asm volatile("" : "+v"(w)); qr[d0] = *reinterpret_cast<bf16x8*>(&w); }
    asm volatile("" ::: "memory");
    const bool skew = wid >= 4;
    bf16x8 pa0 = bf16x8{}, pa1 = bf16x8{}, pa2 = bf16x8{}, pa3 = bf16x8{};
    int sk = 0, sv = 0;
    bool pact = false;
    for (int j = 0; j < NT; ++j) {
        if (j + 1 < NT) RING_WAIT_BAR(4); else RING_WAIT_BAR(0);
#define STEP_FILL() do { if (j + 2 < NT) { const int fk = sk >= 1 ? sk - 1 : 2, fv = sv >= 2 ? sv - 2 : sv + 2; const int tf = TIDX(j + 2); ATT_FILL(Kh + tf * tile_step, Vh + tf * tile_step, fk, fv); } } while (0)
        const int jt = TIDX(j);
        const bool act = (jt >= alo && jt <= ahi);
        if (skew && pact) { const int svp = sv >= 1 ? sv - 1 : 3; pv_d0(o, ldsb + VRING + svp * 16384 + v_rd_base(lane), pa0, pa1, pa2, pa3); }
        pact = act;
        if (act) { ATT_SCORE_SOFTMAX(jt, sk); } else STEP_FILL();
        if (!skew && act) pv_d0(o, ldsb + VRING + sv * 16384 + v_rd_base(lane), pa0, pa1, pa2, pa3);
        sk = sk == 2 ? 0 : sk + 1; sv = (sv + 1) & 3;
    }
    if (skew && pact) { const int svp = sv >= 1 ? sv - 1 : 3; pv_d0(o, ldsb + VRING + svp * 16384 + v_rd_base(lane), pa0, pa1, pa2, pa3); }
#undef STEP_FILL
#undef TIDX
#undef ATT_FILL
    if (hi == 0) li_l[r32] = l_reg;
    RING_WAIT_BAR(0);
    const int ost = ldsb + wid * 8192;
#pragma unroll
    for (int r = 0; r < 16; ++r) { const int orow = crow(r, hi); const float rl = __builtin_amdgcn_rcpf(li_l[orow]);
#pragma unroll
        for (int d0 = 0; d0 < 4; ++d0) *(LAS bf16*)(uintptr_t)(unsigned)(ost + orow * 256 + (d0 * 32 + r32) * 2) = (bf16)(cvtpk(o[d0][r] * rl, 0.f) & 0xffffu); }
    asm volatile("s_waitcnt lgkmcnt(0)" ::: "memory");
    if (do_store) {
#pragma unroll
        for (int i = 0; i < 8; ++i) { const int ch = i * 64 + lane, row = ch >> 4, c16 = ch & 15;
            const u32x4 w = *(const LAS u32x4*)(uintptr_t)(unsigned)(ost + row * 256 + c16 * 16);
            *(u32x4*)(Ob + (size_t)(qrow + row) * LDO + c16 * 8) = w; }
    }
}
__device__ __forceinline__ void attn_stream(const Args& a, const Ctx& c, int l) {
    constexpr int NATT = NB * NH * 32;
    if (c.vcu >= NATT) return;
    int tid = c.tid; asm volatile("" : "+v"(tid));
    const int wid = c.wave, lane = tid & 63, r32 = lane & 31, hi = lane >> 5;
    const int ldsb = (int)(uintptr_t)c.lds;
    constexpr int VRING = 49152;
    LAS float* wsf = (LAS float*)(c.lds + 114688) + wid * 64; LAS float* li_l = wsf; LAS float* al_l = wsf + 32;
    LAS float* BR = (LAS float*)(c.lds + SCR_OFF);
    const bf16* PROJ = (const bf16*)(a.ws + WS_BIG); bf16* MIX = (bf16*)(a.ws + WS_H);
    const int gq = c.vcu & 31, h = (c.vcu >> 5) & 7, b0 = c.vcu >> 8, db = c.G >> 8, nun = (NB - b0 + db - 1) / db;
    const int c0 = 4 * gq, jstart = c0 >= 8 ? 0 : 8 - c0, NT = 12 - jstart, ci = wid >> 1;
    const int alo = ci - jstart < 0 ? 0 : ci - jstart, ahi = ci + 8 - jstart, kend = NT * 64;
    const int R0 = (ci + 8 - jstart) * 64 + (wid & 1) * 32, rot = gq >= 2 ? (8 * gq + 8) % 12 : 0, qrow = wid * 32;
    const float* bias_g = a.rel_bias + (size_t)(l * NH + h) * 257;
    constexpr int LDK = NPROJ, LDO = D;
    asm volatile("s_waitcnt lgkmcnt(0)" ::: "memory"); __builtin_amdgcn_s_barrier(); asm volatile("" ::: "memory");
    const DmaMap dm = dma_map(lane, wid, LDK);
    const size_t tile_step = (size_t)64 * LDK;
    const unsigned dbase = (unsigned)ldsb + (unsigned)wid * 1024u;
#define ATT_FILL(kt_, vt_, sk_, sv_) do { const unsigned dk_ = dbase + (unsigned)(sk_) * 16384u, dv_ = dbase + VRING + (unsigned)(sv_) * 16384u; \
        glds16s(kt_, dm.k0, dk_); glds16s(kt_, dm.k1, dk_ + 8192u); glds16s(vt_, dm.v0, dv_); glds16s(vt_, dm.v1, dv_ + 8192u); } while (0)
#define TIDX(s_) ((s_) + rot - (((s_) + rot) >= NT ? NT : 0))
    const bf16* Qb = PROJ + (size_t)(b0 * SEQ + c0 * 64) * NPROJ + C_Q + h * HD;
    const bf16* Kh = PROJ + (size_t)(b0 * SEQ + (c0 - 8 + jstart) * 64) * NPROJ + C_K + h * HD;
    const bf16* Vh = PROJ + (size_t)(b0 * SEQ + (c0 - 8 + jstart) * 64) * NPROJ + C_V + h * HD;
    bf16* Ob = MIX + (size_t)(b0 * SEQ + c0 * 64) * D + 512 + h * HD;
    const size_t dproj = (size_t)db * SEQ * NPROJ, dmix = (size_t)db * SEQ * D;
    { const int t0_ = TIDX(0), t1_ = TIDX(1);
      ATT_FILL(Kh + t0_ * tile_step, Vh + t0_ * tile_step, 0, 0);
      ATT_FILL(Kh + t1_ * tile_step, Vh + t1_ * tile_step, 1, 1); }
    if (tid < 321) { const int i = tid - 64; BR[tid] = bias_g[256 - (i < 0 ? 0 : i)] * LOG2E; }
    bf16x8 qr[8];
    { const bf16* Qw = Qb + (size_t)(qrow + r32) * NPROJ + hi * 8;
#pragma unroll
      for (int d0 = 0; d0 < 8; ++d0) qr[d0] = *(const bf16x8*)(Qw + d0 * 16); }
    const bool skew = wid >= 4;
    int sk = 0, sv = 0;
#pragma unroll 1
    for (int ui = 0; ui < nun; ++ui) {
        const bool has_next = ui + 1 < nun;
        const bf16* Khn = Kh + dproj; const bf16* Vhn = Vh + dproj;
#pragma unroll
        for (int d0 = 0; d0 < 8; ++d0) { u32x4 w = *reinterpret_cast<u32x4*>(&qr[d0]); asm volatile("" : "+v"(w)); qr[d0] = *reinterpret_cast<bf16x8*>(&w); }
        asm volatile("" ::: "memory");
        float m_reg = -1e30f, l_reg = 0.f; f32x16 o[4] = {f32x16{}, f32x16{}, f32x16{}, f32x16{}};
        bf16x8 pa0 = bf16x8{}, pa1 = bf16x8{}, pa2 = bf16x8{}, pa3 = bf16x8{};
        bool pact = false;
        for (int j = 0; j < NT; ++j) {
            if (j + 1 < NT || has_next) RING_WAIT_BAR(4); else RING_WAIT_BAR(0);
#define STEP_FILL() do { const int fk = sk >= 1 ? sk - 1 : 2, fv = sv >= 2 ? sv - 2 : sv + 2;                                                                  \
                if (j + 2 < NT) { const int tf = TIDX(j + 2); ATT_FILL(Kh + tf * tile_step, Vh + tf * tile_step, fk, fv); }                                         \
                else if (has_next) { const int tf = TIDX(j + 2 - NT); ATT_FILL(Khn + tf * tile_step, Vhn + tf * tile_step, fk, fv); } } while (0)
            const int jt = TIDX(j);
            const bool act = (jt >= alo && jt <= ahi);
            if (skew && pact) { const int svp = sv >= 1 ? sv - 1 : 3; pv_d0(o, ldsb + VRING + svp * 16384 + v_rd_base(lane), pa0, pa1, pa2, pa3); }
            pact = act;
            if (act) { ATT_SCORE_SOFTMAX(jt, sk); } else STEP_FILL();
            if (!skew && act) pv_d0(o, ldsb + VRING + sv * 16384 + v_rd_base(lane), pa0, pa1, pa2, pa3);
            sk = sk == 2 ? 0 : sk + 1; sv = (sv + 1) & 3;
        }
        if (skew && pact) { const int svp = sv >= 1 ? sv - 1 : 3; pv_d0(o, ldsb + VRING + svp * 16384 + v_rd_base(lane), pa0, pa1, pa2, pa3); }
#undef STEP_FILL
        if (has_next) { const bf16* Qw = Qb + dproj + (size_t)(qrow + r32) * NPROJ + hi * 8;
#pragma unroll
            for (int d0 = 0; d0 < 8; ++d0) qr[d0] = *(const bf16x8*)(Qw + d0 * 16); }
        if (hi == 0) li_l[r32] = l_reg;
        asm volatile("s_waitcnt lgkmcnt(0)" ::: "memory"); __builtin_amdgcn_s_barrier(); asm volatile("" ::: "memory");
        const int ost = ldsb + VRING + (((wid < 4 ? sv + 2 : sv + 3) & 3) * 16384) + (wid & 3) * 4096;
#pragma unroll
        for (int hf = 0; hf < 2; ++hf) {
#pragma unroll
            for (int r = 0; r < 16; ++r) { const int orow = crow(r, hi); const float rl = __builtin_amdgcn_rcpf(li_l[orow]);
#pragma unroll
                for (int dd = 0; dd < 2; ++dd) *(LAS bf16*)(uintptr_t)(unsigned)(ost + orow * 128 + (dd * 32 + r32) * 2) = (bf16)(cvtpk(o[2 * hf + dd][r] * rl, 0.f) & 0xffffu); }
            asm volatile("s_waitcnt lgkmcnt(0)" ::: "memory");
#pragma unroll
            for (int i = 0; i < 4; ++i) { const int ch = i * 64 + lane, row = ch >> 3, c16 = ch & 7;
                const u32x4 w = *(const LAS u32x4*)(uintptr_t)(unsigned)(ost + row * 128 + c16 * 16);
                *(u32x4*)(Ob + (size_t)(qrow + row) * LDO + hf * 64 + c16 * 8) = w; }
            asm volatile("s_waitcnt lgkmcnt(0)" ::: "memory");
        }
        Qb += dproj; Kh += dproj; Vh += dproj; Ob += dmix;
    }
#undef TIDX
#undef ATT_FILL
}
#undef ATT_SCORE_SOFTMAX

__device__ __forceinline__ void m3_unit(const Args& a, const Ctx& c, int l, int unit) {
    const int g = unit & 31, bh = unit >> 5, b = bh >> 2, h = bh & 3;
    const bf16* PROJ = (const bf16*)(a.ws + WS_BIG); bf16* MIX = (bf16*)(a.ws + WS_H);
    const float* GATE = (const float*)(a.ws + WS_GATE);
    int tid = c.tid; asm volatile("" : "+v"(tid));
    const int wid = c.wave, lane = tid & 63, r32 = lane & 31, hi = lane >> 5;
    LAS float* scr = (LAS float*)(c.lds + SCR_OFF);
    LAS float* A_S = scr;
    LAS float* M_T = scr + 256;
    LAS float* B_T = scr + 512;
    LAS float* N0L = scr + 768;
    LAS float* TOT = scr + 896;
    const int ldsb = (int)(uintptr_t)c.lds;
    LAS float* wsf = (LAS float*)(c.lds + 98304) + wid * 64;
    const int row0 = b * SEQ + g * 256;
    const float m0 = ((const float*)(a.ws + WS_MSC))[(size_t)unit * 4 + 2];
    asm volatile("s_waitcnt vmcnt(0) lgkmcnt(0)" ::: "memory"); __builtin_amdgcn_s_barrier(); asm volatile("" ::: "memory");
    const DmaMap dm = dma_map(lane, wid, NPROJ); const DmaMap dc = dma_map(lane, wid, HD);
    const bf16* kt = PROJ + (size_t)row0 * NPROJ + C_MK + h * HD; const bf16* vt = PROJ + (size_t)row0 * NPROJ + C_MV + h * HD;
    const bf16* C0 = (const bf16*)(a.ws + WS_C0) + (size_t)unit * HD * HD;
    const size_t tile_step = (size_t)64 * NPROJ;
    dma_fill(c.lds, 0, wid, kt, dm.k0, dm.k1, vt, dm.v0, dm.v1);
    dma_fill(c.lds, 1, wid, kt + tile_step, dm.k0, dm.k1, vt + tile_step, dm.v0, dm.v1);
    bf16x8 qr[8];
    const int trow = wid * 32 + r32;
    { const bf16* Qw = PROJ + (size_t)(row0 + trow) * NPROJ + C_MQ + h * HD + hi * 8;
#pragma unroll
      for (int d0 = 0; d0 < 8; ++d0) qr[d0] = *(const bf16x8*)(Qw + d0 * 16); }
    u32x4 mo8[8];
#pragma unroll
    for (int i = 0; i < 8; ++i) { const int ch = i * 64 + lane, row = ch >> 4, col = (ch & 15) * 8; mo8[i] = *(const u32x4*)(PROJ + (size_t)(row0 + wid * 32 + row) * NPROJ + C_MO + h * HD + col); }
    float li = 0.f, lf = 0.f;
    if (tid < 256) { li = GATE[(size_t)(row0 + tid) * 8 + h]; lf = GATE[(size_t)(row0 + tid) * 8 + 4 + h]; }
    if (tid < 128) N0L[tid] = ((const float*)(a.ws + WS_N0))[(size_t)unit * HD + tid];
    const float bc = scan256_sum(lf, tid, lane, wid, TOT);
    const float as = li - bc;
    const float cm = scan256_max(tid < 256 ? as : -3.0e38f, tid, lane, wid, TOT);
    if (tid < 256) { A_S[tid] = as; M_T[tid] = fmaxf(m0, cm); B_T[tid] = bc; }
    __syncthreads();
    const float Mt = M_T[trow];
    f32x16 o[4] = {f32x16{}, f32x16{}, f32x16{}, f32x16{}};
    float rowsum = 0.f, qn = 0.f;
    const float winter = fast_exp(m0 - Mt);
    const int ci = wid >> 1;
    int slot = 0;
#pragma unroll 1
    for (int j = 0; j < 4; ++j) {
        RING_WAIT_BAR(4);
        { const int fs = slot >= 1 ? slot - 1 : 2;
          if (j + 2 < 4) dma_fill(c.lds, fs, wid, kt + (size_t)(j + 2) * tile_step, dm.k0, dm.k1, vt + (size_t)(j + 2) * tile_step, dm.v0, dm.v1);
          else if (j == 2) dma_fill(c.lds, fs, wid, C0, dc.v0, dc.v1, C0 + 64 * HD, dc.v0, dc.v1); }
        const int S_lds = ldsb + slot * 32768;
        int r32l = r32; asm volatile("" : "+v"(r32l));
        if (j <= ci) {
            f32x16 p0, p1; qkt(p0, p1, S_lds, qr, r32l, hi);
#pragma unroll
            for (int r = 0; r < 16; ++r) { const int s0 = 64 * j + crow(r, hi), s1 = s0 + 32;
                const float w0 = (s0 <= trow) ? fast_exp(A_S[s0] - Mt) * 0.08838834764831845f : 0.f, w1 = (s1 <= trow) ? fast_exp(A_S[s1] - Mt) * 0.08838834764831845f : 0.f;
                p0[r] *= w0; p1[r] *= w1; rowsum += p0[r] + p1[r]; }
            bf16x8 pa0, pa1, pa2, pa3;
            PK4(p0, 0, pa0); PK4(p0, 8, pa1); PK4(p1, 0, pa2); PK4(p1, 8, pa3);
            pv_d0(o, S_lds + 16384 + v_rd_base(lane), pa0, pa1, pa2, pa3);
        }
        slot = slot == 2 ? 0 : slot + 1;
    }
    RING_WAIT_BAR(0);
    {
        const int S_lds = ldsb + slot * 32768;
#pragma unroll
        for (int hf = 0; hf < 2; ++hf) {
            bf16x8 qs[4];
#pragma unroll
            for (int dd = 0; dd < 4; ++dd) { const int d0 = hf * 4 + dd; const u32x4 w = *reinterpret_cast<const u32x4*>(&qr[d0]);
                float f[8] = {bflo(w.x), bfhi(w.x), bflo(w.y), bfhi(w.y), bflo(w.z), bfhi(w.z), bflo(w.w), bfhi(w.w)};
#pragma unroll
                for (int i = 0; i < 8; ++i) qn += f[i] * N0L[d0 * 16 + hi * 8 + i];
                u32x4 s; s.x = cvtpk(f[0] * winter, f[1] * winter); s.y = cvtpk(f[2] * winter, f[3] * winter); s.z = cvtpk(f[4] * winter, f[5] * winter); s.w = cvtpk(f[6] * winter, f[7] * winter);
                qs[dd] = *reinterpret_cast<bf16x8*>(&s); }
            pv_d0(o, S_lds + hf * 16384 + v_rd_base(lane), qs[0], qs[1], qs[2], qs[3]);
        }
    }
    rowsum = half_swap_add(rowsum);
    qn = half_swap_add(qn);
    const float den = winter * qn + rowsum;
    const float dfl = fast_exp(-(B_T[trow] + Mt));
    const float inv = 1.0f / fmaxf(fabsf(den), dfl);
    if (hi == 0) wsf[r32] = inv;
    asm volatile("s_waitcnt lgkmcnt(0)" ::: "memory");
#pragma unroll
    for (int r = 0; r < 16; ++r) { const float sc_ = wsf[crow(r, hi)];
#pragma unroll
        for (int d0 = 0; d0 < 4; ++d0) o[d0][r] *= sc_; }
    RING_WAIT_BAR(0);
    const int hst = ldsb + wid * 16384;
    { int le = lane; asm volatile("" : "+v"(le)); const int r32e = le & 31, hie = le >> 5;
#pragma unroll
    for (int r = 0; r < 16; ++r)
#pragma unroll
        for (int d0 = 0; d0 < 4; ++d0) *(LAS float*)(uintptr_t)(unsigned)(hst + crow(r, hie) * 512 + (d0 * 32 + r32e) * 4) = o[d0][r]; }
    asm volatile("s_waitcnt lgkmcnt(0)" ::: "memory");
    const float* gn = a.mlstm_norm_g + (size_t)l * 512 + h * HD;
    int le = lane; asm volatile("" : "+v"(le));
#pragma unroll
    for (int i = 0; i < 8; ++i) { const int ch = i * 64 + le, row = ch >> 4, col = (ch & 15) * 8;
        const f32x4 a0 = *(const LAS f32x4*)(uintptr_t)(unsigned)(hst + row * 512 + col * 4), a1 = *(const LAS f32x4*)(uintptr_t)(unsigned)(hst + row * 512 + col * 4 + 16);
        float ss = (a0.x * a0.x + a0.y * a0.y) + (a0.z * a0.z + a0.w * a0.w) + (a1.x * a1.x + a1.y * a1.y) + (a1.z * a1.z + a1.w * a1.w);
        ss += shx(ss, 1, le); ss += shx(ss, 2, le); ss += shx(ss, 4, le); ss += shx(ss, 8, le);
        const float rstd = fast_rsqrt(ss * (1.f / HD) + EPS);
        const int orow = row0 + wid * 32 + row;
        const u32x4 mo = mo8[i];
        const f32x4 g0 = *(const f32x4*)(gn + col), g1 = *(const f32x4*)(gn + col + 4);
        float y[8] = {a0.x * g0.x, a0.y * g0.y, a0.z * g0.z, a0.w * g0.w, a1.x * g1.x, a1.y * g1.y, a1.z * g1.z, a1.w * g1.w};
        const float mf[8] = {bflo(mo.x), bfhi(mo.x), bflo(mo.y), bfhi(mo.y), bflo(mo.z), bfhi(mo.z), bflo(mo.w), bfhi(mo.w)};
#pragma unroll
        for (int k = 0; k < 8; ++k) y[k] = y[k] * rstd * (1.0f / (1.0f + fast_exp(-mf[k])));
        u32x4 w; w.x = cvtpk(y[0], y[1]); w.y = cvtpk(y[2], y[3]); w.z = cvtpk(y[4], y[5]); w.w = cvtpk(y[6], y[7]);
        *(u32x4*)(MIX + (size_t)orow * D + 1536 + h * HD + col) = w; }
}

__device__ __forceinline__ void ms_unit(const Args& a, const Ctx& c, int l, int unit) {
    const int b = unit >> 2, h = unit & 3; int tid = c.tid; asm volatile("" : "+v"(tid));
    const int lane = tid & 63, wid = c.wave;
    const bf16* PROJ = (const bf16*)(a.ws + WS_BIG); bf16* MIX = (bf16*)(a.ws + WS_H);
    const float* GATE = (const float*)(a.ws + WS_GATE);
    constexpr int P = 132;
    LAS float* Q = (LAS float*)c.lds;
    LAS float* Kk = Q + 32 * P;
    LAS float* V = Kk + 32 * P;
    LAS float* HB = V + 32 * P;
    LAS float* S = HB + 32 * P;
    LAS float* N0 = S + 32 * 33;
    LAS float* A_S = N0 + 128;
    LAS float* M_T = A_S + 32;
    LAS float* B_T = M_T + 32;
    LAS float* WST = B_T + 32;
    LAS float* DEN = WST + 32;
    LAS float* WIN = DEN + 32;
    LAS float* SC = WIN + 32;
    const int row0 = MP + b * SSEQ;
    const size_t sidx = (size_t)(l * SBATCH + b) * MH + h;
    const float* C0 = a.state_c + sidx * HD * HD;
    __syncthreads();
    for (int i = tid; i < 1536; i += NTHREADS) { const int which = i >> 9, r = (i >> 4) & 31, c8 = (i & 15) * 8;
        const u32x4 w = *(const u32x4*)(PROJ + (size_t)(row0 + r) * NPROJ + (which == 0 ? C_MQ : which == 1 ? C_MK : C_MV) + h * HD + c8);
        const float sc = which == 1 ? 0.08838834764831845f : 1.0f;
        LAS float* dst = (which == 0 ? Q : which == 1 ? Kk : V) + r * P + c8;
        *(LAS f32x4*)dst = (f32x4){bflo(w.x) * sc, bfhi(w.x) * sc, bflo(w.y) * sc, bfhi(w.y) * sc};
        *(LAS f32x4*)(dst + 4) = (f32x4){bflo(w.z) * sc, bfhi(w.z) * sc, bflo(w.w) * sc, bfhi(w.w) * sc}; }
    if (tid < 128) N0[tid] = a.state_n[sidx * HD + tid];
    if (wid == 0) {
        const int t = lane & 31; const float m0 = a.state_m[sidx];
        const float li = GATE[(size_t)(row0 + t) * 8 + h], lf = GATE[(size_t)(row0 + t) * 8 + 4 + h];
        float bc = lf;
#pragma unroll
        for (int o = 1; o < 32; o <<= 1) { const float x = shup(bc, o, lane); if ((lane & 31) >= o) bc += x; }
        const float as = li - bc; float cm = as;
#pragma unroll
        for (int o = 1; o < 32; o <<= 1) { const float x = shup(cm, o, lane); if ((lane & 31) >= o) cm = fmaxf(cm, x); }
        const float blast = __int_as_float(__builtin_amdgcn_ds_bpermute(31 << 2, __float_as_int(bc))), amax = __int_as_float(__builtin_amdgcn_ds_bpermute(31 << 2, __float_as_int(cm)));
        const float Mt = fmaxf(m0, cm), mnew = fmaxf(blast + m0, blast + amax);
        if (lane < 32) { A_S[t] = as; B_T[t] = bc; M_T[t] = Mt; WST[t] = fast_exp(blast + as - mnew); WIN[t] = fast_exp(m0 - Mt); }
        if (lane == 0) { SC[0] = m0; SC[1] = blast; SC[2] = mnew; SC[3] = fast_exp(blast + m0 - mnew); }
    }
    __syncthreads();
    for (int i = tid; i < 1024; i += NTHREADS) { const int t = i >> 5, s = i & 31; float d = 0.f;
        if (s <= t) {
#pragma unroll 8
            for (int k = 0; k < 128; k += 4) { const f32x4 q4 = *(const LAS f32x4*)(Q + t * P + k), k4 = *(const LAS f32x4*)(Kk + s * P + k); d += (q4.x * k4.x + q4.y * k4.y) + (q4.z * k4.z + q4.w * k4.w); }
            d *= fast_exp(A_S[s] - M_T[t]); }
        S[t * 33 + s] = d; }
    __syncthreads();
    if (tid < 32) { const int t = tid; float qn = 0.f, rs = 0.f;
        for (int k = 0; k < 128; ++k) qn += Q[t * P + k] * N0[k];
        for (int s = 0; s < 32; ++s) rs += S[t * 33 + s];
        const float den = WIN[t] * qn + rs; DEN[t] = 1.0f / fmaxf(fabsf(den), fast_exp(-(B_T[t] + M_T[t]))); }
    const int e = tid & 127, tg = tid >> 7;
    { float acc[8];
#pragma unroll
      for (int i = 0; i < 8; ++i) acc[i] = 0.f;
      for (int d0 = 0; d0 < 128; d0 += 16) { float cv[16];
#pragma unroll
          for (int j = 0; j < 16; ++j) cv[j] = C0[(size_t)(d0 + j) * HD + e];
#pragma unroll
          for (int j = 0; j < 16; j += 4)
#pragma unroll
              for (int i = 0; i < 8; ++i) { const f32x4 q4 = *(const LAS f32x4*)(Q + (tg * 8 + i) * P + d0 + j); acc[i] += (q4.x * cv[j] + q4.y * cv[j + 1]) + (q4.z * cv[j + 2] + q4.w * cv[j + 3]); } }
      __syncthreads();
#pragma unroll
      for (int i = 0; i < 8; ++i) { const int t = tg * 8 + i; float v = acc[i] * WIN[t];
          for (int s = 0; s <= t; ++s) v += S[t * 33 + s] * V[s * P + e];
          HB[t * P + e] = v * DEN[t]; } }
    __syncthreads();
    { const int t = tid >> 4, e0 = (tid & 15) * 8; float ss = 0.f;
      const f32x4 h0 = *(const LAS f32x4*)(HB + t * P + e0), h1 = *(const LAS f32x4*)(HB + t * P + e0 + 4);
      ss = (h0.x * h0.x + h0.y * h0.y) + (h0.z * h0.z + h0.w * h0.w) + (h1.x * h1.x + h1.y * h1.y) + (h1.z * h1.z + h1.w * h1.w);
      ss += shx(ss, 1, lane); ss += shx(ss, 2, lane); ss += shx(ss, 4, lane); ss += shx(ss, 8, lane);
      const float rstd = fast_rsqrt(ss * (1.f / HD) + EPS);
      const u32x4 mo = *(const u32x4*)(PROJ + (size_t)(row0 + t) * NPROJ + C_MO + h * HD + e0);
      const float* gn = a.mlstm_norm_g + (size_t)l * 512 + h * HD + e0;
      const f32x4 g0 = *(const f32x4*)gn, g1 = *(const f32x4*)(gn + 4);
      float y[8] = {h0.x * g0.x, h0.y * g0.y, h0.z * g0.z, h0.w * g0.w, h1.x * g1.x, h1.y * g1.y, h1.z * g1.z, h1.w * g1.w};
      const float mf[8] = {bflo(mo.x), bfhi(mo.x), bflo(mo.y), bfhi(mo.y), bflo(mo.z), bfhi(mo.z), bflo(mo.w), bfhi(mo.w)};
#pragma unroll
      for (int k = 0; k < 8; ++k) y[k] = y[k] * rstd * (1.0f / (1.0f + fast_exp(-mf[k])));
      u32x4 w; w.x = cvtpk(y[0], y[1]); w.y = cvtpk(y[2], y[3]); w.z = cvtpk(y[4], y[5]); w.w = cvtpk(y[6], y[7]);
      *(u32x4*)(MIX + (size_t)(row0 + t) * D + 1536 + h * HD + e0) = w; }
    { const float decay = SC[3]; const int dg = tg * 32; float acc[32];
#pragma unroll
      for (int i = 0; i < 32; ++i) acc[i] = C0[(size_t)(dg + i) * HD + e] * decay;
      for (int s = 0; s < 32; ++s) { const float vv = V[s * P + e] * WST[s];
#pragma unroll
          for (int i = 0; i < 32; i += 4) { const f32x4 k4 = *(const LAS f32x4*)(Kk + s * P + dg + i); acc[i] += k4.x * vv; acc[i + 1] += k4.y * vv; acc[i + 2] += k4.z * vv; acc[i + 3] += k4.w * vv; } }
      float* oc = a.out + O_SC + sidx * HD * HD;
#pragma unroll
      for (int i = 0; i < 32; ++i) oc[(size_t)(dg + i) * HD + e] = acc[i];
      if (tid < 128) { float v = decay * N0[tid]; for (int s = 0; s < 32; ++s) v += WST[s] * Kk[s * P + tid]; a.out[O_SN + sidx * HD + tid] = v; }
      if (tid == 0) a.out[O_SM + sidx] = SC[2]; }
}

__device__ __forceinline__ void phase_e(const Args& a, const Ctx& c_in0, int l) {
    const Ctx c = relaunder(c_in0);
    const bf16* PROJ = (const bf16*)(a.ws + WS_BIG); bf16* MIX = (bf16*)(a.ws + WS_H);
    constexpr int NATT = NB * NH * 32;
#if (PE_EN & 1)
    if ((c.G & 255) == 0) attn_stream(a, c, l);
    else
    for (int u = c.vcu; u < NATT; u += c.G) {
        const int gq = u & 31, bhh = u >> 5, b = bhh >> 3, h = bhh & 7;
        const int c0 = 4 * gq, jstart = c0 >= 8 ? 0 : 8 - c0, NT = 12 - jstart, ci = c.wave >> 1;
        const int krow0 = b * SEQ + (c0 - 8 + jstart) * 64;
        const int alo = ci - jstart, ahi = ci + 8 - jstart;
        const int R0 = (ci + 8 - jstart) * 64 + (c.wave & 1) * 32;
        attn_unit(c, PROJ + (size_t)(b * SEQ + c0 * 64) * NPROJ + C_Q + h * HD, NPROJ, c.wave * 32, PROJ + (size_t)krow0 * NPROJ + C_K + h * HD, PROJ + (size_t)krow0 * NPROJ + C_V + h * HD, NPROJ,
                  NT, alo < 0 ? 0 : alo, ahi, NT * 64, R0, a.rel_bias + (size_t)(l * NH + h) * 257, MIX + (size_t)(b * SEQ + c0 * 64) * D + 512 + h * HD, D, true, nullptr,
                  gq >= 2 ? (8 * gq + 8) % 12 : 0);
    }
#endif
#if (PE_EN & 4)
    for (int u = c.vcu; u < 16 * NGRP; u += c.G) m3_unit(a, c, l, u);
#endif
}
__device__ __forceinline__ void sample_kv_prep(const Args& a, const Ctx& c, int l, int b, int h) {
    int tid = c.tid; asm volatile("" : "+v"(tid));
    const int lane = tid & 63, row = tid >> 4, c8 = (tid & 15) * 8;
    const bf16* PROJ = (const bf16*)(a.ws + WS_BIG);
    bf16* SK = (bf16*)(a.ws + WS_SK + (size_t)(l & 1) * SKV_IMG); bf16* SV = (bf16*)(a.ws + WS_SV + (size_t)(l & 1) * SKV_IMG);
    const size_t ro = (size_t)(MP + b * SSEQ + row) * NPROJ + h * HD + c8;
    const u32x4 kq = *(const u32x4*)(PROJ + ro + C_K), vq = *(const u32x4*)(PROJ + ro + C_V);
    float x[8] = {bflo(kq.x), bfhi(kq.x), bflo(kq.y), bfhi(kq.y), bflo(kq.z), bfhi(kq.z), bflo(kq.w), bfhi(kq.w)};
    float ss = 0.f;
#pragma unroll
    for (int i = 0; i < 8; ++i) ss += x[i] * x[i];
    ss += shx(ss, 1, lane); ss += shx(ss, 2, lane); ss += shx(ss, 4, lane); ss += shx(ss, 8, lane);
    const float rk = fast_rsqrt(ss * (1.f / HD) + EPS);
    const float* gk = a.k_norm_g + l * HD + c8; const f32x4 g0 = *(const f32x4*)gk, g1 = *(const f32x4*)(gk + 4);
    x[0] *= rk * g0[0]; x[1] *= rk * g0[1]; x[2] *= rk * g0[2]; x[3] *= rk * g0[3]; x[4] *= rk * g1[0]; x[5] *= rk * g1[1]; x[6] *= rk * g1[2]; x[7] *= rk * g1[3];
    u32x4 o; o.x = cvtpk(x[0], x[1]); o.y = cvtpk(x[2], x[3]); o.z = cvtpk(x[4], x[5]); o.w = cvtpk(x[6], x[7]);
    const size_t io = ((size_t)b * SKV_ROWS + 512 + row) * 1024 + h * HD + c8;
    *(u32x4*)(SK + io) = o; *(u32x4*)(SV + io) = vq;
    const size_t oo = ((size_t)(l * SBATCH + b) * SSEQ + row) * 1024 + h * HD + c8;
    float* ok = a.out + O_SK + oo; float* ov = a.out + O_SV + oo;
    *(f32x4*)ok = (f32x4){x[0], x[1], x[2], x[3]}; *(f32x4*)(ok + 4) = (f32x4){x[4], x[5], x[6], x[7]};
    *(f32x4*)ov = (f32x4){bflo(vq.x), bfhi(vq.x), bflo(vq.y), bfhi(vq.y)}; *(f32x4*)(ov + 4) = (f32x4){bflo(vq.z), bfhi(vq.z), bflo(vq.w), bfhi(vq.w)};
    asm volatile("s_waitcnt vmcnt(0)" ::: "memory"); __syncthreads();
}
__device__ __forceinline__ void sample_mixers(const Args& a, const Ctx& c, int l) {
    const bf16* PROJ = (const bf16*)(a.ws + WS_BIG); bf16* MIX = (bf16*)(a.ws + WS_H);
#if (PE_EN & 2)
    for (int su = c.vcu; su < SBATCH * NH; su += c.G) {
        const int b = su >> 3, h = su & 7;
        sample_kv_prep(a, c, l, b, h);
        const bf16* SK = (const bf16*)(a.ws + WS_SK + (size_t)(l & 1) * SKV_IMG) + (size_t)b * SKV_ROWS * 1024 + h * HD; const bf16* SV = (const bf16*)(a.ws + WS_SV + (size_t)(l & 1) * SKV_IMG) + (size_t)b * SKV_ROWS * 1024 + h * HD;
        attn_unit(c, PROJ + (size_t)(MP + b * SSEQ) * NPROJ + C_Q + h * HD, NPROJ, 0, SK, SV, 1024, 9, 0, 8, 544, 512, a.rel_bias + (size_t)(l * NH + h) * 257,
                  MIX + (size_t)(MP + b * SSEQ) * D + 512 + h * HD, D, c.wave == 0, a.q_norm_g + l * HD);
    }
#endif
#if (PE_EN & 8)
    for (int u = c.vcu - SBATCH * NH; u >= 0 && u < SBATCH * MH; u += c.G) ms_unit(a, c, l, u);
#endif
    __syncthreads();
}
typedef const __attribute__((address_space(4))) Args* KArgP;
#if defined(__HIP_DEVICE_COMPILE__)
__device__ __forceinline__ Args get_args() { KArgP p = (KArgP)__builtin_amdgcn_kernarg_segment_ptr(); asm volatile("" : "+s"(p)); return *p; }
#else
__device__ Args get_args();
#endif
__global__ void __launch_bounds__(NTHREADS, 2) fwd(Args args) {
    extern __shared__ __attribute__((aligned(16))) unsigned char lds_raw[];
    Ctx c; c.lds = (LAS unsigned char*)lds_raw; c.wave = __builtin_amdgcn_readfirstlane((int)threadIdx.x >> 6); c.tid = hw_tid(c.wave); c.lane = c.tid & 63;
    c.G = gridDim.x; { const int bx = blockIdx.x; c.vcu = (c.G % 8 == 0) ? (bx % 8) * (c.G / 8) + bx / 8 : bx; }
    volatile LAS unsigned* MISC = (volatile LAS unsigned*)(c.lds + MISC_OFF);
    { const int t0 = hw_tid(c.wave); if (t0 < 16) MISC[t0] = 0u; }
    __syncthreads();
    unsigned* barw = (unsigned*)(get_args().ws + WS_CTL) + 4096;
    XcdBarrier bar; bar.bar = barw; bar.x = 0; bar.st = nullptr;
    const int lo = args.ph_lo, hi = args.ph_hi;
    const bool multi = (hi - lo) > 1;
    if (multi) bar = xcd_barrier_post(barw, MISC + 8, hw_tid(c.wave) == 0);
#define IN(k) (lo <= (k) && (k) < hi)
#define SEAM(k) do { if (IN(k) && IN((k) + 1)) xcd_barrier(bar.bar, bar.x, bar.st, c.wave); } while (0)
    for (int l = 0; l < DEPTH; ++l) {
        const int pb = l * NPH_LAYER;
        if (IN(pb + 0)) {
#if (PH_EN >> 1) & 1
            { const Args A_ = get_args(); phase_norm<true>(A_, c, l); }
#if (PH_DUP >> 1) & 1
            { __syncthreads(); const Args A_ = get_args(); phase_norm<true>(A_, c, l); }
#endif
#endif
 __syncthreads(); SEAM(pb + 0); }
        if (IN(pb + 1)) {
            const Args A_ = get_args(); bf16* H = (bf16*)(A_.ws + WS_H); bf16* BIG = (bf16*)(A_.ws + WS_BIG);
            bf16* XBp = (bf16*)(A_.ws + WS_XB); const float* RS = (const float*)(A_.ws + WS_RSTD);
            pg8::Gemm g{XBp, (const bf16*)(A_.ws + WS_WIN), MP, NPROJ, D}; pg8::StaticOrder S; S.init(MP, NPROJ, c.G, (int)blockIdx.x, WGM_B);
            pg8::EpiProj E{BIG, NPROJ, A_.q_norm_g + l * HD, A_.k_norm_g + l * HD, (LAS float*)(c.lds + SCR_OFF), RS};

#if (PH_EN >> 2) & 1
            for (int rep_ = 0, nrep_ = ((PH_DUP >> 2) & 1) ? A_.rep : 1; rep_ < nrep_; ++rep_) pg8::gemm_phase<pg8::EpiProj, pg8::StaticOrder, true, true>(c.lds, g, S, E, c.wave);
            { SEpiBf16 SE{BIG + (size_t)MP * NPROJ, NPROJ, 0, RS + MP}; sample_gemm(c.lds, c.wave, c.vcu, c.G, XBp + (size_t)MP * D, g.Bt, NPROJ, D, SE); }
#endif

            SEAM(pb + 1);
        }
        if (IN(pb + 2)) {
#if (PH_EN >> 3) & 1
            { const Args A_ = get_args(); phase_c<true>(A_, c, l); }
#if (PH_DUP >> 3) & 1
            { __syncthreads(); const Args A_ = get_args(); phase_c<false>(A_, c, l); }
#endif
#endif
 SEAM(pb + 2); }
        if (IN(pb + 3)) {
#if (PH_EN >> 4) & 1
            { const Args A_ = get_args(); phase_d(A_, c, l); }
            { const Args A_ = get_args(); if (l + 1 < DEPTH) build_kv_image(A_, c.vcu, c.G, hw_tid(c.wave), l + 1); }
#if (PH_DUP >> 4) & 1
            { __syncthreads(); const Args A_ = get_args(); phase_d(A_, c, l); }
#endif
#endif
 SEAM(pb + 3); }
        if (IN(pb + 4)) {
#if (PH_EN >> 5) & 1
            { const Args A_ = get_args(); phase_e(A_, c, l); }
#if (PH_DUP >> 5) & 1
            { __syncthreads(); const Args A_ = get_args(); phase_e(A_, c, l); }
#endif
#endif
 __syncthreads(); SEAM(pb + 4); }
        if (IN(pb + 5)) {
            const Args A_ = get_args(); bf16* H = (bf16*)(A_.ws + WS_H);
            pg8::Gemm g{H, (const bf16*)(A_.ws + WS_WOUT), MP, D, D}; pg8::StaticOrder S; S.init(MP, D, c.G, (int)blockIdx.x, WGM_F);
            pg8::EpiResAdd E{(bf16*)(A_.ws + WS_XB), A_.out, D, false};

#if (PH_EN >> 6) & 1
            pg8::gemm_phase<pg8::EpiResAdd, pg8::StaticOrder, true, true>(c.lds, g, S, E, c.wave);
            { SEpiResAdd SE{(bf16*)(A_.ws + WS_XB) + (size_t)MP * D, A_.out + (size_t)MP * D, D, false}; sample_gemm(c.lds, c.wave, c.vcu, c.G, H + (size_t)MP * D, g.Bt, D, D, SE); }
#if (PH_DUP >> 6) & 1
            { pg8::EpiBf16<0> E2{(bf16*)(A_.ws + WS_BIG), D, nullptr, (LAS float*)(c.lds + SCR_OFF)}; pg8::gemm_phase<pg8::EpiBf16<0>, pg8::StaticOrder, true, true>(c.lds, g, S, E2, c.wave); }
#endif
#endif

            SEAM(pb + 5);
        }
        if (IN(pb + 6)) {
#if (PH_EN >> 7) & 1
            { const Args A_ = get_args(); phase_norm<false>(A_, c, l); }
#if (PH_DUP >> 7) & 1
            { __syncthreads(); const Args A_ = get_args(); phase_norm<false>(A_, c, l); }
#endif
#endif
 SEAM(pb + 6); }
        if (IN(pb + 7)) {
            const Args A_ = get_args(); bf16* H = (bf16*)(A_.ws + WS_H); bf16* BIG = (bf16*)(A_.ws + WS_BIG);
            bf16* XBp = (bf16*)(A_.ws + WS_XB); const float* RS = (const float*)(A_.ws + WS_RSTD);
            pg8::Gemm g{XBp, (const bf16*)(A_.ws + WS_WUP), MP, FF, D}; pg8::StaticOrder S; S.init(MP, FF, c.G, (int)blockIdx.x, WGM_H);
            pg8::EpiBf16<1> E{BIG, FF, RS, (LAS float*)(c.lds + SCR_OFF)};

#if (PH_EN >> 8) & 1
            for (int rep_ = 0, nrep_ = ((PH_DUP >> 8) & 1) ? A_.rep : 1; rep_ < nrep_; ++rep_) pg8::gemm_phase<pg8::EpiBf16<1>, pg8::StaticOrder, true, true>(c.lds, g, S, E, c.wave);
            { SEpiBf16 SE{BIG + (size_t)MP * FF, FF, 1, RS + MP}; sample_gemm(c.lds, c.wave, c.vcu, c.G, XBp + (size_t)MP * D, g.Bt, FF, D, SE); }
#endif

            SEAM(pb + 7);
        }
        if (IN(pb + 8)) {
            const Args A_ = get_args(); bf16* BIG = (bf16*)(A_.ws + WS_BIG);
            pg8::Gemm g{BIG, (const bf16*)(A_.ws + WS_WDN), MP, D, FF}; pg8::StaticOrder S; S.init(MP, D, c.G, (int)blockIdx.x, WGM_I);
            pg8::EpiResAdd E{(bf16*)(A_.ws + WS_XB), A_.out, D, l == DEPTH - 1};

#if (PH_EN >> 9) & 1
            pg8::gemm_phase<pg8::EpiResAdd, pg8::StaticOrder, true, true>(c.lds, g, S, E, c.wave);
            { SEpiResAdd SE{(bf16*)(A_.ws + WS_XB) + (size_t)MP * D, A_.out + (size_t)MP * D, D, l == DEPTH - 1}; sample_gemm(c.lds, c.wave, c.vcu, c.G, BIG + (size_t)MP * FF, g.Bt, D, FF, SE); }
#if (PH_DUP >> 9) & 1
            { pg8::EpiBf16<0> E2{(bf16*)(A_.ws + WS_H), D, nullptr, (LAS float*)(c.lds + SCR_OFF)}; pg8::gemm_phase<pg8::EpiBf16<0>, pg8::StaticOrder, true, true>(c.lds, g, S, E2, c.wave); }
#endif
#endif

            SEAM(pb + 8);
        }
    }
#undef IN
#undef SEAM
}

extern "C" void kernel_launch(void* const* d_in, const int* in_sizes, int n_in, void* d_out, int out_size, void* d_ws, size_t ws_size, hipStream_t stream) {
    static int grid = 0;
    if (grid == 0) {
        if (n_in != 21 || (size_t)out_size != O_END || ws_size < WS_END) { fprintf(stderr, "kernel_launch: shape mismatch n_in %d out %d ws %zu (need %zu)\n", n_in, out_size, ws_size, (size_t)WS_END); grid = -1; return; }
        int dev = 0, cus = 0, per_cu = 0;
        if (hipGetDevice(&dev) != hipSuccess || hipDeviceGetAttribute(&cus, hipDeviceAttributeMultiprocessorCount, dev) != hipSuccess) { grid = -1; return; }
        if (hipFuncSetAttribute((const void*)fwd, hipFuncAttributeMaxDynamicSharedMemorySize, LDS_BYTES) != hipSuccess) { fprintf(stderr, "kernel_launch: hipFuncSetAttribute failed\n"); grid = -1; return; }
        if (hipOccupancyMaxActiveBlocksPerMultiprocessor(&per_cu, (const void*)fwd, NTHREADS, LDS_BYTES) != hipSuccess || per_cu < 1) { fprintf(stderr, "kernel_launch: occupancy query says %d\n", per_cu); }
        (void)hipGetLastError();
        grid = cus;
    }
    if (grid < 0) return;
    (void)hipMemsetAsync((char*)d_ws + WS_CTL, 0, CTL_BYTES, stream);
    Args a{};
    a.x_prompt = (const float*)d_in[0]; a.x_sample = (const float*)d_in[1]; a.cache_k = (const float*)d_in[2]; a.cache_v = (const float*)d_in[3]; a.state_conv = (const float*)d_in[4];
    a.state_c = (const float*)d_in[5]; a.state_n = (const float*)d_in[6]; a.state_m = (const float*)d_in[7]; a.norm_mix_g = (const float*)d_in[8]; a.w_in = (const float*)d_in[9];
    a.conv_w = (const float*)d_in[10]; a.q_norm_g = (const float*)d_in[11]; a.k_norm_g = (const float*)d_in[12]; a.rel_bias = (const float*)d_in[13]; a.b_igate = (const float*)d_in[14];
    a.b_fgate = (const float*)d_in[15]; a.mlstm_norm_g = (const float*)d_in[16]; a.w_out = (const float*)d_in[17]; a.norm_mlp_g = (const float*)d_in[18]; a.w_up = (const float*)d_in[19];
    a.w_down = (const float*)d_in[20]; a.out = (float*)d_out; a.ws = (unsigned char*)d_ws;
#if MK_PER_PHASE
    for (int p = 0; p < NPHASES; ++p) { a.ph_lo = p; a.ph_hi = p + 1; a.rep = 2; hipLaunchKernelGGL(fwd, dim3(grid), dim3(NTHREADS), LDS_BYTES, stream, a); }
#else
    a.ph_lo = 0; a.ph_hi = NPHASES; a.rep = 2; hipLaunchKernelGGL(fwd, dim3(grid), dim3(NTHREADS), LDS_BYTES, stream, a);
#endif
    const hipError_t le = hipPeekAtLastError();
    if (le != hipSuccess) fprintf(stderr, "kernel_launch: launch failed: %s\n", hipGetErrorName(le));
}
```

```cpp
#include <hip/hip_runtime.h>
#include <cstdio>
#include <cstdint>

#ifndef MK_PER_PHASE
#define MK_PER_PHASE 0
#endif

#ifndef PH_EN
#define PH_EN 0x3ff
#endif
#ifndef PE_EN
#define PE_EN 0xf
#endif
#ifndef WGM_B
#define WGM_B 4
#endif
#ifndef WGM_F
#define WGM_F 4
#endif
#ifndef WGM_H
#define WGM_H 4
#endif
#ifndef WGM_I
#define WGM_I 4
#endif
#ifndef PH_DUP
#define PH_DUP 0
#endif
#define LAS __attribute__((address_space(3)))
#define GAS __attribute__((address_space(1)))
typedef unsigned short bf16;
typedef short bf16x8 __attribute__((ext_vector_type(8)));
typedef short s16x4 __attribute__((ext_vector_type(4)));
typedef float f32x2 __attribute__((ext_vector_type(2)));
typedef float f32x4 __attribute__((ext_vector_type(4)));
typedef float f32x16 __attribute__((ext_vector_type(16)));
typedef unsigned u32x2 __attribute__((ext_vector_type(2)));
typedef unsigned u32x4 __attribute__((ext_vector_type(4)));

constexpr int D = 2048, NB = 4, SEQ = 8192, DEPTH = 4, SBATCH = 8, SSEQ = 32;
constexpr int MP = NB * SEQ, MS = SBATCH * SSEQ, MR = MP + MS;
constexpr int NH = 8, HD = 128, MH = 4;
constexpr int NPROJ = 6656, IN_DIM = 6664, FF = 8192;
constexpr int C_XA = 0, C_GB = 512, C_GC = 1024, C_Q = 1536, C_K = 2560, C_V = 3584, C_MQ = 4608, C_MK = 5120, C_MV = 5632, C_MO = 6144;
constexpr int KEEP = 512;
constexpr int SKV_ROWS = 640;
constexpr float EPS = 1e-6f;
constexpr float LOG2E = 1.4426950408889634f;
constexpr int NGRP = SEQ / 256;

constexpr size_t O_YP = 0, O_YS = O_YP + (size_t)MP * D, O_PCONV = O_YS + (size_t)MS * D, O_PK = O_PCONV + (size_t)DEPTH * NB * 2 * 512,
                 O_PV = O_PK + (size_t)DEPTH * NB * KEEP * 1024, O_PC = O_PV + (size_t)DEPTH * NB * KEEP * 1024, O_PN = O_PC + (size_t)DEPTH * NB * MH * HD * HD,
                 O_PM = O_PN + (size_t)DEPTH * NB * MH * HD, O_SCONV = O_PM + (size_t)DEPTH * NB * MH, O_SK = O_SCONV + (size_t)DEPTH * SBATCH * 2 * 512,
                 O_SV = O_SK + (size_t)DEPTH * SBATCH * SSEQ * 1024, O_SC = O_SV + (size_t)DEPTH * SBATCH * SSEQ * 1024, O_SN = O_SC + (size_t)DEPTH * SBATCH * MH * HD * HD,
                 O_SM = O_SN + (size_t)DEPTH * SBATCH * MH * HD, O_END = O_SM + (size_t)DEPTH * SBATCH * MH;

constexpr size_t al256(size_t x) { return (x + 255) / 256 * 256; }
constexpr size_t WS_CTL = 0, CTL_BYTES = 1u << 20;
constexpr size_t WS_WIN = CTL_BYTES;
constexpr size_t WS_WOUT = WS_WIN + (size_t)NPROJ * D * 2;
constexpr size_t WS_WUP = WS_WOUT + (size_t)D * D * 2;
constexpr size_t WS_WDN = WS_WUP + (size_t)FF * D * 2;
constexpr size_t WS_H = WS_WDN + (size_t)D * FF * 2;
constexpr size_t WS_XB = WS_H + (size_t)MR * D * 2;
constexpr size_t WS_BIG = WS_XB + (size_t)MR * D * 2;
constexpr size_t BIG_BYTES = (size_t)MR * FF * 2;
constexpr size_t WS_CLOC = WS_BIG + al256((size_t)MR * NPROJ * 2);
constexpr size_t WS_C0 = WS_CLOC + (size_t)16 * NGRP * HD * HD * 4;
constexpr size_t WS_NLOC = WS_C0 + (size_t)16 * NGRP * HD * HD * 2;
constexpr size_t WS_N0 = WS_NLOC + (size_t)16 * NGRP * HD * 4;
constexpr size_t WS_MSC = WS_N0 + (size_t)16 * NGRP * HD * 4;
constexpr size_t WS_MIX_END = WS_MSC + (size_t)16 * NGRP * 4 * 4;
static_assert(WS_MIX_END <= WS_BIG + BIG_BYTES, "mLSTM scratch fits in the free top of BIG");
constexpr size_t WS_GATE = WS_BIG + BIG_BYTES;
constexpr size_t SKV_IMG = (size_t)SBATCH * SKV_ROWS * 1024 * 2;
constexpr size_t WS_SK = WS_GATE + (size_t)MR * 8 * 4;
constexpr size_t WS_SV = WS_SK + 2 * SKV_IMG;
constexpr size_t WS_RSTD = WS_SV + 2 * SKV_IMG;
constexpr size_t WS_END = WS_RSTD + (size_t)MR * 4;
static_assert(WS_END <= 1235000000ull, "workspace budget");

constexpr int RING_BYTES = 131072;
constexpr int MISC_OFF = RING_BYTES;
constexpr int SCR_OFF = MISC_OFF + 256;
constexpr int LDS_BYTES = 147456;
constexpr int NWAVES = 8, NTHREADS = 512;

__device__ __forceinline__ unsigned cvtpk(float lo, float hi) { unsigned r; asm volatile("v_cvt_pk_bf16_f32 %0, %1, %2" : "=v"(r) : "v"(lo), "v"(hi)); return r; }
__device__ __forceinline__ float bflo(unsigned w) { return __uint_as_float(w << 16); }
__device__ __forceinline__ float bfhi(unsigned w) { return __uint_as_float(w & 0xffff0000u); }
__device__ __forceinline__ float bf2f(bf16 b) { return __uint_as_float(((unsigned)b) << 16); }
__device__ __forceinline__ float shx(float v, int o, int lane) { return __int_as_float(__builtin_amdgcn_ds_bpermute((lane ^ o) << 2, __float_as_int(v))); }
__device__ __forceinline__ float shup(float v, int o, int lane) { const int s = lane - o; return __int_as_float(__builtin_amdgcn_ds_bpermute((s < 0 ? lane : s) << 2, __float_as_int(v))); }
__device__ __forceinline__ float wave_sum(float v, int lane) {
#pragma unroll
    for (int o = 1; o < 64; o <<= 1) v += shx(v, o, lane);
    return v;
}
__device__ __forceinline__ float fast_rsqrt(float x) { return __builtin_amdgcn_rsqf(x); }
__device__ __forceinline__ float fast_exp(float x) { return __builtin_amdgcn_exp2f(x * 1.4426950408889634f); }
__device__ __forceinline__ float fast_log(float x) { return __builtin_amdgcn_logf(x) * 0.6931471805599453f; }
__device__ __forceinline__ float opaque_zero() { float z; asm volatile("v_mov_b32 %0, 0" : "=v"(z)); return z; }
#define LDS_WAIT() asm volatile("s_waitcnt lgkmcnt(0)" ::: "memory")
#define VM_WAIT() asm volatile("s_waitcnt vmcnt(0)" ::: "memory")
#define SBAR() __builtin_amdgcn_sched_barrier(0)

namespace pg8 {
typedef unsigned short bf16_t;
constexpr int BM = 256, BK = 64, HALF = 128, HTB = HALF * BK * 2, STAGE_BYTES = 8 * HTB, NXCD = 8, WGM = 4;
__host__ __device__ __forceinline__ int lds_byte(int r, int c) { const int st = (r >> 4) * 2 + (c >> 5), rr = r & 15, cc = c & 31, ob = rr * 64 + cc * 2; return st * 1024 + (ob ^ (((ob >> 9) & 1) << 5)); }
__host__ __device__ __forceinline__ void stage_rc(int b, int& R, int& C) { const int st = b / 1024, sb = b % 1024, swz = sb ^ (((sb >> 9) & 1) << 5); R = (st >> 1) * 16 + swz / 64; C = (st & 1) * 32 + (swz % 64) / 2; }
__host__ __device__ __forceinline__ int perm32(int rho) { const int n = rho >> 4, i = rho & 15; return 8 * (i >> 2) + 4 * n + (i & 3); }
struct Unit { int pm, pn; };
struct Gemm { const bf16_t* A; const bf16_t* Bt; int M, N, K; };
struct StaticOrder {
    int nM, nN, nwg, G, c, wgm;
    __host__ __device__ void init(int M, int N, int G_, int c_, int wgm_ = WGM) { nM = M / BM; nN = N / BM; nwg = nM * nN; G = G_; c = c_; wgm = wgm_; }
    __host__ __device__ bool next(int i, Unit& u) const {
        const long L = (long)i * G + c; if (L >= nwg) return false;
        int wgid = (int)L; { const int q = nwg / NXCD, r = nwg % NXCD, xcd = wgid % NXCD, off = wgid / NXCD; wgid = (xcd < r ? xcd * (q + 1) : r * (q + 1) + (xcd - r) * q) + off; }
        const int nig = wgm * nN, gid = wgid / nig, fm = gid * wgm, gsz = (nM - fm) < wgm ? (nM - fm) : wgm;
        u.pm = fm + ((wgid % nig) % gsz); u.pn = (wgid % nig) / gsz; return true;
    }
    __device__ __forceinline__ void a_ready(const Unit&) const {}
    __device__ __forceinline__ void done(const Unit&) const {}
};
template <int ACT  > struct EpiBf16 {
    static constexpr bool PERM = true, AFTER_DRAIN = false;
    static constexpr bool RSL = true;
    bf16_t* O; int ldc; const float* rstd; LAS float* T;
    __device__ __forceinline__ void rs_fetch(const Unit& u, int tid, int par) const { if (rstd && tid < BM) (T + 2048 + par * BM)[tid] = rstd[u.pm * BM + tid]; }
    __device__ __forceinline__ void operator()(const f32x4 (&acc)[2][2][4][2], const Unit& u, int wr, int wc, int fr, int fq, int par) const {
        const int row0 = u.pm * BM + wr * 64 + fr; const int col0 = u.pn * BM + wc * 32 + 8 * fq;
#pragma unroll
        for (int ai = 0; ai < 2; ++ai)
#pragma unroll
            for (int m = 0; m < 4; ++m) { bf16_t* rowp = O + (size_t)(row0 + ai * HALF + m * 16) * ldc + col0; const float rsv = rstd ? (T + 2048 + par * BM)[wr * 64 + fr + ai * HALF + m * 16] : 1.0f;
#pragma unroll
                for (int bj = 0; bj < 2; ++bj) { f32x4 v0 = acc[ai][bj][m][0] * rsv, v1 = acc[ai][bj][m][1] * rsv;
                    if (ACT == 1) {
#pragma unroll
                        for (int j = 0; j < 4; ++j) { const float a = fmaxf(v0[j], 0.f), b = fmaxf(v1[j], 0.f); v0[j] = a * a; v1[j] = b * b; } }
                    u32x4 w; w.x = cvtpk(v0[0], v0[1]); w.y = cvtpk(v0[2], v0[3]); w.z = cvtpk(v1[0], v1[1]); w.w = cvtpk(v1[2], v1[3]);
                    *(u32x4*)(rowp + bj * HALF) = w; } }
    }
};
struct EpiProj {
    static constexpr bool PERM = true, AFTER_DRAIN = false;
    static constexpr bool RSL = true;
    bf16_t* O; int ldc; const float* gq; const float* gk; LAS float* T; const float* rstd;
    __device__ __forceinline__ void rs_fetch(const Unit& u, int tid, int par) const { if (tid < BM) (T + 2048 + par * BM)[tid] = rstd[u.pm * BM + tid]; }
    __device__ __forceinline__ void operator()(const f32x4 (&acc)[2][2][4][2], const Unit& u, int wr, int wc, int fr, int fq, int par) const {
        const int row0 = u.pm * BM + wr * 64 + fr; const int col0 = u.pn * BM + wc * 32 + 8 * fq;
        const bool isqk = (u.pn >= 6) && (u.pn < 14);
        float rs[2][4];
#pragma unroll
        for (int ai = 0; ai < 2; ++ai)
#pragma unroll
            for (int m = 0; m < 4; ++m) rs[ai][m] = (T + 2048 + par * BM)[wr * 64 + fr + ai * HALF + m * 16];
        if (!isqk) {
#pragma unroll
            for (int ai = 0; ai < 2; ++ai)
#pragma unroll
                for (int m = 0; m < 4; ++m) { bf16_t* rowp = O + (size_t)(row0 + ai * HALF + m * 16) * ldc + col0;
#pragma unroll
                    for (int bj = 0; bj < 2; ++bj) { const f32x4 v0 = acc[ai][bj][m][0] * rs[ai][m], v1 = acc[ai][bj][m][1] * rs[ai][m];
                        u32x4 w; w.x = cvtpk(v0[0], v0[1]); w.y = cvtpk(v0[2], v0[3]); w.z = cvtpk(v1[0], v1[1]); w.w = cvtpk(v1[2], v1[3]);
                        *(u32x4*)(rowp + bj * HALF) = w; } }
            return;
        }
        const int lane = fr + 16 * fq;
        float ss[2][4][2];
#pragma unroll
        for (int ai = 0; ai < 2; ++ai)
#pragma unroll
            for (int m = 0; m < 4; ++m)
#pragma unroll
                for (int bj = 0; bj < 2; ++bj) { const f32x4 v0 = acc[ai][bj][m][0] * rs[ai][m], v1 = acc[ai][bj][m][1] * rs[ai][m];
                    float s = (v0[0] * v0[0] + v0[1] * v0[1]) + (v0[2] * v0[2] + v0[3] * v0[3]) + (v1[0] * v1[0] + v1[1] * v1[1]) + (v1[2] * v1[2] + v1[3] * v1[3]);
                    s += shx(s, 16, lane); s += shx(s, 32, lane); ss[ai][m][bj] = s; }
        if (fq == 0) {
#pragma unroll
            for (int ai = 0; ai < 2; ++ai)
#pragma unroll
                for (int m = 0; m < 4; ++m)
#pragma unroll
                    for (int bj = 0; bj < 2; ++bj) T[(ai * HALF + wr * 64 + m * 16 + fr) * 8 + bj * 4 + wc] = ss[ai][m][bj];
        }
        asm volatile("s_waitcnt lgkmcnt(0)" ::: "memory"); __builtin_amdgcn_s_barrier(); asm volatile("" ::: "memory");
        const float* gg = ((u.pn < 10) ? gq : gk) + wc * 32 + 8 * fq;
        const f32x4 g0 = *(const f32x4*)gg, g1 = *(const f32x4*)(gg + 4);
#pragma unroll
        for (int ai = 0; ai < 2; ++ai)
#pragma unroll
            for (int m = 0; m < 4; ++m) { bf16_t* rowp = O + (size_t)(row0 + ai * HALF + m * 16) * ldc + col0;
#pragma unroll
                for (int bj = 0; bj < 2; ++bj) { const f32x4 t = *(const LAS f32x4*)(T + (ai * HALF + wr * 64 + m * 16 + fr) * 8 + bj * 4);
                    const float rq = fast_rsqrt(((t[0] + t[1]) + (t[2] + t[3])) * (1.0f / 128.0f) + 1e-6f) * rs[ai][m];
                    const f32x4 v0 = acc[ai][bj][m][0] * rq * g0, v1 = acc[ai][bj][m][1] * rq * g1;
                    u32x4 w; w.x = cvtpk(v0[0], v0[1]); w.y = cvtpk(v0[2], v0[3]); w.z = cvtpk(v1[0], v1[1]); w.w = cvtpk(v1[2], v1[3]);
                    *(u32x4*)(rowp + bj * HALF) = w; } }
    }
};
struct EpiResAdd {
    static constexpr bool RSL = false;
    static constexpr bool PERM = true, AFTER_DRAIN = false;
    bf16_t* XB; float* Y; int ldc; bool fin;
    __device__ __forceinline__ void operator()(const f32x4 (&acc)[2][2][4][2], const Unit& u, int wr, int wc, int fr, int fq, int) const {
        const int row0 = u.pm * BM + wr * 64 + fr, col0 = u.pn * BM + wc * 32 + 8 * fq;
        u32x4 r[2][4][2];
#pragma unroll
        for (int ai = 0; ai < 2; ++ai)
#pragma unroll
            for (int m = 0; m < 4; ++m)
#pragma unroll
                for (int bj = 0; bj < 2; ++bj) r[ai][m][bj] = *(const u32x4*)(XB + (size_t)(row0 + ai * HALF + m * 16) * ldc + col0 + bj * HALF);
#pragma unroll
        for (int ai = 0; ai < 2; ++ai)
#pragma unroll
            for (int m = 0; m < 4; ++m)
#pragma unroll
                for (int bj = 0; bj < 2; ++bj) { const u32x4 w = r[ai][m][bj]; const f32x4 a0 = acc[ai][bj][m][0], a1 = acc[ai][bj][m][1];
                    const f32x4 v0 = (f32x4){bflo(w.x) + a0[0], bfhi(w.x) + a0[1], bflo(w.y) + a0[2], bfhi(w.y) + a0[3]}, v1 = (f32x4){bflo(w.z) + a1[0], bfhi(w.z) + a1[1], bflo(w.w) + a1[2], bfhi(w.w) + a1[3]};
                    const size_t off = (size_t)(row0 + ai * HALF + m * 16) * ldc + col0 + bj * HALF;
                    if (fin) { *(f32x4*)(Y + off) = v0; *(f32x4*)(Y + off + 4) = v1; }
                    else { u32x4 o; o.x = cvtpk(v0[0], v0[1]); o.y = cvtpk(v0[2], v0[3]); o.z = cvtpk(v1[0], v1[1]); o.w = cvtpk(v1[2], v1[3]); *(u32x4*)(XB + off) = o; } }
    }
};

template <class Epi, class Sched, bool ALIGN_EPI = false, bool SP2 = false>
__device__ __forceinline__ void gemm_phase(LAS unsigned char* lds, const Gemm g, const Sched& S, const Epi& E, const int wave_) {
    int ln_; asm volatile("v_mbcnt_lo_u32_b32 %0, -1, 0\n\tv_mbcnt_hi_u32_b32 %0, -1, %0" : "=v"(ln_)); const int tid = wave_ * 64 + ln_;
    const int wid = __builtin_amdgcn_readfirstlane(tid >> 6), lane = tid & 63, wr = wid >> 2, wc = wid & 3, fr = lane & 15, fq = lane >> 4;
    const int K = g.K, nt = K / BK;
    unsigned voffA[2], voffB[2];
#pragma unroll
    for (int i = 0; i < 2; ++i) { int R, C; stage_rc(tid * 16 + i * 8192, R, C); const int Rb = Epi::PERM ? ((R & ~31) + perm32(R & 31)) : R;
        voffA[i] = (unsigned)(R * K + C) * 2u; voffB[i] = (unsigned)(Rb * K + C) * 2u; }
    const size_t kstep = (size_t)(BK * 2);
    const size_t hstep = (size_t)HALF * K * 2;
    const size_t tstep = 2 * hstep;
    const unsigned ldsw = (unsigned)wid * 1024u;
    const int aoff = lds_byte(wr * 64 + fr, fq * 8), boff = lds_byte(wc * 32 + fr, fq * 8);
#define PG8_SA(b, h) (((b) * 2 + (h)) * HTB)
#define PG8_SB(b, h) ((4 + (b) * 2 + (h)) * HTB)
#define PG8_STAGE(bufoff, gbase, voff) do { _Pragma("unroll") for (int _i = 0; _i < 2; ++_i) \
        __builtin_amdgcn_global_load_lds((const unsigned*)((const char*)(gbase) + (voff)[_i]), (LAS unsigned*)(lds + (bufoff) + ldsw + _i * 8192), 16, 0, 0); } while (0)
#define PG8_LDA(dst, b, h) do { _Pragma("unroll") for (int m = 0; m < 4; ++m) _Pragma("unroll") for (int k = 0; k < 2; ++k) dst[m][k] = *(const LAS bf16x8*)(lds + PG8_SA(b, h) + aoff + m * 2048 + k * 1024); } while (0)
#define PG8_LDB(dst, b, h) do { _Pragma("unroll") for (int n = 0; n < 2; ++n) _Pragma("unroll") for (int k = 0; k < 2; ++k) dst[n][k] = *(const LAS bf16x8*)(lds + PG8_SB(b, h) + boff + n * 2048 + k * 1024); } while (0)
#define PG8_MMA(ai, bj, At, Bt) do { __builtin_amdgcn_s_setprio(1); _Pragma("unroll") for (int m = 0; m < 4; ++m) _Pragma("unroll") for (int n = 0; n < 2; ++n) _Pragma("unroll") for (int k = 0; k < 2; ++k) \
        acc[ai][bj][m][n] = __builtin_amdgcn_mfma_f32_16x16x32_bf16(Bt[n][k], At[m][k], acc[ai][bj][m][n], 0, 0, 0); __builtin_amdgcn_s_setprio(0); } while (0)
#define PG8_WAIT_V(n) asm volatile("s_waitcnt vmcnt(" #n ")" ::: "memory")
#define PG8_WAIT_L(n) asm volatile("s_waitcnt lgkmcnt(" #n ")" ::: "memory")
#define PG8_BAR __builtin_amdgcn_s_barrier()
#define PG8_SCHED __builtin_amdgcn_sched_barrier(0)
    Unit cur, nxt; int ui = 0;
    if (!S.next(0, cur)) return;
    f32x4 acc[2][2][4][2];
    { const float z = opaque_zero();
#pragma unroll
    for (int a = 0; a < 2; ++a)
#pragma unroll
        for (int b = 0; b < 2; ++b)
#pragma unroll
            for (int m = 0; m < 4; ++m)
#pragma unroll
                for (int n = 0; n < 2; ++n) acc[a][b][m][n] = (f32x4){z, z, z, z}; }
    bf16x8 At[4][2], B0[2][2], B1[2][2];
    const char* cA = (const char*)g.A + (size_t)cur.pm * tstep; const char* cB = (const char*)g.Bt + (size_t)cur.pn * tstep;
    S.a_ready(cur);
    if constexpr (Epi::RSL) E.rs_fetch(cur, tid, 0);
    if constexpr (SP2) {
        PG8_STAGE(PG8_SB(0, 0), cB, voffB); PG8_STAGE(PG8_SB(0, 1), cB + hstep, voffB); PG8_STAGE(PG8_SA(0, 0), cA, voffA); PG8_STAGE(PG8_SA(0, 1), cA + hstep, voffA);
        if (wr == 1) PG8_BAR;
        PG8_WAIT_V(2); PG8_BAR;
        PG8_STAGE(PG8_SB(1, 0), cB + kstep, voffB); PG8_STAGE(PG8_SA(1, 0), cA + kstep, voffA); PG8_STAGE(PG8_SB(1, 1), cB + hstep + kstep, voffB);
        PG8_WAIT_V(6); PG8_BAR;
    } else {
        PG8_STAGE(PG8_SB(0, 0), cB, voffB); PG8_STAGE(PG8_SA(0, 0), cA, voffA); PG8_STAGE(PG8_SB(0, 1), cB + hstep, voffB); PG8_STAGE(PG8_SA(0, 1), cA + hstep, voffA);
        if (wr == 1) PG8_BAR;
        PG8_WAIT_V(4); PG8_BAR;
        PG8_STAGE(PG8_SB(1, 0), cB + kstep, voffB); PG8_STAGE(PG8_SA(1, 0), cA + kstep, voffA); PG8_STAGE(PG8_SB(1, 1), cB + hstep + kstep, voffB);
        PG8_WAIT_V(6); PG8_BAR;
    }
    for (;;) {
        const bool has_next = S.next(ui + 1, nxt);
        const char* nA = has_next ? (const char*)g.A + (size_t)nxt.pm * tstep : cA; const char* nB = has_next ? (const char*)g.Bt + (size_t)nxt.pn * tstep : cB;
        for (int t = 0; t < nt; t += 2) {
            const bool last = (t == nt - 2);
            const char* a1 = cA + (size_t)(t + 1) * kstep;
            const char* a2 = last ? nA : cA + (size_t)(t + 2) * kstep; const char* b2 = last ? nB : cB + (size_t)(t + 2) * kstep;
            const char* a3 = a2 + kstep; const char* b3 = b2 + kstep;
            if (last && has_next) S.a_ready(nxt);
            if constexpr (SP2) {
            PG8_LDB(B0, 0, 0); PG8_LDB(B1, 0, 1); PG8_SCHED; PG8_LDA(At, 0, 0); PG8_STAGE(PG8_SA(1, 1), a1 + hstep, voffA);
            PG8_WAIT_V(8); PG8_WAIT_L(0); PG8_BAR; PG8_MMA(0, 0, At, B0); PG8_MMA(0, 1, At, B1); PG8_BAR; PG8_SCHED;
            PG8_LDA(At, 0, 1); PG8_STAGE(PG8_SB(0, 0), b2, voffB); PG8_STAGE(PG8_SB(0, 1), b2 + hstep, voffB); PG8_STAGE(PG8_SA(0, 0), a2, voffA);
            PG8_WAIT_V(8); PG8_WAIT_L(0); PG8_BAR; PG8_MMA(1, 0, At, B0); PG8_MMA(1, 1, At, B1); PG8_BAR; PG8_SCHED;
            PG8_LDB(B0, 1, 0); PG8_LDB(B1, 1, 1); PG8_SCHED; PG8_LDA(At, 1, 0); PG8_STAGE(PG8_SA(0, 1), a2 + hstep, voffA);
            PG8_WAIT_V(8); PG8_WAIT_L(0); PG8_BAR; PG8_MMA(0, 0, At, B0); PG8_MMA(0, 1, At, B1); PG8_BAR; PG8_SCHED;
            PG8_LDA(At, 1, 1); PG8_STAGE(PG8_SB(1, 0), b3, voffB); PG8_STAGE(PG8_SB(1, 1), b3 + hstep, voffB); PG8_STAGE(PG8_SA(1, 0), a3, voffA);
            PG8_WAIT_V(8); PG8_WAIT_L(0); PG8_BAR; PG8_MMA(1, 0, At, B0); PG8_MMA(1, 1, At, B1); PG8_BAR; PG8_SCHED;
            } else {
            PG8_LDB(B0, 0, 0); PG8_SCHED; PG8_LDA(At, 0, 0); PG8_STAGE(PG8_SA(1, 1), a1 + hstep, voffA);
            PG8_WAIT_L(8); PG8_BAR; PG8_WAIT_L(0); PG8_MMA(0, 0, At, B0); PG8_BAR; PG8_SCHED;
            PG8_LDB(B1, 0, 1); PG8_STAGE(PG8_SB(0, 0), b2, voffB);
            PG8_BAR; PG8_WAIT_L(0); PG8_MMA(0, 1, At, B1); PG8_BAR;
            PG8_LDA(At, 0, 1); PG8_STAGE(PG8_SA(0, 0), a2, voffA);
            PG8_BAR; PG8_WAIT_L(0); PG8_MMA(1, 0, At, B0); PG8_BAR; PG8_SCHED;
            PG8_STAGE(PG8_SB(0, 1), b2 + hstep, voffB);
            PG8_WAIT_V(6); PG8_BAR; PG8_MMA(1, 1, At, B1); PG8_BAR;
            PG8_LDB(B0, 1, 0); PG8_SCHED; PG8_LDA(At, 1, 0); PG8_STAGE(PG8_SA(0, 1), a2 + hstep, voffA);
            PG8_WAIT_L(8); PG8_BAR; PG8_WAIT_L(0); PG8_MMA(0, 0, At, B0); PG8_BAR; PG8_SCHED;
            PG8_LDB(B1, 1, 1); PG8_STAGE(PG8_SB(1, 0), b3, voffB);
            PG8_BAR; PG8_WAIT_L(0); PG8_MMA(0, 1, At, B1); PG8_BAR;
            PG8_LDA(At, 1, 1); PG8_STAGE(PG8_SA(1, 0), a3, voffA);
            PG8_BAR; PG8_WAIT_L(0); PG8_MMA(1, 0, At, B0); PG8_BAR; PG8_SCHED;
            PG8_STAGE(PG8_SB(1, 1), b3 + hstep, voffB);
            PG8_WAIT_V(6); PG8_BAR; PG8_MMA(1, 1, At, B1); PG8_BAR;
            }
        }
        if constexpr (ALIGN_EPI) { if (wr == 0) PG8_BAR; }
        if constexpr (!Epi::AFTER_DRAIN) { E(acc, cur, wr, wc, fr, fq, ui & 1); S.done(cur); if constexpr (Epi::RSL) { if (has_next) E.rs_fetch(nxt, tid, (ui + 1) & 1); } }
        if (!has_next) break;
        { const float z = opaque_zero();
#pragma unroll
        for (int a = 0; a < 2; ++a)
#pragma unroll
            for (int b = 0; b < 2; ++b)
#pragma unroll
                for (int m = 0; m < 4; ++m)
#pragma unroll
                    for (int n = 0; n < 2; ++n) acc[a][b][m][n] = (f32x4){z, z, z, z}; }
        cur = nxt; cA = nA; cB = nB; ++ui;
        if constexpr (ALIGN_EPI) { if (wr == 1) PG8_BAR; }
    }
    PG8_WAIT_V(0);
    if constexpr (!ALIGN_EPI) { if (wr == 0) PG8_BAR; }
    PG8_BAR;
#undef PG8_SA
#undef PG8_SB
#undef PG8_STAGE
#undef PG8_LDA
#undef PG8_LDB
#undef PG8_MMA
#undef PG8_WAIT_V
#undef PG8_WAIT_L
#undef PG8_BAR
#undef PG8_SCHED
}
}

struct SEpiBf16 { bf16* O; int ldc; int act; const float* rstd;
    __device__ __forceinline__ void operator()(int row, int col, f32x4 s0, f32x4 s1) const {
        { const float r_ = rstd[row]; s0 = s0 * r_; s1 = s1 * r_; }
        if (act) {
#pragma unroll
            for (int j = 0; j < 4; ++j) { const float a = fmaxf(s0[j], 0.f), b = fmaxf(s1[j], 0.f); s0[j] = a * a; s1[j] = b * b; } }
        u32x4 w; w.x = cvtpk(s0[0], s0[1]); w.y = cvtpk(s0[2], s0[3]); w.z = cvtpk(s1[0], s1[1]); w.w = cvtpk(s1[2], s1[3]);
        *(u32x4*)(O + (size_t)row * ldc + col) = w; } };
struct SEpiResAdd { bf16* XB; float* Y; int ldc; bool fin;
    __device__ __forceinline__ void operator()(int row, int col, f32x4 s0, f32x4 s1) const {
        const size_t off = (size_t)row * ldc + col; const u32x4 w = *(const u32x4*)(XB + off);
        const f32x4 v0 = (f32x4){bflo(w.x) + s0[0], bfhi(w.x) + s0[1], bflo(w.y) + s0[2], bfhi(w.y) + s0[3]}, v1 = (f32x4){bflo(w.z) + s1[0], bfhi(w.z) + s1[1], bflo(w.w) + s1[2], bfhi(w.w) + s1[3]};
        if (fin) { *(f32x4*)(Y + off) = v0; *(f32x4*)(Y + off + 4) = v1; }
        else { u32x4 o; o.x = cvtpk(v0[0], v0[1]); o.y = cvtpk(v0[2], v0[3]); o.z = cvtpk(v1[0], v1[1]); o.w = cvtpk(v1[2], v1[3]); *(u32x4*)(XB + off) = o; } } };
template <class Epi, int MR = 64>
__device__ __forceinline__ void sample_gemm(LAS unsigned char* lds, int wave, int vcu, int G, const bf16* __restrict__ A, const bf16* __restrict__ Bt, int N, int K, const Epi& E) {
    int ln_; asm volatile("v_mbcnt_lo_u32_b32 %0, -1, 0\n\tv_mbcnt_hi_u32_b32 %0, -1, %0" : "=v"(ln_)); const int tid = wave * 64 + ln_;
    const int lane = tid & 63, fr = lane & 15, fq = lane >> 4;
    constexpr int MB = MR / 16, NRT = 256 / MR;
    const int ntiles = NRT * (N >> 6), kslice = K >> 3, kb = wave * kslice;
    LAS float* red = (LAS float*)lds;
    for (int t = vcu; t < ntiles; t += G) {
        const int rt = t % NRT, ct = t / NRT;
        f32x4 acc[MB][4];
        { const float z = opaque_zero();
#pragma unroll
          for (int m = 0; m < MB; ++m)
#pragma unroll
              for (int n = 0; n < 4; ++n) acc[m][n] = (f32x4){z, z, z, z}; }
        const bf16* ap = A + (size_t)(rt * MR + fr) * K + kb + 8 * fq;
        const bf16* bp = Bt + (size_t)(ct * 64 + fr) * K + kb + 8 * fq;
        const size_t r16 = (size_t)16 * K;
#pragma unroll 4
        for (int k = 0; k < kslice; k += 64) {
            bf16x8 a0[MB], a1[MB], b0[4], b1[4];
#pragma unroll
            for (int m = 0; m < MB; ++m) { a0[m] = *(const bf16x8*)(ap + m * r16 + k); a1[m] = *(const bf16x8*)(ap + m * r16 + k + 32); }
#pragma unroll
            for (int n = 0; n < 4; ++n) { b0[n] = *(const bf16x8*)(bp + n * r16 + k); b1[n] = *(const bf16x8*)(bp + n * r16 + k + 32); }
#pragma unroll
            for (int m = 0; m < MB; ++m)
#pragma unroll
                for (int n = 0; n < 4; ++n) { acc[m][n] = __builtin_amdgcn_mfma_f32_16x16x32_bf16(a0[m], b0[n], acc[m][n], 0, 0, 0);
                                              acc[m][n] = __builtin_amdgcn_mfma_f32_16x16x32_bf16(a1[m], b1[n], acc[m][n], 0, 0, 0); }
        }
        __syncthreads();
#pragma unroll
        for (int m = 0; m < MB; ++m)
#pragma unroll
            for (int n = 0; n < 4; ++n)
#pragma unroll
                for (int j = 0; j < 4; ++j) red[wave * (MR * 64) + (16 * m + 4 * fq + j) * 64 + 16 * n + fr] = acc[m][n][j];
        __syncthreads();
        if (tid < MR * 8) {
            const int row = tid >> 3, col = (tid & 7) * 8;
            f32x4 s0 = *(const LAS f32x4*)(red + row * 64 + col), s1 = *(const LAS f32x4*)(red + row * 64 + col + 4);
#pragma unroll
            for (int w = 1; w < 8; ++w) { s0 = s0 + *(const LAS f32x4*)(red + w * (MR * 64) + row * 64 + col); s1 = s1 + *(const LAS f32x4*)(red + w * (MR * 64) + row * 64 + col + 4); }
            E(rt * MR + row, ct * 64 + col, s0, s1);
        }
    }
    __syncthreads();
}

#define XB_TMO      128
#define XB_XCNT(j)  (256  + 64 * (j))
#define XB_XSUB(j)  (1280 + 64 * (j))
#define XB_XGEN(j)  (2304 + 64 * (j))
#define XB_TOP      3328
#define XB_TOPGEN   3392
#define XCD_BAR_WORDS 3456
#define XB_SPIN_CAP (1u << 18)
__device__ __forceinline__ unsigned xb_ld(unsigned* p)              { return __hip_atomic_load(p, __ATOMIC_RELAXED, __HIP_MEMORY_SCOPE_AGENT); }
__device__ __forceinline__ unsigned xb_add(unsigned* p, unsigned v) { return __hip_atomic_fetch_add(p, v, __ATOMIC_RELAXED, __HIP_MEMORY_SCOPE_AGENT); }
__device__ __forceinline__ unsigned xb_xcc_id() { return (unsigned)__builtin_amdgcn_s_getreg((3 << 11) | 20) & 0xFu; }
#define XB_SPIN(cond, bar) do { unsigned _sp = 0; while (cond) { __builtin_amdgcn_s_sleep(1); \
    if ((++_sp & 255u) == 0u) { if (xb_ld(&(bar)[XB_TMO])) break; if (_sp > XB_SPIN_CAP) { atomicAdd(&(bar)[XB_TMO], 1u); break; } } } } while (0)
struct XcdBarrier { unsigned* bar; unsigned x; volatile LAS unsigned* st; };
__device__ __forceinline__ XcdBarrier xcd_barrier_post(unsigned* bar, volatile LAS unsigned* st, bool leader) {
    XcdBarrier b; b.bar = bar; b.x = xb_xcc_id(); b.st = st;
    if (leader) (void)xb_add(&bar[XB_XCNT(b.x)], 1u);
    return b;
}
__device__ __forceinline__ void xcd_barrier_complete(unsigned* bar, unsigned x, unsigned& nloc, unsigned& nx) {
    const unsigned G = gridDim.x * gridDim.y * gridDim.z;
    unsigned sum, cnt, mine, sp = 0u;
    for (;;) {
        sum = 0u; cnt = 0u; mine = 0u;
#pragma unroll
        for (unsigned j = 0; j < 16; ++j) { const unsigned c = xb_ld(&bar[XB_XCNT(j)]); sum += c; cnt += (c > 0u) ? 1u : 0u; mine = (j == x) ? c : mine; }
        if (sum == G) break;
        __builtin_amdgcn_s_sleep(1);
        if ((++sp & 255u) == 0u) { if (xb_ld(&bar[XB_TMO])) break; if (sp > XB_SPIN_CAP) { atomicAdd(&bar[XB_TMO], 1u); break; } }
    }
    nloc = mine > 0u ? mine : 1u; nx = cnt > 0u ? cnt : 1u;
}
__device__ __noinline__ void xcd_barrier(unsigned* bar_, unsigned x_, volatile LAS unsigned* st_, int wave_) {
    XcdBarrier b; b.bar = bar_; b.x = x_; b.st = st_;
    int ln_; asm volatile("v_mbcnt_lo_u32_b32 %0, -1, 0\n\tv_mbcnt_hi_u32_b32 %0, -1, %0" : "=v"(ln_)); const bool leader_ = (wave_ == 0) && (ln_ == 0);
    asm volatile("s_waitcnt vmcnt(0)" ::: "memory");
    __syncthreads();
    if (leader_) {
        unsigned* bar = b.bar;
        __builtin_amdgcn_s_waitcnt(0);
        unsigned nloc = b.st[0], nx = b.st[1];
        if (nloc == 0u) { xcd_barrier_complete(bar, b.x, nloc, nx); b.st[0] = nloc; b.st[1] = nx; }
        const unsigned old = xb_add(&bar[XB_XSUB(b.x)], 1u);
        const unsigned gen = old / nloc;
        if (old + 1u == (gen + 1u) * nloc) {
            __builtin_amdgcn_fence(__ATOMIC_RELEASE, "agent");
            asm volatile("s_waitcnt vmcnt(0)" ::: "memory");
            const unsigned og = xb_add(&bar[XB_TOP], 1u);
            const unsigned tg = og / nx;
            if (og + 1u == (tg + 1u) * nx) xb_add(&bar[XB_TOPGEN], 1u);
            else XB_SPIN(xb_ld(&bar[XB_TOPGEN]) == tg, bar);
            __builtin_amdgcn_fence(__ATOMIC_ACQUIRE, "agent");
            xb_add(&bar[XB_XGEN(b.x)], 1u);
            asm volatile("s_waitcnt vmcnt(0)" ::: "memory");
        } else {
            XB_SPIN(xb_ld(&bar[XB_XGEN(b.x)]) == gen, bar);
            __builtin_amdgcn_fence(__ATOMIC_ACQUIRE, "agent");
            asm volatile("s_waitcnt vmcnt(0)" ::: "memory");
        }
    }
    __syncthreads();
}

#define KSWZ(row, colB) ((row) * 256 + ((colB) ^ (((row) & 7) << 4)))
__device__ __forceinline__ int crow(int r, int hi) { return (r & 3) + 8 * (r >> 2) + 4 * hi; }
__device__ __forceinline__ int v_st(int k, int c) { const int kk = (k & ~0xC) | ((k & 4) << 1) | ((k & 8) >> 1); return ((kk >> 3) * 4 + (c >> 5)) * 512 + ((kk & 7) * 32 + (c & 31)) * 2; }
__device__ __forceinline__ int v_rd_base(int lane) { return ((lane & 3) << 3) | (((lane >> 2) & 3) << 6) | (((lane >> 4) & 1) << 5) | (((lane >> 5) & 1) << 8); }
constexpr int v_rd_off(int d0, int ks, int half) { return d0 * 512 + ks * 4096 + half * 2048; }
template <int OFF> __device__ __forceinline__ s16x4 tr_read(int vb) {
    s16x4 r; asm volatile("ds_read_b64_tr_b16 %0, %1 offset:%2" : "=&v"(r) : "v"(vb), "i"(OFF) : "memory"); return r;
}
#define PKLH(L, H) (bf16x8){L[0], L[1], L[2], L[3], H[0], H[1], H[2], H[3]}
template <int D0> __device__ __forceinline__ void pv_one(f32x16& od, int vb, bf16x8 pa0, bf16x8 pa1, bf16x8 pa2, bf16x8 pa3) {
    const s16x4 l0 = tr_read<v_rd_off(D0, 0, 0)>(vb), h0 = tr_read<v_rd_off(D0, 0, 1)>(vb), l1 = tr_read<v_rd_off(D0, 1, 0)>(vb), h1 = tr_read<v_rd_off(D0, 1, 1)>(vb);
    const s16x4 l2 = tr_read<v_rd_off(D0, 2, 0)>(vb), h2 = tr_read<v_rd_off(D0, 2, 1)>(vb), l3 = tr_read<v_rd_off(D0, 3, 0)>(vb), h3 = tr_read<v_rd_off(D0, 3, 1)>(vb);
    asm volatile("s_waitcnt lgkmcnt(0)" ::: "memory"); SBAR();
    od = __builtin_amdgcn_mfma_f32_32x32x16_bf16(pa0, PKLH(l0, h0), od, 0, 0, 0);
    od = __builtin_amdgcn_mfma_f32_32x32x16_bf16(pa1, PKLH(l1, h1), od, 0, 0, 0);
    od = __builtin_amdgcn_mfma_f32_32x32x16_bf16(pa2, PKLH(l2, h2), od, 0, 0, 0);
    od = __builtin_amdgcn_mfma_f32_32x32x16_bf16(pa3, PKLH(l3, h3), od, 0, 0, 0);
}
__device__ __forceinline__ void pv_d0(f32x16* o, int vb, bf16x8 pa0, bf16x8 pa1, bf16x8 pa2, bf16x8 pa3) {
    pv_one<0>(o[0], vb, pa0, pa1, pa2, pa3); pv_one<1>(o[1], vb, pa0, pa1, pa2, pa3); pv_one<2>(o[2], vb, pa0, pa1, pa2, pa3); pv_one<3>(o[3], vb, pa0, pa1, pa2, pa3);
}
template <int D0, int KS> __device__ __forceinline__ bf16x8 tr_frag(int vb) {
    const s16x4 l = tr_read<v_rd_off(D0, KS, 0)>(vb), h = tr_read<v_rd_off(D0, KS, 1)>(vb);
    return PKLH(l, h);
}
__device__ __forceinline__ void qkt(f32x16& p0, f32x16& p1, int Ks  , const bf16x8* qr, int r32, int hi) {
    p0 = f32x16{}; p1 = f32x16{};
#pragma unroll
    for (int d0 = 0; d0 < 8; ++d0) { const int cb = (d0 * 16 + hi * 8) * 2;
        const bf16x8 b0 = *(const LAS bf16x8*)(uintptr_t)(unsigned)(Ks + KSWZ(r32, cb));
        const bf16x8 b1 = *(const LAS bf16x8*)(uintptr_t)(unsigned)(Ks + KSWZ(32 + r32, cb));
        p0 = __builtin_amdgcn_mfma_f32_32x32x16_bf16(b0, qr[d0], p0, 0, 0, 0);
        p1 = __builtin_amdgcn_mfma_f32_32x32x16_bf16(b1, qr[d0], p1, 0, 0, 0); }
}
#define PK4(P, BASE, OUT) do { unsigned a0 = cvtpk(P[BASE + 0], P[BASE + 1]), a1 = cvtpk(P[BASE + 2], P[BASE + 3]);   \
    unsigned b0 = cvtpk(P[BASE + 4], P[BASE + 5]), b1 = cvtpk(P[BASE + 6], P[BASE + 7]);                              \
    auto r0 = __builtin_amdgcn_permlane32_swap(a0, b0, false, false); auto r1 = __builtin_amdgcn_permlane32_swap(a1, b1, false, false); \
    u32x4 w = {r0[0], r1[0], r0[1], r1[1]}; OUT = *reinterpret_cast<bf16x8*>(&w); } while (0)
__device__ __forceinline__ float half_swap_add(float v) { auto rr = __builtin_amdgcn_permlane32_swap(__float_as_uint(v), __float_as_uint(v), false, false); return __uint_as_float(rr[0]) + __uint_as_float(rr[1]); }
__device__ __forceinline__ float half_swap_max(float v) { auto rr = __builtin_amdgcn_permlane32_swap(__float_as_uint(v), __float_as_uint(v), false, false); return fmaxf(__uint_as_float(rr[0]), __uint_as_float(rr[1])); }

struct Args {
    const float* x_prompt; const float* x_sample; const float* cache_k; const float* cache_v; const float* state_conv; const float* state_c; const float* state_n; const float* state_m;
    const float* norm_mix_g; const float* w_in; const float* conv_w; const float* q_norm_g; const float* k_norm_g; const float* rel_bias; const float* b_igate; const float* b_fgate;
    const float* mlstm_norm_g; const float* w_out; const float* norm_mlp_g; const float* w_up; const float* w_down;
    float* out; unsigned char* ws; int ph_lo, ph_hi, rep, pad;
};
struct Ctx {
    LAS unsigned char* lds; int tid, lane, wave, G, vcu;
};
constexpr int NPH_LAYER = 9, NPHASES = DEPTH * NPH_LAYER;
__device__ __forceinline__ int hw_tid(int wave) { int ln; asm volatile("v_mbcnt_lo_u32_b32 %0, -1, 0\n\tv_mbcnt_hi_u32_b32 %0, -1, %0" : "=v"(ln)); return wave * 64 + ln; }
__device__ __forceinline__ Ctx relaunder(const Ctx& c) { Ctx d = c; const int t = hw_tid(c.wave); d.tid = t; d.lane = t & 63; return d; }

__device__ __forceinline__ void transpose_item(const float* W, int K, int ldn, int nblk, bf16* WT, LAS float* scr, int item, int lane, const float* gain = nullptr) {
    const int kb = item / nblk, nb = item % nblk, k0 = 64 * kb, n0 = 32 * nb;
    const int c = lane & 7;
    f32x4 g0 = (f32x4){1.f, 1.f, 1.f, 1.f}, g1 = g0;
    if (gain) { g0 = *(const f32x4*)(gain + k0 + 8 * c); g1 = *(const f32x4*)(gain + k0 + 8 * c + 4); }
#pragma unroll 8
    for (int i = 0; i < 32; ++i) { const int kk = 2 * i + (lane >> 5); scr[kk * 33 + (lane & 31)] = W[(size_t)(k0 + kk) * ldn + n0 + (lane & 31)]; }
    LDS_WAIT(); asm volatile("" ::: "memory");
#pragma unroll
    for (int j = 0; j < 4; ++j) { const int n = (lane >> 3) + 8 * j; const LAS float* s = scr + (8 * c) * 33 + n;
        u32x4 o; o.x = cvtpk(s[0 * 33] * g0[0], s[1 * 33] * g0[1]); o.y = cvtpk(s[2 * 33] * g0[2], s[3 * 33] * g0[3]); o.z = cvtpk(s[4 * 33] * g1[0], s[5 * 33] * g1[1]); o.w = cvtpk(s[6 * 33] * g1[2], s[7 * 33] * g1[3]);
        *(GAS u32x4*)(WT + (size_t)(n0 + n) * K + k0 + 8 * c) = o; }
    LDS_WAIT(); asm volatile("" ::: "memory");
}
__device__ __forceinline__ void convert_weights(const Args& a, const Ctx& c, int l) {
    LAS float* scr = (LAS float*)(c.lds + c.wave * 16384);
    const int gw = c.vcu * NWAVES + c.wave, NGW = c.G * NWAVES;
    constexpr int I_IN = (D / 64) * (NPROJ / 32), I_OUT = (D / 64) * (D / 32), I_UP = (D / 64) * (FF / 32), I_DN = (FF / 64) * (D / 32), I_L = I_IN + I_OUT + I_UP + I_DN;
    for (int it = gw; it < I_L; it += NGW) {
        int r = it;
        if (r < I_IN) { transpose_item(a.w_in + (size_t)l * D * IN_DIM, D, IN_DIM, NPROJ / 32, (bf16*)(a.ws + WS_WIN), scr, r, c.lane, a.norm_mix_g + (size_t)l * D); continue; } r -= I_IN;
        if (r < I_OUT) { transpose_item(a.w_out + (size_t)l * D * D, D, D, D / 32, (bf16*)(a.ws + WS_WOUT), scr, r, c.lane); continue; } r -= I_OUT;
        if (r < I_UP) { transpose_item(a.w_up + (size_t)l * D * FF, D, FF, FF / 32, (bf16*)(a.ws + WS_WUP), scr, r, c.lane, a.norm_mlp_g + (size_t)l * D); continue; } r -= I_UP;
        transpose_item(a.w_down + (size_t)l * FF * D, FF, D, D / 32, (bf16*)(a.ws + WS_WDN), scr, r, c.lane);
    }
}

__device__ __forceinline__ void build_kv_image(const Args& a, int w, int nw, int tid, int l) {
    bf16* SK = (bf16*)(a.ws + WS_SK + (size_t)(l & 1) * SKV_IMG); bf16* SV = (bf16*)(a.ws + WS_SV + (size_t)(l & 1) * SKV_IMG);
    const unsigned gt = (unsigned)w * NTHREADS + tid, NT = (unsigned)nw * NTHREADS;
    constexpr unsigned NCH = (unsigned)SBATCH * 512 * 1024 / 8;
    for (unsigned i = gt; i < 2 * NCH; i += NT) {
        const bool isv = i >= NCH; const unsigned j = isv ? i - NCH : i; const unsigned e = j * 8; const unsigned b = e / (512 * 1024); const unsigned rem = e % (512 * 1024);
        const float* src = (isv ? a.cache_v : a.cache_k) + ((size_t)(l * SBATCH + b) * 512 * 1024) + rem;
        const f32x4 x0 = *(const f32x4*)src, x1 = *(const f32x4*)(src + 4);
        u32x4 w4; w4.x = cvtpk(x0.x, x0.y); w4.y = cvtpk(x0.z, x0.w); w4.z = cvtpk(x1.x, x1.y); w4.w = cvtpk(x1.z, x1.w);
        *(u32x4*)((isv ? SV : SK) + (size_t)b * SKV_ROWS * 1024 + rem) = w4;
    }
    constexpr unsigned NZ = (unsigned)SBATCH * (SKV_ROWS - 544) * 1024 / 8;
    for (unsigned i = gt; i < 2 * NZ; i += NT) {
        const bool isv = i >= NZ; const unsigned j = isv ? i - NZ : i; const unsigned e = j * 8; const unsigned b = e / ((SKV_ROWS - 544) * 1024); const unsigned rem = e % ((SKV_ROWS - 544) * 1024);
        { const unsigned z = __float_as_uint(opaque_zero()); *(u32x4*)((isv ? SV : SK) + ((size_t)b * SKV_ROWS + 544) * 1024 + rem) = (u32x4){z, z, z, z}; }
    }
}
__device__ __forceinline__ float log_sigmoid(float x) { return fminf(x, 0.f) - fast_log(1.0f + fast_exp(-fabsf(x))); }
template <bool FIRST  >
__device__ __forceinline__ void phase_norm(const Args& a, const Ctx& c_in0, int l) {
    const Ctx c = relaunder(c_in0);
    bf16* XB = (bf16*)(a.ws + WS_XB); bf16* H = (bf16*)(a.ws + WS_H);
    const float* g = (FIRST ? a.norm_mix_g : a.norm_mlp_g) + (size_t)l * D;
    LAS float* Wg = (LAS float*)c.lds;
    if (FIRST) {
        convert_weights(a, c, l);
        __syncthreads();
        const float* wsrc = a.w_in + (size_t)l * D * IN_DIM + NPROJ;
        for (int idx = c.tid; idx < 8 * D; idx += NTHREADS) { const int k = idx >> 3, o = idx & 7; Wg[o * D + k] = wsrc[(size_t)k * IN_DIM + o]; }
        __syncthreads();
    }
    const int gw = c.vcu * NWAVES + c.wave, NGW = c.G * NWAVES;
    f32x4 gv[8];
#pragma unroll
    for (int j = 0; j < 8; ++j) gv[j] = *(const f32x4*)(g + 4 * c.lane + 256 * j);
    for (int row = gw; row < MR; row += NGW) {
        f32x4 v[8]; float s = 0.f;
        if (FIRST && l == 0) {
            const float* src = row < MP ? a.x_prompt + (size_t)row * D : a.x_sample + (size_t)(row - MP) * D;
#pragma unroll
            for (int j = 0; j < 8; ++j) v[j] = *(const f32x4*)(src + 4 * c.lane + 256 * j);
#pragma unroll
            for (int j = 0; j < 8; ++j) { u32x2 w; w.x = cvtpk(v[j].x, v[j].y); w.y = cvtpk(v[j].z, v[j].w); *(u32x2*)(XB + (size_t)row * D + 4 * c.lane + 256 * j) = w; }
        } else {
            u32x2 w[8];
#pragma unroll
            for (int j = 0; j < 8; ++j) w[j] = *(const u32x2*)(XB + (size_t)row * D + 4 * c.lane + 256 * j);
#pragma unroll
            for (int j = 0; j < 8; ++j) v[j] = (f32x4){bflo(w[j].x), bfhi(w[j].x), bflo(w[j].y), bfhi(w[j].y)};
        }
#pragma unroll
        for (int j = 0; j < 8; ++j) s += (v[j].x * v[j].x + v[j].y * v[j].y) + (v[j].z * v[j].z + v[j].w * v[j].w);
        const float rstd = fast_rsqrt(wave_sum(s, c.lane) * (1.f / D) + EPS);
        if (c.lane == 0) ((float*)(a.ws + WS_RSTD))[row] = rstd;
        if (FIRST) {
#pragma unroll
            for (int j = 0; j < 8; ++j) v[j] = v[j] * rstd * gv[j];
            float ga[8];
#pragma unroll
            for (int o = 0; o < 8; ++o) { float t = 0.f;
#pragma unroll
                for (int j = 0; j < 8; ++j) { const f32x4 w4 = *(const LAS f32x4*)(Wg + o * D + 4 * c.lane + 256 * j); t += (v[j].x * w4.x + v[j].y * w4.y) + (v[j].z * w4.z + v[j].w * w4.w); }
                ga[o] = wave_sum(t, c.lane); }
            float val = ga[0];
#pragma unroll
            for (int o = 1; o < 8; ++o) val = (c.lane == o) ? ga[o] : val;
            if (c.lane < 8) {
                float r;
                if (c.lane < 4) r = val + a.b_igate[l * MH + c.lane];
                else r = log_sigmoid(val + a.b_fgate[l * MH + c.lane - 4]);
                ((float*)(a.ws + WS_GATE))[(size_t)row * 8 + c.lane] = r;
            }
        }
    }
    if (FIRST && l == 0) build_kv_image(a, c.vcu, c.G, c.tid, 0);
}

__device__ __forceinline__ float scan256_sum(float v, int tid, int lane, int wave, LAS float* tot  ) {
#pragma unroll
    for (int o = 1; o < 64; o <<= 1) { const float t = shup(v, o, lane); if (lane >= o) v += t; }
    if (lane == 63) tot[wave] = v;
    __syncthreads();
    float off = 0.f;
#pragma unroll
    for (int w = 0; w < 3; ++w) off += (w < wave) ? tot[w] : 0.f;
    __syncthreads();
    return v + off;
}
__device__ __forceinline__ float scan256_max(float v, int tid, int lane, int wave, LAS float* tot) {
#pragma unroll
    for (int o = 1; o < 64; o <<= 1) { const float t = shup(v, o, lane); if (lane >= o) v = fmaxf(v, t); }
    if (lane == 63) tot[wave] = v;
    __syncthreads();
    float off = -3.0e38f;
#pragma unroll
    for (int w = 0; w < 3; ++w) off = (w < wave) ? fmaxf(off, tot[w]) : off;
    __syncthreads();
    return fmaxf(v, off);
}

__device__ __forceinline__ void m1_unit(const Args& a, const Ctx& c_in, int l, int unit) {
    const int g = unit & 31, bh = unit >> 5, b = bh >> 2, h = bh & 3;
    const bf16* PROJ = (const bf16*)(a.ws + WS_BIG);
    const float* GATE = (const float*)(a.ws + WS_GATE);
    Ctx c = c_in; { int t_ = c.tid; asm volatile("" : "+v"(t_)); c.tid = t_; c.lane = t_ & 63; }
    LAS float* scr = (LAS float*)(c.lds + SCR_OFF);
    LAS float* W_S = scr;
    LAS float* NACC = scr + 256;
    LAS float* TOT = scr + 384;
    LAS float* SCAL = scr + 392;
    const int row0 = b * SEQ + g * 256;
    LAS float* PART = scr + 400;
    const int sr = c.tid >> 4, sc = (c.tid & 15) * 8;
    u32x4 kq8[8], vq8[8];
#pragma unroll
    for (int t = 0; t < 4; ++t)
#pragma unroll
        for (int hh = 0; hh < 2; ++hh) { const int rr = t * 64 + hh * 32 + sr; const size_t ro = (size_t)(row0 + rr) * NPROJ;
            kq8[t * 2 + hh] = *(const u32x4*)(PROJ + ro + C_MK + h * HD + sc); vq8[t * 2 + hh] = *(const u32x4*)(PROJ + ro + C_MV + h * HD + sc); }
    __syncthreads();
    float li = 0.f, lf = 0.f;
    if (c.tid < 256) { li = GATE[(size_t)(row0 + c.tid) * 8 + h]; lf = GATE[(size_t)(row0 + c.tid) * 8 + 4 + h]; }
    const float bc = scan256_sum(lf, c.tid, c.lane, c.wave, TOT);
    const float as = li - bc;
    const float am = scan256_max(c.tid < 256 ? as : -3.0e38f, c.tid, c.lane, c.wave, TOT);
    if (c.tid == 255) { SCAL[0] = am; SCAL[1] = bc; }
    __syncthreads();
    const float amax = SCAL[0], blast = SCAL[1];
    if (c.tid < 256) W_S[c.tid] = fast_exp(as - amax);
    __syncthreads();
#pragma unroll
    for (int t = 0; t < 4; ++t)
#pragma unroll
        for (int hh = 0; hh < 2; ++hh) {
            const int rr = t * 64 + hh * 32 + sr;
            const u32x4 kq = kq8[t * 2 + hh];
            const u32x4 vq = vq8[t * 2 + hh];
            const float w = W_S[rr] * 0.08838834764831845f;
            float kf[8] = {bflo(kq.x) * w, bfhi(kq.x) * w, bflo(kq.y) * w, bfhi(kq.y) * w, bflo(kq.z) * w, bfhi(kq.z) * w, bflo(kq.w) * w, bfhi(kq.w) * w};
            u32x4 kw; kw.x = cvtpk(kf[0], kf[1]); kw.y = cvtpk(kf[2], kf[3]); kw.z = cvtpk(kf[4], kf[5]); kw.w = cvtpk(kf[6], kf[7]);
            *(LAS u32x4*)(c.lds + t * 16384 + v_st(hh * 32 + sr, sc)) = kw;
            *(LAS u32x4*)(c.lds + 65536 + t * 16384 + v_st(hh * 32 + sr, sc)) = vq;
        }
    __syncthreads();
    {
        const int col = c.tid & 127, t = c.tid >> 7; float s = 0.f;
        for (int k = 0; k < 64; ++k) s += bf2f(*(const LAS bf16*)(c.lds + t * 16384 + v_st(k, col)));
        PART[c.tid] = s;
    }
    __syncthreads();
    const int Da = c.wave >> 1, Db0 = 2 * (c.wave & 1);
    f32x16 acc0 = f32x16{}, acc1 = f32x16{};
    const int vbk = (int)(uintptr_t)(c.lds) + v_rd_base(c.lane) + Da * 512;
    const int vbv = (int)(uintptr_t)(c.lds) + 65536 + v_rd_base(c.lane) + Db0 * 512;
#pragma unroll
    for (int t = 0; t < 4; ++t) {
        const int ak = vbk + t * 16384, av = vbv + t * 16384;
        const bf16x8 a0 = tr_frag<0, 0>(ak), a1 = tr_frag<0, 1>(ak), a2 = tr_frag<0, 2>(ak), a3 = tr_frag<0, 3>(ak);
        const bf16x8 b00 = tr_frag<0, 0>(av), b01 = tr_frag<0, 1>(av), b02 = tr_frag<0, 2>(av), b03 = tr_frag<0, 3>(av);
        const bf16x8 b10 = tr_frag<1, 0>(av), b11 = tr_frag<1, 1>(av), b12 = tr_frag<1, 2>(av), b13 = tr_frag<1, 3>(av);
        asm volatile("s_waitcnt lgkmcnt(0)" ::: "memory"); SBAR();
        acc0 = __builtin_amdgcn_mfma_f32_32x32x16_bf16(a0, b00, acc0, 0, 0, 0); acc1 = __builtin_amdgcn_mfma_f32_32x32x16_bf16(a0, b10, acc1, 0, 0, 0);
        acc0 = __builtin_amdgcn_mfma_f32_32x32x16_bf16(a1, b01, acc0, 0, 0, 0); acc1 = __builtin_amdgcn_mfma_f32_32x32x16_bf16(a1, b11, acc1, 0, 0, 0);
        acc0 = __builtin_amdgcn_mfma_f32_32x32x16_bf16(a2, b02, acc0, 0, 0, 0); acc1 = __builtin_amdgcn_mfma_f32_32x32x16_bf16(a2, b12, acc1, 0, 0, 0);
        acc0 = __builtin_amdgcn_mfma_f32_32x32x16_bf16(a3, b03, acc0, 0, 0, 0); acc1 = __builtin_amdgcn_mfma_f32_32x32x16_bf16(a3, b13, acc1, 0, 0, 0);
    }
    float* CL = (float*)(a.ws + WS_CLOC) + (size_t)unit * HD * HD;
    const int r32 = c.lane & 31, hi = c.lane >> 5;
#pragma unroll
    for (int r = 0; r < 16; ++r) { const int d = 32 * Da + crow(r, hi);
        CL[(size_t)d * HD + 32 * Db0 + r32] = acc0[r]; CL[(size_t)d * HD + 32 * (Db0 + 1) + r32] = acc1[r]; }
    if (c.tid < 128) ((float*)(a.ws + WS_NLOC))[(size_t)unit * HD + c.tid] = (PART[c.tid] + PART[128 + c.tid]) + (PART[256 + c.tid] + PART[384 + c.tid]);
    if (c.tid == 0) { float* ms = (float*)(a.ws + WS_MSC) + (size_t)unit * 4; ms[0] = blast + amax; ms[1] = blast; }
}

__device__ __forceinline__ void sample_mixers(const Args& a, const Ctx& c, int l);
template <bool WITH_QK>
__device__ __forceinline__ void phase_c(const Args& a, const Ctx& c_in0, int l) {
    const Ctx c = relaunder(c_in0);
    bf16* PROJ = (bf16*)(a.ws + WS_BIG); bf16* MIX = (bf16*)(a.ws + WS_H);
    constexpr int WSMP = SBATCH * NH + SBATCH * MH;
    const bool split = c.G > 2 * WSMP;
    if (WITH_QK && (!split || c.vcu < WSMP)) sample_mixers(a, c, l);
    for (int u = c.vcu; u < 16 * NGRP; u += c.G) m1_unit(a, c, l, u);
    const int gw = c.vcu * NWAVES + c.wave, NGW = c.G * NWAVES;
    if (WITH_QK) {
        const float* gq = a.q_norm_g + l * HD; const float* gk = a.k_norm_g + l * HD;
        const int gi = (16 * c.lane) & 127;
        f32x4 gqv[4], gkv[4];
#pragma unroll
        for (int j = 0; j < 4; ++j) { gqv[j] = *(const f32x4*)(gq + gi + 4 * j); gkv[j] = *(const f32x4*)(gk + gi + 4 * j); }
        bf16* SK = (bf16*)(a.ws + WS_SK + (size_t)(l & 1) * SKV_IMG); bf16* SV = (bf16*)(a.ws + WS_SV + (size_t)(l & 1) * SKV_IMG);
        constexpr int NIT = NB * KEEP;
        for (int it = gw; it < NIT; it += NGW) {
            const int row = (it / KEEP) * SEQ + (SEQ - KEEP) + (it % KEEP);
            const bf16* p = PROJ + (size_t)row * NPROJ + C_K + 16 * c.lane;
            const u32x4 w0 = *(const u32x4*)p, w1 = *(const u32x4*)(p + 8);
            const bf16* pv = PROJ + (size_t)row * NPROJ + C_V + 16 * c.lane;
            const u32x4 v0 = *(const u32x4*)pv, v1 = *(const u32x4*)(pv + 8);
            const int b = row / SEQ, t = row % SEQ; const size_t o = ((size_t)(l * NB + b) * KEEP + (t - (SEQ - KEEP))) * 1024 + 16 * c.lane;
            float* ok = a.out + O_PK + o; float* ov = a.out + O_PV + o;
            *(f32x4*)(ok + 0) = (f32x4){bflo(w0.x), bfhi(w0.x), bflo(w0.y), bfhi(w0.y)}; *(f32x4*)(ok + 4) = (f32x4){bflo(w0.z), bfhi(w0.z), bflo(w0.w), bfhi(w0.w)};
            *(f32x4*)(ok + 8) = (f32x4){bflo(w1.x), bfhi(w1.x), bflo(w1.y), bfhi(w1.y)}; *(f32x4*)(ok + 12) = (f32x4){bflo(w1.z), bfhi(w1.z), bflo(w1.w), bfhi(w1.w)};
            *(f32x4*)(ov + 0) = (f32x4){bflo(v0.x), bfhi(v0.x), bflo(v0.y), bfhi(v0.y)}; *(f32x4*)(ov + 4) = (f32x4){bflo(v0.z), bfhi(v0.z), bflo(v0.w), bfhi(v0.w)};
            *(f32x4*)(ov + 8) = (f32x4){bflo(v1.x), bfhi(v1.x), bflo(v1.y), bfhi(v1.y)}; *(f32x4*)(ov + 12) = (f32x4){bflo(v1.z), bfhi(v1.z), bflo(v1.w), bfhi(v1.w)};
        }
    }
    {
        const int ch = 8 * c.lane;
        float w0[8], w1[8], w2[8];
#pragma unroll
        for (int i = 0; i < 8; ++i) { w0[i] = a.conv_w[(size_t)(l * 3 + 0) * 512 + ch + i]; w1[i] = a.conv_w[(size_t)(l * 3 + 1) * 512 + ch + i]; w2[i] = a.conv_w[(size_t)(l * 3 + 2) * 512 + ch + i]; }
        constexpr int NSEG = SEQ / 32, NITEM = NB * NSEG + SBATCH;
        const int gwc = split ? (c.vcu - WSMP) * NWAVES + c.wave : gw, NGWc = split ? (c.G - WSMP) * NWAVES : NGW;
        for (int it = gwc; it >= 0 && it < NITEM; it += NGWc) {
            float u2[8], u1[8]; int rowb; bool samp = it >= NB * NSEG; int b, seg = 0;
            if (!samp) { b = it / NSEG; seg = it % NSEG; rowb = b * SEQ + seg * 32; } else { b = it - NB * NSEG; rowb = MP + b * SSEQ; }
#pragma unroll
            for (int i = 0; i < 8; ++i) { u2[i] = 0.f; u1[i] = 0.f; }
            if (samp) {
#pragma unroll
                for (int i = 0; i < 8; ++i) { u2[i] = a.state_conv[((size_t)(l * SBATCH + b) * 2 + 0) * 512 + ch + i]; u1[i] = a.state_conv[((size_t)(l * SBATCH + b) * 2 + 1) * 512 + ch + i]; }
            } else if (seg > 0) {
#pragma unroll
                for (int q = 0; q < 2; ++q) { const bf16* pr = PROJ + (size_t)(rowb - 2 + q) * NPROJ + ch;
                    const u32x4 xa = *(const u32x4*)(pr + C_XA), gc = *(const u32x4*)(pr + C_GC);
                    float* dst = q ? u1 : u2;
                    dst[0] = bflo(xa.x) * bflo(gc.x); dst[1] = bfhi(xa.x) * bfhi(gc.x); dst[2] = bflo(xa.y) * bflo(gc.y); dst[3] = bfhi(xa.y) * bfhi(gc.y);
                    dst[4] = bflo(xa.z) * bflo(gc.z); dst[5] = bfhi(xa.z) * bfhi(gc.z); dst[6] = bflo(xa.w) * bflo(gc.w); dst[7] = bfhi(xa.w) * bfhi(gc.w); }
            }
            for (int t0 = 0; t0 < 32; t0 += 4) {
                u32x4 xa4[4], gb4[4], gc4[4];
#pragma unroll
                for (int q = 0; q < 4; ++q) { const bf16* pr = PROJ + (size_t)(rowb + t0 + q) * NPROJ + ch; xa4[q] = *(const u32x4*)(pr + C_XA); gb4[q] = *(const u32x4*)(pr + C_GB); gc4[q] = *(const u32x4*)(pr + C_GC); }
#pragma unroll
                for (int q = 0; q < 4; ++q) { const int t = t0 + q;
                const u32x4 xa = xa4[q], gb = gb4[q], gc = gc4[q];
                float u0[8] = {bflo(xa.x) * bflo(gc.x), bfhi(xa.x) * bfhi(gc.x), bflo(xa.y) * bflo(gc.y), bfhi(xa.y) * bfhi(gc.y),
                               bflo(xa.z) * bflo(gc.z), bfhi(xa.z) * bfhi(gc.z), bflo(xa.w) * bflo(gc.w), bfhi(xa.w) * bfhi(gc.w)};
                float gbf[8] = {bflo(gb.x), bfhi(gb.x), bflo(gb.y), bfhi(gb.y), bflo(gb.z), bfhi(gb.z), bflo(gb.w), bfhi(gb.w)};
                float y[8];
#pragma unroll
                for (int i = 0; i < 8; ++i) { y[i] = gbf[i] * (w0[i] * u2[i] + w1[i] * u1[i] + w2[i] * u0[i]); u2[i] = u1[i]; u1[i] = u0[i]; }
                u32x4 o; o.x = cvtpk(y[0], y[1]); o.y = cvtpk(y[2], y[3]); o.z = cvtpk(y[4], y[5]); o.w = cvtpk(y[6], y[7]);
                *(u32x4*)(MIX + (size_t)(rowb + t) * D + ch) = o;
                }
            }
            float* oc = nullptr;
            if (samp) oc = a.out + O_SCONV + (size_t)(l * SBATCH + b) * 2 * 512 + ch;
            else if (seg == NSEG - 1) oc = a.out + O_PCONV + (size_t)(l * NB + b) * 2 * 512 + ch;
            if (oc) {
                *(f32x4*)(oc) = (f32x4){u2[0], u2[1], u2[2], u2[3]}; *(f32x4*)(oc + 4) = (f32x4){u2[4], u2[5], u2[6], u2[7]};
                *(f32x4*)(oc + 512) = (f32x4){u1[0], u1[1], u1[2], u1[3]}; *(f32x4*)(oc + 516) = (f32x4){u1[4], u1[5], u1[6], u1[7]};
            }
        }
    }
}

__device__ __forceinline__ void phase_d(const Args& a, const Ctx& c_in0, int l) {
    const Ctx c = relaunder(c_in0);
    const float* CL = (const float*)(a.ws + WS_CLOC); const float* NL = (const float*)(a.ws + WS_NLOC); float* MSC = (float*)(a.ws + WS_MSC);
    bf16* C0 = (bf16*)(a.ws + WS_C0); float* N0 = (float*)(a.ws + WS_N0);
    LAS float* DEC = (LAS float*)(c.lds + SCR_OFF);
    LAS float* WLO = DEC + 512;
    LAS float* MFIN = WLO + 512;
    LAS float* MLO = MFIN + 16;
    LAS float* BLA = MLO + 512;
    __syncthreads();
    { const int u = c.tid; MLO[u] = MSC[(size_t)u * 4 + 0]; BLA[u] = MSC[(size_t)u * 4 + 1]; }
    __syncthreads();
    if (c.tid < 16) { const int bh = c.tid; float m = 0.f;
        for (int g = 0; g < NGRP; ++g) { const size_t u = (size_t)bh * NGRP + g; const float mloc = MLO[u], blast = BLA[u];
            const float mn = fmaxf(blast + m, mloc); DEC[bh * NGRP + g] = fast_exp(blast + m - mn); WLO[bh * NGRP + g] = fast_exp(mloc - mn);
            if (c.vcu == 0) MSC[u * 4 + 2] = m;
            m = mn; }
        MFIN[bh] = m; }
    __syncthreads();
    const unsigned gt = (unsigned)c.vcu * NTHREADS + c.tid, NT = (unsigned)c.G * NTHREADS;
    constexpr unsigned PER = (unsigned)HD * HD + HD;
    for (unsigned i = gt; i < 16u * PER; i += NT) {
        const int bh = (int)(i / PER); const int e = (int)(i % PER); const bool isn = e >= HD * HD; const int en = e - HD * HD;
        const float* src = isn ? NL + (size_t)bh * NGRP * HD + en : CL + (size_t)bh * NGRP * HD * HD + e;
        const size_t sstep = isn ? HD : (size_t)HD * HD;
        float x[NGRP];
#pragma unroll
        for (int g = 0; g < NGRP; ++g) x[g] = src[(size_t)g * sstep];
        float C = 0.f;
#pragma unroll
        for (int g = 0; g < NGRP; ++g) {
            const size_t u = (size_t)bh * NGRP + g;
            if (isn) N0[u * HD + en] = C; else C0[u * HD * HD + e] = (bf16)(cvtpk(C, 0.f) & 0xffffu);
            C = DEC[bh * NGRP + g] * C + WLO[bh * NGRP + g] * x[g];
        }
        const int b = bh >> 2, h = bh & 3;
        if (isn) a.out[O_PN + ((size_t)(l * NB + b) * MH + h) * HD + en] = C;
        else a.out[O_PC + ((size_t)(l * NB + b) * MH + h) * HD * HD + e] = C;
        if (e == 0) a.out[O_PM + (size_t)(l * NB + b) * MH + h] = MFIN[bh];
    }
}

constexpr float ATT_C = 0.088388347648318440f * LOG2E;
constexpr float THR2 = 8.f * LOG2E;
struct DmaMap { unsigned k0, k1, v0, v1; };
__device__ __forceinline__ DmaMap dma_map(int lane, int wave, int LD) {
    DmaMap m; unsigned kk_[2], vv_[2];
#pragma unroll
    for (int i = 0; i < 2; ++i) { const int o = (wave + 8 * i) * 1024 + lane * 16;
        const int row = o >> 8, c16 = ((o >> 4) & 15) ^ (row & 7); kk_[i] = (unsigned)(row * LD + c16 * 8) * 2u;
        const int sub = o >> 9, kk = ((sub >> 2) << 3) | ((o >> 6) & 7), k = (kk & ~0xC) | ((kk & 4) << 1) | ((kk & 8) >> 1), cc = ((sub & 3) << 5) | ((o & 63) >> 1); vv_[i] = (unsigned)(k * LD + cc) * 2u; }
    m.k0 = kk_[0]; m.k1 = kk_[1]; m.v0 = vv_[0]; m.v1 = vv_[1]; return m;
}
__device__ __forceinline__ void glds16s(const void* sbase, unsigned voff, unsigned lds_dst) { unsigned keep;
    asm volatile("s_mov_b32 %0, m0\n\ts_mov_b32 m0, %3\n\ts_nop 0\n\tglobal_load_lds_dwordx4 %1, %2\n\ts_mov_b32 m0, %0" : "=&s"(keep) : "v"(voff), "s"(sbase), "s"(lds_dst) : "memory"); }
__device__ __forceinline__ void dma_fill(LAS unsigned char* lds, int slot, int wave, const bf16* Ta, unsigned a0, unsigned a1, const bf16* Tb, unsigned b0, unsigned b1) {
    const unsigned d = (unsigned)(uintptr_t)lds + (unsigned)(slot * 32768 + wave * 1024);
    glds16s(Ta, a0, d); glds16s(Ta, a1, d + 8192u); glds16s(Tb, b0, d + 16384u); glds16s(Tb, b1, d + 24576u);
}
#define RING_WAIT_BAR(N) do { asm volatile("s_waitcnt vmcnt(" #N ") lgkmcnt(0)" ::: "memory"); __builtin_amdgcn_s_barrier(); asm volatile("" ::: "memory"); } while (0)

__device__ __forceinline__ float fma_s(float a, float b, float c) { float d; asm("v_fma_f32 %0, %1, %2, %3" : "=v"(d) : "v"(a), "v"(b), "v"(c)); return d; }
__device__ __forceinline__ float add_s(float a, float b) { float d; asm("v_add_f32 %0, %1, %2" : "=v"(d) : "v"(a), "v"(b)); return d; }
#define ATT_SCORE_SOFTMAX(j, slotk)                                                                                                           \
    {   const int K_lds = ldsb + (slotk) * 16384;                                                                                              \
        f32x16 p0, p1; qkt(p0, p1, K_lds, qr, r32, hi);                                                                                       \
        STEP_FILL();                                                             \
        const int Rl = R0 + r32 - 64 * (j);                                                                                                   \
        const int relmin = R0 - 64 * (j) - 63;                                                                                                \
        if (relmin >= 128) { const float bc = BR[0];                                                                                           \
            _Pragma("unroll") for (int r = 0; r < 16; ++r) { p0[r] = fma_s(p0[r], ATT_C, bc); p1[r] = fma_s(p1[r], ATT_C, bc); }                \
        } else {                                                                                                                               \
            const LAS float* bp = BR + (64 + 128 - Rl + 4 * hi);                                                                               \
            _Pragma("unroll") for (int r = 0; r < 16; ++r) { p0[r] = fma_s(p0[r], ATT_C, bp[(r & 3) + 8 * (r >> 2)]); p1[r] = fma_s(p1[r], ATT_C, bp[32 + (r & 3) + 8 * (r >> 2)]); } \
        }                                                                                                                                      \
        const int nvalid = kend - 64 * (j);                                                                                                    \
        if (nvalid < 64) { asm volatile("" ::: "memory");                           \
            _Pragma("unroll") for (int r = 0; r < 16; ++r) { const int kk = crow(r, hi); if (kk >= nvalid) p0[r] = -1e30f; if (kk + 32 >= nvalid) p1[r] = -1e30f; } \
        }                                                                                                                                      \
        float pmax = p0[0];                                                                                                                    \
        _Pragma("unroll") for (int r = 1; r < 16; ++r) pmax = fmaxf(pmax, p0[r]);                                                              \
        _Pragma("unroll") for (int r = 0; r < 16; ++r) pmax = fmaxf(pmax, p1[r]);                                                              \
        pmax = half_swap_max(pmax);                                                                                                            \
        if (!__all(pmax - m_reg <= THR2)) {                                                                                                    \
            const float mn = fmaxf(m_reg, pmax); const float alpha = __builtin_amdgcn_exp2f(m_reg - mn); m_reg = mn;                           \
            l_reg *= alpha;                                                                                                                    \
            if (hi == 0) al_l[r32] = alpha; asm volatile("s_waitcnt lgkmcnt(0)" ::: "memory");                                               \
            _Pragma("unroll") for (int r = 0; r < 16; ++r) { const float al = al_l[crow(r, hi)];                                               \
                _Pragma("unroll") for (int d = 0; d < 4; ++d) o[d][r] *= al; }                                                                 \
        }                                                                                                                                      \
        float ps = 0.f;                                                                                                                        \
        _Pragma("unroll") for (int r = 0; r < 16; ++r) { p0[r] = __builtin_amdgcn_exp2f(p0[r] - m_reg); p1[r] = __builtin_amdgcn_exp2f(p1[r] - m_reg); ps = add_s(ps, add_s(p0[r], p1[r])); } \
        l_reg += half_swap_add(ps);                                                                                                            \
        PK4(p0, 0, pa0); PK4(p0, 8, pa1); PK4(p1, 0, pa2); PK4(p1, 8, pa3);                                                                    \
    }
__device__ __forceinline__ void attn_unit(const Ctx& c, const bf16* __restrict__ Qb, int LDQ, int qrow, const bf16* __restrict__ Kh, const bf16* __restrict__ Vh, int LDK, int NT, int alo, int ahi, int kend,
                                          int R0  , const float* __restrict__ bias_g, bf16* __restrict__ Ob, int LDO, bool do_store, const float* __restrict__ qgain = nullptr, int rot = 0) {
    int tid = c.tid; asm volatile("" : "+v"(tid));
    const int wid = c.wave, lane = tid & 63, r32 = lane & 31, hi = lane >> 5;
    const int ldsb = (int)(uintptr_t)c.lds;
    constexpr int VRING = 49152;
    LAS float* wsf = (LAS float*)(c.lds + 114688) + wid * 64; LAS float* li_l = wsf; LAS float* al_l = wsf + 32;
    LAS float* BR = (LAS float*)(c.lds + SCR_OFF);
    asm volatile("s_waitcnt lgkmcnt(0)" ::: "memory"); __builtin_amdgcn_s_barrier(); asm volatile("" ::: "memory");
    const DmaMap dm = dma_map(lane, wid, LDK);
    const size_t tile_step = (size_t)64 * LDK;
    const unsigned dbase = (unsigned)ldsb + (unsigned)wid * 1024u;
#define ATT_FILL(kt_, vt_, sk_, sv_) do { const unsigned dk_ = dbase + (unsigned)(sk_) * 16384u, dv_ = dbase + VRING + (unsigned)(sv_) * 16384u; \
        glds16s(kt_, dm.k0, dk_); glds16s(kt_, dm.k1, dk_ + 8192u); glds16s(vt_, dm.v0, dv_); glds16s(vt_, dm.v1, dv_ + 8192u); } while (0)
#define TIDX(s_) ((s_) + rot - (((s_) + rot) >= NT ? NT : 0))
    { const int t0_ = TIDX(0), t1_ = TIDX(1);
      ATT_FILL(Kh + t0_ * tile_step, Vh + t0_ * tile_step, 0, 0);
      ATT_FILL(Kh + t1_ * tile_step, Vh + t1_ * tile_step, 1, 1); }
    if (tid < 321) { const int i = tid - 64; BR[tid] = bias_g[256 - (i < 0 ? 0 : i)] * LOG2E; }
    float m_reg = -1e30f, l_reg = 0.f; f32x16 o[4] = {f32x16{}, f32x16{}, f32x16{}, f32x16{}}; bf16x8 qr[8];
    { const bf16* Qw = Qb + (size_t)(qrow + r32) * LDQ + hi * 8;
#pragma unroll
      for (int d0 = 0; d0 < 8; ++d0) qr[d0] = *(const bf16x8*)(Qw + d0 * 16); }
    if (qgain) {
        float f[8][8]; float ss = 0.f;
#pragma unroll
        for (int d0 = 0; d0 < 8; ++d0) { const u32x4 w = *reinterpret_cast<const u32x4*>(&qr[d0]);
            f[d0][0] = bflo(w.x); f[d0][1] = bfhi(w.x); f[d0][2] = bflo(w.y); f[d0][3] = bfhi(w.y); f[d0][4] = bflo(w.z); f[d0][5] = bfhi(w.z); f[d0][6] = bflo(w.w); f[d0][7] = bfhi(w.w);
#pragma unroll
            for (int i = 0; i < 8; ++i) ss += f[d0][i] * f[d0][i]; }
        ss = half_swap_add(ss);
        const float rq = fast_rsqrt(ss * (1.f / HD) + EPS);
#pragma unroll
        for (int d0 = 0; d0 < 8; ++d0) { const f32x4 g0 = *(const f32x4*)(qgain + d0 * 16 + hi * 8), g1 = *(const f32x4*)(qgain + d0 * 16 + hi * 8 + 4);
            u32x4 s; s.x = cvtpk(f[d0][0] * rq * g0[0], f[d0][1] * rq * g0[1]); s.y = cvtpk(f[d0][2] * rq * g0[2], f[d0][3] * rq * g0[3]);
            s.z = cvtpk(f[d0][4] * rq * g1[0], f[d0][5] * rq * g1[1]); s.w = cvtpk(f[d0][6] * rq * g1[2], f[d0][7] * rq * g1[3]);
            qr[d0] = *reinterpret_cast<bf16x8*>(&s); }
    }
#pragma unroll
    for (int d0 = 0; d0 < 8; ++d0) { u32x4 w = *reinterpret_cast<u32x4*>(&qr[d0]); asm volatile("" : "+v"(w)); qr[d0] = *reinterpret_cast<bf16x8*>(&w); }
    asm volatile("" ::: "memory");
    const bool skew = wid >= 4;
    bf16x8 pa0 = bf16x8{}, pa1 = bf16x8{}, pa2 = bf16x8{}, pa3 = bf16x8{};
    int sk = 0, sv = 0;
    bool pact = false;
    for (int j = 0; j < NT; ++j) {
        if (j + 1 < NT) RING_WAIT_BAR(4); else RING_WAIT_BAR(0);
#define STEP_FILL() do { if (j + 2 < NT) { const int fk = sk >= 1 ? sk - 1 : 2, fv = sv >= 2 ? sv - 2 : sv + 2; const int tf = TIDX(j + 2); ATT_FILL(Kh + tf * tile_step, Vh + tf * tile_step, fk, fv); } } while (0)
        const int jt = TIDX(j);
        const bool act = (jt >= alo && jt <= ahi);
        if (skew && pact) { const int svp = sv >= 1 ? sv - 1 : 3; pv_d0(o, ldsb + VRING + svp * 16384 + v_rd_base(lane), pa0, pa1, pa2, pa3); }
        pact = act;
        if (act) { ATT_SCORE_SOFTMAX(jt, sk); } else STEP_FILL();
        if (!skew && act) pv_d0(o, ldsb + VRING + sv * 16384 + v_rd_base(lane), pa0, pa1, pa2, pa3);
        sk = sk == 2 ? 0 : sk + 1; sv = (sv + 1) & 3;
    }
    if (skew && pact) { const int svp = sv >= 1 ? sv - 1 : 3; pv_d0(o, ldsb + VRING + svp * 16384 + v_rd_base(lane), pa0, pa1, pa2, pa3); }
#undef STEP_FILL
#undef TIDX
#undef ATT_FILL
    if (hi == 0) li_l[r32] = l_reg;
    RING_WAIT_BAR(0);
    const int ost = ldsb + wid * 8192;
#pragma unroll
    for (int r = 0; r < 16; ++r) { const int orow = crow(r, hi); const float rl = __builtin_amdgcn_rcpf(li_l[orow]);
#pragma unroll
        for (int d0 = 0; d0 < 4; ++d0) *(LAS bf16*)(uintptr_t)(unsigned)(ost + orow * 256 + (d0 * 32 + r32) * 2) = (bf16)(cvtpk(o[d0][r] * rl, 0.f) & 0xffffu); }
    asm volatile("s_waitcnt lgkmcnt(0)" ::: "memory");
    if (do_store) {
#pragma unroll
        for (int i = 0; i < 8; ++i) { const int ch = i * 64 + lane, row = ch >> 4, c16 = ch & 15;
            const u32x4 w = *(const LAS u32x4*)(uintptr_t)(unsigned)(ost + row * 256 + c16 * 16);
            *(u32x4*)(Ob + (size_t)(qrow + row) * LDO + c16 * 8) = w; }
    }
}
__device__ __forceinline__ void attn_stream(const Args& a, const Ctx& c, int l) {
    constexpr int NATT = NB * NH * 32;
    if (c.vcu >= NATT) return;
    int tid = c.tid; asm volatile("" : "+v"(tid));
    const int wid = c.wave, lane = tid & 63, r32 = lane & 31, hi = lane >> 5;
    const int ldsb = (int)(uintptr_t)c.lds;
    constexpr int VRING = 49152;
    LAS float* wsf = (LAS float*)(c.lds + 114688) + wid * 64; LAS float* li_l = wsf; LAS float* al_l = wsf + 32;
    LAS float* BR = (LAS float*)(c.lds + SCR_OFF);
    const bf16* PROJ = (const bf16*)(a.ws + WS_BIG); bf16* MIX = (bf16*)(a.ws + WS_H);
    const int gq = c.vcu & 31, h = (c.vcu >> 5) & 7, b0 = c.vcu >> 8, db = c.G >> 8, nun = (NB - b0 + db - 1) / db;
    const int c0 = 4 * gq, jstart = c0 >= 8 ? 0 : 8 - c0, NT = 12 - jstart, ci = wid >> 1;
    const int alo = ci - jstart < 0 ? 0 : ci - jstart, ahi = ci + 8 - jstart, kend = NT * 64;
    const int R0 = (ci + 8 - jstart) * 64 + (wid & 1) * 32, rot = gq >= 2 ? (8 * gq + 8) % 12 : 0, qrow = wid * 32;
    const float* bias_g = a.rel_bias + (size_t)(l * NH + h) * 257;
    constexpr int LDK = NPROJ, LDO = D;
    asm volatile("s_waitcnt lgkmcnt(0)" ::: "memory"); __builtin_amdgcn_s_barrier(); asm volatile("" ::: "memory");
    const DmaMap dm = dma_map(lane, wid, LDK);
    const size_t tile_step = (size_t)64 * LDK;
    const unsigned dbase = (unsigned)ldsb + (unsigned)wid * 1024u;
#define ATT_FILL(kt_, vt_, sk_, sv_) do { const unsigned dk_ = dbase + (unsigned)(sk_) * 16384u, dv_ = dbase + VRING + (unsigned)(sv_) * 16384u; \
        glds16s(kt_, dm.k0, dk_); glds16s(kt_, dm.k1, dk_ + 8192u); glds16s(vt_, dm.v0, dv_); glds16s(vt_, dm.v1, dv_ + 8192u); } while (0)
#define TIDX(s_) ((s_) + rot - (((s_) + rot) >= NT ? NT : 0))
    const bf16* Qb = PROJ + (size_t)(b0 * SEQ + c0 * 64) * NPROJ + C_Q + h * HD;
    const bf16* Kh = PROJ + (size_t)(b0 * SEQ + (c0 - 8 + jstart) * 64) * NPROJ + C_K + h * HD;
    const bf16* Vh = PROJ + (size_t)(b0 * SEQ + (c0 - 8 + jstart) * 64) * NPROJ + C_V + h * HD;
    bf16* Ob = MIX + (size_t)(b0 * SEQ + c0 * 64) * D + 512 + h * HD;
    const size_t dproj = (size_t)db * SEQ * NPROJ, dmix = (size_t)db * SEQ * D;
    { const int t0_ = TIDX(0), t1_ = TIDX(1);
      ATT_FILL(Kh + t0_ * tile_step, Vh + t0_ * tile_step, 0, 0);
      ATT_FILL(Kh + t1_ * tile_step, Vh + t1_ * tile_step, 1, 1); }
    if (tid < 321) { const int i = tid - 64; BR[tid] = bias_g[256 - (i < 0 ? 0 : i)] * LOG2E; }
    bf16x8 qr[8];
    { const bf16* Qw = Qb + (size_t)(qrow + r32) * NPROJ + hi * 8;
#pragma unroll
      for (int d0 = 0; d0 < 8; ++d0) qr[d0] = *(const bf16x8*)(Qw + d0 * 16); }
    const bool skew = wid >= 4;
    int sk = 0, sv = 0;
#pragma unroll 1
    for (int ui = 0; ui < nun; ++ui) {
        const bool has_next = ui + 1 < nun;
        const bf16* Khn = Kh + dproj; const bf16* Vhn = Vh + dproj;
#pragma unroll
        for (int d0 = 0; d0 < 8; ++d0) { u32x4 w = *reinterpret_cast<u32x4*>(&qr[d0]); asm volatile("" : "+v"(w)); qr[d0] = *reinterpret_cast<bf16x8*>(&w); }
        asm volatile("" ::: "memory");
        float m_reg = -1e30f, l_reg = 0.f; f32x16 o[4] = {f32x16{}, f32x16{}, f32x16{}, f32x16{}};
        bf16x8 pa0 = bf16x8{}, pa1 = bf16x8{}, pa2 = bf16x8{}, pa3 = bf16x8{};
        bool pact = false;
        for (int j = 0; j < NT; ++j) {
            if (j + 1 < NT || has_next) RING_WAIT_BAR(4); else RING_WAIT_BAR(0);
#define STEP_FILL() do { const int fk = sk >= 1 ? sk - 1 : 2, fv = sv >= 2 ? sv - 2 : sv + 2;                                                                  \
                if (j + 2 < NT) { const int tf = TIDX(j + 2); ATT_FILL(Kh + tf * tile_step, Vh + tf * tile_step, fk, fv); }                                         \
                else if (has_next) { const int tf = TIDX(j + 2 - NT); ATT_FILL(Khn + tf * tile_step, Vhn + tf * tile_step, fk, fv); } } while (0)
            const int jt = TIDX(j);
            const bool act = (jt >= alo && jt <= ahi);
            if (skew && pact) { const int svp = sv >= 1 ? sv - 1 : 3; pv_d0(o, ldsb + VRING + svp * 16384 + v_rd_base(lane), pa0, pa1, pa2, pa3); }
            pact = act;
            if (act) { ATT_SCORE_SOFTMAX(jt, sk); } else STEP_FILL();
            if (!skew && act) pv_d0(o, ldsb + VRING + sv * 16384 + v_rd_base(lane), pa0, pa1, pa2, pa3);
            sk = sk == 2 ? 0 : sk + 1; sv = (sv + 1) & 3;
        }
        if (skew && pact) { const int svp = sv >= 1 ? sv - 1 : 3; pv_d0(o, ldsb + VRING + svp * 16384 + v_rd_base(lane), pa0, pa1, pa2, pa3); }
#undef STEP_FILL
        if (has_next) { const bf16* Qw = Qb + dproj + (size_t)(qrow + r32) * NPROJ + hi * 8;
#pragma unroll
            for (int d0 = 0; d0 < 8; ++d0) qr[d0] = *(const bf16x8*)(Qw + d0 * 16); }
        if (hi == 0) li_l[r32] = l_reg;
        asm volatile("s_waitcnt lgkmcnt(0)" ::: "memory"); __builtin_amdgcn_s_barrier(); asm volatile("" ::: "memory");
        const int ost = ldsb + VRING + (((wid < 4 ? sv + 2 : sv + 3) & 3) * 16384) + (wid & 3) * 4096;
#pragma unroll
        for (int hf = 0; hf < 2; ++hf) {
#pragma unroll
            for (int r = 0; r < 16; ++r) { const int orow = crow(r, hi); const float rl = __builtin_amdgcn_rcpf(li_l[orow]);
#pragma unroll
                for (int dd = 0; dd < 2; ++dd) *(LAS bf16*)(uintptr_t)(unsigned)(ost + orow * 128 + (dd * 32 + r32) * 2) = (bf16)(cvtpk(o[2 * hf + dd][r] * rl, 0.f) & 0xffffu); }
            asm volatile("s_waitcnt lgkmcnt(0)" ::: "memory");
#pragma unroll
            for (int i = 0; i < 4; ++i) { const int ch = i * 64 + lane, row = ch >> 3, c16 = ch & 7;
                const u32x4 w = *(const LAS u32x4*)(uintptr_t)(unsigned)(ost + row * 128 + c16 * 16);
                *(u32x4*)(Ob + (size_t)(qrow + row) * LDO + hf * 64 + c16 * 8) = w; }
            asm volatile("s_waitcnt lgkmcnt(0)" ::: "memory");
        }
        Qb += dproj; Kh += dproj; Vh += dproj; Ob += dmix;
    }
#undef TIDX
#undef ATT_FILL
}
#undef ATT_SCORE_SOFTMAX

__device__ __forceinline__ void m3_unit(const Args& a, const Ctx& c, int l, int unit) {
    const int g = unit & 31, bh = unit >> 5, b = bh >> 2, h = bh & 3;
    const bf16* PROJ = (const bf16*)(a.ws + WS_BIG); bf16* MIX = (bf16*)(a.ws + WS_H);
    const float* GATE = (const float*)(a.ws + WS_GATE);
    int tid = c.tid; asm volatile("" : "+v"(tid));
    const int wid = c.wave, lane = tid & 63, r32 = lane & 31, hi = lane >> 5;
    LAS float* scr = (LAS float*)(c.lds + SCR_OFF);
    LAS float* A_S = scr;
    LAS float* M_T = scr + 256;
    LAS float* B_T = scr + 512;
    LAS float* N0L = scr + 768;
    LAS float* TOT = scr + 896;
    const int ldsb = (int)(uintptr_t)c.lds;
    LAS float* wsf = (LAS float*)(c.lds + 98304) + wid * 64;
    const int row0 = b * SEQ + g * 256;
    const float m0 = ((const float*)(a.ws + WS_MSC))[(size_t)unit * 4 + 2];
    asm volatile("s_waitcnt vmcnt(0) lgkmcnt(0)" ::: "memory"); __builtin_amdgcn_s_barrier(); asm volatile("" ::: "memory");
    const DmaMap dm = dma_map(lane, wid, NPROJ); const DmaMap dc = dma_map(lane, wid, HD);
    const bf16* kt = PROJ + (size_t)row0 * NPROJ + C_MK + h * HD; const bf16* vt = PROJ + (size_t)row0 * NPROJ + C_MV + h * HD;
    const bf16* C0 = (const bf16*)(a.ws + WS_C0) + (size_t)unit * HD * HD;
    const size_t tile_step = (size_t)64 * NPROJ;
    dma_fill(c.lds, 0, wid, kt, dm.k0, dm.k1, vt, dm.v0, dm.v1);
    dma_fill(c.lds, 1, wid, kt + tile_step, dm.k0, dm.k1, vt + tile_step, dm.v0, dm.v1);
    bf16x8 qr[8];
    const int trow = wid * 32 + r32;
    { const bf16* Qw = PROJ + (size_t)(row0 + trow) * NPROJ + C_MQ + h * HD + hi * 8;
#pragma unroll
      for (int d0 = 0; d0 < 8; ++d0) qr[d0] = *(const bf16x8*)(Qw + d0 * 16); }
    u32x4 mo8[8];
#pragma unroll
    for (int i = 0; i < 8; ++i) { const int ch = i * 64 + lane, row = ch >> 4, col = (ch & 15) * 8; mo8[i] = *(const u32x4*)(PROJ + (size_t)(row0 + wid * 32 + row) * NPROJ + C_MO + h * HD + col); }
    float li = 0.f, lf = 0.f;
    if (tid < 256) { li = GATE[(size_t)(row0 + tid) * 8 + h]; lf = GATE[(size_t)(row0 + tid) * 8 + 4 + h]; }
    if (tid < 128) N0L[tid] = ((const float*)(a.ws + WS_N0))[(size_t)unit * HD + tid];
    const float bc = scan256_sum(lf, tid, lane, wid, TOT);
    const float as = li - bc;
    const float cm = scan256_max(tid < 256 ? as : -3.0e38f, tid, lane, wid, TOT);
    if (tid < 256) { A_S[tid] = as; M_T[tid] = fmaxf(m0, cm); B_T[tid] = bc; }
    __syncthreads();
    const float Mt = M_T[trow];
    f32x16 o[4] = {f32x16{}, f32x16{}, f32x16{}, f32x16{}};
    float rowsum = 0.f, qn = 0.f;
    const float winter = fast_exp(m0 - Mt);
    const int ci = wid >> 1;
    int slot = 0;
#pragma unroll 1
    for (int j = 0; j < 4; ++j) {
        RING_WAIT_BAR(4);
        { const int fs = slot >= 1 ? slot - 1 : 2;
          if (j + 2 < 4) dma_fill(c.lds, fs, wid, kt + (size_t)(j + 2) * tile_step, dm.k0, dm.k1, vt + (size_t)(j + 2) * tile_step, dm.v0, dm.v1);
          else if (j == 2) dma_fill(c.lds, fs, wid, C0, dc.v0, dc.v1, C0 + 64 * HD, dc.v0, dc.v1); }
        const int S_lds = ldsb + slot * 32768;
        int r32l = r32; asm volatile("" : "+v"(r32l));
        if (j <= ci) {
            f32x16 p0, p1; qkt(p0, p1, S_lds, qr, r32l, hi);
#pragma unroll
            for (int r = 0; r < 16; ++r) { const int s0 = 64 * j + crow(r, hi), s1 = s0 + 32;
                const float w0 = (s0 <= trow) ? fast_exp(A_S[s0] - Mt) * 0.08838834764831845f : 0.f, w1 = (s1 <= trow) ? fast_exp(A_S[s1] - Mt) * 0.08838834764831845f : 0.f;
                p0[r] *= w0; p1[r] *= w1; rowsum += p0[r] + p1[r]; }
            bf16x8 pa0, pa1, pa2, pa3;
            PK4(p0, 0, pa0); PK4(p0, 8, pa1); PK4(p1, 0, pa2); PK4(p1, 8, pa3);
            pv_d0(o, S_lds + 16384 + v_rd_base(lane), pa0, pa1, pa2, pa3);
        }
        slot = slot == 2 ? 0 : slot + 1;
    }
    RING_WAIT_BAR(0);
    {
        const int S_lds = ldsb + slot * 32768;
#pragma unroll
        for (int hf = 0; hf < 2; ++hf) {
            bf16x8 qs[4];
#pragma unroll
            for (int dd = 0; dd < 4; ++dd) { const int d0 = hf * 4 + dd; const u32x4 w = *reinterpret_cast<const u32x4*>(&qr[d0]);
                float f[8] = {bflo(w.x), bfhi(w.x), bflo(w.y), bfhi(w.y), bflo(w.z), bfhi(w.z), bflo(w.w), bfhi(w.w)};
#pragma unroll
                for (int i = 0; i < 8; ++i) qn += f[i] * N0L[d0 * 16 + hi * 8 + i];
                u32x4 s; s.x = cvtpk(f[0] * winter, f[1] * winter); s.y = cvtpk(f[2] * winter, f[3] * winter); s.z = cvtpk(f[4] * winter, f[5] * winter); s.w = cvtpk(f[6] * winter, f[7] * winter);
                qs[dd] = *reinterpret_cast<bf16x8*>(&s); }
            pv_d0(o, S_lds + hf * 16384 + v_rd_base(lane), qs[0], qs[1], qs[2], qs[3]);
        }
    }
    rowsum = half_swap_add(rowsum);
    qn = half_swap_add(qn);
    const float den = winter * qn + rowsum;
    const float dfl = fast_exp(-(B_T[trow] + Mt));
    const float inv = 1.0f / fmaxf(fabsf(den), dfl);
    if (hi == 0) wsf[r32] = inv;
    asm volatile("s_waitcnt lgkmcnt(0)" ::: "memory");
#pragma unroll
    for (int r = 0; r < 16; ++r) { const float sc_ = wsf[crow(r, hi)];
#pragma unroll
        for (int d0 = 0; d0 < 4; ++d0) o[d0][r] *= sc_; }
    RING_WAIT_BAR(0);
    const int hst = ldsb + wid * 16384;
    { int le = lane; asm volatile("" : "+v"(le)); const int r32e = le & 31, hie = le >> 5;
#pragma unroll
    for (int r = 0; r < 16; ++r)
#pragma unroll
        for (int d0 = 0; d0 < 4; ++d0) *(LAS float*)(uintptr_t)(unsigned)(hst + crow(r, hie) * 512 + (d0 * 32 + r32e) * 4) = o[d0][r]; }
    asm volatile("s_waitcnt lgkmcnt(0)" ::: "memory");
    const float* gn = a.mlstm_norm_g + (size_t)l * 512 + h * HD;
    int le = lane; asm volatile("" : "+v"(le));
#pragma unroll
    for (int i = 0; i < 8; ++i) { const int ch = i * 64 + le, row = ch >> 4, col = (ch & 15) * 8;
        const f32x4 a0 = *(const LAS f32x4*)(uintptr_t)(unsigned)(hst + row * 512 + col * 4), a1 = *(const LAS f32x4*)(uintptr_t)(unsigned)(hst + row * 512 + col * 4 + 16);
        float ss = (a0.x * a0.x + a0.y * a0.y) + (a0.z * a0.z + a0.w * a0.w) + (a1.x * a1.x + a1.y * a1.y) + (a1.z * a1.z + a1.w * a1.w);
        ss += shx(ss, 1, le); ss += shx(ss, 2, le); ss += shx(ss, 4, le); ss += shx(ss, 8, le);
        const float rstd = fast_rsqrt(ss * (1.f / HD) + EPS);
        const int orow = row0 + wid * 32 + row;
        const u32x4 mo = mo8[i];
        const f32x4 g0 = *(const f32x4*)(gn + col), g1 = *(const f32x4*)(gn + col + 4);
        float y[8] = {a0.x * g0.x, a0.y * g0.y, a0.z * g0.z, a0.w * g0.w, a1.x * g1.x, a1.y * g1.y, a1.z * g1.z, a1.w * g1.w};
        const float mf[8] = {bflo(mo.x), bfhi(mo.x), bflo(mo.y), bfhi(mo.y), bflo(mo.z), bfhi(mo.z), bflo(mo.w), bfhi(mo.w)};
#pragma unroll
        for (int k = 0; k < 8; ++k) y[k] = y[k] * rstd * (1.0f / (1.0f + fast_exp(-mf[k])));
        u32x4 w; w.x = cvtpk(y[0], y[1]); w.y = cvtpk(y[2], y[3]); w.z = cvtpk(y[4], y[5]); w.w = cvtpk(y[6], y[7]);
        *(u32x4*)(MIX + (size_t)orow * D + 1536 + h * HD + col) = w; }
}

__device__ __forceinline__ void ms_unit(const Args& a, const Ctx& c, int l, int unit) {
    const int b = unit >> 2, h = unit & 3; int tid = c.tid; asm volatile("" : "+v"(tid));
    const int lane = tid & 63, wid = c.wave;
    const bf16* PROJ = (const bf16*)(a.ws + WS_BIG); bf16* MIX = (bf16*)(a.ws + WS_H);
    const float* GATE = (const float*)(a.ws + WS_GATE);
    constexpr int P = 132;
    LAS float* Q = (LAS float*)c.lds;
    LAS float* Kk = Q + 32 * P;
    LAS float* V = Kk + 32 * P;
    LAS float* HB = V + 32 * P;
    LAS float* S = HB + 32 * P;
    LAS float* N0 = S + 32 * 33;
    LAS float* A_S = N0 + 128;
    LAS float* M_T = A_S + 32;
    LAS float* B_T = M_T + 32;
    LAS float* WST = B_T + 32;
    LAS float* DEN = WST + 32;
    LAS float* WIN = DEN + 32;
    LAS float* SC = WIN + 32;
    const int row0 = MP + b * SSEQ;
    const size_t sidx = (size_t)(l * SBATCH + b) * MH + h;
    const float* C0 = a.state_c + sidx * HD * HD;
    __syncthreads();
    for (int i = tid; i < 1536; i += NTHREADS) { const int which = i >> 9, r = (i >> 4) & 31, c8 = (i & 15) * 8;
        const u32x4 w = *(const u32x4*)(PROJ + (size_t)(row0 + r) * NPROJ + (which == 0 ? C_MQ : which == 1 ? C_MK : C_MV) + h * HD + c8);
        const float sc = which == 1 ? 0.08838834764831845f : 1.0f;
        LAS float* dst = (which == 0 ? Q : which == 1 ? Kk : V) + r * P + c8;
        *(LAS f32x4*)dst = (f32x4){bflo(w.x) * sc, bfhi(w.x) * sc, bflo(w.y) * sc, bfhi(w.y) * sc};
        *(LAS f32x4*)(dst + 4) = (f32x4){bflo(w.z) * sc, bfhi(w.z) * sc, bflo(w.w) * sc, bfhi(w.w) * sc}; }
    if (tid < 128) N0[tid] = a.state_n[sidx * HD + tid];
    if (wid == 0) {
        const int t = lane & 31; const float m0 = a.state_m[sidx];
        const float li = GATE[(size_t)(row0 + t) * 8 + h], lf = GATE[(size_t)(row0 + t) * 8 + 4 + h];
        float bc = lf;
#pragma unroll
        for (int o = 1; o < 32; o <<= 1) { const float x = shup(bc, o, lane); if ((lane & 31) >= o) bc += x; }
        const float as = li - bc; float cm = as;
#pragma unroll
        for (int o = 1; o < 32; o <<= 1) { const float x = shup(cm, o, lane); if ((lane & 31) >= o) cm = fmaxf(cm, x); }
        const float blast = __int_as_float(__builtin_amdgcn_ds_bpermute(31 << 2, __float_as_int(bc))), amax = __int_as_float(__builtin_amdgcn_ds_bpermute(31 << 2, __float_as_int(cm)));
        const float Mt = fmaxf(m0, cm), mnew = fmaxf(blast + m0, blast + amax);
        if (lane < 32) { A_S[t] = as; B_T[t] = bc; M_T[t] = Mt; WST[t] = fast_exp(blast + as - mnew); WIN[t] = fast_exp(m0 - Mt); }
        if (lane == 0) { SC[0] = m0; SC[1] = blast; SC[2] = mnew; SC[3] = fast_exp(blast + m0 - mnew); }
    }
    __syncthreads();
    for (int i = tid; i < 1024; i += NTHREADS) { const int t = i >> 5, s = i & 31; float d = 0.f;
        if (s <= t) {
#pragma unroll 8
            for (int k = 0; k < 128; k += 4) { const f32x4 q4 = *(const LAS f32x4*)(Q + t * P + k), k4 = *(const LAS f32x4*)(Kk + s * P + k); d += (q4.x * k4.x + q4.y * k4.y) + (q4.z * k4.z + q4.w * k4.w); }
            d *= fast_exp(A_S[s] - M_T[t]); }
        S[t * 33 + s] = d; }
    __syncthreads();
    if (tid < 32) { const int t = tid; float qn = 0.f, rs = 0.f;
        for (int k = 0; k < 128; ++k) qn += Q[t * P + k] * N0[k];
        for (int s = 0; s < 32; ++s) rs += S[t * 33 + s];
        const float den = WIN[t] * qn + rs; DEN[t] = 1.0f / fmaxf(fabsf(den), fast_exp(-(B_T[t] + M_T[t]))); }
    const int e = tid & 127, tg = tid >> 7;
    { float acc[8];
#pragma unroll
      for (int i = 0; i < 8; ++i) acc[i] = 0.f;
      for (int d0 = 0; d0 < 128; d0 += 16) { float cv[16];
#pragma unroll
          for (int j = 0; j < 16; ++j) cv[j] = C0[(size_t)(d0 + j) * HD + e];
#pragma unroll
          for (int j = 0; j < 16; j += 4)
#pragma unroll
              for (int i = 0; i < 8; ++i) { const f32x4 q4 = *(const LAS f32x4*)(Q + (tg * 8 + i) * P + d0 + j); acc[i] += (q4.x * cv[j] + q4.y * cv[j + 1]) + (q4.z * cv[j + 2] + q4.w * cv[j + 3]); } }
      __syncthreads();
#pragma unroll
      for (int i = 0; i < 8; ++i) { const int t = tg * 8 + i; float v = acc[i] * WIN[t];
          for (int s = 0; s <= t; ++s) v += S[t * 33 + s] * V[s * P + e];
          HB[t * P + e] = v * DEN[t]; } }
    __syncthreads();
    { const int t = tid >> 4, e0 = (tid & 15) * 8; float ss = 0.f;
      const f32x4 h0 = *(const LAS f32x4*)(HB + t * P + e0), h1 = *(const LAS f32x4*)(HB + t * P + e0 + 4);
      ss = (h0.x * h0.x + h0.y * h0.y) + (h0.z * h0.z + h0.w * h0.w) + (h1.x * h1.x + h1.y * h1.y) + (h1.z * h1.z + h1.w * h1.w);
      ss += shx(ss, 1, lane); ss += shx(ss, 2, lane); ss += shx(ss, 4, lane); ss += shx(ss, 8, lane);
      const float rstd = fast_rsqrt(ss * (1.f / HD) + EPS);
      const u32x4 mo = *(const u32x4*)(PROJ + (size_t)(row0 + t) * NPROJ + C_MO + h * HD + e0);
      const float* gn = a.mlstm_norm_g + (size_t)l * 512 + h * HD + e0;
      const f32x4 g0 = *(const f32x4*)gn, g1 = *(const f32x4*)(gn + 4);
      float y[8] = {h0.x * g0.x, h0.y * g0.y, h0.z * g0.z, h0.w * g0.w, h1.x * g1.x, h1.y * g1.y, h1.z * g1.z, h1.w * g1.w};
      const float mf[8] = {bflo(mo.x), bfhi(mo.x), bflo(mo.y), bfhi(mo.y), bflo(mo.z), bfhi(mo.z), bflo(mo.w), bfhi(mo.w)};
#pragma unroll
      for (int k = 0; k < 8; ++k) y[k] = y[k] * rstd * (1.0f / (1.0f + fast_exp(-mf[k])));
      u32x4 w; w.x = cvtpk(y[0], y[1]); w.y = cvtpk(y[2], y[3]); w.z = cvtpk(y[4], y[5]); w.w = cvtpk(y[6], y[7]);
      *(u32x4*)(MIX + (size_t)(row0 + t) * D + 1536 + h * HD + e0) = w; }
    { const float decay = SC[3]; const int dg = tg * 32; float acc[32];
#pragma unroll
      for (int i = 0; i < 32; ++i) acc[i] = C0[(size_t)(dg + i) * HD + e] * decay;
      for (int s = 0; s < 32; ++s) { const float vv = V[s * P + e] * WST[s];
#pragma unroll
          for (int i = 0; i < 32; i += 4) { const f32x4 k4 = *(const LAS f32x4*)(Kk + s * P + dg + i); acc[i] += k4.x * vv; acc[i + 1] += k4.y * vv; acc[i + 2] += k4.z * vv; acc[i + 3] += k4.w * vv; } }
      float* oc = a.out + O_SC + sidx * HD * HD;
#pragma unroll
      for (int i = 0; i < 32; ++i) oc[(size_t)(dg + i) * HD + e] = acc[i];
      if (tid < 128) { float v = decay * N0[tid]; for (int s = 0; s < 32; ++s) v += WST[s] * Kk[s * P + tid]; a.out[O_SN + sidx * HD + tid] = v; }
      if (tid == 0) a.out[O_SM + sidx] = SC[2]; }
}

__device__ __forceinline__ void phase_e(const Args& a, const Ctx& c_in0, int l) {
    const Ctx c = relaunder(c_in0);
    const bf16* PROJ = (const bf16*)(a.ws + WS_BIG); bf16* MIX = (bf16*)(a.ws + WS_H);
    constexpr int NATT = NB * NH * 32;
#if (PE_EN & 1)
    if ((c.G & 255) == 0) attn_stream(a, c, l);
    else
    for (int u = c.vcu; u < NATT; u += c.G) {
        const int gq = u & 31, bhh = u >> 5, b = bhh >> 3, h = bhh & 7;
        const int c0 = 4 * gq, jstart = c0 >= 8 ? 0 : 8 - c0, NT = 12 - jstart, ci = c.wave >> 1;
        const int krow0 = b * SEQ + (c0 - 8 + jstart) * 64;
        const int alo = ci - jstart, ahi = ci + 8 - jstart;
        const int R0 = (ci + 8 - jstart) * 64 + (c.wave & 1) * 32;
        attn_unit(c, PROJ + (size_t)(b * SEQ + c0 * 64) * NPROJ + C_Q + h * HD, NPROJ, c.wave * 32, PROJ + (size_t)krow0 * NPROJ + C_K + h * HD, PROJ + (size_t)krow0 * NPROJ + C_V + h * HD, NPROJ,
                  NT, alo < 0 ? 0 : alo, ahi, NT * 64, R0, a.rel_bias + (size_t)(l * NH + h) * 257, MIX + (size_t)(b * SEQ + c0 * 64) * D + 512 + h * HD, D, true, nullptr,
                  gq >= 2 ? (8 * gq + 8) % 12 : 0);
    }
#endif
#if (PE_EN & 4)
    for (int u = c.vcu; u < 16 * NGRP; u += c.G) m3_unit(a, c, l, u);
#endif
}
__device__ __forceinline__ void sample_kv_prep(const Args& a, const Ctx& c, int l, int b, int h) {
    int tid = c.tid; asm volatile("" : "+v"(tid));
    const int lane = tid & 63, row = tid >> 4, c8 = (tid & 15) * 8;
    const bf16* PROJ = (const bf16*)(a.ws + WS_BIG);
    bf16* SK = (bf16*)(a.ws + WS_SK + (size_t)(l & 1) * SKV_IMG); bf16* SV = (bf16*)(a.ws + WS_SV + (size_t)(l & 1) * SKV_IMG);
    const size_t ro = (size_t)(MP + b * SSEQ + row) * NPROJ + h * HD + c8;
    const u32x4 kq = *(const u32x4*)(PROJ + ro + C_K), vq = *(const u32x4*)(PROJ + ro + C_V);
    float x[8] = {bflo(kq.x), bfhi(kq.x), bflo(kq.y), bfhi(kq.y), bflo(kq.z), bfhi(kq.z), bflo(kq.w), bfhi(kq.w)};
    float ss = 0.f;
#pragma unroll
    for (int i = 0; i < 8; ++i) ss += x[i] * x[i];
    ss += shx(ss, 1, lane); ss += shx(ss, 2, lane); ss += shx(ss, 4, lane); ss += shx(ss, 8, lane);
    const float rk = fast_rsqrt(ss * (1.f / HD) + EPS);
    const float* gk = a.k_norm_g + l * HD + c8; const f32x4 g0 = *(const f32x4*)gk, g1 = *(const f32x4*)(gk + 4);
    x[0] *= rk * g0[0]; x[1] *= rk * g0[1]; x[2] *= rk * g0[2]; x[3] *= rk * g0[3]; x[4] *= rk * g1[0]; x[5] *= rk * g1[1]; x[6] *= rk * g1[2]; x[7] *= rk * g1[3];
    u32x4 o; o.x = cvtpk(x[0], x[1]); o.y = cvtpk(x[2], x[3]); o.z = cvtpk(x[4], x[5]); o.w = cvtpk(x[6], x[7]);
    const size_t io = ((size_t)b * SKV_ROWS + 512 + row) * 1024 + h * HD + c8;
    *(u32x4*)(SK + io) = o; *(u32x4*)(SV + io) = vq;
    const size_t oo = ((size_t)(l * SBATCH + b) * SSEQ + row) * 1024 + h * HD + c8;
    float* ok = a.out + O_SK + oo; float* ov = a.out + O_SV + oo;
    *(f32x4*)ok = (f32x4){x[0], x[1], x[2], x[3]}; *(f32x4*)(ok + 4) = (f32x4){x[4], x[5], x[6], x[7]};
    *(f32x4*)ov = (f32x4){bflo(vq.x), bfhi(vq.x), bflo(vq.y), bfhi(vq.y)}; *(f32x4*)(ov + 4) = (f32x4){bflo(vq.z), bfhi(vq.z), bflo(vq.w), bfhi(vq.w)};
    asm volatile("s_waitcnt vmcnt(0)" ::: "memory"); __syncthreads();
}
__device__ __forceinline__ void sample_mixers(const Args& a, const Ctx& c, int l) {
    const bf16* PROJ = (const bf16*)(a.ws + WS_BIG); bf16* MIX = (bf16*)(a.ws + WS_H);
#if (PE_EN & 2)
    for (int su = c.vcu; su < SBATCH * NH; su += c.G) {
        const int b = su >> 3, h = su & 7;
        sample_kv_prep(a, c, l, b, h);
        const bf16* SK = (const bf16*)(a.ws + WS_SK + (size_t)(l & 1) * SKV_IMG) + (size_t)b * SKV_ROWS * 1024 + h * HD; const bf16* SV = (const bf16*)(a.ws + WS_SV + (size_t)(l & 1) * SKV_IMG) + (size_t)b * SKV_ROWS * 1024 + h * HD;
        attn_unit(c, PROJ + (size_t)(MP + b * SSEQ) * NPROJ + C_Q + h * HD, NPROJ, 0, SK, SV, 1024, 9, 0, 8, 544, 512, a.rel_bias + (size_t)(l * NH + h) * 257,
                  MIX + (size_t)(MP + b * SSEQ) * D + 512 + h * HD, D, c.wave == 0, a.q_norm_g + l * HD);
    }
#endif
#if (PE_EN & 8)
    for (int u = c.vcu - SBATCH * NH; u >= 0 && u < SBATCH * MH; u += c.G) ms_unit(a, c, l, u);
#endif
    __syncthreads();
}
typedef const __attribute__((address_space(4))) Args* KArgP;
#if defined(__HIP_DEVICE_COMPILE__)
__device__ __forceinline__ Args get_args() { KArgP p = (KArgP)__builtin_amdgcn_kernarg_segment_ptr(); asm volatile("" : "+s"(p)); return *p; }
#else
__device__ Args get_args();
#endif
__global__ void __launch_bounds__(NTHREADS, 2) fwd(Args args) {
    extern __shared__ __attribute__((aligned(16))) unsigned char lds_raw[];
    Ctx c; c.lds = (LAS unsigned char*)lds_raw; c.wave = __builtin_amdgcn_readfirstlane((int)threadIdx.x >> 6); c.tid = hw_tid(c.wave); c.lane = c.tid & 63;
    c.G = gridDim.x; { const int bx = blockIdx.x; c.vcu = (c.G % 8 == 0) ? (bx % 8) * (c.G / 8) + bx / 8 : bx; }
    volatile LAS unsigned* MISC = (volatile LAS unsigned*)(c.lds + MISC_OFF);
    { const int t0 = hw_tid(c.wave); if (t0 < 16) MISC[t0] = 0u; }
    __syncthreads();
    unsigned* barw = (unsigned*)(get_args().ws + WS_CTL) + 4096;
    XcdBarrier bar; bar.bar = barw; bar.x = 0; bar.st = nullptr;
    const int lo = args.ph_lo, hi = args.ph_hi;
    const bool multi = (hi - lo) > 1;
    if (multi) bar = xcd_barrier_post(barw, MISC + 8, hw_tid(c.wave) == 0);
#define IN(k) (lo <= (k) && (k) < hi)
#define SEAM(k) do { if (IN(k) && IN((k) + 1)) xcd_barrier(bar.bar, bar.x, bar.st, c.wave); } while (0)
    for (int l = 0; l < DEPTH; ++l) {
        const int pb = l * NPH_LAYER;
        if (IN(pb + 0)) {
#if (PH_EN >> 1) & 1
            { const Args A_ = get_args(); phase_norm<true>(A_, c, l); }
#if (PH_DUP >> 1) & 1
            { __syncthreads(); const Args A_ = get_args(); phase_norm<true>(A_, c, l); }
#endif
#endif
 __syncthreads(); SEAM(pb + 0); }
        if (IN(pb + 1)) {
            const Args A_ = get_args(); bf16* H = (bf16*)(A_.ws + WS_H); bf16* BIG = (bf16*)(A_.ws + WS_BIG);
            bf16* XBp = (bf16*)(A_.ws + WS_XB); const float* RS = (const float*)(A_.ws + WS_RSTD);
            pg8::Gemm g{XBp, (const bf16*)(A_.ws + WS_WIN), MP, NPROJ, D}; pg8::StaticOrder S; S.init(MP, NPROJ, c.G, (int)blockIdx.x, WGM_B);
            pg8::EpiProj E{BIG, NPROJ, A_.q_norm_g + l * HD, A_.k_norm_g + l * HD, (LAS float*)(c.lds + SCR_OFF), RS};

#if (PH_EN >> 2) & 1
            for (int rep_ = 0, nrep_ = ((PH_DUP >> 2) & 1) ? A_.rep : 1; rep_ < nrep_; ++rep_) pg8::gemm_phase<pg8::EpiProj, pg8::StaticOrder, true, true>(c.lds, g, S, E, c.wave);
            { SEpiBf16 SE{BIG + (size_t)MP * NPROJ, NPROJ, 0, RS + MP}; sample_gemm(c.lds, c.wave, c.vcu, c.G, XBp + (size_t)MP * D, g.Bt, NPROJ, D, SE); }
#endif

            SEAM(pb + 1);
        }
        if (IN(pb + 2)) {
#if (PH_EN >> 3) & 1
            { const Args A_ = get_args(); phase_c<true>(A_, c, l); }
#if (PH_DUP >> 3) & 1
            { __syncthreads(); const Args A_ = get_args(); phase_c<false>(A_, c, l); }
#endif
#endif
 SEAM(pb + 2); }
        if (IN(pb + 3)) {
#if (PH_EN >> 4) & 1
            { const Args A_ = get_args(); phase_d(A_, c, l); }
            { const Args A_ = get_args(); if (l + 1 < DEPTH) build_kv_image(A_, c.vcu, c.G, hw_tid(c.wave), l + 1); }
#if (PH_DUP >> 4) & 1
            { __syncthreads(); const Args A_ = get_args(); phase_d(A_, c, l); }
#endif
#endif
 SEAM(pb + 3); }
        if (IN(pb + 4)) {
#if (PH_EN >> 5) & 1
            { const Args A_ = get_args(); phase_e(A_, c, l); }
#if (PH_DUP >> 5) & 1
            { __syncthreads(); const Args A_ = get_args(); phase_e(A_, c, l); }
#endif
#endif
 __syncthreads(); SEAM(pb + 4); }
        if (IN(pb + 5)) {
            const Args A_ = get_args(); bf16* H = (bf16*)(A_.ws + WS_H);
            pg8::Gemm g{H, (const bf16*)(A_.ws + WS_WOUT), MP, D, D}; pg8::StaticOrder S; S.init(MP, D, c.G, (int)blockIdx.x, WGM_F);
            pg8::EpiResAdd E{(bf16*)(A_.ws + WS_XB), A_.out, D, false};

#if (PH_EN >> 6) & 1
            pg8::gemm_phase<pg8::EpiResAdd, pg8::StaticOrder, true, true>(c.lds, g, S, E, c.wave);
            { SEpiResAdd SE{(bf16*)(A_.ws + WS_XB) + (size_t)MP * D, A_.out + (size_t)MP * D, D, false}; sample_gemm<SEpiResAdd, 32>(c.lds, c.wave, c.vcu, c.G, H + (size_t)MP * D, g.Bt, D, D, SE); }
#if (PH_DUP >> 6) & 1
            { pg8::EpiBf16<0> E2{(bf16*)(A_.ws + WS_BIG), D, nullptr, (LAS float*)(c.lds + SCR_OFF)}; pg8::gemm_phase<pg8::EpiBf16<0>, pg8::StaticOrder, true, true>(c.lds, g, S, E2, c.wave); }
#endif
#endif

            SEAM(pb + 5);
        }
        if (IN(pb + 6)) {
#if (PH_EN >> 7) & 1
            { const Args A_ = get_args(); phase_norm<false>(A_, c, l); }
#if (PH_DUP >> 7) & 1
            { __syncthreads(); const Args A_ = get_args(); phase_norm<false>(A_, c, l); }
#endif
#endif
 SEAM(pb + 6); }
        if (IN(pb + 7)) {
            const Args A_ = get_args(); bf16* H = (bf16*)(A_.ws + WS_H); bf16* BIG = (bf16*)(A_.ws + WS_BIG);
            bf16* XBp = (bf16*)(A_.ws + WS_XB); const float* RS = (const float*)(A_.ws + WS_RSTD);
            pg8::Gemm g{XBp, (const bf16*)(A_.ws + WS_WUP), MP, FF, D}; pg8::StaticOrder S; S.init(MP, FF, c.G, (int)blockIdx.x, WGM_H);
            pg8::EpiBf16<1> E{BIG, FF, RS, (LAS float*)(c.lds + SCR_OFF)};

#if (PH_EN >> 8) & 1
            for (int rep_ = 0, nrep_ = ((PH_DUP >> 8) & 1) ? A_.rep : 1; rep_ < nrep_; ++rep_) pg8::gemm_phase<pg8::EpiBf16<1>, pg8::StaticOrder, true, true>(c.lds, g, S, E, c.wave);
            { SEpiBf16 SE{BIG + (size_t)MP * FF, FF, 1, RS + MP}; sample_gemm(c.lds, c.wave, c.vcu, c.G, XBp + (size_t)MP * D, g.Bt, FF, D, SE); }
#endif

            SEAM(pb + 7);
        }
        if (IN(pb + 8)) {
            const Args A_ = get_args(); bf16* BIG = (bf16*)(A_.ws + WS_BIG);
            pg8::Gemm g{BIG, (const bf16*)(A_.ws + WS_WDN), MP, D, FF}; pg8::StaticOrder S; S.init(MP, D, c.G, (int)blockIdx.x, WGM_I);
            pg8::EpiResAdd E{(bf16*)(A_.ws + WS_XB), A_.out, D, l == DEPTH - 1};

#if (PH_EN >> 9) & 1
            pg8::gemm_phase<pg8::EpiResAdd, pg8::StaticOrder, true, true>(c.lds, g, S, E, c.wave);
            { SEpiResAdd SE{(bf16*)(A_.ws + WS_XB) + (size_t)MP * D, A_.out + (size_t)MP * D, D, l == DEPTH - 1}; sample_gemm<SEpiResAdd, 32>(c.lds, c.wave, c.vcu, c.G, BIG + (size_t)MP * FF, g.Bt, D, FF, SE); }
#if (PH_DUP >> 9) & 1
            { pg8::EpiBf16<0> E2{(bf16*)(A_.ws + WS_H), D, nullptr, (LAS float*)(c.lds + SCR_OFF)}; pg8::gemm_phase<pg8::EpiBf16<0>, pg8::StaticOrder, true, true>(c.lds, g, S, E2, c.wave); }
#endif
#endif

            SEAM(pb + 8);
        }
    }
#undef IN
#undef SEAM
}

extern "C" void kernel_launch(void* const* d_in, const int* in_sizes, int n_in, void* d_out, int out_size, void* d_ws, size_t ws_size, hipStream_t stream) {
    static int grid = 0;
    if (grid == 0) {
        if (n_in != 21 || (size_t)out_size != O_END || ws_size < WS_END) { fprintf(stderr, "kernel_launch: shape mismatch n_in %d out %d ws %zu (need %zu)\n", n_in, out_size, ws_size, (size_t)WS_END); grid = -1; return; }
        int dev = 0, cus = 0, per_cu = 0;
        if (hipGetDevice(&dev) != hipSuccess || hipDeviceGetAttribute(&cus, hipDeviceAttributeMultiprocessorCount, dev) != hipSuccess) { grid = -1; return; }
        if (hipFuncSetAttribute((const void*)fwd, hipFuncAttributeMaxDynamicSharedMemorySize, LDS_BYTES) != hipSuccess) { fprintf(stderr, "kernel_launch: hipFuncSetAttribute failed\n"); grid = -1; return; }
        if (hipOccupancyMaxActiveBlocksPerMultiprocessor(&per_cu, (const void*)fwd, NTHREADS, LDS_BYTES) != hipSuccess || per_cu < 1) { fprintf(stderr, "kernel_launch: occupancy query says %d\n", per_cu); }
        (void)hipGetLastError();
        grid = cus;
    }
    if (grid < 0) return;
    (void)hipMemsetAsync((char*)d_ws + WS_CTL, 0, CTL_BYTES, stream);
    Args a{};
    a.x_prompt = (const float*)d_in[0]; a.x_sample = (const float*)d_in[1]; a.cache_k = (const float*)d_in[2]; a.cache_v = (const float*)d_in[3]; a.state_conv = (const float*)d_in[4];
    a.state_c = (const float*)d_in[5]; a.state_n = (const float*)d_in[6]; a.state_m = (const float*)d_in[7]; a.norm_mix_g = (const float*)d_in[8]; a.w_in = (const float*)d_in[9];
    a.conv_w = (const float*)d_in[10]; a.q_norm_g = (const float*)d_in[11]; a.k_norm_g = (const float*)d_in[12]; a.rel_bias = (const float*)d_in[13]; a.b_igate = (const float*)d_in[14];
    a.b_fgate = (const float*)d_in[15]; a.mlstm_norm_g = (const float*)d_in[16]; a.w_out = (const float*)d_in[17]; a.norm_mlp_g = (const float*)d_in[18]; a.w_up = (const float*)d_in[19];
    a.w_down = (const float*)d_in[20]; a.out = (float*)d_out; a.ws = (unsigned char*)d_ws;
#if MK_PER_PHASE
    for (int p = 0; p < NPHASES; ++p) { a.ph_lo = p; a.ph_hi = p + 1; a.rep = 2; hipLaunchKernelGGL(fwd, dim3(grid), dim3(NTHREADS), LDS_BYTES, stream, a); }
#else
    a.ph_lo = 0; a.ph_hi = NPHASES; a.rep = 2; hipLaunchKernelGGL(fwd, dim3(grid), dim3(NTHREADS), LDS_BYTES, stream, a);
#endif
    const hipError_t le = hipPeekAtLastError();
    if (le != hipSuccess) fprintf(stderr, "kernel_launch: launch failed: %s\n", hipGetErrorName(le));
}
```

```cpp
#include <hip/hip_runtime.h>
#include <cstdio>
#include <cstdint>

#ifndef MK_PER_PHASE
#define MK_PER_PHASE 0
#endif

#ifndef PH_EN
#define PH_EN 0x3ff
#endif
#ifndef PE_EN
#define PE_EN 0xf
#endif
#ifndef WGM_B
#define WGM_B 4
#endif
#ifndef WGM_F
#define WGM_F 4
#endif
#ifndef WGM_H
#define WGM_H 4
#endif
#ifndef WGM_I
#define WGM_I 4
#endif
#ifndef PH_DUP
#define PH_DUP 0
#endif
#define LAS __attribute__((address_space(3)))
#define GAS __attribute__((address_space(1)))
typedef unsigned short bf16;
typedef short bf16x8 __attribute__((ext_vector_type(8)));
typedef short s16x4 __attribute__((ext_vector_type(4)));
typedef float f32x2 __attribute__((ext_vector_type(2)));
typedef float f32x4 __attribute__((ext_vector_type(4)));
typedef float f32x16 __attribute__((ext_vector_type(16)));
typedef unsigned u32x2 __attribute__((ext_vector_type(2)));
typedef unsigned u32x4 __attribute__((ext_vector_type(4)));

constexpr int D = 2048, NB = 4, SEQ = 8192, DEPTH = 4, SBATCH = 8, SSEQ = 32;
constexpr int MP = NB * SEQ, MS = SBATCH * SSEQ, MR = MP + MS;
constexpr int NH = 8, HD = 128, MH = 4;
constexpr int NPROJ = 6656, IN_DIM = 6664, FF = 8192;
constexpr int C_XA = 0, C_GB = 512, C_GC = 1024, C_Q = 1536, C_K = 2560, C_V = 3584, C_MQ = 4608, C_MK = 5120, C_MV = 5632, C_MO = 6144;
constexpr int KEEP = 512;
constexpr int SKV_ROWS = 640;
constexpr float EPS = 1e-6f;
constexpr float LOG2E = 1.4426950408889634f;
constexpr int NGRP = SEQ / 256;

constexpr size_t O_YP = 0, O_YS = O_YP + (size_t)MP * D, O_PCONV = O_YS + (size_t)MS * D, O_PK = O_PCONV + (size_t)DEPTH * NB * 2 * 512,
                 O_PV = O_PK + (size_t)DEPTH * NB * KEEP * 1024, O_PC = O_PV + (size_t)DEPTH * NB * KEEP * 1024, O_PN = O_PC + (size_t)DEPTH * NB * MH * HD * HD,
                 O_PM = O_PN + (size_t)DEPTH * NB * MH * HD, O_SCONV = O_PM + (size_t)DEPTH * NB * MH, O_SK = O_SCONV + (size_t)DEPTH * SBATCH * 2 * 512,
                 O_SV = O_SK + (size_t)DEPTH * SBATCH * SSEQ * 1024, O_SC = O_SV + (size_t)DEPTH * SBATCH * SSEQ * 1024, O_SN = O_SC + (size_t)DEPTH * SBATCH * MH * HD * HD,
                 O_SM = O_SN + (size_t)DEPTH * SBATCH * MH * HD, O_END = O_SM + (size_t)DEPTH * SBATCH * MH;

constexpr size_t al256(size_t x) { return (x + 255) / 256 * 256; }
constexpr size_t WS_CTL = 0, CTL_BYTES = 1u << 20;
constexpr size_t WSET = ((size_t)NPROJ * D + (size_t)D * D + (size_t)FF * D + (size_t)D * FF) * 2;
constexpr size_t WS_WIN = CTL_BYTES;
constexpr size_t WS_WOUT = WS_WIN + (size_t)NPROJ * D * 2;
constexpr size_t WS_WUP = WS_WOUT + (size_t)D * D * 2;
constexpr size_t WS_WDN = WS_WUP + (size_t)FF * D * 2;
constexpr size_t WS_H = WS_WIN + 2 * WSET;
constexpr size_t WS_XB = WS_H + (size_t)MR * D * 2;
constexpr size_t WS_BIG = WS_XB + (size_t)MR * D * 2;
constexpr size_t BIG_BYTES = (size_t)MR * FF * 2;
constexpr size_t WS_CLOC = WS_BIG + al256((size_t)MR * NPROJ * 2);
constexpr size_t WS_C0 = WS_CLOC + (size_t)16 * NGRP * HD * HD * 4;
constexpr size_t WS_NLOC = WS_C0 + (size_t)16 * NGRP * HD * HD * 2;
constexpr size_t WS_N0 = WS_NLOC + (size_t)16 * NGRP * HD * 4;
constexpr size_t WS_MSC = WS_N0 + (size_t)16 * NGRP * HD * 4;
constexpr size_t WS_MIX_END = WS_MSC + (size_t)16 * NGRP * 4 * 4;
static_assert(WS_MIX_END <= WS_BIG + BIG_BYTES, "mLSTM scratch fits in the free top of BIG");
constexpr size_t WS_GATE = WS_BIG + BIG_BYTES;
constexpr size_t SKV_IMG = (size_t)SBATCH * SKV_ROWS * 1024 * 2;
constexpr size_t WS_SK = WS_GATE + (size_t)MR * 8 * 4;
constexpr size_t WS_SV = WS_SK + 2 * SKV_IMG;
constexpr size_t WS_RSTD = WS_SV + 2 * SKV_IMG;
constexpr size_t WS_END = WS_RSTD + (size_t)MR * 4;
static_assert(WS_END <= 1235000000ull, "workspace budget");

constexpr int RING_BYTES = 131072;
constexpr int MISC_OFF = RING_BYTES;
constexpr int SCR_OFF = MISC_OFF + 256;
constexpr int LDS_BYTES = 147456;
constexpr int NWAVES = 8, NTHREADS = 512;

__device__ __forceinline__ unsigned cvtpk(float lo, float hi) { unsigned r; asm volatile("v_cvt_pk_bf16_f32 %0, %1, %2" : "=v"(r) : "v"(lo), "v"(hi)); return r; }
__device__ __forceinline__ float bflo(unsigned w) { return __uint_as_float(w << 16); }
__device__ __forceinline__ float bfhi(unsigned w) { return __uint_as_float(w & 0xffff0000u); }
__device__ __forceinline__ float bf2f(bf16 b) { return __uint_as_float(((unsigned)b) << 16); }
__device__ __forceinline__ float shx(float v, int o, int lane) { return __int_as_float(__builtin_amdgcn_ds_bpermute((lane ^ o) << 2, __float_as_int(v))); }
__device__ __forceinline__ float shup(float v, int o, int lane) { const int s = lane - o; return __int_as_float(__builtin_amdgcn_ds_bpermute((s < 0 ? lane : s) << 2, __float_as_int(v))); }
__device__ __forceinline__ float wave_sum(float v, int lane) {
#pragma unroll
    for (int o = 1; o < 64; o <<= 1) v += shx(v, o, lane);
    return v;
}
__device__ __forceinline__ float fast_rsqrt(float x) { return __builtin_amdgcn_rsqf(x); }
__device__ __forceinline__ float fast_exp(float x) { return __builtin_amdgcn_exp2f(x * 1.4426950408889634f); }
__device__ __forceinline__ float fast_log(float x) { return __builtin_amdgcn_logf(x) * 0.6931471805599453f; }
__device__ __forceinline__ float opaque_zero() { float z; asm volatile("v_mov_b32 %0, 0" : "=v"(z)); return z; }
#define LDS_WAIT() asm volatile("s_waitcnt lgkmcnt(0)" ::: "memory")
#define VM_WAIT() asm volatile("s_waitcnt vmcnt(0)" ::: "memory")
#define SBAR() __builtin_amdgcn_sched_barrier(0)

namespace pg8 {
typedef unsigned short bf16_t;
constexpr int BM = 256, BK = 64, HALF = 128, HTB = HALF * BK * 2, STAGE_BYTES = 8 * HTB, NXCD = 8, WGM = 4;
__host__ __device__ __forceinline__ int lds_byte(int r, int c) { const int st = (r >> 4) * 2 + (c >> 5), rr = r & 15, cc = c & 31, ob = rr * 64 + cc * 2; return st * 1024 + (ob ^ (((ob >> 9) & 1) << 5)); }
__host__ __device__ __forceinline__ void stage_rc(int b, int& R, int& C) { const int st = b / 1024, sb = b % 1024, swz = sb ^ (((sb >> 9) & 1) << 5); R = (st >> 1) * 16 + swz / 64; C = (st & 1) * 32 + (swz % 64) / 2; }
__host__ __device__ __forceinline__ int perm32(int rho) { const int n = rho >> 4, i = rho & 15; return 8 * (i >> 2) + 4 * n + (i & 3); }
struct Unit { int pm, pn; };
struct Gemm { const bf16_t* A; const bf16_t* Bt; int M, N, K; };
struct StaticOrder {
    int nM, nN, nwg, G, c, wgm;
    __host__ __device__ void init(int M, int N, int G_, int c_, int wgm_ = WGM) { nM = M / BM; nN = N / BM; nwg = nM * nN; G = G_; c = c_; wgm = wgm_; }
    __host__ __device__ bool next(int i, Unit& u) const {
        const long L = (long)i * G + c; if (L >= nwg) return false;
        int wgid = (int)L; { const int q = nwg / NXCD, r = nwg % NXCD, xcd = wgid % NXCD, off = wgid / NXCD; wgid = (xcd < r ? xcd * (q + 1) : r * (q + 1) + (xcd - r) * q) + off; }
        const int nig = wgm * nN, gid = wgid / nig, fm = gid * wgm, gsz = (nM - fm) < wgm ? (nM - fm) : wgm;
        u.pm = fm + ((wgid % nig) % gsz); u.pn = (wgid % nig) / gsz; return true;
    }
    __device__ __forceinline__ void a_ready(const Unit&) const {}
    __device__ __forceinline__ void done(const Unit&) const {}
};
template <int ACT  > struct EpiBf16 {
    static constexpr bool PERM = true, AFTER_DRAIN = false;
    static constexpr bool RSL = true;
    bf16_t* O; int ldc; const float* rstd; LAS float* T;
    __device__ __forceinline__ void rs_fetch(const Unit& u, int tid, int par) const { if (rstd && tid < BM) (T + 2048 + par * BM)[tid] = rstd[u.pm * BM + tid]; }
    __device__ __forceinline__ void operator()(const f32x4 (&acc)[2][2][4][2], const Unit& u, int wr, int wc, int fr, int fq, int par) const {
        const int row0 = u.pm * BM + wr * 64 + fr; const int col0 = u.pn * BM + wc * 32 + 8 * fq;
#pragma unroll
        for (int ai = 0; ai < 2; ++ai)
#pragma unroll
            for (int m = 0; m < 4; ++m) { bf16_t* rowp = O + (size_t)(row0 + ai * HALF + m * 16) * ldc + col0; const float rsv = rstd ? (T + 2048 + par * BM)[wr * 64 + fr + ai * HALF + m * 16] : 1.0f;
#pragma unroll
                for (int bj = 0; bj < 2; ++bj) { f32x4 v0 = acc[ai][bj][m][0] * rsv, v1 = acc[ai][bj][m][1] * rsv;
                    if (ACT == 1) {
#pragma unroll
                        for (int j = 0; j < 4; ++j) { const float a = fmaxf(v0[j], 0.f), b = fmaxf(v1[j], 0.f); v0[j] = a * a; v1[j] = b * b; } }
                    u32x4 w; w.x = cvtpk(v0[0], v0[1]); w.y = cvtpk(v0[2], v0[3]); w.z = cvtpk(v1[0], v1[1]); w.w = cvtpk(v1[2], v1[3]);
                    *(u32x4*)(rowp + bj * HALF) = w; } }
    }
};
struct EpiProj {
    static constexpr bool PERM = true, AFTER_DRAIN = false;
    static constexpr bool RSL = true;
    bf16_t* O; int ldc; const float* gq; const float* gk; LAS float* T; const float* rstd;
    __device__ __forceinline__ void rs_fetch(const Unit& u, int tid, int par) const { if (tid < BM) (T + 2048 + par * BM)[tid] = rstd[u.pm * BM + tid]; }
    __device__ __forceinline__ void operator()(const f32x4 (&acc)[2][2][4][2], const Unit& u, int wr, int wc, int fr, int fq, int par) const {
        const int row0 = u.pm * BM + wr * 64 + fr; const int col0 = u.pn * BM + wc * 32 + 8 * fq;
        const bool isqk = (u.pn >= 6) && (u.pn < 14);
        float rs[2][4];
#pragma unroll
        for (int ai = 0; ai < 2; ++ai)
#pragma unroll
            for (int m = 0; m < 4; ++m) rs[ai][m] = (T + 2048 + par * BM)[wr * 64 + fr + ai * HALF + m * 16];
        if (!isqk) {
#pragma unroll
            for (int ai = 0; ai < 2; ++ai)
#pragma unroll
                for (int m = 0; m < 4; ++m) { bf16_t* rowp = O + (size_t)(row0 + ai * HALF + m * 16) * ldc + col0;
#pragma unroll
                    for (int bj = 0; bj < 2; ++bj) { const f32x4 v0 = acc[ai][bj][m][0] * rs[ai][m], v1 = acc[ai][bj][m][1] * rs[ai][m];
                        u32x4 w; w.x = cvtpk(v0[0], v0[1]); w.y = cvtpk(v0[2], v0[3]); w.z = cvtpk(v1[0], v1[1]); w.w = cvtpk(v1[2], v1[3]);
                        *(u32x4*)(rowp + bj * HALF) = w; } }
            return;
        }
        const int lane = fr + 16 * fq;
        float ss[2][4][2];
#pragma unroll
        for (int ai = 0; ai < 2; ++ai)
#pragma unroll
            for (int m = 0; m < 4; ++m)
#pragma unroll
                for (int bj = 0; bj < 2; ++bj) { const f32x4 v0 = acc[ai][bj][m][0] * rs[ai][m], v1 = acc[ai][bj][m][1] * rs[ai][m];
                    float s = (v0[0] * v0[0] + v0[1] * v0[1]) + (v0[2] * v0[2] + v0[3] * v0[3]) + (v1[0] * v1[0] + v1[1] * v1[1]) + (v1[2] * v1[2] + v1[3] * v1[3]);
                    s += shx(s, 16, lane); s += shx(s, 32, lane); ss[ai][m][bj] = s; }
        if (fq == 0) {
#pragma unroll
            for (int ai = 0; ai < 2; ++ai)
#pragma unroll
                for (int m = 0; m < 4; ++m)
#pragma unroll
                    for (int bj = 0; bj < 2; ++bj) T[(ai * HALF + wr * 64 + m * 16 + fr) * 8 + bj * 4 + wc] = ss[ai][m][bj];
        }
        asm volatile("s_waitcnt lgkmcnt(0)" ::: "memory"); __builtin_amdgcn_s_barrier(); asm volatile("" ::: "memory");
        const float* gg = ((u.pn < 10) ? gq : gk) + wc * 32 + 8 * fq;
        const f32x4 g0 = *(const f32x4*)gg, g1 = *(const f32x4*)(gg + 4);
#pragma unroll
        for (int ai = 0; ai < 2; ++ai)
#pragma unroll
            for (int m = 0; m < 4; ++m) { bf16_t* rowp = O + (size_t)(row0 + ai * HALF + m * 16) * ldc + col0;
#pragma unroll
                for (int bj = 0; bj < 2; ++bj) { const f32x4 t = *(const LAS f32x4*)(T + (ai * HALF + wr * 64 + m * 16 + fr) * 8 + bj * 4);
                    const float rq = fast_rsqrt(((t[0] + t[1]) + (t[2] + t[3])) * (1.0f / 128.0f) + 1e-6f) * rs[ai][m];
                    const f32x4 v0 = acc[ai][bj][m][0] * rq * g0, v1 = acc[ai][bj][m][1] * rq * g1;
                    u32x4 w; w.x = cvtpk(v0[0], v0[1]); w.y = cvtpk(v0[2], v0[3]); w.z = cvtpk(v1[0], v1[1]); w.w = cvtpk(v1[2], v1[3]);
                    *(u32x4*)(rowp + bj * HALF) = w; } }
    }
};
struct EpiResAdd {
    static constexpr bool RSL = false;
    static constexpr bool PERM = true, AFTER_DRAIN = false;
    bf16_t* XB; float* Y; int ldc; bool fin;
    __device__ __forceinline__ void operator()(const f32x4 (&acc)[2][2][4][2], const Unit& u, int wr, int wc, int fr, int fq, int) const {
        const int row0 = u.pm * BM + wr * 64 + fr, col0 = u.pn * BM + wc * 32 + 8 * fq;
        u32x4 r[2][4][2];
#pragma unroll
        for (int ai = 0; ai < 2; ++ai)
#pragma unroll
            for (int m = 0; m < 4; ++m)
#pragma unroll
                for (int bj = 0; bj < 2; ++bj) r[ai][m][bj] = *(const u32x4*)(XB + (size_t)(row0 + ai * HALF + m * 16) * ldc + col0 + bj * HALF);
#pragma unroll
        for (int ai = 0; ai < 2; ++ai)
#pragma unroll
            for (int m = 0; m < 4; ++m)
#pragma unroll
                for (int bj = 0; bj < 2; ++bj) { const u32x4 w = r[ai][m][bj]; const f32x4 a0 = acc[ai][bj][m][0], a1 = acc[ai][bj][m][1];
                    const f32x4 v0 = (f32x4){bflo(w.x) + a0[0], bfhi(w.x) + a0[1], bflo(w.y) + a0[2], bfhi(w.y) + a0[3]}, v1 = (f32x4){bflo(w.z) + a1[0], bfhi(w.z) + a1[1], bflo(w.w) + a1[2], bfhi(w.w) + a1[3]};
                    const size_t off = (size_t)(row0 + ai * HALF + m * 16) * ldc + col0 + bj * HALF;
                    if (fin) { *(f32x4*)(Y + off) = v0; *(f32x4*)(Y + off + 4) = v1; }
                    else { u32x4 o; o.x = cvtpk(v0[0], v0[1]); o.y = cvtpk(v0[2], v0[3]); o.z = cvtpk(v1[0], v1[1]); o.w = cvtpk(v1[2], v1[3]); *(u32x4*)(XB + off) = o; } }
    }
};

template <class Epi, class Sched, bool ALIGN_EPI = false, bool SP2 = false>
__device__ __forceinline__ void gemm_phase(LAS unsigned char* lds, const Gemm g, const Sched& S, const Epi& E, const int wave_) {
    int ln_; asm volatile("v_mbcnt_lo_u32_b32 %0, -1, 0\n\tv_mbcnt_hi_u32_b32 %0, -1, %0" : "=v"(ln_)); const int tid = wave_ * 64 + ln_;
    const int wid = __builtin_amdgcn_readfirstlane(tid >> 6), lane = tid & 63, wr = wid >> 2, wc = wid & 3, fr = lane & 15, fq = lane >> 4;
    const int K = g.K, nt = K / BK;
    unsigned voffA[2], voffB[2];
#pragma unroll
    for (int i = 0; i < 2; ++i) { int R, C; stage_rc(tid * 16 + i * 8192, R, C); const int Rb = Epi::PERM ? ((R & ~31) + perm32(R & 31)) : R;
        voffA[i] = (unsigned)(R * K + C) * 2u; voffB[i] = (unsigned)(Rb * K + C) * 2u; }
    const size_t kstep = (size_t)(BK * 2);
    const size_t hstep = (size_t)HALF * K * 2;
    const size_t tstep = 2 * hstep;
    const unsigned ldsw = (unsigned)wid * 1024u;
    const int aoff = lds_byte(wr * 64 + fr, fq * 8), boff = lds_byte(wc * 32 + fr, fq * 8);
#define PG8_SA(b, h) (((b) * 2 + (h)) * HTB)
#define PG8_SB(b, h) ((4 + (b) * 2 + (h)) * HTB)
#define PG8_STAGE(bufoff, gbase, voff) do { _Pragma("unroll") for (int _i = 0; _i < 2; ++_i) \
        __builtin_amdgcn_global_load_lds((const unsigned*)((const char*)(gbase) + (voff)[_i]), (LAS unsigned*)(lds + (bufoff) + ldsw + _i * 8192), 16, 0, 0); } while (0)
#define PG8_LDA(dst, b, h) do { _Pragma("unroll") for (int m = 0; m < 4; ++m) _Pragma("unroll") for (int k = 0; k < 2; ++k) dst[m][k] = *(const LAS bf16x8*)(lds + PG8_SA(b, h) + aoff + m * 2048 + k * 1024); } while (0)
#define PG8_LDB(dst, b, h) do { _Pragma("unroll") for (int n = 0; n < 2; ++n) _Pragma("unroll") for (int k = 0; k < 2; ++k) dst[n][k] = *(const LAS bf16x8*)(lds + PG8_SB(b, h) + boff + n * 2048 + k * 1024); } while (0)
#define PG8_MMA(ai, bj, At, Bt) do { __builtin_amdgcn_s_setprio(1); _Pragma("unroll") for (int m = 0; m < 4; ++m) _Pragma("unroll") for (int n = 0; n < 2; ++n) _Pragma("unroll") for (int k = 0; k < 2; ++k) \
        acc[ai][bj][m][n] = __builtin_amdgcn_mfma_f32_16x16x32_bf16(Bt[n][k], At[m][k], acc[ai][bj][m][n], 0, 0, 0); __builtin_amdgcn_s_setprio(0); } while (0)
#define PG8_WAIT_V(n) asm volatile("s_waitcnt vmcnt(" #n ")" ::: "memory")
#define PG8_WAIT_L(n) asm volatile("s_waitcnt lgkmcnt(" #n ")" ::: "memory")
#define PG8_BAR __builtin_amdgcn_s_barrier()
#define PG8_SCHED __builtin_amdgcn_sched_barrier(0)
    Unit cur, nxt; int ui = 0;
    if (!S.next(0, cur)) return;
    f32x4 acc[2][2][4][2];
    { const float z = opaque_zero();
#pragma unroll
    for (int a = 0; a < 2; ++a)
#pragma unroll
        for (int b = 0; b < 2; ++b)
#pragma unroll
            for (int m = 0; m < 4; ++m)
#pragma unroll
                for (int n = 0; n < 2; ++n) acc[a][b][m][n] = (f32x4){z, z, z, z}; }
    bf16x8 At[4][2], B0[2][2], B1[2][2];
    const char* cA = (const char*)g.A + (size_t)cur.pm * tstep; const char* cB = (const char*)g.Bt + (size_t)cur.pn * tstep;
    S.a_ready(cur);
    if constexpr (Epi::RSL) E.rs_fetch(cur, tid, 0);
    if constexpr (SP2) {
        PG8_STAGE(PG8_SB(0, 0), cB, voffB); PG8_STAGE(PG8_SB(0, 1), cB + hstep, voffB); PG8_STAGE(PG8_SA(0, 0), cA, voffA); PG8_STAGE(PG8_SA(0, 1), cA + hstep, voffA);
        if (wr == 1) PG8_BAR;
        PG8_WAIT_V(2); PG8_BAR;
        PG8_STAGE(PG8_SB(1, 0), cB + kstep, voffB); PG8_STAGE(PG8_SA(1, 0), cA + kstep, voffA); PG8_STAGE(PG8_SB(1, 1), cB + hstep + kstep, voffB);
        PG8_WAIT_V(6); PG8_BAR;
    } else {
        PG8_STAGE(PG8_SB(0, 0), cB, voffB); PG8_STAGE(PG8_SA(0, 0), cA, voffA); PG8_STAGE(PG8_SB(0, 1), cB + hstep, voffB); PG8_STAGE(PG8_SA(0, 1), cA + hstep, voffA);
        if (wr == 1) PG8_BAR;
        PG8_WAIT_V(4); PG8_BAR;
        PG8_STAGE(PG8_SB(1, 0), cB + kstep, voffB); PG8_STAGE(PG8_SA(1, 0), cA + kstep, voffA); PG8_STAGE(PG8_SB(1, 1), cB + hstep + kstep, voffB);
        PG8_WAIT_V(6); PG8_BAR;
    }
    for (;;) {
        const bool has_next = S.next(ui + 1, nxt);
        const char* nA = has_next ? (const char*)g.A + (size_t)nxt.pm * tstep : cA; const char* nB = has_next ? (const char*)g.Bt + (size_t)nxt.pn * tstep : cB;
        for (int t = 0; t < nt; t += 2) {
            const bool last = (t == nt - 2);
            const char* a1 = cA + (size_t)(t + 1) * kstep;
            const char* a2 = last ? nA : cA + (size_t)(t + 2) * kstep; const char* b2 = last ? nB : cB + (size_t)(t + 2) * kstep;
            const char* a3 = a2 + kstep; const char* b3 = b2 + kstep;
            if (last && has_next) S.a_ready(nxt);
            if constexpr (SP2) {
            PG8_LDB(B0, 0, 0); PG8_LDB(B1, 0, 1); PG8_SCHED; PG8_LDA(At, 0, 0); PG8_STAGE(PG8_SA(1, 1), a1 + hstep, voffA);
            PG8_WAIT_V(8); PG8_WAIT_L(0); PG8_BAR; PG8_MMA(0, 0, At, B0); PG8_MMA(0, 1, At, B1); PG8_BAR; PG8_SCHED;
            PG8_LDA(At, 0, 1); PG8_STAGE(PG8_SB(0, 0), b2, voffB); PG8_STAGE(PG8_SB(0, 1), b2 + hstep, voffB); PG8_STAGE(PG8_SA(0, 0), a2, voffA);
            PG8_WAIT_V(8); PG8_WAIT_L(0); PG8_BAR; PG8_MMA(1, 0, At, B0); PG8_MMA(1, 1, At, B1); PG8_BAR; PG8_SCHED;
            PG8_LDB(B0, 1, 0); PG8_LDB(B1, 1, 1); PG8_SCHED; PG8_LDA(At, 1, 0); PG8_STAGE(PG8_SA(0, 1), a2 + hstep, voffA);
            PG8_WAIT_V(8); PG8_WAIT_L(0); PG8_BAR; PG8_MMA(0, 0, At, B0); PG8_MMA(0, 1, At, B1); PG8_BAR; PG8_SCHED;
            PG8_LDA(At, 1, 1); PG8_STAGE(PG8_SB(1, 0), b3, voffB); PG8_STAGE(PG8_SB(1, 1), b3 + hstep, voffB); PG8_STAGE(PG8_SA(1, 0), a3, voffA);
            PG8_WAIT_V(8); PG8_WAIT_L(0); PG8_BAR; PG8_MMA(1, 0, At, B0); PG8_MMA(1, 1, At, B1); PG8_BAR; PG8_SCHED;
            } else {
            PG8_LDB(B0, 0, 0); PG8_SCHED; PG8_LDA(At, 0, 0); PG8_STAGE(PG8_SA(1, 1), a1 + hstep, voffA);
            PG8_WAIT_L(8); PG8_BAR; PG8_WAIT_L(0); PG8_MMA(0, 0, At, B0); PG8_BAR; PG8_SCHED;
            PG8_LDB(B1, 0, 1); PG8_STAGE(PG8_SB(0, 0), b2, voffB);
            PG8_BAR; PG8_WAIT_L(0); PG8_MMA(0, 1, At, B1); PG8_BAR;
            PG8_LDA(At, 0, 1); PG8_STAGE(PG8_SA(0, 0), a2, voffA);
            PG8_BAR; PG8_WAIT_L(0); PG8_MMA(1, 0, At, B0); PG8_BAR; PG8_SCHED;
            PG8_STAGE(PG8_SB(0, 1), b2 + hstep, voffB);
            PG8_WAIT_V(6); PG8_BAR; PG8_MMA(1, 1, At, B1); PG8_BAR;
            PG8_LDB(B0, 1, 0); PG8_SCHED; PG8_LDA(At, 1, 0); PG8_STAGE(PG8_SA(0, 1), a2 + hstep, voffA);
            PG8_WAIT_L(8); PG8_BAR; PG8_WAIT_L(0); PG8_MMA(0, 0, At, B0); PG8_BAR; PG8_SCHED;
            PG8_LDB(B1, 1, 1); PG8_STAGE(PG8_SB(1, 0), b3, voffB);
            PG8_BAR; PG8_WAIT_L(0); PG8_MMA(0, 1, At, B1); PG8_BAR;
            PG8_LDA(At, 1, 1); PG8_STAGE(PG8_SA(1, 0), a3, voffA);
            PG8_BAR; PG8_WAIT_L(0); PG8_MMA(1, 0, At, B0); PG8_BAR; PG8_SCHED;
            PG8_STAGE(PG8_SB(1, 1), b3 + hstep, voffB);
            PG8_WAIT_V(6); PG8_BAR; PG8_MMA(1, 1, At, B1); PG8_BAR;
            }
        }
        if constexpr (ALIGN_EPI) { if (wr == 0) PG8_BAR; }
        if constexpr (!Epi::AFTER_DRAIN) { E(acc, cur, wr, wc, fr, fq, ui & 1); S.done(cur); if constexpr (Epi::RSL) { if (has_next) E.rs_fetch(nxt, tid, (ui + 1) & 1); } }
        if (!has_next) break;
        { const float z = opaque_zero();
#pragma unroll
        for (int a = 0; a < 2; ++a)
#pragma unroll
            for (int b = 0; b < 2; ++b)
#pragma unroll
                for (int m = 0; m < 4; ++m)
#pragma unroll
                    for (int n = 0; n < 2; ++n) acc[a][b][m][n] = (f32x4){z, z, z, z}; }
        cur = nxt; cA = nA; cB = nB; ++ui;
        if constexpr (ALIGN_EPI) { if (wr == 1) PG8_BAR; }
    }
    PG8_WAIT_V(0);
    if constexpr (!ALIGN_EPI) { if (wr == 0) PG8_BAR; }
    PG8_BAR;
#undef PG8_SA
#undef PG8_SB
#undef PG8_STAGE
#undef PG8_LDA
#undef PG8_LDB
#undef PG8_MMA
#undef PG8_WAIT_V
#undef PG8_WAIT_L
#undef PG8_BAR
#undef PG8_SCHED
}
}

struct SEpiBf16 { bf16* O; int ldc; int act; const float* rstd;
    __device__ __forceinline__ void operator()(int row, int col, f32x4 s0, f32x4 s1) const {
        { const float r_ = rstd[row]; s0 = s0 * r_; s1 = s1 * r_; }
        if (act) {
#pragma unroll
            for (int j = 0; j < 4; ++j) { const float a = fmaxf(s0[j], 0.f), b = fmaxf(s1[j], 0.f); s0[j] = a * a; s1[j] = b * b; } }
        u32x4 w; w.x = cvtpk(s0[0], s0[1]); w.y = cvtpk(s0[2], s0[3]); w.z = cvtpk(s1[0], s1[1]); w.w = cvtpk(s1[2], s1[3]);
        *(u32x4*)(O + (size_t)row * ldc + col) = w; } };
struct SEpiResAdd { bf16* XB; float* Y; int ldc; bool fin;
    __device__ __forceinline__ void operator()(int row, int col, f32x4 s0, f32x4 s1) const {
        const size_t off = (size_t)row * ldc + col; const u32x4 w = *(const u32x4*)(XB + off);
        const f32x4 v0 = (f32x4){bflo(w.x) + s0[0], bfhi(w.x) + s0[1], bflo(w.y) + s0[2], bfhi(w.y) + s0[3]}, v1 = (f32x4){bflo(w.z) + s1[0], bfhi(w.z) + s1[1], bflo(w.w) + s1[2], bfhi(w.w) + s1[3]};
        if (fin) { *(f32x4*)(Y + off) = v0; *(f32x4*)(Y + off + 4) = v1; }
        else { u32x4 o; o.x = cvtpk(v0[0], v0[1]); o.y = cvtpk(v0[2], v0[3]); o.z = cvtpk(v1[0], v1[1]); o.w = cvtpk(v1[2], v1[3]); *(u32x4*)(XB + off) = o; } } };
template <class Epi, int MR = 64>
__device__ __forceinline__ void sample_gemm(LAS unsigned char* lds, int wave, int vcu, int G, const bf16* __restrict__ A, const bf16* __restrict__ Bt, int N, int K, const Epi& E) {
    int ln_; asm volatile("v_mbcnt_lo_u32_b32 %0, -1, 0\n\tv_mbcnt_hi_u32_b32 %0, -1, %0" : "=v"(ln_)); const int tid = wave * 64 + ln_;
    const int lane = tid & 63, fr = lane & 15, fq = lane >> 4;
    constexpr int MB = MR / 16, NRT = 256 / MR;
    const int ntiles = NRT * (N >> 6), kslice = K >> 3, kb = wave * kslice;
    LAS float* red = (LAS float*)lds;
    for (int t = vcu; t < ntiles; t += G) {
        const int rt = t % NRT, ct = t / NRT;
        f32x4 acc[MB][4];
        { const float z = opaque_zero();
#pragma unroll
          for (int m = 0; m < MB; ++m)
#pragma unroll
              for (int n = 0; n < 4; ++n) acc[m][n] = (f32x4){z, z, z, z}; }
        const bf16* ap = A + (size_t)(rt * MR + fr) * K + kb + 8 * fq;
        const bf16* bp = Bt + (size_t)(ct * 64 + fr) * K + kb + 8 * fq;
        const size_t r16 = (size_t)16 * K;
#pragma unroll 4
        for (int k = 0; k < kslice; k += 64) {
            bf16x8 a0[MB], a1[MB], b0[4], b1[4];
#pragma unroll
            for (int m = 0; m < MB; ++m) { a0[m] = *(const bf16x8*)(ap + m * r16 + k); a1[m] = *(const bf16x8*)(ap + m * r16 + k + 32); }
#pragma unroll
            for (int n = 0; n < 4; ++n) { b0[n] = *(const bf16x8*)(bp + n * r16 + k); b1[n] = *(const bf16x8*)(bp + n * r16 + k + 32); }
#pragma unroll
            for (int m = 0; m < MB; ++m)
#pragma unroll
                for (int n = 0; n < 4; ++n) { acc[m][n] = __builtin_amdgcn_mfma_f32_16x16x32_bf16(a0[m], b0[n], acc[m][n], 0, 0, 0);
                                              acc[m][n] = __builtin_amdgcn_mfma_f32_16x16x32_bf16(a1[m], b1[n], acc[m][n], 0, 0, 0); }
        }
        __syncthreads();
#pragma unroll
        for (int m = 0; m < MB; ++m)
#pragma unroll
            for (int n = 0; n < 4; ++n)
#pragma unroll
                for (int j = 0; j < 4; ++j) red[wave * (MR * 64) + (16 * m + 4 * fq + j) * 64 + 16 * n + fr] = acc[m][n][j];
        __syncthreads();
        if (tid < MR * 8) {
            const int row = tid >> 3, col = (tid & 7) * 8;
            f32x4 s0 = *(const LAS f32x4*)(red + row * 64 + col), s1 = *(const LAS f32x4*)(red + row * 64 + col + 4);
#pragma unroll
            for (int w = 1; w < 8; ++w) { s0 = s0 + *(const LAS f32x4*)(red + w * (MR * 64) + row * 64 + col); s1 = s1 + *(const LAS f32x4*)(red + w * (MR * 64) + row * 64 + col + 4); }
            E(rt * MR + row, ct * 64 + col, s0, s1);
        }
    }
    __syncthreads();
}

#define XB_TMO      128
#define XB_XCNT(j)  (256  + 64 * (j))
#define XB_XSUB(j)  (1280 + 64 * (j))
#define XB_XGEN(j)  (2304 + 64 * (j))
#define XB_TOP      3328
#define XB_TOPGEN   3392
#define XCD_BAR_WORDS 3456
#define XB_SPIN_CAP (1u << 18)
__device__ __forceinline__ unsigned xb_ld(unsigned* p)              { return __hip_atomic_load(p, __ATOMIC_RELAXED, __HIP_MEMORY_SCOPE_AGENT); }
__device__ __forceinline__ unsigned xb_add(unsigned* p, unsigned v) { return __hip_atomic_fetch_add(p, v, __ATOMIC_RELAXED, __HIP_MEMORY_SCOPE_AGENT); }
__device__ __forceinline__ unsigned xb_xcc_id() { return (unsigned)__builtin_amdgcn_s_getreg((3 << 11) | 20) & 0xFu; }
#define XB_SPIN(cond, bar) do { unsigned _sp = 0; while (cond) { __builtin_amdgcn_s_sleep(1); \
    if ((++_sp & 255u) == 0u) { if (xb_ld(&(bar)[XB_TMO])) break; if (_sp > XB_SPIN_CAP) { atomicAdd(&(bar)[XB_TMO], 1u); break; } } } } while (0)
struct XcdBarrier { unsigned* bar; unsigned x; volatile LAS unsigned* st; };
__device__ __forceinline__ XcdBarrier xcd_barrier_post(unsigned* bar, volatile LAS unsigned* st, bool leader) {
    XcdBarrier b; b.bar = bar; b.x = xb_xcc_id(); b.st = st;
    if (leader) (void)xb_add(&bar[XB_XCNT(b.x)], 1u);
    return b;
}
__device__ __forceinline__ void xcd_barrier_complete(unsigned* bar, unsigned x, unsigned& nloc, unsigned& nx) {
    const unsigned G = gridDim.x * gridDim.y * gridDim.z;
    unsigned sum, cnt, mine, sp = 0u;
    for (;;) {
        sum = 0u; cnt = 0u; mine = 0u;
#pragma unroll
        for (unsigned j = 0; j < 16; ++j) { const unsigned c = xb_ld(&bar[XB_XCNT(j)]); sum += c; cnt += (c > 0u) ? 1u : 0u; mine = (j == x) ? c : mine; }
        if (sum == G) break;
        __builtin_amdgcn_s_sleep(1);
        if ((++sp & 255u) == 0u) { if (xb_ld(&bar[XB_TMO])) break; if (sp > XB_SPIN_CAP) { atomicAdd(&bar[XB_TMO], 1u); break; } }
    }
    nloc = mine > 0u ? mine : 1u; nx = cnt > 0u ? cnt : 1u;
}
__device__ __noinline__ void xcd_barrier(unsigned* bar_, unsigned x_, volatile LAS unsigned* st_, int wave_) {
    XcdBarrier b; b.bar = bar_; b.x = x_; b.st = st_;
    int ln_; asm volatile("v_mbcnt_lo_u32_b32 %0, -1, 0\n\tv_mbcnt_hi_u32_b32 %0, -1, %0" : "=v"(ln_)); const bool leader_ = (wave_ == 0) && (ln_ == 0);
    asm volatile("s_waitcnt vmcnt(0)" ::: "memory");
    __syncthreads();
    if (leader_) {
        unsigned* bar = b.bar;
        __builtin_amdgcn_s_waitcnt(0);
        unsigned nloc = b.st[0], nx = b.st[1];
        if (nloc == 0u) { xcd_barrier_complete(bar, b.x, nloc, nx); b.st[0] = nloc; b.st[1] = nx; }
        const unsigned old = xb_add(&bar[XB_XSUB(b.x)], 1u);
        const unsigned gen = old / nloc;
        if (old + 1u == (gen + 1u) * nloc) {
            __builtin_amdgcn_fence(__ATOMIC_RELEASE, "agent");
            asm volatile("s_waitcnt vmcnt(0)" ::: "memory");
            const unsigned og = xb_add(&bar[XB_TOP], 1u);
            const unsigned tg = og / nx;
            if (og + 1u == (tg + 1u) * nx) xb_add(&bar[XB_TOPGEN], 1u);
            else XB_SPIN(xb_ld(&bar[XB_TOPGEN]) == tg, bar);
            __builtin_amdgcn_fence(__ATOMIC_ACQUIRE, "agent");
            xb_add(&bar[XB_XGEN(b.x)], 1u);
            asm volatile("s_waitcnt vmcnt(0)" ::: "memory");
        } else {
            XB_SPIN(xb_ld(&bar[XB_XGEN(b.x)]) == gen, bar);
            __builtin_amdgcn_fence(__ATOMIC_ACQUIRE, "agent");
            asm volatile("s_waitcnt vmcnt(0)" ::: "memory");
        }
    }
    __syncthreads();
}

#define KSWZ(row, colB) ((row) * 256 + ((colB) ^ (((row) & 7) << 4)))
__device__ __forceinline__ int crow(int r, int hi) { return (r & 3) + 8 * (r >> 2) + 4 * hi; }
__device__ __forceinline__ int v_st(int k, int c) { const int kk = (k & ~0xC) | ((k & 4) << 1) | ((k & 8) >> 1); return ((kk >> 3) * 4 + (c >> 5)) * 512 + ((kk & 7) * 32 + (c & 31)) * 2; }
__device__ __forceinline__ int v_rd_base(int lane) { return ((lane & 3) << 3) | (((lane >> 2) & 3) << 6) | (((lane >> 4) & 1) << 5) | (((lane >> 5) & 1) << 8); }
constexpr int v_rd_off(int d0, int ks, int half) { return d0 * 512 + ks * 4096 + half * 2048; }
template <int OFF> __device__ __forceinline__ s16x4 tr_read(int vb) {
    s16x4 r; asm volatile("ds_read_b64_tr_b16 %0, %1 offset:%2" : "=&v"(r) : "v"(vb), "i"(OFF) : "memory"); return r;
}
#define PKLH(L, H) (bf16x8){L[0], L[1], L[2], L[3], H[0], H[1], H[2], H[3]}
template <int D0> __device__ __forceinline__ void pv_one(f32x16& od, int vb, bf16x8 pa0, bf16x8 pa1, bf16x8 pa2, bf16x8 pa3) {
    const s16x4 l0 = tr_read<v_rd_off(D0, 0, 0)>(vb), h0 = tr_read<v_rd_off(D0, 0, 1)>(vb), l1 = tr_read<v_rd_off(D0, 1, 0)>(vb), h1 = tr_read<v_rd_off(D0, 1, 1)>(vb);
    const s16x4 l2 = tr_read<v_rd_off(D0, 2, 0)>(vb), h2 = tr_read<v_rd_off(D0, 2, 1)>(vb), l3 = tr_read<v_rd_off(D0, 3, 0)>(vb), h3 = tr_read<v_rd_off(D0, 3, 1)>(vb);
    asm volatile("s_waitcnt lgkmcnt(0)" ::: "memory"); SBAR();
    od = __builtin_amdgcn_mfma_f32_32x32x16_bf16(pa0, PKLH(l0, h0), od, 0, 0, 0);
    od = __builtin_amdgcn_mfma_f32_32x32x16_bf16(pa1, PKLH(l1, h1), od, 0, 0, 0);
    od = __builtin_amdgcn_mfma_f32_32x32x16_bf16(pa2, PKLH(l2, h2), od, 0, 0, 0);
    od = __builtin_amdgcn_mfma_f32_32x32x16_bf16(pa3, PKLH(l3, h3), od, 0, 0, 0);
}
__device__ __forceinline__ void pv_d0(f32x16* o, int vb, bf16x8 pa0, bf16x8 pa1, bf16x8 pa2, bf16x8 pa3) {
    pv_one<0>(o[0], vb, pa0, pa1, pa2, pa3); pv_one<1>(o[1], vb, pa0, pa1, pa2, pa3); pv_one<2>(o[2], vb, pa0, pa1, pa2, pa3); pv_one<3>(o[3], vb, pa0, pa1, pa2, pa3);
}
template <int D0, int KS> __device__ __forceinline__ bf16x8 tr_frag(int vb) {
    const s16x4 l = tr_read<v_rd_off(D0, KS, 0)>(vb), h = tr_read<v_rd_off(D0, KS, 1)>(vb);
    return PKLH(l, h);
}
__device__ __forceinline__ void qkt(f32x16& p0, f32x16& p1, int Ks  , const bf16x8* qr, int r32, int hi) {
    p0 = f32x16{}; p1 = f32x16{};
#pragma unroll
    for (int d0 = 0; d0 < 8; ++d0) { const int cb = (d0 * 16 + hi * 8) * 2;
        const bf16x8 b0 = *(const LAS bf16x8*)(uintptr_t)(unsigned)(Ks + KSWZ(r32, cb));
        const bf16x8 b1 = *(const LAS bf16x8*)(uintptr_t)(unsigned)(Ks + KSWZ(32 + r32, cb));
        p0 = __builtin_amdgcn_mfma_f32_32x32x16_bf16(b0, qr[d0], p0, 0, 0, 0);
        p1 = __builtin_amdgcn_mfma_f32_32x32x16_bf16(b1, qr[d0], p1, 0, 0, 0); }
}
#define PK4(P, BASE, OUT) do { unsigned a0 = cvtpk(P[BASE + 0], P[BASE + 1]), a1 = cvtpk(P[BASE + 2], P[BASE + 3]);   \
    unsigned b0 = cvtpk(P[BASE + 4], P[BASE + 5]), b1 = cvtpk(P[BASE + 6], P[BASE + 7]);                              \
    auto r0 = __builtin_amdgcn_permlane32_swap(a0, b0, false, false); auto r1 = __builtin_amdgcn_permlane32_swap(a1, b1, false, false); \
    u32x4 w = {r0[0], r1[0], r0[1], r1[1]}; OUT = *reinterpret_cast<bf16x8*>(&w); } while (0)
__device__ __forceinline__ float half_swap_add(float v) { auto rr = __builtin_amdgcn_permlane32_swap(__float_as_uint(v), __float_as_uint(v), false, false); return __uint_as_float(rr[0]) + __uint_as_float(rr[1]); }
__device__ __forceinline__ float half_swap_max(float v) { auto rr = __builtin_amdgcn_permlane32_swap(__float_as_uint(v), __float_as_uint(v), false, false); return fmaxf(__uint_as_float(rr[0]), __uint_as_float(rr[1])); }

struct Args {
    const float* x_prompt; const float* x_sample; const float* cache_k; const float* cache_v; const float* state_conv; const float* state_c; const float* state_n; const float* state_m;
    const float* norm_mix_g; const float* w_in; const float* conv_w; const float* q_norm_g; const float* k_norm_g; const float* rel_bias; const float* b_igate; const float* b_fgate;
    const float* mlstm_norm_g; const float* w_out; const float* norm_mlp_g; const float* w_up; const float* w_down;
    float* out; unsigned char* ws; int ph_lo, ph_hi, rep, pad;
};
struct Ctx {
    LAS unsigned char* lds; int tid, lane, wave, G, vcu;
};
constexpr int NPH_LAYER = 9, NPHASES = DEPTH * NPH_LAYER;
__device__ __forceinline__ int hw_tid(int wave) { int ln; asm volatile("v_mbcnt_lo_u32_b32 %0, -1, 0\n\tv_mbcnt_hi_u32_b32 %0, -1, %0" : "=v"(ln)); return wave * 64 + ln; }
__device__ __forceinline__ Ctx relaunder(const Ctx& c) { Ctx d = c; const int t = hw_tid(c.wave); d.tid = t; d.lane = t & 63; return d; }

__device__ __forceinline__ void transpose_item(const float* W, int K, int ldn, int nblk, bf16* WT, LAS float* scr, int item, int lane, const float* gain = nullptr) {
    const int kb = item / nblk, nb = item % nblk, k0 = 64 * kb, n0 = 32 * nb;
    const int c = lane & 7;
    f32x4 g0 = (f32x4){1.f, 1.f, 1.f, 1.f}, g1 = g0;
    if (gain) { g0 = *(const f32x4*)(gain + k0 + 8 * c); g1 = *(const f32x4*)(gain + k0 + 8 * c + 4); }
#pragma unroll 8
    for (int i = 0; i < 32; ++i) { const int kk = 2 * i + (lane >> 5); scr[kk * 33 + (lane & 31)] = W[(size_t)(k0 + kk) * ldn + n0 + (lane & 31)]; }
    LDS_WAIT(); asm volatile("" ::: "memory");
#pragma unroll
    for (int j = 0; j < 4; ++j) { const int n = (lane >> 3) + 8 * j; const LAS float* s = scr + (8 * c) * 33 + n;
        u32x4 o; o.x = cvtpk(s[0 * 33] * g0[0], s[1 * 33] * g0[1]); o.y = cvtpk(s[2 * 33] * g0[2], s[3 * 33] * g0[3]); o.z = cvtpk(s[4 * 33] * g1[0], s[5 * 33] * g1[1]); o.w = cvtpk(s[6 * 33] * g1[2], s[7 * 33] * g1[3]);
        *(GAS u32x4*)(WT + (size_t)(n0 + n) * K + k0 + 8 * c) = o; }
    LDS_WAIT(); asm volatile("" ::: "memory");
}
__device__ __forceinline__ void convert_weights(const Args& a, const Ctx& c, int l) {
    LAS float* scr = (LAS float*)(c.lds + c.wave * 16384);
    const size_t wo = (size_t)(l & 1) * WSET;
    const int gw = c.vcu * NWAVES + c.wave, NGW = c.G * NWAVES;
    constexpr int I_IN = (D / 64) * (NPROJ / 32), I_OUT = (D / 64) * (D / 32), I_UP = (D / 64) * (FF / 32), I_DN = (FF / 64) * (D / 32), I_L = I_IN + I_OUT + I_UP + I_DN;
    for (int it = gw; it < I_L; it += NGW) {
        int r = it;
        if (r < I_IN) { transpose_item(a.w_in + (size_t)l * D * IN_DIM, D, IN_DIM, NPROJ / 32, (bf16*)(a.ws + WS_WIN + wo), scr, r, c.lane, a.norm_mix_g + (size_t)l * D); continue; } r -= I_IN;
        if (r < I_OUT) { transpose_item(a.w_out + (size_t)l * D * D, D, D, D / 32, (bf16*)(a.ws + WS_WOUT + wo), scr, r, c.lane); continue; } r -= I_OUT;
        if (r < I_UP) { transpose_item(a.w_up + (size_t)l * D * FF, D, FF, FF / 32, (bf16*)(a.ws + WS_WUP + wo), scr, r, c.lane, a.norm_mlp_g + (size_t)l * D); continue; } r -= I_UP;
        transpose_item(a.w_down + (size_t)l * FF * D, FF, D, D / 32, (bf16*)(a.ws + WS_WDN + wo), scr, r, c.lane);
    }
}
struct ConvJob { const float* w_in; const float* w_out; const float* w_up; const float* w_down; const float* g_mix; const float* g_mlp; unsigned char* ws; int l, gw, ngw; };
constexpr int CV_I_IN = (D / 64) * (NPROJ / 32), CV_I_OUT = (D / 64) * (D / 32), CV_I_UP = (D / 64) * (FF / 32), CV_I_DN = (FF / 64) * (D / 32), CV_I_L = CV_I_IN + CV_I_OUT + CV_I_UP + CV_I_DN;
struct ConvItem { const float* W; bf16* WT; int gsel; int K, ldn, nblk, r; };
constexpr int GT0_OFF = 116736, GT1_OFF = SCR_OFF + 2048;
__device__ __forceinline__ ConvItem conv_item(const ConvJob& j, int it) {
    const int l = j.l; const size_t wo = (size_t)(l & 1) * WSET; int r = it; ConvItem x;
    if (r < CV_I_IN) { x = ConvItem{j.w_in + (size_t)l * D * IN_DIM, (bf16*)(j.ws + WS_WIN + wo), 1, D, IN_DIM, NPROJ / 32, r}; return x; } r -= CV_I_IN;
    if (r < CV_I_OUT) { x = ConvItem{j.w_out + (size_t)l * D * D, (bf16*)(j.ws + WS_WOUT + wo), 0, D, D, D / 32, r}; return x; } r -= CV_I_OUT;
    if (r < CV_I_UP) { x = ConvItem{j.w_up + (size_t)l * D * FF, (bf16*)(j.ws + WS_WUP + wo), 2, D, FF, FF / 32, r}; return x; } r -= CV_I_UP;
    x = ConvItem{j.w_down + (size_t)l * FF * D, (bf16*)(j.ws + WS_WDN + wo), 0, FF, D, D / 32, r}; return x;
}
__device__ __forceinline__ void conv_load(const ConvJob& j, int it, int lane, float (&v)[32]) {
    const ConvItem x = conv_item(j, it);
    const int kb = x.r / x.nblk, nb = x.r % x.nblk;
    const float* base = x.W + (size_t)(64 * kb) * x.ldn + 32 * nb;
    const unsigned off = (unsigned)((32 * (lane >> 5)) * x.ldn + (lane & 31));
#pragma unroll
    for (int i = 0; i < 32; ++i) v[i] = (base + (size_t)i * x.ldn)[off];
}
__device__ __forceinline__ void conv_finish(const ConvJob& j, int it, int lane, float (&v)[32], LAS unsigned char* lds) {
    const ConvItem x = conv_item(j, it);
    const int kb = x.r / x.nblk, nb = x.r % x.nblk, k0 = 64 * kb + 32 * (lane >> 5), n = 32 * nb + (lane & 31);
    if (x.gsel) { const LAS float* gp = (const LAS float*)(lds + (x.gsel == 1 ? GT0_OFF : GT1_OFF)) + k0;
#pragma unroll
        for (int q = 0; q < 8; ++q) { const f32x4 g = *(const LAS f32x4*)(gp + 4 * q); v[4 * q] *= g[0]; v[4 * q + 1] *= g[1]; v[4 * q + 2] *= g[2]; v[4 * q + 3] *= g[3]; } }
#pragma unroll
    for (int q = 0; q < 4; ++q) { u32x4 o; o.x = cvtpk(v[8 * q], v[8 * q + 1]); o.y = cvtpk(v[8 * q + 2], v[8 * q + 3]); o.z = cvtpk(v[8 * q + 4], v[8 * q + 5]); o.w = cvtpk(v[8 * q + 6], v[8 * q + 7]);
        *(u32x4*)(x.WT + (size_t)n * x.K + k0 + 8 * q) = o; }
}
__device__ __forceinline__ bool conv_step(const ConvJob& j, int& k, int lane, LAS unsigned char* lds) {
    const int it = j.gw + k * j.ngw; if (it >= CV_I_L) return false;
    ++k; float v[32]; conv_load(j, it, lane, v); conv_finish(j, it, lane, v, lds); return true;
}

__device__ __forceinline__ void build_kv_image(const Args& a, int w, int nw, int tid, int l) {
    bf16* SK = (bf16*)(a.ws + WS_SK + (size_t)(l & 1) * SKV_IMG); bf16* SV = (bf16*)(a.ws + WS_SV + (size_t)(l & 1) * SKV_IMG);
    const unsigned gt = (unsigned)w * NTHREADS + tid, NT = (unsigned)nw * NTHREADS;
    constexpr unsigned NCH = (unsigned)SBATCH * 512 * 1024 / 8;
    for (unsigned i = gt; i < 2 * NCH; i += NT) {
        const bool isv = i >= NCH; const unsigned j = isv ? i - NCH : i; const unsigned e = j * 8; const unsigned b = e / (512 * 1024); const unsigned rem = e % (512 * 1024);
        const float* src = (isv ? a.cache_v : a.cache_k) + ((size_t)(l * SBATCH + b) * 512 * 1024) + rem;
        const f32x4 x0 = *(const f32x4*)src, x1 = *(const f32x4*)(src + 4);
        u32x4 w4; w4.x = cvtpk(x0.x, x0.y); w4.y = cvtpk(x0.z, x0.w); w4.z = cvtpk(x1.x, x1.y); w4.w = cvtpk(x1.z, x1.w);
        *(u32x4*)((isv ? SV : SK) + (size_t)b * SKV_ROWS * 1024 + rem) = w4;
    }
    constexpr unsigned NZ = (unsigned)SBATCH * (SKV_ROWS - 544) * 1024 / 8;
    for (unsigned i = gt; i < 2 * NZ; i += NT) {
        const bool isv = i >= NZ; const unsigned j = isv ? i - NZ : i; const unsigned e = j * 8; const unsigned b = e / ((SKV_ROWS - 544) * 1024); const unsigned rem = e % ((SKV_ROWS - 544) * 1024);
        { const unsigned z = __float_as_uint(opaque_zero()); *(u32x4*)((isv ? SV : SK) + ((size_t)b * SKV_ROWS + 544) * 1024 + rem) = (u32x4){z, z, z, z}; }
    }
}
__device__ __forceinline__ float log_sigmoid(float x) { return fminf(x, 0.f) - fast_log(1.0f + fast_exp(-fabsf(x))); }
template <bool FIRST  >
__device__ __forceinline__ void phase_norm(const Args& a, const Ctx& c_in0, int l) {
    const Ctx c = relaunder(c_in0);
    bf16* XB = (bf16*)(a.ws + WS_XB); bf16* H = (bf16*)(a.ws + WS_H);
    const float* g = (FIRST ? a.norm_mix_g : a.norm_mlp_g) + (size_t)l * D;
    LAS float* Wg = (LAS float*)c.lds;
    if (FIRST) {
        if (l == 0) { convert_weights(a, c, 0); __syncthreads(); }
        const float* wsrc = a.w_in + (size_t)l * D * IN_DIM + NPROJ;
        for (int idx = c.tid; idx < 8 * D; idx += NTHREADS) { const int k = idx >> 3, o = idx & 7; Wg[o * D + k] = wsrc[(size_t)k * IN_DIM + o]; }
        __syncthreads();
    }
    const int gw = c.vcu * NWAVES + c.wave, NGW = c.G * NWAVES;
    f32x4 gv[8];
#pragma unroll
    for (int j = 0; j < 8; ++j) gv[j] = *(const f32x4*)(g + 4 * c.lane + 256 * j);
    for (int row = gw; row < MR; row += NGW) {
        f32x4 v[8]; float s = 0.f;
        if (FIRST && l == 0) {
            const float* src = row < MP ? a.x_prompt + (size_t)row * D : a.x_sample + (size_t)(row - MP) * D;
#pragma unroll
            for (int j = 0; j < 8; ++j) v[j] = *(const f32x4*)(src + 4 * c.lane + 256 * j);
#pragma unroll
            for (int j = 0; j < 8; ++j) { u32x2 w; w.x = cvtpk(v[j].x, v[j].y); w.y = cvtpk(v[j].z, v[j].w); *(u32x2*)(XB + (size_t)row * D + 4 * c.lane + 256 * j) = w; }
        } else {
            u32x2 w[8];
#pragma unroll
            for (int j = 0; j < 8; ++j) w[j] = *(const u32x2*)(XB + (size_t)row * D + 4 * c.lane + 256 * j);
#pragma unroll
            for (int j = 0; j < 8; ++j) v[j] = (f32x4){bflo(w[j].x), bfhi(w[j].x), bflo(w[j].y), bfhi(w[j].y)};
        }
#pragma unroll
        for (int j = 0; j < 8; ++j) s += (v[j].x * v[j].x + v[j].y * v[j].y) + (v[j].z * v[j].z + v[j].w * v[j].w);
        const float rstd = fast_rsqrt(wave_sum(s, c.lane) * (1.f / D) + EPS);
        if (c.lane == 0) ((float*)(a.ws + WS_RSTD))[row] = rstd;
        if (FIRST) {
#pragma unroll
            for (int j = 0; j < 8; ++j) v[j] = v[j] * rstd * gv[j];
            float ga[8];
#pragma unroll
            for (int o = 0; o < 8; ++o) { float t = 0.f;
#pragma unroll
                for (int j = 0; j < 8; ++j) { const f32x4 w4 = *(const LAS f32x4*)(Wg + o * D + 4 * c.lane + 256 * j); t += (v[j].x * w4.x + v[j].y * w4.y) + (v[j].z * w4.z + v[j].w * w4.w); }
                ga[o] = wave_sum(t, c.lane); }
            float val = ga[0];
#pragma unroll
            for (int o = 1; o < 8; ++o) val = (c.lane == o) ? ga[o] : val;
            if (c.lane < 8) {
                float r;
                if (c.lane < 4) r = val + a.b_igate[l * MH + c.lane];
                else r = log_sigmoid(val + a.b_fgate[l * MH + c.lane - 4]);
                ((float*)(a.ws + WS_GATE))[(size_t)row * 8 + c.lane] = r;
            }
        }
    }
    if (FIRST && l == 0) build_kv_image(a, c.vcu, c.G, c.tid, 0);
}

__device__ __forceinline__ float scan256_sum(float v, int tid, int lane, int wave, LAS float* tot  ) {
#pragma unroll
    for (int o = 1; o < 64; o <<= 1) { const float t = shup(v, o, lane); if (lane >= o) v += t; }
    if (lane == 63) tot[wave] = v;
    __syncthreads();
    float off = 0.f;
#pragma unroll
    for (int w = 0; w < 3; ++w) off += (w < wave) ? tot[w] : 0.f;
    __syncthreads();
    return v + off;
}
__device__ __forceinline__ float scan256_max(float v, int tid, int lane, int wave, LAS float* tot) {
#pragma unroll
    for (int o = 1; o < 64; o <<= 1) { const float t = shup(v, o, lane); if (lane >= o) v = fmaxf(v, t); }
    if (lane == 63) tot[wave] = v;
    __syncthreads();
    float off = -3.0e38f;
#pragma unroll
    for (int w = 0; w < 3; ++w) off = (w < wave) ? fmaxf(off, tot[w]) : off;
    __syncthreads();
    return fmaxf(v, off);
}

__device__ __forceinline__ void m1_unit(const Args& a, const Ctx& c_in, int l, int unit) {
    const int g = unit & 31, bh = unit >> 5, b = bh >> 2, h = bh & 3;
    const bf16* PROJ = (const bf16*)(a.ws + WS_BIG);
    const float* GATE = (const float*)(a.ws + WS_GATE);
    Ctx c = c_in; { int t_ = c.tid; asm volatile("" : "+v"(t_)); c.tid = t_; c.lane = t_ & 63; }
    LAS float* scr = (LAS float*)(c.lds + SCR_OFF);
    LAS float* W_S = scr;
    LAS float* NACC = scr + 256;
    LAS float* TOT = scr + 384;
    LAS float* SCAL = scr + 392;
    const int row0 = b * SEQ + g * 256;
    LAS float* PART = scr + 400;
    const int sr = c.tid >> 4, sc = (c.tid & 15) * 8;
    u32x4 kq8[8], vq8[8];
#pragma unroll
    for (int t = 0; t < 4; ++t)
#pragma unroll
        for (int hh = 0; hh < 2; ++hh) { const int rr = t * 64 + hh * 32 + sr; const size_t ro = (size_t)(row0 + rr) * NPROJ;
            kq8[t * 2 + hh] = *(const u32x4*)(PROJ + ro + C_MK + h * HD + sc); vq8[t * 2 + hh] = *(const u32x4*)(PROJ + ro + C_MV + h * HD + sc); }
    __syncthreads();
    float li = 0.f, lf = 0.f;
    if (c.tid < 256) { li = GATE[(size_t)(row0 + c.tid) * 8 + h]; lf = GATE[(size_t)(row0 + c.tid) * 8 + 4 + h]; }
    const float bc = scan256_sum(lf, c.tid, c.lane, c.wave, TOT);
    const float as = li - bc;
    const float am = scan256_max(c.tid < 256 ? as : -3.0e38f, c.tid, c.lane, c.wave, TOT);
    if (c.tid == 255) { SCAL[0] = am; SCAL[1] = bc; }
    __syncthreads();
    const float amax = SCAL[0], blast = SCAL[1];
    if (c.tid < 256) W_S[c.tid] = fast_exp(as - amax);
    __syncthreads();
#pragma unroll
    for (int t = 0; t < 4; ++t)
#pragma unroll
        for (int hh = 0; hh < 2; ++hh) {
            const int rr = t * 64 + hh * 32 + sr;
            const u32x4 kq = kq8[t * 2 + hh];
            const u32x4 vq = vq8[t * 2 + hh];
            const float w = W_S[rr] * 0.08838834764831845f;
            float kf[8] = {bflo(kq.x) * w, bfhi(kq.x) * w, bflo(kq.y) * w, bfhi(kq.y) * w, bflo(kq.z) * w, bfhi(kq.z) * w, bflo(kq.w) * w, bfhi(kq.w) * w};
            u32x4 kw; kw.x = cvtpk(kf[0], kf[1]); kw.y = cvtpk(kf[2], kf[3]); kw.z = cvtpk(kf[4], kf[5]); kw.w = cvtpk(kf[6], kf[7]);
            *(LAS u32x4*)(c.lds + t * 16384 + v_st(hh * 32 + sr, sc)) = kw;
            *(LAS u32x4*)(c.lds + 65536 + t * 16384 + v_st(hh * 32 + sr, sc)) = vq;
        }
    __syncthreads();
    {
        const int col = c.tid & 127, t = c.tid >> 7; float s = 0.f;
        for (int k = 0; k < 64; ++k) s += bf2f(*(const LAS bf16*)(c.lds + t * 16384 + v_st(k, col)));
        PART[c.tid] = s;
    }
    __syncthreads();
    const int Da = c.wave >> 1, Db0 = 2 * (c.wave & 1);
    f32x16 acc0 = f32x16{}, acc1 = f32x16{};
    const int vbk = (int)(uintptr_t)(c.lds) + v_rd_base(c.lane) + Da * 512;
    const int vbv = (int)(uintptr_t)(c.lds) + 65536 + v_rd_base(c.lane) + Db0 * 512;
#pragma unroll
    for (int t = 0; t < 4; ++t) {
        const int ak = vbk + t * 16384, av = vbv + t * 16384;
        const bf16x8 a0 = tr_frag<0, 0>(ak), a1 = tr_frag<0, 1>(ak), a2 = tr_frag<0, 2>(ak), a3 = tr_frag<0, 3>(ak);
        const bf16x8 b00 = tr_frag<0, 0>(av), b01 = tr_frag<0, 1>(av), b02 = tr_frag<0, 2>(av), b03 = tr_frag<0, 3>(av);
        const bf16x8 b10 = tr_frag<1, 0>(av), b11 = tr_frag<1, 1>(av), b12 = tr_frag<1, 2>(av), b13 = tr_frag<1, 3>(av);
        asm volatile("s_waitcnt lgkmcnt(0)" ::: "memory"); SBAR();
        acc0 = __builtin_amdgcn_mfma_f32_32x32x16_bf16(a0, b00, acc0, 0, 0, 0); acc1 = __builtin_amdgcn_mfma_f32_32x32x16_bf16(a0, b10, acc1, 0, 0, 0);
        acc0 = __builtin_amdgcn_mfma_f32_32x32x16_bf16(a1, b01, acc0, 0, 0, 0); acc1 = __builtin_amdgcn_mfma_f32_32x32x16_bf16(a1, b11, acc1, 0, 0, 0);
        acc0 = __builtin_amdgcn_mfma_f32_32x32x16_bf16(a2, b02, acc0, 0, 0, 0); acc1 = __builtin_amdgcn_mfma_f32_32x32x16_bf16(a2, b12, acc1, 0, 0, 0);
        acc0 = __builtin_amdgcn_mfma_f32_32x32x16_bf16(a3, b03, acc0, 0, 0, 0); acc1 = __builtin_amdgcn_mfma_f32_32x32x16_bf16(a3, b13, acc1, 0, 0, 0);
    }
    float* CL = (float*)(a.ws + WS_CLOC) + (size_t)unit * HD * HD;
    const int r32 = c.lane & 31, hi = c.lane >> 5;
#pragma unroll
    for (int r = 0; r < 16; ++r) { const int d = 32 * Da + crow(r, hi);
        CL[(size_t)d * HD + 32 * Db0 + r32] = acc0[r]; CL[(size_t)d * HD + 32 * (Db0 + 1) + r32] = acc1[r]; }
    if (c.tid < 128) ((float*)(a.ws + WS_NLOC))[(size_t)unit * HD + c.tid] = (PART[c.tid] + PART[128 + c.tid]) + (PART[256 + c.tid] + PART[384 + c.tid]);
    if (c.tid == 0) { float* ms = (float*)(a.ws + WS_MSC) + (size_t)unit * 4; ms[0] = blast + amax; ms[1] = blast; }
}

__device__ __forceinline__ void sample_mixers(const Args& a, const Ctx& c, int l);
template <bool WITH_QK>
__device__ __forceinline__ void phase_c(const Args& a, const Ctx& c_in0, int l) {
    const Ctx c = relaunder(c_in0);
    bf16* PROJ = (bf16*)(a.ws + WS_BIG); bf16* MIX = (bf16*)(a.ws + WS_H);
    constexpr int WSMP = SBATCH * NH + SBATCH * MH;
    const bool split = c.G > 2 * WSMP;
    if (WITH_QK && (!split || c.vcu < WSMP)) sample_mixers(a, c, l);
    for (int u = c.vcu; u < 16 * NGRP; u += c.G) m1_unit(a, c, l, u);
    const int gw = c.vcu * NWAVES + c.wave, NGW = c.G * NWAVES;
    if (WITH_QK) {
        const float* gq = a.q_norm_g + l * HD; const float* gk = a.k_norm_g + l * HD;
        const int gi = (16 * c.lane) & 127;
        f32x4 gqv[4], gkv[4];
#pragma unroll
        for (int j = 0; j < 4; ++j) { gqv[j] = *(const f32x4*)(gq + gi + 4 * j); gkv[j] = *(const f32x4*)(gk + gi + 4 * j); }
        bf16* SK = (bf16*)(a.ws + WS_SK + (size_t)(l & 1) * SKV_IMG); bf16* SV = (bf16*)(a.ws + WS_SV + (size_t)(l & 1) * SKV_IMG);
        constexpr int NIT = NB * KEEP;
        for (int it = gw; it < NIT; it += NGW) {
            const int row = (it / KEEP) * SEQ + (SEQ - KEEP) + (it % KEEP);
            const bf16* p = PROJ + (size_t)row * NPROJ + C_K + 16 * c.lane;
            const u32x4 w0 = *(const u32x4*)p, w1 = *(const u32x4*)(p + 8);
            const bf16* pv = PROJ + (size_t)row * NPROJ + C_V + 16 * c.lane;
            const u32x4 v0 = *(const u32x4*)pv, v1 = *(const u32x4*)(pv + 8);
            const int b = row / SEQ, t = row % SEQ; const size_t o = ((size_t)(l * NB + b) * KEEP + (t - (SEQ - KEEP))) * 1024 + 16 * c.lane;
            float* ok = a.out + O_PK + o; float* ov = a.out + O_PV + o;
            *(f32x4*)(ok + 0) = (f32x4){bflo(w0.x), bfhi(w0.x), bflo(w0.y), bfhi(w0.y)}; *(f32x4*)(ok + 4) = (f32x4){bflo(w0.z), bfhi(w0.z), bflo(w0.w), bfhi(w0.w)};
            *(f32x4*)(ok + 8) = (f32x4){bflo(w1.x), bfhi(w1.x), bflo(w1.y), bfhi(w1.y)}; *(f32x4*)(ok + 12) = (f32x4){bflo(w1.z), bfhi(w1.z), bflo(w1.w), bfhi(w1.w)};
            *(f32x4*)(ov + 0) = (f32x4){bflo(v0.x), bfhi(v0.x), bflo(v0.y), bfhi(v0.y)}; *(f32x4*)(ov + 4) = (f32x4){bflo(v0.z), bfhi(v0.z), bflo(v0.w), bfhi(v0.w)};
            *(f32x4*)(ov + 8) = (f32x4){bflo(v1.x), bfhi(v1.x), bflo(v1.y), bfhi(v1.y)}; *(f32x4*)(ov + 12) = (f32x4){bflo(v1.z), bfhi(v1.z), bflo(v1.w), bfhi(v1.w)};
        }
    }
    {
        const int ch = 8 * c.lane;
        float w0[8], w1[8], w2[8];
#pragma unroll
        for (int i = 0; i < 8; ++i) { w0[i] = a.conv_w[(size_t)(l * 3 + 0) * 512 + ch + i]; w1[i] = a.conv_w[(size_t)(l * 3 + 1) * 512 + ch + i]; w2[i] = a.conv_w[(size_t)(l * 3 + 2) * 512 + ch + i]; }
        constexpr int NSEG = SEQ / 32, NITEM = NB * NSEG + SBATCH;
        const int gwc = split ? (c.vcu - WSMP) * NWAVES + c.wave : gw, NGWc = split ? (c.G - WSMP) * NWAVES : NGW;
        for (int it = gwc; it >= 0 && it < NITEM; it += NGWc) {
            float u2[8], u1[8]; int rowb; bool samp = it >= NB * NSEG; int b, seg = 0;
            if (!samp) { b = it / NSEG; seg = it % NSEG; rowb = b * SEQ + seg * 32; } else { b = it - NB * NSEG; rowb = MP + b * SSEQ; }
#pragma unroll
            for (int i = 0; i < 8; ++i) { u2[i] = 0.f; u1[i] = 0.f; }
            if (samp) {
#pragma unroll
                for (int i = 0; i < 8; ++i) { u2[i] = a.state_conv[((size_t)(l * SBATCH + b) * 2 + 0) * 512 + ch + i]; u1[i] = a.state_conv[((size_t)(l * SBATCH + b) * 2 + 1) * 512 + ch + i]; }
            } else if (seg > 0) {
#pragma unroll
                for (int q = 0; q < 2; ++q) { const bf16* pr = PROJ + (size_t)(rowb - 2 + q) * NPROJ + ch;
                    const u32x4 xa = *(const u32x4*)(pr + C_XA), gc = *(const u32x4*)(pr + C_GC);
                    float* dst = q ? u1 : u2;
                    dst[0] = bflo(xa.x) * bflo(gc.x); dst[1] = bfhi(xa.x) * bfhi(gc.x); dst[2] = bflo(xa.y) * bflo(gc.y); dst[3] = bfhi(xa.y) * bfhi(gc.y);
                    dst[4] = bflo(xa.z) * bflo(gc.z); dst[5] = bfhi(xa.z) * bfhi(gc.z); dst[6] = bflo(xa.w) * bflo(gc.w); dst[7] = bfhi(xa.w) * bfhi(gc.w); }
            }
            for (int t0 = 0; t0 < 32; t0 += 4) {
                u32x4 xa4[4], gb4[4], gc4[4];
#pragma unroll
                for (int q = 0; q < 4; ++q) { const bf16* pr = PROJ + (size_t)(rowb + t0 + q) * NPROJ + ch; xa4[q] = *(const u32x4*)(pr + C_XA); gb4[q] = *(const u32x4*)(pr + C_GB); gc4[q] = *(const u32x4*)(pr + C_GC); }
#pragma unroll
                for (int q = 0; q < 4; ++q) { const int t = t0 + q;
                const u32x4 xa = xa4[q], gb = gb4[q], gc = gc4[q];
                float u0[8] = {bflo(xa.x) * bflo(gc.x), bfhi(xa.x) * bfhi(gc.x), bflo(xa.y) * bflo(gc.y), bfhi(xa.y) * bfhi(gc.y),
                               bflo(xa.z) * bflo(gc.z), bfhi(xa.z) * bfhi(gc.z), bflo(xa.w) * bflo(gc.w), bfhi(xa.w) * bfhi(gc.w)};
                float gbf[8] = {bflo(gb.x), bfhi(gb.x), bflo(gb.y), bfhi(gb.y), bflo(gb.z), bfhi(gb.z), bflo(gb.w), bfhi(gb.w)};
                float y[8];
#pragma unroll
                for (int i = 0; i < 8; ++i) { y[i] = gbf[i] * (w0[i] * u2[i] + w1[i] * u1[i] + w2[i] * u0[i]); u2[i] = u1[i]; u1[i] = u0[i]; }
                u32x4 o; o.x = cvtpk(y[0], y[1]); o.y = cvtpk(y[2], y[3]); o.z = cvtpk(y[4], y[5]); o.w = cvtpk(y[6], y[7]);
                *(u32x4*)(MIX + (size_t)(rowb + t) * D + ch) = o;
                }
            }
            float* oc = nullptr;
            if (samp) oc = a.out + O_SCONV + (size_t)(l * SBATCH + b) * 2 * 512 + ch;
            else if (seg == NSEG - 1) oc = a.out + O_PCONV + (size_t)(l * NB + b) * 2 * 512 + ch;
            if (oc) {
                *(f32x4*)(oc) = (f32x4){u2[0], u2[1], u2[2], u2[3]}; *(f32x4*)(oc + 4) = (f32x4){u2[4], u2[5], u2[6], u2[7]};
                *(f32x4*)(oc + 512) = (f32x4){u1[0], u1[1], u1[2], u1[3]}; *(f32x4*)(oc + 516) = (f32x4){u1[4], u1[5], u1[6], u1[7]};
            }
        }
    }
}

__device__ __forceinline__ void phase_d(const Args& a, const Ctx& c_in0, int l) {
    const Ctx c = relaunder(c_in0);
    const float* CL = (const float*)(a.ws + WS_CLOC); const float* NL = (const float*)(a.ws + WS_NLOC); float* MSC = (float*)(a.ws + WS_MSC);
    bf16* C0 = (bf16*)(a.ws + WS_C0); float* N0 = (float*)(a.ws + WS_N0);
    LAS float* DEC = (LAS float*)(c.lds + SCR_OFF);
    LAS float* WLO = DEC + 512;
    LAS float* MFIN = WLO + 512;
    LAS float* MLO = MFIN + 16;
    LAS float* BLA = MLO + 512;
    __syncthreads();
    { const int u = c.tid; MLO[u] = MSC[(size_t)u * 4 + 0]; BLA[u] = MSC[(size_t)u * 4 + 1]; }
    __syncthreads();
    if (c.tid < 16) { const int bh = c.tid; float m = 0.f;
        for (int g = 0; g < NGRP; ++g) { const size_t u = (size_t)bh * NGRP + g; const float mloc = MLO[u], blast = BLA[u];
            const float mn = fmaxf(blast + m, mloc); DEC[bh * NGRP + g] = fast_exp(blast + m - mn); WLO[bh * NGRP + g] = fast_exp(mloc - mn);
            if (c.vcu == 0) MSC[u * 4 + 2] = m;
            m = mn; }
        MFIN[bh] = m; }
    __syncthreads();
    const unsigned gt = (unsigned)c.vcu * NTHREADS + c.tid, NT = (unsigned)c.G * NTHREADS;
    constexpr unsigned PER = (unsigned)HD * HD + HD;
    for (unsigned i = gt; i < 16u * PER; i += NT) {
        const int bh = (int)(i / PER); const int e = (int)(i % PER); const bool isn = e >= HD * HD; const int en = e - HD * HD;
        const float* src = isn ? NL + (size_t)bh * NGRP * HD + en : CL + (size_t)bh * NGRP * HD * HD + e;
        const size_t sstep = isn ? HD : (size_t)HD * HD;
        float x[NGRP];
#pragma unroll
        for (int g = 0; g < NGRP; ++g) x[g] = src[(size_t)g * sstep];
        float C = 0.f;
#pragma unroll
        for (int g = 0; g < NGRP; ++g) {
            const size_t u = (size_t)bh * NGRP + g;
            if (isn) N0[u * HD + en] = C; else C0[u * HD * HD + e] = (bf16)(cvtpk(C, 0.f) & 0xffffu);
            C = DEC[bh * NGRP + g] * C + WLO[bh * NGRP + g] * x[g];
        }
        const int b = bh >> 2, h = bh & 3;
        if (isn) a.out[O_PN + ((size_t)(l * NB + b) * MH + h) * HD + en] = C;
        else a.out[O_PC + ((size_t)(l * NB + b) * MH + h) * HD * HD + e] = C;
        if (e == 0) a.out[O_PM + (size_t)(l * NB + b) * MH + h] = MFIN[bh];
    }
}

constexpr float ATT_C = 0.088388347648318440f * LOG2E;
constexpr float THR2 = 8.f * LOG2E;
struct DmaMap { unsigned k0, k1, v0, v1; };
__device__ __forceinline__ DmaMap dma_map(int lane, int wave, int LD) {
    DmaMap m; unsigned kk_[2], vv_[2];
#pragma unroll
    for (int i = 0; i < 2; ++i) { const int o = (wave + 8 * i) * 1024 + lane * 16;
        const int row = o >> 8, c16 = ((o >> 4) & 15) ^ (row & 7); kk_[i] = (unsigned)(row * LD + c16 * 8) * 2u;
        const int sub = o >> 9, kk = ((sub >> 2) << 3) | ((o >> 6) & 7), k = (kk & ~0xC) | ((kk & 4) << 1) | ((kk & 8) >> 1), cc = ((sub & 3) << 5) | ((o & 63) >> 1); vv_[i] = (unsigned)(k * LD + cc) * 2u; }
    m.k0 = kk_[0]; m.k1 = kk_[1]; m.v0 = vv_[0]; m.v1 = vv_[1]; return m;
}
__device__ __forceinline__ void glds16s(const void* sbase, unsigned voff, unsigned lds_dst) { unsigned keep;
    asm volatile("s_mov_b32 %0, m0\n\ts_mov_b32 m0, %3\n\ts_nop 0\n\tglobal_load_lds_dwordx4 %1, %2\n\ts_mov_b32 m0, %0" : "=&s"(keep) : "v"(voff), "s"(sbase), "s"(lds_dst) : "memory"); }
__device__ __forceinline__ void dma_fill(LAS unsigned char* lds, int slot, int wave, const bf16* Ta, unsigned a0, unsigned a1, const bf16* Tb, unsigned b0, unsigned b1) {
    const unsigned d = (unsigned)(uintptr_t)lds + (unsigned)(slot * 32768 + wave * 1024);
    glds16s(Ta, a0, d); glds16s(Ta, a1, d + 8192u); glds16s(Tb, b0, d + 16384u); glds16s(Tb, b1, d + 24576u);
}
#define RING_WAIT_BAR(N) do { asm volatile("s_waitcnt vmcnt(" #N ") lgkmcnt(0)" ::: "memory"); __builtin_amdgcn_s_barrier(); asm volatile("" ::: "memory"); } while (0)

__device__ __forceinline__ float fma_s(float a, float b, float c) { float d; asm("v_fma_f32 %0, %1, %2, %3" : "=v"(d) : "v"(a), "v"(b), "v"(c)); return d; }
__device__ __forceinline__ float add_s(float a, float b) { float d; asm("v_add_f32 %0, %1, %2" : "=v"(d) : "v"(a), "v"(b)); return d; }
#define ATT_SCORE_SOFTMAX(j, slotk)                                                                                                           \
    {   const int K_lds = ldsb + (slotk) * 16384;                                                                                              \
        f32x16 p0, p1; qkt(p0, p1, K_lds, qr, r32, hi);                                                                                       \
        STEP_FILL();                                                             \
        const int Rl = R0 + r32 - 64 * (j);                                                                                                   \
        const int relmin = R0 - 64 * (j) - 63;                                                                                                \
        if (relmin >= 128) { const float bc = BR[0];                                                                                           \
            _Pragma("unroll") for (int r = 0; r < 16; ++r) { p0[r] = fma_s(p0[r], ATT_C, bc); p1[r] = fma_s(p1[r], ATT_C, bc); }                \
        } else {                                                                                                                               \
            const LAS float* bp = BR + (64 + 128 - Rl + 4 * hi);                                                                               \
            _Pragma("unroll") for (int r = 0; r < 16; ++r) { p0[r] = fma_s(p0[r], ATT_C, bp[(r & 3) + 8 * (r >> 2)]); p1[r] = fma_s(p1[r], ATT_C, bp[32 + (r & 3) + 8 * (r >> 2)]); } \
        }                                                                                                                                      \
        const int nvalid = kend - 64 * (j);                                                                                                    \
        if (nvalid < 64) { asm volatile("" ::: "memory");                           \
            _Pragma("unroll") for (int r = 0; r < 16; ++r) { const int kk = crow(r, hi); if (kk >= nvalid) p0[r] = -1e30f; if (kk + 32 >= nvalid) p1[r] = -1e30f; } \
        }                                                                                                                                      \
        float pmax = p0[0];                                                                                                                    \
        _Pragma("unroll") for (int r = 1; r < 16; ++r) pmax = fmaxf(pmax, p0[r]);                                                              \
        _Pragma("unroll") for (int r = 0; r < 16; ++r) pmax = fmaxf(pmax, p1[r]);                                                              \
        pmax = half_swap_max(pmax);                                                                                                            \
        if (!__all(pmax - m_reg <= THR2)) {                                                                                                    \
            const float mn = fmaxf(m_reg, pmax); const float alpha = __builtin_amdgcn_exp2f(m_reg - mn); m_reg = mn;                           \
            l_reg *= alpha;                                                                                                                    \
            if (hi == 0) al_l[r32] = alpha; asm volatile("s_waitcnt lgkmcnt(0)" ::: "memory");                                               \
            _Pragma("unroll") for (int r = 0; r < 16; ++r) { const float al = al_l[crow(r, hi)];                                               \
                _Pragma("unroll") for (int d = 0; d < 4; ++d) o[d][r] *= al; }                                                                 \
        }                                                                                                                                      \
        float ps = 0.f;                                                                                                                        \
        _Pragma("unroll") for (int r = 0; r < 16; ++r) { p0[r] = __builtin_amdgcn_exp2f(p0[r] - m_reg); p1[r] = __builtin_amdgcn_exp2f(p1[r] - m_reg); ps = add_s(ps, add_s(p0[r], p1[r])); } \
        l_reg += half_swap_add(ps);                                                                                                            \
        PK4(p0, 0, pa0); PK4(p0, 8, pa1); PK4(p1, 0, pa2); PK4(p1, 8, pa3);                                                                    \
    }
__device__ __forceinline__ void attn_unit(const Ctx& c, const bf16* __restrict__ Qb, int LDQ, int qrow, const bf16* __restrict__ Kh, const bf16* __restrict__ Vh, int LDK, int NT, int alo, int ahi, int kend,
                                          int R0  , const float* __restrict__ bias_g, bf16* __restrict__ Ob, int LDO, bool do_store, const float* __restrict__ qgain = nullptr, int rot = 0) {
    int tid = c.tid; asm volatile("" : "+v"(tid));
    const int wid = c.wave, lane = tid & 63, r32 = lane & 31, hi = lane >> 5;
    const int ldsb = (int)(uintptr_t)c.lds;
    constexpr int VRING = 49152;
    LAS float* wsf = (LAS float*)(c.lds + 114688) + wid * 64; LAS float* li_l = wsf; LAS float* al_l = wsf + 32;
    LAS float* BR = (LAS float*)(c.lds + SCR_OFF);
    asm volatile("s_waitcnt lgkmcnt(0)" ::: "memory"); __builtin_amdgcn_s_barrier(); asm volatile("" ::: "memory");
    const DmaMap dm = dma_map(lane, wid, LDK);
    const size_t tile_step = (size_t)64 * LDK;
    const unsigned dbase = (unsigned)ldsb + (unsigned)wid * 1024u;
#define ATT_FILL(kt_, vt_, sk_, sv_) do { const unsigned dk_ = dbase + (unsigned)(sk_) * 16384u, dv_ = dbase + VRING + (unsigned)(sv_) * 16384u; \
        glds16s(kt_, dm.k0, dk_); glds16s(kt_, dm.k1, dk_ + 8192u); glds16s(vt_, dm.v0, dv_); glds16s(vt_, dm.v1, dv_ + 8192u); } while (0)
#define TIDX(s_) ((s_) + rot - (((s_) + rot) >= NT ? NT : 0))
    { const int t0_ = TIDX(0), t1_ = TIDX(1);
      ATT_FILL(Kh + t0_ * tile_step, Vh + t0_ * tile_step, 0, 0);
      ATT_FILL(Kh + t1_ * tile_step, Vh + t1_ * tile_step, 1, 1); }
    if (tid < 321) { const int i = tid - 64; BR[tid] = bias_g[256 - (i < 0 ? 0 : i)] * LOG2E; }
    float m_reg = -1e30f, l_reg = 0.f; f32x16 o[4] = {f32x16{}, f32x16{}, f32x16{}, f32x16{}}; bf16x8 qr[8];
    { const bf16* Qw = Qb + (size_t)(qrow + r32) * LDQ + hi * 8;
#pragma unroll
      for (int d0 = 0; d0 < 8; ++d0) qr[d0] = *(const bf16x8*)(Qw + d0 * 16); }
    if (qgain) {
        float f[8][8]; float ss = 0.f;
#pragma unroll
        for (int d0 = 0; d0 < 8; ++d0) { const u32x4 w = *reinterpret_cast<const u32x4*>(&qr[d0]);
            f[d0][0] = bflo(w.x); f[d0][1] = bfhi(w.x); f[d0][2] = bflo(w.y); f[d0][3] = bfhi(w.y); f[d0][4] = bflo(w.z); f[d0][5] = bfhi(w.z); f[d0][6] = bflo(w.w); f[d0][7] = bfhi(w.w);
#pragma unroll
            for (int i = 0; i < 8; ++i) ss += f[d0][i] * f[d0][i]; }
        ss = half_swap_add(ss);
        const float rq = fast_rsqrt(ss * (1.f / HD) + EPS);
#pragma unroll
        for (int d0 = 0; d0 < 8; ++d0) { const f32x4 g0 = *(const f32x4*)(qgain + d0 * 16 + hi * 8), g1 = *(const f32x4*)(qgain + d0 * 16 + hi * 8 + 4);
            u32x4 s; s.x = cvtpk(f[d0][0] * rq * g0[0], f[d0][1] * rq * g0[1]); s.y = cvtpk(f[d0][2] * rq * g0[2], f[d0][3] * rq * g0[3]);
            s.z = cvtpk(f[d0][4] * rq * g1[0], f[d0][5] * rq * g1[1]); s.w = cvtpk(f[d0][6] * rq * g1[2], f[d0][7] * rq * g1[3]);
            qr[d0] = *reinterpret_cast<bf16x8*>(&s); }
    }
#pragma unroll
    for (int d0 = 0; d0 < 8; ++d0) { u32x4 w = *reinterpret_cast<u32x4*>(&qr[d0]); asm volatile("" : "+v"(w)); qr[d0] = *reinterpret_cast<bf16x8*>(&w); }
    asm volatile("" ::: "memory");
    const bool skew = wid >= 4;
    bf16x8 pa0 = bf16x8{}, pa1 = bf16x8{}, pa2 = bf16x8{}, pa3 = bf16x8{};
    int sk = 0, sv = 0;
    bool pact = false;
    for (int j = 0; j < NT; ++j) {
        if (j + 1 < NT) RING_WAIT_BAR(4); else RING_WAIT_BAR(0);
#define STEP_FILL() do { if (j + 2 < NT) { const int fk = sk >= 1 ? sk - 1 : 2, fv = sv >= 2 ? sv - 2 : sv + 2; const int tf = TIDX(j + 2); ATT_FILL(Kh + tf * tile_step, Vh + tf * tile_step, fk, fv); } } while (0)
        const int jt = TIDX(j);
        const bool act = (jt >= alo && jt <= ahi);
        if (skew && pact) { const int svp = sv >= 1 ? sv - 1 : 3; pv_d0(o, ldsb + VRING + svp * 16384 + v_rd_base(lane), pa0, pa1, pa2, pa3); }
        pact = act;
        if (act) { ATT_SCORE_SOFTMAX(jt, sk); } else STEP_FILL();
        if (!skew && act) pv_d0(o, ldsb + VRING + sv * 16384 + v_rd_base(lane), pa0, pa1, pa2, pa3);
        sk = sk == 2 ? 0 : sk + 1; sv = (sv + 1) & 3;
    }
    if (skew && pact) { const int svp = sv >= 1 ? sv - 1 : 3; pv_d0(o, ldsb + VRING + svp * 16384 + v_rd_base(lane), pa0, pa1, pa2, pa3); }
#undef STEP_FILL
#undef TIDX
#undef ATT_FILL
    if (hi == 0) li_l[r32] = l_reg;
    RING_WAIT_BAR(0);
    const int ost = ldsb + wid * 8192;
#pragma unroll
    for (int r = 0; r < 16; ++r) { const int orow = crow(r, hi); const float rl = __builtin_amdgcn_rcpf(li_l[orow]);
#pragma unroll
        for (int d0 = 0; d0 < 4; ++d0) *(LAS bf16*)(uintptr_t)(unsigned)(ost + orow * 256 + (d0 * 32 + r32) * 2) = (bf16)(cvtpk(o[d0][r] * rl, 0.f) & 0xffffu); }
    asm volatile("s_waitcnt lgkmcnt(0)" ::: "memory");
    if (do_store) {
#pragma unroll
        for (int i = 0; i < 8; ++i) { const int ch = i * 64 + lane, row = ch >> 4, c16 = ch & 15;
            const u32x4 w = *(const LAS u32x4*)(uintptr_t)(unsigned)(ost + row * 256 + c16 * 16);
            *(u32x4*)(Ob + (size_t)(qrow + row) * LDO + c16 * 8) = w; }
    }
}
__device__ __forceinline__ void attn_stream(const Args& a, const Ctx& c, int l, const bool docv, const ConvJob& cvj, int& cvk) {
    constexpr int NATT = NB * NH * 32;
    if (c.vcu >= NATT) return;
    int tid = c.tid; asm volatile("" : "+v"(tid));
    const int wid = c.wave, lane = tid & 63, r32 = lane & 31, hi = lane >> 5;
    const int ldsb = (int)(uintptr_t)c.lds;
    constexpr int VRING = 49152;
    LAS float* wsf = (LAS float*)(c.lds + 114688) + wid * 64; LAS float* li_l = wsf; LAS float* al_l = wsf + 32;
    LAS float* BR = (LAS float*)(c.lds + SCR_OFF);
    const bf16* PROJ = (const bf16*)(a.ws + WS_BIG); bf16* MIX = (bf16*)(a.ws + WS_H);
    const int gq = c.vcu & 31, h = (c.vcu >> 5) & 7, b0 = c.vcu >> 8, db = c.G >> 8, nun = (NB - b0 + db - 1) / db;
    const int c0 = 4 * gq, jstart = c0 >= 8 ? 0 : 8 - c0, NT = 12 - jstart, ci = wid >> 1;
    const int alo = ci - jstart < 0 ? 0 : ci - jstart, ahi = ci + 8 - jstart, kend = NT * 64;
    const int R0 = (ci + 8 - jstart) * 64 + (wid & 1) * 32, rot = gq >= 2 ? (8 * gq + 8) % 12 : 0, qrow = wid * 32;
    const float* bias_g = a.rel_bias + (size_t)(l * NH + h) * 257;
    constexpr int LDK = NPROJ, LDO = D;
    asm volatile("s_waitcnt lgkmcnt(0)" ::: "memory"); __builtin_amdgcn_s_barrier(); asm volatile("" ::: "memory");
    const DmaMap dm = dma_map(lane, wid, LDK);
    const size_t tile_step = (size_t)64 * LDK;
    const unsigned dbase = (unsigned)ldsb + (unsigned)wid * 1024u;
#define ATT_FILL(kt_, vt_, sk_, sv_) do { const unsigned dk_ = dbase + (unsigned)(sk_) * 16384u, dv_ = dbase + VRING + (unsigned)(sv_) * 16384u; \
        glds16s(kt_, dm.k0, dk_); glds16s(kt_, dm.k1, dk_ + 8192u); glds16s(vt_, dm.v0, dv_); glds16s(vt_, dm.v1, dv_ + 8192u); } while (0)
#define TIDX(s_) ((s_) + rot - (((s_) + rot) >= NT ? NT : 0))
    const bf16* Qb = PROJ + (size_t)(b0 * SEQ + c0 * 64) * NPROJ + C_Q + h * HD;
    const bf16* Kh = PROJ + (size_t)(b0 * SEQ + (c0 - 8 + jstart) * 64) * NPROJ + C_K + h * HD;
    const bf16* Vh = PROJ + (size_t)(b0 * SEQ + (c0 - 8 + jstart) * 64) * NPROJ + C_V + h * HD;
    bf16* Ob = MIX + (size_t)(b0 * SEQ + c0 * 64) * D + 512 + h * HD;
    const size_t dproj = (size_t)db * SEQ * NPROJ, dmix = (size_t)db * SEQ * D;
    { const int t0_ = TIDX(0), t1_ = TIDX(1);
      ATT_FILL(Kh + t0_ * tile_step, Vh + t0_ * tile_step, 0, 0);
      ATT_FILL(Kh + t1_ * tile_step, Vh + t1_ * tile_step, 1, 1); }
    if (tid < 321) { const int i = tid - 64; BR[tid] = bias_g[256 - (i < 0 ? 0 : i)] * LOG2E; }
    bf16x8 qr[8];
    { const bf16* Qw = Qb + (size_t)(qrow + r32) * NPROJ + hi * 8;
#pragma unroll
      for (int d0 = 0; d0 < 8; ++d0) qr[d0] = *(const bf16x8*)(Qw + d0 * 16); }
    const bool skew = wid >= 4;
    int sk = 0, sv = 0;
#define Q_CONSUME() do { _Pragma("unroll") for (int d0 = 0; d0 < 8; ++d0) { u32x4 w = *reinterpret_cast<u32x4*>(&qr[d0]); asm volatile("" : "+v"(w)); qr[d0] = *reinterpret_cast<bf16x8*>(&w); } asm volatile("" ::: "memory"); } while (0)
    Q_CONSUME();
#pragma unroll 1
    for (int ui = 0; ui < nun; ++ui) {
        const bool has_next = ui + 1 < nun;
        const bf16* Khn = Kh + dproj; const bf16* Vhn = Vh + dproj;
        float m_reg = -1e30f, l_reg = 0.f; f32x16 o[4] = {f32x16{}, f32x16{}, f32x16{}, f32x16{}};
        bf16x8 pa0 = bf16x8{}, pa1 = bf16x8{}, pa2 = bf16x8{}, pa3 = bf16x8{};
        bool pact = false, skipw = false;
        for (int j = 0; j < NT; ++j) {
            if (!skipw) { if (j + 1 < NT || has_next) RING_WAIT_BAR(4); else RING_WAIT_BAR(0); }
            skipw = false;
#define STEP_FILL() do { const int fk = sk >= 1 ? sk - 1 : 2, fv = sv >= 2 ? sv - 2 : sv + 2;                                                                  \
                if (j + 2 < NT) { const int tf = TIDX(j + 2); ATT_FILL(Kh + tf * tile_step, Vh + tf * tile_step, fk, fv); }                                         \
                else if (has_next) { const int tf = TIDX(j + 2 - NT); ATT_FILL(Khn + tf * tile_step, Vhn + tf * tile_step, fk, fv); } } while (0)
            const int jt = TIDX(j);
            const bool act = (jt >= alo && jt <= ahi);
            const bool ppv = skew && pact;
            if (ppv) { const int svp = sv >= 1 ? sv - 1 : 3; pv_d0(o, ldsb + VRING + svp * 16384 + v_rd_base(lane), pa0, pa1, pa2, pa3); }
            pact = act;
            if (act) { ATT_SCORE_SOFTMAX(jt, sk); } else STEP_FILL();
            if (!skew && act) pv_d0(o, ldsb + VRING + sv * 16384 + v_rd_base(lane), pa0, pa1, pa2, pa3);
            sk = sk == 2 ? 0 : sk + 1; sv = (sv + 1) & 3;
            const int cit = cvj.gw + cvk * cvj.ngw;
            if (docv && !act && !ppv && j + 1 < NT && cit < CV_I_L) {
                float cvv[32]; conv_load(cvj, cit, lane, cvv); ++cvk;
                if (j + 2 < NT || has_next) RING_WAIT_BAR(36); else RING_WAIT_BAR(32);
                conv_finish(cvj, cit, lane, cvv, c.lds);
                skipw = true;
            }
        }
        if (skew && pact) { const int svp = sv >= 1 ? sv - 1 : 3; pv_d0(o, ldsb + VRING + svp * 16384 + v_rd_base(lane), pa0, pa1, pa2, pa3); }
#undef STEP_FILL
        if (has_next) { const bf16* Qw = Qb + dproj + (size_t)(qrow + r32) * NPROJ + hi * 8;
#pragma unroll
            for (int d0 = 0; d0 < 8; ++d0) qr[d0] = *(const bf16x8*)(Qw + d0 * 16); }
        if (hi == 0) li_l[r32] = l_reg;
        asm volatile("s_waitcnt lgkmcnt(0)" ::: "memory"); __builtin_amdgcn_s_barrier(); asm volatile("" ::: "memory");
        const int ost = ldsb + VRING + (((wid < 4 ? sv + 2 : sv + 3) & 3) * 16384) + (wid & 3) * 4096;
#pragma unroll
        for (int hf = 0; hf < 2; ++hf) {
#pragma unroll
            for (int r = 0; r < 16; ++r) { const int orow = crow(r, hi); const float rl = __builtin_amdgcn_rcpf(li_l[orow]);
#pragma unroll
                for (int dd = 0; dd < 2; ++dd) *(LAS bf16*)(uintptr_t)(unsigned)(ost + orow * 128 + (dd * 32 + r32) * 2) = (bf16)(cvtpk(o[2 * hf + dd][r] * rl, 0.f) & 0xffffu); }
            asm volatile("s_waitcnt lgkmcnt(0)" ::: "memory");
#pragma unroll
            for (int i = 0; i < 4; ++i) { const int ch = i * 64 + lane, row = ch >> 3, c16 = ch & 7;
                const u32x4 w = *(const LAS u32x4*)(uintptr_t)(unsigned)(ost + row * 128 + c16 * 16);
                *(u32x4*)(Ob + (size_t)(qrow + row) * LDO + hf * 64 + c16 * 8) = w; }
            asm volatile("s_waitcnt lgkmcnt(0)" ::: "memory");
        }
        Qb += dproj; Kh += dproj; Vh += dproj; Ob += dmix;
        if (has_next) Q_CONSUME();
    }
#undef Q_CONSUME
#undef TIDX
#undef ATT_FILL
}
#undef ATT_SCORE_SOFTMAX

__device__ __forceinline__ void m3_unit(const Args& a, const Ctx& c, int l, int unit) {
    const int g = unit & 31, bh = unit >> 5, b = bh >> 2, h = bh & 3;
    const bf16* PROJ = (const bf16*)(a.ws + WS_BIG); bf16* MIX = (bf16*)(a.ws + WS_H);
    const float* GATE = (const float*)(a.ws + WS_GATE);
    int tid = c.tid; asm volatile("" : "+v"(tid));
    const int wid = c.wave, lane = tid & 63, r32 = lane & 31, hi = lane >> 5;
    LAS float* scr = (LAS float*)(c.lds + SCR_OFF);
    LAS float* A_S = scr;
    LAS float* M_T = scr + 256;
    LAS float* B_T = scr + 512;
    LAS float* N0L = scr + 768;
    LAS float* TOT = scr + 896;
    const int ldsb = (int)(uintptr_t)c.lds;
    LAS float* wsf = (LAS float*)(c.lds + 98304) + wid * 64;
    const int row0 = b * SEQ + g * 256;
    const float m0 = ((const float*)(a.ws + WS_MSC))[(size_t)unit * 4 + 2];
    asm volatile("s_waitcnt vmcnt(0) lgkmcnt(0)" ::: "memory"); __builtin_amdgcn_s_barrier(); asm volatile("" ::: "memory");
    const DmaMap dm = dma_map(lane, wid, NPROJ); const DmaMap dc = dma_map(lane, wid, HD);
    const bf16* kt = PROJ + (size_t)row0 * NPROJ + C_MK + h * HD; const bf16* vt = PROJ + (size_t)row0 * NPROJ + C_MV + h * HD;
    const bf16* C0 = (const bf16*)(a.ws + WS_C0) + (size_t)unit * HD * HD;
    const size_t tile_step = (size_t)64 * NPROJ;
    dma_fill(c.lds, 0, wid, kt, dm.k0, dm.k1, vt, dm.v0, dm.v1);
    dma_fill(c.lds, 1, wid, kt + tile_step, dm.k0, dm.k1, vt + tile_step, dm.v0, dm.v1);
    bf16x8 qr[8];
    const int trow = wid * 32 + r32;
    { const bf16* Qw = PROJ + (size_t)(row0 + trow) * NPROJ + C_MQ + h * HD + hi * 8;
#pragma unroll
      for (int d0 = 0; d0 < 8; ++d0) qr[d0] = *(const bf16x8*)(Qw + d0 * 16); }
    u32x4 mo8[8];
#pragma unroll
    for (int i = 0; i < 8; ++i) { const int ch = i * 64 + lane, row = ch >> 4, col = (ch & 15) * 8; mo8[i] = *(const u32x4*)(PROJ + (size_t)(row0 + wid * 32 + row) * NPROJ + C_MO + h * HD + col); }
    float li = 0.f, lf = 0.f;
    if (tid < 256) { li = GATE[(size_t)(row0 + tid) * 8 + h]; lf = GATE[(size_t)(row0 + tid) * 8 + 4 + h]; }
    if (tid < 128) N0L[tid] = ((const float*)(a.ws + WS_N0))[(size_t)unit * HD + tid];
    const float bc = scan256_sum(lf, tid, lane, wid, TOT);
    const float as = li - bc;
    const float cm = scan256_max(tid < 256 ? as : -3.0e38f, tid, lane, wid, TOT);
    if (tid < 256) { A_S[tid] = as; M_T[tid] = fmaxf(m0, cm); B_T[tid] = bc; }
    __syncthreads();
    const float Mt = M_T[trow];
    f32x16 o[4] = {f32x16{}, f32x16{}, f32x16{}, f32x16{}};
    float rowsum = 0.f, qn = 0.f;
    const float winter = fast_exp(m0 - Mt);
    const int ci = wid >> 1;
    int slot = 0;
#pragma unroll 1
    for (int j = 0; j < 4; ++j) {
        RING_WAIT_BAR(4);
        { const int fs = slot >= 1 ? slot - 1 : 2;
          if (j + 2 < 4) dma_fill(c.lds, fs, wid, kt + (size_t)(j + 2) * tile_step, dm.k0, dm.k1, vt + (size_t)(j + 2) * tile_step, dm.v0, dm.v1);
          else if (j == 2) dma_fill(c.lds, fs, wid, C0, dc.v0, dc.v1, C0 + 64 * HD, dc.v0, dc.v1); }
        const int S_lds = ldsb + slot * 32768;
        int r32l = r32; asm volatile("" : "+v"(r32l));
        if (j <= ci) {
            f32x16 p0, p1; qkt(p0, p1, S_lds, qr, r32l, hi);
#pragma unroll
            for (int r = 0; r < 16; ++r) { const int s0 = 64 * j + crow(r, hi), s1 = s0 + 32;
                const float w0 = (s0 <= trow) ? fast_exp(A_S[s0] - Mt) * 0.08838834764831845f : 0.f, w1 = (s1 <= trow) ? fast_exp(A_S[s1] - Mt) * 0.08838834764831845f : 0.f;
                p0[r] *= w0; p1[r] *= w1; rowsum += p0[r] + p1[r]; }
            bf16x8 pa0, pa1, pa2, pa3;
            PK4(p0, 0, pa0); PK4(p0, 8, pa1); PK4(p1, 0, pa2); PK4(p1, 8, pa3);
            pv_d0(o, S_lds + 16384 + v_rd_base(lane), pa0, pa1, pa2, pa3);
        }
        slot = slot == 2 ? 0 : slot + 1;
    }
    RING_WAIT_BAR(0);
    {
        const int S_lds = ldsb + slot * 32768;
#pragma unroll
        for (int hf = 0; hf < 2; ++hf) {
            bf16x8 qs[4];
#pragma unroll
            for (int dd = 0; dd < 4; ++dd) { const int d0 = hf * 4 + dd; const u32x4 w = *reinterpret_cast<const u32x4*>(&qr[d0]);
                float f[8] = {bflo(w.x), bfhi(w.x), bflo(w.y), bfhi(w.y), bflo(w.z), bfhi(w.z), bflo(w.w), bfhi(w.w)};
#pragma unroll
                for (int i = 0; i < 8; ++i) qn += f[i] * N0L[d0 * 16 + hi * 8 + i];
                u32x4 s; s.x = cvtpk(f[0] * winter, f[1] * winter); s.y = cvtpk(f[2] * winter, f[3] * winter); s.z = cvtpk(f[4] * winter, f[5] * winter); s.w = cvtpk(f[6] * winter, f[7] * winter);
                qs[dd] = *reinterpret_cast<bf16x8*>(&s); }
            pv_d0(o, S_lds + hf * 16384 + v_rd_base(lane), qs[0], qs[1], qs[2], qs[3]);
        }
    }
    rowsum = half_swap_add(rowsum);
    qn = half_swap_add(qn);
    const float den = winter * qn + rowsum;
    const float dfl = fast_exp(-(B_T[trow] + Mt));
    const float inv = 1.0f / fmaxf(fabsf(den), dfl);
    if (hi == 0) wsf[r32] = inv;
    asm volatile("s_waitcnt lgkmcnt(0)" ::: "memory");
#pragma unroll
    for (int r = 0; r < 16; ++r) { const float sc_ = wsf[crow(r, hi)];
#pragma unroll
        for (int d0 = 0; d0 < 4; ++d0) o[d0][r] *= sc_; }
    RING_WAIT_BAR(0);
    const int hst = ldsb + wid * 16384;
    { int le = lane; asm volatile("" : "+v"(le)); const int r32e = le & 31, hie = le >> 5;
#pragma unroll
    for (int r = 0; r < 16; ++r)
#pragma unroll
        for (int d0 = 0; d0 < 4; ++d0) *(LAS float*)(uintptr_t)(unsigned)(hst + crow(r, hie) * 512 + (d0 * 32 + r32e) * 4) = o[d0][r]; }
    asm volatile("s_waitcnt lgkmcnt(0)" ::: "memory");
    const float* gn = a.mlstm_norm_g + (size_t)l * 512 + h * HD;
    int le = lane; asm volatile("" : "+v"(le));
#pragma unroll
    for (int i = 0; i < 8; ++i) { const int ch = i * 64 + le, row = ch >> 4, col = (ch & 15) * 8;
        const f32x4 a0 = *(const LAS f32x4*)(uintptr_t)(unsigned)(hst + row * 512 + col * 4), a1 = *(const LAS f32x4*)(uintptr_t)(unsigned)(hst + row * 512 + col * 4 + 16);
        float ss = (a0.x * a0.x + a0.y * a0.y) + (a0.z * a0.z + a0.w * a0.w) + (a1.x * a1.x + a1.y * a1.y) + (a1.z * a1.z + a1.w * a1.w);
        ss += shx(ss, 1, le); ss += shx(ss, 2, le); ss += shx(ss, 4, le); ss += shx(ss, 8, le);
        const float rstd = fast_rsqrt(ss * (1.f / HD) + EPS);
        const int orow = row0 + wid * 32 + row;
        const u32x4 mo = mo8[i];
        const f32x4 g0 = *(const f32x4*)(gn + col), g1 = *(const f32x4*)(gn + col + 4);
        float y[8] = {a0.x * g0.x, a0.y * g0.y, a0.z * g0.z, a0.w * g0.w, a1.x * g1.x, a1.y * g1.y, a1.z * g1.z, a1.w * g1.w};
        const float mf[8] = {bflo(mo.x), bfhi(mo.x), bflo(mo.y), bfhi(mo.y), bflo(mo.z), bfhi(mo.z), bflo(mo.w), bfhi(mo.w)};
#pragma unroll
        for (int k = 0; k < 8; ++k) y[k] = y[k] * rstd * (1.0f / (1.0f + fast_exp(-mf[k])));
        u32x4 w; w.x = cvtpk(y[0], y[1]); w.y = cvtpk(y[2], y[3]); w.z = cvtpk(y[4], y[5]); w.w = cvtpk(y[6], y[7]);
        *(u32x4*)(MIX + (size_t)orow * D + 1536 + h * HD + col) = w; }
}

__device__ __forceinline__ void ms_unit(const Args& a, const Ctx& c, int l, int unit) {
    const int b = unit >> 2, h = unit & 3; int tid = c.tid; asm volatile("" : "+v"(tid));
    const int lane = tid & 63, wid = c.wave;
    const bf16* PROJ = (const bf16*)(a.ws + WS_BIG); bf16* MIX = (bf16*)(a.ws + WS_H);
    const float* GATE = (const float*)(a.ws + WS_GATE);
    constexpr int P = 132;
    LAS float* Q = (LAS float*)c.lds;
    LAS float* Kk = Q + 32 * P;
    LAS float* V = Kk + 32 * P;
    LAS float* HB = V + 32 * P;
    LAS float* S = HB + 32 * P;
    LAS float* N0 = S + 32 * 33;
    LAS float* A_S = N0 + 128;
    LAS float* M_T = A_S + 32;
    LAS float* B_T = M_T + 32;
    LAS float* WST = B_T + 32;
    LAS float* DEN = WST + 32;
    LAS float* WIN = DEN + 32;
    LAS float* SC = WIN + 32;
    const int row0 = MP + b * SSEQ;
    const size_t sidx = (size_t)(l * SBATCH + b) * MH + h;
    const float* C0 = a.state_c + sidx * HD * HD;
    __syncthreads();
    for (int i = tid; i < 1536; i += NTHREADS) { const int which = i >> 9, r = (i >> 4) & 31, c8 = (i & 15) * 8;
        const u32x4 w = *(const u32x4*)(PROJ + (size_t)(row0 + r) * NPROJ + (which == 0 ? C_MQ : which == 1 ? C_MK : C_MV) + h * HD + c8);
        const float sc = which == 1 ? 0.08838834764831845f : 1.0f;
        LAS float* dst = (which == 0 ? Q : which == 1 ? Kk : V) + r * P + c8;
        *(LAS f32x4*)dst = (f32x4){bflo(w.x) * sc, bfhi(w.x) * sc, bflo(w.y) * sc, bfhi(w.y) * sc};
        *(LAS f32x4*)(dst + 4) = (f32x4){bflo(w.z) * sc, bfhi(w.z) * sc, bflo(w.w) * sc, bfhi(w.w) * sc}; }
    if (tid < 128) N0[tid] = a.state_n[sidx * HD + tid];
    if (wid == 0) {
        const int t = lane & 31; const float m0 = a.state_m[sidx];
        const float li = GATE[(size_t)(row0 + t) * 8 + h], lf = GATE[(size_t)(row0 + t) * 8 + 4 + h];
        float bc = lf;
#pragma unroll
        for (int o = 1; o < 32; o <<= 1) { const float x = shup(bc, o, lane); if ((lane & 31) >= o) bc += x; }
        const float as = li - bc; float cm = as;
#pragma unroll
        for (int o = 1; o < 32; o <<= 1) { const float x = shup(cm, o, lane); if ((lane & 31) >= o) cm = fmaxf(cm, x); }
        const float blast = __int_as_float(__builtin_amdgcn_ds_bpermute(31 << 2, __float_as_int(bc))), amax = __int_as_float(__builtin_amdgcn_ds_bpermute(31 << 2, __float_as_int(cm)));
        const float Mt = fmaxf(m0, cm), mnew = fmaxf(blast + m0, blast + amax);
        if (lane < 32) { A_S[t] = as; B_T[t] = bc; M_T[t] = Mt; WST[t] = fast_exp(blast + as - mnew); WIN[t] = fast_exp(m0 - Mt); }
        if (lane == 0) { SC[0] = m0; SC[1] = blast; SC[2] = mnew; SC[3] = fast_exp(blast + m0 - mnew); }
    }
    __syncthreads();
    for (int i = tid; i < 1024; i += NTHREADS) { const int t = i >> 5, s = i & 31; float d = 0.f;
        if (s <= t) {
#pragma unroll 8
            for (int k = 0; k < 128; k += 4) { const f32x4 q4 = *(const LAS f32x4*)(Q + t * P + k), k4 = *(const LAS f32x4*)(Kk + s * P + k); d += (q4.x * k4.x + q4.y * k4.y) + (q4.z * k4.z + q4.w * k4.w); }
            d *= fast_exp(A_S[s] - M_T[t]); }
        S[t * 33 + s] = d; }
    __syncthreads();
    if (tid < 32) { const int t = tid; float qn = 0.f, rs = 0.f;
        for (int k = 0; k < 128; ++k) qn += Q[t * P + k] * N0[k];
        for (int s = 0; s < 32; ++s) rs += S[t * 33 + s];
        const float den = WIN[t] * qn + rs; DEN[t] = 1.0f / fmaxf(fabsf(den), fast_exp(-(B_T[t] + M_T[t]))); }
    const int e = tid & 127, tg = tid >> 7;
    { float acc[8];
#pragma unroll
      for (int i = 0; i < 8; ++i) acc[i] = 0.f;
      for (int d0 = 0; d0 < 128; d0 += 16) { float cv[16];
#pragma unroll
          for (int j = 0; j < 16; ++j) cv[j] = C0[(size_t)(d0 + j) * HD + e];
#pragma unroll
          for (int j = 0; j < 16; j += 4)
#pragma unroll
              for (int i = 0; i < 8; ++i) { const f32x4 q4 = *(const LAS f32x4*)(Q + (tg * 8 + i) * P + d0 + j); acc[i] += (q4.x * cv[j] + q4.y * cv[j + 1]) + (q4.z * cv[j + 2] + q4.w * cv[j + 3]); } }
      __syncthreads();
#pragma unroll
      for (int i = 0; i < 8; ++i) { const int t = tg * 8 + i; float v = acc[i] * WIN[t];
          for (int s = 0; s <= t; ++s) v += S[t * 33 + s] * V[s * P + e];
          HB[t * P + e] = v * DEN[t]; } }
    __syncthreads();
    { const int t = tid >> 4, e0 = (tid & 15) * 8; float ss = 0.f;
      const f32x4 h0 = *(const LAS f32x4*)(HB + t * P + e0), h1 = *(const LAS f32x4*)(HB + t * P + e0 + 4);
      ss = (h0.x * h0.x + h0.y * h0.y) + (h0.z * h0.z + h0.w * h0.w) + (h1.x * h1.x + h1.y * h1.y) + (h1.z * h1.z + h1.w * h1.w);
      ss += shx(ss, 1, lane); ss += shx(ss, 2, lane); ss += shx(ss, 4, lane); ss += shx(ss, 8, lane);
      const float rstd = fast_rsqrt(ss * (1.f / HD) + EPS);
      const u32x4 mo = *(const u32x4*)(PROJ + (size_t)(row0 + t) * NPROJ + C_MO + h * HD + e0);
      const float* gn = a.mlstm_norm_g + (size_t)l * 512 + h * HD + e0;
      const f32x4 g0 = *(const f32x4*)gn, g1 = *(const f32x4*)(gn + 4);
      float y[8] = {h0.x * g0.x, h0.y * g0.y, h0.z * g0.z, h0.w * g0.w, h1.x * g1.x, h1.y * g1.y, h1.z * g1.z, h1.w * g1.w};
      const float mf[8] = {bflo(mo.x), bfhi(mo.x), bflo(mo.y), bfhi(mo.y), bflo(mo.z), bfhi(mo.z), bflo(mo.w), bfhi(mo.w)};
#pragma unroll
      for (int k = 0; k < 8; ++k) y[k] = y[k] * rstd * (1.0f / (1.0f + fast_exp(-mf[k])));
      u32x4 w; w.x = cvtpk(y[0], y[1]); w.y = cvtpk(y[2], y[3]); w.z = cvtpk(y[4], y[5]); w.w = cvtpk(y[6], y[7]);
      *(u32x4*)(MIX + (size_t)(row0 + t) * D + 1536 + h * HD + e0) = w; }
    { const float decay = SC[3]; const int dg = tg * 32; float acc[32];
#pragma unroll
      for (int i = 0; i < 32; ++i) acc[i] = C0[(size_t)(dg + i) * HD + e] * decay;
      for (int s = 0; s < 32; ++s) { const float vv = V[s * P + e] * WST[s];
#pragma unroll
          for (int i = 0; i < 32; i += 4) { const f32x4 k4 = *(const LAS f32x4*)(Kk + s * P + dg + i); acc[i] += k4.x * vv; acc[i + 1] += k4.y * vv; acc[i + 2] += k4.z * vv; acc[i + 3] += k4.w * vv; } }
      float* oc = a.out + O_SC + sidx * HD * HD;
#pragma unroll
      for (int i = 0; i < 32; ++i) oc[(size_t)(dg + i) * HD + e] = acc[i];
      if (tid < 128) { float v = decay * N0[tid]; for (int s = 0; s < 32; ++s) v += WST[s] * Kk[s * P + tid]; a.out[O_SN + sidx * HD + tid] = v; }
      if (tid == 0) a.out[O_SM + sidx] = SC[2]; }
}

__device__ __forceinline__ void phase_e(const Args& a, const Ctx& c_in0, int l) {
    const Ctx c = relaunder(c_in0);
    const bf16* PROJ = (const bf16*)(a.ws + WS_BIG); bf16* MIX = (bf16*)(a.ws + WS_H);
    constexpr int NATT = NB * NH * 32;
#if (PE_EN & 1)
    const bool hasjob = l + 1 < DEPTH;
    const ConvJob job{a.w_in, a.w_out, a.w_up, a.w_down, a.norm_mix_g, a.norm_mlp_g, a.ws, l + 1, c.vcu * NWAVES + c.wave, c.G * NWAVES}; int cvk = 0;
    if (hasjob) {
        __syncthreads();
        *(LAS f32x4*)(c.lds + GT0_OFF + c.tid * 16) = *(const f32x4*)(a.norm_mix_g + (size_t)(l + 1) * D + c.tid * 4);
        *(LAS f32x4*)(c.lds + GT1_OFF + c.tid * 16) = *(const f32x4*)(a.norm_mlp_g + (size_t)(l + 1) * D + c.tid * 4);
    }
    if ((c.G & 255) == 0) attn_stream(a, c, l, hasjob, job, cvk);
    else
    for (int u = c.vcu; u < NATT; u += c.G) {
        const int gq = u & 31, bhh = u >> 5, b = bhh >> 3, h = bhh & 7;
        const int c0 = 4 * gq, jstart = c0 >= 8 ? 0 : 8 - c0, NT = 12 - jstart, ci = c.wave >> 1;
        const int krow0 = b * SEQ + (c0 - 8 + jstart) * 64;
        const int alo = ci - jstart, ahi = ci + 8 - jstart;
        const int R0 = (ci + 8 - jstart) * 64 + (c.wave & 1) * 32;
        attn_unit(c, PROJ + (size_t)(b * SEQ + c0 * 64) * NPROJ + C_Q + h * HD, NPROJ, c.wave * 32, PROJ + (size_t)krow0 * NPROJ + C_K + h * HD, PROJ + (size_t)krow0 * NPROJ + C_V + h * HD, NPROJ,
                  NT, alo < 0 ? 0 : alo, ahi, NT * 64, R0, a.rel_bias + (size_t)(l * NH + h) * 257, MIX + (size_t)(b * SEQ + c0 * 64) * D + 512 + h * HD, D, true, nullptr,
                  gq >= 2 ? (8 * gq + 8) % 12 : 0);
    }
    if (hasjob) { while (conv_step(job, cvk, c.lane, c.lds)) {} }
#endif
#if (PE_EN & 4)
    for (int u = c.vcu; u < 16 * NGRP; u += c.G) m3_unit(a, c, l, u);
#endif
}
__device__ __forceinline__ void sample_kv_prep(const Args& a, const Ctx& c, int l, int b, int h) {
    int tid = c.tid; asm volatile("" : "+v"(tid));
    const int lane = tid & 63, row = tid >> 4, c8 = (tid & 15) * 8;
    const bf16* PROJ = (const bf16*)(a.ws + WS_BIG);
    bf16* SK = (bf16*)(a.ws + WS_SK + (size_t)(l & 1) * SKV_IMG); bf16* SV = (bf16*)(a.ws + WS_SV + (size_t)(l & 1) * SKV_IMG);
    const size_t ro = (size_t)(MP + b * SSEQ + row) * NPROJ + h * HD + c8;
    const u32x4 kq = *(const u32x4*)(PROJ + ro + C_K), vq = *(const u32x4*)(PROJ + ro + C_V);
    float x[8] = {bflo(kq.x), bfhi(kq.x), bflo(kq.y), bfhi(kq.y), bflo(kq.z), bfhi(kq.z), bflo(kq.w), bfhi(kq.w)};
    float ss = 0.f;
#pragma unroll
    for (int i = 0; i < 8; ++i) ss += x[i] * x[i];
    ss += shx(ss, 1, lane); ss += shx(ss, 2, lane); ss += shx(ss, 4, lane); ss += shx(ss, 8, lane);
    const float rk = fast_rsqrt(ss * (1.f / HD) + EPS);
    const float* gk = a.k_norm_g + l * HD + c8; const f32x4 g0 = *(const f32x4*)gk, g1 = *(const f32x4*)(gk + 4);
    x[0] *= rk * g0[0]; x[1] *= rk * g0[1]; x[2] *= rk * g0[2]; x[3] *= rk * g0[3]; x[4] *= rk * g1[0]; x[5] *= rk * g1[1]; x[6] *= rk * g1[2]; x[7] *= rk * g1[3];
    u32x4 o; o.x = cvtpk(x[0], x[1]); o.y = cvtpk(x[2], x[3]); o.z = cvtpk(x[4], x[5]); o.w = cvtpk(x[6], x[7]);
    const size_t io = ((size_t)b * SKV_ROWS + 512 + row) * 1024 + h * HD + c8;
    *(u32x4*)(SK + io) = o; *(u32x4*)(SV + io) = vq;
    const size_t oo = ((size_t)(l * SBATCH + b) * SSEQ + row) * 1024 + h * HD + c8;
    float* ok = a.out + O_SK + oo; float* ov = a.out + O_SV + oo;
    *(f32x4*)ok = (f32x4){x[0], x[1], x[2], x[3]}; *(f32x4*)(ok + 4) = (f32x4){x[4], x[5], x[6], x[7]};
    *(f32x4*)ov = (f32x4){bflo(vq.x), bfhi(vq.x), bflo(vq.y), bfhi(vq.y)}; *(f32x4*)(ov + 4) = (f32x4){bflo(vq.z), bfhi(vq.z), bflo(vq.w), bfhi(vq.w)};
    asm volatile("s_waitcnt vmcnt(0)" ::: "memory"); __syncthreads();
}
__device__ __forceinline__ void sample_mixers(const Args& a, const Ctx& c, int l) {
    const bf16* PROJ = (const bf16*)(a.ws + WS_BIG); bf16* MIX = (bf16*)(a.ws + WS_H);
#if (PE_EN & 2)
    for (int su = c.vcu; su < SBATCH * NH; su += c.G) {
        const int b = su >> 3, h = su & 7;
        sample_kv_prep(a, c, l, b, h);
        const bf16* SK = (const bf16*)(a.ws + WS_SK + (size_t)(l & 1) * SKV_IMG) + (size_t)b * SKV_ROWS * 1024 + h * HD; const bf16* SV = (const bf16*)(a.ws + WS_SV + (size_t)(l & 1) * SKV_IMG) + (size_t)b * SKV_ROWS * 1024 + h * HD;
        attn_unit(c, PROJ + (size_t)(MP + b * SSEQ) * NPROJ + C_Q + h * HD, NPROJ, 0, SK, SV, 1024, 9, 0, 8, 544, 512, a.rel_bias + (size_t)(l * NH + h) * 257,
                  MIX + (size_t)(MP + b * SSEQ) * D + 512 + h * HD, D, c.wave == 0, a.q_norm_g + l * HD);
    }
#endif
#if (PE_EN & 8)
    for (int u = c.vcu - SBATCH * NH; u >= 0 && u < SBATCH * MH; u += c.G) ms_unit(a, c, l, u);
#endif
    __syncthreads();
}
typedef const __attribute__((address_space(4))) Args* KArgP;
#if defined(__HIP_DEVICE_COMPILE__)
__device__ __forceinline__ Args get_args() { KArgP p = (KArgP)__builtin_amdgcn_kernarg_segment_ptr(); asm volatile("" : "+s"(p)); return *p; }
#else
__device__ Args get_args();
#endif
__global__ void __launch_bounds__(NTHREADS, 2) fwd(Args args) {
    extern __shared__ __attribute__((aligned(16))) unsigned char lds_raw[];
    Ctx c; c.lds = (LAS unsigned char*)lds_raw; c.wave = __builtin_amdgcn_readfirstlane((int)threadIdx.x >> 6); c.tid = hw_tid(c.wave); c.lane = c.tid & 63;
    c.G = gridDim.x; { const int bx = blockIdx.x; c.vcu = (c.G % 8 == 0) ? (bx % 8) * (c.G / 8) + bx / 8 : bx; }
    volatile LAS unsigned* MISC = (volatile LAS unsigned*)(c.lds + MISC_OFF);
    { const int t0 = hw_tid(c.wave); if (t0 < 16) MISC[t0] = 0u; }
    __syncthreads();
    unsigned* barw = (unsigned*)(get_args().ws + WS_CTL) + 4096;
    XcdBarrier bar; bar.bar = barw; bar.x = 0; bar.st = nullptr;
    const int lo = args.ph_lo, hi = args.ph_hi;
    const bool multi = (hi - lo) > 1;
    if (multi) bar = xcd_barrier_post(barw, MISC + 8, hw_tid(c.wave) == 0);
#define IN(k) (lo <= (k) && (k) < hi)
#define SEAM(k) do { if (IN(k) && IN((k) + 1)) xcd_barrier(bar.bar, bar.x, bar.st, c.wave); } while (0)
    for (int l = 0; l < DEPTH; ++l) {
        const int pb = l * NPH_LAYER;
        if (IN(pb + 0)) {
#if (PH_EN >> 1) & 1
            { const Args A_ = get_args(); phase_norm<true>(A_, c, l); }
#if (PH_DUP >> 1) & 1
            { __syncthreads(); const Args A_ = get_args(); phase_norm<true>(A_, c, l); }
#endif
#endif
 __syncthreads(); SEAM(pb + 0); }
        if (IN(pb + 1)) {
            const Args A_ = get_args(); bf16* H = (bf16*)(A_.ws + WS_H); bf16* BIG = (bf16*)(A_.ws + WS_BIG);
            bf16* XBp = (bf16*)(A_.ws + WS_XB); const float* RS = (const float*)(A_.ws + WS_RSTD);
            pg8::Gemm g{XBp, (const bf16*)(A_.ws + WS_WIN + (size_t)(l & 1) * WSET), MP, NPROJ, D}; pg8::StaticOrder S; S.init(MP, NPROJ, c.G, (int)blockIdx.x, WGM_B);
            pg8::EpiProj E{BIG, NPROJ, A_.q_norm_g + l * HD, A_.k_norm_g + l * HD, (LAS float*)(c.lds + SCR_OFF), RS};

#if (PH_EN >> 2) & 1
            for (int rep_ = 0, nrep_ = ((PH_DUP >> 2) & 1) ? A_.rep : 1; rep_ < nrep_; ++rep_) pg8::gemm_phase<pg8::EpiProj, pg8::StaticOrder, true, true>(c.lds, g, S, E, c.wave);
            { SEpiBf16 SE{BIG + (size_t)MP * NPROJ, NPROJ, 0, RS + MP}; sample_gemm(c.lds, c.wave, c.vcu, c.G, XBp + (size_t)MP * D, g.Bt, NPROJ, D, SE); }
#endif

            SEAM(pb + 1);
        }
        if (IN(pb + 2)) {
#if (PH_EN >> 3) & 1
            { const Args A_ = get_args(); phase_c<true>(A_, c, l); }
#if (PH_DUP >> 3) & 1
            { __syncthreads(); const Args A_ = get_args(); phase_c<false>(A_, c, l); }
#endif
#endif
 SEAM(pb + 2); }
        if (IN(pb + 3)) {
#if (PH_EN >> 4) & 1
            { const Args A_ = get_args(); phase_d(A_, c, l); }
            { const Args A_ = get_args(); if (l + 1 < DEPTH) build_kv_image(A_, c.vcu, c.G, hw_tid(c.wave), l + 1); }
#if (PH_DUP >> 4) & 1
            { __syncthreads(); const Args A_ = get_args(); phase_d(A_, c, l); }
#endif
#endif
 SEAM(pb + 3); }
        if (IN(pb + 4)) {
#if (PH_EN >> 5) & 1
            { const Args A_ = get_args(); phase_e(A_, c, l); }
#if (PH_DUP >> 5) & 1
            { __syncthreads(); const Args A_ = get_args(); phase_e(A_, c, l); }
#endif
#endif
 __syncthreads(); SEAM(pb + 4); }
        if (IN(pb + 5)) {
            const Args A_ = get_args(); bf16* H = (bf16*)(A_.ws + WS_H);
            pg8::Gemm g{H, (const bf16*)(A_.ws + WS_WOUT + (size_t)(l & 1) * WSET), MP, D, D}; pg8::StaticOrder S; S.init(MP, D, c.G, (int)blockIdx.x, WGM_F);
            pg8::EpiResAdd E{(bf16*)(A_.ws + WS_XB), A_.out, D, false};

#if (PH_EN >> 6) & 1
            pg8::gemm_phase<pg8::EpiResAdd, pg8::StaticOrder, true, true>(c.lds, g, S, E, c.wave);
            { SEpiResAdd SE{(bf16*)(A_.ws + WS_XB) + (size_t)MP * D, A_.out + (size_t)MP * D, D, false}; sample_gemm<SEpiResAdd, 32>(c.lds, c.wave, c.vcu, c.G, H + (size_t)MP * D, g.Bt, D, D, SE); }
#if (PH_DUP >> 6) & 1
            { pg8::EpiBf16<0> E2{(bf16*)(A_.ws + WS_BIG), D, nullptr, (LAS float*)(c.lds + SCR_OFF)}; pg8::gemm_phase<pg8::EpiBf16<0>, pg8::StaticOrder, true, true>(c.lds, g, S, E2, c.wave); }
#endif
#endif

            SEAM(pb + 5);
        }
        if (IN(pb + 6)) {
#if (PH_EN >> 7) & 1
            { const Args A_ = get_args(); phase_norm<false>(A_, c, l); }
#if (PH_DUP >> 7) & 1
            { __syncthreads(); const Args A_ = get_args(); phase_norm<false>(A_, c, l); }
#endif
#endif
 SEAM(pb + 6); }
        if (IN(pb + 7)) {
            const Args A_ = get_args(); bf16* H = (bf16*)(A_.ws + WS_H); bf16* BIG = (bf16*)(A_.ws + WS_BIG);
            bf16* XBp = (bf16*)(A_.ws + WS_XB); const float* RS = (const float*)(A_.ws + WS_RSTD);
            pg8::Gemm g{XBp, (const bf16*)(A_.ws + WS_WUP + (size_t)(l & 1) * WSET), MP, FF, D}; pg8::StaticOrder S; S.init(MP, FF, c.G, (int)blockIdx.x, WGM_H);
            pg8::EpiBf16<1> E{BIG, FF, RS, (LAS float*)(c.lds + SCR_OFF)};

#if (PH_EN >> 8) & 1
            for (int rep_ = 0, nrep_ = ((PH_DUP >> 8) & 1) ? A_.rep : 1; rep_ < nrep_; ++rep_) pg8::gemm_phase<pg8::EpiBf16<1>, pg8::StaticOrder, true, true>(c.lds, g, S, E, c.wave);
            { SEpiBf16 SE{BIG + (size_t)MP * FF, FF, 1, RS + MP}; sample_gemm(c.lds, c.wave, c.vcu, c.G, XBp + (size_t)MP * D, g.Bt, FF, D, SE); }
#endif

            SEAM(pb + 7);
        }
        if (IN(pb + 8)) {
            const Args A_ = get_args(); bf16* BIG = (bf16*)(A_.ws + WS_BIG);
            pg8::Gemm g{BIG, (const bf16*)(A_.ws + WS_WDN + (size_t)(l & 1) * WSET), MP, D, FF}; pg8::StaticOrder S; S.init(MP, D, c.G, (int)blockIdx.x, WGM_I);
            pg8::EpiResAdd E{(bf16*)(A_.ws + WS_XB), A_.out, D, l == DEPTH - 1};

#if (PH_EN >> 9) & 1
            pg8::gemm_phase<pg8::EpiResAdd, pg8::StaticOrder, true, true>(c.lds, g, S, E, c.wave);
            { SEpiResAdd SE{(bf16*)(A_.ws + WS_XB) + (size_t)MP * D, A_.out + (size_t)MP * D, D, l == DEPTH - 1}; sample_gemm<SEpiResAdd, 32>(c.lds, c.wave, c.vcu, c.G, BIG + (size_t)MP * FF, g.Bt, D, FF, SE); }
#if (PH_DUP >> 9) & 1
            { pg8::EpiBf16<0> E2{(bf16*)(A_.ws + WS_H), D, nullptr, (LAS float*)(c.lds + SCR_OFF)}; pg8::gemm_phase<pg8::EpiBf16<0>, pg8::StaticOrder, true, true>(c.lds, g, S, E2, c.wave); }
#endif
#endif

            SEAM(pb + 8);
        }
    }
#undef IN
#undef SEAM
}

extern "C" void kernel_launch(void* const* d_in, const int* in_sizes, int n_in, void* d_out, int out_size, void* d_ws, size_t ws_size, hipStream_t stream) {
    static int grid = 0;
    if (grid == 0) {
        if (n_in != 21 || (size_t)out_size != O_END || ws_size < WS_END) { fprintf(stderr, "kernel_launch: shape mismatch n_in %d out %d ws %zu (need %zu)\n", n_in, out_size, ws_size, (size_t)WS_END); grid = -1; return; }
        int dev = 0, cus = 0, per_cu = 0;
        if (hipGetDevice(&dev) != hipSuccess || hipDeviceGetAttribute(&cus, hipDeviceAttributeMultiprocessorCount, dev) != hipSuccess) { grid = -1; return; }
        if (hipFuncSetAttribute((const void*)fwd, hipFuncAttributeMaxDynamicSharedMemorySize, LDS_BYTES) != hipSuccess) { fprintf(stderr, "kernel_launch: hipFuncSetAttribute failed\n"); grid = -1; return; }
        if (hipOccupancyMaxActiveBlocksPerMultiprocessor(&per_cu, (const void*)fwd, NTHREADS, LDS_BYTES) != hipSuccess || per_cu < 1) { fprintf(stderr, "kernel_launch: occupancy query says %d\n", per_cu); }
        (void)hipGetLastError();
        grid = cus;
    }
    if (grid < 0) return;
    (void)hipMemsetAsync((char*)d_ws + WS_CTL, 0, CTL_BYTES, stream);
    Args a{};
    a.x_prompt = (const float*)d_in[0]; a.x_sample = (const float*)d_in[1]; a.cache_k = (const float*)d_in[2]; a.cache_v = (const float*)d_in[3]; a.state_conv = (const float*)d_in[4];
    a.state_c = (const float*)d_in[5]; a.state_n = (const float*)d_in[6]; a.state_m = (const float*)d_in[7]; a.norm_mix_g = (const float*)d_in[8]; a.w_in = (const float*)d_in[9];
    a.conv_w = (const float*)d_in[10]; a.q_norm_g = (const float*)d_in[11]; a.k_norm_g = (const float*)d_in[12]; a.rel_bias = (const float*)d_in[13]; a.b_igate = (const float*)d_in[14];
    a.b_fgate = (const float*)d_in[15]; a.mlstm_norm_g = (const float*)d_in[16]; a.w_out = (const float*)d_in[17]; a.norm_mlp_g = (const float*)d_in[18]; a.w_up = (const float*)d_in[19];
    a.w_down = (const float*)d_in[20]; a.out = (float*)d_out; a.ws = (unsigned char*)d_ws;
#if MK_PER_PHASE
    for (int p = 0; p < NPHASES; ++p) { a.ph_lo = p; a.ph_hi = p + 1; a.rep = 2; hipLaunchKernelGGL(fwd, dim3(grid), dim3(NTHREADS), LDS_BYTES, stream, a); }
#else
    a.ph_lo = 0; a.ph_hi = NPHASES; a.rep = 2; hipLaunchKernelGGL(fwd, dim3(grid), dim3(NTHREADS), LDS_BYTES, stream, a);
#endif
    const hipError_t le = hipPeekAtLastError();
    if (le != hipSuccess) fprintf(stderr, "kernel_launch: launch failed: %s\n", hipGetErrorName(le));
}
```

```cpp
#include <hip/hip_runtime.h>
#include <cstdio>
#include <cstdint>

#ifndef MK_PER_PHASE
#define MK_PER_PHASE 0
#endif

#ifndef PH_EN
#define PH_EN 0x3ff
#endif
#ifndef PE_EN
#define PE_EN 0xf
#endif
#ifndef WGM_B
#define WGM_B 4
#endif
#ifndef WGM_F
#define WGM_F 4
#endif
#ifndef WGM_H
#define WGM_H 4
#endif
#ifndef WGM_I
#define WGM_I 4
#endif
#ifndef PH_DUP
#define PH_DUP 0
#endif
#define LAS __attribute__((address_space(3)))
#define GAS __attribute__((address_space(1)))
typedef unsigned short bf16;
typedef short bf16x8 __attribute__((ext_vector_type(8)));
typedef short s16x4 __attribute__((ext_vector_type(4)));
typedef float f32x2 __attribute__((ext_vector_type(2)));
typedef float f32x4 __attribute__((ext_vector_type(4)));
typedef float f32x16 __attribute__((ext_vector_type(16)));
typedef unsigned u32x2 __attribute__((ext_vector_type(2)));
typedef unsigned u32x4 __attribute__((ext_vector_type(4)));

constexpr int D = 2048, NB = 4, SEQ = 8192, DEPTH = 4, SBATCH = 8, SSEQ = 32;
constexpr int MP = NB * SEQ, MS = SBATCH * SSEQ, MR = MP + MS;
constexpr int NH = 8, HD = 128, MH = 4;
constexpr int NPROJ = 6656, IN_DIM = 6664, FF = 8192;
constexpr int C_XA = 0, C_GB = 512, C_GC = 1024, C_Q = 1536, C_K = 2560, C_V = 3584, C_MQ = 4608, C_MK = 5120, C_MV = 5632, C_MO = 6144;
constexpr int KEEP = 512;
constexpr int SKV_ROWS = 640;
constexpr float EPS = 1e-6f;
constexpr float LOG2E = 1.4426950408889634f;
constexpr int NGRP = SEQ / 256;

constexpr size_t O_YP = 0, O_YS = O_YP + (size_t)MP * D, O_PCONV = O_YS + (size_t)MS * D, O_PK = O_PCONV + (size_t)DEPTH * NB * 2 * 512,
                 O_PV = O_PK + (size_t)DEPTH * NB * KEEP * 1024, O_PC = O_PV + (size_t)DEPTH * NB * KEEP * 1024, O_PN = O_PC + (size_t)DEPTH * NB * MH * HD * HD,
                 O_PM = O_PN + (size_t)DEPTH * NB * MH * HD, O_SCONV = O_PM + (size_t)DEPTH * NB * MH, O_SK = O_SCONV + (size_t)DEPTH * SBATCH * 2 * 512,
                 O_SV = O_SK + (size_t)DEPTH * SBATCH * SSEQ * 1024, O_SC = O_SV + (size_t)DEPTH * SBATCH * SSEQ * 1024, O_SN = O_SC + (size_t)DEPTH * SBATCH * MH * HD * HD,
                 O_SM = O_SN + (size_t)DEPTH * SBATCH * MH * HD, O_END = O_SM + (size_t)DEPTH * SBATCH * MH;

constexpr size_t al256(size_t x) { return (x + 255) / 256 * 256; }
constexpr size_t WS_CTL = 0, CTL_BYTES = 1u << 20;
constexpr size_t WSET = ((size_t)NPROJ * D + (size_t)D * D + (size_t)FF * D + (size_t)D * FF) * 2;
constexpr size_t WS_WIN = CTL_BYTES;
constexpr size_t WS_WOUT = WS_WIN + (size_t)NPROJ * D * 2;
constexpr size_t WS_WUP = WS_WOUT + (size_t)D * D * 2;
constexpr size_t WS_WDN = WS_WUP + (size_t)FF * D * 2;
constexpr size_t WS_H = WS_WIN + 2 * WSET;
constexpr size_t WS_XB = WS_H + (size_t)MR * D * 2;
constexpr size_t WS_BIG = WS_XB + (size_t)MR * D * 2;
constexpr size_t BIG_BYTES = (size_t)MR * FF * 2;
constexpr size_t WS_CLOC = WS_BIG + al256((size_t)MR * NPROJ * 2);
constexpr size_t WS_C0 = WS_CLOC + (size_t)16 * NGRP * HD * HD * 4;
constexpr size_t WS_NLOC = WS_C0 + (size_t)16 * NGRP * HD * HD * 2;
constexpr size_t WS_N0 = WS_NLOC + (size_t)16 * NGRP * HD * 4;
constexpr size_t WS_MSC = WS_N0 + (size_t)16 * NGRP * HD * 4;
constexpr size_t WS_MIX_END = WS_MSC + (size_t)16 * NGRP * 4 * 4;
static_assert(WS_MIX_END <= WS_BIG + BIG_BYTES, "mLSTM scratch fits in the free top of BIG");
constexpr size_t WS_GATE = WS_BIG + BIG_BYTES;
constexpr size_t SKV_IMG = (size_t)SBATCH * SKV_ROWS * 1024 * 2;
constexpr size_t WS_SK = WS_GATE + (size_t)MR * 8 * 4;
constexpr size_t WS_SV = WS_SK + 2 * SKV_IMG;
constexpr size_t WS_RSTD = WS_SV + 2 * SKV_IMG;
constexpr size_t WS_END = WS_RSTD + (size_t)MR * 4;
static_assert(WS_END <= 1235000000ull, "workspace budget");

constexpr int RING_BYTES = 131072;
constexpr int MISC_OFF = RING_BYTES;
constexpr int SCR_OFF = MISC_OFF + 256;
constexpr int LDS_BYTES = 147456;
constexpr int NWAVES = 8, NTHREADS = 512;

__device__ __forceinline__ unsigned cvtpk(float lo, float hi) { unsigned r; asm volatile("v_cvt_pk_bf16_f32 %0, %1, %2" : "=v"(r) : "v"(lo), "v"(hi)); return r; }
__device__ __forceinline__ float bflo(unsigned w) { return __uint_as_float(w << 16); }
__device__ __forceinline__ float bfhi(unsigned w) { return __uint_as_float(w & 0xffff0000u); }
__device__ __forceinline__ float bf2f(bf16 b) { return __uint_as_float(((unsigned)b) << 16); }
__device__ __forceinline__ float shx(float v, int o, int lane) { return __int_as_float(__builtin_amdgcn_ds_bpermute((lane ^ o) << 2, __float_as_int(v))); }
__device__ __forceinline__ float shup(float v, int o, int lane) { const int s = lane - o; return __int_as_float(__builtin_amdgcn_ds_bpermute((s < 0 ? lane : s) << 2, __float_as_int(v))); }
__device__ __forceinline__ float wave_sum(float v, int lane) {
#pragma unroll
    for (int o = 1; o < 64; o <<= 1) v += shx(v, o, lane);
    return v;
}
__device__ __forceinline__ float fast_rsqrt(float x) { return __builtin_amdgcn_rsqf(x); }
__device__ __forceinline__ float fast_exp(float x) { return __builtin_amdgcn_exp2f(x * 1.4426950408889634f); }
__device__ __forceinline__ float fast_log(float x) { return __builtin_amdgcn_logf(x) * 0.6931471805599453f; }
__device__ __forceinline__ float opaque_zero() { float z; asm volatile("v_mov_b32 %0, 0" : "=v"(z)); return z; }
#define LDS_WAIT() asm volatile("s_waitcnt lgkmcnt(0)" ::: "memory")
#define VM_WAIT() asm volatile("s_waitcnt vmcnt(0)" ::: "memory")
#define SBAR() __builtin_amdgcn_sched_barrier(0)

namespace pg8 {
typedef unsigned short bf16_t;
constexpr int BM = 256, BK = 64, HALF = 128, HTB = HALF * BK * 2, STAGE_BYTES = 8 * HTB, NXCD = 8, WGM = 4;
__host__ __device__ __forceinline__ int lds_byte(int r, int c) { const int st = (r >> 4) * 2 + (c >> 5), rr = r & 15, cc = c & 31, ob = rr * 64 + cc * 2; return st * 1024 + (ob ^ (((ob >> 9) & 1) << 5)); }
__host__ __device__ __forceinline__ void stage_rc(int b, int& R, int& C) { const int st = b / 1024, sb = b % 1024, swz = sb ^ (((sb >> 9) & 1) << 5); R = (st >> 1) * 16 + swz / 64; C = (st & 1) * 32 + (swz % 64) / 2; }
__host__ __device__ __forceinline__ int perm32(int rho) { const int n = rho >> 4, i = rho & 15; return 8 * (i >> 2) + 4 * n + (i & 3); }
struct Unit { int pm, pn; };
struct Gemm { const bf16_t* A; const bf16_t* Bt; int M, N, K; };
struct StaticOrder {
    int nM, nN, nwg, G, c, wgm;
    __host__ __device__ void init(int M, int N, int G_, int c_, int wgm_ = WGM) { nM = M / BM; nN = N / BM; nwg = nM * nN; G = G_; c = c_; wgm = wgm_; }
    __host__ __device__ bool next(int i, Unit& u) const {
        const long L = (long)i * G + c; if (L >= nwg) return false;
        int wgid = (int)L; { const int q = nwg / NXCD, r = nwg % NXCD, xcd = wgid % NXCD, off = wgid / NXCD; wgid = (xcd < r ? xcd * (q + 1) : r * (q + 1) + (xcd - r) * q) + off; }
        const int nig = wgm * nN, gid = wgid / nig, fm = gid * wgm, gsz = (nM - fm) < wgm ? (nM - fm) : wgm;
        u.pm = fm + ((wgid % nig) % gsz); u.pn = (wgid % nig) / gsz; return true;
    }
    __device__ __forceinline__ void a_ready(const Unit&) const {}
    __device__ __forceinline__ void done(const Unit&) const {}
};
template <int ACT  > struct EpiBf16 {
    static constexpr bool PERM = true, AFTER_DRAIN = false;
    static constexpr bool RSL = true;
    bf16_t* O; int ldc; const float* rstd; LAS float* T;
    __device__ __forceinline__ void rs_fetch(const Unit& u, int tid, int par) const { if (rstd && tid < BM) (T + 2048 + par * BM)[tid] = rstd[u.pm * BM + tid]; }
    __device__ __forceinline__ void operator()(const f32x4 (&acc)[2][2][4][2], const Unit& u, int wr, int wc, int fr, int fq, int par) const {
        const int row0 = u.pm * BM + wr * 64 + fr; const int col0 = u.pn * BM + wc * 32 + 8 * fq;
#pragma unroll
        for (int ai = 0; ai < 2; ++ai)
#pragma unroll
            for (int m = 0; m < 4; ++m) { bf16_t* rowp = O + (size_t)(row0 + ai * HALF + m * 16) * ldc + col0; const float rsv = rstd ? (T + 2048 + par * BM)[wr * 64 + fr + ai * HALF + m * 16] : 1.0f;
#pragma unroll
                for (int bj = 0; bj < 2; ++bj) { f32x4 v0 = acc[ai][bj][m][0] * rsv, v1 = acc[ai][bj][m][1] * rsv;
                    if (ACT == 1) {
#pragma unroll
                        for (int j = 0; j < 4; ++j) { const float a = fmaxf(v0[j], 0.f), b = fmaxf(v1[j], 0.f); v0[j] = a * a; v1[j] = b * b; } }
                    u32x4 w; w.x = cvtpk(v0[0], v0[1]); w.y = cvtpk(v0[2], v0[3]); w.z = cvtpk(v1[0], v1[1]); w.w = cvtpk(v1[2], v1[3]);
                    *(u32x4*)(rowp + bj * HALF) = w; } }
    }
};
struct EpiProj {
    static constexpr bool PERM = true, AFTER_DRAIN = false;
    static constexpr bool RSL = true;
    bf16_t* O; int ldc; const float* gq; const float* gk; LAS float* T; const float* rstd;
    __device__ __forceinline__ void rs_fetch(const Unit& u, int tid, int par) const { if (tid < BM) (T + 2048 + par * BM)[tid] = rstd[u.pm * BM + tid]; }
    __device__ __forceinline__ void operator()(const f32x4 (&acc)[2][2][4][2], const Unit& u, int wr, int wc, int fr, int fq, int par) const {
        const int row0 = u.pm * BM + wr * 64 + fr; const int col0 = u.pn * BM + wc * 32 + 8 * fq;
        const bool isqk = (u.pn >= 6) && (u.pn < 14);
        float rs[2][4];
#pragma unroll
        for (int ai = 0; ai < 2; ++ai)
#pragma unroll
            for (int m = 0; m < 4; ++m) rs[ai][m] = (T + 2048 + par * BM)[wr * 64 + fr + ai * HALF + m * 16];
        if (!isqk) {
#pragma unroll
            for (int ai = 0; ai < 2; ++ai)
#pragma unroll
                for (int m = 0; m < 4; ++m) { bf16_t* rowp = O + (size_t)(row0 + ai * HALF + m * 16) * ldc + col0;
#pragma unroll
                    for (int bj = 0; bj < 2; ++bj) { const f32x4 v0 = acc[ai][bj][m][0] * rs[ai][m], v1 = acc[ai][bj][m][1] * rs[ai][m];
                        u32x4 w; w.x = cvtpk(v0[0], v0[1]); w.y = cvtpk(v0[2], v0[3]); w.z = cvtpk(v1[0], v1[1]); w.w = cvtpk(v1[2], v1[3]);
                        *(u32x4*)(rowp + bj * HALF) = w; } }
            return;
        }
        const int lane = fr + 16 * fq;
        float ss[2][4][2];
#pragma unroll
        for (int ai = 0; ai < 2; ++ai)
#pragma unroll
            for (int m = 0; m < 4; ++m)
#pragma unroll
                for (int bj = 0; bj < 2; ++bj) { const f32x4 v0 = acc[ai][bj][m][0] * rs[ai][m], v1 = acc[ai][bj][m][1] * rs[ai][m];
                    float s = (v0[0] * v0[0] + v0[1] * v0[1]) + (v0[2] * v0[2] + v0[3] * v0[3]) + (v1[0] * v1[0] + v1[1] * v1[1]) + (v1[2] * v1[2] + v1[3] * v1[3]);
                    s += shx(s, 16, lane); s += shx(s, 32, lane); ss[ai][m][bj] = s; }
        if (fq == 0) {
#pragma unroll
            for (int ai = 0; ai < 2; ++ai)
#pragma unroll
                for (int m = 0; m < 4; ++m)
#pragma unroll
                    for (int bj = 0; bj < 2; ++bj) T[(ai * HALF + wr * 64 + m * 16 + fr) * 8 + bj * 4 + wc] = ss[ai][m][bj];
        }
        asm volatile("s_waitcnt lgkmcnt(0)" ::: "memory"); __builtin_amdgcn_s_barrier(); asm volatile("" ::: "memory");
        const float* gg = ((u.pn < 10) ? gq : gk) + wc * 32 + 8 * fq;
        const f32x4 g0 = *(const f32x4*)gg, g1 = *(const f32x4*)(gg + 4);
#pragma unroll
        for (int ai = 0; ai < 2; ++ai)
#pragma unroll
            for (int m = 0; m < 4; ++m) { bf16_t* rowp = O + (size_t)(row0 + ai * HALF + m * 16) * ldc + col0;
#pragma unroll
                for (int bj = 0; bj < 2; ++bj) { const f32x4 t = *(const LAS f32x4*)(T + (ai * HALF + wr * 64 + m * 16 + fr) * 8 + bj * 4);
                    const float rq = fast_rsqrt(((t[0] + t[1]) + (t[2] + t[3])) * (1.0f / 128.0f) + 1e-6f) * rs[ai][m];
                    const f32x4 v0 = acc[ai][bj][m][0] * rq * g0, v1 = acc[ai][bj][m][1] * rq * g1;
                    u32x4 w; w.x = cvtpk(v0[0], v0[1]); w.y = cvtpk(v0[2], v0[3]); w.z = cvtpk(v1[0], v1[1]); w.w = cvtpk(v1[2], v1[3]);
                    *(u32x4*)(rowp + bj * HALF) = w; } }
    }
};
struct EpiResAdd {
    static constexpr bool RSL = false;
    static constexpr bool PERM = true, AFTER_DRAIN = false;
    bf16_t* XB; float* Y; int ldc; bool fin;
    __device__ __forceinline__ void operator()(const f32x4 (&acc)[2][2][4][2], const Unit& u, int wr, int wc, int fr, int fq, int) const {
        const int row0 = u.pm * BM + wr * 64 + fr, col0 = u.pn * BM + wc * 32 + 8 * fq;
        u32x4 r[2][4][2];
#pragma unroll
        for (int ai = 0; ai < 2; ++ai)
#pragma unroll
            for (int m = 0; m < 4; ++m)
#pragma unroll
                for (int bj = 0; bj < 2; ++bj) r[ai][m][bj] = *(const u32x4*)(XB + (size_t)(row0 + ai * HALF + m * 16) * ldc + col0 + bj * HALF);
#pragma unroll
        for (int ai = 0; ai < 2; ++ai)
#pragma unroll
            for (int m = 0; m < 4; ++m)
#pragma unroll
                for (int bj = 0; bj < 2; ++bj) { const u32x4 w = r[ai][m][bj]; const f32x4 a0 = acc[ai][bj][m][0], a1 = acc[ai][bj][m][1];
                    const f32x4 v0 = (f32x4){bflo(w.x) + a0[0], bfhi(w.x) + a0[1], bflo(w.y) + a0[2], bfhi(w.y) + a0[3]}, v1 = (f32x4){bflo(w.z) + a1[0], bfhi(w.z) + a1[1], bflo(w.w) + a1[2], bfhi(w.w) + a1[3]};
                    const size_t off = (size_t)(row0 + ai * HALF + m * 16) * ldc + col0 + bj * HALF;
                    if (fin) { *(f32x4*)(Y + off) = v0; *(f32x4*)(Y + off + 4) = v1; }
                    else { u32x4 o; o.x = cvtpk(v0[0], v0[1]); o.y = cvtpk(v0[2], v0[3]); o.z = cvtpk(v1[0], v1[1]); o.w = cvtpk(v1[2], v1[3]); *(u32x4*)(XB + off) = o; } }
    }
};

template <class Epi, class Sched, bool ALIGN_EPI = false, bool SP2 = false>
__device__ __forceinline__ void gemm_phase(LAS unsigned char* lds, const Gemm g, const Sched& S, const Epi& E, const int wave_) {
    int ln_; asm volatile("v_mbcnt_lo_u32_b32 %0, -1, 0\n\tv_mbcnt_hi_u32_b32 %0, -1, %0" : "=v"(ln_)); const int tid = wave_ * 64 + ln_;
    const int wid = __builtin_amdgcn_readfirstlane(tid >> 6), lane = tid & 63, wr = wid >> 2, wc = wid & 3, fr = lane & 15, fq = lane >> 4;
    const int K = g.K, nt = K / BK;
    unsigned voffA[2], voffB[2];
#pragma unroll
    for (int i = 0; i < 2; ++i) { int R, C; stage_rc(tid * 16 + i * 8192, R, C); const int Rb = Epi::PERM ? ((R & ~31) + perm32(R & 31)) : R;
        voffA[i] = (unsigned)(R * K + C) * 2u; voffB[i] = (unsigned)(Rb * K + C) * 2u; }
    const size_t kstep = (size_t)(BK * 2);
    const size_t hstep = (size_t)HALF * K * 2;
    const size_t tstep = 2 * hstep;
    const unsigned ldsw = (unsigned)wid * 1024u;
    const int aoff = lds_byte(wr * 64 + fr, fq * 8), boff = lds_byte(wc * 32 + fr, fq * 8);
#define PG8_SA(b, h) (((b) * 2 + (h)) * HTB)
#define PG8_SB(b, h) ((4 + (b) * 2 + (h)) * HTB)
#define PG8_STAGE(bufoff, gbase, voff) do { _Pragma("unroll") for (int _i = 0; _i < 2; ++_i) \
        __builtin_amdgcn_global_load_lds((const unsigned*)((const char*)(gbase) + (voff)[_i]), (LAS unsigned*)(lds + (bufoff) + ldsw + _i * 8192), 16, 0, 0); } while (0)
#define PG8_LDA(dst, b, h) do { _Pragma("unroll") for (int m = 0; m < 4; ++m) _Pragma("unroll") for (int k = 0; k < 2; ++k) dst[m][k] = *(const LAS bf16x8*)(lds + PG8_SA(b, h) + aoff + m * 2048 + k * 1024); } while (0)
#define PG8_LDB(dst, b, h) do { _Pragma("unroll") for (int n = 0; n < 2; ++n) _Pragma("unroll") for (int k = 0; k < 2; ++k) dst[n][k] = *(const LAS bf16x8*)(lds + PG8_SB(b, h) + boff + n * 2048 + k * 1024); } while (0)
#define PG8_MMA(ai, bj, At, Bt) do { __builtin_amdgcn_s_setprio(1); _Pragma("unroll") for (int m = 0; m < 4; ++m) _Pragma("unroll") for (int n = 0; n < 2; ++n) _Pragma("unroll") for (int k = 0; k < 2; ++k) \
        acc[ai][bj][m][n] = __builtin_amdgcn_mfma_f32_16x16x32_bf16(Bt[n][k], At[m][k], acc[ai][bj][m][n], 0, 0, 0); __builtin_amdgcn_s_setprio(0); } while (0)
#define PG8_WAIT_V(n) asm volatile("s_waitcnt vmcnt(" #n ")" ::: "memory")
#define PG8_WAIT_L(n) asm volatile("s_waitcnt lgkmcnt(" #n ")" ::: "memory")
#define PG8_BAR __builtin_amdgcn_s_barrier()
#define PG8_SCHED __builtin_amdgcn_sched_barrier(0)
    Unit cur, nxt; int ui = 0;
    if (!S.next(0, cur)) return;
    f32x4 acc[2][2][4][2];
    { const float z = opaque_zero();
#pragma unroll
    for (int a = 0; a < 2; ++a)
#pragma unroll
        for (int b = 0; b < 2; ++b)
#pragma unroll
            for (int m = 0; m < 4; ++m)
#pragma unroll
                for (int n = 0; n < 2; ++n) acc[a][b][m][n] = (f32x4){z, z, z, z}; }
    bf16x8 At[4][2], B0[2][2], B1[2][2];
    const char* cA = (const char*)g.A + (size_t)cur.pm * tstep; const char* cB = (const char*)g.Bt + (size_t)cur.pn * tstep;
    S.a_ready(cur);
    if constexpr (Epi::RSL) E.rs_fetch(cur, tid, 0);
    if constexpr (SP2) {
        PG8_STAGE(PG8_SB(0, 0), cB, voffB); PG8_STAGE(PG8_SB(0, 1), cB + hstep, voffB); PG8_STAGE(PG8_SA(0, 0), cA, voffA); PG8_STAGE(PG8_SA(0, 1), cA + hstep, voffA);
        if (wr == 1) PG8_BAR;
        PG8_WAIT_V(2); PG8_BAR;
        PG8_STAGE(PG8_SB(1, 0), cB + kstep, voffB); PG8_STAGE(PG8_SA(1, 0), cA + kstep, voffA); PG8_STAGE(PG8_SB(1, 1), cB + hstep + kstep, voffB);
        PG8_WAIT_V(6); PG8_BAR;
    } else {
        PG8_STAGE(PG8_SB(0, 0), cB, voffB); PG8_STAGE(PG8_SA(0, 0), cA, voffA); PG8_STAGE(PG8_SB(0, 1), cB + hstep, voffB); PG8_STAGE(PG8_SA(0, 1), cA + hstep, voffA);
        if (wr == 1) PG8_BAR;
        PG8_WAIT_V(4); PG8_BAR;
        PG8_STAGE(PG8_SB(1, 0), cB + kstep, voffB); PG8_STAGE(PG8_SA(1, 0), cA + kstep, voffA); PG8_STAGE(PG8_SB(1, 1), cB + hstep + kstep, voffB);
        PG8_WAIT_V(6); PG8_BAR;
    }
    for (;;) {
        const bool has_next = S.next(ui + 1, nxt);
        const char* nA = has_next ? (const char*)g.A + (size_t)nxt.pm * tstep : cA; const char* nB = has_next ? (const char*)g.Bt + (size_t)nxt.pn * tstep : cB;
        for (int t = 0; t < nt; t += 2) {
            const bool last = (t == nt - 2);
            const char* a1 = cA + (size_t)(t + 1) * kstep;
            const char* a2 = last ? nA : cA + (size_t)(t + 2) * kstep; const char* b2 = last ? nB : cB + (size_t)(t + 2) * kstep;
            const char* a3 = a2 + kstep; const char* b3 = b2 + kstep;
            if (last && has_next) S.a_ready(nxt);
            if constexpr (SP2) {
            PG8_LDB(B0, 0, 0); PG8_LDB(B1, 0, 1); PG8_SCHED; PG8_LDA(At, 0, 0); PG8_STAGE(PG8_SA(1, 1), a1 + hstep, voffA);
            PG8_WAIT_V(8); PG8_WAIT_L(0); PG8_BAR; PG8_MMA(0, 0, At, B0); PG8_MMA(0, 1, At, B1); PG8_BAR; PG8_SCHED;
            PG8_LDA(At, 0, 1); PG8_STAGE(PG8_SB(0, 0), b2, voffB); PG8_STAGE(PG8_SB(0, 1), b2 + hstep, voffB); PG8_STAGE(PG8_SA(0, 0), a2, voffA);
            PG8_WAIT_V(8); PG8_WAIT_L(0); PG8_BAR; PG8_MMA(1, 0, At, B0); PG8_MMA(1, 1, At, B1); PG8_BAR; PG8_SCHED;
            PG8_LDB(B0, 1, 0); PG8_LDB(B1, 1, 1); PG8_SCHED; PG8_LDA(At, 1, 0); PG8_STAGE(PG8_SA(0, 1), a2 + hstep, voffA);
            PG8_WAIT_V(8); PG8_WAIT_L(0); PG8_BAR; PG8_MMA(0, 0, At, B0); PG8_MMA(0, 1, At, B1); PG8_BAR; PG8_SCHED;
            PG8_LDA(At, 1, 1); PG8_STAGE(PG8_SB(1, 0), b3, voffB); PG8_STAGE(PG8_SB(1, 1), b3 + hstep, voffB); PG8_STAGE(PG8_SA(1, 0), a3, voffA);
            PG8_WAIT_V(8); PG8_WAIT_L(0); PG8_BAR; PG8_MMA(1, 0, At, B0); PG8_MMA(1, 1, At, B1); PG8_BAR; PG8_SCHED;
            } else {
            PG8_LDB(B0, 0, 0); PG8_SCHED; PG8_LDA(At, 0, 0); PG8_STAGE(PG8_SA(1, 1), a1 + hstep, voffA);
            PG8_WAIT_L(8); PG8_BAR; PG8_WAIT_L(0); PG8_MMA(0, 0, At, B0); PG8_BAR; PG8_SCHED;
            PG8_LDB(B1, 0, 1); PG8_STAGE(PG8_SB(0, 0), b2, voffB);
            PG8_BAR; PG8_WAIT_L(0); PG8_MMA(0, 1, At, B1); PG8_BAR;
            PG8_LDA(At, 0, 1); PG8_STAGE(PG8_SA(0, 0), a2, voffA);
            PG8_BAR; PG8_WAIT_L(0); PG8_MMA(1, 0, At, B0); PG8_BAR; PG8_SCHED;
            PG8_STAGE(PG8_SB(0, 1), b2 + hstep, voffB);
            PG8_WAIT_V(6); PG8_BAR; PG8_MMA(1, 1, At, B1); PG8_BAR;
            PG8_LDB(B0, 1, 0); PG8_SCHED; PG8_LDA(At, 1, 0); PG8_STAGE(PG8_SA(0, 1), a2 + hstep, voffA);
            PG8_WAIT_L(8); PG8_BAR; PG8_WAIT_L(0); PG8_MMA(0, 0, At, B0); PG8_BAR; PG8_SCHED;
            PG8_LDB(B1, 1, 1); PG8_STAGE(PG8_SB(1, 0), b3, voffB);
            PG8_BAR; PG8_WAIT_L(0); PG8_MMA(0, 1, At, B1); PG8_BAR;
            PG8_LDA(At, 1, 1); PG8_STAGE(PG8_SA(1, 0), a3, voffA);
            PG8_BAR; PG8_WAIT_L(0); PG8_MMA(1, 0, At, B0); PG8_BAR; PG8_SCHED;
            PG8_STAGE(PG8_SB(1, 1), b3 + hstep, voffB);
            PG8_WAIT_V(6); PG8_BAR; PG8_MMA(1, 1, At, B1); PG8_BAR;
            }
        }
        if constexpr (ALIGN_EPI) { if (wr == 0) PG8_BAR; }
        if constexpr (!Epi::AFTER_DRAIN) { E(acc, cur, wr, wc, fr, fq, ui & 1); S.done(cur); if constexpr (Epi::RSL) { if (has_next) E.rs_fetch(nxt, tid, (ui + 1) & 1); } }
        if (!has_next) break;
        { const float z = opaque_zero();
#pragma unroll
        for (int a = 0; a < 2; ++a)
#pragma unroll
            for (int b = 0; b < 2; ++b)
#pragma unroll
                for (int m = 0; m < 4; ++m)
#pragma unroll
                    for (int n = 0; n < 2; ++n) acc[a][b][m][n] = (f32x4){z, z, z, z}; }
        cur = nxt; cA = nA; cB = nB; ++ui;
        if constexpr (ALIGN_EPI) { if (wr == 1) PG8_BAR; }
    }
    PG8_WAIT_V(0);
    if constexpr (!ALIGN_EPI) { if (wr == 0) PG8_BAR; }
    PG8_BAR;
#undef PG8_SA
#undef PG8_SB
#undef PG8_STAGE
#undef PG8_LDA
#undef PG8_LDB
#undef PG8_MMA
#undef PG8_WAIT_V
#undef PG8_WAIT_L
#undef PG8_BAR
#undef PG8_SCHED
}
}

struct SEpiBf16 { bf16* O; int ldc; int act; const float* rstd;
    __device__ __forceinline__ void operator()(int row, int col, f32x4 s0, f32x4 s1) const {
        { const float r_ = rstd[row]; s0 = s0 * r_; s1 = s1 * r_; }
        if (act) {
#pragma unroll
            for (int j = 0; j < 4; ++j) { const float a = fmaxf(s0[j], 0.f), b = fmaxf(s1[j], 0.f); s0[j] = a * a; s1[j] = b * b; } }
        u32x4 w; w.x = cvtpk(s0[0], s0[1]); w.y = cvtpk(s0[2], s0[3]); w.z = cvtpk(s1[0], s1[1]); w.w = cvtpk(s1[2], s1[3]);
        *(u32x4*)(O + (size_t)row * ldc + col) = w; } };
struct SEpiResAdd { bf16* XB; float* Y; int ldc; bool fin;
    __device__ __forceinline__ void operator()(int row, int col, f32x4 s0, f32x4 s1) const {
        const size_t off = (size_t)row * ldc + col; const u32x4 w = *(const u32x4*)(XB + off);
        const f32x4 v0 = (f32x4){bflo(w.x) + s0[0], bfhi(w.x) + s0[1], bflo(w.y) + s0[2], bfhi(w.y) + s0[3]}, v1 = (f32x4){bflo(w.z) + s1[0], bfhi(w.z) + s1[1], bflo(w.w) + s1[2], bfhi(w.w) + s1[3]};
        if (fin) { *(f32x4*)(Y + off) = v0; *(f32x4*)(Y + off + 4) = v1; }
        else { u32x4 o; o.x = cvtpk(v0[0], v0[1]); o.y = cvtpk(v0[2], v0[3]); o.z = cvtpk(v1[0], v1[1]); o.w = cvtpk(v1[2], v1[3]); *(u32x4*)(XB + off) = o; } } };
template <class Epi, int MR = 64>
__device__ __forceinline__ void sample_gemm(LAS unsigned char* lds, int wave, int vcu, int G, const bf16* __restrict__ A, const bf16* __restrict__ Bt, int N, int K, const Epi& E) {
    int ln_; asm volatile("v_mbcnt_lo_u32_b32 %0, -1, 0\n\tv_mbcnt_hi_u32_b32 %0, -1, %0" : "=v"(ln_)); const int tid = wave * 64 + ln_;
    const int lane = tid & 63, fr = lane & 15, fq = lane >> 4;
    constexpr int MB = MR / 16, NRT = 256 / MR;
    const int ntiles = NRT * (N >> 6), kslice = K >> 3, kb = wave * kslice;
    LAS float* red = (LAS float*)lds;
    for (int t = vcu; t < ntiles; t += G) {
        const int rt = t % NRT, ct = t / NRT;
        f32x4 acc[MB][4];
        { const float z = opaque_zero();
#pragma unroll
          for (int m = 0; m < MB; ++m)
#pragma unroll
              for (int n = 0; n < 4; ++n) acc[m][n] = (f32x4){z, z, z, z}; }
        const bf16* ap = A + (size_t)(rt * MR + fr) * K + kb + 8 * fq;
        const bf16* bp = Bt + (size_t)(ct * 64 + fr) * K + kb + 8 * fq;
        const size_t r16 = (size_t)16 * K;
#pragma unroll 4
        for (int k = 0; k < kslice; k += 64) {
            bf16x8 a0[MB], a1[MB], b0[4], b1[4];
#pragma unroll
            for (int m = 0; m < MB; ++m) { a0[m] = *(const bf16x8*)(ap + m * r16 + k); a1[m] = *(const bf16x8*)(ap + m * r16 + k + 32); }
#pragma unroll
            for (int n = 0; n < 4; ++n) { b0[n] = *(const bf16x8*)(bp + n * r16 + k); b1[n] = *(const bf16x8*)(bp + n * r16 + k + 32); }
#pragma unroll
            for (int m = 0; m < MB; ++m)
#pragma unroll
                for (int n = 0; n < 4; ++n) { acc[m][n] = __builtin_amdgcn_mfma_f32_16x16x32_bf16(a0[m], b0[n], acc[m][n], 0, 0, 0);
                                              acc[m][n] = __builtin_amdgcn_mfma_f32_16x16x32_bf16(a1[m], b1[n], acc[m][n], 0, 0, 0); }
        }
        __syncthreads();
#pragma unroll
        for (int m = 0; m < MB; ++m)
#pragma unroll
            for (int n = 0; n < 4; ++n)
#pragma unroll
                for (int j = 0; j < 4; ++j) red[wave * (MR * 64) + (16 * m + 4 * fq + j) * 64 + 16 * n + fr] = acc[m][n][j];
        __syncthreads();
        if (tid < MR * 8) {
            const int row = tid >> 3, col = (tid & 7) * 8;
            f32x4 s0 = *(const LAS f32x4*)(red + row * 64 + col), s1 = *(const LAS f32x4*)(red + row * 64 + col + 4);
#pragma unroll
            for (int w = 1; w < 8; ++w) { s0 = s0 + *(const LAS f32x4*)(red + w * (MR * 64) + row * 64 + col); s1 = s1 + *(const LAS f32x4*)(red + w * (MR * 64) + row * 64 + col + 4); }
            E(rt * MR + row, ct * 64 + col, s0, s1);
        }
    }
    __syncthreads();
}

#define XB_TMO      128
#define XB_XCNT(j)  (256  + 64 * (j))
#define XB_XSUB(j)  (1280 + 64 * (j))
#define XB_XGEN(j)  (2304 + 64 * (j))
#define XB_TOP      3328
#define XB_TOPGEN   3392
#define XCD_BAR_WORDS 3456
#define XB_SPIN_CAP (1u << 18)
__device__ __forceinline__ unsigned xb_ld(unsigned* p)              { return __hip_atomic_load(p, __ATOMIC_RELAXED, __HIP_MEMORY_SCOPE_AGENT); }
__device__ __forceinline__ unsigned xb_add(unsigned* p, unsigned v) { return __hip_atomic_fetch_add(p, v, __ATOMIC_RELAXED, __HIP_MEMORY_SCOPE_AGENT); }
__device__ __forceinline__ unsigned xb_xcc_id() { return (unsigned)__builtin_amdgcn_s_getreg((3 << 11) | 20) & 0xFu; }
#define XB_SPIN(cond, bar) do { unsigned _sp = 0; while (cond) { __builtin_amdgcn_s_sleep(1); \
    if ((++_sp & 255u) == 0u) { if (xb_ld(&(bar)[XB_TMO])) break; if (_sp > XB_SPIN_CAP) { atomicAdd(&(bar)[XB_TMO], 1u); break; } } } } while (0)
struct XcdBarrier { unsigned* bar; unsigned x; volatile LAS unsigned* st; };
__device__ __forceinline__ XcdBarrier xcd_barrier_post(unsigned* bar, volatile LAS unsigned* st, bool leader) {
    XcdBarrier b; b.bar = bar; b.x = xb_xcc_id(); b.st = st;
    if (leader) (void)xb_add(&bar[XB_XCNT(b.x)], 1u);
    return b;
}
__device__ __forceinline__ void xcd_barrier_complete(unsigned* bar, unsigned x, unsigned& nloc, unsigned& nx) {
    const unsigned G = gridDim.x * gridDim.y * gridDim.z;
    unsigned sum, cnt, mine, sp = 0u;
    for (;;) {
        sum = 0u; cnt = 0u; mine = 0u;
#pragma unroll
        for (unsigned j = 0; j < 16; ++j) { const unsigned c = xb_ld(&bar[XB_XCNT(j)]); sum += c; cnt += (c > 0u) ? 1u : 0u; mine = (j == x) ? c : mine; }
        if (sum == G) break;
        __builtin_amdgcn_s_sleep(1);
        if ((++sp & 255u) == 0u) { if (xb_ld(&bar[XB_TMO])) break; if (sp > XB_SPIN_CAP) { atomicAdd(&bar[XB_TMO], 1u); break; } }
    }
    nloc = mine > 0u ? mine : 1u; nx = cnt > 0u ? cnt : 1u;
}
__device__ __noinline__ void xcd_barrier(unsigned* bar_, unsigned x_, volatile LAS unsigned* st_, int wave_) {
    XcdBarrier b; b.bar = bar_; b.x = x_; b.st = st_;
    int ln_; asm volatile("v_mbcnt_lo_u32_b32 %0, -1, 0\n\tv_mbcnt_hi_u32_b32 %0, -1, %0" : "=v"(ln_)); const bool leader_ = (wave_ == 0) && (ln_ == 0);
    asm volatile("s_waitcnt vmcnt(0)" ::: "memory");
    __syncthreads();
    if (leader_) {
        unsigned* bar = b.bar;
        __builtin_amdgcn_s_waitcnt(0);
        unsigned nloc = b.st[0], nx = b.st[1];
        if (nloc == 0u) { xcd_barrier_complete(bar, b.x, nloc, nx); b.st[0] = nloc; b.st[1] = nx; }
        const unsigned old = xb_add(&bar[XB_XSUB(b.x)], 1u);
        const unsigned gen = old / nloc;
        if (old + 1u == (gen + 1u) * nloc) {
            __builtin_amdgcn_fence(__ATOMIC_RELEASE, "agent");
            asm volatile("s_waitcnt vmcnt(0)" ::: "memory");
            const unsigned og = xb_add(&bar[XB_TOP], 1u);
            const unsigned tg = og / nx;
            if (og + 1u == (tg + 1u) * nx) xb_add(&bar[XB_TOPGEN], 1u);
            else XB_SPIN(xb_ld(&bar[XB_TOPGEN]) == tg, bar);
            __builtin_amdgcn_fence(__ATOMIC_ACQUIRE, "agent");
            xb_add(&bar[XB_XGEN(b.x)], 1u);
            asm volatile("s_waitcnt vmcnt(0)" ::: "memory");
        } else {
            XB_SPIN(xb_ld(&bar[XB_XGEN(b.x)]) == gen, bar);
            __builtin_amdgcn_fence(__ATOMIC_ACQUIRE, "agent");
            asm volatile("s_waitcnt vmcnt(0)" ::: "memory");
        }
    }
    __syncthreads();
}

#define KSWZ(row, colB) ((row) * 256 + ((colB) ^ (((row) & 7) << 4)))
__device__ __forceinline__ int crow(int r, int hi) { return (r & 3) + 8 * (r >> 2) + 4 * hi; }
__device__ __forceinline__ int v_st(int k, int c) { const int kk = (k & ~0xC) | ((k & 4) << 1) | ((k & 8) >> 1); return ((kk >> 3) * 4 + (c >> 5)) * 512 + ((kk & 7) * 32 + (c & 31)) * 2; }
__device__ __forceinline__ int v_rd_base(int lane) { return ((lane & 3) << 3) | (((lane >> 2) & 3) << 6) | (((lane >> 4) & 1) << 5) | (((lane >> 5) & 1) << 8); }
constexpr int v_rd_off(int d0, int ks, int half) { return d0 * 512 + ks * 4096 + half * 2048; }
template <int OFF> __device__ __forceinline__ s16x4 tr_read(int vb) {
    s16x4 r; asm volatile("ds_read_b64_tr_b16 %0, %1 offset:%2" : "=&v"(r) : "v"(vb), "i"(OFF) : "memory"); return r;
}
#define PKLH(L, H) (bf16x8){L[0], L[1], L[2], L[3], H[0], H[1], H[2], H[3]}
template <int D0> __device__ __forceinline__ void pv_one(f32x16& od, int vb, bf16x8 pa0, bf16x8 pa1, bf16x8 pa2, bf16x8 pa3) {
    const s16x4 l0 = tr_read<v_rd_off(D0, 0, 0)>(vb), h0 = tr_read<v_rd_off(D0, 0, 1)>(vb), l1 = tr_read<v_rd_off(D0, 1, 0)>(vb), h1 = tr_read<v_rd_off(D0, 1, 1)>(vb);
    const s16x4 l2 = tr_read<v_rd_off(D0, 2, 0)>(vb), h2 = tr_read<v_rd_off(D0, 2, 1)>(vb), l3 = tr_read<v_rd_off(D0, 3, 0)>(vb), h3 = tr_read<v_rd_off(D0, 3, 1)>(vb);
    asm volatile("s_waitcnt lgkmcnt(0)" ::: "memory"); SBAR();
    od = __builtin_amdgcn_mfma_f32_32x32x16_bf16(pa0, PKLH(l0, h0), od, 0, 0, 0);
    od = __builtin_amdgcn_mfma_f32_32x32x16_bf16(pa1, PKLH(l1, h1), od, 0, 0, 0);
    od = __builtin_amdgcn_mfma_f32_32x32x16_bf16(pa2, PKLH(l2, h2), od, 0, 0, 0);
    od = __builtin_amdgcn_mfma_f32_32x32x16_bf16(pa3, PKLH(l3, h3), od, 0, 0, 0);
}
__device__ __forceinline__ void pv_d0(f32x16* o, int vb, bf16x8 pa0, bf16x8 pa1, bf16x8 pa2, bf16x8 pa3) {
    pv_one<0>(o[0], vb, pa0, pa1, pa2, pa3); pv_one<1>(o[1], vb, pa0, pa1, pa2, pa3); pv_one<2>(o[2], vb, pa0, pa1, pa2, pa3); pv_one<3>(o[3], vb, pa0, pa1, pa2, pa3);
}
template <int D0, int KS> __device__ __forceinline__ bf16x8 tr_frag(int vb) {
    const s16x4 l = tr_read<v_rd_off(D0, KS, 0)>(vb), h = tr_read<v_rd_off(D0, KS, 1)>(vb);
    return PKLH(l, h);
}
__device__ __forceinline__ void qkt(f32x16& p0, f32x16& p1, int Ks  , const bf16x8* qr, int r32, int hi) {
    p0 = f32x16{}; p1 = f32x16{};
#pragma unroll
    for (int d0 = 0; d0 < 8; ++d0) { const int cb = (d0 * 16 + hi * 8) * 2;
        const bf16x8 b0 = *(const LAS bf16x8*)(uintptr_t)(unsigned)(Ks + KSWZ(r32, cb));
        const bf16x8 b1 = *(const LAS bf16x8*)(uintptr_t)(unsigned)(Ks + KSWZ(32 + r32, cb));
        p0 = __builtin_amdgcn_mfma_f32_32x32x16_bf16(b0, qr[d0], p0, 0, 0, 0);
        p1 = __builtin_amdgcn_mfma_f32_32x32x16_bf16(b1, qr[d0], p1, 0, 0, 0); }
}
#define QK_RD(d0_, A_, B_) do { const int cb_ = ((d0_) * 16 + hi * 8) * 2; A_ = *(const LAS bf16x8*)(uintptr_t)(unsigned)(Ks + KSWZ(r32, cb_)); B_ = *(const LAS bf16x8*)(uintptr_t)(unsigned)(Ks + KSWZ(32 + r32, cb_)); } while (0)
#define QK_MM(d0_, A_, B_) do { p0 = __builtin_amdgcn_mfma_f32_32x32x16_bf16(A_, qr[d0_], p0, 0, 0, 0); p1 = __builtin_amdgcn_mfma_f32_32x32x16_bf16(B_, qr[d0_], p1, 0, 0, 0); } while (0)
#define QK_WAIT(n_) do { SBAR(); asm volatile("s_waitcnt lgkmcnt(" #n_ ")" ::: "memory"); SBAR(); } while (0)
__device__ __forceinline__ void qkt_b(f32x16& p0, f32x16& p1, int Ks  , const bf16x8* qr, int r32, int hi) {
    p0 = f32x16{}; p1 = f32x16{};
    bf16x8 a0, b0, a1, b1, a2, b2, a3, b3, a4, b4, a5, b5;
    QK_RD(0, a0, b0); QK_RD(1, a1, b1); QK_RD(2, a2, b2); QK_RD(3, a3, b3);
    QK_WAIT(4); QK_MM(0, a0, b0); QK_MM(1, a1, b1);
    QK_RD(4, a4, b4); QK_RD(5, a5, b5);
    QK_WAIT(4); QK_MM(2, a2, b2); QK_MM(3, a3, b3);
    QK_RD(6, a0, b0); QK_RD(7, a1, b1);
    QK_WAIT(4); QK_MM(4, a4, b4); QK_MM(5, a5, b5);
    QK_WAIT(0); QK_MM(6, a0, b0); QK_MM(7, a1, b1);
}
#undef QK_RD
#undef QK_MM
#undef QK_WAIT
#define PK4(P, BASE, OUT) do { unsigned a0 = cvtpk(P[BASE + 0], P[BASE + 1]), a1 = cvtpk(P[BASE + 2], P[BASE + 3]);   \
    unsigned b0 = cvtpk(P[BASE + 4], P[BASE + 5]), b1 = cvtpk(P[BASE + 6], P[BASE + 7]);                              \
    auto r0 = __builtin_amdgcn_permlane32_swap(a0, b0, false, false); auto r1 = __builtin_amdgcn_permlane32_swap(a1, b1, false, false); \
    u32x4 w = {r0[0], r1[0], r0[1], r1[1]}; OUT = *reinterpret_cast<bf16x8*>(&w); } while (0)
__device__ __forceinline__ float half_swap_add(float v) { auto rr = __builtin_amdgcn_permlane32_swap(__float_as_uint(v), __float_as_uint(v), false, false); return __uint_as_float(rr[0]) + __uint_as_float(rr[1]); }
__device__ __forceinline__ float half_swap_max(float v) { auto rr = __builtin_amdgcn_permlane32_swap(__float_as_uint(v), __float_as_uint(v), false, false); return fmaxf(__uint_as_float(rr[0]), __uint_as_float(rr[1])); }

struct Args {
    const float* x_prompt; const float* x_sample; const float* cache_k; const float* cache_v; const float* state_conv; const float* state_c; const float* state_n; const float* state_m;
    const float* norm_mix_g; const float* w_in; const float* conv_w; const float* q_norm_g; const float* k_norm_g; const float* rel_bias; const float* b_igate; const float* b_fgate;
    const float* mlstm_norm_g; const float* w_out; const float* norm_mlp_g; const float* w_up; const float* w_down;
    float* out; unsigned char* ws; int ph_lo, ph_hi, rep, pad;
};
struct Ctx {
    LAS unsigned char* lds; int tid, lane, wave, G, vcu;
};
constexpr int NPH_LAYER = 9, NPHASES = DEPTH * NPH_LAYER;
__device__ __forceinline__ int hw_tid(int wave) { int ln; asm volatile("v_mbcnt_lo_u32_b32 %0, -1, 0\n\tv_mbcnt_hi_u32_b32 %0, -1, %0" : "=v"(ln)); return wave * 64 + ln; }
__device__ __forceinline__ Ctx relaunder(const Ctx& c) { Ctx d = c; const int t = hw_tid(c.wave); d.tid = t; d.lane = t & 63; return d; }

__device__ __forceinline__ void transpose_item(const float* W, int K, int ldn, int nblk, bf16* WT, LAS float* scr, int item, int lane, const float* gain = nullptr) {
    const int kb = item / nblk, nb = item % nblk, k0 = 64 * kb, n0 = 32 * nb;
    const int c = lane & 7;
    f32x4 g0 = (f32x4){1.f, 1.f, 1.f, 1.f}, g1 = g0;
    if (gain) { g0 = *(const f32x4*)(gain + k0 + 8 * c); g1 = *(const f32x4*)(gain + k0 + 8 * c + 4); }
#pragma unroll 8
    for (int i = 0; i < 32; ++i) { const int kk = 2 * i + (lane >> 5); scr[kk * 33 + (lane & 31)] = W[(size_t)(k0 + kk) * ldn + n0 + (lane & 31)]; }
    LDS_WAIT(); asm volatile("" ::: "memory");
#pragma unroll
    for (int j = 0; j < 4; ++j) { const int n = (lane >> 3) + 8 * j; const LAS float* s = scr + (8 * c) * 33 + n;
        u32x4 o; o.x = cvtpk(s[0 * 33] * g0[0], s[1 * 33] * g0[1]); o.y = cvtpk(s[2 * 33] * g0[2], s[3 * 33] * g0[3]); o.z = cvtpk(s[4 * 33] * g1[0], s[5 * 33] * g1[1]); o.w = cvtpk(s[6 * 33] * g1[2], s[7 * 33] * g1[3]);
        *(GAS u32x4*)(WT + (size_t)(n0 + n) * K + k0 + 8 * c) = o; }
    LDS_WAIT(); asm volatile("" ::: "memory");
}
__device__ __forceinline__ void convert_weights(const Args& a, const Ctx& c, int l) {
    LAS float* scr = (LAS float*)(c.lds + c.wave * 16384);
    const size_t wo = (size_t)(l & 1) * WSET;
    const int gw = c.vcu * NWAVES + c.wave, NGW = c.G * NWAVES;
    constexpr int I_IN = (D / 64) * (NPROJ / 32), I_OUT = (D / 64) * (D / 32), I_UP = (D / 64) * (FF / 32), I_DN = (FF / 64) * (D / 32), I_L = I_IN + I_OUT + I_UP + I_DN;
    for (int it = gw; it < I_L; it += NGW) {
        int r = it;
        if (r < I_IN) { transpose_item(a.w_in + (size_t)l * D * IN_DIM, D, IN_DIM, NPROJ / 32, (bf16*)(a.ws + WS_WIN + wo), scr, r, c.lane, a.norm_mix_g + (size_t)l * D); continue; } r -= I_IN;
        if (r < I_OUT) { transpose_item(a.w_out + (size_t)l * D * D, D, D, D / 32, (bf16*)(a.ws + WS_WOUT + wo), scr, r, c.lane); continue; } r -= I_OUT;
        if (r < I_UP) { transpose_item(a.w_up + (size_t)l * D * FF, D, FF, FF / 32, (bf16*)(a.ws + WS_WUP + wo), scr, r, c.lane, a.norm_mlp_g + (size_t)l * D); continue; } r -= I_UP;
        transpose_item(a.w_down + (size_t)l * FF * D, FF, D, D / 32, (bf16*)(a.ws + WS_WDN + wo), scr, r, c.lane);
    }
}
struct ConvJob { const float* w_in; const float* w_out; const float* w_up; const float* w_down; const float* g_mix; const float* g_mlp; unsigned char* ws; int l, gw, ngw; };
constexpr int CV_I_IN = (D / 64) * (NPROJ / 32), CV_I_OUT = (D / 64) * (D / 32), CV_I_UP = (D / 64) * (FF / 32), CV_I_DN = (FF / 64) * (D / 32), CV_I_L = CV_I_IN + CV_I_OUT + CV_I_UP + CV_I_DN;
struct ConvItem { const float* W; bf16* WT; int gsel; int K, ldn, nblk, r; };
constexpr int GT0_OFF = 116736, GT1_OFF = SCR_OFF + 2048;
__device__ __forceinline__ ConvItem conv_item(const ConvJob& j, int it) {
    const int l = j.l; const size_t wo = (size_t)(l & 1) * WSET; int r = it; ConvItem x;
    if (r < CV_I_IN) { x = ConvItem{j.w_in + (size_t)l * D * IN_DIM, (bf16*)(j.ws + WS_WIN + wo), 1, D, IN_DIM, NPROJ / 32, r}; return x; } r -= CV_I_IN;
    if (r < CV_I_OUT) { x = ConvItem{j.w_out + (size_t)l * D * D, (bf16*)(j.ws + WS_WOUT + wo), 0, D, D, D / 32, r}; return x; } r -= CV_I_OUT;
    if (r < CV_I_UP) { x = ConvItem{j.w_up + (size_t)l * D * FF, (bf16*)(j.ws + WS_WUP + wo), 2, D, FF, FF / 32, r}; return x; } r -= CV_I_UP;
    x = ConvItem{j.w_down + (size_t)l * FF * D, (bf16*)(j.ws + WS_WDN + wo), 0, FF, D, D / 32, r}; return x;
}
__device__ __forceinline__ void conv_load(const ConvJob& j, int it, int lane, float (&v)[32]) {
    const ConvItem x = conv_item(j, it);
    const int kb = x.r / x.nblk, nb = x.r % x.nblk;
    const float* base = x.W + (size_t)(64 * kb) * x.ldn + 32 * nb;
    const unsigned off = (unsigned)((32 * (lane >> 5)) * x.ldn + (lane & 31));
#pragma unroll
    for (int i = 0; i < 32; ++i) v[i] = (base + (size_t)i * x.ldn)[off];
}
__device__ __forceinline__ void conv_finish(const ConvJob& j, int it, int lane, float (&v)[32], LAS unsigned char* lds) {
    const ConvItem x = conv_item(j, it);
    const int kb = x.r / x.nblk, nb = x.r % x.nblk, k0 = 64 * kb + 32 * (lane >> 5), n = 32 * nb + (lane & 31);
    if (x.gsel) { const LAS float* gp = (const LAS float*)(lds + (x.gsel == 1 ? GT0_OFF : GT1_OFF)) + k0;
#pragma unroll
        for (int q = 0; q < 8; ++q) { const f32x4 g = *(const LAS f32x4*)(gp + 4 * q); v[4 * q] *= g[0]; v[4 * q + 1] *= g[1]; v[4 * q + 2] *= g[2]; v[4 * q + 3] *= g[3]; } }
#pragma unroll
    for (int q = 0; q < 4; ++q) { u32x4 o; o.x = cvtpk(v[8 * q], v[8 * q + 1]); o.y = cvtpk(v[8 * q + 2], v[8 * q + 3]); o.z = cvtpk(v[8 * q + 4], v[8 * q + 5]); o.w = cvtpk(v[8 * q + 6], v[8 * q + 7]);
        *(u32x4*)(x.WT + (size_t)n * x.K + k0 + 8 * q) = o; }
}
__device__ __forceinline__ bool conv_step(const ConvJob& j, int& k, int lane, LAS unsigned char* lds) {
    const int it = j.gw + k * j.ngw; if (it >= CV_I_L) return false;
    ++k; float v[32]; conv_load(j, it, lane, v); conv_finish(j, it, lane, v, lds); return true;
}

__device__ __forceinline__ void build_kv_image(const Args& a, int w, int nw, int tid, int l) {
    bf16* SK = (bf16*)(a.ws + WS_SK + (size_t)(l & 1) * SKV_IMG); bf16* SV = (bf16*)(a.ws + WS_SV + (size_t)(l & 1) * SKV_IMG);
    const unsigned gt = (unsigned)w * NTHREADS + tid, NT = (unsigned)nw * NTHREADS;
    constexpr unsigned NCH = (unsigned)SBATCH * 512 * 1024 / 8;
    for (unsigned i = gt; i < 2 * NCH; i += NT) {
        const bool isv = i >= NCH; const unsigned j = isv ? i - NCH : i; const unsigned e = j * 8; const unsigned b = e / (512 * 1024); const unsigned rem = e % (512 * 1024);
        const float* src = (isv ? a.cache_v : a.cache_k) + ((size_t)(l * SBATCH + b) * 512 * 1024) + rem;
        const f32x4 x0 = *(const f32x4*)src, x1 = *(const f32x4*)(src + 4);
        u32x4 w4; w4.x = cvtpk(x0.x, x0.y); w4.y = cvtpk(x0.z, x0.w); w4.z = cvtpk(x1.x, x1.y); w4.w = cvtpk(x1.z, x1.w);
        *(u32x4*)((isv ? SV : SK) + (size_t)b * SKV_ROWS * 1024 + rem) = w4;
    }
    constexpr unsigned NZ = (unsigned)SBATCH * (SKV_ROWS - 544) * 1024 / 8;
    for (unsigned i = gt; i < 2 * NZ; i += NT) {
        const bool isv = i >= NZ; const unsigned j = isv ? i - NZ : i; const unsigned e = j * 8; const unsigned b = e / ((SKV_ROWS - 544) * 1024); const unsigned rem = e % ((SKV_ROWS - 544) * 1024);
        { const unsigned z = __float_as_uint(opaque_zero()); *(u32x4*)((isv ? SV : SK) + ((size_t)b * SKV_ROWS + 544) * 1024 + rem) = (u32x4){z, z, z, z}; }
    }
}
__device__ __forceinline__ float log_sigmoid(float x) { return fminf(x, 0.f) - fast_log(1.0f + fast_exp(-fabsf(x))); }
template <bool FIRST  >
__device__ __forceinline__ void phase_norm(const Args& a, const Ctx& c_in0, int l) {
    const Ctx c = relaunder(c_in0);
    bf16* XB = (bf16*)(a.ws + WS_XB); bf16* H = (bf16*)(a.ws + WS_H);
    const float* g = (FIRST ? a.norm_mix_g : a.norm_mlp_g) + (size_t)l * D;
    LAS float* Wg = (LAS float*)c.lds;
    if (FIRST) {
        if (l == 0) { convert_weights(a, c, 0); __syncthreads(); }
        const float* wsrc = a.w_in + (size_t)l * D * IN_DIM + NPROJ;
        for (int idx = c.tid; idx < 8 * D; idx += NTHREADS) { const int k = idx >> 3, o = idx & 7; Wg[o * D + k] = wsrc[(size_t)k * IN_DIM + o]; }
        __syncthreads();
    }
    const int gw = c.vcu * NWAVES + c.wave, NGW = c.G * NWAVES;
    f32x4 gv[8];
#pragma unroll
    for (int j = 0; j < 8; ++j) gv[j] = *(const f32x4*)(g + 4 * c.lane + 256 * j);
    for (int row = gw; row < MR; row += NGW) {
        f32x4 v[8]; float s = 0.f;
        if (FIRST && l == 0) {
            const float* src = row < MP ? a.x_prompt + (size_t)row * D : a.x_sample + (size_t)(row - MP) * D;
#pragma unroll
            for (int j = 0; j < 8; ++j) v[j] = *(const f32x4*)(src + 4 * c.lane + 256 * j);
#pragma unroll
            for (int j = 0; j < 8; ++j) { u32x2 w; w.x = cvtpk(v[j].x, v[j].y); w.y = cvtpk(v[j].z, v[j].w); *(u32x2*)(XB + (size_t)row * D + 4 * c.lane + 256 * j) = w; }
        } else {
            u32x2 w[8];
#pragma unroll
            for (int j = 0; j < 8; ++j) w[j] = *(const u32x2*)(XB + (size_t)row * D + 4 * c.lane + 256 * j);
#pragma unroll
            for (int j = 0; j < 8; ++j) v[j] = (f32x4){bflo(w[j].x), bfhi(w[j].x), bflo(w[j].y), bfhi(w[j].y)};
        }
#pragma unroll
        for (int j = 0; j < 8; ++j) s += (v[j].x * v[j].x + v[j].y * v[j].y) + (v[j].z * v[j].z + v[j].w * v[j].w);
        const float rstd = fast_rsqrt(wave_sum(s, c.lane) * (1.f / D) + EPS);
        if (c.lane == 0) ((float*)(a.ws + WS_RSTD))[row] = rstd;
        if (FIRST) {
#pragma unroll
            for (int j = 0; j < 8; ++j) v[j] = v[j] * rstd * gv[j];
            float ga[8];
#pragma unroll
            for (int o = 0; o < 8; ++o) { float t = 0.f;
#pragma unroll
                for (int j = 0; j < 8; ++j) { const f32x4 w4 = *(const LAS f32x4*)(Wg + o * D + 4 * c.lane + 256 * j); t += (v[j].x * w4.x + v[j].y * w4.y) + (v[j].z * w4.z + v[j].w * w4.w); }
                ga[o] = wave_sum(t, c.lane); }
            float val = ga[0];
#pragma unroll
            for (int o = 1; o < 8; ++o) val = (c.lane == o) ? ga[o] : val;
            if (c.lane < 8) {
                float r;
                if (c.lane < 4) r = val + a.b_igate[l * MH + c.lane];
                else r = log_sigmoid(val + a.b_fgate[l * MH + c.lane - 4]);
                ((float*)(a.ws + WS_GATE))[(size_t)row * 8 + c.lane] = r;
            }
        }
    }
    if (FIRST && l == 0) build_kv_image(a, c.vcu, c.G, c.tid, 0);
}

__device__ __forceinline__ float scan256_sum(float v, int tid, int lane, int wave, LAS float* tot  ) {
#pragma unroll
    for (int o = 1; o < 64; o <<= 1) { const float t = shup(v, o, lane); if (lane >= o) v += t; }
    if (lane == 63) tot[wave] = v;
    __syncthreads();
    float off = 0.f;
#pragma unroll
    for (int w = 0; w < 3; ++w) off += (w < wave) ? tot[w] : 0.f;
    __syncthreads();
    return v + off;
}
__device__ __forceinline__ float scan256_max(float v, int tid, int lane, int wave, LAS float* tot) {
#pragma unroll
    for (int o = 1; o < 64; o <<= 1) { const float t = shup(v, o, lane); if (lane >= o) v = fmaxf(v, t); }
    if (lane == 63) tot[wave] = v;
    __syncthreads();
    float off = -3.0e38f;
#pragma unroll
    for (int w = 0; w < 3; ++w) off = (w < wave) ? fmaxf(off, tot[w]) : off;
    __syncthreads();
    return fmaxf(v, off);
}

__device__ __forceinline__ void m1_unit(const Args& a, const Ctx& c_in, int l, int unit) {
    const int g = unit & 31, bh = unit >> 5, b = bh >> 2, h = bh & 3;
    const bf16* PROJ = (const bf16*)(a.ws + WS_BIG);
    const float* GATE = (const float*)(a.ws + WS_GATE);
    Ctx c = c_in; { int t_ = c.tid; asm volatile("" : "+v"(t_)); c.tid = t_; c.lane = t_ & 63; }
    LAS float* scr = (LAS float*)(c.lds + SCR_OFF);
    LAS float* W_S = scr;
    LAS float* NACC = scr + 256;
    LAS float* TOT = scr + 384;
    LAS float* SCAL = scr + 392;
    const int row0 = b * SEQ + g * 256;
    LAS float* PART = scr + 400;
    const int sr = c.tid >> 4, sc = (c.tid & 15) * 8;
    u32x4 kq8[8], vq8[8];
#pragma unroll
    for (int t = 0; t < 4; ++t)
#pragma unroll
        for (int hh = 0; hh < 2; ++hh) { const int rr = t * 64 + hh * 32 + sr; const size_t ro = (size_t)(row0 + rr) * NPROJ;
            kq8[t * 2 + hh] = *(const u32x4*)(PROJ + ro + C_MK + h * HD + sc); vq8[t * 2 + hh] = *(const u32x4*)(PROJ + ro + C_MV + h * HD + sc); }
    __syncthreads();
    float li = 0.f, lf = 0.f;
    if (c.tid < 256) { li = GATE[(size_t)(row0 + c.tid) * 8 + h]; lf = GATE[(size_t)(row0 + c.tid) * 8 + 4 + h]; }
    const float bc = scan256_sum(lf, c.tid, c.lane, c.wave, TOT);
    const float as = li - bc;
    const float am = scan256_max(c.tid < 256 ? as : -3.0e38f, c.tid, c.lane, c.wave, TOT);
    if (c.tid == 255) { SCAL[0] = am; SCAL[1] = bc; }
    __syncthreads();
    const float amax = SCAL[0], blast = SCAL[1];
    if (c.tid < 256) W_S[c.tid] = fast_exp(as - amax);
    __syncthreads();
#pragma unroll
    for (int t = 0; t < 4; ++t)
#pragma unroll
        for (int hh = 0; hh < 2; ++hh) {
            const int rr = t * 64 + hh * 32 + sr;
            const u32x4 kq = kq8[t * 2 + hh];
            const u32x4 vq = vq8[t * 2 + hh];
            const float w = W_S[rr] * 0.08838834764831845f;
            float kf[8] = {bflo(kq.x) * w, bfhi(kq.x) * w, bflo(kq.y) * w, bfhi(kq.y) * w, bflo(kq.z) * w, bfhi(kq.z) * w, bflo(kq.w) * w, bfhi(kq.w) * w};
            u32x4 kw; kw.x = cvtpk(kf[0], kf[1]); kw.y = cvtpk(kf[2], kf[3]); kw.z = cvtpk(kf[4], kf[5]); kw.w = cvtpk(kf[6], kf[7]);
            *(LAS u32x4*)(c.lds + t * 16384 + v_st(hh * 32 + sr, sc)) = kw;
            *(LAS u32x4*)(c.lds + 65536 + t * 16384 + v_st(hh * 32 + sr, sc)) = vq;
        }
    __syncthreads();
    {
        const int col = c.tid & 127, t = c.tid >> 7; float s = 0.f;
        for (int k = 0; k < 64; ++k) s += bf2f(*(const LAS bf16*)(c.lds + t * 16384 + v_st(k, col)));
        PART[c.tid] = s;
    }
    __syncthreads();
    const int Da = c.wave >> 1, Db0 = 2 * (c.wave & 1);
    f32x16 acc0 = f32x16{}, acc1 = f32x16{};
    const int vbk = (int)(uintptr_t)(c.lds) + v_rd_base(c.lane) + Da * 512;
    const int vbv = (int)(uintptr_t)(c.lds) + 65536 + v_rd_base(c.lane) + Db0 * 512;
#pragma unroll
    for (int t = 0; t < 4; ++t) {
        const int ak = vbk + t * 16384, av = vbv + t * 16384;
        const bf16x8 a0 = tr_frag<0, 0>(ak), a1 = tr_frag<0, 1>(ak), a2 = tr_frag<0, 2>(ak), a3 = tr_frag<0, 3>(ak);
        const bf16x8 b00 = tr_frag<0, 0>(av), b01 = tr_frag<0, 1>(av), b02 = tr_frag<0, 2>(av), b03 = tr_frag<0, 3>(av);
        const bf16x8 b10 = tr_frag<1, 0>(av), b11 = tr_frag<1, 1>(av), b12 = tr_frag<1, 2>(av), b13 = tr_frag<1, 3>(av);
        asm volatile("s_waitcnt lgkmcnt(0)" ::: "memory"); SBAR();
        acc0 = __builtin_amdgcn_mfma_f32_32x32x16_bf16(a0, b00, acc0, 0, 0, 0); acc1 = __builtin_amdgcn_mfma_f32_32x32x16_bf16(a0, b10, acc1, 0, 0, 0);
        acc0 = __builtin_amdgcn_mfma_f32_32x32x16_bf16(a1, b01, acc0, 0, 0, 0); acc1 = __builtin_amdgcn_mfma_f32_32x32x16_bf16(a1, b11, acc1, 0, 0, 0);
        acc0 = __builtin_amdgcn_mfma_f32_32x32x16_bf16(a2, b02, acc0, 0, 0, 0); acc1 = __builtin_amdgcn_mfma_f32_32x32x16_bf16(a2, b12, acc1, 0, 0, 0);
        acc0 = __builtin_amdgcn_mfma_f32_32x32x16_bf16(a3, b03, acc0, 0, 0, 0); acc1 = __builtin_amdgcn_mfma_f32_32x32x16_bf16(a3, b13, acc1, 0, 0, 0);
    }
    float* CL = (float*)(a.ws + WS_CLOC) + (size_t)unit * HD * HD;
    const int r32 = c.lane & 31, hi = c.lane >> 5;
#pragma unroll
    for (int r = 0; r < 16; ++r) { const int d = 32 * Da + crow(r, hi);
        CL[(size_t)d * HD + 32 * Db0 + r32] = acc0[r]; CL[(size_t)d * HD + 32 * (Db0 + 1) + r32] = acc1[r]; }
    if (c.tid < 128) ((float*)(a.ws + WS_NLOC))[(size_t)unit * HD + c.tid] = (PART[c.tid] + PART[128 + c.tid]) + (PART[256 + c.tid] + PART[384 + c.tid]);
    if (c.tid == 0) { float* ms = (float*)(a.ws + WS_MSC) + (size_t)unit * 4; ms[0] = blast + amax; ms[1] = blast; }
}

__device__ __forceinline__ void sample_mixers(const Args& a, const Ctx& c, int l);
template <bool WITH_QK>
__device__ __forceinline__ void phase_c(const Args& a, const Ctx& c_in0, int l) {
    const Ctx c = relaunder(c_in0);
    bf16* PROJ = (bf16*)(a.ws + WS_BIG); bf16* MIX = (bf16*)(a.ws + WS_H);
    constexpr int WSMP = SBATCH * NH + SBATCH * MH;
    const bool split = c.G > 2 * WSMP;
    if (WITH_QK && (!split || c.vcu < WSMP)) sample_mixers(a, c, l);
    for (int u = c.vcu; u < 16 * NGRP; u += c.G) m1_unit(a, c, l, u);
    const int gw = c.vcu * NWAVES + c.wave, NGW = c.G * NWAVES;
    if (WITH_QK) {
        const float* gq = a.q_norm_g + l * HD; const float* gk = a.k_norm_g + l * HD;
        const int gi = (16 * c.lane) & 127;
        f32x4 gqv[4], gkv[4];
#pragma unroll
        for (int j = 0; j < 4; ++j) { gqv[j] = *(const f32x4*)(gq + gi + 4 * j); gkv[j] = *(const f32x4*)(gk + gi + 4 * j); }
        bf16* SK = (bf16*)(a.ws + WS_SK + (size_t)(l & 1) * SKV_IMG); bf16* SV = (bf16*)(a.ws + WS_SV + (size_t)(l & 1) * SKV_IMG);
        constexpr int NIT = NB * KEEP;
        for (int it = gw; it < NIT; it += NGW) {
            const int row = (it / KEEP) * SEQ + (SEQ - KEEP) + (it % KEEP);
            const bf16* p = PROJ + (size_t)row * NPROJ + C_K + 16 * c.lane;
            const u32x4 w0 = *(const u32x4*)p, w1 = *(const u32x4*)(p + 8);
            const bf16* pv = PROJ + (size_t)row * NPROJ + C_V + 16 * c.lane;
            const u32x4 v0 = *(const u32x4*)pv, v1 = *(const u32x4*)(pv + 8);
            const int b = row / SEQ, t = row % SEQ; const size_t o = ((size_t)(l * NB + b) * KEEP + (t - (SEQ - KEEP))) * 1024 + 16 * c.lane;
            float* ok = a.out + O_PK + o; float* ov = a.out + O_PV + o;
            *(f32x4*)(ok + 0) = (f32x4){bflo(w0.x), bfhi(w0.x), bflo(w0.y), bfhi(w0.y)}; *(f32x4*)(ok + 4) = (f32x4){bflo(w0.z), bfhi(w0.z), bflo(w0.w), bfhi(w0.w)};
            *(f32x4*)(ok + 8) = (f32x4){bflo(w1.x), bfhi(w1.x), bflo(w1.y), bfhi(w1.y)}; *(f32x4*)(ok + 12) = (f32x4){bflo(w1.z), bfhi(w1.z), bflo(w1.w), bfhi(w1.w)};
            *(f32x4*)(ov + 0) = (f32x4){bflo(v0.x), bfhi(v0.x), bflo(v0.y), bfhi(v0.y)}; *(f32x4*)(ov + 4) = (f32x4){bflo(v0.z), bfhi(v0.z), bflo(v0.w), bfhi(v0.w)};
            *(f32x4*)(ov + 8) = (f32x4){bflo(v1.x), bfhi(v1.x), bflo(v1.y), bfhi(v1.y)}; *(f32x4*)(ov + 12) = (f32x4){bflo(v1.z), bfhi(v1.z), bflo(v1.w), bfhi(v1.w)};
        }
    }
    {
        const int ch = 8 * c.lane;
        float w0[8], w1[8], w2[8];
#pragma unroll
        for (int i = 0; i < 8; ++i) { w0[i] = a.conv_w[(size_t)(l * 3 + 0) * 512 + ch + i]; w1[i] = a.conv_w[(size_t)(l * 3 + 1) * 512 + ch + i]; w2[i] = a.conv_w[(size_t)(l * 3 + 2) * 512 + ch + i]; }
        constexpr int NSEG = SEQ / 32, NITEM = NB * NSEG + SBATCH;
        const int gwc = split ? (c.vcu - WSMP) * NWAVES + c.wave : gw, NGWc = split ? (c.G - WSMP) * NWAVES : NGW;
        for (int it = gwc; it >= 0 && it < NITEM; it += NGWc) {
            float u2[8], u1[8]; int rowb; bool samp = it >= NB * NSEG; int b, seg = 0;
            if (!samp) { b = it / NSEG; seg = it % NSEG; rowb = b * SEQ + seg * 32; } else { b = it - NB * NSEG; rowb = MP + b * SSEQ; }
#pragma unroll
            for (int i = 0; i < 8; ++i) { u2[i] = 0.f; u1[i] = 0.f; }
            if (samp) {
#pragma unroll
                for (int i = 0; i < 8; ++i) { u2[i] = a.state_conv[((size_t)(l * SBATCH + b) * 2 + 0) * 512 + ch + i]; u1[i] = a.state_conv[((size_t)(l * SBATCH + b) * 2 + 1) * 512 + ch + i]; }
            } else if (seg > 0) {
#pragma unroll
                for (int q = 0; q < 2; ++q) { const bf16* pr = PROJ + (size_t)(rowb - 2 + q) * NPROJ + ch;
                    const u32x4 xa = *(const u32x4*)(pr + C_XA), gc = *(const u32x4*)(pr + C_GC);
                    float* dst = q ? u1 : u2;
                    dst[0] = bflo(xa.x) * bflo(gc.x); dst[1] = bfhi(xa.x) * bfhi(gc.x); dst[2] = bflo(xa.y) * bflo(gc.y); dst[3] = bfhi(xa.y) * bfhi(gc.y);
                    dst[4] = bflo(xa.z) * bflo(gc.z); dst[5] = bfhi(xa.z) * bfhi(gc.z); dst[6] = bflo(xa.w) * bflo(gc.w); dst[7] = bfhi(xa.w) * bfhi(gc.w); }
            }
            for (int t0 = 0; t0 < 32; t0 += 4) {
                u32x4 xa4[4], gb4[4], gc4[4];
#pragma unroll
                for (int q = 0; q < 4; ++q) { const bf16* pr = PROJ + (size_t)(rowb + t0 + q) * NPROJ + ch; xa4[q] = *(const u32x4*)(pr + C_XA); gb4[q] = *(const u32x4*)(pr + C_GB); gc4[q] = *(const u32x4*)(pr + C_GC); }
#pragma unroll
                for (int q = 0; q < 4; ++q) { const int t = t0 + q;
                const u32x4 xa = xa4[q], gb = gb4[q], gc = gc4[q];
                float u0[8] = {bflo(xa.x) * bflo(gc.x), bfhi(xa.x) * bfhi(gc.x), bflo(xa.y) * bflo(gc.y), bfhi(xa.y) * bfhi(gc.y),
                               bflo(xa.z) * bflo(gc.z), bfhi(xa.z) * bfhi(gc.z), bflo(xa.w) * bflo(gc.w), bfhi(xa.w) * bfhi(gc.w)};
                float gbf[8] = {bflo(gb.x), bfhi(gb.x), bflo(gb.y), bfhi(gb.y), bflo(gb.z), bfhi(gb.z), bflo(gb.w), bfhi(gb.w)};
                float y[8];
#pragma unroll
                for (int i = 0; i < 8; ++i) { y[i] = gbf[i] * (w0[i] * u2[i] + w1[i] * u1[i] + w2[i] * u0[i]); u2[i] = u1[i]; u1[i] = u0[i]; }
                u32x4 o; o.x = cvtpk(y[0], y[1]); o.y = cvtpk(y[2], y[3]); o.z = cvtpk(y[4], y[5]); o.w = cvtpk(y[6], y[7]);
                *(u32x4*)(MIX + (size_t)(rowb + t) * D + ch) = o;
                }
            }
            float* oc = nullptr;
            if (samp) oc = a.out + O_SCONV + (size_t)(l * SBATCH + b) * 2 * 512 + ch;
            else if (seg == NSEG - 1) oc = a.out + O_PCONV + (size_t)(l * NB + b) * 2 * 512 + ch;
            if (oc) {
                *(f32x4*)(oc) = (f32x4){u2[0], u2[1], u2[2], u2[3]}; *(f32x4*)(oc + 4) = (f32x4){u2[4], u2[5], u2[6], u2[7]};
                *(f32x4*)(oc + 512) = (f32x4){u1[0], u1[1], u1[2], u1[3]}; *(f32x4*)(oc + 516) = (f32x4){u1[4], u1[5], u1[6], u1[7]};
            }
        }
    }
}

__device__ __forceinline__ void phase_d(const Args& a, const Ctx& c_in0, int l) {
    const Ctx c = relaunder(c_in0);
    const float* CL = (const float*)(a.ws + WS_CLOC); const float* NL = (const float*)(a.ws + WS_NLOC); float* MSC = (float*)(a.ws + WS_MSC);
    bf16* C0 = (bf16*)(a.ws + WS_C0); float* N0 = (float*)(a.ws + WS_N0);
    LAS float* DEC = (LAS float*)(c.lds + SCR_OFF);
    LAS float* WLO = DEC + 512;
    LAS float* MFIN = WLO + 512;
    LAS float* MLO = MFIN + 16;
    LAS float* BLA = MLO + 512;
    __syncthreads();
    { const int u = c.tid; MLO[u] = MSC[(size_t)u * 4 + 0]; BLA[u] = MSC[(size_t)u * 4 + 1]; }
    __syncthreads();
    if (c.tid < 16) { const int bh = c.tid; float m = 0.f;
        for (int g = 0; g < NGRP; ++g) { const size_t u = (size_t)bh * NGRP + g; const float mloc = MLO[u], blast = BLA[u];
            const float mn = fmaxf(blast + m, mloc); DEC[bh * NGRP + g] = fast_exp(blast + m - mn); WLO[bh * NGRP + g] = fast_exp(mloc - mn);
            if (c.vcu == 0) MSC[u * 4 + 2] = m;
            m = mn; }
        MFIN[bh] = m; }
    __syncthreads();
    const unsigned gt = (unsigned)c.vcu * NTHREADS + c.tid, NT = (unsigned)c.G * NTHREADS;
    constexpr unsigned PER = (unsigned)HD * HD + HD;
    for (unsigned i = gt; i < 16u * PER; i += NT) {
        const int bh = (int)(i / PER); const int e = (int)(i % PER); const bool isn = e >= HD * HD; const int en = e - HD * HD;
        const float* src = isn ? NL + (size_t)bh * NGRP * HD + en : CL + (size_t)bh * NGRP * HD * HD + e;
        const size_t sstep = isn ? HD : (size_t)HD * HD;
        float x[NGRP];
#pragma unroll
        for (int g = 0; g < NGRP; ++g) x[g] = src[(size_t)g * sstep];
        float C = 0.f;
#pragma unroll
        for (int g = 0; g < NGRP; ++g) {
            const size_t u = (size_t)bh * NGRP + g;
            if (isn) N0[u * HD + en] = C; else C0[u * HD * HD + e] = (bf16)(cvtpk(C, 0.f) & 0xffffu);
            C = DEC[bh * NGRP + g] * C + WLO[bh * NGRP + g] * x[g];
        }
        const int b = bh >> 2, h = bh & 3;
        if (isn) a.out[O_PN + ((size_t)(l * NB + b) * MH + h) * HD + en] = C;
        else a.out[O_PC + ((size_t)(l * NB + b) * MH + h) * HD * HD + e] = C;
        if (e == 0) a.out[O_PM + (size_t)(l * NB + b) * MH + h] = MFIN[bh];
    }
}

constexpr float ATT_C = 0.088388347648318440f * LOG2E;
constexpr float THR2 = 8.f * LOG2E;
struct DmaMap { unsigned k0, k1, v0, v1; };
__device__ __forceinline__ DmaMap dma_map(int lane, int wave, int LD) {
    DmaMap m; unsigned kk_[2], vv_[2];
#pragma unroll
    for (int i = 0; i < 2; ++i) { const int o = (wave + 8 * i) * 1024 + lane * 16;
        const int row = o >> 8, c16 = ((o >> 4) & 15) ^ (row & 7); kk_[i] = (unsigned)(row * LD + c16 * 8) * 2u;
        const int sub = o >> 9, kk = ((sub >> 2) << 3) | ((o >> 6) & 7), k = (kk & ~0xC) | ((kk & 4) << 1) | ((kk & 8) >> 1), cc = ((sub & 3) << 5) | ((o & 63) >> 1); vv_[i] = (unsigned)(k * LD + cc) * 2u; }
    m.k0 = kk_[0]; m.k1 = kk_[1]; m.v0 = vv_[0]; m.v1 = vv_[1]; return m;
}
__device__ __forceinline__ void glds16s(const void* sbase, unsigned voff, unsigned lds_dst) { unsigned keep;
    asm volatile("s_mov_b32 %0, m0\n\ts_mov_b32 m0, %3\n\ts_nop 0\n\tglobal_load_lds_dwordx4 %1, %2\n\ts_mov_b32 m0, %0" : "=&s"(keep) : "v"(voff), "s"(sbase), "s"(lds_dst) : "memory"); }
__device__ __forceinline__ void dma_fill(LAS unsigned char* lds, int slot, int wave, const bf16* Ta, unsigned a0, unsigned a1, const bf16* Tb, unsigned b0, unsigned b1) {
    const unsigned d = (unsigned)(uintptr_t)lds + (unsigned)(slot * 32768 + wave * 1024);
    glds16s(Ta, a0, d); glds16s(Ta, a1, d + 8192u); glds16s(Tb, b0, d + 16384u); glds16s(Tb, b1, d + 24576u);
}
#define RING_WAIT_BAR(N) do { asm volatile("s_waitcnt vmcnt(" #N ") lgkmcnt(0)" ::: "memory"); __builtin_amdgcn_s_barrier(); asm volatile("" ::: "memory"); } while (0)

__device__ __forceinline__ float fma_s(float a, float b, float c) { float d; asm("v_fma_f32 %0, %1, %2, %3" : "=v"(d) : "v"(a), "v"(b), "v"(c)); return d; }
__device__ __forceinline__ float add_s(float a, float b) { float d; asm("v_add_f32 %0, %1, %2" : "=v"(d) : "v"(a), "v"(b)); return d; }
#define ATT_SCORE_SOFTMAX(j, slotk)                                                                                                           \
    {   const int K_lds = ldsb + (slotk) * 16384;                                                                                              \
        f32x16 p0, p1; qkt(p0, p1, K_lds, qr, r32, hi);                                                                                       \
        STEP_FILL();                                                             \
        const int Rl = R0 + r32 - 64 * (j);                                                                                                   \
        const int relmin = R0 - 64 * (j) - 63;                                                                                                \
        if (relmin >= 128) { const float bc = BR[0];                                                                                           \
            _Pragma("unroll") for (int r = 0; r < 16; ++r) { p0[r] = fma_s(p0[r], ATT_C, bc); p1[r] = fma_s(p1[r], ATT_C, bc); }                \
        } else {                                                                                                                               \
            const LAS float* bp = BR + (64 + 128 - Rl + 4 * hi);                                                                               \
            _Pragma("unroll") for (int r = 0; r < 16; ++r) { p0[r] = fma_s(p0[r], ATT_C, bp[(r & 3) + 8 * (r >> 2)]); p1[r] = fma_s(p1[r], ATT_C, bp[32 + (r & 3) + 8 * (r >> 2)]); } \
        }                                                                                                                                      \
        const int nvalid = kend - 64 * (j);                                                                                                    \
        if (nvalid < 64) { asm volatile("" ::: "memory");                           \
            _Pragma("unroll") for (int r = 0; r < 16; ++r) { const int kk = crow(r, hi); if (kk >= nvalid) p0[r] = -1e30f; if (kk + 32 >= nvalid) p1[r] = -1e30f; } \
        }                                                                                                                                      \
        float pmax = p0[0];                                                                                                                    \
        _Pragma("unroll") for (int r = 1; r < 16; ++r) pmax = fmaxf(pmax, p0[r]);                                                              \
        _Pragma("unroll") for (int r = 0; r < 16; ++r) pmax = fmaxf(pmax, p1[r]);                                                              \
        pmax = half_swap_max(pmax);                                                                                                            \
        if (!__all(pmax - m_reg <= THR2)) {                                                                                                    \
            const float mn = fmaxf(m_reg, pmax); const float alpha = __builtin_amdgcn_exp2f(m_reg - mn); m_reg = mn;                           \
            l_reg *= alpha;                                                                                                                    \
            if (hi == 0) al_l[r32] = alpha; asm volatile("s_waitcnt lgkmcnt(0)" ::: "memory");                                               \
            _Pragma("unroll") for (int r = 0; r < 16; ++r) { const float al = al_l[crow(r, hi)];                                               \
                _Pragma("unroll") for (int d = 0; d < 4; ++d) o[d][r] *= al; }                                                                 \
        }                                                                                                                                      \
        float ps = 0.f;                                                                                                                        \
        _Pragma("unroll") for (int r = 0; r < 16; ++r) { p0[r] = __builtin_amdgcn_exp2f(p0[r] - m_reg); p1[r] = __builtin_amdgcn_exp2f(p1[r] - m_reg); ps = add_s(ps, add_s(p0[r], p1[r])); } \
        l_reg += half_swap_add(ps);                                                                                                            \
        PK4(p0, 0, pa0); PK4(p0, 8, pa1); PK4(p1, 0, pa2); PK4(p1, 8, pa3);                                                                    \
    }
__device__ __forceinline__ void attn_unit(const Ctx& c, const bf16* __restrict__ Qb, int LDQ, int qrow, const bf16* __restrict__ Kh, const bf16* __restrict__ Vh, int LDK, int NT, int alo, int ahi, int kend,
                                          int R0  , const float* __restrict__ bias_g, bf16* __restrict__ Ob, int LDO, bool do_store, const float* __restrict__ qgain = nullptr, int rot = 0) {
    int tid = c.tid; asm volatile("" : "+v"(tid));
    const int wid = c.wave, lane = tid & 63, r32 = lane & 31, hi = lane >> 5;
    const int ldsb = (int)(uintptr_t)c.lds;
    constexpr int VRING = 49152;
    LAS float* wsf = (LAS float*)(c.lds + 114688) + wid * 64; LAS float* li_l = wsf; LAS float* al_l = wsf + 32;
    LAS float* BR = (LAS float*)(c.lds + SCR_OFF);
    asm volatile("s_waitcnt lgkmcnt(0)" ::: "memory"); __builtin_amdgcn_s_barrier(); asm volatile("" ::: "memory");
    const DmaMap dm = dma_map(lane, wid, LDK);
    const size_t tile_step = (size_t)64 * LDK;
    const unsigned dbase = (unsigned)ldsb + (unsigned)wid * 1024u;
#define ATT_FILL(kt_, vt_, sk_, sv_) do { const unsigned dk_ = dbase + (unsigned)(sk_) * 16384u, dv_ = dbase + VRING + (unsigned)(sv_) * 16384u; \
        glds16s(kt_, dm.k0, dk_); glds16s(kt_, dm.k1, dk_ + 8192u); glds16s(vt_, dm.v0, dv_); glds16s(vt_, dm.v1, dv_ + 8192u); } while (0)
#define TIDX(s_) ((s_) + rot - (((s_) + rot) >= NT ? NT : 0))
    { const int t0_ = TIDX(0), t1_ = TIDX(1);
      ATT_FILL(Kh + t0_ * tile_step, Vh + t0_ * tile_step, 0, 0);
      ATT_FILL(Kh + t1_ * tile_step, Vh + t1_ * tile_step, 1, 1); }
    if (tid < 321) { const int i = tid - 64; BR[tid] = bias_g[256 - (i < 0 ? 0 : i)] * LOG2E; }
    float m_reg = -1e30f, l_reg = 0.f; f32x16 o[4] = {f32x16{}, f32x16{}, f32x16{}, f32x16{}}; bf16x8 qr[8];
    { const bf16* Qw = Qb + (size_t)(qrow + r32) * LDQ + hi * 8;
#pragma unroll
      for (int d0 = 0; d0 < 8; ++d0) qr[d0] = *(const bf16x8*)(Qw + d0 * 16); }
    if (qgain) {
        float f[8][8]; float ss = 0.f;
#pragma unroll
        for (int d0 = 0; d0 < 8; ++d0) { const u32x4 w = *reinterpret_cast<const u32x4*>(&qr[d0]);
            f[d0][0] = bflo(w.x); f[d0][1] = bfhi(w.x); f[d0][2] = bflo(w.y); f[d0][3] = bfhi(w.y); f[d0][4] = bflo(w.z); f[d0][5] = bfhi(w.z); f[d0][6] = bflo(w.w); f[d0][7] = bfhi(w.w);
#pragma unroll
            for (int i = 0; i < 8; ++i) ss += f[d0][i] * f[d0][i]; }
        ss = half_swap_add(ss);
        const float rq = fast_rsqrt(ss * (1.f / HD) + EPS);
#pragma unroll
        for (int d0 = 0; d0 < 8; ++d0) { const f32x4 g0 = *(const f32x4*)(qgain + d0 * 16 + hi * 8), g1 = *(const f32x4*)(qgain + d0 * 16 + hi * 8 + 4);
            u32x4 s; s.x = cvtpk(f[d0][0] * rq * g0[0], f[d0][1] * rq * g0[1]); s.y = cvtpk(f[d0][2] * rq * g0[2], f[d0][3] * rq * g0[3]);
            s.z = cvtpk(f[d0][4] * rq * g1[0], f[d0][5] * rq * g1[1]); s.w = cvtpk(f[d0][6] * rq * g1[2], f[d0][7] * rq * g1[3]);
            qr[d0] = *reinterpret_cast<bf16x8*>(&s); }
    }
#pragma unroll
    for (int d0 = 0; d0 < 8; ++d0) { u32x4 w = *reinterpret_cast<u32x4*>(&qr[d0]); asm volatile("" : "+v"(w)); qr[d0] = *reinterpret_cast<bf16x8*>(&w); }
    asm volatile("" ::: "memory");
    const bool skew = wid >= 4;
    bf16x8 pa0 = bf16x8{}, pa1 = bf16x8{}, pa2 = bf16x8{}, pa3 = bf16x8{};
    int sk = 0, sv = 0;
    bool pact = false;
    for (int j = 0; j < NT; ++j) {
        if (j + 1 < NT) RING_WAIT_BAR(4); else RING_WAIT_BAR(0);
#define STEP_FILL() do { if (j + 2 < NT) { const int fk = sk >= 1 ? sk - 1 : 2, fv = sv >= 2 ? sv - 2 : sv + 2; const int tf = TIDX(j + 2); ATT_FILL(Kh + tf * tile_step, Vh + tf * tile_step, fk, fv); } } while (0)
        const int jt = TIDX(j);
        const bool act = (jt >= alo && jt <= ahi);
        if (skew && pact) { const int svp = sv >= 1 ? sv - 1 : 3; pv_d0(o, ldsb + VRING + svp * 16384 + v_rd_base(lane), pa0, pa1, pa2, pa3); }
        pact = act;
        if (act) { ATT_SCORE_SOFTMAX(jt, sk); } else STEP_FILL();
        if (!skew && act) pv_d0(o, ldsb + VRING + sv * 16384 + v_rd_base(lane), pa0, pa1, pa2, pa3);
        sk = sk == 2 ? 0 : sk + 1; sv = (sv + 1) & 3;
    }
    if (skew && pact) { const int svp = sv >= 1 ? sv - 1 : 3; pv_d0(o, ldsb + VRING + svp * 16384 + v_rd_base(lane), pa0, pa1, pa2, pa3); }
#undef STEP_FILL
#undef TIDX
#undef ATT_FILL
    if (hi == 0) li_l[r32] = l_reg;
    RING_WAIT_BAR(0);
    const int ost = ldsb + wid * 8192;
#pragma unroll
    for (int r = 0; r < 16; ++r) { const int orow = crow(r, hi); const float rl = __builtin_amdgcn_rcpf(li_l[orow]);
#pragma unroll
        for (int d0 = 0; d0 < 4; ++d0) *(LAS bf16*)(uintptr_t)(unsigned)(ost + orow * 256 + (d0 * 32 + r32) * 2) = (bf16)(cvtpk(o[d0][r] * rl, 0.f) & 0xffffu); }
    asm volatile("s_waitcnt lgkmcnt(0)" ::: "memory");
    if (do_store) {
#pragma unroll
        for (int i = 0; i < 8; ++i) { const int ch = i * 64 + lane, row = ch >> 4, c16 = ch & 15;
            const u32x4 w = *(const LAS u32x4*)(uintptr_t)(unsigned)(ost + row * 256 + c16 * 16);
            *(u32x4*)(Ob + (size_t)(qrow + row) * LDO + c16 * 8) = w; }
    }
}
#define ATT_SCORE_FIXED(j, slotk)                                                                                                             \
    {   const int K_lds = ldsb + (slotk) * 16384;                                                                                              \
        f32x16 p0, p1; qkt_b(p0, p1, K_lds, qr, r32, hi);                                                                                       \
        STEP_FILL();                                                                                                                           \
        const int Rl = R0 + r32 - 64 * (j);                                                                                                   \
        const int relmin = R0 - 64 * (j) - 63;                                                                                                \
        if (relmin >= 128) { const float bc = BR[0];                                                                                           \
            _Pragma("unroll") for (int r = 0; r < 16; ++r) { p0[r] = __builtin_amdgcn_exp2f(fma_s(p0[r], ATT_C, bc)); p1[r] = __builtin_amdgcn_exp2f(fma_s(p1[r], ATT_C, bc)); } \
        } else {                                                                                                                               \
            const LAS float* bp = BR + (64 + 128 - Rl + 4 * hi);                                                                               \
            _Pragma("unroll") for (int r = 0; r < 16; ++r) { p0[r] = __builtin_amdgcn_exp2f(fma_s(p0[r], ATT_C, bp[(r & 3) + 8 * (r >> 2)])); p1[r] = __builtin_amdgcn_exp2f(fma_s(p1[r], ATT_C, bp[32 + (r & 3) + 8 * (r >> 2)])); } \
        }                                                                                                                                      \
        float ps0 = add_s(p0[0], p1[0]), ps1 = add_s(p0[1], p1[1]);                                                                            \
        _Pragma("unroll") for (int r = 2; r < 16; r += 2) { ps0 = add_s(ps0, add_s(p0[r], p1[r])); ps1 = add_s(ps1, add_s(p0[r + 1], p1[r + 1])); } \
        l_reg = add_s(l_reg, add_s(ps0, ps1));                             \
        PK4(p0, 0, pa0); PK4(p0, 8, pa1); PK4(p1, 0, pa2); PK4(p1, 8, pa3);                                                                    \
    }
__device__ __forceinline__ void attn_stream(const Args& a, const Ctx& c, int l, const float Mref, const bool docv, const ConvJob& cvj, int& cvk) {
    constexpr int NATT = NB * NH * 32;
    if (c.vcu >= NATT) return;
    int tid = c.tid; asm volatile("" : "+v"(tid));
    const int wid = c.wave, lane = tid & 63, r32 = lane & 31, hi = lane >> 5;
    const int ldsb = (int)(uintptr_t)c.lds;
    constexpr int VRING = 49152;
    LAS float* wsf = (LAS float*)(c.lds + 114688) + wid * 64; LAS float* li_l = wsf; LAS float* al_l = wsf + 32;
    LAS float* BR = (LAS float*)(c.lds + SCR_OFF);
    const bf16* PROJ = (const bf16*)(a.ws + WS_BIG); bf16* MIX = (bf16*)(a.ws + WS_H);
    const int gq = c.vcu & 31, h = (c.vcu >> 5) & 7, b0 = c.vcu >> 8, db = c.G >> 8, nun = (NB - b0 + db - 1) / db;
    const int c0 = 4 * gq, jstart = c0 >= 8 ? 0 : 8 - c0, NT = 12 - jstart, ci = wid >> 1;
    const int alo = ci - jstart < 0 ? 0 : ci - jstart, ahi = ci + 8 - jstart, kend = NT * 64;
    const int R0 = (ci + 8 - jstart) * 64 + (wid & 1) * 32, rot = gq >= 2 ? (8 * gq + 8) % 12 : 0, qrow = wid * 32;
    const float* bias_g = a.rel_bias + (size_t)(l * NH + h) * 257;
    constexpr int LDK = NPROJ, LDO = D;
    asm volatile("s_waitcnt lgkmcnt(0)" ::: "memory"); __builtin_amdgcn_s_barrier(); asm volatile("" ::: "memory");
    const DmaMap dm = dma_map(lane, wid, LDK);
    const size_t tile_step = (size_t)64 * LDK;
    const unsigned dbase = (unsigned)ldsb + (unsigned)wid * 1024u;
#define ATT_FILL(kt_, vt_, sk_, sv_) do { const unsigned dk_ = dbase + (unsigned)(sk_) * 16384u, dv_ = dbase + VRING + (unsigned)(sv_) * 16384u; \
        glds16s(kt_, dm.k0, dk_); glds16s(kt_, dm.k1, dk_ + 8192u); glds16s(vt_, dm.v0, dv_); glds16s(vt_, dm.v1, dv_ + 8192u); } while (0)
#define TIDX(s_) ((s_) + rot - (((s_) + rot) >= NT ? NT : 0))
    const bf16* Qb = PROJ + (size_t)(b0 * SEQ + c0 * 64) * NPROJ + C_Q + h * HD;
    const bf16* Kh = PROJ + (size_t)(b0 * SEQ + (c0 - 8 + jstart) * 64) * NPROJ + C_K + h * HD;
    const bf16* Vh = PROJ + (size_t)(b0 * SEQ + (c0 - 8 + jstart) * 64) * NPROJ + C_V + h * HD;
    bf16* Ob = MIX + (size_t)(b0 * SEQ + c0 * 64) * D + 512 + h * HD;
    const size_t dproj = (size_t)db * SEQ * NPROJ, dmix = (size_t)db * SEQ * D;
    { const int t0_ = TIDX(0), t1_ = TIDX(1);
      ATT_FILL(Kh + t0_ * tile_step, Vh + t0_ * tile_step, 0, 0);
      ATT_FILL(Kh + t1_ * tile_step, Vh + t1_ * tile_step, 1, 1); }
    if (tid < 321) { const int i = tid - 64; BR[tid] = bias_g[256 - (i < 0 ? 0 : i)] * LOG2E - Mref; }
    bf16x8 qr[8];
    { const bf16* Qw = Qb + (size_t)(qrow + r32) * NPROJ + hi * 8;
#pragma unroll
      for (int d0 = 0; d0 < 8; ++d0) qr[d0] = *(const bf16x8*)(Qw + d0 * 16); }
    const bool skew = wid >= 4;
    int sk = 0, sv = 0;
#define Q_CONSUME() do { _Pragma("unroll") for (int d0 = 0; d0 < 8; ++d0) { u32x4 w = *reinterpret_cast<u32x4*>(&qr[d0]); asm volatile("" : "+v"(w)); qr[d0] = *reinterpret_cast<bf16x8*>(&w); } asm volatile("" ::: "memory"); } while (0)
    Q_CONSUME();
#pragma unroll 1
    for (int ui = 0; ui < nun; ++ui) {
        const bool has_next = ui + 1 < nun;
        const bf16* Khn = Kh + dproj; const bf16* Vhn = Vh + dproj;
        float l_reg = 0.f; f32x16 o[4] = {f32x16{}, f32x16{}, f32x16{}, f32x16{}};
        bf16x8 pa0 = bf16x8{}, pa1 = bf16x8{}, pa2 = bf16x8{}, pa3 = bf16x8{};
        bool pact = false, skipw = false;
        for (int j = 0; j < NT; ++j) {
            if (!skipw) { if (j + 1 < NT || has_next) RING_WAIT_BAR(4); else RING_WAIT_BAR(0); }
            skipw = false;
#define STEP_FILL() do { const int fk = sk >= 1 ? sk - 1 : 2, fv = sv >= 2 ? sv - 2 : sv + 2;                                                                  \
                if (j + 2 < NT) { const int tf = TIDX(j + 2); ATT_FILL(Kh + tf * tile_step, Vh + tf * tile_step, fk, fv); }                                         \
                else if (has_next) { const int tf = TIDX(j + 2 - NT); ATT_FILL(Khn + tf * tile_step, Vhn + tf * tile_step, fk, fv); } } while (0)
            const int jt = TIDX(j);
            const bool act = (jt >= alo && jt <= ahi);
            const bool ppv = skew && pact;
            if (ppv) { const int svp = sv >= 1 ? sv - 1 : 3; pv_d0(o, ldsb + VRING + svp * 16384 + v_rd_base(lane), pa0, pa1, pa2, pa3); }
            pact = act;
            if (act) { ATT_SCORE_FIXED(jt, sk); } else STEP_FILL();
            if (!skew && act) pv_d0(o, ldsb + VRING + sv * 16384 + v_rd_base(lane), pa0, pa1, pa2, pa3);
            sk = sk == 2 ? 0 : sk + 1; sv = (sv + 1) & 3;
            const int cit = cvj.gw + cvk * cvj.ngw;
            if (docv && !act && !ppv && j + 1 < NT && cit < CV_I_L) {
                float cvv[32]; conv_load(cvj, cit, lane, cvv); ++cvk;
                if (j + 2 < NT || has_next) RING_WAIT_BAR(36); else RING_WAIT_BAR(32);
                conv_finish(cvj, cit, lane, cvv, c.lds);
                skipw = true;
            }
        }
        if (skew && pact) { const int svp = sv >= 1 ? sv - 1 : 3; pv_d0(o, ldsb + VRING + svp * 16384 + v_rd_base(lane), pa0, pa1, pa2, pa3); }
#undef STEP_FILL
        if (has_next) { const bf16* Qw = Qb + dproj + (size_t)(qrow + r32) * NPROJ + hi * 8;
#pragma unroll
            for (int d0 = 0; d0 < 8; ++d0) qr[d0] = *(const bf16x8*)(Qw + d0 * 16); }
        l_reg = half_swap_add(l_reg);
        if (hi == 0) li_l[r32] = l_reg;
        asm volatile("s_waitcnt lgkmcnt(0)" ::: "memory"); __builtin_amdgcn_s_barrier(); asm volatile("" ::: "memory");
        const int ost = ldsb + VRING + (((wid < 4 ? sv + 2 : sv + 3) & 3) * 16384) + (wid & 3) * 4096;
#pragma unroll
        for (int hf = 0; hf < 2; ++hf) {
#pragma unroll
            for (int r = 0; r < 16; ++r) { const int orow = crow(r, hi); const float rl = __builtin_amdgcn_rcpf(li_l[orow]);
#pragma unroll
                for (int dd = 0; dd < 2; ++dd) *(LAS bf16*)(uintptr_t)(unsigned)(ost + orow * 128 + (dd * 32 + r32) * 2) = (bf16)(cvtpk(o[2 * hf + dd][r] * rl, 0.f) & 0xffffu); }
            asm volatile("s_waitcnt lgkmcnt(0)" ::: "memory");
#pragma unroll
            for (int i = 0; i < 4; ++i) { const int ch = i * 64 + lane, row = ch >> 3, c16 = ch & 7;
                const u32x4 w = *(const LAS u32x4*)(uintptr_t)(unsigned)(ost + row * 128 + c16 * 16);
                *(u32x4*)(Ob + (size_t)(qrow + row) * LDO + hf * 64 + c16 * 8) = w; }
            asm volatile("s_waitcnt lgkmcnt(0)" ::: "memory");
        }
        Qb += dproj; Kh += dproj; Vh += dproj; Ob += dmix;
        if (has_next) Q_CONSUME();
    }
#undef Q_CONSUME
#undef TIDX
#undef ATT_FILL
}
#undef ATT_SCORE_SOFTMAX
#undef ATT_SCORE_FIXED

__device__ __forceinline__ void m3_unit(const Args& a, const Ctx& c, int l, int unit) {
    const int g = unit & 31, bh = unit >> 5, b = bh >> 2, h = bh & 3;
    const bf16* PROJ = (const bf16*)(a.ws + WS_BIG); bf16* MIX = (bf16*)(a.ws + WS_H);
    const float* GATE = (const float*)(a.ws + WS_GATE);
    int tid = c.tid; asm volatile("" : "+v"(tid));
    const int wid = c.wave, lane = tid & 63, r32 = lane & 31, hi = lane >> 5;
    LAS float* scr = (LAS float*)(c.lds + SCR_OFF);
    LAS float* A_S = scr;
    LAS float* M_T = scr + 256;
    LAS float* B_T = scr + 512;
    LAS float* N0L = scr + 768;
    LAS float* TOT = scr + 896;
    const int ldsb = (int)(uintptr_t)c.lds;
    LAS float* wsf = (LAS float*)(c.lds + 98304) + wid * 64;
    const int row0 = b * SEQ + g * 256;
    const float m0 = ((const float*)(a.ws + WS_MSC))[(size_t)unit * 4 + 2];
    asm volatile("s_waitcnt vmcnt(0) lgkmcnt(0)" ::: "memory"); __builtin_amdgcn_s_barrier(); asm volatile("" ::: "memory");
    const DmaMap dm = dma_map(lane, wid, NPROJ); const DmaMap dc = dma_map(lane, wid, HD);
    const bf16* kt = PROJ + (size_t)row0 * NPROJ + C_MK + h * HD; const bf16* vt = PROJ + (size_t)row0 * NPROJ + C_MV + h * HD;
    const bf16* C0 = (const bf16*)(a.ws + WS_C0) + (size_t)unit * HD * HD;
    const size_t tile_step = (size_t)64 * NPROJ;
    dma_fill(c.lds, 0, wid, kt, dm.k0, dm.k1, vt, dm.v0, dm.v1);
    dma_fill(c.lds, 1, wid, kt + tile_step, dm.k0, dm.k1, vt + tile_step, dm.v0, dm.v1);
    bf16x8 qr[8];
    const int trow = wid * 32 + r32;
    { const bf16* Qw = PROJ + (size_t)(row0 + trow) * NPROJ + C_MQ + h * HD + hi * 8;
#pragma unroll
      for (int d0 = 0; d0 < 8; ++d0) qr[d0] = *(const bf16x8*)(Qw + d0 * 16); }
    u32x4 mo8[8];
#pragma unroll
    for (int i = 0; i < 8; ++i) { const int ch = i * 64 + lane, row = ch >> 4, col = (ch & 15) * 8; mo8[i] = *(const u32x4*)(PROJ + (size_t)(row0 + wid * 32 + row) * NPROJ + C_MO + h * HD + col); }
    float li = 0.f, lf = 0.f;
    if (tid < 256) { li = GATE[(size_t)(row0 + tid) * 8 + h]; lf = GATE[(size_t)(row0 + tid) * 8 + 4 + h]; }
    if (tid < 128) N0L[tid] = ((const float*)(a.ws + WS_N0))[(size_t)unit * HD + tid];
    const float bc = scan256_sum(lf, tid, lane, wid, TOT);
    const float as = li - bc;
    const float cm = scan256_max(tid < 256 ? as : -3.0e38f, tid, lane, wid, TOT);
    if (tid < 256) { A_S[tid] = as; M_T[tid] = fmaxf(m0, cm); B_T[tid] = bc; }
    __syncthreads();
    const float Mt = M_T[trow];
    f32x16 o[4] = {f32x16{}, f32x16{}, f32x16{}, f32x16{}};
    float rowsum = 0.f, qn = 0.f;
    const float winter = fast_exp(m0 - Mt);
    const int ci = wid >> 1;
    int slot = 0;
#pragma unroll 1
    for (int j = 0; j < 4; ++j) {
        RING_WAIT_BAR(4);
        { const int fs = slot >= 1 ? slot - 1 : 2;
          if (j + 2 < 4) dma_fill(c.lds, fs, wid, kt + (size_t)(j + 2) * tile_step, dm.k0, dm.k1, vt + (size_t)(j + 2) * tile_step, dm.v0, dm.v1);
          else if (j == 2) dma_fill(c.lds, fs, wid, C0, dc.v0, dc.v1, C0 + 64 * HD, dc.v0, dc.v1); }
        const int S_lds = ldsb + slot * 32768;
        int r32l = r32; asm volatile("" : "+v"(r32l));
        if (j <= ci) {
            f32x16 p0, p1; qkt(p0, p1, S_lds, qr, r32l, hi);
#pragma unroll
            for (int r = 0; r < 16; ++r) { const int s0 = 64 * j + crow(r, hi), s1 = s0 + 32;
                const float w0 = (s0 <= trow) ? fast_exp(A_S[s0] - Mt) * 0.08838834764831845f : 0.f, w1 = (s1 <= trow) ? fast_exp(A_S[s1] - Mt) * 0.08838834764831845f : 0.f;
                p0[r] *= w0; p1[r] *= w1; rowsum += p0[r] + p1[r]; }
            bf16x8 pa0, pa1, pa2, pa3;
            PK4(p0, 0, pa0); PK4(p0, 8, pa1); PK4(p1, 0, pa2); PK4(p1, 8, pa3);
            pv_d0(o, S_lds + 16384 + v_rd_base(lane), pa0, pa1, pa2, pa3);
        }
        slot = slot == 2 ? 0 : slot + 1;
    }
    RING_WAIT_BAR(0);
    {
        const int S_lds = ldsb + slot * 32768;
#pragma unroll
        for (int hf = 0; hf < 2; ++hf) {
            bf16x8 qs[4];
#pragma unroll
            for (int dd = 0; dd < 4; ++dd) { const int d0 = hf * 4 + dd; const u32x4 w = *reinterpret_cast<const u32x4*>(&qr[d0]);
                float f[8] = {bflo(w.x), bfhi(w.x), bflo(w.y), bfhi(w.y), bflo(w.z), bfhi(w.z), bflo(w.w), bfhi(w.w)};
#pragma unroll
                for (int i = 0; i < 8; ++i) qn += f[i] * N0L[d0 * 16 + hi * 8 + i];
                u32x4 s; s.x = cvtpk(f[0] * winter, f[1] * winter); s.y = cvtpk(f[2] * winter, f[3] * winter); s.z = cvtpk(f[4] * winter, f[5] * winter); s.w = cvtpk(f[6] * winter, f[7] * winter);
                qs[dd] = *reinterpret_cast<bf16x8*>(&s); }
            pv_d0(o, S_lds + hf * 16384 + v_rd_base(lane), qs[0], qs[1], qs[2], qs[3]);
        }
    }
    rowsum = half_swap_add(rowsum);
    qn = half_swap_add(qn);
    const float den = winter * qn + rowsum;
    const float dfl = fast_exp(-(B_T[trow] + Mt));
    const float inv = 1.0f / fmaxf(fabsf(den), dfl);
    if (hi == 0) wsf[r32] = inv;
    asm volatile("s_waitcnt lgkmcnt(0)" ::: "memory");
#pragma unroll
    for (int r = 0; r < 16; ++r) { const float sc_ = wsf[crow(r, hi)];
#pragma unroll
        for (int d0 = 0; d0 < 4; ++d0) o[d0][r] *= sc_; }
    RING_WAIT_BAR(0);
    const int hst = ldsb + wid * 16384;
    { int le = lane; asm volatile("" : "+v"(le)); const int r32e = le & 31, hie = le >> 5;
#pragma unroll
    for (int r = 0; r < 16; ++r)
#pragma unroll
        for (int d0 = 0; d0 < 4; ++d0) *(LAS float*)(uintptr_t)(unsigned)(hst + crow(r, hie) * 512 + (d0 * 32 + r32e) * 4) = o[d0][r]; }
    asm volatile("s_waitcnt lgkmcnt(0)" ::: "memory");
    const float* gn = a.mlstm_norm_g + (size_t)l * 512 + h * HD;
    int le = lane; asm volatile("" : "+v"(le));
#pragma unroll
    for (int i = 0; i < 8; ++i) { const int ch = i * 64 + le, row = ch >> 4, col = (ch & 15) * 8;
        const f32x4 a0 = *(const LAS f32x4*)(uintptr_t)(unsigned)(hst + row * 512 + col * 4), a1 = *(const LAS f32x4*)(uintptr_t)(unsigned)(hst + row * 512 + col * 4 + 16);
        float ss = (a0.x * a0.x + a0.y * a0.y) + (a0.z * a0.z + a0.w * a0.w) + (a1.x * a1.x + a1.y * a1.y) + (a1.z * a1.z + a1.w * a1.w);
        ss += shx(ss, 1, le); ss += shx(ss, 2, le); ss += shx(ss, 4, le); ss += shx(ss, 8, le);
        const float rstd = fast_rsqrt(ss * (1.f / HD) + EPS);
        const int orow = row0 + wid * 32 + row;
        const u32x4 mo = mo8[i];
        const f32x4 g0 = *(const f32x4*)(gn + col), g1 = *(const f32x4*)(gn + col + 4);
        float y[8] = {a0.x * g0.x, a0.y * g0.y, a0.z * g0.z, a0.w * g0.w, a1.x * g1.x, a1.y * g1.y, a1.z * g1.z, a1.w * g1.w};
        const float mf[8] = {bflo(mo.x), bfhi(mo.x), bflo(mo.y), bfhi(mo.y), bflo(mo.z), bfhi(mo.z), bflo(mo.w), bfhi(mo.w)};
#pragma unroll
        for (int k = 0; k < 8; ++k) y[k] = y[k] * rstd * (1.0f / (1.0f + fast_exp(-mf[k])));
        u32x4 w; w.x = cvtpk(y[0], y[1]); w.y = cvtpk(y[2], y[3]); w.z = cvtpk(y[4], y[5]); w.w = cvtpk(y[6], y[7]);
        *(u32x4*)(MIX + (size_t)orow * D + 1536 + h * HD + col) = w; }
}

__device__ __forceinline__ void ms_unit(const Args& a, const Ctx& c, int l, int unit) {
    const int b = unit >> 2, h = unit & 3; int tid = c.tid; asm volatile("" : "+v"(tid));
    const int lane = tid & 63, wid = c.wave;
    const bf16* PROJ = (const bf16*)(a.ws + WS_BIG); bf16* MIX = (bf16*)(a.ws + WS_H);
    const float* GATE = (const float*)(a.ws + WS_GATE);
    constexpr int P = 132;
    LAS float* Q = (LAS float*)c.lds;
    LAS float* Kk = Q + 32 * P;
    LAS float* V = Kk + 32 * P;
    LAS float* HB = V + 32 * P;
    LAS float* S = HB + 32 * P;
    LAS float* N0 = S + 32 * 33;
    LAS float* A_S = N0 + 128;
    LAS float* M_T = A_S + 32;
    LAS float* B_T = M_T + 32;
    LAS float* WST = B_T + 32;
    LAS float* DEN = WST + 32;
    LAS float* WIN = DEN + 32;
    LAS float* SC = WIN + 32;
    const int row0 = MP + b * SSEQ;
    const size_t sidx = (size_t)(l * SBATCH + b) * MH + h;
    const float* C0 = a.state_c + sidx * HD * HD;
    __syncthreads();
    for (int i = tid; i < 1536; i += NTHREADS) { const int which = i >> 9, r = (i >> 4) & 31, c8 = (i & 15) * 8;
        const u32x4 w = *(const u32x4*)(PROJ + (size_t)(row0 + r) * NPROJ + (which == 0 ? C_MQ : which == 1 ? C_MK : C_MV) + h * HD + c8);
        const float sc = which == 1 ? 0.08838834764831845f : 1.0f;
        LAS float* dst = (which == 0 ? Q : which == 1 ? Kk : V) + r * P + c8;
        *(LAS f32x4*)dst = (f32x4){bflo(w.x) * sc, bfhi(w.x) * sc, bflo(w.y) * sc, bfhi(w.y) * sc};
        *(LAS f32x4*)(dst + 4) = (f32x4){bflo(w.z) * sc, bfhi(w.z) * sc, bflo(w.w) * sc, bfhi(w.w) * sc}; }
    if (tid < 128) N0[tid] = a.state_n[sidx * HD + tid];
    if (wid == 0) {
        const int t = lane & 31; const float m0 = a.state_m[sidx];
        const float li = GATE[(size_t)(row0 + t) * 8 + h], lf = GATE[(size_t)(row0 + t) * 8 + 4 + h];
        float bc = lf;
#pragma unroll
        for (int o = 1; o < 32; o <<= 1) { const float x = shup(bc, o, lane); if ((lane & 31) >= o) bc += x; }
        const float as = li - bc; float cm = as;
#pragma unroll
        for (int o = 1; o < 32; o <<= 1) { const float x = shup(cm, o, lane); if ((lane & 31) >= o) cm = fmaxf(cm, x); }
        const float blast = __int_as_float(__builtin_amdgcn_ds_bpermute(31 << 2, __float_as_int(bc))), amax = __int_as_float(__builtin_amdgcn_ds_bpermute(31 << 2, __float_as_int(cm)));
        const float Mt = fmaxf(m0, cm), mnew = fmaxf(blast + m0, blast + amax);
        if (lane < 32) { A_S[t] = as; B_T[t] = bc; M_T[t] = Mt; WST[t] = fast_exp(blast + as - mnew); WIN[t] = fast_exp(m0 - Mt); }
        if (lane == 0) { SC[0] = m0; SC[1] = blast; SC[2] = mnew; SC[3] = fast_exp(blast + m0 - mnew); }
    }
    __syncthreads();
    for (int i = tid; i < 1024; i += NTHREADS) { const int t = i >> 5, s = i & 31; float d = 0.f;
        if (s <= t) {
#pragma unroll 8
            for (int k = 0; k < 128; k += 4) { const f32x4 q4 = *(const LAS f32x4*)(Q + t * P + k), k4 = *(const LAS f32x4*)(Kk + s * P + k); d += (q4.x * k4.x + q4.y * k4.y) + (q4.z * k4.z + q4.w * k4.w); }
            d *= fast_exp(A_S[s] - M_T[t]); }
        S[t * 33 + s] = d; }
    __syncthreads();
    if (tid < 32) { const int t = tid; float qn = 0.f, rs = 0.f;
        for (int k = 0; k < 128; ++k) qn += Q[t * P + k] * N0[k];
        for (int s = 0; s < 32; ++s) rs += S[t * 33 + s];
        const float den = WIN[t] * qn + rs; DEN[t] = 1.0f / fmaxf(fabsf(den), fast_exp(-(B_T[t] + M_T[t]))); }
    const int e = tid & 127, tg = tid >> 7;
    { float acc[8];
#pragma unroll
      for (int i = 0; i < 8; ++i) acc[i] = 0.f;
      for (int d0 = 0; d0 < 128; d0 += 16) { float cv[16];
#pragma unroll
          for (int j = 0; j < 16; ++j) cv[j] = C0[(size_t)(d0 + j) * HD + e];
#pragma unroll
          for (int j = 0; j < 16; j += 4)
#pragma unroll
              for (int i = 0; i < 8; ++i) { const f32x4 q4 = *(const LAS f32x4*)(Q + (tg * 8 + i) * P + d0 + j); acc[i] += (q4.x * cv[j] + q4.y * cv[j + 1]) + (q4.z * cv[j + 2] + q4.w * cv[j + 3]); } }
      __syncthreads();
#pragma unroll
      for (int i = 0; i < 8; ++i) { const int t = tg * 8 + i; float v = acc[i] * WIN[t];
          for (int s = 0; s <= t; ++s) v += S[t * 33 + s] * V[s * P + e];
          HB[t * P + e] = v * DEN[t]; } }
    __syncthreads();
    { const int t = tid >> 4, e0 = (tid & 15) * 8; float ss = 0.f;
      const f32x4 h0 = *(const LAS f32x4*)(HB + t * P + e0), h1 = *(const LAS f32x4*)(HB + t * P + e0 + 4);
      ss = (h0.x * h0.x + h0.y * h0.y) + (h0.z * h0.z + h0.w * h0.w) + (h1.x * h1.x + h1.y * h1.y) + (h1.z * h1.z + h1.w * h1.w);
      ss += shx(ss, 1, lane); ss += shx(ss, 2, lane); ss += shx(ss, 4, lane); ss += shx(ss, 8, lane);
      const float rstd = fast_rsqrt(ss * (1.f / HD) + EPS);
      const u32x4 mo = *(const u32x4*)(PROJ + (size_t)(row0 + t) * NPROJ + C_MO + h * HD + e0);
      const float* gn = a.mlstm_norm_g + (size_t)l * 512 + h * HD + e0;
      const f32x4 g0 = *(const f32x4*)gn, g1 = *(const f32x4*)(gn + 4);
      float y[8] = {h0.x * g0.x, h0.y * g0.y, h0.z * g0.z, h0.w * g0.w, h1.x * g1.x, h1.y * g1.y, h1.z * g1.z, h1.w * g1.w};
      const float mf[8] = {bflo(mo.x), bfhi(mo.x), bflo(mo.y), bfhi(mo.y), bflo(mo.z), bfhi(mo.z), bflo(mo.w), bfhi(mo.w)};
#pragma unroll
      for (int k = 0; k < 8; ++k) y[k] = y[k] * rstd * (1.0f / (1.0f + fast_exp(-mf[k])));
      u32x4 w; w.x = cvtpk(y[0], y[1]); w.y = cvtpk(y[2], y[3]); w.z = cvtpk(y[4], y[5]); w.w = cvtpk(y[6], y[7]);
      *(u32x4*)(MIX + (size_t)(row0 + t) * D + 1536 + h * HD + e0) = w; }
    { const float decay = SC[3]; const int dg = tg * 32; float acc[32];
#pragma unroll
      for (int i = 0; i < 32; ++i) acc[i] = C0[(size_t)(dg + i) * HD + e] * decay;
      for (int s = 0; s < 32; ++s) { const float vv = V[s * P + e] * WST[s];
#pragma unroll
          for (int i = 0; i < 32; i += 4) { const f32x4 k4 = *(const LAS f32x4*)(Kk + s * P + dg + i); acc[i] += k4.x * vv; acc[i + 1] += k4.y * vv; acc[i + 2] += k4.z * vv; acc[i + 3] += k4.w * vv; } }
      float* oc = a.out + O_SC + sidx * HD * HD;
#pragma unroll
      for (int i = 0; i < 32; ++i) oc[(size_t)(dg + i) * HD + e] = acc[i];
      if (tid < 128) { float v = decay * N0[tid]; for (int s = 0; s < 32; ++s) v += WST[s] * Kk[s * P + tid]; a.out[O_SN + sidx * HD + tid] = v; }
      if (tid == 0) a.out[O_SM + sidx] = SC[2]; }
}

__device__ __forceinline__ void phase_e(const Args& a, const Ctx& c_in0, int l) {
    const Ctx c = relaunder(c_in0);
    const bf16* PROJ = (const bf16*)(a.ws + WS_BIG); bf16* MIX = (bf16*)(a.ws + WS_H);
    constexpr int NATT = NB * NH * 32;
#if (PE_EN & 1)
    const bool hasjob = l + 1 < DEPTH;
    const ConvJob job{a.w_in, a.w_out, a.w_up, a.w_down, a.norm_mix_g, a.norm_mlp_g, a.ws, l + 1, c.vcu * NWAVES + c.wave, c.G * NWAVES}; int cvk = 0;
    if (hasjob) {
        __syncthreads();
        *(LAS f32x4*)(c.lds + GT0_OFF + c.tid * 16) = *(const f32x4*)(a.norm_mix_g + (size_t)(l + 1) * D + c.tid * 4);
        *(LAS f32x4*)(c.lds + GT1_OFF + c.tid * 16) = *(const f32x4*)(a.norm_mlp_g + (size_t)(l + 1) * D + c.tid * 4);
    }
    float Mref;
    { const float* gq_ = a.q_norm_g + l * HD; const float* gk_ = a.k_norm_g + l * HD; const float* bs_ = a.rel_bias + (size_t)(l * NH + ((c.vcu >> 5) & 7)) * 257;
      float gqm = fmaxf(fabsf(gq_[c.lane]), fabsf(gq_[c.lane + 64])), gkm = fmaxf(fabsf(gk_[c.lane]), fabsf(gk_[c.lane + 64]));
      float bm = fmaxf(fmaxf(bs_[c.lane], bs_[c.lane + 64]), fmaxf(bs_[c.lane + 128], bs_[c.lane + 192])); bm = fmaxf(bm, bs_[256]);
#pragma unroll
      for (int o_ = 1; o_ < 64; o_ <<= 1) { gqm = fmaxf(gqm, shx(gqm, o_, c.lane)); gkm = fmaxf(gkm, shx(gkm, o_, c.lane)); bm = fmaxf(bm, shx(bm, o_, c.lane)); }
      Mref = 16.5f * gqm * gkm + bm * LOG2E; }
    if ((c.G & 255) == 0 && Mref <= 100.f) attn_stream(a, c, l, Mref, hasjob, job, cvk);
    else
    for (int u = c.vcu; u < NATT; u += c.G) {
        const int gq = u & 31, bhh = u >> 5, b = bhh >> 3, h = bhh & 7;
        const int c0 = 4 * gq, jstart = c0 >= 8 ? 0 : 8 - c0, NT = 12 - jstart, ci = c.wave >> 1;
        const int krow0 = b * SEQ + (c0 - 8 + jstart) * 64;
        const int alo = ci - jstart, ahi = ci + 8 - jstart;
        const int R0 = (ci + 8 - jstart) * 64 + (c.wave & 1) * 32;
        attn_unit(c, PROJ + (size_t)(b * SEQ + c0 * 64) * NPROJ + C_Q + h * HD, NPROJ, c.wave * 32, PROJ + (size_t)krow0 * NPROJ + C_K + h * HD, PROJ + (size_t)krow0 * NPROJ + C_V + h * HD, NPROJ,
                  NT, alo < 0 ? 0 : alo, ahi, NT * 64, R0, a.rel_bias + (size_t)(l * NH + h) * 257, MIX + (size_t)(b * SEQ + c0 * 64) * D + 512 + h * HD, D, true, nullptr,
                  gq >= 2 ? (8 * gq + 8) % 12 : 0);
    }
    if (hasjob) { while (conv_step(job, cvk, c.lane, c.lds)) {} }
#endif
#if (PE_EN & 4)
    for (int u = c.vcu; u < 16 * NGRP; u += c.G) m3_unit(a, c, l, u);
#endif
}
__device__ __forceinline__ void sample_kv_prep(const Args& a, const Ctx& c, int l, int b, int h) {
    int tid = c.tid; asm volatile("" : "+v"(tid));
    const int lane = tid & 63, row = tid >> 4, c8 = (tid & 15) * 8;
    const bf16* PROJ = (const bf16*)(a.ws + WS_BIG);
    bf16* SK = (bf16*)(a.ws + WS_SK + (size_t)(l & 1) * SKV_IMG); bf16* SV = (bf16*)(a.ws + WS_SV + (size_t)(l & 1) * SKV_IMG);
    const size_t ro = (size_t)(MP + b * SSEQ + row) * NPROJ + h * HD + c8;
    const u32x4 kq = *(const u32x4*)(PROJ + ro + C_K), vq = *(const u32x4*)(PROJ + ro + C_V);
    float x[8] = {bflo(kq.x), bfhi(kq.x), bflo(kq.y), bfhi(kq.y), bflo(kq.z), bfhi(kq.z), bflo(kq.w), bfhi(kq.w)};
    float ss = 0.f;
#pragma unroll
    for (int i = 0; i < 8; ++i) ss += x[i] * x[i];
    ss += shx(ss, 1, lane); ss += shx(ss, 2, lane); ss += shx(ss, 4, lane); ss += shx(ss, 8, lane);
    const float rk = fast_rsqrt(ss * (1.f / HD) + EPS);
    const float* gk = a.k_norm_g + l * HD + c8; const f32x4 g0 = *(const f32x4*)gk, g1 = *(const f32x4*)(gk + 4);
    x[0] *= rk * g0[0]; x[1] *= rk * g0[1]; x[2] *= rk * g0[2]; x[3] *= rk * g0[3]; x[4] *= rk * g1[0]; x[5] *= rk * g1[1]; x[6] *= rk * g1[2]; x[7] *= rk * g1[3];
    u32x4 o; o.x = cvtpk(x[0], x[1]); o.y = cvtpk(x[2], x[3]); o.z = cvtpk(x[4], x[5]); o.w = cvtpk(x[6], x[7]);
    const size_t io = ((size_t)b * SKV_ROWS + 512 + row) * 1024 + h * HD + c8;
    *(u32x4*)(SK + io) = o; *(u32x4*)(SV + io) = vq;
    const size_t oo = ((size_t)(l * SBATCH + b) * SSEQ + row) * 1024 + h * HD + c8;
    float* ok = a.out + O_SK + oo; float* ov = a.out + O_SV + oo;
    *(f32x4*)ok = (f32x4){x[0], x[1], x[2], x[3]}; *(f32x4*)(ok + 4) = (f32x4){x[4], x[5], x[6], x[7]};
    *(f32x4*)ov = (f32x4){bflo(vq.x), bfhi(vq.x), bflo(vq.y), bfhi(vq.y)}; *(f32x4*)(ov + 4) = (f32x4){bflo(vq.z), bfhi(vq.z), bflo(vq.w), bfhi(vq.w)};
    asm volatile("s_waitcnt vmcnt(0)" ::: "memory"); __syncthreads();
}
__device__ __forceinline__ void sample_mixers(const Args& a, const Ctx& c, int l) {
    const bf16* PROJ = (const bf16*)(a.ws + WS_BIG); bf16* MIX = (bf16*)(a.ws + WS_H);
#if (PE_EN & 2)
    for (int su = c.vcu; su < SBATCH * NH; su += c.G) {
        const int b = su >> 3, h = su & 7;
        sample_kv_prep(a, c, l, b, h);
        const bf16* SK = (const bf16*)(a.ws + WS_SK + (size_t)(l & 1) * SKV_IMG) + (size_t)b * SKV_ROWS * 1024 + h * HD; const bf16* SV = (const bf16*)(a.ws + WS_SV + (size_t)(l & 1) * SKV_IMG) + (size_t)b * SKV_ROWS * 1024 + h * HD;
        attn_unit(c, PROJ + (size_t)(MP + b * SSEQ) * NPROJ + C_Q + h * HD, NPROJ, 0, SK, SV, 1024, 9, 0, 8, 544, 512, a.rel_bias + (size_t)(l * NH + h) * 257,
                  MIX + (size_t)(MP + b * SSEQ) * D + 512 + h * HD, D, c.wave == 0, a.q_norm_g + l * HD);
    }
#endif
#if (PE_EN & 8)
    for (int u = c.vcu - SBATCH * NH; u >= 0 && u < SBATCH * MH; u += c.G) ms_unit(a, c, l, u);
#endif
    __syncthreads();
}
typedef const __attribute__((address_space(4))) Args* KArgP;
#if defined(__HIP_DEVICE_COMPILE__)
__device__ __forceinline__ Args get_args() { KArgP p = (KArgP)__builtin_amdgcn_kernarg_segment_ptr(); asm volatile("" : "+s"(p)); return *p; }
#else
__device__ Args get_args();
#endif
__global__ void __launch_bounds__(NTHREADS, 2) fwd(Args args) {
    extern __shared__ __attribute__((aligned(16))) unsigned char lds_raw[];
    Ctx c; c.lds = (LAS unsigned char*)lds_raw; c.wave = __builtin_amdgcn_readfirstlane((int)threadIdx.x >> 6); c.tid = hw_tid(c.wave); c.lane = c.tid & 63;
    c.G = gridDim.x; { const int bx = blockIdx.x; c.vcu = (c.G % 8 == 0) ? (bx % 8) * (c.G / 8) + bx / 8 : bx; }
    volatile LAS unsigned* MISC = (volatile LAS unsigned*)(c.lds + MISC_OFF);
    { const int t0 = hw_tid(c.wave); if (t0 < 16) MISC[t0] = 0u; }
    __syncthreads();
    unsigned* barw = (unsigned*)(get_args().ws + WS_CTL) + 4096;
    XcdBarrier bar; bar.bar = barw; bar.x = 0; bar.st = nullptr;
    const int lo = args.ph_lo, hi = args.ph_hi;
    const bool multi = (hi - lo) > 1;
    if (multi) bar = xcd_barrier_post(barw, MISC + 8, hw_tid(c.wave) == 0);
#define IN(k) (lo <= (k) && (k) < hi)
#define SEAM(k) do { if (IN(k) && IN((k) + 1)) xcd_barrier(bar.bar, bar.x, bar.st, c.wave); } while (0)
    for (int l = 0; l < DEPTH; ++l) {
        const int pb = l * NPH_LAYER;
        if (IN(pb + 0)) {
#if (PH_EN >> 1) & 1
            { const Args A_ = get_args(); phase_norm<true>(A_, c, l); }
#if (PH_DUP >> 1) & 1
            { __syncthreads(); const Args A_ = get_args(); phase_norm<true>(A_, c, l); }
#endif
#endif
 __syncthreads(); SEAM(pb + 0); }
        if (IN(pb + 1)) {
            const Args A_ = get_args(); bf16* H = (bf16*)(A_.ws + WS_H); bf16* BIG = (bf16*)(A_.ws + WS_BIG);
            bf16* XBp = (bf16*)(A_.ws + WS_XB); const float* RS = (const float*)(A_.ws + WS_RSTD);
            pg8::Gemm g{XBp, (const bf16*)(A_.ws + WS_WIN + (size_t)(l & 1) * WSET), MP, NPROJ, D}; pg8::StaticOrder S; S.init(MP, NPROJ, c.G, (int)blockIdx.x, WGM_B);
            pg8::EpiProj E{BIG, NPROJ, A_.q_norm_g + l * HD, A_.k_norm_g + l * HD, (LAS float*)(c.lds + SCR_OFF), RS};

#if (PH_EN >> 2) & 1
            for (int rep_ = 0, nrep_ = ((PH_DUP >> 2) & 1) ? A_.rep : 1; rep_ < nrep_; ++rep_) pg8::gemm_phase<pg8::EpiProj, pg8::StaticOrder, true, true>(c.lds, g, S, E, c.wave);
            { SEpiBf16 SE{BIG + (size_t)MP * NPROJ, NPROJ, 0, RS + MP}; sample_gemm(c.lds, c.wave, c.vcu, c.G, XBp + (size_t)MP * D, g.Bt, NPROJ, D, SE); }
#endif

            SEAM(pb + 1);
        }
        if (IN(pb + 2)) {
#if (PH_EN >> 3) & 1
            { const Args A_ = get_args(); phase_c<true>(A_, c, l); }
#if (PH_DUP >> 3) & 1
            { __syncthreads(); const Args A_ = get_args(); phase_c<false>(A_, c, l); }
#endif
#endif
 SEAM(pb + 2); }
        if (IN(pb + 3)) {
#if (PH_EN >> 4) & 1
            { const Args A_ = get_args(); phase_d(A_, c, l); }
            { const Args A_ = get_args(); if (l + 1 < DEPTH) build_kv_image(A_, c.vcu, c.G, hw_tid(c.wave), l + 1); }
#if (PH_DUP >> 4) & 1
            { __syncthreads(); const Args A_ = get_args(); phase_d(A_, c, l); }
#endif
#endif
 SEAM(pb + 3); }
        if (IN(pb + 4)) {
#if (PH_EN >> 5) & 1
            { const Args A_ = get_args(); phase_e(A_, c, l); }
#if (PH_DUP >> 5) & 1
            { __syncthreads(); const Args A_ = get_args(); phase_e(A_, c, l); }
#endif
#endif
 __syncthreads(); SEAM(pb + 4); }
        if (IN(pb + 5)) {
            const Args A_ = get_args(); bf16* H = (bf16*)(A_.ws + WS_H);
            pg8::Gemm g{H, (const bf16*)(A_.ws + WS_WOUT + (size_t)(l & 1) * WSET), MP, D, D}; pg8::StaticOrder S; S.init(MP, D, c.G, (int)blockIdx.x, WGM_F);
            pg8::EpiResAdd E{(bf16*)(A_.ws + WS_XB), A_.out, D, false};

#if (PH_EN >> 6) & 1
            pg8::gemm_phase<pg8::EpiResAdd, pg8::StaticOrder, true, true>(c.lds, g, S, E, c.wave);
            { SEpiResAdd SE{(bf16*)(A_.ws + WS_XB) + (size_t)MP * D, A_.out + (size_t)MP * D, D, false}; sample_gemm<SEpiResAdd, 32>(c.lds, c.wave, c.vcu, c.G, H + (size_t)MP * D, g.Bt, D, D, SE); }
#if (PH_DUP >> 6) & 1
            { pg8::EpiBf16<0> E2{(bf16*)(A_.ws + WS_BIG), D, nullptr, (LAS float*)(c.lds + SCR_OFF)}; pg8::gemm_phase<pg8::EpiBf16<0>, pg8::StaticOrder, true, true>(c.lds, g, S, E2, c.wave); }
#endif
#endif

            SEAM(pb + 5);
        }
        if (IN(pb + 6)) {
#if (PH_EN >> 7) & 1
            { const Args A_ = get_args(); phase_norm<false>(A_, c, l); }
#if (PH_DUP >> 7) & 1
            { __syncthreads(); const Args A_ = get_args(); phase_norm<false>(A_, c, l); }
#endif
#endif
 SEAM(pb + 6); }
        if (IN(pb + 7)) {
            const Args A_ = get_args(); bf16* H = (bf16*)(A_.ws + WS_H); bf16* BIG = (bf16*)(A_.ws + WS_BIG);
            bf16* XBp = (bf16*)(A_.ws + WS_XB); const float* RS = (const float*)(A_.ws + WS_RSTD);
            pg8::Gemm g{XBp, (const bf16*)(A_.ws + WS_WUP + (size_t)(l & 1) * WSET), MP, FF, D}; pg8::StaticOrder S; S.init(MP, FF, c.G, (int)blockIdx.x, WGM_H);
            pg8::EpiBf16<1> E{BIG, FF, RS, (LAS float*)(c.lds + SCR_OFF)};

#if (PH_EN >> 8) & 1
            for (int rep_ = 0, nrep_ = ((PH_DUP >> 8) & 1) ? A_.rep : 1; rep_ < nrep_; ++rep_) pg8::gemm_phase<pg8::EpiBf16<1>, pg8::StaticOrder, true, true>(c.lds, g, S, E, c.wave);
            { SEpiBf16 SE{BIG + (size_t)MP * FF, FF, 1, RS + MP}; sample_gemm(c.lds, c.wave, c.vcu, c.G, XBp + (size_t)MP * D, g.Bt, FF, D, SE); }
#endif

            SEAM(pb + 7);
        }
        if (IN(pb + 8)) {
            const Args A_ = get_args(); bf16* BIG = (bf16*)(A_.ws + WS_BIG);
            pg8::Gemm g{BIG, (const bf16*)(A_.ws + WS_WDN + (size_t)(l & 1) * WSET), MP, D, FF}; pg8::StaticOrder S; S.init(MP, D, c.G, (int)blockIdx.x, WGM_I);
            pg8::EpiResAdd E{(bf16*)(A_.ws + WS_XB), A_.out, D, l == DEPTH - 1};

#if (PH_EN >> 9) & 1
            pg8::gemm_phase<pg8::EpiResAdd, pg8::StaticOrder, true, true>(c.lds, g, S, E, c.wave);
            { SEpiResAdd SE{(bf16*)(A_.ws + WS_XB) + (size_t)MP * D, A_.out + (size_t)MP * D, D, l == DEPTH - 1}; sample_gemm<SEpiResAdd, 32>(c.lds, c.wave, c.vcu, c.G, BIG + (size_t)MP * FF, g.Bt, D, FF, SE); }
#if (PH_DUP >> 9) & 1
            { pg8::EpiBf16<0> E2{(bf16*)(A_.ws + WS_H), D, nullptr, (LAS float*)(c.lds + SCR_OFF)}; pg8::gemm_phase<pg8::EpiBf16<0>, pg8::StaticOrder, true, true>(c.lds, g, S, E2, c.wave); }
#endif
#endif

            SEAM(pb + 8);
        }
    }
#undef IN
#undef SEAM
}

extern "C" void kernel_launch(void* const* d_in, const int* in_sizes, int n_in, void* d_out, int out_size, void* d_ws, size_t ws_size, hipStream_t stream) {
    static int grid = 0;
    if (grid == 0) {
        if (n_in != 21 || (size_t)out_size != O_END || ws_size < WS_END) { fprintf(stderr, "kernel_launch: shape mismatch n_in %d out %d ws %zu (need %zu)\n", n_in, out_size, ws_size, (size_t)WS_END); grid = -1; return; }
        int dev = 0, cus = 0, per_cu = 0;
        if (hipGetDevice(&dev) != hipSuccess || hipDeviceGetAttribute(&cus, hipDeviceAttributeMultiprocessorCount, dev) != hipSuccess) { grid = -1; return; }
        if (hipFuncSetAttribute((const void*)fwd, hipFuncAttributeMaxDynamicSharedMemorySize, LDS_BYTES) != hipSuccess) { fprintf(stderr, "kernel_launch: hipFuncSetAttribute failed\n"); grid = -1; return; }
        if (hipOccupancyMaxActiveBlocksPerMultiprocessor(&per_cu, (const void*)fwd, NTHREADS, LDS_BYTES) != hipSuccess || per_cu < 1) { fprintf(stderr, "kernel_launch: occupancy query says %d\n", per_cu); }
        (void)hipGetLastError();
        grid = cus;
    }
    if (grid < 0) return;
    (void)hipMemsetAsync((char*)d_ws + WS_CTL, 0, CTL_BYTES, stream);
    Args a{};
    a.x_prompt = (const float*)d_in[0]; a.x_sample = (const float*)d_in[1]; a.cache_k = (const float*)d_in[2]; a.cache_v = (const float*)d_in[3]; a.state_conv = (const float*)d_in[4];
    a.state_c = (const float*)d_in[5]; a.state_n = (const float*)d_in[6]; a.state_m = (const float*)d_in[7]; a.norm_mix_g = (const float*)d_in[8]; a.w_in = (const float*)d_in[9];
    a.conv_w = (const float*)d_in[10]; a.q_norm_g = (const float*)d_in[11]; a.k_norm_g = (const float*)d_in[12]; a.rel_bias = (const float*)d_in[13]; a.b_igate = (const float*)d_in[14];
    a.b_fgate = (const float*)d_in[15]; a.mlstm_norm_g = (const float*)d_in[16]; a.w_out = (const float*)d_in[17]; a.norm_mlp_g = (const float*)d_in[18]; a.w_up = (const float*)d_in[19];
    a.w_down = (const float*)d_in[20]; a.out = (float*)d_out; a.ws = (unsigned char*)d_ws;
#if MK_PER_PHASE
    for (int p = 0; p < NPHASES; ++p) { a.ph_lo = p; a.ph_hi = p + 1; a.rep = 2; hipLaunchKernelGGL(fwd, dim3(grid), dim3(NTHREADS), LDS_BYTES, stream, a); }
#else
    a.ph_lo = 0; a.ph_hi = NPHASES; a.rep = 2; hipLaunchKernelGGL(fwd, dim3(grid), dim3(NTHREADS), LDS_BYTES, stream, a);
#endif
    const hipError_t le = hipPeekAtLastError();
    if (le != hipSuccess) fprintf(stderr, "kernel_launch: launch failed: %s\n", hipGetErrorName(le));
}
```

```cpp
#include <hip/hip_runtime.h>
#include <cstdio>
#include <cstdint>

#ifndef MK_PER_PHASE
#define MK_PER_PHASE 0
#endif

#ifndef PH_EN
#define PH_EN 0x3ff
#endif
#ifndef PE_EN
#define PE_EN 0xf
#endif
#ifndef WGM_B
#define WGM_B 4
#endif
#ifndef WGM_F
#define WGM_F 4
#endif
#ifndef WGM_H
#define WGM_H 4
#endif
#ifndef WGM_I
#define WGM_I 4
#endif
#ifndef PH_DUP
#define PH_DUP 0
#endif
#define LAS __attribute__((address_space(3)))
#define GAS __attribute__((address_space(1)))
typedef unsigned short bf16;
typedef short bf16x8 __attribute__((ext_vector_type(8)));
typedef short s16x4 __attribute__((ext_vector_type(4)));
typedef float f32x2 __attribute__((ext_vector_type(2)));
typedef float f32x4 __attribute__((ext_vector_type(4)));
typedef float f32x16 __attribute__((ext_vector_type(16)));
typedef unsigned u32x2 __attribute__((ext_vector_type(2)));
typedef unsigned u32x4 __attribute__((ext_vector_type(4)));

constexpr int D = 2048, NB = 4, SEQ = 8192, DEPTH = 4, SBATCH = 8, SSEQ = 32;
constexpr int MP = NB * SEQ, MS = SBATCH * SSEQ, MR = MP + MS;
constexpr int NH = 8, HD = 128, MH = 4;
constexpr int NPROJ = 6656, IN_DIM = 6664, FF = 8192;
constexpr int C_XA = 0, C_GB = 512, C_GC = 1024, C_Q = 1536, C_K = 2560, C_V = 3584, C_MQ = 4608, C_MK = 5120, C_MV = 5632, C_MO = 6144;
constexpr int KEEP = 512;
constexpr int SKV_ROWS = 640;
constexpr float EPS = 1e-6f;
constexpr float LOG2E = 1.4426950408889634f;
constexpr int NGRP = SEQ / 256;

constexpr size_t O_YP = 0, O_YS = O_YP + (size_t)MP * D, O_PCONV = O_YS + (size_t)MS * D, O_PK = O_PCONV + (size_t)DEPTH * NB * 2 * 512,
                 O_PV = O_PK + (size_t)DEPTH * NB * KEEP * 1024, O_PC = O_PV + (size_t)DEPTH * NB * KEEP * 1024, O_PN = O_PC + (size_t)DEPTH * NB * MH * HD * HD,
                 O_PM = O_PN + (size_t)DEPTH * NB * MH * HD, O_SCONV = O_PM + (size_t)DEPTH * NB * MH, O_SK = O_SCONV + (size_t)DEPTH * SBATCH * 2 * 512,
                 O_SV = O_SK + (size_t)DEPTH * SBATCH * SSEQ * 1024, O_SC = O_SV + (size_t)DEPTH * SBATCH * SSEQ * 1024, O_SN = O_SC + (size_t)DEPTH * SBATCH * MH * HD * HD,
                 O_SM = O_SN + (size_t)DEPTH * SBATCH * MH * HD, O_END = O_SM + (size_t)DEPTH * SBATCH * MH;

constexpr size_t al256(size_t x) { return (x + 255) / 256 * 256; }
constexpr size_t WS_CTL = 0, CTL_BYTES = 1u << 20;
constexpr size_t WSET = ((size_t)NPROJ * D + (size_t)D * D + (size_t)FF * D + (size_t)D * FF) * 2;
constexpr size_t WS_WIN = CTL_BYTES;
constexpr size_t WS_WOUT = WS_WIN + (size_t)NPROJ * D * 2;
constexpr size_t WS_WUP = WS_WOUT + (size_t)D * D * 2;
constexpr size_t WS_WDN = WS_WUP + (size_t)FF * D * 2;
constexpr size_t WS_H = WS_WIN + 2 * WSET;
constexpr size_t WS_XB = WS_H + (size_t)MR * D * 2;
constexpr size_t WS_BIG = WS_XB + (size_t)MR * D * 2;
constexpr size_t BIG_BYTES = (size_t)MR * FF * 2;
constexpr size_t WS_CLOC = WS_BIG + al256((size_t)MR * NPROJ * 2);
constexpr size_t WS_C0 = WS_CLOC + (size_t)16 * NGRP * HD * HD * 4;
constexpr size_t WS_NLOC = WS_C0 + (size_t)16 * NGRP * HD * HD * 2;
constexpr size_t WS_N0 = WS_NLOC + (size_t)16 * NGRP * HD * 4;
constexpr size_t WS_MSC = WS_N0 + (size_t)16 * NGRP * HD * 4;
constexpr size_t WS_MIX_END = WS_MSC + (size_t)16 * NGRP * 4 * 4;
static_assert(WS_MIX_END <= WS_BIG + BIG_BYTES, "mLSTM scratch fits in the free top of BIG");
constexpr size_t WS_GATE = WS_BIG + BIG_BYTES;
constexpr size_t SKV_IMG = (size_t)SBATCH * SKV_ROWS * 1024 * 2;
constexpr size_t WS_SK = WS_GATE + (size_t)MR * 8 * 4;
constexpr size_t WS_SV = WS_SK + 2 * SKV_IMG;
constexpr size_t WS_RSTD = WS_SV + 2 * SKV_IMG;
constexpr size_t WS_END = WS_RSTD + (size_t)MR * 4;
static_assert(WS_END <= 1235000000ull, "workspace budget");

constexpr int RING_BYTES = 131072;
constexpr int MISC_OFF = RING_BYTES;
constexpr int SCR_OFF = MISC_OFF + 256;
constexpr int LDS_BYTES = 147456;
constexpr int NWAVES = 8, NTHREADS = 512;

__device__ __forceinline__ unsigned cvtpk(float lo, float hi) { unsigned r; asm volatile("v_cvt_pk_bf16_f32 %0, %1, %2" : "=v"(r) : "v"(lo), "v"(hi)); return r; }
__device__ __forceinline__ float bflo(unsigned w) { return __uint_as_float(w << 16); }
__device__ __forceinline__ float bfhi(unsigned w) { return __uint_as_float(w & 0xffff0000u); }
__device__ __forceinline__ float bf2f(bf16 b) { return __uint_as_float(((unsigned)b) << 16); }
__device__ __forceinline__ float shx(float v, int o, int lane) { return __int_as_float(__builtin_amdgcn_ds_bpermute((lane ^ o) << 2, __float_as_int(v))); }
__device__ __forceinline__ float shup(float v, int o, int lane) { const int s = lane - o; return __int_as_float(__builtin_amdgcn_ds_bpermute((s < 0 ? lane : s) << 2, __float_as_int(v))); }
__device__ __forceinline__ float wave_sum(float v, int lane) {
#pragma unroll
    for (int o = 1; o < 64; o <<= 1) v += shx(v, o, lane);
    return v;
}
__device__ __forceinline__ float fast_rsqrt(float x) { return __builtin_amdgcn_rsqf(x); }
__device__ __forceinline__ float fast_exp(float x) { return __builtin_amdgcn_exp2f(x * 1.4426950408889634f); }
__device__ __forceinline__ float fast_log(float x) { return __builtin_amdgcn_logf(x) * 0.6931471805599453f; }
__device__ __forceinline__ float opaque_zero() { float z; asm volatile("v_mov_b32 %0, 0" : "=v"(z)); return z; }
#define LDS_WAIT() asm volatile("s_waitcnt lgkmcnt(0)" ::: "memory")
#define VM_WAIT() asm volatile("s_waitcnt vmcnt(0)" ::: "memory")
#define SBAR() __builtin_amdgcn_sched_barrier(0)

namespace pg8 {
typedef unsigned short bf16_t;
constexpr int BM = 256, BK = 64, HALF = 128, HTB = HALF * BK * 2, STAGE_BYTES = 8 * HTB, NXCD = 8, WGM = 4;
__host__ __device__ __forceinline__ int lds_byte(int r, int c) { const int st = (r >> 4) * 2 + (c >> 5), rr = r & 15, cc = c & 31, ob = rr * 64 + cc * 2; return st * 1024 + (ob ^ (((ob >> 9) & 1) << 5)); }
__host__ __device__ __forceinline__ void stage_rc(int b, int& R, int& C) { const int st = b / 1024, sb = b % 1024, swz = sb ^ (((sb >> 9) & 1) << 5); R = (st >> 1) * 16 + swz / 64; C = (st & 1) * 32 + (swz % 64) / 2; }
__host__ __device__ __forceinline__ int perm32(int rho) { const int n = rho >> 4, i = rho & 15; return 8 * (i >> 2) + 4 * n + (i & 3); }
struct Unit { int pm, pn; };
struct Gemm { const bf16_t* A; const bf16_t* Bt; int M, N, K; };
struct StaticOrder {
    int nM, nN, nwg, G, c, wgm;
    __host__ __device__ void init(int M, int N, int G_, int c_, int wgm_ = WGM) { nM = M / BM; nN = N / BM; nwg = nM * nN; G = G_; c = c_; wgm = wgm_; }
    __host__ __device__ bool next(int i, Unit& u) const {
        const long L = (long)i * G + c; if (L >= nwg) return false;
        int wgid = (int)L; { const int q = nwg / NXCD, r = nwg % NXCD, xcd = wgid % NXCD, off = wgid / NXCD; wgid = (xcd < r ? xcd * (q + 1) : r * (q + 1) + (xcd - r) * q) + off; }
        const int nig = wgm * nN, gid = wgid / nig, fm = gid * wgm, gsz = (nM - fm) < wgm ? (nM - fm) : wgm;
        u.pm = fm + ((wgid % nig) % gsz); u.pn = (wgid % nig) / gsz; return true;
    }
    __device__ __forceinline__ void a_ready(const Unit&) const {}
    __device__ __forceinline__ void done(const Unit&) const {}
};
template <int ACT  > struct EpiBf16 {
    static constexpr bool PERM = true, AFTER_DRAIN = false;
    static constexpr bool RSL = true;
    bf16_t* O; int ldc; const float* rstd; LAS float* T;
    __device__ __forceinline__ void rs_fetch(const Unit& u, int tid, int par) const { if (rstd && tid < BM) (T + 2048 + par * BM)[tid] = rstd[u.pm * BM + tid]; }
    __device__ __forceinline__ void operator()(const f32x4 (&acc)[2][2][4][2], const Unit& u, int wr, int wc, int fr, int fq, int par) const {
        const int row0 = u.pm * BM + wr * 64 + fr; const int col0 = u.pn * BM + wc * 32 + 8 * fq;
#pragma unroll
        for (int ai = 0; ai < 2; ++ai)
#pragma unroll
            for (int m = 0; m < 4; ++m) { bf16_t* rowp = O + (size_t)(row0 + ai * HALF + m * 16) * ldc + col0; const float rsv = rstd ? (T + 2048 + par * BM)[wr * 64 + fr + ai * HALF + m * 16] : 1.0f;
#pragma unroll
                for (int bj = 0; bj < 2; ++bj) { f32x4 v0 = acc[ai][bj][m][0] * rsv, v1 = acc[ai][bj][m][1] * rsv;
                    if (ACT == 1) {
#pragma unroll
                        for (int j = 0; j < 4; ++j) { const float a = fmaxf(v0[j], 0.f), b = fmaxf(v1[j], 0.f); v0[j] = a * a; v1[j] = b * b; } }
                    u32x4 w; w.x = cvtpk(v0[0], v0[1]); w.y = cvtpk(v0[2], v0[3]); w.z = cvtpk(v1[0], v1[1]); w.w = cvtpk(v1[2], v1[3]);
                    *(u32x4*)(rowp + bj * HALF) = w; } }
    }
};
struct EpiProj {
    static constexpr bool PERM = true, AFTER_DRAIN = false;
    static constexpr bool RSL = true;
    bf16_t* O; int ldc; const float* gq; const float* gk; LAS float* T; const float* rstd;
    __device__ __forceinline__ void rs_fetch(const Unit& u, int tid, int par) const { if (tid < BM) (T + 2048 + par * BM)[tid] = rstd[u.pm * BM + tid]; }
    __device__ __forceinline__ void operator()(const f32x4 (&acc)[2][2][4][2], const Unit& u, int wr, int wc, int fr, int fq, int par) const {
        const int row0 = u.pm * BM + wr * 64 + fr; const int col0 = u.pn * BM + wc * 32 + 8 * fq;
        const bool isqk = (u.pn >= 6) && (u.pn < 14);
        float rs[2][4];
#pragma unroll
        for (int ai = 0; ai < 2; ++ai)
#pragma unroll
            for (int m = 0; m < 4; ++m) rs[ai][m] = (T + 2048 + par * BM)[wr * 64 + fr + ai * HALF + m * 16];
        if (!isqk) {
#pragma unroll
            for (int ai = 0; ai < 2; ++ai)
#pragma unroll
                for (int m = 0; m < 4; ++m) { bf16_t* rowp = O + (size_t)(row0 + ai * HALF + m * 16) * ldc + col0;
#pragma unroll
                    for (int bj = 0; bj < 2; ++bj) { const f32x4 v0 = acc[ai][bj][m][0] * rs[ai][m], v1 = acc[ai][bj][m][1] * rs[ai][m];
                        u32x4 w; w.x = cvtpk(v0[0], v0[1]); w.y = cvtpk(v0[2], v0[3]); w.z = cvtpk(v1[0], v1[1]); w.w = cvtpk(v1[2], v1[3]);
                        *(u32x4*)(rowp + bj * HALF) = w; } }
            return;
        }
        const int lane = fr + 16 * fq;
        float ss[2][4][2];
#pragma unroll
        for (int ai = 0; ai < 2; ++ai)
#pragma unroll
            for (int m = 0; m < 4; ++m)
#pragma unroll
                for (int bj = 0; bj < 2; ++bj) { const f32x4 v0 = acc[ai][bj][m][0] * rs[ai][m], v1 = acc[ai][bj][m][1] * rs[ai][m];
                    float s = (v0[0] * v0[0] + v0[1] * v0[1]) + (v0[2] * v0[2] + v0[3] * v0[3]) + (v1[0] * v1[0] + v1[1] * v1[1]) + (v1[2] * v1[2] + v1[3] * v1[3]);
                    s += shx(s, 16, lane); s += shx(s, 32, lane); ss[ai][m][bj] = s; }
        if (fq == 0) {
#pragma unroll
            for (int ai = 0; ai < 2; ++ai)
#pragma unroll
                for (int m = 0; m < 4; ++m)
#pragma unroll
                    for (int bj = 0; bj < 2; ++bj) T[(ai * HALF + wr * 64 + m * 16 + fr) * 8 + bj * 4 + wc] = ss[ai][m][bj];
        }
        asm volatile("s_waitcnt lgkmcnt(0)" ::: "memory"); __builtin_amdgcn_s_barrier(); asm volatile("" ::: "memory");
        const float* gg = ((u.pn < 10) ? gq : gk) + wc * 32 + 8 * fq;
        const f32x4 g0 = *(const f32x4*)gg, g1 = *(const f32x4*)(gg + 4);
#pragma unroll
        for (int ai = 0; ai < 2; ++ai)
#pragma unroll
            for (int m = 0; m < 4; ++m) { bf16_t* rowp = O + (size_t)(row0 + ai * HALF + m * 16) * ldc + col0;
#pragma unroll
                for (int bj = 0; bj < 2; ++bj) { const f32x4 t = *(const LAS f32x4*)(T + (ai * HALF + wr * 64 + m * 16 + fr) * 8 + bj * 4);
                    const float rq = fast_rsqrt(((t[0] + t[1]) + (t[2] + t[3])) * (1.0f / 128.0f) + 1e-6f) * rs[ai][m];
                    const f32x4 v0 = acc[ai][bj][m][0] * rq * g0, v1 = acc[ai][bj][m][1] * rq * g1;
                    u32x4 w; w.x = cvtpk(v0[0], v0[1]); w.y = cvtpk(v0[2], v0[3]); w.z = cvtpk(v1[0], v1[1]); w.w = cvtpk(v1[2], v1[3]);
                    *(u32x4*)(rowp + bj * HALF) = w; } }
    }
};
struct EpiResAdd {
    static constexpr bool RSL = false;
    static constexpr bool PERM = true, AFTER_DRAIN = false;
    bf16_t* XB; float* Y; int ldc; bool fin;
    __device__ __forceinline__ void operator()(const f32x4 (&acc)[2][2][4][2], const Unit& u, int wr, int wc, int fr, int fq, int) const {
        const int row0 = u.pm * BM + wr * 64 + fr, col0 = u.pn * BM + wc * 32 + 8 * fq;
        u32x4 r[2][4][2];
#pragma unroll
        for (int ai = 0; ai < 2; ++ai)
#pragma unroll
            for (int m = 0; m < 4; ++m)
#pragma unroll
                for (int bj = 0; bj < 2; ++bj) r[ai][m][bj] = *(const u32x4*)(XB + (size_t)(row0 + ai * HALF + m * 16) * ldc + col0 + bj * HALF);
#pragma unroll
        for (int ai = 0; ai < 2; ++ai)
#pragma unroll
            for (int m = 0; m < 4; ++m)
#pragma unroll
                for (int bj = 0; bj < 2; ++bj) { const u32x4 w = r[ai][m][bj]; const f32x4 a0 = acc[ai][bj][m][0], a1 = acc[ai][bj][m][1];
                    const f32x4 v0 = (f32x4){bflo(w.x) + a0[0], bfhi(w.x) + a0[1], bflo(w.y) + a0[2], bfhi(w.y) + a0[3]}, v1 = (f32x4){bflo(w.z) + a1[0], bfhi(w.z) + a1[1], bflo(w.w) + a1[2], bfhi(w.w) + a1[3]};
                    const size_t off = (size_t)(row0 + ai * HALF + m * 16) * ldc + col0 + bj * HALF;
                    if (fin) { *(f32x4*)(Y + off) = v0; *(f32x4*)(Y + off + 4) = v1; }
                    else { u32x4 o; o.x = cvtpk(v0[0], v0[1]); o.y = cvtpk(v0[2], v0[3]); o.z = cvtpk(v1[0], v1[1]); o.w = cvtpk(v1[2], v1[3]); *(u32x4*)(XB + off) = o; } }
    }
};

template <class Epi, class Sched, bool ALIGN_EPI = false, bool SP2 = false>
__device__ __forceinline__ void gemm_phase(LAS unsigned char* lds, const Gemm g, const Sched& S, const Epi& E, const int wave_) {
    int ln_; asm volatile("v_mbcnt_lo_u32_b32 %0, -1, 0\n\tv_mbcnt_hi_u32_b32 %0, -1, %0" : "=v"(ln_)); const int tid = wave_ * 64 + ln_;
    const int wid = __builtin_amdgcn_readfirstlane(tid >> 6), lane = tid & 63, wr = wid >> 2, wc = wid & 3, fr = lane & 15, fq = lane >> 4;
    const int K = g.K, nt = K / BK;
    unsigned voffA[2], voffB[2];
#pragma unroll
    for (int i = 0; i < 2; ++i) { int R, C; stage_rc(tid * 16 + i * 8192, R, C); const int Rb = Epi::PERM ? ((R & ~31) + perm32(R & 31)) : R;
        voffA[i] = (unsigned)(R * K + C) * 2u; voffB[i] = (unsigned)(Rb * K + C) * 2u; }
    const size_t kstep = (size_t)(BK * 2);
    const size_t hstep = (size_t)HALF * K * 2;
    const size_t tstep = 2 * hstep;
    const unsigned ldsw = (unsigned)wid * 1024u;
    const int aoff = lds_byte(wr * 64 + fr, fq * 8), boff = lds_byte(wc * 32 + fr, fq * 8);
#define PG8_SA(b, h) (((b) * 2 + (h)) * HTB)
#define PG8_SB(b, h) ((4 + (b) * 2 + (h)) * HTB)
#define PG8_STAGE(bufoff, gbase, voff) do { _Pragma("unroll") for (int _i = 0; _i < 2; ++_i) \
        __builtin_amdgcn_global_load_lds((const unsigned*)((const char*)(gbase) + (voff)[_i]), (LAS unsigned*)(lds + (bufoff) + ldsw + _i * 8192), 16, 0, 0); } while (0)
#define PG8_LDA(dst, b, h) do { _Pragma("unroll") for (int m = 0; m < 4; ++m) _Pragma("unroll") for (int k = 0; k < 2; ++k) dst[m][k] = *(const LAS bf16x8*)(lds + PG8_SA(b, h) + aoff + m * 2048 + k * 1024); } while (0)
#define PG8_LDB(dst, b, h) do { _Pragma("unroll") for (int n = 0; n < 2; ++n) _Pragma("unroll") for (int k = 0; k < 2; ++k) dst[n][k] = *(const LAS bf16x8*)(lds + PG8_SB(b, h) + boff + n * 2048 + k * 1024); } while (0)
#define PG8_MMA(ai, bj, At, Bt) do { __builtin_amdgcn_s_setprio(1); _Pragma("unroll") for (int m = 0; m < 4; ++m) _Pragma("unroll") for (int n = 0; n < 2; ++n) _Pragma("unroll") for (int k = 0; k < 2; ++k) \
        acc[ai][bj][m][n] = __builtin_amdgcn_mfma_f32_16x16x32_bf16(Bt[n][k], At[m][k], acc[ai][bj][m][n], 0, 0, 0); __builtin_amdgcn_s_setprio(0); } while (0)
#define PG8_WAIT_V(n) asm volatile("s_waitcnt vmcnt(" #n ")" ::: "memory")
#define PG8_WAIT_L(n) asm volatile("s_waitcnt lgkmcnt(" #n ")" ::: "memory")
#define PG8_BAR __builtin_amdgcn_s_barrier()
#define PG8_SCHED __builtin_amdgcn_sched_barrier(0)
    Unit cur, nxt; int ui = 0;
    if (!S.next(0, cur)) return;
    f32x4 acc[2][2][4][2];
    { const float z = opaque_zero();
#pragma unroll
    for (int a = 0; a < 2; ++a)
#pragma unroll
        for (int b = 0; b < 2; ++b)
#pragma unroll
            for (int m = 0; m < 4; ++m)
#pragma unroll
                for (int n = 0; n < 2; ++n) acc[a][b][m][n] = (f32x4){z, z, z, z}; }
    bf16x8 At[4][2], B0[2][2], B1[2][2];
    const char* cA = (const char*)g.A + (size_t)cur.pm * tstep; const char* cB = (const char*)g.Bt + (size_t)cur.pn * tstep;
    S.a_ready(cur);
    if constexpr (Epi::RSL) E.rs_fetch(cur, tid, 0);
    if constexpr (SP2) {
        PG8_STAGE(PG8_SB(0, 0), cB, voffB); PG8_STAGE(PG8_SB(0, 1), cB + hstep, voffB); PG8_STAGE(PG8_SA(0, 0), cA, voffA); PG8_STAGE(PG8_SA(0, 1), cA + hstep, voffA);
        if (wr == 1) PG8_BAR;
        PG8_WAIT_V(2); PG8_BAR;
        PG8_STAGE(PG8_SB(1, 0), cB + kstep, voffB); PG8_STAGE(PG8_SA(1, 0), cA + kstep, voffA); PG8_STAGE(PG8_SB(1, 1), cB + hstep + kstep, voffB);
        PG8_WAIT_V(6); PG8_BAR;
    } else {
        PG8_STAGE(PG8_SB(0, 0), cB, voffB); PG8_STAGE(PG8_SA(0, 0), cA, voffA); PG8_STAGE(PG8_SB(0, 1), cB + hstep, voffB); PG8_STAGE(PG8_SA(0, 1), cA + hstep, voffA);
        if (wr == 1) PG8_BAR;
        PG8_WAIT_V(4); PG8_BAR;
        PG8_STAGE(PG8_SB(1, 0), cB + kstep, voffB); PG8_STAGE(PG8_SA(1, 0), cA + kstep, voffA); PG8_STAGE(PG8_SB(1, 1), cB + hstep + kstep, voffB);
        PG8_WAIT_V(6); PG8_BAR;
    }
    for (;;) {
        const bool has_next = S.next(ui + 1, nxt);
        const char* nA = has_next ? (const char*)g.A + (size_t)nxt.pm * tstep : cA; const char* nB = has_next ? (const char*)g.Bt + (size_t)nxt.pn * tstep : cB;
        for (int t = 0; t < nt; t += 2) {
            const bool last = (t == nt - 2);
            const char* a1 = cA + (size_t)(t + 1) * kstep;
            const char* a2 = last ? nA : cA + (size_t)(t + 2) * kstep; const char* b2 = last ? nB : cB + (size_t)(t + 2) * kstep;
            const char* a3 = a2 + kstep; const char* b3 = b2 + kstep;
            if (last && has_next) S.a_ready(nxt);
            if constexpr (SP2) {
            PG8_LDB(B0, 0, 0); PG8_LDB(B1, 0, 1); PG8_SCHED; PG8_LDA(At, 0, 0); PG8_STAGE(PG8_SA(1, 1), a1 + hstep, voffA);
            PG8_WAIT_V(8); PG8_WAIT_L(0); PG8_BAR; PG8_MMA(0, 0, At, B0); PG8_MMA(0, 1, At, B1); PG8_BAR; PG8_SCHED;
            PG8_LDA(At, 0, 1); PG8_STAGE(PG8_SB(0, 0), b2, voffB); PG8_STAGE(PG8_SB(0, 1), b2 + hstep, voffB); PG8_STAGE(PG8_SA(0, 0), a2, voffA);
            PG8_WAIT_V(8); PG8_WAIT_L(0); PG8_BAR; PG8_MMA(1, 0, At, B0); PG8_MMA(1, 1, At, B1); PG8_BAR; PG8_SCHED;
            PG8_LDB(B0, 1, 0); PG8_LDB(B1, 1, 1); PG8_SCHED; PG8_LDA(At, 1, 0); PG8_STAGE(PG8_SA(0, 1), a2 + hstep, voffA);
            PG8_WAIT_V(8); PG8_WAIT_L(0); PG8_BAR; PG8_MMA(0, 0, At, B0); PG8_MMA(0, 1, At, B1); PG8_BAR; PG8_SCHED;
            PG8_LDA(At, 1, 1); PG8_STAGE(PG8_SB(1, 0), b3, voffB); PG8_STAGE(PG8_SB(1, 1), b3 + hstep, voffB); PG8_STAGE(PG8_SA(1, 0), a3, voffA);
            PG8_WAIT_V(8); PG8_WAIT_L(0); PG8_BAR; PG8_MMA(1, 0, At, B0); PG8_MMA(1, 1, At, B1); PG8_BAR; PG8_SCHED;
            } else {
            PG8_LDB(B0, 0, 0); PG8_SCHED; PG8_LDA(At, 0, 0); PG8_STAGE(PG8_SA(1, 1), a1 + hstep, voffA);
            PG8_WAIT_L(8); PG8_BAR; PG8_WAIT_L(0); PG8_MMA(0, 0, At, B0); PG8_BAR; PG8_SCHED;
            PG8_LDB(B1, 0, 1); PG8_STAGE(PG8_SB(0, 0), b2, voffB);
            PG8_BAR; PG8_WAIT_L(0); PG8_MMA(0, 1, At, B1); PG8_BAR;
            PG8_LDA(At, 0, 1); PG8_STAGE(PG8_SA(0, 0), a2, voffA);
            PG8_BAR; PG8_WAIT_L(0); PG8_MMA(1, 0, At, B0); PG8_BAR; PG8_SCHED;
            PG8_STAGE(PG8_SB(0, 1), b2 + hstep, voffB);
            PG8_WAIT_V(6); PG8_BAR; PG8_MMA(1, 1, At, B1); PG8_BAR;
            PG8_LDB(B0, 1, 0); PG8_SCHED; PG8_LDA(At, 1, 0); PG8_STAGE(PG8_SA(0, 1), a2 + hstep, voffA);
            PG8_WAIT_L(8); PG8_BAR; PG8_WAIT_L(0); PG8_MMA(0, 0, At, B0); PG8_BAR; PG8_SCHED;
            PG8_LDB(B1, 1, 1); PG8_STAGE(PG8_SB(1, 0), b3, voffB);
            PG8_BAR; PG8_WAIT_L(0); PG8_MMA(0, 1, At, B1); PG8_BAR;
            PG8_LDA(At, 1, 1); PG8_STAGE(PG8_SA(1, 0), a3, voffA);
            PG8_BAR; PG8_WAIT_L(0); PG8_MMA(1, 0, At, B0); PG8_BAR; PG8_SCHED;
            PG8_STAGE(PG8_SB(1, 1), b3 + hstep, voffB);
            PG8_WAIT_V(6); PG8_BAR; PG8_MMA(1, 1, At, B1); PG8_BAR;
            }
        }
        if constexpr (ALIGN_EPI) { if (wr == 0) PG8_BAR; }
        if constexpr (!Epi::AFTER_DRAIN) { E(acc, cur, wr, wc, fr, fq, ui & 1); S.done(cur); if constexpr (Epi::RSL) { if (has_next) E.rs_fetch(nxt, tid, (ui + 1) & 1); } }
        if (!has_next) break;
        { const float z = opaque_zero();
#pragma unroll
        for (int a = 0; a < 2; ++a)
#pragma unroll
            for (int b = 0; b < 2; ++b)
#pragma unroll
                for (int m = 0; m < 4; ++m)
#pragma unroll
                    for (int n = 0; n < 2; ++n) acc[a][b][m][n] = (f32x4){z, z, z, z}; }
        cur = nxt; cA = nA; cB = nB; ++ui;
        if constexpr (ALIGN_EPI) { if (wr == 1) PG8_BAR; }
    }
    PG8_WAIT_V(0);
    if constexpr (!ALIGN_EPI) { if (wr == 0) PG8_BAR; }
    PG8_BAR;
#undef PG8_SA
#undef PG8_SB
#undef PG8_STAGE
#undef PG8_LDA
#undef PG8_LDB
#undef PG8_MMA
#undef PG8_WAIT_V
#undef PG8_WAIT_L
#undef PG8_BAR
#undef PG8_SCHED
}
}

struct SEpiBf16 { bf16* O; int ldc; int act; const float* rstd;
    __device__ __forceinline__ void operator()(int row, int col, f32x4 s0, f32x4 s1) const {
        { const float r_ = rstd[row]; s0 = s0 * r_; s1 = s1 * r_; }
        if (act) {
#pragma unroll
            for (int j = 0; j < 4; ++j) { const float a = fmaxf(s0[j], 0.f), b = fmaxf(s1[j], 0.f); s0[j] = a * a; s1[j] = b * b; } }
        u32x4 w; w.x = cvtpk(s0[0], s0[1]); w.y = cvtpk(s0[2], s0[3]); w.z = cvtpk(s1[0], s1[1]); w.w = cvtpk(s1[2], s1[3]);
        *(u32x4*)(O + (size_t)row * ldc + col) = w; } };
struct SEpiResAdd { bf16* XB; float* Y; int ldc; bool fin;
    __device__ __forceinline__ void operator()(int row, int col, f32x4 s0, f32x4 s1) const {
        const size_t off = (size_t)row * ldc + col; const u32x4 w = *(const u32x4*)(XB + off);
        const f32x4 v0 = (f32x4){bflo(w.x) + s0[0], bfhi(w.x) + s0[1], bflo(w.y) + s0[2], bfhi(w.y) + s0[3]}, v1 = (f32x4){bflo(w.z) + s1[0], bfhi(w.z) + s1[1], bflo(w.w) + s1[2], bfhi(w.w) + s1[3]};
        if (fin) { *(f32x4*)(Y + off) = v0; *(f32x4*)(Y + off + 4) = v1; }
        else { u32x4 o; o.x = cvtpk(v0[0], v0[1]); o.y = cvtpk(v0[2], v0[3]); o.z = cvtpk(v1[0], v1[1]); o.w = cvtpk(v1[2], v1[3]); *(u32x4*)(XB + off) = o; } } };
template <class Epi, int MR = 64>
__device__ __forceinline__ void sample_gemm(LAS unsigned char* lds, int wave, int vcu, int G, const bf16* __restrict__ A, const bf16* __restrict__ Bt, int N, int K, const Epi& E, int rlo = 0, int rhi = 1 << 20) {
    int ln_; asm volatile("v_mbcnt_lo_u32_b32 %0, -1, 0\n\tv_mbcnt_hi_u32_b32 %0, -1, %0" : "=v"(ln_)); const int tid = wave * 64 + ln_;
    const int lane = tid & 63, fr = lane & 15, fq = lane >> 4;
    constexpr int MB = MR / 16, NRT = 256 / MR;
    const int ntiles = NRT * (N >> 6), kslice = K >> 3, kb = wave * kslice;
    LAS float* red = (LAS float*)lds;
    for (int r_ = rlo, t = vcu + rlo * G; r_ < rhi && t < ntiles; ++r_, t += G) {
        const int rt = t % NRT, ct = t / NRT;
        f32x4 acc[MB][4];
        { const float z = opaque_zero();
#pragma unroll
          for (int m = 0; m < MB; ++m)
#pragma unroll
              for (int n = 0; n < 4; ++n) acc[m][n] = (f32x4){z, z, z, z}; }
        const bf16* ap = A + (size_t)(rt * MR + fr) * K + kb + 8 * fq;
        const bf16* bp = Bt + (size_t)(ct * 64 + fr) * K + kb + 8 * fq;
        const size_t r16 = (size_t)16 * K;
#pragma unroll 4
        for (int k = 0; k < kslice; k += 64) {
            bf16x8 a0[MB], a1[MB], b0[4], b1[4];
#pragma unroll
            for (int m = 0; m < MB; ++m) { a0[m] = *(const bf16x8*)(ap + m * r16 + k); a1[m] = *(const bf16x8*)(ap + m * r16 + k + 32); }
#pragma unroll
            for (int n = 0; n < 4; ++n) { b0[n] = *(const bf16x8*)(bp + n * r16 + k); b1[n] = *(const bf16x8*)(bp + n * r16 + k + 32); }
#pragma unroll
            for (int m = 0; m < MB; ++m)
#pragma unroll
                for (int n = 0; n < 4; ++n) { acc[m][n] = __builtin_amdgcn_mfma_f32_16x16x32_bf16(a0[m], b0[n], acc[m][n], 0, 0, 0);
                                              acc[m][n] = __builtin_amdgcn_mfma_f32_16x16x32_bf16(a1[m], b1[n], acc[m][n], 0, 0, 0); }
        }
        __syncthreads();
#pragma unroll
        for (int m = 0; m < MB; ++m)
#pragma unroll
            for (int n = 0; n < 4; ++n)
#pragma unroll
                for (int j = 0; j < 4; ++j) red[wave * (MR * 64) + (16 * m + 4 * fq + j) * 64 + 16 * n + fr] = acc[m][n][j];
        __syncthreads();
        if (tid < MR * 8) {
            const int row = tid >> 3, col = (tid & 7) * 8;
            f32x4 s0 = *(const LAS f32x4*)(red + row * 64 + col), s1 = *(const LAS f32x4*)(red + row * 64 + col + 4);
#pragma unroll
            for (int w = 1; w < 8; ++w) { s0 = s0 + *(const LAS f32x4*)(red + w * (MR * 64) + row * 64 + col); s1 = s1 + *(const LAS f32x4*)(red + w * (MR * 64) + row * 64 + col + 4); }
            E(rt * MR + row, ct * 64 + col, s0, s1);
        }
    }
    __syncthreads();
}

#define XB_TMO      128
#define XB_XCNT(j)  (256  + 64 * (j))
#define XB_XSUB(j)  (1280 + 64 * (j))
#define XB_XGEN(j)  (2304 + 64 * (j))
#define XB_TOP      3328
#define XB_TOPGEN   3392
#define XCD_BAR_WORDS 3456
#define XB_SPIN_CAP (1u << 18)
__device__ __forceinline__ unsigned xb_ld(unsigned* p)              { return __hip_atomic_load(p, __ATOMIC_RELAXED, __HIP_MEMORY_SCOPE_AGENT); }
__device__ __forceinline__ unsigned xb_add(unsigned* p, unsigned v) { return __hip_atomic_fetch_add(p, v, __ATOMIC_RELAXED, __HIP_MEMORY_SCOPE_AGENT); }
__device__ __forceinline__ unsigned xb_xcc_id() { return (unsigned)__builtin_amdgcn_s_getreg((3 << 11) | 20) & 0xFu; }
#define XB_SPIN(cond, bar) do { unsigned _sp = 0; while (cond) { __builtin_amdgcn_s_sleep(1); \
    if ((++_sp & 255u) == 0u) { if (xb_ld(&(bar)[XB_TMO])) break; if (_sp > XB_SPIN_CAP) { atomicAdd(&(bar)[XB_TMO], 1u); break; } } } } while (0)
struct XcdBarrier { unsigned* bar; unsigned x; volatile LAS unsigned* st; };
__device__ __forceinline__ XcdBarrier xcd_barrier_post(unsigned* bar, volatile LAS unsigned* st, bool leader) {
    XcdBarrier b; b.bar = bar; b.x = xb_xcc_id(); b.st = st;
    if (leader) (void)xb_add(&bar[XB_XCNT(b.x)], 1u);
    return b;
}
__device__ __forceinline__ void xcd_barrier_complete(unsigned* bar, unsigned x, unsigned& nloc, unsigned& nx) {
    const unsigned G = gridDim.x * gridDim.y * gridDim.z;
    unsigned sum, cnt, mine, sp = 0u;
    for (;;) {
        sum = 0u; cnt = 0u; mine = 0u;
#pragma unroll
        for (unsigned j = 0; j < 16; ++j) { const unsigned c = xb_ld(&bar[XB_XCNT(j)]); sum += c; cnt += (c > 0u) ? 1u : 0u; mine = (j == x) ? c : mine; }
        if (sum == G) break;
        __builtin_amdgcn_s_sleep(1);
        if ((++sp & 255u) == 0u) { if (xb_ld(&bar[XB_TMO])) break; if (sp > XB_SPIN_CAP) { atomicAdd(&bar[XB_TMO], 1u); break; } }
    }
    nloc = mine > 0u ? mine : 1u; nx = cnt > 0u ? cnt : 1u;
}
__device__ __noinline__ void xcd_barrier(unsigned* bar_, unsigned x_, volatile LAS unsigned* st_, int wave_) {
    XcdBarrier b; b.bar = bar_; b.x = x_; b.st = st_;
    int ln_; asm volatile("v_mbcnt_lo_u32_b32 %0, -1, 0\n\tv_mbcnt_hi_u32_b32 %0, -1, %0" : "=v"(ln_)); const bool leader_ = (wave_ == 0) && (ln_ == 0);
    asm volatile("s_waitcnt vmcnt(0)" ::: "memory");
    __syncthreads();
    if (leader_) {
        unsigned* bar = b.bar;
        __builtin_amdgcn_s_waitcnt(0);
        unsigned nloc = b.st[0], nx = b.st[1];
        if (nloc == 0u) { xcd_barrier_complete(bar, b.x, nloc, nx); b.st[0] = nloc; b.st[1] = nx; }
        const unsigned old = xb_add(&bar[XB_XSUB(b.x)], 1u);
        const unsigned gen = old / nloc;
        if (old + 1u == (gen + 1u) * nloc) {
            __builtin_amdgcn_fence(__ATOMIC_RELEASE, "agent");
            asm volatile("s_waitcnt vmcnt(0)" ::: "memory");
            const unsigned og = xb_add(&bar[XB_TOP], 1u);
            const unsigned tg = og / nx;
            if (og + 1u == (tg + 1u) * nx) xb_add(&bar[XB_TOPGEN], 1u);
            else XB_SPIN(xb_ld(&bar[XB_TOPGEN]) == tg, bar);
            __builtin_amdgcn_fence(__ATOMIC_ACQUIRE, "agent");
            xb_add(&bar[XB_XGEN(b.x)], 1u);
            asm volatile("s_waitcnt vmcnt(0)" ::: "memory");
        } else {
            XB_SPIN(xb_ld(&bar[XB_XGEN(b.x)]) == gen, bar);
            __builtin_amdgcn_fence(__ATOMIC_ACQUIRE, "agent");
            asm volatile("s_waitcnt vmcnt(0)" ::: "memory");
        }
    }
    __syncthreads();
}

#define KSWZ(row, colB) ((row) * 256 + ((colB) ^ (((row) & 7) << 4)))
__device__ __forceinline__ int crow(int r, int hi) { return (r & 3) + 8 * (r >> 2) + 4 * hi; }
__device__ __forceinline__ int v_st(int k, int c) { const int kk = (k & ~0xC) | ((k & 4) << 1) | ((k & 8) >> 1); return ((kk >> 3) * 4 + (c >> 5)) * 512 + ((kk & 7) * 32 + (c & 31)) * 2; }
__device__ __forceinline__ int v_rd_base(int lane) { return ((lane & 3) << 3) | (((lane >> 2) & 3) << 6) | (((lane >> 4) & 1) << 5) | (((lane >> 5) & 1) << 8); }
constexpr int v_rd_off(int d0, int ks, int half) { return d0 * 512 + ks * 4096 + half * 2048; }
template <int OFF> __device__ __forceinline__ s16x4 tr_read(int vb) {
    s16x4 r; asm volatile("ds_read_b64_tr_b16 %0, %1 offset:%2" : "=&v"(r) : "v"(vb), "i"(OFF) : "memory"); return r;
}
#define PKLH(L, H) (bf16x8){L[0], L[1], L[2], L[3], H[0], H[1], H[2], H[3]}
template <int D0> __device__ __forceinline__ void pv_one(f32x16& od, int vb, bf16x8 pa0, bf16x8 pa1, bf16x8 pa2, bf16x8 pa3) {
    const s16x4 l0 = tr_read<v_rd_off(D0, 0, 0)>(vb), h0 = tr_read<v_rd_off(D0, 0, 1)>(vb), l1 = tr_read<v_rd_off(D0, 1, 0)>(vb), h1 = tr_read<v_rd_off(D0, 1, 1)>(vb);
    const s16x4 l2 = tr_read<v_rd_off(D0, 2, 0)>(vb), h2 = tr_read<v_rd_off(D0, 2, 1)>(vb), l3 = tr_read<v_rd_off(D0, 3, 0)>(vb), h3 = tr_read<v_rd_off(D0, 3, 1)>(vb);
    asm volatile("s_waitcnt lgkmcnt(0)" ::: "memory"); SBAR();
    od = __builtin_amdgcn_mfma_f32_32x32x16_bf16(pa0, PKLH(l0, h0), od, 0, 0, 0);
    od = __builtin_amdgcn_mfma_f32_32x32x16_bf16(pa1, PKLH(l1, h1), od, 0, 0, 0);
    od = __builtin_amdgcn_mfma_f32_32x32x16_bf16(pa2, PKLH(l2, h2), od, 0, 0, 0);
    od = __builtin_amdgcn_mfma_f32_32x32x16_bf16(pa3, PKLH(l3, h3), od, 0, 0, 0);
}
__device__ __forceinline__ void pv_d0(f32x16* o, int vb, bf16x8 pa0, bf16x8 pa1, bf16x8 pa2, bf16x8 pa3) {
    pv_one<0>(o[0], vb, pa0, pa1, pa2, pa3); pv_one<1>(o[1], vb, pa0, pa1, pa2, pa3); pv_one<2>(o[2], vb, pa0, pa1, pa2, pa3); pv_one<3>(o[3], vb, pa0, pa1, pa2, pa3);
}
template <int D0, int KS> __device__ __forceinline__ bf16x8 tr_frag(int vb) {
    const s16x4 l = tr_read<v_rd_off(D0, KS, 0)>(vb), h = tr_read<v_rd_off(D0, KS, 1)>(vb);
    return PKLH(l, h);
}
__device__ __forceinline__ void qkt(f32x16& p0, f32x16& p1, int Ks  , const bf16x8* qr, int r32, int hi) {
    p0 = f32x16{}; p1 = f32x16{};
#pragma unroll
    for (int d0 = 0; d0 < 8; ++d0) { const int cb = (d0 * 16 + hi * 8) * 2;
        const bf16x8 b0 = *(const LAS bf16x8*)(uintptr_t)(unsigned)(Ks + KSWZ(r32, cb));
        const bf16x8 b1 = *(const LAS bf16x8*)(uintptr_t)(unsigned)(Ks + KSWZ(32 + r32, cb));
        p0 = __builtin_amdgcn_mfma_f32_32x32x16_bf16(b0, qr[d0], p0, 0, 0, 0);
        p1 = __builtin_amdgcn_mfma_f32_32x32x16_bf16(b1, qr[d0], p1, 0, 0, 0); }
}
#define QK_RD(d0_, A_, B_) do { const int cb_ = ((d0_) * 16 + hi * 8) * 2; A_ = *(const LAS bf16x8*)(uintptr_t)(unsigned)(Ks + KSWZ(r32, cb_)); B_ = *(const LAS bf16x8*)(uintptr_t)(unsigned)(Ks + KSWZ(32 + r32, cb_)); } while (0)
#define QK_MM(d0_, A_, B_) do { p0 = __builtin_amdgcn_mfma_f32_32x32x16_bf16(A_, qr[d0_], p0, 0, 0, 0); p1 = __builtin_amdgcn_mfma_f32_32x32x16_bf16(B_, qr[d0_], p1, 0, 0, 0); } while (0)
#define QK_WAIT(n_) do { SBAR(); asm volatile("s_waitcnt lgkmcnt(" #n_ ")" ::: "memory"); SBAR(); } while (0)
__device__ __forceinline__ void qkt_b(f32x16& p0, f32x16& p1, int Ks  , const bf16x8* qr, int r32, int hi) {
    p0 = f32x16{}; p1 = f32x16{};
    bf16x8 a0, b0, a1, b1, a2, b2, a3, b3, a4, b4, a5, b5;
    QK_RD(0, a0, b0); QK_RD(1, a1, b1); QK_RD(2, a2, b2); QK_RD(3, a3, b3);
    QK_WAIT(4); QK_MM(0, a0, b0); QK_MM(1, a1, b1);
    QK_RD(4, a4, b4); QK_RD(5, a5, b5);
    QK_WAIT(4); QK_MM(2, a2, b2); QK_MM(3, a3, b3);
    QK_RD(6, a0, b0); QK_RD(7, a1, b1);
    QK_WAIT(4); QK_MM(4, a4, b4); QK_MM(5, a5, b5);
    QK_WAIT(0); QK_MM(6, a0, b0); QK_MM(7, a1, b1);
}
#undef QK_RD
#undef QK_MM
#undef QK_WAIT
#define PK4(P, BASE, OUT) do { unsigned a0 = cvtpk(P[BASE + 0], P[BASE + 1]), a1 = cvtpk(P[BASE + 2], P[BASE + 3]);   \
    unsigned b0 = cvtpk(P[BASE + 4], P[BASE + 5]), b1 = cvtpk(P[BASE + 6], P[BASE + 7]);                              \
    auto r0 = __builtin_amdgcn_permlane32_swap(a0, b0, false, false); auto r1 = __builtin_amdgcn_permlane32_swap(a1, b1, false, false); \
    u32x4 w = {r0[0], r1[0], r0[1], r1[1]}; OUT = *reinterpret_cast<bf16x8*>(&w); } while (0)
__device__ __forceinline__ float half_swap_add(float v) { auto rr = __builtin_amdgcn_permlane32_swap(__float_as_uint(v), __float_as_uint(v), false, false); return __uint_as_float(rr[0]) + __uint_as_float(rr[1]); }
__device__ __forceinline__ float half_swap_max(float v) { auto rr = __builtin_amdgcn_permlane32_swap(__float_as_uint(v), __float_as_uint(v), false, false); return fmaxf(__uint_as_float(rr[0]), __uint_as_float(rr[1])); }

struct Args {
    const float* x_prompt; const float* x_sample; const float* cache_k; const float* cache_v; const float* state_conv; const float* state_c; const float* state_n; const float* state_m;
    const float* norm_mix_g; const float* w_in; const float* conv_w; const float* q_norm_g; const float* k_norm_g; const float* rel_bias; const float* b_igate; const float* b_fgate;
    const float* mlstm_norm_g; const float* w_out; const float* norm_mlp_g; const float* w_up; const float* w_down;
    float* out; unsigned char* ws; int ph_lo, ph_hi, rep, pad;
};
struct Ctx {
    LAS unsigned char* lds; int tid, lane, wave, G, vcu;
};
constexpr int NPH_LAYER = 9, NPHASES = DEPTH * NPH_LAYER;
__device__ __forceinline__ int hw_tid(int wave) { int ln; asm volatile("v_mbcnt_lo_u32_b32 %0, -1, 0\n\tv_mbcnt_hi_u32_b32 %0, -1, %0" : "=v"(ln)); return wave * 64 + ln; }
__device__ __forceinline__ Ctx relaunder(const Ctx& c) { Ctx d = c; const int t = hw_tid(c.wave); d.tid = t; d.lane = t & 63; return d; }

__device__ __forceinline__ void transpose_item(const float* W, int K, int ldn, int nblk, bf16* WT, LAS float* scr, int item, int lane, const float* gain = nullptr) {
    const int kb = item / nblk, nb = item % nblk, k0 = 64 * kb, n0 = 32 * nb;
    const int c = lane & 7;
    f32x4 g0 = (f32x4){1.f, 1.f, 1.f, 1.f}, g1 = g0;
    if (gain) { g0 = *(const f32x4*)(gain + k0 + 8 * c); g1 = *(const f32x4*)(gain + k0 + 8 * c + 4); }
#pragma unroll 8
    for (int i = 0; i < 32; ++i) { const int kk = 2 * i + (lane >> 5); scr[kk * 33 + (lane & 31)] = W[(size_t)(k0 + kk) * ldn + n0 + (lane & 31)]; }
    LDS_WAIT(); asm volatile("" ::: "memory");
#pragma unroll
    for (int j = 0; j < 4; ++j) { const int n = (lane >> 3) + 8 * j; const LAS float* s = scr + (8 * c) * 33 + n;
        u32x4 o; o.x = cvtpk(s[0 * 33] * g0[0], s[1 * 33] * g0[1]); o.y = cvtpk(s[2 * 33] * g0[2], s[3 * 33] * g0[3]); o.z = cvtpk(s[4 * 33] * g1[0], s[5 * 33] * g1[1]); o.w = cvtpk(s[6 * 33] * g1[2], s[7 * 33] * g1[3]);
        *(GAS u32x4*)(WT + (size_t)(n0 + n) * K + k0 + 8 * c) = o; }
    LDS_WAIT(); asm volatile("" ::: "memory");
}
__device__ __forceinline__ void convert_weights(const Args& a, const Ctx& c, int l) {
    LAS float* scr = (LAS float*)(c.lds + c.wave * 16384);
    const size_t wo = (size_t)(l & 1) * WSET;
    const int gw = c.vcu * NWAVES + c.wave, NGW = c.G * NWAVES;
    constexpr int I_IN = (D / 64) * (NPROJ / 32), I_OUT = (D / 64) * (D / 32), I_UP = (D / 64) * (FF / 32), I_DN = (FF / 64) * (D / 32), I_L = I_IN + I_OUT + I_UP + I_DN;
    for (int it = gw; it < I_L; it += NGW) {
        int r = it;
        if (r < I_IN) { transpose_item(a.w_in + (size_t)l * D * IN_DIM, D, IN_DIM, NPROJ / 32, (bf16*)(a.ws + WS_WIN + wo), scr, r, c.lane, a.norm_mix_g + (size_t)l * D); continue; } r -= I_IN;
        if (r < I_OUT) { transpose_item(a.w_out + (size_t)l * D * D, D, D, D / 32, (bf16*)(a.ws + WS_WOUT + wo), scr, r, c.lane); continue; } r -= I_OUT;
        if (r < I_UP) { transpose_item(a.w_up + (size_t)l * D * FF, D, FF, FF / 32, (bf16*)(a.ws + WS_WUP + wo), scr, r, c.lane, a.norm_mlp_g + (size_t)l * D); continue; } r -= I_UP;
        transpose_item(a.w_down + (size_t)l * FF * D, FF, D, D / 32, (bf16*)(a.ws + WS_WDN + wo), scr, r, c.lane);
    }
}
struct ConvJob { const float* w_in; const float* w_out; const float* w_up; const float* w_down; const float* g_mix; const float* g_mlp; unsigned char* ws; int l, gw, ngw; };
constexpr int CV_I_IN = (D / 64) * (NPROJ / 32), CV_I_OUT = (D / 64) * (D / 32), CV_I_UP = (D / 64) * (FF / 32), CV_I_DN = (FF / 64) * (D / 32), CV_I_L = CV_I_IN + CV_I_OUT + CV_I_UP + CV_I_DN;
struct ConvItem { const float* W; bf16* WT; int gsel; int K, ldn, nblk, r; };
constexpr int GT0_OFF = 116736, GT1_OFF = SCR_OFF + 2048;
__device__ __forceinline__ ConvItem conv_item(const ConvJob& j, int it) {
    const int l = j.l; const size_t wo = (size_t)(l & 1) * WSET; int r = it; ConvItem x;
    if (r < CV_I_IN) { x = ConvItem{j.w_in + (size_t)l * D * IN_DIM, (bf16*)(j.ws + WS_WIN + wo), 1, D, IN_DIM, NPROJ / 32, r}; return x; } r -= CV_I_IN;
    if (r < CV_I_OUT) { x = ConvItem{j.w_out + (size_t)l * D * D, (bf16*)(j.ws + WS_WOUT + wo), 0, D, D, D / 32, r}; return x; } r -= CV_I_OUT;
    if (r < CV_I_UP) { x = ConvItem{j.w_up + (size_t)l * D * FF, (bf16*)(j.ws + WS_WUP + wo), 2, D, FF, FF / 32, r}; return x; } r -= CV_I_UP;
    x = ConvItem{j.w_down + (size_t)l * FF * D, (bf16*)(j.ws + WS_WDN + wo), 0, FF, D, D / 32, r}; return x;
}
__device__ __forceinline__ void conv_load(const ConvJob& j, int it, int lane, float (&v)[32]) {
    const ConvItem x = conv_item(j, it);
    const int kb = x.r / x.nblk, nb = x.r % x.nblk;
    const float* base = x.W + (size_t)(64 * kb) * x.ldn + 32 * nb;
    const unsigned off = (unsigned)((32 * (lane >> 5)) * x.ldn + (lane & 31));
#pragma unroll
    for (int i = 0; i < 32; ++i) v[i] = (base + (size_t)i * x.ldn)[off];
}
__device__ __forceinline__ void conv_finish(const ConvJob& j, int it, int lane, float (&v)[32], LAS unsigned char* lds) {
    const ConvItem x = conv_item(j, it);
    const int kb = x.r / x.nblk, nb = x.r % x.nblk, k0 = 64 * kb + 32 * (lane >> 5), n = 32 * nb + (lane & 31);
    if (x.gsel) { const LAS float* gp = (const LAS float*)(lds + (x.gsel == 1 ? GT0_OFF : GT1_OFF)) + k0;
#pragma unroll
        for (int q = 0; q < 8; ++q) { const f32x4 g = *(const LAS f32x4*)(gp + 4 * q); v[4 * q] *= g[0]; v[4 * q + 1] *= g[1]; v[4 * q + 2] *= g[2]; v[4 * q + 3] *= g[3]; } }
#pragma unroll
    for (int q = 0; q < 4; ++q) { u32x4 o; o.x = cvtpk(v[8 * q], v[8 * q + 1]); o.y = cvtpk(v[8 * q + 2], v[8 * q + 3]); o.z = cvtpk(v[8 * q + 4], v[8 * q + 5]); o.w = cvtpk(v[8 * q + 6], v[8 * q + 7]);
        *(u32x4*)(x.WT + (size_t)n * x.K + k0 + 8 * q) = o; }
}
__device__ __forceinline__ bool conv_step(const ConvJob& j, int& k, int lane, LAS unsigned char* lds) {
    const int it = j.gw + k * j.ngw; if (it >= CV_I_L) return false;
    ++k; float v[32]; conv_load(j, it, lane, v); conv_finish(j, it, lane, v, lds); return true;
}

__device__ __forceinline__ void build_kv_image(const Args& a, int w, int nw, int tid, int l) {
    bf16* SK = (bf16*)(a.ws + WS_SK + (size_t)(l & 1) * SKV_IMG); bf16* SV = (bf16*)(a.ws + WS_SV + (size_t)(l & 1) * SKV_IMG);
    const unsigned gt = (unsigned)w * NTHREADS + tid, NT = (unsigned)nw * NTHREADS;
    constexpr unsigned NCH = (unsigned)SBATCH * 512 * 1024 / 8;
    for (unsigned i = gt; i < 2 * NCH; i += NT) {
        const bool isv = i >= NCH; const unsigned j = isv ? i - NCH : i; const unsigned e = j * 8; const unsigned b = e / (512 * 1024); const unsigned rem = e % (512 * 1024);
        const float* src = (isv ? a.cache_v : a.cache_k) + ((size_t)(l * SBATCH + b) * 512 * 1024) + rem;
        const f32x4 x0 = *(const f32x4*)src, x1 = *(const f32x4*)(src + 4);
        u32x4 w4; w4.x = cvtpk(x0.x, x0.y); w4.y = cvtpk(x0.z, x0.w); w4.z = cvtpk(x1.x, x1.y); w4.w = cvtpk(x1.z, x1.w);
        *(u32x4*)((isv ? SV : SK) + (size_t)b * SKV_ROWS * 1024 + rem) = w4;
    }
    constexpr unsigned NZ = (unsigned)SBATCH * (SKV_ROWS - 544) * 1024 / 8;
    for (unsigned i = gt; i < 2 * NZ; i += NT) {
        const bool isv = i >= NZ; const unsigned j = isv ? i - NZ : i; const unsigned e = j * 8; const unsigned b = e / ((SKV_ROWS - 544) * 1024); const unsigned rem = e % ((SKV_ROWS - 544) * 1024);
        { const unsigned z = __float_as_uint(opaque_zero()); *(u32x4*)((isv ? SV : SK) + ((size_t)b * SKV_ROWS + 544) * 1024 + rem) = (u32x4){z, z, z, z}; }
    }
}
__device__ __forceinline__ float log_sigmoid(float x) { return fminf(x, 0.f) - fast_log(1.0f + fast_exp(-fabsf(x))); }
template <bool FIRST  >
__device__ __forceinline__ void phase_norm(const Args& a, const Ctx& c_in0, int l) {
    const Ctx c = relaunder(c_in0);
    bf16* XB = (bf16*)(a.ws + WS_XB); bf16* H = (bf16*)(a.ws + WS_H);
    const float* g = (FIRST ? a.norm_mix_g : a.norm_mlp_g) + (size_t)l * D;
    LAS float* Wg = (LAS float*)c.lds;
    if (FIRST) {
        if (l == 0) { convert_weights(a, c, 0); __syncthreads(); }
        const float* wsrc = a.w_in + (size_t)l * D * IN_DIM + NPROJ;
        for (int idx = c.tid; idx < 8 * D; idx += NTHREADS) { const int k = idx >> 3, o = idx & 7; Wg[o * D + k] = wsrc[(size_t)k * IN_DIM + o]; }
        __syncthreads();
    }
    const int gw = c.vcu * NWAVES + c.wave, NGW = c.G * NWAVES;
    f32x4 gv[8];
#pragma unroll
    for (int j = 0; j < 8; ++j) gv[j] = *(const f32x4*)(g + 4 * c.lane + 256 * j);
    for (int row = gw; row < MR; row += NGW) {
        f32x4 v[8]; float s = 0.f;
        if (FIRST && l == 0) {
            const float* src = row < MP ? a.x_prompt + (size_t)row * D : a.x_sample + (size_t)(row - MP) * D;
#pragma unroll
            for (int j = 0; j < 8; ++j) v[j] = *(const f32x4*)(src + 4 * c.lane + 256 * j);
#pragma unroll
            for (int j = 0; j < 8; ++j) { u32x2 w; w.x = cvtpk(v[j].x, v[j].y); w.y = cvtpk(v[j].z, v[j].w); *(u32x2*)(XB + (size_t)row * D + 4 * c.lane + 256 * j) = w; }
        } else {
            u32x2 w[8];
#pragma unroll
            for (int j = 0; j < 8; ++j) w[j] = *(const u32x2*)(XB + (size_t)row * D + 4 * c.lane + 256 * j);
#pragma unroll
            for (int j = 0; j < 8; ++j) v[j] = (f32x4){bflo(w[j].x), bfhi(w[j].x), bflo(w[j].y), bfhi(w[j].y)};
        }
#pragma unroll
        for (int j = 0; j < 8; ++j) s += (v[j].x * v[j].x + v[j].y * v[j].y) + (v[j].z * v[j].z + v[j].w * v[j].w);
        const float rstd = fast_rsqrt(wave_sum(s, c.lane) * (1.f / D) + EPS);
        if (c.lane == 0) ((float*)(a.ws + WS_RSTD))[row] = rstd;
        if (FIRST) {
#pragma unroll
            for (int j = 0; j < 8; ++j) v[j] = v[j] * rstd * gv[j];
            float ga[8];
#pragma unroll
            for (int o = 0; o < 8; ++o) { float t = 0.f;
#pragma unroll
                for (int j = 0; j < 8; ++j) { const f32x4 w4 = *(const LAS f32x4*)(Wg + o * D + 4 * c.lane + 256 * j); t += (v[j].x * w4.x + v[j].y * w4.y) + (v[j].z * w4.z + v[j].w * w4.w); }
                ga[o] = wave_sum(t, c.lane); }
            float val = ga[0];
#pragma unroll
            for (int o = 1; o < 8; ++o) val = (c.lane == o) ? ga[o] : val;
            if (c.lane < 8) {
                float r;
                if (c.lane < 4) r = val + a.b_igate[l * MH + c.lane];
                else r = log_sigmoid(val + a.b_fgate[l * MH + c.lane - 4]);
                ((float*)(a.ws + WS_GATE))[(size_t)row * 8 + c.lane] = r;
            }
        }
    }
    if (FIRST && l == 0) build_kv_image(a, c.vcu, c.G, c.tid, 0);
}

__device__ __forceinline__ float scan256_sum(float v, int tid, int lane, int wave, LAS float* tot  ) {
#pragma unroll
    for (int o = 1; o < 64; o <<= 1) { const float t = shup(v, o, lane); if (lane >= o) v += t; }
    if (lane == 63) tot[wave] = v;
    __syncthreads();
    float off = 0.f;
#pragma unroll
    for (int w = 0; w < 3; ++w) off += (w < wave) ? tot[w] : 0.f;
    __syncthreads();
    return v + off;
}
__device__ __forceinline__ float scan256_max(float v, int tid, int lane, int wave, LAS float* tot) {
#pragma unroll
    for (int o = 1; o < 64; o <<= 1) { const float t = shup(v, o, lane); if (lane >= o) v = fmaxf(v, t); }
    if (lane == 63) tot[wave] = v;
    __syncthreads();
    float off = -3.0e38f;
#pragma unroll
    for (int w = 0; w < 3; ++w) off = (w < wave) ? fmaxf(off, tot[w]) : off;
    __syncthreads();
    return fmaxf(v, off);
}

__device__ __forceinline__ void m1_unit(const Args& a, const Ctx& c_in, int l, int unit) {
    const int g = unit & 31, bh = unit >> 5, b = bh >> 2, h = bh & 3;
    const bf16* PROJ = (const bf16*)(a.ws + WS_BIG);
    const float* GATE = (const float*)(a.ws + WS_GATE);
    Ctx c = c_in; { int t_ = c.tid; asm volatile("" : "+v"(t_)); c.tid = t_; c.lane = t_ & 63; }
    LAS float* scr = (LAS float*)(c.lds + SCR_OFF);
    LAS float* W_S = scr;
    LAS float* NACC = scr + 256;
    LAS float* TOT = scr + 384;
    LAS float* SCAL = scr + 392;
    const int row0 = b * SEQ + g * 256;
    LAS float* PART = scr + 400;
    const int sr = c.tid >> 4, sc = (c.tid & 15) * 8;
    u32x4 kq8[8], vq8[8];
#pragma unroll
    for (int t = 0; t < 4; ++t)
#pragma unroll
        for (int hh = 0; hh < 2; ++hh) { const int rr = t * 64 + hh * 32 + sr; const size_t ro = (size_t)(row0 + rr) * NPROJ;
            kq8[t * 2 + hh] = *(const u32x4*)(PROJ + ro + C_MK + h * HD + sc); vq8[t * 2 + hh] = *(const u32x4*)(PROJ + ro + C_MV + h * HD + sc); }
    __syncthreads();
    float li = 0.f, lf = 0.f;
    if (c.tid < 256) { li = GATE[(size_t)(row0 + c.tid) * 8 + h]; lf = GATE[(size_t)(row0 + c.tid) * 8 + 4 + h]; }
    const float bc = scan256_sum(lf, c.tid, c.lane, c.wave, TOT);
    const float as = li - bc;
    const float am = scan256_max(c.tid < 256 ? as : -3.0e38f, c.tid, c.lane, c.wave, TOT);
    if (c.tid == 255) { SCAL[0] = am; SCAL[1] = bc; }
    __syncthreads();
    const float amax = SCAL[0], blast = SCAL[1];
    if (c.tid < 256) W_S[c.tid] = fast_exp(as - amax);
    __syncthreads();
#pragma unroll
    for (int t = 0; t < 4; ++t)
#pragma unroll
        for (int hh = 0; hh < 2; ++hh) {
            const int rr = t * 64 + hh * 32 + sr;
            const u32x4 kq = kq8[t * 2 + hh];
            const u32x4 vq = vq8[t * 2 + hh];
            const float w = W_S[rr] * 0.08838834764831845f;
            float kf[8] = {bflo(kq.x) * w, bfhi(kq.x) * w, bflo(kq.y) * w, bfhi(kq.y) * w, bflo(kq.z) * w, bfhi(kq.z) * w, bflo(kq.w) * w, bfhi(kq.w) * w};
            u32x4 kw; kw.x = cvtpk(kf[0], kf[1]); kw.y = cvtpk(kf[2], kf[3]); kw.z = cvtpk(kf[4], kf[5]); kw.w = cvtpk(kf[6], kf[7]);
            *(LAS u32x4*)(c.lds + t * 16384 + v_st(hh * 32 + sr, sc)) = kw;
            *(LAS u32x4*)(c.lds + 65536 + t * 16384 + v_st(hh * 32 + sr, sc)) = vq;
        }
    __syncthreads();
    {
        const int col = c.tid & 127, t = c.tid >> 7; float s = 0.f;
        for (int k = 0; k < 64; ++k) s += bf2f(*(const LAS bf16*)(c.lds + t * 16384 + v_st(k, col)));
        PART[c.tid] = s;
    }
    __syncthreads();
    const int Da = c.wave >> 1, Db0 = 2 * (c.wave & 1);
    f32x16 acc0 = f32x16{}, acc1 = f32x16{};
    const int vbk = (int)(uintptr_t)(c.lds) + v_rd_base(c.lane) + Da * 512;
    const int vbv = (int)(uintptr_t)(c.lds) + 65536 + v_rd_base(c.lane) + Db0 * 512;
#pragma unroll
    for (int t = 0; t < 4; ++t) {
        const int ak = vbk + t * 16384, av = vbv + t * 16384;
        const bf16x8 a0 = tr_frag<0, 0>(ak), a1 = tr_frag<0, 1>(ak), a2 = tr_frag<0, 2>(ak), a3 = tr_frag<0, 3>(ak);
        const bf16x8 b00 = tr_frag<0, 0>(av), b01 = tr_frag<0, 1>(av), b02 = tr_frag<0, 2>(av), b03 = tr_frag<0, 3>(av);
        const bf16x8 b10 = tr_frag<1, 0>(av), b11 = tr_frag<1, 1>(av), b12 = tr_frag<1, 2>(av), b13 = tr_frag<1, 3>(av);
        asm volatile("s_waitcnt lgkmcnt(0)" ::: "memory"); SBAR();
        acc0 = __builtin_amdgcn_mfma_f32_32x32x16_bf16(a0, b00, acc0, 0, 0, 0); acc1 = __builtin_amdgcn_mfma_f32_32x32x16_bf16(a0, b10, acc1, 0, 0, 0);
        acc0 = __builtin_amdgcn_mfma_f32_32x32x16_bf16(a1, b01, acc0, 0, 0, 0); acc1 = __builtin_amdgcn_mfma_f32_32x32x16_bf16(a1, b11, acc1, 0, 0, 0);
        acc0 = __builtin_amdgcn_mfma_f32_32x32x16_bf16(a2, b02, acc0, 0, 0, 0); acc1 = __builtin_amdgcn_mfma_f32_32x32x16_bf16(a2, b12, acc1, 0, 0, 0);
        acc0 = __builtin_amdgcn_mfma_f32_32x32x16_bf16(a3, b03, acc0, 0, 0, 0); acc1 = __builtin_amdgcn_mfma_f32_32x32x16_bf16(a3, b13, acc1, 0, 0, 0);
    }
    float* CL = (float*)(a.ws + WS_CLOC) + (size_t)unit * HD * HD;
    const int r32 = c.lane & 31, hi = c.lane >> 5;
#pragma unroll
    for (int r = 0; r < 16; ++r) { const int d = 32 * Da + crow(r, hi);
        CL[(size_t)d * HD + 32 * Db0 + r32] = acc0[r]; CL[(size_t)d * HD + 32 * (Db0 + 1) + r32] = acc1[r]; }
    if (c.tid < 128) ((float*)(a.ws + WS_NLOC))[(size_t)unit * HD + c.tid] = (PART[c.tid] + PART[128 + c.tid]) + (PART[256 + c.tid] + PART[384 + c.tid]);
    if (c.tid == 0) { float* ms = (float*)(a.ws + WS_MSC) + (size_t)unit * 4; ms[0] = blast + amax; ms[1] = blast; }
}

__device__ __forceinline__ void sample_mixers(const Args& a, const Ctx& c, int l);
template <bool WITH_QK>
__device__ __forceinline__ void phase_c(const Args& a, const Ctx& c_in0, int l) {
    const Ctx c = relaunder(c_in0);
    bf16* PROJ = (bf16*)(a.ws + WS_BIG); bf16* MIX = (bf16*)(a.ws + WS_H);
    constexpr int WSMP = SBATCH * NH + SBATCH * MH;
    const bool split = c.G > 2 * WSMP;
    if (WITH_QK && (!split || c.vcu < WSMP)) sample_mixers(a, c, l);
    for (int u = c.vcu; u < 16 * NGRP; u += c.G) m1_unit(a, c, l, u);
    const int gw = c.vcu * NWAVES + c.wave, NGW = c.G * NWAVES;
    if (WITH_QK) {
        const float* gq = a.q_norm_g + l * HD; const float* gk = a.k_norm_g + l * HD;
        const int gi = (16 * c.lane) & 127;
        f32x4 gqv[4], gkv[4];
#pragma unroll
        for (int j = 0; j < 4; ++j) { gqv[j] = *(const f32x4*)(gq + gi + 4 * j); gkv[j] = *(const f32x4*)(gk + gi + 4 * j); }
        bf16* SK = (bf16*)(a.ws + WS_SK + (size_t)(l & 1) * SKV_IMG); bf16* SV = (bf16*)(a.ws + WS_SV + (size_t)(l & 1) * SKV_IMG);
        constexpr int NIT = NB * KEEP;
        for (int it = gw; it < NIT; it += NGW) {
            const int row = (it / KEEP) * SEQ + (SEQ - KEEP) + (it % KEEP);
            const bf16* p = PROJ + (size_t)row * NPROJ + C_K + 16 * c.lane;
            const u32x4 w0 = *(const u32x4*)p, w1 = *(const u32x4*)(p + 8);
            const bf16* pv = PROJ + (size_t)row * NPROJ + C_V + 16 * c.lane;
            const u32x4 v0 = *(const u32x4*)pv, v1 = *(const u32x4*)(pv + 8);
            const int b = row / SEQ, t = row % SEQ; const size_t o = ((size_t)(l * NB + b) * KEEP + (t - (SEQ - KEEP))) * 1024 + 16 * c.lane;
            float* ok = a.out + O_PK + o; float* ov = a.out + O_PV + o;
            *(f32x4*)(ok + 0) = (f32x4){bflo(w0.x), bfhi(w0.x), bflo(w0.y), bfhi(w0.y)}; *(f32x4*)(ok + 4) = (f32x4){bflo(w0.z), bfhi(w0.z), bflo(w0.w), bfhi(w0.w)};
            *(f32x4*)(ok + 8) = (f32x4){bflo(w1.x), bfhi(w1.x), bflo(w1.y), bfhi(w1.y)}; *(f32x4*)(ok + 12) = (f32x4){bflo(w1.z), bfhi(w1.z), bflo(w1.w), bfhi(w1.w)};
            *(f32x4*)(ov + 0) = (f32x4){bflo(v0.x), bfhi(v0.x), bflo(v0.y), bfhi(v0.y)}; *(f32x4*)(ov + 4) = (f32x4){bflo(v0.z), bfhi(v0.z), bflo(v0.w), bfhi(v0.w)};
            *(f32x4*)(ov + 8) = (f32x4){bflo(v1.x), bfhi(v1.x), bflo(v1.y), bfhi(v1.y)}; *(f32x4*)(ov + 12) = (f32x4){bflo(v1.z), bfhi(v1.z), bflo(v1.w), bfhi(v1.w)};
        }
    }
    {
        const int ch = 8 * c.lane;
        float w0[8], w1[8], w2[8];
#pragma unroll
        for (int i = 0; i < 8; ++i) { w0[i] = a.conv_w[(size_t)(l * 3 + 0) * 512 + ch + i]; w1[i] = a.conv_w[(size_t)(l * 3 + 1) * 512 + ch + i]; w2[i] = a.conv_w[(size_t)(l * 3 + 2) * 512 + ch + i]; }
        constexpr int NSEG = SEQ / 32, NITEM = NB * NSEG + SBATCH;
        const int gwc = split ? (c.vcu - WSMP) * NWAVES + c.wave : gw, NGWc = split ? (c.G - WSMP) * NWAVES : NGW;
        for (int it = gwc; it >= 0 && it < NITEM; it += NGWc) {
            float u2[8], u1[8]; int rowb; bool samp = it >= NB * NSEG; int b, seg = 0;
            if (!samp) { b = it / NSEG; seg = it % NSEG; rowb = b * SEQ + seg * 32; } else { b = it - NB * NSEG; rowb = MP + b * SSEQ; }
#pragma unroll
            for (int i = 0; i < 8; ++i) { u2[i] = 0.f; u1[i] = 0.f; }
            if (samp) {
#pragma unroll
                for (int i = 0; i < 8; ++i) { u2[i] = a.state_conv[((size_t)(l * SBATCH + b) * 2 + 0) * 512 + ch + i]; u1[i] = a.state_conv[((size_t)(l * SBATCH + b) * 2 + 1) * 512 + ch + i]; }
            } else if (seg > 0) {
#pragma unroll
                for (int q = 0; q < 2; ++q) { const bf16* pr = PROJ + (size_t)(rowb - 2 + q) * NPROJ + ch;
                    const u32x4 xa = *(const u32x4*)(pr + C_XA), gc = *(const u32x4*)(pr + C_GC);
                    float* dst = q ? u1 : u2;
                    dst[0] = bflo(xa.x) * bflo(gc.x); dst[1] = bfhi(xa.x) * bfhi(gc.x); dst[2] = bflo(xa.y) * bflo(gc.y); dst[3] = bfhi(xa.y) * bfhi(gc.y);
                    dst[4] = bflo(xa.z) * bflo(gc.z); dst[5] = bfhi(xa.z) * bfhi(gc.z); dst[6] = bflo(xa.w) * bflo(gc.w); dst[7] = bfhi(xa.w) * bfhi(gc.w); }
            }
            for (int t0 = 0; t0 < 32; t0 += 4) {
                u32x4 xa4[4], gb4[4], gc4[4];
#pragma unroll
                for (int q = 0; q < 4; ++q) { const bf16* pr = PROJ + (size_t)(rowb + t0 + q) * NPROJ + ch; xa4[q] = *(const u32x4*)(pr + C_XA); gb4[q] = *(const u32x4*)(pr + C_GB); gc4[q] = *(const u32x4*)(pr + C_GC); }
#pragma unroll
                for (int q = 0; q < 4; ++q) { const int t = t0 + q;
                const u32x4 xa = xa4[q], gb = gb4[q], gc = gc4[q];
                float u0[8] = {bflo(xa.x) * bflo(gc.x), bfhi(xa.x) * bfhi(gc.x), bflo(xa.y) * bflo(gc.y), bfhi(xa.y) * bfhi(gc.y),
                               bflo(xa.z) * bflo(gc.z), bfhi(xa.z) * bfhi(gc.z), bflo(xa.w) * bflo(gc.w), bfhi(xa.w) * bfhi(gc.w)};
                float gbf[8] = {bflo(gb.x), bfhi(gb.x), bflo(gb.y), bfhi(gb.y), bflo(gb.z), bfhi(gb.z), bflo(gb.w), bfhi(gb.w)};
                float y[8];
#pragma unroll
                for (int i = 0; i < 8; ++i) { y[i] = gbf[i] * (w0[i] * u2[i] + w1[i] * u1[i] + w2[i] * u0[i]); u2[i] = u1[i]; u1[i] = u0[i]; }
                u32x4 o; o.x = cvtpk(y[0], y[1]); o.y = cvtpk(y[2], y[3]); o.z = cvtpk(y[4], y[5]); o.w = cvtpk(y[6], y[7]);
                *(u32x4*)(MIX + (size_t)(rowb + t) * D + ch) = o;
                }
            }
            float* oc = nullptr;
            if (samp) oc = a.out + O_SCONV + (size_t)(l * SBATCH + b) * 2 * 512 + ch;
            else if (seg == NSEG - 1) oc = a.out + O_PCONV + (size_t)(l * NB + b) * 2 * 512 + ch;
            if (oc) {
                *(f32x4*)(oc) = (f32x4){u2[0], u2[1], u2[2], u2[3]}; *(f32x4*)(oc + 4) = (f32x4){u2[4], u2[5], u2[6], u2[7]};
                *(f32x4*)(oc + 512) = (f32x4){u1[0], u1[1], u1[2], u1[3]}; *(f32x4*)(oc + 516) = (f32x4){u1[4], u1[5], u1[6], u1[7]};
            }
        }
    }
}

__device__ __forceinline__ void phase_d(const Args& a, const Ctx& c_in0, int l) {
    const Ctx c = relaunder(c_in0);
    const float* CL = (const float*)(a.ws + WS_CLOC); const float* NL = (const float*)(a.ws + WS_NLOC); float* MSC = (float*)(a.ws + WS_MSC);
    bf16* C0 = (bf16*)(a.ws + WS_C0); float* N0 = (float*)(a.ws + WS_N0);
    LAS float* DEC = (LAS float*)(c.lds + SCR_OFF);
    LAS float* WLO = DEC + 512;
    LAS float* MFIN = WLO + 512;
    LAS float* MLO = MFIN + 16;
    LAS float* BLA = MLO + 512;
    __syncthreads();
    { const int u = c.tid; MLO[u] = MSC[(size_t)u * 4 + 0]; BLA[u] = MSC[(size_t)u * 4 + 1]; }
    __syncthreads();
    if (c.tid < 16) { const int bh = c.tid; float m = 0.f;
        for (int g = 0; g < NGRP; ++g) { const size_t u = (size_t)bh * NGRP + g; const float mloc = MLO[u], blast = BLA[u];
            const float mn = fmaxf(blast + m, mloc); DEC[bh * NGRP + g] = fast_exp(blast + m - mn); WLO[bh * NGRP + g] = fast_exp(mloc - mn);
            if (c.vcu == 0) MSC[u * 4 + 2] = m;
            m = mn; }
        MFIN[bh] = m; }
    __syncthreads();
    const unsigned gt = (unsigned)c.vcu * NTHREADS + c.tid, NT = (unsigned)c.G * NTHREADS;
    constexpr unsigned PER = (unsigned)HD * HD + HD;
    for (unsigned i = gt; i < 16u * PER; i += NT) {
        const int bh = (int)(i / PER); const int e = (int)(i % PER); const bool isn = e >= HD * HD; const int en = e - HD * HD;
        const float* src = isn ? NL + (size_t)bh * NGRP * HD + en : CL + (size_t)bh * NGRP * HD * HD + e;
        const size_t sstep = isn ? HD : (size_t)HD * HD;
        float x[NGRP];
#pragma unroll
        for (int g = 0; g < NGRP; ++g) x[g] = src[(size_t)g * sstep];
        float C = 0.f;
#pragma unroll
        for (int g = 0; g < NGRP; ++g) {
            const size_t u = (size_t)bh * NGRP + g;
            if (isn) N0[u * HD + en] = C; else C0[u * HD * HD + e] = (bf16)(cvtpk(C, 0.f) & 0xffffu);
            C = DEC[bh * NGRP + g] * C + WLO[bh * NGRP + g] * x[g];
        }
        const int b = bh >> 2, h = bh & 3;
        if (isn) a.out[O_PN + ((size_t)(l * NB + b) * MH + h) * HD + en] = C;
        else a.out[O_PC + ((size_t)(l * NB + b) * MH + h) * HD * HD + e] = C;
        if (e == 0) a.out[O_PM + (size_t)(l * NB + b) * MH + h] = MFIN[bh];
    }
}

constexpr float ATT_C = 0.088388347648318440f * LOG2E;
constexpr float THR2 = 8.f * LOG2E;
struct DmaMap { unsigned k0, k1, v0, v1; };
__device__ __forceinline__ DmaMap dma_map(int lane, int wave, int LD) {
    DmaMap m; unsigned kk_[2], vv_[2];
#pragma unroll
    for (int i = 0; i < 2; ++i) { const int o = (wave + 8 * i) * 1024 + lane * 16;
        const int row = o >> 8, c16 = ((o >> 4) & 15) ^ (row & 7); kk_[i] = (unsigned)(row * LD + c16 * 8) * 2u;
        const int sub = o >> 9, kk = ((sub >> 2) << 3) | ((o >> 6) & 7), k = (kk & ~0xC) | ((kk & 4) << 1) | ((kk & 8) >> 1), cc = ((sub & 3) << 5) | ((o & 63) >> 1); vv_[i] = (unsigned)(k * LD + cc) * 2u; }
    m.k0 = kk_[0]; m.k1 = kk_[1]; m.v0 = vv_[0]; m.v1 = vv_[1]; return m;
}
__device__ __forceinline__ void glds16s(const void* sbase, unsigned voff, unsigned lds_dst) { unsigned keep;
    asm volatile("s_mov_b32 %0, m0\n\ts_mov_b32 m0, %3\n\ts_nop 0\n\tglobal_load_lds_dwordx4 %1, %2\n\ts_mov_b32 m0, %0" : "=&s"(keep) : "v"(voff), "s"(sbase), "s"(lds_dst) : "memory"); }
__device__ __forceinline__ void dma_fill(LAS unsigned char* lds, int slot, int wave, const bf16* Ta, unsigned a0, unsigned a1, const bf16* Tb, unsigned b0, unsigned b1) {
    const unsigned d = (unsigned)(uintptr_t)lds + (unsigned)(slot * 32768 + wave * 1024);
    glds16s(Ta, a0, d); glds16s(Ta, a1, d + 8192u); glds16s(Tb, b0, d + 16384u); glds16s(Tb, b1, d + 24576u);
}
#define RING_WAIT_BAR(N) do { asm volatile("s_waitcnt vmcnt(" #N ") lgkmcnt(0)" ::: "memory"); __builtin_amdgcn_s_barrier(); asm volatile("" ::: "memory"); } while (0)

__device__ __forceinline__ float fma_s(float a, float b, float c) { float d; asm("v_fma_f32 %0, %1, %2, %3" : "=v"(d) : "v"(a), "v"(b), "v"(c)); return d; }
__device__ __forceinline__ float add_s(float a, float b) { float d; asm("v_add_f32 %0, %1, %2" : "=v"(d) : "v"(a), "v"(b)); return d; }
#define ATT_SCORE_SOFTMAX(j, slotk)                                                                                                           \
    {   const int K_lds = ldsb + (slotk) * 16384;                                                                                              \
        f32x16 p0, p1; qkt(p0, p1, K_lds, qr, r32, hi);                                                                                       \
        STEP_FILL();                                                             \
        const int Rl = R0 + r32 - 64 * (j);                                                                                                   \
        const int relmin = R0 - 64 * (j) - 63;                                                                                                \
        if (relmin >= 128) { const float bc = BR[0];                                                                                           \
            _Pragma("unroll") for (int r = 0; r < 16; ++r) { p0[r] = fma_s(p0[r], ATT_C, bc); p1[r] = fma_s(p1[r], ATT_C, bc); }                \
        } else {                                                                                                                               \
            const LAS float* bp = BR + (64 + 128 - Rl + 4 * hi);                                                                               \
            _Pragma("unroll") for (int r = 0; r < 16; ++r) { p0[r] = fma_s(p0[r], ATT_C, bp[(r & 3) + 8 * (r >> 2)]); p1[r] = fma_s(p1[r], ATT_C, bp[32 + (r & 3) + 8 * (r >> 2)]); } \
        }                                                                                                                                      \
        const int nvalid = kend - 64 * (j);                                                                                                    \
        if (nvalid < 64) { asm volatile("" ::: "memory");                           \
            _Pragma("unroll") for (int r = 0; r < 16; ++r) { const int kk = crow(r, hi); if (kk >= nvalid) p0[r] = -1e30f; if (kk + 32 >= nvalid) p1[r] = -1e30f; } \
        }                                                                                                                                      \
        float pmax = p0[0];                                                                                                                    \
        _Pragma("unroll") for (int r = 1; r < 16; ++r) pmax = fmaxf(pmax, p0[r]);                                                              \
        _Pragma("unroll") for (int r = 0; r < 16; ++r) pmax = fmaxf(pmax, p1[r]);                                                              \
        pmax = half_swap_max(pmax);                                                                                                            \
        if (!__all(pmax - m_reg <= THR2)) {                                                                                                    \
            const float mn = fmaxf(m_reg, pmax); const float alpha = __builtin_amdgcn_exp2f(m_reg - mn); m_reg = mn;                           \
            l_reg *= alpha;                                                                                                                    \
            if (hi == 0) al_l[r32] = alpha; asm volatile("s_waitcnt lgkmcnt(0)" ::: "memory");                                               \
            _Pragma("unroll") for (int r = 0; r < 16; ++r) { const float al = al_l[crow(r, hi)];                                               \
                _Pragma("unroll") for (int d = 0; d < 4; ++d) o[d][r] *= al; }                                                                 \
        }                                                                                                                                      \
        float ps = 0.f;                                                                                                                        \
        _Pragma("unroll") for (int r = 0; r < 16; ++r) { p0[r] = __builtin_amdgcn_exp2f(p0[r] - m_reg); p1[r] = __builtin_amdgcn_exp2f(p1[r] - m_reg); ps = add_s(ps, add_s(p0[r], p1[r])); } \
        l_reg += half_swap_add(ps);                                                                                                            \
        PK4(p0, 0, pa0); PK4(p0, 8, pa1); PK4(p1, 0, pa2); PK4(p1, 8, pa3);                                                                    \
    }
__device__ __forceinline__ void attn_unit(const Ctx& c, const bf16* __restrict__ Qb, int LDQ, int qrow, const bf16* __restrict__ Kh, const bf16* __restrict__ Vh, int LDK, int NT, int alo, int ahi, int kend,
                                          int R0  , const float* __restrict__ bias_g, bf16* __restrict__ Ob, int LDO, bool do_store, const float* __restrict__ qgain = nullptr, int rot = 0) {
    int tid = c.tid; asm volatile("" : "+v"(tid));
    const int wid = c.wave, lane = tid & 63, r32 = lane & 31, hi = lane >> 5;
    const int ldsb = (int)(uintptr_t)c.lds;
    constexpr int VRING = 49152;
    LAS float* wsf = (LAS float*)(c.lds + 114688) + wid * 64; LAS float* li_l = wsf; LAS float* al_l = wsf + 32;
    LAS float* BR = (LAS float*)(c.lds + SCR_OFF);
    asm volatile("s_waitcnt lgkmcnt(0)" ::: "memory"); __builtin_amdgcn_s_barrier(); asm volatile("" ::: "memory");
    const DmaMap dm = dma_map(lane, wid, LDK);
    const size_t tile_step = (size_t)64 * LDK;
    const unsigned dbase = (unsigned)ldsb + (unsigned)wid * 1024u;
#define ATT_FILL(kt_, vt_, sk_, sv_) do { const unsigned dk_ = dbase + (unsigned)(sk_) * 16384u, dv_ = dbase + VRING + (unsigned)(sv_) * 16384u; \
        glds16s(kt_, dm.k0, dk_); glds16s(kt_, dm.k1, dk_ + 8192u); glds16s(vt_, dm.v0, dv_); glds16s(vt_, dm.v1, dv_ + 8192u); } while (0)
#define TIDX(s_) ((s_) + rot - (((s_) + rot) >= NT ? NT : 0))
    { const int t0_ = TIDX(0), t1_ = TIDX(1);
      ATT_FILL(Kh + t0_ * tile_step, Vh + t0_ * tile_step, 0, 0);
      ATT_FILL(Kh + t1_ * tile_step, Vh + t1_ * tile_step, 1, 1); }
    if (tid < 321) { const int i = tid - 64; BR[tid] = bias_g[256 - (i < 0 ? 0 : i)] * LOG2E; }
    float m_reg = -1e30f, l_reg = 0.f; f32x16 o[4] = {f32x16{}, f32x16{}, f32x16{}, f32x16{}}; bf16x8 qr[8];
    { const bf16* Qw = Qb + (size_t)(qrow + r32) * LDQ + hi * 8;
#pragma unroll
      for (int d0 = 0; d0 < 8; ++d0) qr[d0] = *(const bf16x8*)(Qw + d0 * 16); }
    if (qgain) {
        float f[8][8]; float ss = 0.f;
#pragma unroll
        for (int d0 = 0; d0 < 8; ++d0) { const u32x4 w = *reinterpret_cast<const u32x4*>(&qr[d0]);
            f[d0][0] = bflo(w.x); f[d0][1] = bfhi(w.x); f[d0][2] = bflo(w.y); f[d0][3] = bfhi(w.y); f[d0][4] = bflo(w.z); f[d0][5] = bfhi(w.z); f[d0][6] = bflo(w.w); f[d0][7] = bfhi(w.w);
#pragma unroll
            for (int i = 0; i < 8; ++i) ss += f[d0][i] * f[d0][i]; }
        ss = half_swap_add(ss);
        const float rq = fast_rsqrt(ss * (1.f / HD) + EPS);
#pragma unroll
        for (int d0 = 0; d0 < 8; ++d0) { const f32x4 g0 = *(const f32x4*)(qgain + d0 * 16 + hi * 8), g1 = *(const f32x4*)(qgain + d0 * 16 + hi * 8 + 4);
            u32x4 s; s.x = cvtpk(f[d0][0] * rq * g0[0], f[d0][1] * rq * g0[1]); s.y = cvtpk(f[d0][2] * rq * g0[2], f[d0][3] * rq * g0[3]);
            s.z = cvtpk(f[d0][4] * rq * g1[0], f[d0][5] * rq * g1[1]); s.w = cvtpk(f[d0][6] * rq * g1[2], f[d0][7] * rq * g1[3]);
            qr[d0] = *reinterpret_cast<bf16x8*>(&s); }
    }
#pragma unroll
    for (int d0 = 0; d0 < 8; ++d0) { u32x4 w = *reinterpret_cast<u32x4*>(&qr[d0]); asm volatile("" : "+v"(w)); qr[d0] = *reinterpret_cast<bf16x8*>(&w); }
    asm volatile("" ::: "memory");
    const bool skew = wid >= 4;
    bf16x8 pa0 = bf16x8{}, pa1 = bf16x8{}, pa2 = bf16x8{}, pa3 = bf16x8{};
    int sk = 0, sv = 0;
    bool pact = false;
    for (int j = 0; j < NT; ++j) {
        if (j + 1 < NT) RING_WAIT_BAR(4); else RING_WAIT_BAR(0);
#define STEP_FILL() do { if (j + 2 < NT) { const int fk = sk >= 1 ? sk - 1 : 2, fv = sv >= 2 ? sv - 2 : sv + 2; const int tf = TIDX(j + 2); ATT_FILL(Kh + tf * tile_step, Vh + tf * tile_step, fk, fv); } } while (0)
        const int jt = TIDX(j);
        const bool act = (jt >= alo && jt <= ahi);
        if (skew && pact) { const int svp = sv >= 1 ? sv - 1 : 3; pv_d0(o, ldsb + VRING + svp * 16384 + v_rd_base(lane), pa0, pa1, pa2, pa3); }
        pact = act;
        if (act) { ATT_SCORE_SOFTMAX(jt, sk); } else STEP_FILL();
        if (!skew && act) pv_d0(o, ldsb + VRING + sv * 16384 + v_rd_base(lane), pa0, pa1, pa2, pa3);
        sk = sk == 2 ? 0 : sk + 1; sv = (sv + 1) & 3;
    }
    if (skew && pact) { const int svp = sv >= 1 ? sv - 1 : 3; pv_d0(o, ldsb + VRING + svp * 16384 + v_rd_base(lane), pa0, pa1, pa2, pa3); }
#undef STEP_FILL
#undef TIDX
#undef ATT_FILL
    if (hi == 0) li_l[r32] = l_reg;
    RING_WAIT_BAR(0);
    const int ost = ldsb + wid * 8192;
#pragma unroll
    for (int r = 0; r < 16; ++r) { const int orow = crow(r, hi); const float rl = __builtin_amdgcn_rcpf(li_l[orow]);
#pragma unroll
        for (int d0 = 0; d0 < 4; ++d0) *(LAS bf16*)(uintptr_t)(unsigned)(ost + orow * 256 + (d0 * 32 + r32) * 2) = (bf16)(cvtpk(o[d0][r] * rl, 0.f) & 0xffffu); }
    asm volatile("s_waitcnt lgkmcnt(0)" ::: "memory");
    if (do_store) {
#pragma unroll
        for (int i = 0; i < 8; ++i) { const int ch = i * 64 + lane, row = ch >> 4, c16 = ch & 15;
            const u32x4 w = *(const LAS u32x4*)(uintptr_t)(unsigned)(ost + row * 256 + c16 * 16);
            *(u32x4*)(Ob + (size_t)(qrow + row) * LDO + c16 * 8) = w; }
    }
}
#define ATT_SCORE_FIXED(j, slotk)                                                                                                             \
    {   const int K_lds = ldsb + (slotk) * 16384;                                                                                              \
        f32x16 p0, p1; qkt_b(p0, p1, K_lds, qr, r32, hi);                                                                                       \
        STEP_FILL();                                                                                                                           \
        const int Rl = R0 + r32 - 64 * (j);                                                                                                   \
        const int relmin = R0 - 64 * (j) - 63;                                                                                                \
        if (relmin >= 128) { const float bc = BR[0];                                                                                           \
            _Pragma("unroll") for (int r = 0; r < 16; ++r) { p0[r] = __builtin_amdgcn_exp2f(fma_s(p0[r], ATT_C, bc)); p1[r] = __builtin_amdgcn_exp2f(fma_s(p1[r], ATT_C, bc)); } \
        } else {                                                                                                                               \
            const LAS float* bp = BR + (64 + 128 - Rl + 4 * hi);                                                                               \
            _Pragma("unroll") for (int r = 0; r < 16; ++r) { p0[r] = __builtin_amdgcn_exp2f(fma_s(p0[r], ATT_C, bp[(r & 3) + 8 * (r >> 2)])); p1[r] = __builtin_amdgcn_exp2f(fma_s(p1[r], ATT_C, bp[32 + (r & 3) + 8 * (r >> 2)])); } \
        }                                                                                                                                      \
        float ps0 = add_s(p0[0], p1[0]), ps1 = add_s(p0[1], p1[1]);                                                                            \
        _Pragma("unroll") for (int r = 2; r < 16; r += 2) { ps0 = add_s(ps0, add_s(p0[r], p1[r])); ps1 = add_s(ps1, add_s(p0[r + 1], p1[r + 1])); } \
        l_reg = add_s(l_reg, add_s(ps0, ps1));                             \
        PK4(p0, 0, pa0); PK4(p0, 8, pa1); PK4(p1, 0, pa2); PK4(p1, 8, pa3);                                                                    \
    }
__device__ __forceinline__ void attn_stream(const Args& a, const Ctx& c, int l, const float Mref, const bool docv, const ConvJob& cvj, int& cvk) {
    constexpr int NATT = NB * NH * 32;
    if (c.vcu >= NATT) return;
    int tid = c.tid; asm volatile("" : "+v"(tid));
    const int wid = c.wave, lane = tid & 63, r32 = lane & 31, hi = lane >> 5;
    const int ldsb = (int)(uintptr_t)c.lds;
    constexpr int VRING = 49152;
    LAS float* wsf = (LAS float*)(c.lds + 114688) + wid * 64; LAS float* li_l = wsf; LAS float* al_l = wsf + 32;
    LAS float* BR = (LAS float*)(c.lds + SCR_OFF);
    const bf16* PROJ = (const bf16*)(a.ws + WS_BIG); bf16* MIX = (bf16*)(a.ws + WS_H);
    const int gq = c.vcu & 31, h = (c.vcu >> 5) & 7, b0 = c.vcu >> 8, db = c.G >> 8, nun = (NB - b0 + db - 1) / db;
    const int c0 = 4 * gq, jstart = c0 >= 8 ? 0 : 8 - c0, NT = 12 - jstart, ci = wid >> 1;
    const int alo = ci - jstart < 0 ? 0 : ci - jstart, ahi = ci + 8 - jstart, kend = NT * 64;
    const int R0 = (ci + 8 - jstart) * 64 + (wid & 1) * 32, rot = gq >= 2 ? (8 * gq + 8) % 12 : 0, qrow = wid * 32;
    const float* bias_g = a.rel_bias + (size_t)(l * NH + h) * 257;
    constexpr int LDK = NPROJ, LDO = D;
    asm volatile("s_waitcnt lgkmcnt(0)" ::: "memory"); __builtin_amdgcn_s_barrier(); asm volatile("" ::: "memory");
    const DmaMap dm = dma_map(lane, wid, LDK);
    const size_t tile_step = (size_t)64 * LDK;
    const unsigned dbase = (unsigned)ldsb + (unsigned)wid * 1024u;
#define ATT_FILL(kt_, vt_, sk_, sv_) do { const unsigned dk_ = dbase + (unsigned)(sk_) * 16384u, dv_ = dbase + VRING + (unsigned)(sv_) * 16384u; \
        glds16s(kt_, dm.k0, dk_); glds16s(kt_, dm.k1, dk_ + 8192u); glds16s(vt_, dm.v0, dv_); glds16s(vt_, dm.v1, dv_ + 8192u); } while (0)
#define TIDX(s_) ((s_) + rot - (((s_) + rot) >= NT ? NT : 0))
    const bf16* Qb = PROJ + (size_t)(b0 * SEQ + c0 * 64) * NPROJ + C_Q + h * HD;
    const bf16* Kh = PROJ + (size_t)(b0 * SEQ + (c0 - 8 + jstart) * 64) * NPROJ + C_K + h * HD;
    const bf16* Vh = PROJ + (size_t)(b0 * SEQ + (c0 - 8 + jstart) * 64) * NPROJ + C_V + h * HD;
    bf16* Ob = MIX + (size_t)(b0 * SEQ + c0 * 64) * D + 512 + h * HD;
    const size_t dproj = (size_t)db * SEQ * NPROJ, dmix = (size_t)db * SEQ * D;
    { const int t0_ = TIDX(0), t1_ = TIDX(1);
      ATT_FILL(Kh + t0_ * tile_step, Vh + t0_ * tile_step, 0, 0);
      ATT_FILL(Kh + t1_ * tile_step, Vh + t1_ * tile_step, 1, 1); }
    if (tid < 321) { const int i = tid - 64; BR[tid] = bias_g[256 - (i < 0 ? 0 : i)] * LOG2E - Mref; }
    bf16x8 qr[8];
    { const bf16* Qw = Qb + (size_t)(qrow + r32) * NPROJ + hi * 8;
#pragma unroll
      for (int d0 = 0; d0 < 8; ++d0) qr[d0] = *(const bf16x8*)(Qw + d0 * 16); }
    const bool skew = wid >= 4;
    int sk = 0, sv = 0;
#define Q_CONSUME() do { _Pragma("unroll") for (int d0 = 0; d0 < 8; ++d0) { u32x4 w = *reinterpret_cast<u32x4*>(&qr[d0]); asm volatile("" : "+v"(w)); qr[d0] = *reinterpret_cast<bf16x8*>(&w); } asm volatile("" ::: "memory"); } while (0)
    Q_CONSUME();
#pragma unroll 1
    for (int ui = 0; ui < nun; ++ui) {
        const bool has_next = ui + 1 < nun;
        const bf16* Khn = Kh + dproj; const bf16* Vhn = Vh + dproj;
        float l_reg = 0.f; f32x16 o[4] = {f32x16{}, f32x16{}, f32x16{}, f32x16{}};
        bf16x8 pa0 = bf16x8{}, pa1 = bf16x8{}, pa2 = bf16x8{}, pa3 = bf16x8{};
        bool pact = false, skipw = false;
        for (int j = 0; j < NT; ++j) {
            if (!skipw) { if (j + 1 < NT || has_next) RING_WAIT_BAR(4); else RING_WAIT_BAR(0); }
            skipw = false;
#define STEP_FILL() do { const int fk = sk >= 1 ? sk - 1 : 2, fv = sv >= 2 ? sv - 2 : sv + 2;                                                                  \
                if (j + 2 < NT) { const int tf = TIDX(j + 2); ATT_FILL(Kh + tf * tile_step, Vh + tf * tile_step, fk, fv); }                                         \
                else if (has_next) { const int tf = TIDX(j + 2 - NT); ATT_FILL(Khn + tf * tile_step, Vhn + tf * tile_step, fk, fv); } } while (0)
            const int jt = TIDX(j);
            const bool act = (jt >= alo && jt <= ahi);
            const bool ppv = skew && pact;
            if (ppv) { const int svp = sv >= 1 ? sv - 1 : 3; pv_d0(o, ldsb + VRING + svp * 16384 + v_rd_base(lane), pa0, pa1, pa2, pa3); }
            pact = act;
            if (act) { ATT_SCORE_FIXED(jt, sk); } else STEP_FILL();
            if (!skew && act) pv_d0(o, ldsb + VRING + sv * 16384 + v_rd_base(lane), pa0, pa1, pa2, pa3);
            sk = sk == 2 ? 0 : sk + 1; sv = (sv + 1) & 3;
            const int cit = cvj.gw + cvk * cvj.ngw;
            if (docv && !act && !ppv && j + 1 < NT && cit < CV_I_L) {
                float cvv[32]; conv_load(cvj, cit, lane, cvv); ++cvk;
                if (j + 2 < NT || has_next) RING_WAIT_BAR(36); else RING_WAIT_BAR(32);
                conv_finish(cvj, cit, lane, cvv, c.lds);
                skipw = true;
            }
        }
        if (skew && pact) { const int svp = sv >= 1 ? sv - 1 : 3; pv_d0(o, ldsb + VRING + svp * 16384 + v_rd_base(lane), pa0, pa1, pa2, pa3); }
#undef STEP_FILL
        if (has_next) { const bf16* Qw = Qb + dproj + (size_t)(qrow + r32) * NPROJ + hi * 8;
#pragma unroll
            for (int d0 = 0; d0 < 8; ++d0) qr[d0] = *(const bf16x8*)(Qw + d0 * 16); }
        l_reg = half_swap_add(l_reg);
        if (hi == 0) li_l[r32] = l_reg;
        asm volatile("s_waitcnt lgkmcnt(0)" ::: "memory"); __builtin_amdgcn_s_barrier(); asm volatile("" ::: "memory");
        const int ost = ldsb + VRING + (((wid < 4 ? sv + 2 : sv + 3) & 3) * 16384) + (wid & 3) * 4096;
#pragma unroll
        for (int hf = 0; hf < 2; ++hf) {
#pragma unroll
            for (int r = 0; r < 16; ++r) { const int orow = crow(r, hi); const float rl = __builtin_amdgcn_rcpf(li_l[orow]);
#pragma unroll
                for (int dd = 0; dd < 2; ++dd) *(LAS bf16*)(uintptr_t)(unsigned)(ost + orow * 128 + (dd * 32 + r32) * 2) = (bf16)(cvtpk(o[2 * hf + dd][r] * rl, 0.f) & 0xffffu); }
            asm volatile("s_waitcnt lgkmcnt(0)" ::: "memory");
#pragma unroll
            for (int i = 0; i < 4; ++i) { const int ch = i * 64 + lane, row = ch >> 3, c16 = ch & 7;
                const u32x4 w = *(const LAS u32x4*)(uintptr_t)(unsigned)(ost + row * 128 + c16 * 16);
                *(u32x4*)(Ob + (size_t)(qrow + row) * LDO + hf * 64 + c16 * 8) = w; }
            asm volatile("s_waitcnt lgkmcnt(0)" ::: "memory");
        }
        Qb += dproj; Kh += dproj; Vh += dproj; Ob += dmix;
        if (has_next) Q_CONSUME();
    }
#undef Q_CONSUME
#undef TIDX
#undef ATT_FILL
}
#undef ATT_SCORE_SOFTMAX
#undef ATT_SCORE_FIXED

__device__ __forceinline__ void m3_unit(const Args& a, const Ctx& c, int l, int unit) {
    const int g = unit & 31, bh = unit >> 5, b = bh >> 2, h = bh & 3;
    const bf16* PROJ = (const bf16*)(a.ws + WS_BIG); bf16* MIX = (bf16*)(a.ws + WS_H);
    const float* GATE = (const float*)(a.ws + WS_GATE);
    int tid = c.tid; asm volatile("" : "+v"(tid));
    const int wid = c.wave, lane = tid & 63, r32 = lane & 31, hi = lane >> 5;
    LAS float* scr = (LAS float*)(c.lds + SCR_OFF);
    LAS float* A_S = scr;
    LAS float* M_T = scr + 256;
    LAS float* B_T = scr + 512;
    LAS float* N0L = scr + 768;
    LAS float* TOT = scr + 896;
    const int ldsb = (int)(uintptr_t)c.lds;
    LAS float* wsf = (LAS float*)(c.lds + 98304) + wid * 64;
    const int row0 = b * SEQ + g * 256;
    const float m0 = ((const float*)(a.ws + WS_MSC))[(size_t)unit * 4 + 2];
    asm volatile("s_waitcnt vmcnt(0) lgkmcnt(0)" ::: "memory"); __builtin_amdgcn_s_barrier(); asm volatile("" ::: "memory");
    const DmaMap dm = dma_map(lane, wid, NPROJ); const DmaMap dc = dma_map(lane, wid, HD);
    const bf16* kt = PROJ + (size_t)row0 * NPROJ + C_MK + h * HD; const bf16* vt = PROJ + (size_t)row0 * NPROJ + C_MV + h * HD;
    const bf16* C0 = (const bf16*)(a.ws + WS_C0) + (size_t)unit * HD * HD;
    const size_t tile_step = (size_t)64 * NPROJ;
    dma_fill(c.lds, 0, wid, kt, dm.k0, dm.k1, vt, dm.v0, dm.v1);
    dma_fill(c.lds, 1, wid, kt + tile_step, dm.k0, dm.k1, vt + tile_step, dm.v0, dm.v1);
    bf16x8 qr[8];
    const int trow = wid * 32 + r32;
    { const bf16* Qw = PROJ + (size_t)(row0 + trow) * NPROJ + C_MQ + h * HD + hi * 8;
#pragma unroll
      for (int d0 = 0; d0 < 8; ++d0) qr[d0] = *(const bf16x8*)(Qw + d0 * 16); }
    u32x4 mo8[8];
#pragma unroll
    for (int i = 0; i < 8; ++i) { const int ch = i * 64 + lane, row = ch >> 4, col = (ch & 15) * 8; mo8[i] = *(const u32x4*)(PROJ + (size_t)(row0 + wid * 32 + row) * NPROJ + C_MO + h * HD + col); }
    float li = 0.f, lf = 0.f;
    if (tid < 256) { li = GATE[(size_t)(row0 + tid) * 8 + h]; lf = GATE[(size_t)(row0 + tid) * 8 + 4 + h]; }
    if (tid < 128) N0L[tid] = ((const float*)(a.ws + WS_N0))[(size_t)unit * HD + tid];
    const float bc = scan256_sum(lf, tid, lane, wid, TOT);
    const float as = li - bc;
    const float cm = scan256_max(tid < 256 ? as : -3.0e38f, tid, lane, wid, TOT);
    if (tid < 256) { A_S[tid] = as; M_T[tid] = fmaxf(m0, cm); B_T[tid] = bc; }
    __syncthreads();
    const float Mt = M_T[trow];
    f32x16 o[4] = {f32x16{}, f32x16{}, f32x16{}, f32x16{}};
    float rowsum = 0.f, qn = 0.f;
    const float winter = fast_exp(m0 - Mt);
    const int ci = wid >> 1;
    int slot = 0;
#pragma unroll 1
    for (int j = 0; j < 4; ++j) {
        RING_WAIT_BAR(4);
        { const int fs = slot >= 1 ? slot - 1 : 2;
          if (j + 2 < 4) dma_fill(c.lds, fs, wid, kt + (size_t)(j + 2) * tile_step, dm.k0, dm.k1, vt + (size_t)(j + 2) * tile_step, dm.v0, dm.v1);
          else if (j == 2) dma_fill(c.lds, fs, wid, C0, dc.v0, dc.v1, C0 + 64 * HD, dc.v0, dc.v1); }
        const int S_lds = ldsb + slot * 32768;
        int r32l = r32; asm volatile("" : "+v"(r32l));
        if (j <= ci) {
            f32x16 p0, p1; qkt(p0, p1, S_lds, qr, r32l, hi);
#pragma unroll
            for (int r = 0; r < 16; ++r) { const int s0 = 64 * j + crow(r, hi), s1 = s0 + 32;
                const float w0 = (s0 <= trow) ? fast_exp(A_S[s0] - Mt) * 0.08838834764831845f : 0.f, w1 = (s1 <= trow) ? fast_exp(A_S[s1] - Mt) * 0.08838834764831845f : 0.f;
                p0[r] *= w0; p1[r] *= w1; rowsum += p0[r] + p1[r]; }
            bf16x8 pa0, pa1, pa2, pa3;
            PK4(p0, 0, pa0); PK4(p0, 8, pa1); PK4(p1, 0, pa2); PK4(p1, 8, pa3);
            pv_d0(o, S_lds + 16384 + v_rd_base(lane), pa0, pa1, pa2, pa3);
        }
        slot = slot == 2 ? 0 : slot + 1;
    }
    RING_WAIT_BAR(0);
    {
        const int S_lds = ldsb + slot * 32768;
#pragma unroll
        for (int hf = 0; hf < 2; ++hf) {
            bf16x8 qs[4];
#pragma unroll
            for (int dd = 0; dd < 4; ++dd) { const int d0 = hf * 4 + dd; const u32x4 w = *reinterpret_cast<const u32x4*>(&qr[d0]);
                float f[8] = {bflo(w.x), bfhi(w.x), bflo(w.y), bfhi(w.y), bflo(w.z), bfhi(w.z), bflo(w.w), bfhi(w.w)};
#pragma unroll
                for (int i = 0; i < 8; ++i) qn += f[i] * N0L[d0 * 16 + hi * 8 + i];
                u32x4 s; s.x = cvtpk(f[0] * winter, f[1] * winter); s.y = cvtpk(f[2] * winter, f[3] * winter); s.z = cvtpk(f[4] * winter, f[5] * winter); s.w = cvtpk(f[6] * winter, f[7] * winter);
                qs[dd] = *reinterpret_cast<bf16x8*>(&s); }
            pv_d0(o, S_lds + hf * 16384 + v_rd_base(lane), qs[0], qs[1], qs[2], qs[3]);
        }
    }
    rowsum = half_swap_add(rowsum);
    qn = half_swap_add(qn);
    const float den = winter * qn + rowsum;
    const float dfl = fast_exp(-(B_T[trow] + Mt));
    const float inv = 1.0f / fmaxf(fabsf(den), dfl);
    if (hi == 0) wsf[r32] = inv;
    asm volatile("s_waitcnt lgkmcnt(0)" ::: "memory");
#pragma unroll
    for (int r = 0; r < 16; ++r) { const float sc_ = wsf[crow(r, hi)];
#pragma unroll
        for (int d0 = 0; d0 < 4; ++d0) o[d0][r] *= sc_; }
    RING_WAIT_BAR(0);
    const int hst = ldsb + wid * 16384;
    { int le = lane; asm volatile("" : "+v"(le)); const int r32e = le & 31, hie = le >> 5;
#pragma unroll
    for (int r = 0; r < 16; ++r)
#pragma unroll
        for (int d0 = 0; d0 < 4; ++d0) *(LAS float*)(uintptr_t)(unsigned)(hst + crow(r, hie) * 512 + (d0 * 32 + r32e) * 4) = o[d0][r]; }
    asm volatile("s_waitcnt lgkmcnt(0)" ::: "memory");
    const float* gn = a.mlstm_norm_g + (size_t)l * 512 + h * HD;
    int le = lane; asm volatile("" : "+v"(le));
#pragma unroll
    for (int i = 0; i < 8; ++i) { const int ch = i * 64 + le, row = ch >> 4, col = (ch & 15) * 8;
        const f32x4 a0 = *(const LAS f32x4*)(uintptr_t)(unsigned)(hst + row * 512 + col * 4), a1 = *(const LAS f32x4*)(uintptr_t)(unsigned)(hst + row * 512 + col * 4 + 16);
        float ss = (a0.x * a0.x + a0.y * a0.y) + (a0.z * a0.z + a0.w * a0.w) + (a1.x * a1.x + a1.y * a1.y) + (a1.z * a1.z + a1.w * a1.w);
        ss += shx(ss, 1, le); ss += shx(ss, 2, le); ss += shx(ss, 4, le); ss += shx(ss, 8, le);
        const float rstd = fast_rsqrt(ss * (1.f / HD) + EPS);
        const int orow = row0 + wid * 32 + row;
        const u32x4 mo = mo8[i];
        const f32x4 g0 = *(const f32x4*)(gn + col), g1 = *(const f32x4*)(gn + col + 4);
        float y[8] = {a0.x * g0.x, a0.y * g0.y, a0.z * g0.z, a0.w * g0.w, a1.x * g1.x, a1.y * g1.y, a1.z * g1.z, a1.w * g1.w};
        const float mf[8] = {bflo(mo.x), bfhi(mo.x), bflo(mo.y), bfhi(mo.y), bflo(mo.z), bfhi(mo.z), bflo(mo.w), bfhi(mo.w)};
#pragma unroll
        for (int k = 0; k < 8; ++k) y[k] = y[k] * rstd * (1.0f / (1.0f + fast_exp(-mf[k])));
        u32x4 w; w.x = cvtpk(y[0], y[1]); w.y = cvtpk(y[2], y[3]); w.z = cvtpk(y[4], y[5]); w.w = cvtpk(y[6], y[7]);
        *(u32x4*)(MIX + (size_t)orow * D + 1536 + h * HD + col) = w; }
}

__device__ __forceinline__ void ms_unit(const Args& a, const Ctx& c, int l, int unit) {
    const int b = unit >> 2, h = unit & 3; int tid = c.tid; asm volatile("" : "+v"(tid));
    const int lane = tid & 63, wid = c.wave;
    const bf16* PROJ = (const bf16*)(a.ws + WS_BIG); bf16* MIX = (bf16*)(a.ws + WS_H);
    const float* GATE = (const float*)(a.ws + WS_GATE);
    constexpr int P = 132;
    LAS float* Q = (LAS float*)c.lds;
    LAS float* Kk = Q + 32 * P;
    LAS float* V = Kk + 32 * P;
    LAS float* HB = V + 32 * P;
    LAS float* S = HB + 32 * P;
    LAS float* N0 = S + 32 * 33;
    LAS float* A_S = N0 + 128;
    LAS float* M_T = A_S + 32;
    LAS float* B_T = M_T + 32;
    LAS float* WST = B_T + 32;
    LAS float* DEN = WST + 32;
    LAS float* WIN = DEN + 32;
    LAS float* SC = WIN + 32;
    const int row0 = MP + b * SSEQ;
    const size_t sidx = (size_t)(l * SBATCH + b) * MH + h;
    const float* C0 = a.state_c + sidx * HD * HD;
    __syncthreads();
    for (int i = tid; i < 1536; i += NTHREADS) { const int which = i >> 9, r = (i >> 4) & 31, c8 = (i & 15) * 8;
        const u32x4 w = *(const u32x4*)(PROJ + (size_t)(row0 + r) * NPROJ + (which == 0 ? C_MQ : which == 1 ? C_MK : C_MV) + h * HD + c8);
        const float sc = which == 1 ? 0.08838834764831845f : 1.0f;
        LAS float* dst = (which == 0 ? Q : which == 1 ? Kk : V) + r * P + c8;
        *(LAS f32x4*)dst = (f32x4){bflo(w.x) * sc, bfhi(w.x) * sc, bflo(w.y) * sc, bfhi(w.y) * sc};
        *(LAS f32x4*)(dst + 4) = (f32x4){bflo(w.z) * sc, bfhi(w.z) * sc, bflo(w.w) * sc, bfhi(w.w) * sc}; }
    if (tid < 128) N0[tid] = a.state_n[sidx * HD + tid];
    if (wid == 0) {
        const int t = lane & 31; const float m0 = a.state_m[sidx];
        const float li = GATE[(size_t)(row0 + t) * 8 + h], lf = GATE[(size_t)(row0 + t) * 8 + 4 + h];
        float bc = lf;
#pragma unroll
        for (int o = 1; o < 32; o <<= 1) { const float x = shup(bc, o, lane); if ((lane & 31) >= o) bc += x; }
        const float as = li - bc; float cm = as;
#pragma unroll
        for (int o = 1; o < 32; o <<= 1) { const float x = shup(cm, o, lane); if ((lane & 31) >= o) cm = fmaxf(cm, x); }
        const float blast = __int_as_float(__builtin_amdgcn_ds_bpermute(31 << 2, __float_as_int(bc))), amax = __int_as_float(__builtin_amdgcn_ds_bpermute(31 << 2, __float_as_int(cm)));
        const float Mt = fmaxf(m0, cm), mnew = fmaxf(blast + m0, blast + amax);
        if (lane < 32) { A_S[t] = as; B_T[t] = bc; M_T[t] = Mt; WST[t] = fast_exp(blast + as - mnew); WIN[t] = fast_exp(m0 - Mt); }
        if (lane == 0) { SC[0] = m0; SC[1] = blast; SC[2] = mnew; SC[3] = fast_exp(blast + m0 - mnew); }
    }
    __syncthreads();
    for (int i = tid; i < 1024; i += NTHREADS) { const int t = i >> 5, s = i & 31; float d = 0.f;
        if (s <= t) {
#pragma unroll 8
            for (int k = 0; k < 128; k += 4) { const f32x4 q4 = *(const LAS f32x4*)(Q + t * P + k), k4 = *(const LAS f32x4*)(Kk + s * P + k); d += (q4.x * k4.x + q4.y * k4.y) + (q4.z * k4.z + q4.w * k4.w); }
            d *= fast_exp(A_S[s] - M_T[t]); }
        S[t * 33 + s] = d; }
    __syncthreads();
    if (tid < 32) { const int t = tid; float qn = 0.f, rs = 0.f;
        for (int k = 0; k < 128; ++k) qn += Q[t * P + k] * N0[k];
        for (int s = 0; s < 32; ++s) rs += S[t * 33 + s];
        const float den = WIN[t] * qn + rs; DEN[t] = 1.0f / fmaxf(fabsf(den), fast_exp(-(B_T[t] + M_T[t]))); }
    const int e = tid & 127, tg = tid >> 7;
    { float acc[8];
#pragma unroll
      for (int i = 0; i < 8; ++i) acc[i] = 0.f;
      for (int d0 = 0; d0 < 128; d0 += 16) { float cv[16];
#pragma unroll
          for (int j = 0; j < 16; ++j) cv[j] = C0[(size_t)(d0 + j) * HD + e];
#pragma unroll
          for (int j = 0; j < 16; j += 4)
#pragma unroll
              for (int i = 0; i < 8; ++i) { const f32x4 q4 = *(const LAS f32x4*)(Q + (tg * 8 + i) * P + d0 + j); acc[i] += (q4.x * cv[j] + q4.y * cv[j + 1]) + (q4.z * cv[j + 2] + q4.w * cv[j + 3]); } }
      __syncthreads();
#pragma unroll
      for (int i = 0; i < 8; ++i) { const int t = tg * 8 + i; float v = acc[i] * WIN[t];
          for (int s = 0; s <= t; ++s) v += S[t * 33 + s] * V[s * P + e];
          HB[t * P + e] = v * DEN[t]; } }
    __syncthreads();
    { const int t = tid >> 4, e0 = (tid & 15) * 8; float ss = 0.f;
      const f32x4 h0 = *(const LAS f32x4*)(HB + t * P + e0), h1 = *(const LAS f32x4*)(HB + t * P + e0 + 4);
      ss = (h0.x * h0.x + h0.y * h0.y) + (h0.z * h0.z + h0.w * h0.w) + (h1.x * h1.x + h1.y * h1.y) + (h1.z * h1.z + h1.w * h1.w);
      ss += shx(ss, 1, lane); ss += shx(ss, 2, lane); ss += shx(ss, 4, lane); ss += shx(ss, 8, lane);
      const float rstd = fast_rsqrt(ss * (1.f / HD) + EPS);
      const u32x4 mo = *(const u32x4*)(PROJ + (size_t)(row0 + t) * NPROJ + C_MO + h * HD + e0);
      const float* gn = a.mlstm_norm_g + (size_t)l * 512 + h * HD + e0;
      const f32x4 g0 = *(const f32x4*)gn, g1 = *(const f32x4*)(gn + 4);
      float y[8] = {h0.x * g0.x, h0.y * g0.y, h0.z * g0.z, h0.w * g0.w, h1.x * g1.x, h1.y * g1.y, h1.z * g1.z, h1.w * g1.w};
      const float mf[8] = {bflo(mo.x), bfhi(mo.x), bflo(mo.y), bfhi(mo.y), bflo(mo.z), bfhi(mo.z), bflo(mo.w), bfhi(mo.w)};
#pragma unroll
      for (int k = 0; k < 8; ++k) y[k] = y[k] * rstd * (1.0f / (1.0f + fast_exp(-mf[k])));
      u32x4 w; w.x = cvtpk(y[0], y[1]); w.y = cvtpk(y[2], y[3]); w.z = cvtpk(y[4], y[5]); w.w = cvtpk(y[6], y[7]);
      *(u32x4*)(MIX + (size_t)(row0 + t) * D + 1536 + h * HD + e0) = w; }
    { const float decay = SC[3]; const int dg = tg * 32; float acc[32];
#pragma unroll
      for (int i = 0; i < 32; ++i) acc[i] = C0[(size_t)(dg + i) * HD + e] * decay;
      for (int s = 0; s < 32; ++s) { const float vv = V[s * P + e] * WST[s];
#pragma unroll
          for (int i = 0; i < 32; i += 4) { const f32x4 k4 = *(const LAS f32x4*)(Kk + s * P + dg + i); acc[i] += k4.x * vv; acc[i + 1] += k4.y * vv; acc[i + 2] += k4.z * vv; acc[i + 3] += k4.w * vv; } }
      float* oc = a.out + O_SC + sidx * HD * HD;
#pragma unroll
      for (int i = 0; i < 32; ++i) oc[(size_t)(dg + i) * HD + e] = acc[i];
      if (tid < 128) { float v = decay * N0[tid]; for (int s = 0; s < 32; ++s) v += WST[s] * Kk[s * P + tid]; a.out[O_SN + sidx * HD + tid] = v; }
      if (tid == 0) a.out[O_SM + sidx] = SC[2]; }
}

__device__ __forceinline__ void phase_e(const Args& a, const Ctx& c_in0, int l) {
    const Ctx c = relaunder(c_in0);
    const bf16* PROJ = (const bf16*)(a.ws + WS_BIG); bf16* MIX = (bf16*)(a.ws + WS_H);
    constexpr int NATT = NB * NH * 32;
#if (PE_EN & 1)
    const bool hasjob = l + 1 < DEPTH;
    const ConvJob job{a.w_in, a.w_out, a.w_up, a.w_down, a.norm_mix_g, a.norm_mlp_g, a.ws, l + 1, c.vcu * NWAVES + c.wave, c.G * NWAVES}; int cvk = 0;
    if (hasjob) {
        __syncthreads();
        *(LAS f32x4*)(c.lds + GT0_OFF + c.tid * 16) = *(const f32x4*)(a.norm_mix_g + (size_t)(l + 1) * D + c.tid * 4);
        *(LAS f32x4*)(c.lds + GT1_OFF + c.tid * 16) = *(const f32x4*)(a.norm_mlp_g + (size_t)(l + 1) * D + c.tid * 4);
    }
    float Mref;
    { const float* gq_ = a.q_norm_g + l * HD; const float* gk_ = a.k_norm_g + l * HD; const float* bs_ = a.rel_bias + (size_t)(l * NH + ((c.vcu >> 5) & 7)) * 257;
      float gqm = fmaxf(fabsf(gq_[c.lane]), fabsf(gq_[c.lane + 64])), gkm = fmaxf(fabsf(gk_[c.lane]), fabsf(gk_[c.lane + 64]));
      float bm = fmaxf(fmaxf(bs_[c.lane], bs_[c.lane + 64]), fmaxf(bs_[c.lane + 128], bs_[c.lane + 192])); bm = fmaxf(bm, bs_[256]);
#pragma unroll
      for (int o_ = 1; o_ < 64; o_ <<= 1) { gqm = fmaxf(gqm, shx(gqm, o_, c.lane)); gkm = fmaxf(gkm, shx(gkm, o_, c.lane)); bm = fmaxf(bm, shx(bm, o_, c.lane)); }
      Mref = 16.5f * gqm * gkm + bm * LOG2E; }
    if ((c.G & 255) == 0 && Mref <= 100.f) attn_stream(a, c, l, Mref, hasjob, job, cvk);
    else
    for (int u = c.vcu; u < NATT; u += c.G) {
        const int gq = u & 31, bhh = u >> 5, b = bhh >> 3, h = bhh & 7;
        const int c0 = 4 * gq, jstart = c0 >= 8 ? 0 : 8 - c0, NT = 12 - jstart, ci = c.wave >> 1;
        const int krow0 = b * SEQ + (c0 - 8 + jstart) * 64;
        const int alo = ci - jstart, ahi = ci + 8 - jstart;
        const int R0 = (ci + 8 - jstart) * 64 + (c.wave & 1) * 32;
        attn_unit(c, PROJ + (size_t)(b * SEQ + c0 * 64) * NPROJ + C_Q + h * HD, NPROJ, c.wave * 32, PROJ + (size_t)krow0 * NPROJ + C_K + h * HD, PROJ + (size_t)krow0 * NPROJ + C_V + h * HD, NPROJ,
                  NT, alo < 0 ? 0 : alo, ahi, NT * 64, R0, a.rel_bias + (size_t)(l * NH + h) * 257, MIX + (size_t)(b * SEQ + c0 * 64) * D + 512 + h * HD, D, true, nullptr,
                  gq >= 2 ? (8 * gq + 8) % 12 : 0);
    }
    if (hasjob) { while (conv_step(job, cvk, c.lane, c.lds)) {} }
#endif
#if (PE_EN & 4)
    for (int u = c.vcu; u < 16 * NGRP; u += c.G) m3_unit(a, c, l, u);
#endif
}
__device__ __forceinline__ void sample_kv_prep(const Args& a, const Ctx& c, int l, int b, int h) {
    int tid = c.tid; asm volatile("" : "+v"(tid));
    const int lane = tid & 63, row = tid >> 4, c8 = (tid & 15) * 8;
    const bf16* PROJ = (const bf16*)(a.ws + WS_BIG);
    bf16* SK = (bf16*)(a.ws + WS_SK + (size_t)(l & 1) * SKV_IMG); bf16* SV = (bf16*)(a.ws + WS_SV + (size_t)(l & 1) * SKV_IMG);
    const size_t ro = (size_t)(MP + b * SSEQ + row) * NPROJ + h * HD + c8;
    const u32x4 kq = *(const u32x4*)(PROJ + ro + C_K), vq = *(const u32x4*)(PROJ + ro + C_V);
    float x[8] = {bflo(kq.x), bfhi(kq.x), bflo(kq.y), bfhi(kq.y), bflo(kq.z), bfhi(kq.z), bflo(kq.w), bfhi(kq.w)};
    float ss = 0.f;
#pragma unroll
    for (int i = 0; i < 8; ++i) ss += x[i] * x[i];
    ss += shx(ss, 1, lane); ss += shx(ss, 2, lane); ss += shx(ss, 4, lane); ss += shx(ss, 8, lane);
    const float rk = fast_rsqrt(ss * (1.f / HD) + EPS);
    const float* gk = a.k_norm_g + l * HD + c8; const f32x4 g0 = *(const f32x4*)gk, g1 = *(const f32x4*)(gk + 4);
    x[0] *= rk * g0[0]; x[1] *= rk * g0[1]; x[2] *= rk * g0[2]; x[3] *= rk * g0[3]; x[4] *= rk * g1[0]; x[5] *= rk * g1[1]; x[6] *= rk * g1[2]; x[7] *= rk * g1[3];
    u32x4 o; o.x = cvtpk(x[0], x[1]); o.y = cvtpk(x[2], x[3]); o.z = cvtpk(x[4], x[5]); o.w = cvtpk(x[6], x[7]);
    const size_t io = ((size_t)b * SKV_ROWS + 512 + row) * 1024 + h * HD + c8;
    *(u32x4*)(SK + io) = o; *(u32x4*)(SV + io) = vq;
    const size_t oo = ((size_t)(l * SBATCH + b) * SSEQ + row) * 1024 + h * HD + c8;
    float* ok = a.out + O_SK + oo; float* ov = a.out + O_SV + oo;
    *(f32x4*)ok = (f32x4){x[0], x[1], x[2], x[3]}; *(f32x4*)(ok + 4) = (f32x4){x[4], x[5], x[6], x[7]};
    *(f32x4*)ov = (f32x4){bflo(vq.x), bfhi(vq.x), bflo(vq.y), bfhi(vq.y)}; *(f32x4*)(ov + 4) = (f32x4){bflo(vq.z), bfhi(vq.z), bflo(vq.w), bfhi(vq.w)};
    asm volatile("s_waitcnt vmcnt(0)" ::: "memory"); __syncthreads();
}
__device__ __forceinline__ void sample_mixers(const Args& a, const Ctx& c, int l) {
    const bf16* PROJ = (const bf16*)(a.ws + WS_BIG); bf16* MIX = (bf16*)(a.ws + WS_H);
#if (PE_EN & 2)
    for (int su = c.vcu; su < SBATCH * NH; su += c.G) {
        const int b = su >> 3, h = su & 7;
        sample_kv_prep(a, c, l, b, h);
        const bf16* SK = (const bf16*)(a.ws + WS_SK + (size_t)(l & 1) * SKV_IMG) + (size_t)b * SKV_ROWS * 1024 + h * HD; const bf16* SV = (const bf16*)(a.ws + WS_SV + (size_t)(l & 1) * SKV_IMG) + (size_t)b * SKV_ROWS * 1024 + h * HD;
        attn_unit(c, PROJ + (size_t)(MP + b * SSEQ) * NPROJ + C_Q + h * HD, NPROJ, 0, SK, SV, 1024, 9, 0, 8, 544, 512, a.rel_bias + (size_t)(l * NH + h) * 257,
                  MIX + (size_t)(MP + b * SSEQ) * D + 512 + h * HD, D, c.wave == 0, a.q_norm_g + l * HD);
    }
#endif
#if (PE_EN & 8)
    for (int u = c.vcu - SBATCH * NH; u >= 0 && u < SBATCH * MH; u += c.G) ms_unit(a, c, l, u);
#endif
    __syncthreads();
}
typedef const __attribute__((address_space(4))) Args* KArgP;
#if defined(__HIP_DEVICE_COMPILE__)
__device__ __forceinline__ Args get_args() { KArgP p = (KArgP)__builtin_amdgcn_kernarg_segment_ptr(); asm volatile("" : "+s"(p)); return *p; }
#else
__device__ Args get_args();
#endif
__global__ void __launch_bounds__(NTHREADS, 2) fwd(Args args) {
    extern __shared__ __attribute__((aligned(16))) unsigned char lds_raw[];
    Ctx c; c.lds = (LAS unsigned char*)lds_raw; c.wave = __builtin_amdgcn_readfirstlane((int)threadIdx.x >> 6); c.tid = hw_tid(c.wave); c.lane = c.tid & 63;
    c.G = gridDim.x; { const int bx = blockIdx.x; c.vcu = (c.G % 8 == 0) ? (bx % 8) * (c.G / 8) + bx / 8 : bx; }
    volatile LAS unsigned* MISC = (volatile LAS unsigned*)(c.lds + MISC_OFF);
    { const int t0 = hw_tid(c.wave); if (t0 < 16) MISC[t0] = 0u; }
    __syncthreads();
    unsigned* barw = (unsigned*)(get_args().ws + WS_CTL) + 4096;
    XcdBarrier bar; bar.bar = barw; bar.x = 0; bar.st = nullptr;
    const int lo = args.ph_lo, hi = args.ph_hi;
    const bool multi = (hi - lo) > 1;
    if (multi) bar = xcd_barrier_post(barw, MISC + 8, hw_tid(c.wave) == 0);
#define IN(k) (lo <= (k) && (k) < hi)
#define SEAM(k) do { if (IN(k) && IN((k) + 1)) xcd_barrier(bar.bar, bar.x, bar.st, c.wave); } while (0)
    for (int l = 0; l < DEPTH; ++l) {
        const int pb = l * NPH_LAYER;
        if (IN(pb + 0)) {
#if (PH_EN >> 1) & 1
            { const Args A_ = get_args(); phase_norm<true>(A_, c, l); }
#if (PH_DUP >> 1) & 1
            { __syncthreads(); const Args A_ = get_args(); phase_norm<true>(A_, c, l); }
#endif
#endif
 __syncthreads(); SEAM(pb + 0); }
        if (IN(pb + 1)) {
            const Args A_ = get_args(); bf16* H = (bf16*)(A_.ws + WS_H); bf16* BIG = (bf16*)(A_.ws + WS_BIG);
            bf16* XBp = (bf16*)(A_.ws + WS_XB); const float* RS = (const float*)(A_.ws + WS_RSTD);
            pg8::Gemm g{XBp, (const bf16*)(A_.ws + WS_WIN + (size_t)(l & 1) * WSET), MP, NPROJ, D}; pg8::StaticOrder S; S.init(MP, NPROJ, c.G, (int)blockIdx.x, WGM_B);
            pg8::EpiProj E{BIG, NPROJ, A_.q_norm_g + l * HD, A_.k_norm_g + l * HD, (LAS float*)(c.lds + SCR_OFF), RS};

#if (PH_EN >> 2) & 1
            const int xcd_ = (c.vcu * 8) / c.G, nbef = xcd_ >= 6 ? (1 << 20) : (xcd_ >= 3 ? 1 : 0);
            { SEpiBf16 SE{BIG + (size_t)MP * NPROJ, NPROJ, 0, RS + MP}; sample_gemm(c.lds, c.wave, c.vcu, c.G, XBp + (size_t)MP * D, g.Bt, NPROJ, D, SE, 0, nbef); }
            for (int rep_ = 0, nrep_ = ((PH_DUP >> 2) & 1) ? A_.rep : 1; rep_ < nrep_; ++rep_) pg8::gemm_phase<pg8::EpiProj, pg8::StaticOrder, true, true>(c.lds, g, S, E, c.wave);
            { SEpiBf16 SE{BIG + (size_t)MP * NPROJ, NPROJ, 0, RS + MP}; sample_gemm(c.lds, c.wave, c.vcu, c.G, XBp + (size_t)MP * D, g.Bt, NPROJ, D, SE, nbef); }
#endif

            SEAM(pb + 1);
        }
        if (IN(pb + 2)) {
#if (PH_EN >> 3) & 1
            { const Args A_ = get_args(); phase_c<true>(A_, c, l); }
#if (PH_DUP >> 3) & 1
            { __syncthreads(); const Args A_ = get_args(); phase_c<false>(A_, c, l); }
#endif
#endif
 SEAM(pb + 2); }
        if (IN(pb + 3)) {
#if (PH_EN >> 4) & 1
            { const Args A_ = get_args(); phase_d(A_, c, l); }
            { const Args A_ = get_args(); if (l + 1 < DEPTH) build_kv_image(A_, c.vcu, c.G, hw_tid(c.wave), l + 1); }
#if (PH_DUP >> 4) & 1
            { __syncthreads(); const Args A_ = get_args(); phase_d(A_, c, l); }
#endif
#endif
 SEAM(pb + 3); }
        if (IN(pb + 4)) {
#if (PH_EN >> 5) & 1
            { const Args A_ = get_args(); phase_e(A_, c, l); }
#if (PH_DUP >> 5) & 1
            { __syncthreads(); const Args A_ = get_args(); phase_e(A_, c, l); }
#endif
#endif
 __syncthreads(); SEAM(pb + 4); }
        if (IN(pb + 5)) {
            const Args A_ = get_args(); bf16* H = (bf16*)(A_.ws + WS_H);
            pg8::Gemm g{H, (const bf16*)(A_.ws + WS_WOUT + (size_t)(l & 1) * WSET), MP, D, D}; pg8::StaticOrder S; S.init(MP, D, c.G, (int)blockIdx.x, WGM_F);
            pg8::EpiResAdd E{(bf16*)(A_.ws + WS_XB), A_.out, D, false};

#if (PH_EN >> 6) & 1
            const int xcd_ = (c.vcu * 8) / c.G, nbef = xcd_ >= 4 ? (1 << 20) : 0;
            { SEpiResAdd SE{(bf16*)(A_.ws + WS_XB) + (size_t)MP * D, A_.out + (size_t)MP * D, D, false}; sample_gemm<SEpiResAdd, 32>(c.lds, c.wave, c.vcu, c.G, H + (size_t)MP * D, g.Bt, D, D, SE, 0, nbef); }
            pg8::gemm_phase<pg8::EpiResAdd, pg8::StaticOrder, true, true>(c.lds, g, S, E, c.wave);
            { SEpiResAdd SE{(bf16*)(A_.ws + WS_XB) + (size_t)MP * D, A_.out + (size_t)MP * D, D, false}; sample_gemm<SEpiResAdd, 32>(c.lds, c.wave, c.vcu, c.G, H + (size_t)MP * D, g.Bt, D, D, SE, nbef); }
#if (PH_DUP >> 6) & 1
            { pg8::EpiBf16<0> E2{(bf16*)(A_.ws + WS_BIG), D, nullptr, (LAS float*)(c.lds + SCR_OFF)}; pg8::gemm_phase<pg8::EpiBf16<0>, pg8::StaticOrder, true, true>(c.lds, g, S, E2, c.wave); }
#endif
#endif

            SEAM(pb + 5);
        }
        if (IN(pb + 6)) {
#if (PH_EN >> 7) & 1
            { const Args A_ = get_args(); phase_norm<false>(A_, c, l); }
#if (PH_DUP >> 7) & 1
            { __syncthreads(); const Args A_ = get_args(); phase_norm<false>(A_, c, l); }
#endif
#endif
 SEAM(pb + 6); }
        if (IN(pb + 7)) {
            const Args A_ = get_args(); bf16* H = (bf16*)(A_.ws + WS_H); bf16* BIG = (bf16*)(A_.ws + WS_BIG);
            bf16* XBp = (bf16*)(A_.ws + WS_XB); const float* RS = (const float*)(A_.ws + WS_RSTD);
            pg8::Gemm g{XBp, (const bf16*)(A_.ws + WS_WUP + (size_t)(l & 1) * WSET), MP, FF, D}; pg8::StaticOrder S; S.init(MP, FF, c.G, (int)blockIdx.x, WGM_H);
            pg8::EpiBf16<1> E{BIG, FF, RS, (LAS float*)(c.lds + SCR_OFF)};

#if (PH_EN >> 8) & 1
            const int xcd_ = (c.vcu * 8) / c.G, nbef = xcd_ >= 6 ? (1 << 20) : (xcd_ >= 3 ? 1 : 0);
            { SEpiBf16 SE{BIG + (size_t)MP * FF, FF, 1, RS + MP}; sample_gemm(c.lds, c.wave, c.vcu, c.G, XBp + (size_t)MP * D, g.Bt, FF, D, SE, 0, nbef); }
            for (int rep_ = 0, nrep_ = ((PH_DUP >> 8) & 1) ? A_.rep : 1; rep_ < nrep_; ++rep_) pg8::gemm_phase<pg8::EpiBf16<1>, pg8::StaticOrder, true, true>(c.lds, g, S, E, c.wave);
            { SEpiBf16 SE{BIG + (size_t)MP * FF, FF, 1, RS + MP}; sample_gemm(c.lds, c.wave, c.vcu, c.G, XBp + (size_t)MP * D, g.Bt, FF, D, SE, nbef); }
#endif

            SEAM(pb + 7);
        }
        if (IN(pb + 8)) {
            const Args A_ = get_args(); bf16* BIG = (bf16*)(A_.ws + WS_BIG);
            pg8::Gemm g{BIG, (const bf16*)(A_.ws + WS_WDN + (size_t)(l & 1) * WSET), MP, D, FF}; pg8::StaticOrder S; S.init(MP, D, c.G, (int)blockIdx.x, WGM_I);
            pg8::EpiResAdd E{(bf16*)(A_.ws + WS_XB), A_.out, D, l == DEPTH - 1};

#if (PH_EN >> 9) & 1
            const int xcd_ = (c.vcu * 8) / c.G, nbef = xcd_ >= 4 ? (1 << 20) : 0;
            { SEpiResAdd SE{(bf16*)(A_.ws + WS_XB) + (size_t)MP * D, A_.out + (size_t)MP * D, D, l == DEPTH - 1}; sample_gemm<SEpiResAdd, 32>(c.lds, c.wave, c.vcu, c.G, BIG + (size_t)MP * FF, g.Bt, D, FF, SE, 0, nbef); }
            pg8::gemm_phase<pg8::EpiResAdd, pg8::StaticOrder, true, true>(c.lds, g, S, E, c.wave);
            { SEpiResAdd SE{(bf16*)(A_.ws + WS_XB) + (size_t)MP * D, A_.out + (size_t)MP * D, D, l == DEPTH - 1}; sample_gemm<SEpiResAdd, 32>(c.lds, c.wave, c.vcu, c.G, BIG + (size_t)MP * FF, g.Bt, D, FF, SE, nbef); }
#if (PH_DUP >> 9) & 1
            { pg8::EpiBf16<0> E2{(bf16*)(A_.ws + WS_H), D, nullptr, (LAS float*)(c.lds + SCR_OFF)}; pg8::gemm_phase<pg8::EpiBf16<0>, pg8::StaticOrder, true, true>(c.lds, g, S, E2, c.wave); }
#endif
#endif

            SEAM(pb + 8);
        }
    }
#undef IN
#undef SEAM
}

extern "C" void kernel_launch(void* const* d_in, const int* in_sizes, int n_in, void* d_out, int out_size, void* d_ws, size_t ws_size, hipStream_t stream) {
    static int grid = 0;
    if (grid == 0) {
        if (n_in != 21 || (size_t)out_size != O_END || ws_size < WS_END) { fprintf(stderr, "kernel_launch: shape mismatch n_in %d out %d ws %zu (need %zu)\n", n_in, out_size, ws_size, (size_t)WS_END); grid = -1; return; }
        int dev = 0, cus = 0, per_cu = 0;
        if (hipGetDevice(&dev) != hipSuccess || hipDeviceGetAttribute(&cus, hipDeviceAttributeMultiprocessorCount, dev) != hipSuccess) { grid = -1; return; }
        if (hipFuncSetAttribute((const void*)fwd, hipFuncAttributeMaxDynamicSharedMemorySize, LDS_BYTES) != hipSuccess) { fprintf(stderr, "kernel_launch: hipFuncSetAttribute failed\n"); grid = -1; return; }
        if (hipOccupancyMaxActiveBlocksPerMultiprocessor(&per_cu, (const void*)fwd, NTHREADS, LDS_BYTES) != hipSuccess || per_cu < 1) { fprintf(stderr, "kernel_launch: occupancy query says %d\n", per_cu); }
        (void)hipGetLastError();
        grid = cus;
    }
    if (grid < 0) return;
    (void)hipMemsetAsync((char*)d_ws + WS_CTL, 0, CTL_BYTES, stream);
    Args a{};
    a.x_prompt = (const float*)d_in[0]; a.x_sample = (const float*)d_in[1]; a.cache_k = (const float*)d_in[2]; a.cache_v = (const float*)d_in[3]; a.state_conv = (const float*)d_in[4];
    a.state_c = (const float*)d_in[5]; a.state_n = (const float*)d_in[6]; a.state_m = (const float*)d_in[7]; a.norm_mix_g = (const float*)d_in[8]; a.w_in = (const float*)d_in[9];
    a.conv_w = (const float*)d_in[10]; a.q_norm_g = (const float*)d_in[11]; a.k_norm_g = (const float*)d_in[12]; a.rel_bias = (const float*)d_in[13]; a.b_igate = (const float*)d_in[14];
    a.b_fgate = (const float*)d_in[15]; a.mlstm_norm_g = (const float*)d_in[16]; a.w_out = (const float*)d_in[17]; a.norm_mlp_g = (const float*)d_in[18]; a.w_up = (const float*)d_in[19];
    a.w_down = (const float*)d_in[20]; a.out = (float*)d_out; a.ws = (unsigned char*)d_ws;
#if MK_PER_PHASE
    for (int p = 0; p < NPHASES; ++p) { a.ph_lo = p; a.ph_hi = p + 1; a.rep = 2; hipLaunchKernelGGL(fwd, dim3(grid), dim3(NTHREADS), LDS_BYTES, stream, a); }
#else
    a.ph_lo = 0; a.ph_hi = NPHASES; a.rep = 2; hipLaunchKernelGGL(fwd, dim3(grid), dim3(NTHREADS), LDS_BYTES, stream, a);
#endif
    const hipError_t le = hipPeekAtLastError();
    if (le != hipSuccess) fprintf(stderr, "kernel_launch: launch failed: %s\n", hipGetErrorName(le));
}
```
